# Optimizing an MI355X kernel written in HIP

```python
import math
import jax
import jax.numpy as jnp
from jax import lax
import numpy as np


D_MODEL = 1024
BATCH = 2
SEQ = 16384
DEPTH = 2
DEC_BATCH = 16
DEC_SEQ = 2048
PAST_LEN = 128

PLE_DIM = 256
D_FF = 2816
ROPE_THETA = 10000.0
NORM_EPS = 1e-6
Q_BLOCK = 128
N_BRANCH = 4
BRANCH_WIDTH = 256
NEG_BIG = -1e30

MLA_HEADS = 4
MLA_Q_RANK = 256
MLA_KV_RANK = 128
MLA_NOPE = 64
MLA_ROPE = 32
MLA_V = 64

DIFF_HEADS = 4
DIFF_HD = 32
DIFF_VD = 2 * DIFF_HD
DIFF_QK = 2 * DIFF_HEADS * DIFF_HD
DIFF_V_COLS = DIFF_HEADS * DIFF_VD

DN_HEADS = 4
DN_DK = 64
DN_DV = 64
DN_CONV = 5
DN_CHUNK = 64
DN_QKV = DN_HEADS * (2 * DN_DK + DN_DV)

DIL_GROUPS = ((128, 1), (512, 4), (2048, 16))
DIL_HEADS = 4
DIL_HD = 64
DIL_COLS = len(DIL_GROUPS) * DIL_HEADS * DIL_HD

IN_SIZES = (MLA_Q_RANK, MLA_KV_RANK, MLA_ROPE,
            DIFF_QK, DIFF_QK, DIFF_V_COLS,
            DN_QKV, DN_HEADS, DN_HEADS, DN_HEADS, DN_HEADS, DN_HEADS * DN_DV,
            DIL_COLS, DIL_COLS, DIL_COLS)
IN_COLS = sum(IN_SIZES)

kernel_name = 'hybrid_bidir_mla_diff_gdn_dilated_encoder'


def rmsnorm(x, g):
    xf = x.astype(jnp.float32)
    y = xf * lax.rsqrt(jnp.mean(xf * xf, axis=-1, keepdims=True) + NORM_EPS)
    return (y * g.astype(jnp.float32)).astype(x.dtype)


def l2norm(x):
    return x * lax.rsqrt(jnp.sum(x * x, axis=-1, keepdims=True) + NORM_EPS)


def swiglu(x, w1, w3, w2):
    return (jax.nn.silu(x @ w1) * (x @ w3)) @ w2


def rope(x):
    S, d = x.shape[1], x.shape[-1]
    inv = ROPE_THETA ** (-jnp.arange(0, d, 2, dtype=jnp.float32) / d)
    ang = jnp.arange(S, dtype=jnp.float32)[:, None] * inv[None, :]
    cos = jnp.cos(ang)[None, :, None, :]
    sin = jnp.sin(ang)[None, :, None, :]
    xf = x.astype(jnp.float32)
    x1, x2 = xf[..., : d // 2], xf[..., d // 2:]
    return jnp.concatenate([x1 * cos - x2 * sin, x2 * cos + x1 * sin], axis=-1).astype(x.dtype)


def split_cols(t, sizes):
    offs = np.cumsum(sizes)[:-1].tolist()
    return jnp.split(t, offs, axis=-1)


def softmax_attention(q, k, v, scale):
    B, S, H, dk = q.shape
    nb = S // Q_BLOCK
    qb = jnp.moveaxis(q.reshape(B, nb, Q_BLOCK, H, dk), 1, 0)

    def block(qi):
        s = jnp.einsum('bqhd,bkhd->bhqk', qi, k, preferred_element_type=jnp.float32) * scale
        p = jax.nn.softmax(s, axis=-1).astype(v.dtype)
        return jnp.einsum('bhqk,bkhe->bqhe', p, v)

    o = lax.map(block, qb)
    return jnp.moveaxis(o, 0, 1).reshape(B, S, H, v.shape[-1])


def mla_mixer(c_q, c_kv, k_r, q_norm, kv_norm, w_uq, w_ukv):
    B, S, _ = c_q.shape
    q = (rmsnorm(c_q, q_norm) @ w_uq).reshape(B, S, MLA_HEADS, MLA_NOPE + MLA_ROPE)
    q = jnp.concatenate([q[..., :MLA_NOPE], rope(q[..., MLA_NOPE:])], axis=-1)
    kv = (rmsnorm(c_kv, kv_norm) @ w_ukv).reshape(B, S, MLA_HEADS, MLA_NOPE + MLA_V)
    k_nope, v = kv[..., :MLA_NOPE], kv[..., MLA_NOPE:]
    k_rope = rope(k_r[:, :, None, :])
    k = jnp.concatenate([k_nope, jnp.broadcast_to(k_rope, (B, S, MLA_HEADS, MLA_ROPE))], axis=-1)
    o = softmax_attention(q, k, v, (MLA_NOPE + MLA_ROPE) ** -0.5)
    return o.reshape(B, S, MLA_HEADS * MLA_V)


def diff_mixer(q, k, v, lam, subln, lambda_init):
    B, S, _ = q.shape
    H, d = DIFF_HEADS, DIFF_HD
    q = rope(q.reshape(B, S, 2 * H, d)).reshape(B, S, H, 2, d)
    k = rope(k.reshape(B, S, 2 * H, d)).reshape(B, S, H, 2, d)
    v = v.reshape(B, S, H, DIFF_VD)
    lf = lam.astype(jnp.float32)
    lambda_full = jnp.exp(jnp.sum(lf[0] * lf[1])) - jnp.exp(jnp.sum(lf[2] * lf[3])) + lambda_init
    nb = S // Q_BLOCK
    qb = jnp.moveaxis(q.reshape(B, nb, Q_BLOCK, H, 2, d), 1, 0)

    def block(qi):
        s = jnp.einsum('bqhmd,bkhmd->bhmqk', qi, k, preferred_element_type=jnp.float32) * d ** -0.5
        p = jax.nn.softmax(s, axis=-1)
        a = (p[:, :, 0] - lambda_full * p[:, :, 1]).astype(v.dtype)
        return jnp.einsum('bhqk,bkhe->bqhe', a, v)

    o = jnp.moveaxis(lax.map(block, qb), 0, 1).reshape(B, S, H, DIFF_VD)
    o = rmsnorm(o, subln) * (1.0 - lambda_init)
    return o.reshape(B, S, H * DIFF_VD)


def short_conv(x, w):
    K, C = w.shape
    pad = (K - 1) // 2
    return lax.conv_general_dilated(x, w[:, None, :].astype(x.dtype), window_strides=(1,),
                                    padding=[(pad, pad)], dimension_numbers=('NWC', 'WIO', 'NWC'),
                                    feature_group_count=C)


def gated_delta_chunked(q, k, v, beta, g):
    B, S, H, dk = q.shape
    dv = v.shape[-1]
    C = DN_CHUNK
    N = S // C

    def chunks(t):
        return jnp.swapaxes(t.reshape((B, N, C) + t.shape[2:]), 2, 3)

    qc, kc, vc, bc = chunks(q), chunks(k), chunks(v), chunks(beta)
    gc = jnp.cumsum(chunks(g), axis=-1)
    idx = jnp.arange(C)
    incl = idx[:, None] >= idx[None, :]
    strict = idx[:, None] > idx[None, :]
    decay = jnp.exp(jnp.where(incl, gc[..., :, None] - gc[..., None, :], -jnp.inf))
    kb = kc * bc[..., None]
    a_mat = jnp.where(strict, jnp.einsum('bnhid,bnhjd->bnhij', kb, kc) * decay, 0.0)
    t_mat = a_mat + jnp.eye(C, dtype=a_mat.dtype)
    rhs = jnp.concatenate([vc * bc[..., None], kb * jnp.exp(gc)[..., None]], axis=-1)
    sol = lax.linalg.triangular_solve(t_mat, rhs, left_side=True, lower=True, unit_diagonal=True)
    u, w = sol[..., :dv], sol[..., dv:]
    intra = jnp.einsum('bnhid,bnhjd->bnhij', qc, kc) * decay
    q_dec = qc * jnp.exp(gc)[..., None]
    k_dec = kc * jnp.exp(gc[..., -1:] - gc)[..., None]
    g_last = jnp.exp(gc[..., -1])

    def step(state, xs):
        u_i, w_i, q_i, k_i, a_i, gl = xs
        v_new = u_i - jnp.einsum('bhcd,bhde->bhce', w_i, state)
        o_i = jnp.einsum('bhcd,bhde->bhce', q_i, state) + jnp.einsum('bhij,bhje->bhie', a_i, v_new)
        state = state * gl[..., None, None] + jnp.einsum('bhcd,bhce->bhde', k_i, v_new)
        return state, o_i

    xs = tuple(jnp.moveaxis(t, 1, 0) for t in (u, w, q_dec, k_dec, intra, g_last))
    state0 = jnp.zeros((B, H, dk, dv), jnp.float32)
    _, o = lax.scan(step, state0, xs)
    return jnp.transpose(o, (1, 0, 3, 2, 4)).reshape(B, S, H, dv)


def deltanet_mixer(qkv, a_f, b_f, a_b, b_b, z, conv_w, a_log, dt_bias, out_norm):
    B, S, _ = qkv.shape
    H = DN_HEADS
    act = jax.nn.silu(short_conv(qkv, conv_w))
    q, k, v = jnp.split(act, [H * DN_DK, 2 * H * DN_DK], axis=-1)
    q = l2norm(q.reshape(B, S, H, DN_DK).astype(jnp.float32)) * DN_DK ** -0.5
    k = l2norm(k.reshape(B, S, H, DN_DK).astype(jnp.float32))
    v = v.reshape(B, S, H, DN_DV).astype(jnp.float32)
    al = a_log.astype(jnp.float32)
    dtb = dt_bias.astype(jnp.float32)
    beta_f = jax.nn.sigmoid(b_f.astype(jnp.float32))
    g_f = -jnp.exp(al[0]) * jax.nn.softplus(a_f.astype(jnp.float32) + dtb[0])
    beta_b = jax.nn.sigmoid(b_b.astype(jnp.float32))
    g_b = -jnp.exp(al[1]) * jax.nn.softplus(a_b.astype(jnp.float32) + dtb[1])
    flip = lambda t: jnp.flip(t, axis=1)
    o_f = gated_delta_chunked(q, k, v, beta_f, g_f)
    o_b = flip(gated_delta_chunked(flip(q), flip(k), flip(v), flip(beta_b), flip(g_b)))
    o = rmsnorm(o_f + o_b, out_norm) * jax.nn.silu(z.reshape(B, S, H, DN_DV).astype(jnp.float32))
    return o.reshape(B, S, H * DN_DV).astype(qkv.dtype)


def dilated_window_attention(q, k, v, dilation, radius):
    B, S, H, d = q.shape
    L = S // dilation
    blk = radius
    nb = -(-L // blk)
    Lp = nb * blk
    Bp = B * dilation

    def by_residue(t):
        return jnp.transpose(t.reshape(B, L, dilation, H, d), (0, 2, 1, 3, 4)).reshape(Bp, L, H, d)

    qr = jnp.pad(by_residue(q), ((0, 0), (0, Lp - L), (0, 0), (0, 0))).reshape(Bp, nb, blk, H, d)

    def windows(t):
        tb = jnp.pad(by_residue(t), ((0, 0), (blk, Lp - L + blk), (0, 0), (0, 0))).reshape(Bp, nb + 2, blk, H, d)
        return jnp.concatenate([tb[:, :-2], tb[:, 1:-1], tb[:, 2:]], axis=2)

    kw, vw = windows(k), windows(v)
    s = jnp.einsum('bnqhd,bnkhd->bnhqk', qr, kw, preferred_element_type=jnp.float32) * d ** -0.5
    bi = jnp.arange(nb)[:, None, None] * blk
    t_idx = bi + jnp.arange(blk)[None, :, None]
    u_idx = bi - blk + jnp.arange(3 * blk)[None, None, :]
    valid = (jnp.abs(u_idx - t_idx) <= radius) & (u_idx >= 0) & (u_idx < L)
    s = jnp.where(valid[None, :, None], s, NEG_BIG)
    m = jnp.max(s, axis=-1, keepdims=True)
    e = jnp.exp(s - m)
    den = jnp.sum(e, axis=-1, keepdims=True)
    o = jnp.einsum('bnhqk,bnkhd->bnqhd', (e / den).astype(vw.dtype), vw)
    lse = (m + jnp.log(den))[..., 0]
    o = o.reshape(Bp, Lp, H, d)[:, :L]
    o = jnp.transpose(o.reshape(B, dilation, L, H, d), (0, 2, 1, 3, 4)).reshape(B, S, H, d)
    lse = jnp.transpose(lse, (0, 1, 3, 2)).reshape(Bp, Lp, H)[:, :L]
    lse = jnp.transpose(lse.reshape(B, dilation, L, H), (0, 2, 1, 3)).reshape(B, S, H)
    return o, lse


def dilated_mixer(q, k, v):
    B, S, _ = q.shape
    G = len(DIL_GROUPS)
    q = rope(q.reshape(B, S, G * DIL_HEADS, DIL_HD)).reshape(B, S, G, DIL_HEADS, DIL_HD)
    k = rope(k.reshape(B, S, G * DIL_HEADS, DIL_HD)).reshape(B, S, G, DIL_HEADS, DIL_HD)
    v = v.reshape(B, S, G, DIL_HEADS, DIL_HD)
    outs, lses = [], []
    for gi, (window, dilation) in enumerate(DIL_GROUPS):
        o_g, lse_g = dilated_window_attention(q[:, :, gi], k[:, :, gi], v[:, :, gi], dilation,
                                              window // (2 * dilation))
        outs.append(o_g.astype(jnp.float32))
        lses.append(lse_g)
    alpha = jax.nn.softmax(jnp.stack(lses, axis=0), axis=0)
    o = jnp.sum(alpha[..., None] * jnp.stack(outs, axis=0), axis=0)
    return o.reshape(B, S, DIL_HEADS * DIL_HD).astype(q.dtype)


def encoder_layer(x, p_l, w, li):
    x = x + 0.5 * swiglu(rmsnorm(x, w['norm_ff1']), w['ff1_w1'], w['ff1_w3'], w['ff1_w2'])
    h = rmsnorm(x, w['norm_mix'])
    (cq, ckv, kr, bq, bk, bv, cqkv, caf, cbf, cab, cbb, cz, dq, dk, dv) = split_cols(h @ w['w_in'], IN_SIZES)
    y_a = mla_mixer(cq, ckv, kr, w['mla_q_norm'], w['mla_kv_norm'], w['mla_w_uq'], w['mla_w_ukv'])
    y_b = diff_mixer(bq, bk, bv, w['diff_lambda'], w['diff_subln'], 0.8 - 0.6 * math.exp(-0.3 * li))
    y_c = deltanet_mixer(cqkv, caf, cbf, cab, cbb, cz, w['dn_conv'], w['dn_a_log'], w['dn_dt_bias'],
                         w['dn_out_norm'])
    y_d = dilated_mixer(dq, dk, dv)
    merged = None
    for n, y_n in enumerate((y_a, y_b, y_c, y_d)):
        term = jax.nn.sigmoid(h @ w['w_gate'][n]) * (y_n @ w['w_branch'][n])
        merged = term if merged is None else merged + term
    x = x + merged @ w['w_out']
    x = x + 0.5 * swiglu(rmsnorm(x, w['norm_ff2']), w['ff2_w1'], w['ff2_w3'], w['ff2_w2'])
    x = x + jax.nn.sigmoid(rmsnorm(x, w['norm_ple']) @ w['ple_gate']) * (p_l @ w['ple_proj'])
    return x


def run_trunk(x, p, w_stack, norm_final):
    for li in range(DEPTH):
        w = {name: arr[li] for name, arr in w_stack.items()}
        x = encoder_layer(x, p[li], w, li)
    return rmsnorm(x, norm_final)


def setup_inputs(seed: int = 0) -> dict:
    key = jax.random.key(seed)
    ks = iter(jax.random.split(key, 48))
    f32 = jnp.float32
    L = DEPTH

    def nrm(shape, scale):
        return jax.random.normal(next(ks), shape, f32) * scale

    def gain(shape):
        return 1.0 + 0.02 * jax.random.normal(next(ks), shape, f32)

    inp = {}
    inp['x_prompt'] = nrm((BATCH, SEQ, D_MODEL), 1.0)
    inp['x_sample'] = nrm((DEC_BATCH, DEC_SEQ, D_MODEL), 1.0)
    inp['p_prompt'] = nrm((DEPTH, BATCH, SEQ, PLE_DIM), 1.0)
    inp['p_sample'] = nrm((DEPTH, DEC_BATCH, DEC_SEQ, PLE_DIM), 1.0)
    inp['norm_ff1'] = gain((L, D_MODEL))
    inp['ff1_w1'] = nrm((L, D_MODEL, D_FF), D_MODEL ** -0.5)
    inp['ff1_w3'] = nrm((L, D_MODEL, D_FF), D_MODEL ** -0.5)
    inp['ff1_w2'] = nrm((L, D_FF, D_MODEL), D_FF ** -0.5)
    inp['norm_mix'] = gain((L, D_MODEL))
    inp['w_in'] = nrm((L, D_MODEL, IN_COLS), D_MODEL ** -0.5)
    inp['mla_q_norm'] = gain((L, MLA_Q_RANK))
    inp['mla_kv_norm'] = gain((L, MLA_KV_RANK))
    inp['mla_w_uq'] = nrm((L, MLA_Q_RANK, MLA_HEADS * (MLA_NOPE + MLA_ROPE)), MLA_Q_RANK ** -0.5)
    inp['mla_w_ukv'] = nrm((L, MLA_KV_RANK, MLA_HEADS * (MLA_NOPE + MLA_V)), MLA_KV_RANK ** -0.5)
    inp['diff_lambda'] = nrm((L, 4, DIFF_HD), 0.1)
    inp['diff_subln'] = gain((L, DIFF_VD))
    inp['dn_conv'] = nrm((L, DN_CONV, DN_QKV), DN_CONV ** -0.5)
    inp['dn_a_log'] = jnp.log(jax.random.uniform(next(ks), (L, 2, DN_HEADS), f32, 1.0, 16.0))
    dt = jnp.exp(jax.random.uniform(next(ks), (L, 2, DN_HEADS), f32, math.log(1e-3), math.log(1e-1)))
    inp['dn_dt_bias'] = dt + jnp.log(-jnp.expm1(-dt))
    inp['dn_out_norm'] = gain((L, DN_DV))
    inp['w_branch'] = nrm((L, N_BRANCH, BRANCH_WIDTH, D_MODEL), BRANCH_WIDTH ** -0.5)
    inp['w_gate'] = nrm((L, N_BRANCH, D_MODEL, D_MODEL), D_MODEL ** -0.5)
    inp['w_out'] = nrm((L, D_MODEL, D_MODEL), D_MODEL ** -0.5)
    inp['norm_ff2'] = gain((L, D_MODEL))
    inp['ff2_w1'] = nrm((L, D_MODEL, D_FF), D_MODEL ** -0.5)
    inp['ff2_w3'] = nrm((L, D_MODEL, D_FF), D_MODEL ** -0.5)
    inp['ff2_w2'] = nrm((L, D_FF, D_MODEL), D_FF ** -0.5)
    inp['norm_ple'] = gain((L, D_MODEL))
    inp['ple_gate'] = nrm((L, D_MODEL, D_MODEL), D_MODEL ** -0.5)
    inp['ple_proj'] = nrm((L, PLE_DIM, D_MODEL), PLE_DIM ** -0.5)
    inp['norm_final'] = gain((D_MODEL,))
    return inp


def reference(x_prompt, x_sample, p_prompt, p_sample,
              norm_ff1, ff1_w1, ff1_w3, ff1_w2,
              norm_mix, w_in,
              mla_q_norm, mla_kv_norm, mla_w_uq, mla_w_ukv,
              diff_lambda, diff_subln,
              dn_conv, dn_a_log, dn_dt_bias, dn_out_norm,
              w_branch, w_gate, w_out,
              norm_ff2, ff2_w1, ff2_w3, ff2_w2,
              norm_ple, ple_gate, ple_proj,
              norm_final):
    w_stack = {
        'norm_ff1': norm_ff1, 'ff1_w1': ff1_w1, 'ff1_w3': ff1_w3, 'ff1_w2': ff1_w2,
        'norm_mix': norm_mix, 'w_in': w_in,
        'mla_q_norm': mla_q_norm, 'mla_kv_norm': mla_kv_norm, 'mla_w_uq': mla_w_uq, 'mla_w_ukv': mla_w_ukv,
        'diff_lambda': diff_lambda, 'diff_subln': diff_subln,
        'dn_conv': dn_conv, 'dn_a_log': dn_a_log, 'dn_dt_bias': dn_dt_bias, 'dn_out_norm': dn_out_norm,
        'w_branch': w_branch, 'w_gate': w_gate, 'w_out': w_out,
        'norm_ff2': norm_ff2, 'ff2_w1': ff2_w1, 'ff2_w3': ff2_w3, 'ff2_w2': ff2_w2,
        'norm_ple': norm_ple, 'ple_gate': ple_gate, 'ple_proj': ple_proj,
    }
    y_prompt = run_trunk(x_prompt, p_prompt, w_stack, norm_final)
    y_sample = run_trunk(x_sample, p_sample, w_stack, norm_final)
    return (y_prompt, y_sample)
```

```cpp
#include <hip/hip_runtime.h>
#include <hip/hip_cooperative_groups.h>
#include <stdint.h>
#include <stdio.h>
namespace cg = cooperative_groups;

typedef unsigned short bf16_t;
using bf16x8 = __attribute__((ext_vector_type(8))) short;
using bf16x4 = __attribute__((ext_vector_type(4))) short;
using f32x16 = __attribute__((ext_vector_type(16))) float;
using f32x4 = __attribute__((ext_vector_type(4))) float;
using u32x4 = __attribute__((ext_vector_type(4))) unsigned;
using u32x2 = __attribute__((ext_vector_type(2))) unsigned;

#define DI __device__ __forceinline__
#define MFMA32(a, b, c) __builtin_amdgcn_mfma_f32_32x32x16_bf16((a), (b), (c), 0, 0, 0)
#define MFMA16(a, b, c) __builtin_amdgcn_mfma_f32_16x16x32_bf16((a), (b), (c), 0, 0, 0)

constexpr int TG = 32768;
constexpr int NPR = 4608;
constexpr float EPS = 1e-6f;
constexpr float LOG2E = 1.4426950408889634f;
constexpr int C_CQ = 0, C_CKV = 256, C_BQ = 384, C_BK = 640, C_BV = 896, C_DNQKV = 1152, C_Z = 1920,
              C_DQ = 2176, C_DK = 2944, C_DV = 3712;
constexpr size_t MiB = 1048576;
constexpr size_t OFF_WB = 0, OFF_TAB = 57 * MiB, OFF_CNT = 63 * MiB, OFF_N = 64 * MiB, OFF_PR = 128 * MiB,
                 OFF_Q = 416 * MiB, OFF_K = 440 * MiB, OFF_V = 464 * MiB, OFF_AB = 480 * MiB, OFF_OD = 482 * MiB,
                 OFF_LSE = 530 * MiB, OFF_OF = 532 * MiB, OFF_OB = 548 * MiB, WS_NEED = 564 * MiB;
constexpr size_t W_FF1_1 = 0, W_FF1_3 = 2883584, W_FF1_2 = 5767168, W_IN = 8650752, W_UQ = 13369344,
                 W_UKV = 13467648, W_G = 13533184, W_B = 17727488, W_O = 18776064, W_FF2_1 = 19824640,
                 W_FF2_3 = 22708224, W_FF2_2 = 25591808, W_PG = 28475392, W_PP = 29523968;
constexpr size_t LDS_BYTES = 78336;

struct Params {
  const float* x_in[2];
  const float* p_in[2];
  const float *norm_ff1, *ff1_w1, *ff1_w3, *ff1_w2, *norm_mix, *w_in, *mla_q_norm, *mla_kv_norm, *mla_w_uq,
      *mla_w_ukv, *diff_lambda, *diff_subln, *dn_conv, *dn_a_log, *dn_dt_bias, *dn_out_norm, *w_branch, *w_gate,
      *w_out, *norm_ff2, *ff2_w1, *ff2_w3, *ff2_w2, *norm_ple, *ple_gate, *ple_proj, *norm_final;
  float* x;
  char* ws;
};

typedef const __attribute__((address_space(4))) Params CParams;
DI CParams* launder(CParams* q) { asm volatile("" : "+s"(q)); return q; }

DI bf16_t f2bf(float x) {
  unsigned u = __float_as_uint(x);
  u += 0x7fffu + ((u >> 16) & 1u);
  return (bf16_t)(u >> 16);
}
DI float bf2f(bf16_t b) { return __uint_as_float(((unsigned)b) << 16); }
DI unsigned pack2(float a, float b) { return (unsigned)f2bf(a) | ((unsigned)f2bf(b) << 16); }
DI float wave_sum(float v) {
#pragma unroll
  for (int o = 32; o > 0; o >>= 1) v += __shfl_xor(v, o);
  return v;
}
DI float sigmoidf_(float x) { return 1.f / (1.f + __expf(-x)); }
DI float siluf_(float x) { return x / (1.f + __expf(-x)); }
DI float exp2_(float x) { return __builtin_amdgcn_exp2f(x); }
DI int opq() { int z; asm volatile("v_mov_b32 %0, 0" : "=v"(z)); return z; }
DI int crow(int r, int h2) { return (r & 3) + 8 * (r >> 2) + 4 * h2; }
DI bf16x8 pack8(float a0, float a1, float a2, float a3, float a4, float a5, float a6, float a7) {
  u32x4 u;
  u.x = pack2(a0, a1); u.y = pack2(a2, a3); u.z = pack2(a4, a5); u.w = pack2(a6, a7);
  return __builtin_bit_cast(bf16x8, u);
}
DI bf16x8 ld2x4(const bf16_t* p0, const bf16_t* p1) {
  u32x2 a = *(const u32x2*)p0, b = *(const u32x2*)p1;
  u32x4 u; u.x = a.x; u.y = a.y; u.z = b.x; u.w = b.y;
  return __builtin_bit_cast(bf16x8, u);
}
DI void store8bf(bf16_t* dst, const float* v) {
  u32x4 u; u.x = pack2(v[0], v[1]); u.y = pack2(v[2], v[3]); u.z = pack2(v[4], v[5]); u.w = pack2(v[6], v[7]);
  *(u32x4*)dst = u;
}

struct MatDesc { const float* src; bf16_t* dst; int K, ldsrc, Ndst, map; const float* rowscale; };

DI int map_col(int map, int n) {
  if (map == 0) return n;
  if (map == 1) {
    if (n < 384) return n;
    if (n < 1920) return n + 32;
    if (n < 4480) return n + 48;
    if (n < 4512) return n - 4480 + 384;
    if (n < 4528) return n - 4512 + 1952;
    return -1;
  }
  if (n < 256) return (n >> 6) * 96 + (n & 63);
  return ((n - 256) >> 5) * 96 + 64 + ((n - 256) & 31);
}

DI MatDesc get_mat(CParams& p, int l, int id) {
  bf16_t* wb = (bf16_t*)(p.ws + OFF_WB);
  MatDesc d; d.map = 0; d.rowscale = nullptr;
  const size_t FF = (size_t)1024 * 2816;
  switch (id) {
    case 0: d.src = p.ff1_w1 + l * FF; d.dst = wb + W_FF1_1; d.K = 1024; d.ldsrc = 2816; d.Ndst = 2816; break;
    case 1: d.src = p.ff1_w3 + l * FF; d.dst = wb + W_FF1_3; d.K = 1024; d.ldsrc = 2816; d.Ndst = 2816; break;
    case 2: d.src = p.ff1_w2 + l * FF; d.dst = wb + W_FF1_2; d.K = 2816; d.ldsrc = 1024; d.Ndst = 1024; break;
    case 3: d.src = p.w_in + (size_t)l * 1024 * 4528; d.dst = wb + W_IN; d.K = 1024; d.ldsrc = 4528; d.Ndst = 4608; d.map = 1; break;
    case 4: d.src = p.mla_w_uq + (size_t)l * 256 * 384; d.dst = wb + W_UQ; d.K = 256; d.ldsrc = 384; d.Ndst = 384; d.map = 2; d.rowscale = p.mla_q_norm + l * 256; break;
    case 5: d.src = p.mla_w_ukv + (size_t)l * 128 * 512; d.dst = wb + W_UKV; d.K = 128; d.ldsrc = 512; d.Ndst = 512; d.rowscale = p.mla_kv_norm + l * 128; break;
    case 6: case 7: case 8: case 9:
      d.src = p.w_gate + (size_t)(l * 4 + id - 6) * 1048576; d.dst = wb + W_G + (size_t)(id - 6) * 1048576; d.K = 1024; d.ldsrc = 1024; d.Ndst = 1024; break;
    case 10: case 11: case 12: case 13:
      d.src = p.w_branch + (size_t)(l * 4 + id - 10) * 262144; d.dst = wb + W_B + (size_t)(id - 10) * 262144; d.K = 256; d.ldsrc = 1024; d.Ndst = 1024; break;
    case 14: d.src = p.w_out + (size_t)l * 1048576; d.dst = wb + W_O; d.K = 1024; d.ldsrc = 1024; d.Ndst = 1024; break;
    case 15: d.src = p.ff2_w1 + l * FF; d.dst = wb + W_FF2_1; d.K = 1024; d.ldsrc = 2816; d.Ndst = 2816; break;
    case 16: d.src = p.ff2_w3 + l * FF; d.dst = wb + W_FF2_3; d.K = 1024; d.ldsrc = 2816; d.Ndst = 2816; break;
    case 17: d.src = p.ff2_w2 + l * FF; d.dst = wb + W_FF2_2; d.K = 2816; d.ldsrc = 1024; d.Ndst = 1024; break;
    case 18: d.src = p.ple_gate + (size_t)l * 1048576; d.dst = wb + W_PG; d.K = 1024; d.ldsrc = 1024; d.Ndst = 1024; break;
    default: d.src = p.ple_proj + (size_t)l * 262144; d.dst = wb + W_PP; d.K = 256; d.ldsrc = 1024; d.Ndst = 1024; break;
  }
  return d;
}

__device__ void phase_convert(CParams& p, int l, char* lds) {
  float* T = (float*)lds;
  const int tid = threadIdx.x + opq();
  for (int id = 0; id < 20; ++id) {
    MatDesc d = get_mat(p, l, id);
    const int nkt = d.K >> 6, nnt = d.Ndst >> 6, nt_all = nkt * nnt;
    for (int t = blockIdx.x; t < nt_all; t += gridDim.x) {
      const int kt = t / nnt, nt = t % nnt;
      __syncthreads();
      {
        const int nl = tid & 63;
        const int sc = map_col(d.map, nt * 64 + nl);
#pragma unroll 4
        for (int i = 0; i < 16; ++i) {
          const int kl = (tid >> 6) + 4 * i;
          const int k = kt * 64 + kl;
          float v = 0.f;
          if (sc >= 0) v = d.src[(size_t)k * d.ldsrc + sc];
          if (d.rowscale) v *= d.rowscale[k];
          T[kl * 65 + nl] = v;
        }
      }
      __syncthreads();
      {
        const int kl = tid & 63;
#pragma unroll 4
        for (int i = 0; i < 16; ++i) {
          const int nl = (tid >> 6) + 4 * i;
          d.dst[(size_t)(nt * 64 + nl) * d.K + kt * 64 + kl] = f2bf(T[kl * 65 + nl]);
        }
      }
    }
  }
}

__device__ void phase_init(CParams& p, char* lds) {
  const size_t gtid = (size_t)blockIdx.x * 256 + threadIdx.x + opq(), gn = (size_t)gridDim.x * 256;
  {
    const size_t n4 = (size_t)TG * 1024 / 4;
    float4* dst = (float4*)p.x;
    const float4* s0 = (const float4*)p.x_in[0];
    const float4* s1 = (const float4*)p.x_in[1];
    for (size_t i = gtid; i < n4; i += gn) { dst[i] = s0[i]; dst[n4 + i] = s1[i]; }
  }
  {
    float2* t32 = (float2*)(p.ws + OFF_TAB);
    float2* t64 = (float2*)(p.ws + OFF_TAB + 2 * MiB);
    for (size_t i = gtid; i < (size_t)16384 * 48; i += gn) {
      const int pos = (int)(i / 48), f = (int)(i % 48);
      float inv;
      if (f < 16) inv = exp2f(-(float)f * (13.287712379549449f / 16.f));
      else inv = exp2f(-(float)(f - 16) * (13.287712379549449f / 32.f));
      const float ang = (float)pos * inv;
      const double xd = (double)ang;
      const double n = rint(xd * 0.15915494309189535);
      const float rf = (float)(xd - n * 6.283185307179586);
      float2 cs; cs.x = __cosf(rf); cs.y = __sinf(rf);
      if (f < 16) t32[(size_t)pos * 16 + f] = cs; else t64[(size_t)pos * 32 + (f - 16)] = cs;
    }
  }
  if (blockIdx.x == 0 && threadIdx.x < 64) ((int*)(p.ws + OFF_CNT))[threadIdx.x] = 0;
  phase_convert(p, 0, lds);
}

__device__ void phase_norm(const float* __restrict__ x, const float* __restrict__ g, bf16_t* __restrict__ dst,
                           const float* __restrict__ psrc, bf16_t* __restrict__ pdst) {
  const int tidq = threadIdx.x + opq(); const int wave = tidq >> 6, lane = tidq & 63;
  for (int r = blockIdx.x * 4 + wave; r < TG; r += gridDim.x * 4) {
    const float4* xr = (const float4*)(x + (size_t)r * 1024);
    float4 v[4];
    float ss = 0.f;
#pragma unroll
    for (int i = 0; i < 4; ++i) { v[i] = xr[lane + 64 * i]; ss += v[i].x * v[i].x + v[i].y * v[i].y + v[i].z * v[i].z + v[i].w * v[i].w; }
    ss = wave_sum(ss);
    const float rs = rsqrtf(ss * (1.f / 1024.f) + EPS);
#pragma unroll
    for (int i = 0; i < 4; ++i) {
      const float4 gg = ((const float4*)g)[lane + 64 * i];
      u32x2 o; o.x = pack2(v[i].x * rs * gg.x, v[i].y * rs * gg.y); o.y = pack2(v[i].z * rs * gg.z, v[i].w * rs * gg.w);
      ((u32x2*)(dst + (size_t)r * 1024))[lane + 64 * i] = o;
    }
    if (psrc) {
      const float4 pv = ((const float4*)(psrc + (size_t)r * 256))[lane];
      u32x2 o; o.x = pack2(pv.x, pv.y); o.y = pack2(pv.z, pv.w);
      ((u32x2*)(pdst + (size_t)r * 256))[lane] = o;
    }
  }
}

__device__ void phase_final_norm(float* __restrict__ x, const float* __restrict__ g) {
  const int tidq = threadIdx.x + opq(); const int wave = tidq >> 6, lane = tidq & 63;
  for (int r = blockIdx.x * 4 + wave; r < 2 * TG; r += gridDim.x * 4) {
    float4* xr = (float4*)(x + (size_t)r * 1024);
    float4 v[4];
    float ss = 0.f;
#pragma unroll
    for (int i = 0; i < 4; ++i) { v[i] = xr[lane + 64 * i]; ss += v[i].x * v[i].x + v[i].y * v[i].y + v[i].z * v[i].z + v[i].w * v[i].w; }
    ss = wave_sum(ss);
    const float rs = rsqrtf(ss * (1.f / 1024.f) + EPS);
#pragma unroll
    for (int i = 0; i < 4; ++i) {
      const float4 gg = ((const float4*)g)[lane + 64 * i];
      float4 o; o.x = v[i].x * rs * gg.x; o.y = v[i].y * rs * gg.y; o.z = v[i].z * rs * gg.z; o.w = v[i].w * rs * gg.w;
      xr[lane + 64 * i] = o;
    }
  }
}

template <int NI, int NB>
DI void gemm_main(f32x16 (&acc0)[2][NI], f32x16 (&acc1)[2][NI], const bf16_t* __restrict__ A, int lda,
                  const bf16_t* __restrict__ B0, const bf16_t* __restrict__ B1, int ldb, int K, char* lds) {
  const int tid = threadIdx.x + opq(), lane = tid & 63, w = tid >> 6, wm = w >> 1, wn = w & 1, l31 = lane & 31, h2 = lane >> 5;
  bf16_t* As = (bf16_t*)lds;
  bf16_t* B0s = As + 128 * 72;
  bf16_t* B1s = B0s + 64 * NI * 72;
  const int lr = tid >> 3, lc = (tid & 7) * 8;
  u32x4 ra[4], rb0[2 * NI], rb1[2 * NI];
  const bf16_t* ap = A + (size_t)lr * lda + lc;
  const bf16_t* bp0 = B0 + (size_t)lr * ldb + lc;
  const bf16_t* bp1 = (NB == 2) ? (B1 + (size_t)lr * ldb + lc) : B0;
#pragma unroll
  for (int i = 0; i < 4; ++i) ra[i] = *(const u32x4*)(ap + (size_t)(32 * i) * lda);
#pragma unroll
  for (int i = 0; i < 2 * NI; ++i) {
    rb0[i] = *(const u32x4*)(bp0 + (size_t)(32 * i) * ldb);
    if (NB == 2) rb1[i] = *(const u32x4*)(bp1 + (size_t)(32 * i) * ldb);
  }
  for (int k0 = 0; k0 < K; k0 += 64) {
    __syncthreads();
#pragma unroll
    for (int i = 0; i < 4; ++i) *(u32x4*)(As + (lr + 32 * i) * 72 + lc) = ra[i];
#pragma unroll
    for (int i = 0; i < 2 * NI; ++i) {
      *(u32x4*)(B0s + (lr + 32 * i) * 72 + lc) = rb0[i];
      if (NB == 2) *(u32x4*)(B1s + (lr + 32 * i) * 72 + lc) = rb1[i];
    }
    __syncthreads();
    if (k0 + 64 < K) {
      const int kn = k0 + 64;
#pragma unroll
      for (int i = 0; i < 4; ++i) ra[i] = *(const u32x4*)(ap + (size_t)(32 * i) * lda + kn);
#pragma unroll
      for (int i = 0; i < 2 * NI; ++i) {
        rb0[i] = *(const u32x4*)(bp0 + (size_t)(32 * i) * ldb + kn);
        if (NB == 2) rb1[i] = *(const u32x4*)(bp1 + (size_t)(32 * i) * ldb + kn);
      }
    }
#pragma unroll
    for (int ks = 0; ks < 4; ++ks) {
      bf16x8 af[2], bf0[NI], bf1[NI];
#pragma unroll
      for (int mi = 0; mi < 2; ++mi) af[mi] = *(const bf16x8*)(As + (64 * wm + 32 * mi + l31) * 72 + 16 * ks + 8 * h2);
#pragma unroll
      for (int ni = 0; ni < NI; ++ni) {
        bf0[ni] = *(const bf16x8*)(B0s + (32 * NI * wn + 32 * ni + l31) * 72 + 16 * ks + 8 * h2);
        if (NB == 2) bf1[ni] = *(const bf16x8*)(B1s + (32 * NI * wn + 32 * ni + l31) * 72 + 16 * ks + 8 * h2);
      }
#pragma unroll
      for (int mi = 0; mi < 2; ++mi)
#pragma unroll
        for (int ni = 0; ni < NI; ++ni) {
          acc0[mi][ni] = MFMA32(af[mi], bf0[ni], acc0[mi][ni]);
          if (NB == 2) acc1[mi][ni] = MFMA32(af[mi], bf1[ni], acc1[mi][ni]);
        }
    }
  }
}

template <int NI>
DI void zero_acc(f32x16 (&a)[2][NI]) {
#pragma unroll
  for (int mi = 0; mi < 2; ++mi)
#pragma unroll
    for (int ni = 0; ni < NI; ++ni)
#pragma unroll
      for (int r = 0; r < 16; ++r) a[mi][ni][r] = 0.f;
}

#define EPI_VARS const int tid = threadIdx.x + opq(), lane = tid & 63, w = tid >> 6, wm = w >> 1, wn = w & 1, l31 = lane & 31, h2 = lane >> 5; (void)tid; (void)lane; (void)w
#define EPI_BEGIN(NI_) _Pragma("unroll") for (int mi = 0; mi < 2; ++mi) _Pragma("unroll") for (int ni = 0; ni < NI_; ++ni) _Pragma("unroll") for (int r = 0; r < 16; ++r) { \
    const int row = 64 * wm + 32 * mi + crow(r, h2); const int col = 32 * NI_ * wn + 32 * ni + l31;
#define EPI_END }

__device__ void phase_ffn_a(const bf16_t* __restrict__ Nb, const bf16_t* __restrict__ W1, const bf16_t* __restrict__ W3,
                            bf16_t* __restrict__ H, char* lds) {
  EPI_VARS;
  for (int t = blockIdx.x; t < 256 * 22; t += gridDim.x) {
    const int mt = t / 22, nt = t % 22;
    f32x16 a0[2][2], a1[2][2];
    zero_acc<2>(a0); zero_acc<2>(a1);
    gemm_main<2, 2>(a0, a1, Nb + (size_t)mt * 128 * 1024, 1024, W1 + (size_t)nt * 128 * 1024, W3 + (size_t)nt * 128 * 1024, 1024, 1024, lds);
    EPI_BEGIN(2)
      H[(size_t)(mt * 128 + row) * 2816 + nt * 128 + col] = f2bf(siluf_(a0[mi][ni][r]) * a1[mi][ni][r]);
    EPI_END
  }
}

__device__ void phase_gemm_resid(const bf16_t* __restrict__ A, int K, const bf16_t* __restrict__ Bt, float* __restrict__ x,
                                 float scale, char* lds) {
  EPI_VARS;
  for (int t = blockIdx.x; t < 256 * 8; t += gridDim.x) {
    const int mt = t >> 3, nt = t & 7;
    f32x16 a0[2][2];
    zero_acc<2>(a0);
    gemm_main<2, 1>(a0, a0, A + (size_t)mt * 128 * K, K, Bt + (size_t)nt * 128 * K, nullptr, K, K, lds);
    EPI_BEGIN(2)
      float* xp = x + (size_t)(mt * 128 + row) * 1024 + nt * 128 + col;
      *xp = *xp + scale * a0[mi][ni][r];
    EPI_END
  }
}

__device__ void phase_ple(const bf16_t* __restrict__ Nb, const bf16_t* __restrict__ PB, const bf16_t* __restrict__ PG,
                          const bf16_t* __restrict__ PP, float* __restrict__ x, char* lds) {
  EPI_VARS;
  for (int t = blockIdx.x; t < 256 * 16; t += gridDim.x) {
    const int mt = t >> 4, nt = t & 15;
    f32x16 a0[2][1], a1[2][1];
    zero_acc<1>(a0); zero_acc<1>(a1);
    gemm_main<1, 1>(a0, a0, Nb + (size_t)mt * 128 * 1024, 1024, PG + (size_t)nt * 64 * 1024, nullptr, 1024, 1024, lds);
    gemm_main<1, 1>(a1, a1, PB + (size_t)mt * 128 * 256, 256, PP + (size_t)nt * 64 * 256, nullptr, 256, 256, lds);
    EPI_BEGIN(1)
      float* xp = x + (size_t)(mt * 128 + row) * 1024 + nt * 64 + col;
      *xp = *xp + sigmoidf_(a0[mi][ni][r]) * a1[mi][ni][r];
    EPI_END
  }
}

__device__ void phase_merge(const bf16_t* __restrict__ Np, const bf16_t* __restrict__ Y, const bf16_t* __restrict__ WG,
                            const bf16_t* __restrict__ WB, bf16_t* __restrict__ M, char* lds) {
  EPI_VARS;
  for (int t = blockIdx.x; t < 256 * 16; t += gridDim.x) {
    const int mt = t >> 4, nt = t & 15;
    f32x16 am[2][1];
    zero_acc<1>(am);
#pragma unroll 1
    for (int n = 0; n < 4; ++n) {
      f32x16 ag[2][1], ab[2][1];
      zero_acc<1>(ag); zero_acc<1>(ab);
      gemm_main<1, 1>(ag, ag, Np + (size_t)mt * 128 * 1024, 1024, WG + (size_t)n * 1048576 + (size_t)nt * 64 * 1024, nullptr, 1024, 1024, lds);
      gemm_main<1, 1>(ab, ab, Y + (size_t)mt * 128 * 1024 + n * 256, 1024, WB + (size_t)n * 262144 + (size_t)nt * 64 * 256, nullptr, 256, 256, lds);
#pragma unroll
      for (int mi = 0; mi < 2; ++mi)
#pragma unroll
        for (int r = 0; r < 16; ++r) am[mi][0][r] += sigmoidf_(ag[mi][0][r]) * ab[mi][0][r];
    }
    EPI_BEGIN(1)
      M[(size_t)(mt * 128 + row) * 1024 + nt * 64 + col] = f2bf(am[mi][ni][r]);
    EPI_END
  }
}

DI void rope32_out(const float* c, const float2* tab, float sc, float* o) {
#pragma unroll
  for (int i = 0; i < 16; ++i) {
    const float2 cs = tab[i];
    const float a = c[i], b = c[16 + i];
    o[i] = (a * cs.x - b * cs.y) * sc;
    o[16 + i] = (b * cs.x + a * cs.y) * sc;
  }
}

__device__ void phase_proj(CParams& p, const bf16_t* __restrict__ Nb, const bf16_t* __restrict__ WIN, int S, char* lds) {
  EPI_VARS;
  bf16_t* PR = (bf16_t*)(p.ws + OFF_PR);
  bf16_t* Kb = (bf16_t*)(p.ws + OFF_K);
  float* AB = (float*)(p.ws + OFF_AB);
  const float2* t32 = (const float2*)(p.ws + OFF_TAB);
  const float2* t64 = (const float2*)(p.ws + OFF_TAB + 2 * MiB);
  float* Ct = (float*)lds;
  for (int t = blockIdx.x; t < 256 * 36; t += gridDim.x) {
    const int mt = t / 36, nt = t % 36;
    f32x16 a0[2][2];
    zero_acc<2>(a0);
    gemm_main<2, 1>(a0, a0, Nb + (size_t)mt * 128 * 1024, 1024, WIN + (size_t)nt * 128 * 1024, nullptr, 1024, 1024, lds);
    __syncthreads();
    EPI_BEGIN(2)
      Ct[row * 132 + col] = a0[mi][ni][r];
    EPI_END
    __syncthreads();
    const int erow = tid >> 1, half = tid & 1;
    const int tok = mt * 128 + erow, pos = tok & (S - 1);
    const float* cr = Ct + erow * 132 + 64 * half;
    bf16_t* dst = PR + (size_t)tok * NPR + nt * 128 + 64 * half;
    int type = 0; float sc = 1.f;
    if (nt == 3 || nt == 4) { type = 1; sc = 0.17677669529663687f * LOG2E; }
    else if (nt == 5 || nt == 6) { type = 1; }
    else if (nt >= 17 && nt <= 22) { type = 2; sc = 0.125f * LOG2E; }
    else if (nt >= 23 && nt <= 28) { type = 2; }
    else if (nt == 35) type = 3;
    if (type == 0) {
#pragma unroll
      for (int j = 0; j < 8; ++j) store8bf(dst + 8 * j, cr + 8 * j);
    } else if (type == 1) {
#pragma unroll
      for (int hh = 0; hh < 2; ++hh) {
        float o[32];
        rope32_out(cr + 32 * hh, t32 + (size_t)pos * 16, sc, o);
#pragma unroll
        for (int j = 0; j < 4; ++j) store8bf(dst + 32 * hh + 8 * j, o + 8 * j);
      }
    } else if (type == 2) {
      const float2* tab = t64 + (size_t)pos * 32;
#pragma unroll
      for (int j = 0; j < 4; ++j) {
        float lo[8], hi[8];
#pragma unroll
        for (int e = 0; e < 8; ++e) {
          const float2 cs = tab[8 * j + e];
          const float a = cr[8 * j + e], b = cr[32 + 8 * j + e];
          lo[e] = (a * cs.x - b * cs.y) * sc;
          hi[e] = (b * cs.x + a * cs.y) * sc;
        }
        store8bf(dst + 8 * j, lo);
        store8bf(dst + 32 + 8 * j, hi);
      }
    } else {
      if (half == 0) {
        float o[32];
        rope32_out(cr, t32 + (size_t)pos * 16, 1.f, o);
#pragma unroll
        for (int hd = 0; hd < 4; ++hd)
#pragma unroll
          for (int j = 0; j < 4; ++j) store8bf(Kb + ((size_t)tok * 4 + hd) * 96 + 64 + 8 * j, o + 8 * j);
      } else {
        const float* c2 = Ct + erow * 132 + 32;
#pragma unroll
        for (int j = 0; j < 4; ++j) {
          float4 v; v.x = c2[4 * j]; v.y = c2[4 * j + 1]; v.z = c2[4 * j + 2]; v.w = c2[4 * j + 3];
          ((float4*)(AB + (size_t)tok * 16))[j] = v;
        }
      }
    }
  }
}

__device__ void mla_up_tile(CParams& p, int mt, int j, int S, char* lds) {
  EPI_VARS;
  const bf16_t* PR = (const bf16_t*)(p.ws + OFF_PR);
  const bf16_t* wb = (const bf16_t*)(p.ws + OFF_WB);
  bf16_t* Qb = (bf16_t*)(p.ws + OFF_Q);
  bf16_t* Kb = (bf16_t*)(p.ws + OFF_K);
  bf16_t* Vb = (bf16_t*)(p.ws + OFF_V);
  const float2* t32 = (const float2*)(p.ws + OFF_TAB);
  float* Ct = (float*)lds;
  float* rst = (float*)(lds + 67584);
  const bool isq = j < 3;
  const int K = isq ? 256 : 128;
  const int nt = isq ? j : j - 3;
  const bf16_t* A = PR + (size_t)mt * 128 * NPR + (isq ? C_CQ : C_CKV);
  const bf16_t* B = wb + (isq ? W_UQ : W_UKV) + (size_t)nt * 128 * K;
  const int erow = tid >> 1, half = tid & 1;
  {
    const bf16_t* ar = A + (size_t)erow * NPR + half * (K / 2);
    float ss = 0.f;
    for (int c = 0; c < K / 16; ++c) {
      const u32x4 u = *(const u32x4*)(ar + 8 * c);
      const unsigned uu[4] = {u.x, u.y, u.z, u.w};
#pragma unroll
      for (int e = 0; e < 4; ++e) {
        const float lo = __uint_as_float(uu[e] << 16), hi = __uint_as_float(uu[e] & 0xffff0000u);
        ss += lo * lo + hi * hi;
      }
    }
    ss += __shfl_xor(ss, 1);
    if (half == 0) rst[erow] = rsqrtf(ss / (float)K + EPS);
  }
  f32x16 a0[2][2];
  zero_acc<2>(a0);
  gemm_main<2, 1>(a0, a0, A, NPR, B, nullptr, K, K, lds);
  __syncthreads();
  EPI_BEGIN(2)
    Ct[row * 132 + col] = a0[mi][ni][r];
  EPI_END
  __syncthreads();
  const int tok = mt * 128 + erow, pos = tok & (S - 1);
  const float rs = rst[erow];
  const float* cr = Ct + erow * 132 + 64 * half;
  if (isq) {
    const float sc = rs * 0.10206207261596577f * LOG2E;
    if (nt < 2) {
      bf16_t* dst = Qb + ((size_t)tok * 4 + 2 * nt + half) * 96;
#pragma unroll
      for (int jj = 0; jj < 8; ++jj) {
        float o[8];
#pragma unroll
        for (int e = 0; e < 8; ++e) o[e] = cr[8 * jj + e] * sc;
        store8bf(dst + 8 * jj, o);
      }
    } else {
#pragma unroll
      for (int hh = 0; hh < 2; ++hh) {
        float o[32];
        rope32_out(cr + 32 * hh, t32 + (size_t)pos * 16, sc, o);
        bf16_t* dst = Qb + ((size_t)tok * 4 + 2 * half + hh) * 96 + 64;
#pragma unroll
        for (int jj = 0; jj < 4; ++jj) store8bf(dst + 8 * jj, o + 8 * jj);
      }
    }
  } else {
    bf16_t* dst = half == 0 ? (Kb + ((size_t)tok * 4 + nt) * 96) : (Vb + ((size_t)tok * 4 + nt) * 64);
#pragma unroll
    for (int jj = 0; jj < 8; ++jj) {
      float o[8];
#pragma unroll
      for (int e = 0; e < 8; ++e) o[e] = cr[8 * jj + e] * rs;
      store8bf(dst + 8 * jj, o);
    }
  }
}

template <int DK, bool BAND>
DI void flash_loop(f32x16 (&O)[2], float& m, float& l, const bf16_t* __restrict__ qrow, const bf16_t* __restrict__ kbase,
                   size_t kstride, const bf16_t* __restrict__ vbase, size_t vstride, int ntiles, int tq, int u0, int L,
                   char* lds) {
  const int tid = threadIdx.x + opq(), lane = tid & 63, l31 = lane & 31, h2 = lane >> 5;
  constexpr int KR = DK + 8, KCH = DK / 8, KN = 64 * KCH / 256;
  bf16_t* Ks = (bf16_t*)lds;
  bf16_t* Vt = Ks + 64 * KR;
  bf16x8 qf[DK / 16];
#pragma unroll
  for (int ks = 0; ks < DK / 16; ++ks) qf[ks] = *(const bf16x8*)(qrow + 16 * ks + 8 * h2);
  u32x4 rk[KN], rv[2];
  auto gload = [&](int kt) {
#pragma unroll
    for (int i = 0; i < KN; ++i) {
      const int ci = tid + 256 * i, row = ci / KCH, c = ci % KCH;
      int rr = u0 + 64 * kt + row;
      if (BAND) rr = min(max(rr, 0), L - 1);
      rk[i] = *(const u32x4*)(kbase + (size_t)rr * kstride + c * 8);
    }
#pragma unroll
    for (int i = 0; i < 2; ++i) {
      const int ci = tid + 256 * i, row = ci & 63, c = ci >> 6;
      int rr = u0 + 64 * kt + row;
      if (BAND) rr = min(max(rr, 0), L - 1);
      rv[i] = *(const u32x4*)(vbase + (size_t)rr * vstride + c * 8);
    }
  };
  gload(0);
  for (int kt = 0; kt < ntiles; ++kt) {
    __syncthreads();
#pragma unroll
    for (int i = 0; i < KN; ++i) {
      const int ci = tid + 256 * i, row = ci / KCH, c = ci % KCH;
      *(u32x4*)(Ks + row * KR + c * 8) = rk[i];
    }
#pragma unroll
    for (int i = 0; i < 2; ++i) {
      const int ci = tid + 256 * i, row = ci & 63, c = ci >> 6;
      const unsigned uu[4] = {rv[i].x, rv[i].y, rv[i].z, rv[i].w};
#pragma unroll
      for (int e = 0; e < 4; ++e) {
        Vt[(8 * c + 2 * e) * 72 + row] = (bf16_t)(uu[e] & 0xffffu);
        Vt[(8 * c + 2 * e + 1) * 72 + row] = (bf16_t)(uu[e] >> 16);
      }
    }
    __syncthreads();
    if (kt + 1 < ntiles) gload(kt + 1);
    f32x16 Sx[2];
#pragma unroll
    for (int j = 0; j < 2; ++j)
#pragma unroll
      for (int r = 0; r < 16; ++r) Sx[j][r] = 0.f;
#pragma unroll
    for (int ks = 0; ks < DK / 16; ++ks)
#pragma unroll
      for (int j = 0; j < 2; ++j) {
        const bf16x8 kf = *(const bf16x8*)(Ks + (32 * j + l31) * KR + 16 * ks + 8 * h2);
        Sx[j] = MFMA32(kf, qf[ks], Sx[j]);
      }
    if (BAND) {
#pragma unroll
      for (int j = 0; j < 2; ++j)
#pragma unroll
        for (int r = 0; r < 16; ++r) {
          const int u = u0 + 64 * kt + 32 * j + crow(r, h2);
          const int d = u - tq;
          const bool valid = (d <= 64) && (d >= -64) && (u >= 0) && (u < L);
          Sx[j][r] = valid ? Sx[j][r] : -1e30f;
        }
    }
    float mx = Sx[0][0];
#pragma unroll
    for (int j = 0; j < 2; ++j)
#pragma unroll
      for (int r = 0; r < 16; ++r) mx = fmaxf(mx, Sx[j][r]);
    mx = fmaxf(mx, __shfl_xor(mx, 32));
    const float mn = fmaxf(m, mx);
    const float alpha = exp2_(m - mn);
    m = mn;
    float ls = 0.f;
#pragma unroll
    for (int j = 0; j < 2; ++j)
#pragma unroll
      for (int r = 0; r < 16; ++r) { const float pv = exp2_(Sx[j][r] - mn); Sx[j][r] = pv; ls += pv; }
    l = l * alpha + ls;
#pragma unroll
    for (int t = 0; t < 2; ++t)
#pragma unroll
      for (int r = 0; r < 16; ++r) O[t][r] *= alpha;
#pragma unroll
    for (int j = 0; j < 2; ++j)
#pragma unroll
      for (int s = 0; s < 2; ++s) {
        const bf16x8 pf = pack8(Sx[j][8 * s], Sx[j][8 * s + 1], Sx[j][8 * s + 2], Sx[j][8 * s + 3], Sx[j][8 * s + 4],
                                Sx[j][8 * s + 5], Sx[j][8 * s + 6], Sx[j][8 * s + 7]);
#pragma unroll
        for (int t = 0; t < 2; ++t) {
          const bf16_t* vp = Vt + (32 * t + l31) * 72 + 32 * j + 16 * s + 4 * h2;
          const bf16x8 vf = ld2x4(vp, vp + 8);
          O[t] = MFMA32(vf, pf, O[t]);
        }
      }
  }
}

DI void zeroO(f32x16 (&O)[2]) {
#pragma unroll
  for (int t = 0; t < 2; ++t)
#pragma unroll
    for (int r = 0; r < 16; ++r) O[t][r] = 0.f;
}

DI void store_o(bf16_t* dst, const f32x16 (&O)[2], int h2) {
#pragma unroll
  for (int t = 0; t < 2; ++t)
#pragma unroll
    for (int g = 0; g < 4; ++g) {
      u32x2 u; u.x = pack2(O[t][4 * g], O[t][4 * g + 1]); u.y = pack2(O[t][4 * g + 2], O[t][4 * g + 3]);
      *(u32x2*)(dst + 32 * t + 8 * g + 4 * h2) = u;
    }
}

__device__ void mla_item(CParams& p, int it, int S, char* lds) {
  const int tid = threadIdx.x + opq(), lane = tid & 63, w = tid >> 6, l31 = lane & 31, h2 = lane >> 5;
  const int nqb = S / 128;
  const int qb = it % nqb, bh = it / nqb, h = bh & 3, b = bh >> 2;
  const int tokbase = b * S, gtok = tokbase + 128 * qb + 32 * w + l31;
  const bf16_t* Qb = (const bf16_t*)(p.ws + OFF_Q);
  const bf16_t* Kb = (const bf16_t*)(p.ws + OFF_K);
  const bf16_t* Vb = (const bf16_t*)(p.ws + OFF_V);
  bf16_t* Y = (bf16_t*)(p.ws + OFF_N);
  f32x16 O[2]; zeroO(O);
  float m = -1e30f, l = 0.f;
  flash_loop<96, false>(O, m, l, Qb + ((size_t)gtok * 4 + h) * 96, Kb + ((size_t)tokbase * 4 + h) * 96, 384,
                        Vb + ((size_t)tokbase * 4 + h) * 64, 256, S / 64, 0, 0, 0, lds);
  l += __shfl_xor(l, 32);
  const float il = 1.f / l;
#pragma unroll
  for (int t = 0; t < 2; ++t)
#pragma unroll
    for (int r = 0; r < 16; ++r) O[t][r] *= il;
  store_o(Y + (size_t)gtok * 1024 + h * 64, O, h2);
}

__device__ void diff_item(CParams& p, int layer, int it, int S, char* lds) {
  const int tid = threadIdx.x + opq(), lane = tid & 63, w = tid >> 6, l31 = lane & 31, h2 = lane >> 5;
  const int nqb = S / 128;
  const int qb = it % nqb, bh = it / nqb, h = bh & 3, b = bh >> 2;
  const int tokbase = b * S, gtok = tokbase + 128 * qb + 32 * w + l31;
  const bf16_t* PR = (const bf16_t*)(p.ws + OFF_PR);
  bf16_t* Y = (bf16_t*)(p.ws + OFF_N);
  const float* lam = p.diff_lambda + layer * 128;
  float s1 = 0.f, s2 = 0.f;
  if (lane < 32) { s1 = lam[lane] * lam[32 + lane]; s2 = lam[64 + lane] * lam[96 + lane]; }
  s1 = wave_sum(s1); s2 = wave_sum(s2);
  const float lambda_init = 0.8f - 0.6f * expf(-0.3f * (float)layer);
  const float lambda_full = expf(s1) - expf(s2) + lambda_init;
  f32x16 of[2]; zeroO(of);
  for (int mp = 0; mp < 2; ++mp) {
    f32x16 O[2]; zeroO(O);
    float m = -1e30f, l = 0.f;
    flash_loop<32, false>(O, m, l, PR + (size_t)gtok * NPR + C_BQ + (2 * h + mp) * 32,
                          PR + (size_t)tokbase * NPR + C_BK + (2 * h + mp) * 32, NPR,
                          PR + (size_t)tokbase * NPR + C_BV + h * 64, NPR, S / 64, 0, 0, 0, lds);
    l += __shfl_xor(l, 32);
    const float cf = (mp == 0 ? 1.f : -lambda_full) / l;
#pragma unroll
    for (int t = 0; t < 2; ++t)
#pragma unroll
      for (int r = 0; r < 16; ++r) of[t][r] += cf * O[t][r];
  }
  float ss = 0.f;
#pragma unroll
  for (int t = 0; t < 2; ++t)
#pragma unroll
    for (int r = 0; r < 16; ++r) ss += of[t][r] * of[t][r];
  ss += __shfl_xor(ss, 32);
  const float rs = rsqrtf(ss * (1.f / 64.f) + EPS) * (1.f - lambda_init);
  const float* sg = p.diff_subln + layer * 64;
#pragma unroll
  for (int t = 0; t < 2; ++t)
#pragma unroll
    for (int r = 0; r < 16; ++r) of[t][r] *= rs * sg[32 * t + crow(r, h2)];
  store_o(Y + (size_t)gtok * 1024 + 256 + h * 64, of, h2);
}

__device__ void dil_item(CParams& p, int it, int S, int B, char* lds) {
  const int tid = threadIdx.x + opq(), lane = tid & 63, w = tid >> 6, l31 = lane & 31, h2 = lane >> 5;
  const int nrq = S / 128;
  const int rq = it % nrq;
  int rest = it / nrq;
  const int head = rest & 3; rest >>= 2;
  const int b = rest % B, g = rest / B;
  const int dil = (g == 0) ? 1 : (g == 1 ? 4 : 16);
  const int L = S / dil, nqb = L / 128;
  const int res = rq / nqb, qb = rq % nqb;
  const int tokbase = b * S;
  const int tq = 128 * qb + 32 * w + l31;
  const int gtok = tokbase + tq * dil + res;
  const bf16_t* PR = (const bf16_t*)(p.ws + OFF_PR);
  bf16_t* OD = (bf16_t*)(p.ws + OFF_OD);
  float* LSE = (float*)(p.ws + OFF_LSE);
  f32x16 O[2]; zeroO(O);
  float m = -1e30f, l = 0.f;
  const int hc = (g * 4 + head) * 64;
  flash_loop<64, true>(O, m, l, PR + (size_t)gtok * NPR + C_DQ + hc, PR + (size_t)(tokbase + res) * NPR + C_DK + hc,
                       (size_t)dil * NPR, PR + (size_t)(tokbase + res) * NPR + C_DV + hc, (size_t)dil * NPR, 4, tq,
                       128 * qb - 64, L, lds);
  l += __shfl_xor(l, 32);
  const float il = 1.f / l;
#pragma unroll
  for (int t = 0; t < 2; ++t)
#pragma unroll
    for (int r = 0; r < 16; ++r) O[t][r] *= il;
  store_o(OD + ((size_t)g * TG + gtok) * 256 + head * 64, O, h2);
  if (h2 == 0) LSE[((size_t)g * TG + gtok) * 4 + head] = m + __log2f(l);
}

__device__ void dn_chain(CParams& p, int layer, int it, int S, char* lds) {
  const int tid0 = threadIdx.x;
  const int dir = it & 1, h = (it >> 1) & 3, b = it >> 3;
  const int tokbase = b * S, NC = S / 64;
  const bf16_t* PR = (const bf16_t*)(p.ws + OFF_PR);
  const float* AB = (const float*)(p.ws + OFF_AB);
  bf16_t* OUT = (bf16_t*)(p.ws + (dir ? OFF_OB : OFF_OF));
  bf16_t* raw = (bf16_t*)lds;
  float* convw = (float*)(lds + 27200);
  float* RU = (float*)lds;
  float* RW = (float*)(lds + 16384);
  bf16_t* Iimg = (bf16_t*)(lds + 16384);
  float* Am = (float*)(lds + 32768);
  float* U = Am;
  bf16_t* Kimg = (bf16_t*)(lds + 50176);
  bf16_t* Wn = Kimg;
  bf16_t* Qimg = (bf16_t*)(lds + 59392);
  bf16_t* Kt = (bf16_t*)(lds + 68608);
  float* gcs = (float*)(lds + 77824);
  float* betas = gcs + 64;
  const float Aexp = expf(p.dn_a_log[layer * 8 + dir * 4 + h]);
  const float dtb = p.dn_dt_bias[layer * 8 + dir * 4 + h];
  const float* cw = p.dn_conv + (size_t)layer * 5 * 768;
  f32x4 Sd[4];
#pragma unroll
  for (int t = 0; t < 4; ++t) Sd[t] = f32x4{0.f, 0.f, 0.f, 0.f};

  for (int cc = 0; cc < NC; ++cc) {
    int zz;
    asm volatile("v_mov_b32 %0, 0" : "=v"(zz));
    const int tid = tid0 + zz, lane = tid & 63, w = tid >> 6, l15 = lane & 15, g4 = lane >> 4;
    const int e_col = 16 * w + l15;
    const int ch = dir ? (NC - 1 - cc) : cc;
    const int s0 = ch * 64;
    __syncthreads();
    for (int ci = tid; ci < 68 * 24; ci += 256) {
      const int rr = ci / 24, c = ci % 24, seg = c >> 3, c8 = c & 7;
      const int s = s0 + rr - 2;
      u32x4 v = u32x4{0u, 0u, 0u, 0u};
      if (s >= 0 && s < S) v = *(const u32x4*)(PR + (size_t)(tokbase + s) * NPR + C_DNQKV + seg * 256 + h * 64 + c8 * 8);
      *(u32x4*)(raw + rr * 200 + seg * 64 + c8 * 8) = v;
    }
    for (int i = tid; i < 960; i += 256) {
      const int j = i / 192, c = i % 192;
      convw[i] = cw[j * 768 + (c >> 6) * 256 + h * 64 + (c & 63)];
    }
    if (tid < 64) {
      const int i = dir ? 63 - tid : tid;
      const size_t tok = (size_t)tokbase + s0 + i;
      const float a = AB[tok * 16 + dir * 8 + h] + dtb;
      const float bb = AB[tok * 16 + dir * 8 + 4 + h];
      const float sp = fmaxf(a, 0.f) + __logf(1.f + __expf(-fabsf(a)));
      float g = -Aexp * sp;
#pragma unroll
      for (int o = 1; o < 64; o <<= 1) { const float tv = __shfl_up(g, o); if (lane >= o) g += tv; }
      gcs[tid] = g;
      betas[tid] = sigmoidf_(bb);
    }
    __syncthreads();
    const int pp = tid >> 2, cgp = tid & 3;
    float qv[16], kv[16], vv[16];
    {
      const int i0 = dir ? 63 - pp : pp;
#pragma unroll
      for (int seg = 0; seg < 3; ++seg) {
        float acc[16];
#pragma unroll
        for (int c = 0; c < 16; ++c) acc[c] = 0.f;
#pragma unroll
        for (int j = 0; j < 5; ++j) {
          const bf16_t* rp = raw + (i0 + j) * 200 + seg * 64 + 16 * cgp;
          const float* wp = convw + j * 192 + seg * 64 + 16 * cgp;
          const u32x4 u0 = *(const u32x4*)rp, u1 = *(const u32x4*)(rp + 8);
          const unsigned uu[8] = {u0.x, u0.y, u0.z, u0.w, u1.x, u1.y, u1.z, u1.w};
#pragma unroll
          for (int e = 0; e < 8; ++e) {
            acc[2 * e] += wp[2 * e] * __uint_as_float(uu[e] << 16);
            acc[2 * e + 1] += wp[2 * e + 1] * __uint_as_float(uu[e] & 0xffff0000u);
          }
        }
#pragma unroll
        for (int c = 0; c < 16; ++c) {
          const float sv = siluf_(acc[c]);
          if (seg == 0) qv[c] = sv; else if (seg == 1) kv[c] = sv; else vv[c] = sv;
        }
      }
      float sq = 0.f, sk = 0.f;
#pragma unroll
      for (int c = 0; c < 16; ++c) { sq += qv[c] * qv[c]; sk += kv[c] * kv[c]; }
      sq += __shfl_xor(sq, 1); sq += __shfl_xor(sq, 2);
      sk += __shfl_xor(sk, 1); sk += __shfl_xor(sk, 2);
      const float rq = rsqrtf(sq + EPS) * 0.125f, rk = rsqrtf(sk + EPS);
#pragma unroll
      for (int c = 0; c < 16; ++c) { qv[c] *= rq; kv[c] *= rk; }
    }
    __syncthreads();
    {
      const float bet = betas[pp], egc = __expf(gcs[pp]);
      store8bf(Kimg + pp * 72 + 16 * cgp, kv); store8bf(Kimg + pp * 72 + 16 * cgp + 8, kv + 8);
      store8bf(Qimg + pp * 72 + 16 * cgp, qv); store8bf(Qimg + pp * 72 + 16 * cgp + 8, qv + 8);
#pragma unroll
      for (int c = 0; c < 16; ++c) {
        Kt[(16 * cgp + c) * 72 + pp] = f2bf(kv[c]);
        RU[pp * 64 + 16 * cgp + c] = vv[c] * bet;
        RW[pp * 64 + 16 * cgp + c] = kv[c] * bet * egc;
      }
    }
    __syncthreads();
    f32x4 KK[4], QK[4];
#pragma unroll
    for (int t = 0; t < 4; ++t) { KK[t] = f32x4{0.f, 0.f, 0.f, 0.f}; QK[t] = f32x4{0.f, 0.f, 0.f, 0.f}; }
#pragma unroll
    for (int ks = 0; ks < 2; ++ks) {
      const bf16x8 bfk = *(const bf16x8*)(Kimg + (16 * w + l15) * 72 + 32 * ks + 8 * g4);
#pragma unroll
      for (int rt = 0; rt < 4; ++rt) {
        const bf16x8 afk = *(const bf16x8*)(Kimg + (16 * rt + l15) * 72 + 32 * ks + 8 * g4);
        const bf16x8 afq = *(const bf16x8*)(Qimg + (16 * rt + l15) * 72 + 32 * ks + 8 * g4);
        KK[rt] = MFMA16(afk, bfk, KK[rt]);
        QK[rt] = MFMA16(afq, bfk, QK[rt]);
      }
    }
    {
      const int j = e_col;
      const float gcj = gcs[j];
#pragma unroll
      for (int rt = 0; rt < 4; ++rt)
#pragma unroll
        for (int r = 0; r < 4; ++r) {
          const int i = 16 * rt + 4 * g4 + r;
          const float ee = __expf(fminf(gcs[i] - gcj, 0.f));
          Am[i * 68 + j] = (i > j) ? betas[i] * KK[rt][r] * ee : 0.f;
          QK[rt][r] = (i >= j) ? QK[rt][r] * ee : 0.f;
        }
    }
    unsigned qkp[8];
#pragma unroll
    for (int rt = 0; rt < 4; ++rt) { qkp[2 * rt] = pack2(QK[rt][0], QK[rt][1]); qkp[2 * rt + 1] = pack2(QK[rt][2], QK[rt][3]); }
    __syncthreads();
    float xs[32];
#pragma unroll
    for (int q = 0; q < 32; ++q) xs[q] = 0.f;
    {
      const int c = tid >> 1, half = tid & 1;
      const float* Rc = (c < 64) ? (RU + c) : (RW + (c - 64));
      const float* Ah = Am + 4 * half;
#pragma unroll
      for (int i = 0; i < 64; ++i) {
        float part = 0.f;
#pragma unroll
        for (int q = 0; q < (i + 7) / 8; ++q) {
          const f32x4 a = *(const f32x4*)(Ah + i * 68 + 8 * q);
          part += a[0] * xs[4 * q] + a[1] * xs[4 * q + 1] + a[2] * xs[4 * q + 2] + a[3] * xs[4 * q + 3];
        }
        const float other = __int_as_float(__builtin_amdgcn_update_dpp(0, __float_as_int(part), 0xB1, 0xf, 0xf, true));
        const float xi = Rc[i * 64] - (part + other);
        const int loc = ((i >> 3) << 2) + (i & 3);
        if (((i >> 2) & 1) == 0) xs[loc] = (half == 0) ? xi : xs[loc];
        else xs[loc] = (half == 1) ? xi : xs[loc];
        asm volatile("" ::: "memory");
      }
    }
    __syncthreads();
    {
      const int c = tid >> 1, half = tid & 1;
#pragma unroll
      for (int loc = 0; loc < 32; ++loc) {
        const int i = (((loc >> 2) * 2 + half) << 2) + (loc & 3);
        if (c < 64) U[i * 68 + c] = xs[loc];
        else Wn[i * 72 + (c - 64)] = f2bf(-xs[loc]);
      }
    }
#pragma unroll
    for (int rt = 0; rt < 4; ++rt)
#pragma unroll
      for (int r = 0; r < 4; ++r)
        Iimg[(16 * rt + 4 * g4 + r) * 72 + e_col] = (bf16_t)((r & 1) ? (qkp[2 * rt + (r >> 1)] >> 16) : (qkp[2 * rt + (r >> 1)] & 0xffffu));
    __syncthreads();
    {
      bf16x8 Bs[2];
#pragma unroll
      for (int ks = 0; ks < 2; ++ks)
        Bs[ks] = pack8(Sd[2 * ks][0], Sd[2 * ks][1], Sd[2 * ks][2], Sd[2 * ks][3], Sd[2 * ks + 1][0], Sd[2 * ks + 1][1],
                       Sd[2 * ks + 1][2], Sd[2 * ks + 1][3]);
      f32x4 vn[4], qs[4], iv[4];
#pragma unroll
      for (int rt = 0; rt < 4; ++rt) {
#pragma unroll
        for (int r = 0; r < 4; ++r) vn[rt][r] = U[(16 * rt + 4 * g4 + r) * 68 + e_col];
        qs[rt] = f32x4{0.f, 0.f, 0.f, 0.f};
        iv[rt] = f32x4{0.f, 0.f, 0.f, 0.f};
#pragma unroll
        for (int ks = 0; ks < 2; ++ks) {
          const bf16_t* wp = Wn + (16 * rt + l15) * 72 + 32 * ks + 4 * g4;
          const bf16_t* qp = Qimg + (16 * rt + l15) * 72 + 32 * ks + 4 * g4;
          vn[rt] = MFMA16(ld2x4(wp, wp + 16), Bs[ks], vn[rt]);
          qs[rt] = MFMA16(ld2x4(qp, qp + 16), Bs[ks], qs[rt]);
        }
      }
      bf16x8 Bv[2];
#pragma unroll
      for (int ks = 0; ks < 2; ++ks)
        Bv[ks] = pack8(vn[2 * ks][0], vn[2 * ks][1], vn[2 * ks][2], vn[2 * ks][3], vn[2 * ks + 1][0], vn[2 * ks + 1][1],
                       vn[2 * ks + 1][2], vn[2 * ks + 1][3]);
#pragma unroll
      for (int rt = 0; rt < 4; ++rt)
#pragma unroll
        for (int ks = 0; ks < 2; ++ks) {
          const bf16_t* ip = Iimg + (16 * rt + l15) * 72 + 32 * ks + 4 * g4;
          iv[rt] = MFMA16(ld2x4(ip, ip + 16), Bv[ks], iv[rt]);
        }
      const float gc63 = gcs[63];
#pragma unroll
      for (int rt = 0; rt < 4; ++rt)
#pragma unroll
        for (int r = 0; r < 4; ++r) {
          const int pos = 16 * rt + 4 * g4 + r;
          const float o = qs[rt][r] * __expf(gcs[pos]) + iv[rt][r];
          const int i = dir ? 63 - pos : pos;
          OUT[((size_t)tokbase + s0 + i) * 256 + h * 64 + e_col] = f2bf(o);
          vn[rt][r] *= __expf(gc63 - gcs[pos]);
        }
      bf16x8 Bv2[2];
#pragma unroll
      for (int ks = 0; ks < 2; ++ks)
        Bv2[ks] = pack8(vn[2 * ks][0], vn[2 * ks][1], vn[2 * ks][2], vn[2 * ks][3], vn[2 * ks + 1][0], vn[2 * ks + 1][1],
                        vn[2 * ks + 1][2], vn[2 * ks + 1][3]);
      const float gl = __expf(gc63);
#pragma unroll
      for (int dt = 0; dt < 4; ++dt) {
#pragma unroll
        for (int r = 0; r < 4; ++r) Sd[dt][r] *= gl;
#pragma unroll
        for (int ks = 0; ks < 2; ++ks) {
          const bf16_t* kp = Kt + (16 * dt + l15) * 72 + 32 * ks + 4 * g4;
          Sd[dt] = MFMA16(ld2x4(kp, kp + 16), Bv2[ks], Sd[dt]);
        }
      }
    }
  }
}

__device__ void phase_combine(CParams& p, int layer, const float* __restrict__ xg) {
  const int tidq = threadIdx.x + opq(); const int wave = tidq >> 6, lane = tidq & 63;
  const bf16_t* PR = (const bf16_t*)(p.ws + OFF_PR);
  const bf16_t* OD = (const bf16_t*)(p.ws + OFF_OD);
  const float* LSE = (const float*)(p.ws + OFF_LSE);
  const bf16_t* OFb = (const bf16_t*)(p.ws + OFF_OF);
  const bf16_t* OBb = (const bf16_t*)(p.ws + OFF_OB);
  bf16_t* Y = (bf16_t*)(p.ws + OFF_N);
  bf16_t* Np = (bf16_t*)(p.ws + OFF_Q);
  const float* gmix = p.norm_mix + layer * 1024;
  const float* gdn = p.dn_out_norm + layer * 64;
  const int head = lane >> 4;
  for (int r = blockIdx.x * 4 + wave; r < TG; r += gridDim.x * 4) {
    {
      float lg[3];
#pragma unroll
      for (int g = 0; g < 3; ++g) lg[g] = LSE[((size_t)g * TG + r) * 4 + head];
      const float mx = fmaxf(lg[0], fmaxf(lg[1], lg[2]));
      float wg[3], den = 0.f;
#pragma unroll
      for (int g = 0; g < 3; ++g) { wg[g] = exp2_(lg[g] - mx); den += wg[g]; }
      const float id = 1.f / den;
      float o[4] = {0.f, 0.f, 0.f, 0.f};
#pragma unroll
      for (int g = 0; g < 3; ++g) {
        const u32x2 u = ((const u32x2*)(OD + ((size_t)g * TG + r) * 256))[lane];
        const float c = wg[g] * id;
        o[0] += c * __uint_as_float(u.x << 16); o[1] += c * __uint_as_float(u.x & 0xffff0000u);
        o[2] += c * __uint_as_float(u.y << 16); o[3] += c * __uint_as_float(u.y & 0xffff0000u);
      }
      u32x2 ou; ou.x = pack2(o[0], o[1]); ou.y = pack2(o[2], o[3]);
      ((u32x2*)(Y + (size_t)r * 1024 + 768))[lane] = ou;
    }
    {
      const u32x2 uf = ((const u32x2*)(OFb + (size_t)r * 256))[lane];
      const u32x2 ub = ((const u32x2*)(OBb + (size_t)r * 256))[lane];
      const u32x2 uz = ((const u32x2*)(PR + (size_t)r * NPR + C_Z))[lane];
      float o[4], z[4];
      o[0] = __uint_as_float(uf.x << 16) + __uint_as_float(ub.x << 16);
      o[1] = __uint_as_float(uf.x & 0xffff0000u) + __uint_as_float(ub.x & 0xffff0000u);
      o[2] = __uint_as_float(uf.y << 16) + __uint_as_float(ub.y << 16);
      o[3] = __uint_as_float(uf.y & 0xffff0000u) + __uint_as_float(ub.y & 0xffff0000u);
      z[0] = __uint_as_float(uz.x << 16); z[1] = __uint_as_float(uz.x & 0xffff0000u);
      z[2] = __uint_as_float(uz.y << 16); z[3] = __uint_as_float(uz.y & 0xffff0000u);
      float ss = o[0] * o[0] + o[1] * o[1] + o[2] * o[2] + o[3] * o[3];
      ss += __shfl_xor(ss, 1); ss += __shfl_xor(ss, 2); ss += __shfl_xor(ss, 4); ss += __shfl_xor(ss, 8);
      const float rs = rsqrtf(ss * (1.f / 64.f) + EPS);
      const float4 gg = ((const float4*)gdn)[lane & 15];
      u32x2 ou;
      ou.x = pack2(o[0] * rs * gg.x * siluf_(z[0]), o[1] * rs * gg.y * siluf_(z[1]));
      ou.y = pack2(o[2] * rs * gg.z * siluf_(z[2]), o[3] * rs * gg.w * siluf_(z[3]));
      ((u32x2*)(Y + (size_t)r * 1024 + 512))[lane] = ou;
    }
    {
      const float4* xr = (const float4*)(xg + (size_t)r * 1024);
      float4 v[4];
      float ss = 0.f;
#pragma unroll
      for (int i = 0; i < 4; ++i) { v[i] = xr[lane + 64 * i]; ss += v[i].x * v[i].x + v[i].y * v[i].y + v[i].z * v[i].z + v[i].w * v[i].w; }
      ss = wave_sum(ss);
      const float rs = rsqrtf(ss * (1.f / 1024.f) + EPS);
#pragma unroll
      for (int i = 0; i < 4; ++i) {
        const float4 gg = ((const float4*)gmix)[lane + 64 * i];
        u32x2 o; o.x = pack2(v[i].x * rs * gg.x, v[i].y * rs * gg.y); o.y = pack2(v[i].z * rs * gg.z, v[i].w * rs * gg.w);
        ((u32x2*)(Np + (size_t)r * 1024))[lane + 64 * i] = o;
      }
    }
  }
}

__global__ void __launch_bounds__(256, 2) mega(Params pk) {
  extern __shared__ __attribute__((aligned(16))) char lds[];
  __shared__ int s_item;
  cg::grid_group grid = cg::this_grid();
  CParams* kp = (CParams*)__builtin_amdgcn_kernarg_segment_ptr();
#define PP_ CParams& p = *launder(kp); const bf16_t* wb = (const bf16_t*)(p.ws + OFF_WB); bf16_t* Nb = (bf16_t*)(p.ws + OFF_N); \
            bf16_t* PRb = (bf16_t*)(p.ws + OFF_PR); bf16_t* Npb = (bf16_t*)(p.ws + OFF_Q); bf16_t* PB = (bf16_t*)(p.ws + OFF_OD); \
            float* xg = p.x + (size_t)grp * TG * 1024; (void)wb; (void)Nb; (void)PRb; (void)Npb; (void)PB; (void)xg;
  { CParams& p = *launder(kp); phase_init(p, lds); }
  grid.sync();
  for (int layer = 0; layer < 2; ++layer) {
    if (layer > 0) { CParams& p = *launder(kp); phase_convert(p, layer, lds); grid.sync(); }
    for (int grp = 0; grp < 2; ++grp) {
      const int S = grp ? 2048 : 16384, B = grp ? 16 : 2;
      { PP_ phase_norm(xg, p.norm_ff1 + layer * 1024, Nb, nullptr, nullptr); }
      grid.sync();
      { PP_ phase_ffn_a(Nb, wb + W_FF1_1, wb + W_FF1_3, PRb, lds); }
      grid.sync();
      { PP_ phase_gemm_resid(PRb, 2816, wb + W_FF1_2, xg, 0.5f, lds); }
      grid.sync();
      { PP_ phase_norm(xg, p.norm_mix + layer * 1024, Nb, nullptr, nullptr); }
      grid.sync();
      { PP_ phase_proj(p, Nb, wb + W_IN, S, lds); }
      grid.sync();
      {
        PP_
        int* c0 = (int*)(p.ws + OFF_CNT) + (layer * 2 + grp) * 2;
        const int nDN = B * 8, nDiff = 1024, nDil = 3072, nUp = 256 * 7;
        const int total = nDN + nDiff + nDil + nUp;
        for (;;) {
          __syncthreads();
          if (threadIdx.x == 0) s_item = atomicAdd(c0, 1);
          __syncthreads();
          int it = s_item;
          if (it >= total) break;
          if (it < nDN) { dn_chain(p, layer, it, S, lds); continue; }
          it -= nDN;
          if (it < nDiff) { diff_item(p, layer, it, S, lds); continue; }
          it -= nDiff;
          if (it < nDil) { dil_item(p, it, S, B, lds); continue; }
          it -= nDil;
          mla_up_tile(p, it / 7, it % 7, S, lds);
        }
      }
      grid.sync();
      {
        PP_
        int* c1 = (int*)(p.ws + OFF_CNT) + (layer * 2 + grp) * 2 + 1;
        for (;;) {
          __syncthreads();
          if (threadIdx.x == 0) s_item = atomicAdd(c1, 1);
          __syncthreads();
          const int it = s_item;
          if (it >= 1024) break;
          mla_item(p, it, S, lds);
        }
      }
      grid.sync();
      { PP_ phase_combine(p, layer, xg); }
      grid.sync();
      { PP_ phase_merge(Npb, Nb, wb + W_G, wb + W_B, PRb, lds); }
      grid.sync();
      { PP_ phase_gemm_resid(PRb, 1024, wb + W_O, xg, 1.0f, lds); }
      grid.sync();
      { PP_ phase_norm(xg, p.norm_ff2 + layer * 1024, Nb, nullptr, nullptr); }
      grid.sync();
      { PP_ phase_ffn_a(Nb, wb + W_FF2_1, wb + W_FF2_3, PRb, lds); }
      grid.sync();
      { PP_ phase_gemm_resid(PRb, 2816, wb + W_FF2_2, xg, 0.5f, lds); }
      grid.sync();
      { PP_ phase_norm(xg, p.norm_ple + layer * 1024, Nb, p.p_in[grp] + (size_t)layer * TG * 256, PB); }
      grid.sync();
      { PP_ phase_ple(Nb, PB, wb + W_PG, wb + W_PP, xg, lds); }
      grid.sync();
    }
  }
  { CParams& p = *launder(kp); phase_final_norm(p.x, p.norm_final); }
}

extern "C" void kernel_launch(void* const* d_in, const int* in_sizes, int n_in, void* d_out, int out_size, void* d_ws,
                              size_t ws_size, hipStream_t stream) {
  (void)in_sizes; (void)n_in; (void)out_size;
  Params p{};
  p.x_in[0] = (const float*)d_in[0]; p.x_in[1] = (const float*)d_in[1];
  p.p_in[0] = (const float*)d_in[2]; p.p_in[1] = (const float*)d_in[3];
  p.norm_ff1 = (const float*)d_in[4]; p.ff1_w1 = (const float*)d_in[5]; p.ff1_w3 = (const float*)d_in[6];
  p.ff1_w2 = (const float*)d_in[7]; p.norm_mix = (const float*)d_in[8]; p.w_in = (const float*)d_in[9];
  p.mla_q_norm = (const float*)d_in[10]; p.mla_kv_norm = (const float*)d_in[11]; p.mla_w_uq = (const float*)d_in[12];
  p.mla_w_ukv = (const float*)d_in[13]; p.diff_lambda = (const float*)d_in[14]; p.diff_subln = (const float*)d_in[15];
  p.dn_conv = (const float*)d_in[16]; p.dn_a_log = (const float*)d_in[17]; p.dn_dt_bias = (const float*)d_in[18];
  p.dn_out_norm = (const float*)d_in[19]; p.w_branch = (const float*)d_in[20]; p.w_gate = (const float*)d_in[21];
  p.w_out = (const float*)d_in[22]; p.norm_ff2 = (const float*)d_in[23]; p.ff2_w1 = (const float*)d_in[24];
  p.ff2_w3 = (const float*)d_in[25]; p.ff2_w2 = (const float*)d_in[26]; p.norm_ple = (const float*)d_in[27];
  p.ple_gate = (const float*)d_in[28]; p.ple_proj = (const float*)d_in[29]; p.norm_final = (const float*)d_in[30];
  p.x = (float*)d_out;
  p.ws = (char*)d_ws;
  static int grid_blocks = 0;
  if (!grid_blocks) {
    int dev = 0, cus = 0, per_cu = 0;
    hipGetDevice(&dev);
    hipDeviceGetAttribute(&cus, hipDeviceAttributeMultiprocessorCount, dev);
    hipFuncSetAttribute((const void*)mega, hipFuncAttributeMaxDynamicSharedMemorySize, (int)LDS_BYTES);
    hipOccupancyMaxActiveBlocksPerMultiprocessor(&per_cu, mega, 256, LDS_BYTES);
    if (per_cu < 1) per_cu = 1;
    grid_blocks = cus * per_cu;
  }
  if (ws_size < WS_NEED) {
    fprintf(stderr, "workspace too small: %zu < %zu\n", ws_size, (size_t)WS_NEED);
    return;
  }
  void* args[] = {&p};
  hipError_t e = hipLaunchCooperativeKernel((void*)mega, dim3(grid_blocks), dim3(256), args, LDS_BYTES, stream);
  if (e != hipSuccess) fprintf(stderr, "cooperative launch failed: %s (grid %d)\n", hipGetErrorString(e), grid_blocks);
}
```

```cpp
#include <hip/hip_runtime.h>
#include <hip/hip_cooperative_groups.h>
#include <stdint.h>
#include <stdio.h>
namespace cg = cooperative_groups;

typedef unsigned short bf16_t;
using bf16x8 = __attribute__((ext_vector_type(8))) short;
using bf16x4 = __attribute__((ext_vector_type(4))) short;
using f32x16 = __attribute__((ext_vector_type(16))) float;
using f32x4 = __attribute__((ext_vector_type(4))) float;
using u32x4 = __attribute__((ext_vector_type(4))) unsigned;
using u32x2 = __attribute__((ext_vector_type(2))) unsigned;

#define DI __device__ __forceinline__
#define MFMA32(a, b, c) __builtin_amdgcn_mfma_f32_32x32x16_bf16((a), (b), (c), 0, 0, 0)
#define MFMA16(a, b, c) __builtin_amdgcn_mfma_f32_16x16x32_bf16((a), (b), (c), 0, 0, 0)

constexpr int TG = 32768;
constexpr int NPR = 4608;
constexpr float EPS = 1e-6f;
constexpr float LOG2E = 1.4426950408889634f;
constexpr int C_CQ = 0, C_CKV = 256, C_BQ = 384, C_BK = 640, C_BV = 896, C_DNQKV = 1152, C_Z = 1920,
              C_DQ = 2176, C_DK = 2944, C_DV = 3712;
constexpr size_t MiB = 1048576;
constexpr size_t OFF_WB = 0, OFF_TAB = 57 * MiB, OFF_CNT = 63 * MiB, OFF_N = 64 * MiB, OFF_PR = 128 * MiB,
                 OFF_Q = 416 * MiB, OFF_K = 440 * MiB, OFF_V = 464 * MiB, OFF_AB = 480 * MiB, OFF_OD = 482 * MiB,
                 OFF_LSE = 530 * MiB, OFF_OF = 532 * MiB, OFF_OB = 548 * MiB, WS_NEED = 564 * MiB;
constexpr size_t W_FF1_1 = 0, W_FF1_3 = 2883584, W_FF1_2 = 5767168, W_IN = 8650752, W_UQ = 13369344,
                 W_UKV = 13467648, W_G = 13533184, W_B = 17727488, W_O = 18776064, W_FF2_1 = 19824640,
                 W_FF2_3 = 22708224, W_FF2_2 = 25591808, W_PG = 28475392, W_PP = 29523968;
constexpr size_t LDS_BYTES = 78336;

struct Params {
  const float* x_in[2];
  const float* p_in[2];
  const float *norm_ff1, *ff1_w1, *ff1_w3, *ff1_w2, *norm_mix, *w_in, *mla_q_norm, *mla_kv_norm, *mla_w_uq,
      *mla_w_ukv, *diff_lambda, *diff_subln, *dn_conv, *dn_a_log, *dn_dt_bias, *dn_out_norm, *w_branch, *w_gate,
      *w_out, *norm_ff2, *ff2_w1, *ff2_w3, *ff2_w2, *norm_ple, *ple_gate, *ple_proj, *norm_final;
  float* x;
  char* ws;
};

typedef const __attribute__((address_space(4))) Params CParams;
DI CParams* launder(CParams* q) { asm volatile("" : "+s"(q)); return q; }

typedef __bf16 bf2_t __attribute__((ext_vector_type(2)));
typedef float f2_t __attribute__((ext_vector_type(2)));
DI bf16_t f2bf(float x) { return __builtin_bit_cast(bf16_t, (__bf16)x); }
DI float bf2f(bf16_t b) { return __uint_as_float(((unsigned)b) << 16); }
DI unsigned pack2(float a, float b) { f2_t v = {a, b}; return __builtin_bit_cast(unsigned, __builtin_convertvector(v, bf2_t)); }
DI float wave_sum(float v) {
#pragma unroll
  for (int o = 32; o > 0; o >>= 1) v += __shfl_xor(v, o);
  return v;
}
DI float sigmoidf_(float x) { return 1.f / (1.f + __expf(-x)); }
DI float siluf_(float x) { return x / (1.f + __expf(-x)); }
DI float exp2_(float x) { return __builtin_amdgcn_exp2f(x); }
DI int opq() { int z; asm volatile("v_mov_b32 %0, 0" : "=v"(z)); return z; }
DI int crow(int r, int h2) { return (r & 3) + 8 * (r >> 2) + 4 * h2; }
DI bf16x8 pack8(float a0, float a1, float a2, float a3, float a4, float a5, float a6, float a7) {
  u32x4 u;
  u.x = pack2(a0, a1); u.y = pack2(a2, a3); u.z = pack2(a4, a5); u.w = pack2(a6, a7);
  return __builtin_bit_cast(bf16x8, u);
}
DI bf16x8 ld2x4(const bf16_t* p0, const bf16_t* p1) {
  u32x2 a = *(const u32x2*)p0, b = *(const u32x2*)p1;
  u32x4 u; u.x = a.x; u.y = a.y; u.z = b.x; u.w = b.y;
  return __builtin_bit_cast(bf16x8, u);
}
DI void store8bf(bf16_t* dst, const float* v) {
  u32x4 u; u.x = pack2(v[0], v[1]); u.y = pack2(v[2], v[3]); u.z = pack2(v[4], v[5]); u.w = pack2(v[6], v[7]);
  *(u32x4*)dst = u;
}

struct MatDesc { const float* src; bf16_t* dst; int K, ldsrc, Ndst, map; const float* rowscale; };

DI int map_col(int map, int n) {
  if (map == 0) return n;
  if (map == 1) {
    if (n < 384) return n;
    if (n < 1920) return n + 32;
    if (n < 4480) return n + 48;
    if (n < 4512) return n - 4480 + 384;
    if (n < 4528) return n - 4512 + 1952;
    return -1;
  }
  if (n < 256) return (n >> 6) * 96 + (n & 63);
  return ((n - 256) >> 5) * 96 + 64 + ((n - 256) & 31);
}

DI MatDesc get_mat(CParams& p, int l, int id) {
  bf16_t* wb = (bf16_t*)(p.ws + OFF_WB);
  MatDesc d; d.map = 0; d.rowscale = nullptr;
  const size_t FF = (size_t)1024 * 2816;
  switch (id) {
    case 0: d.src = p.ff1_w1 + l * FF; d.dst = wb + W_FF1_1; d.K = 1024; d.ldsrc = 2816; d.Ndst = 2816; break;
    case 1: d.src = p.ff1_w3 + l * FF; d.dst = wb + W_FF1_3; d.K = 1024; d.ldsrc = 2816; d.Ndst = 2816; break;
    case 2: d.src = p.ff1_w2 + l * FF; d.dst = wb + W_FF1_2; d.K = 2816; d.ldsrc = 1024; d.Ndst = 1024; break;
    case 3: d.src = p.w_in + (size_t)l * 1024 * 4528; d.dst = wb + W_IN; d.K = 1024; d.ldsrc = 4528; d.Ndst = 4608; d.map = 1; break;
    case 4: d.src = p.mla_w_uq + (size_t)l * 256 * 384; d.dst = wb + W_UQ; d.K = 256; d.ldsrc = 384; d.Ndst = 384; d.map = 2; d.rowscale = p.mla_q_norm + l * 256; break;
    case 5: d.src = p.mla_w_ukv + (size_t)l * 128 * 512; d.dst = wb + W_UKV; d.K = 128; d.ldsrc = 512; d.Ndst = 512; d.rowscale = p.mla_kv_norm + l * 128; break;
    case 6: case 7: case 8: case 9:
      d.src = p.w_gate + (size_t)(l * 4 + id - 6) * 1048576; d.dst = wb + W_G + (size_t)(id - 6) * 1048576; d.K = 1024; d.ldsrc = 1024; d.Ndst = 1024; break;
    case 10: case 11: case 12: case 13:
      d.src = p.w_branch + (size_t)(l * 4 + id - 10) * 262144; d.dst = wb + W_B + (size_t)(id - 10) * 262144; d.K = 256; d.ldsrc = 1024; d.Ndst = 1024; break;
    case 14: d.src = p.w_out + (size_t)l * 1048576; d.dst = wb + W_O; d.K = 1024; d.ldsrc = 1024; d.Ndst = 1024; break;
    case 15: d.src = p.ff2_w1 + l * FF; d.dst = wb + W_FF2_1; d.K = 1024; d.ldsrc = 2816; d.Ndst = 2816; break;
    case 16: d.src = p.ff2_w3 + l * FF; d.dst = wb + W_FF2_3; d.K = 1024; d.ldsrc = 2816; d.Ndst = 2816; break;
    case 17: d.src = p.ff2_w2 + l * FF; d.dst = wb + W_FF2_2; d.K = 2816; d.ldsrc = 1024; d.Ndst = 1024; break;
    case 18: d.src = p.ple_gate + (size_t)l * 1048576; d.dst = wb + W_PG; d.K = 1024; d.ldsrc = 1024; d.Ndst = 1024; break;
    default: d.src = p.ple_proj + (size_t)l * 262144; d.dst = wb + W_PP; d.K = 256; d.ldsrc = 1024; d.Ndst = 1024; break;
  }
  return d;
}

__device__ void phase_convert(CParams& p, int l, char* lds) {
  float* T = (float*)lds;
  const int tid = threadIdx.x + opq();
  for (int id = 0; id < 20; ++id) {
    MatDesc d = get_mat(p, l, id);
    const int nkt = d.K >> 6, nnt = d.Ndst >> 6, nt_all = nkt * nnt;
    for (int t = blockIdx.x; t < nt_all; t += gridDim.x) {
      const int kt = t / nnt, nt = t % nnt;
      __syncthreads();
      {
        const int nl = tid & 63;
        const int sc = map_col(d.map, nt * 64 + nl);
#pragma unroll 4
        for (int i = 0; i < 16; ++i) {
          const int kl = (tid >> 6) + 4 * i;
          const int k = kt * 64 + kl;
          float v = 0.f;
          if (sc >= 0) v = d.src[(size_t)k * d.ldsrc + sc];
          if (d.rowscale) v *= d.rowscale[k];
          T[kl * 65 + nl] = v;
        }
      }
      __syncthreads();
      {
        const int kl = tid & 63;
#pragma unroll 4
        for (int i = 0; i < 16; ++i) {
          const int nl = (tid >> 6) + 4 * i;
          d.dst[(size_t)(nt * 64 + nl) * d.K + kt * 64 + kl] = f2bf(T[kl * 65 + nl]);
        }
      }
    }
  }
}

__device__ void phase_init(CParams& p, char* lds) {
  const size_t gtid = (size_t)blockIdx.x * 256 + threadIdx.x + opq(), gn = (size_t)gridDim.x * 256;
  {
    const size_t n4 = (size_t)TG * 1024 / 4;
    float4* dst = (float4*)p.x;
    const float4* s0 = (const float4*)p.x_in[0];
    const float4* s1 = (const float4*)p.x_in[1];
    for (size_t i = gtid; i < n4; i += gn) { dst[i] = s0[i]; dst[n4 + i] = s1[i]; }
  }
  {
    float2* t32 = (float2*)(p.ws + OFF_TAB);
    float2* t64 = (float2*)(p.ws + OFF_TAB + 2 * MiB);
    for (size_t i = gtid; i < (size_t)16384 * 48; i += gn) {
      const int pos = (int)(i / 48), f = (int)(i % 48);
      float inv;
      if (f < 16) inv = exp2f(-(float)f * (13.287712379549449f / 16.f));
      else inv = exp2f(-(float)(f - 16) * (13.287712379549449f / 32.f));
      const float ang = (float)pos * inv;
      const double xd = (double)ang;
      const double n = rint(xd * 0.15915494309189535);
      const float rf = (float)(xd - n * 6.283185307179586);
      float2 cs; cs.x = __cosf(rf); cs.y = __sinf(rf);
      if (f < 16) t32[(size_t)pos * 16 + f] = cs; else t64[(size_t)pos * 32 + (f - 16)] = cs;
    }
  }
  if (blockIdx.x == 0 && threadIdx.x < 64) ((int*)(p.ws + OFF_CNT))[threadIdx.x] = 0;
  phase_convert(p, 0, lds);
}

__device__ void phase_norm(const float* __restrict__ x, const float* __restrict__ g, bf16_t* __restrict__ dst,
                           const float* __restrict__ psrc, bf16_t* __restrict__ pdst) {
  const int tidq = threadIdx.x + opq(); const int wave = tidq >> 6, lane = tidq & 63;
  for (int r = blockIdx.x * 4 + wave; r < TG; r += gridDim.x * 4) {
    const float4* xr = (const float4*)(x + (size_t)r * 1024);
    float4 v[4];
    float ss = 0.f;
#pragma unroll
    for (int i = 0; i < 4; ++i) { v[i] = xr[lane + 64 * i]; ss += v[i].x * v[i].x + v[i].y * v[i].y + v[i].z * v[i].z + v[i].w * v[i].w; }
    ss = wave_sum(ss);
    const float rs = rsqrtf(ss * (1.f / 1024.f) + EPS);
#pragma unroll
    for (int i = 0; i < 4; ++i) {
      const float4 gg = ((const float4*)g)[lane + 64 * i];
      u32x2 o; o.x = pack2(v[i].x * rs * gg.x, v[i].y * rs * gg.y); o.y = pack2(v[i].z * rs * gg.z, v[i].w * rs * gg.w);
      ((u32x2*)(dst + (size_t)r * 1024))[lane + 64 * i] = o;
    }
    if (psrc) {
      const float4 pv = ((const float4*)(psrc + (size_t)r * 256))[lane];
      u32x2 o; o.x = pack2(pv.x, pv.y); o.y = pack2(pv.z, pv.w);
      ((u32x2*)(pdst + (size_t)r * 256))[lane] = o;
    }
  }
}

__device__ void phase_final_norm(float* __restrict__ x, const float* __restrict__ g) {
  const int tidq = threadIdx.x + opq(); const int wave = tidq >> 6, lane = tidq & 63;
  for (int r = blockIdx.x * 4 + wave; r < 2 * TG; r += gridDim.x * 4) {
    float4* xr = (float4*)(x + (size_t)r * 1024);
    float4 v[4];
    float ss = 0.f;
#pragma unroll
    for (int i = 0; i < 4; ++i) { v[i] = xr[lane + 64 * i]; ss += v[i].x * v[i].x + v[i].y * v[i].y + v[i].z * v[i].z + v[i].w * v[i].w; }
    ss = wave_sum(ss);
    const float rs = rsqrtf(ss * (1.f / 1024.f) + EPS);
#pragma unroll
    for (int i = 0; i < 4; ++i) {
      const float4 gg = ((const float4*)g)[lane + 64 * i];
      float4 o; o.x = v[i].x * rs * gg.x; o.y = v[i].y * rs * gg.y; o.z = v[i].z * rs * gg.z; o.w = v[i].w * rs * gg.w;
      xr[lane + 64 * i] = o;
    }
  }
}

template <int NI, int NB>
DI void gemm_main(f32x16 (&acc0)[2][NI], f32x16 (&acc1)[2][NI], const bf16_t* __restrict__ A, int lda,
                  const bf16_t* __restrict__ B0, const bf16_t* __restrict__ B1, int ldb, int K, char* lds) {
  const int tid = threadIdx.x + opq(), lane = tid & 63, w = tid >> 6, wm = w >> 1, wn = w & 1, l31 = lane & 31, h2 = lane >> 5;
  bf16_t* As = (bf16_t*)lds;
  bf16_t* B0s = As + 128 * 72;
  bf16_t* B1s = B0s + 64 * NI * 72;
  const int lr = tid >> 3, lc = (tid & 7) * 8;
  u32x4 ra[4], rb0[2 * NI], rb1[2 * NI];
  const bf16_t* ap = A + (size_t)lr * lda + lc;
  const bf16_t* bp0 = B0 + (size_t)lr * ldb + lc;
  const bf16_t* bp1 = (NB == 2) ? (B1 + (size_t)lr * ldb + lc) : B0;
#pragma unroll
  for (int i = 0; i < 4; ++i) ra[i] = *(const u32x4*)(ap + (size_t)(32 * i) * lda);
#pragma unroll
  for (int i = 0; i < 2 * NI; ++i) {
    rb0[i] = *(const u32x4*)(bp0 + (size_t)(32 * i) * ldb);
    if (NB == 2) rb1[i] = *(const u32x4*)(bp1 + (size_t)(32 * i) * ldb);
  }
  for (int k0 = 0; k0 < K; k0 += 64) {
    __syncthreads();
#pragma unroll
    for (int i = 0; i < 4; ++i) *(u32x4*)(As + (lr + 32 * i) * 72 + lc) = ra[i];
#pragma unroll
    for (int i = 0; i < 2 * NI; ++i) {
      *(u32x4*)(B0s + (lr + 32 * i) * 72 + lc) = rb0[i];
      if (NB == 2) *(u32x4*)(B1s + (lr + 32 * i) * 72 + lc) = rb1[i];
    }
    __syncthreads();
    if (k0 + 64 < K) {
      const int kn = k0 + 64;
#pragma unroll
      for (int i = 0; i < 4; ++i) ra[i] = *(const u32x4*)(ap + (size_t)(32 * i) * lda + kn);
#pragma unroll
      for (int i = 0; i < 2 * NI; ++i) {
        rb0[i] = *(const u32x4*)(bp0 + (size_t)(32 * i) * ldb + kn);
        if (NB == 2) rb1[i] = *(const u32x4*)(bp1 + (size_t)(32 * i) * ldb + kn);
      }
    }
#pragma unroll
    for (int ks = 0; ks < 4; ++ks) {
      bf16x8 af[2], bf0[NI], bf1[NI];
#pragma unroll
      for (int mi = 0; mi < 2; ++mi) af[mi] = *(const bf16x8*)(As + (64 * wm + 32 * mi + l31) * 72 + 16 * ks + 8 * h2);
#pragma unroll
      for (int ni = 0; ni < NI; ++ni) {
        bf0[ni] = *(const bf16x8*)(B0s + (32 * NI * wn + 32 * ni + l31) * 72 + 16 * ks + 8 * h2);
        if (NB == 2) bf1[ni] = *(const bf16x8*)(B1s + (32 * NI * wn + 32 * ni + l31) * 72 + 16 * ks + 8 * h2);
      }
#pragma unroll
      for (int mi = 0; mi < 2; ++mi)
#pragma unroll
        for (int ni = 0; ni < NI; ++ni) {
          acc0[mi][ni] = MFMA32(af[mi], bf0[ni], acc0[mi][ni]);
          if (NB == 2) acc1[mi][ni] = MFMA32(af[mi], bf1[ni], acc1[mi][ni]);
        }
    }
  }
}

template <int NI>
DI void zero_acc(f32x16 (&a)[2][NI]) {
#pragma unroll
  for (int mi = 0; mi < 2; ++mi)
#pragma unroll
    for (int ni = 0; ni < NI; ++ni)
#pragma unroll
      for (int r = 0; r < 16; ++r) a[mi][ni][r] = 0.f;
}

#define EPI_VARS const int tid = threadIdx.x + opq(), lane = tid & 63, w = tid >> 6, wm = w >> 1, wn = w & 1, l31 = lane & 31, h2 = lane >> 5; (void)tid; (void)lane; (void)w
#define EPI_BEGIN(NI_) _Pragma("unroll") for (int mi = 0; mi < 2; ++mi) _Pragma("unroll") for (int ni = 0; ni < NI_; ++ni) _Pragma("unroll") for (int r = 0; r < 16; ++r) { \
    const int row = 64 * wm + 32 * mi + crow(r, h2); const int col = 32 * NI_ * wn + 32 * ni + l31;
#define EPI_END }

__device__ void phase_ffn_a(const bf16_t* __restrict__ Nb, const bf16_t* __restrict__ W1, const bf16_t* __restrict__ W3,
                            bf16_t* __restrict__ H, char* lds) {
  EPI_VARS;
  for (int t = blockIdx.x; t < 256 * 22; t += gridDim.x) {
    const int mt = t / 22, nt = t % 22;
    f32x16 a0[2][2], a1[2][2];
    zero_acc<2>(a0); zero_acc<2>(a1);
    gemm_main<2, 2>(a0, a1, Nb + (size_t)mt * 128 * 1024, 1024, W1 + (size_t)nt * 128 * 1024, W3 + (size_t)nt * 128 * 1024, 1024, 1024, lds);
    EPI_BEGIN(2)
      H[(size_t)(mt * 128 + row) * 2816 + nt * 128 + col] = f2bf(siluf_(a0[mi][ni][r]) * a1[mi][ni][r]);
    EPI_END
  }
}

__device__ void phase_gemm_resid(const bf16_t* __restrict__ A, int K, const bf16_t* __restrict__ Bt, float* __restrict__ x,
                                 float scale, char* lds) {
  EPI_VARS;
  for (int t = blockIdx.x; t < 256 * 8; t += gridDim.x) {
    const int mt = t >> 3, nt = t & 7;
    f32x16 a0[2][2];
    zero_acc<2>(a0);
    gemm_main<2, 1>(a0, a0, A + (size_t)mt * 128 * K, K, Bt + (size_t)nt * 128 * K, nullptr, K, K, lds);
    EPI_BEGIN(2)
      float* xp = x + (size_t)(mt * 128 + row) * 1024 + nt * 128 + col;
      *xp = *xp + scale * a0[mi][ni][r];
    EPI_END
  }
}

__device__ void phase_ple(const bf16_t* __restrict__ Nb, const bf16_t* __restrict__ PB, const bf16_t* __restrict__ PG,
                          const bf16_t* __restrict__ PP, float* __restrict__ x, char* lds) {
  EPI_VARS;
  for (int t = blockIdx.x; t < 256 * 16; t += gridDim.x) {
    const int mt = t >> 4, nt = t & 15;
    f32x16 a0[2][1], a1[2][1];
    zero_acc<1>(a0); zero_acc<1>(a1);
    gemm_main<1, 1>(a0, a0, Nb + (size_t)mt * 128 * 1024, 1024, PG + (size_t)nt * 64 * 1024, nullptr, 1024, 1024, lds);
    gemm_main<1, 1>(a1, a1, PB + (size_t)mt * 128 * 256, 256, PP + (size_t)nt * 64 * 256, nullptr, 256, 256, lds);
    EPI_BEGIN(1)
      float* xp = x + (size_t)(mt * 128 + row) * 1024 + nt * 64 + col;
      *xp = *xp + sigmoidf_(a0[mi][ni][r]) * a1[mi][ni][r];
    EPI_END
  }
}

__device__ void phase_merge(const bf16_t* __restrict__ Np, const bf16_t* __restrict__ Y, const bf16_t* __restrict__ WG,
                            const bf16_t* __restrict__ WB, bf16_t* __restrict__ M, char* lds) {
  EPI_VARS;
  for (int t = blockIdx.x; t < 256 * 16; t += gridDim.x) {
    const int mt = t >> 4, nt = t & 15;
    f32x16 am[2][1];
    zero_acc<1>(am);
#pragma unroll 1
    for (int n = 0; n < 4; ++n) {
      f32x16 ag[2][1], ab[2][1];
      zero_acc<1>(ag); zero_acc<1>(ab);
      gemm_main<1, 1>(ag, ag, Np + (size_t)mt * 128 * 1024, 1024, WG + (size_t)n * 1048576 + (size_t)nt * 64 * 1024, nullptr, 1024, 1024, lds);
      gemm_main<1, 1>(ab, ab, Y + (size_t)mt * 128 * 1024 + n * 256, 1024, WB + (size_t)n * 262144 + (size_t)nt * 64 * 256, nullptr, 256, 256, lds);
#pragma unroll
      for (int mi = 0; mi < 2; ++mi)
#pragma unroll
        for (int r = 0; r < 16; ++r) am[mi][0][r] += sigmoidf_(ag[mi][0][r]) * ab[mi][0][r];
    }
    EPI_BEGIN(1)
      M[(size_t)(mt * 128 + row) * 1024 + nt * 64 + col] = f2bf(am[mi][ni][r]);
    EPI_END
  }
}

DI void rope32_out(const float* c, const float2* tab, float sc, float* o) {
#pragma unroll
  for (int i = 0; i < 16; ++i) {
    const float2 cs = tab[i];
    const float a = c[i], b = c[16 + i];
    o[i] = (a * cs.x - b * cs.y) * sc;
    o[16 + i] = (b * cs.x + a * cs.y) * sc;
  }
}

__device__ void phase_proj(CParams& p, const bf16_t* __restrict__ Nb, const bf16_t* __restrict__ WIN, int S, char* lds) {
  EPI_VARS;
  bf16_t* PR = (bf16_t*)(p.ws + OFF_PR);
  float* AB = (float*)(p.ws + OFF_AB);
  const float2* t32 = (const float2*)(p.ws + OFF_TAB);
  const float2* t64 = (const float2*)(p.ws + OFF_TAB + 2 * MiB);
  float* Ct = (float*)lds;
  for (int t = blockIdx.x; t < 256 * 36; t += gridDim.x) {
    const int mt = t / 36, nt = t % 36;
    f32x16 a0[2][2];
    zero_acc<2>(a0);
    gemm_main<2, 1>(a0, a0, Nb + (size_t)mt * 128 * 1024, 1024, WIN + (size_t)nt * 128 * 1024, nullptr, 1024, 1024, lds);
    __syncthreads();
    EPI_BEGIN(2)
      Ct[row * 132 + col] = a0[mi][ni][r];
    EPI_END
    __syncthreads();
    const int erow = tid >> 1, half = tid & 1;
    const int tok = mt * 128 + erow, pos = tok & (S - 1);
    const float* cr = Ct + erow * 132 + 64 * half;
    bf16_t* dst = PR + (size_t)tok * NPR + nt * 128 + 64 * half;
    int type = 0; float sc = 1.f;
    if (nt == 3 || nt == 4) { type = 1; sc = 0.17677669529663687f * LOG2E; }
    else if (nt == 5 || nt == 6) { type = 1; }
    else if (nt >= 17 && nt <= 22) { type = 2; sc = 0.125f * LOG2E; }
    else if (nt >= 23 && nt <= 28) { type = 2; }
    else if (nt == 35) type = 3;
    if (type == 0) {
#pragma unroll
      for (int j = 0; j < 8; ++j) store8bf(dst + 8 * j, cr + 8 * j);
    } else if (type == 1) {
#pragma unroll
      for (int hh = 0; hh < 2; ++hh) {
        float o[32];
        rope32_out(cr + 32 * hh, t32 + (size_t)pos * 16, sc, o);
#pragma unroll
        for (int j = 0; j < 4; ++j) store8bf(dst + 32 * hh + 8 * j, o + 8 * j);
      }
    } else if (type == 2) {
      const float2* tab = t64 + (size_t)pos * 32;
#pragma unroll
      for (int j = 0; j < 4; ++j) {
        float lo[8], hi[8];
#pragma unroll
        for (int e = 0; e < 8; ++e) {
          const float2 cs = tab[8 * j + e];
          const float a = cr[8 * j + e], b = cr[32 + 8 * j + e];
          lo[e] = (a * cs.x - b * cs.y) * sc;
          hi[e] = (b * cs.x + a * cs.y) * sc;
        }
        store8bf(dst + 8 * j, lo);
        store8bf(dst + 32 + 8 * j, hi);
      }
    } else {
      if (half == 0) {
        float o[32];
        rope32_out(cr, t32 + (size_t)pos * 16, 1.f, o);
#pragma unroll
        for (int j = 0; j < 4; ++j) store8bf(dst + 8 * j, o + 8 * j);
      } else {
        const float* c2 = Ct + erow * 132 + 32;
#pragma unroll
        for (int j = 0; j < 4; ++j) {
          float4 v; v.x = c2[4 * j]; v.y = c2[4 * j + 1]; v.z = c2[4 * j + 2]; v.w = c2[4 * j + 3];
          ((float4*)(AB + (size_t)tok * 16))[j] = v;
        }
      }
    }
  }
}

__device__ void mla_up_tile(CParams& p, int mt, int j, int S, char* lds) {
  EPI_VARS;
  const bf16_t* PR = (const bf16_t*)(p.ws + OFF_PR);
  const bf16_t* wb = (const bf16_t*)(p.ws + OFF_WB);
  bf16_t* Qb = (bf16_t*)(p.ws + OFF_Q);
  bf16_t* Kb = (bf16_t*)(p.ws + OFF_K);
  bf16_t* Vb = (bf16_t*)(p.ws + OFF_V);
  const float2* t32 = (const float2*)(p.ws + OFF_TAB);
  float* Ct = (float*)lds;
  float* rst = (float*)(lds + 67584);
  const bool isq = j < 3;
  const int K = isq ? 256 : 128;
  const int nt = isq ? j : j - 3;
  const bf16_t* A = PR + (size_t)mt * 128 * NPR + (isq ? C_CQ : C_CKV);
  const bf16_t* B = wb + (isq ? W_UQ : W_UKV) + (size_t)nt * 128 * K;
  const int erow = tid >> 1, half = tid & 1;
  {
    const bf16_t* ar = A + (size_t)erow * NPR + half * (K / 2);
    float ss = 0.f;
    for (int c = 0; c < K / 16; ++c) {
      const u32x4 u = *(const u32x4*)(ar + 8 * c);
      const unsigned uu[4] = {u.x, u.y, u.z, u.w};
#pragma unroll
      for (int e = 0; e < 4; ++e) {
        const float lo = __uint_as_float(uu[e] << 16), hi = __uint_as_float(uu[e] & 0xffff0000u);
        ss += lo * lo + hi * hi;
      }
    }
    ss += __shfl_xor(ss, 1);
    if (half == 0) rst[erow] = rsqrtf(ss / (float)K + EPS);
  }
  f32x16 a0[2][2];
  zero_acc<2>(a0);
  gemm_main<2, 1>(a0, a0, A, NPR, B, nullptr, K, K, lds);
  __syncthreads();
  EPI_BEGIN(2)
    Ct[row * 132 + col] = a0[mi][ni][r];
  EPI_END
  __syncthreads();
  const int tok = mt * 128 + erow, pos = tok & (S - 1);
  const float rs = rst[erow];
  const float* cr = Ct + erow * 132 + 64 * half;
  if (isq) {
    const float sc = rs * 0.10206207261596577f * LOG2E;
    if (nt < 2) {
      bf16_t* dst = Qb + ((size_t)tok * 4 + 2 * nt + half) * 96;
#pragma unroll
      for (int jj = 0; jj < 8; ++jj) {
        float o[8];
#pragma unroll
        for (int e = 0; e < 8; ++e) o[e] = cr[8 * jj + e] * sc;
        store8bf(dst + 8 * jj, o);
      }
    } else {
#pragma unroll
      for (int hh = 0; hh < 2; ++hh) {
        float o[32];
        rope32_out(cr + 32 * hh, t32 + (size_t)pos * 16, sc, o);
        bf16_t* dst = Qb + ((size_t)tok * 4 + 2 * half + hh) * 96 + 64;
#pragma unroll
        for (int jj = 0; jj < 4; ++jj) store8bf(dst + 8 * jj, o + 8 * jj);
      }
    }
  } else {
    bf16_t* dst = half == 0 ? (Kb + ((size_t)tok * 4 + nt) * 96) : (Vb + ((size_t)tok * 4 + nt) * 64);
#pragma unroll
    for (int jj = 0; jj < 8; ++jj) {
      float o[8];
#pragma unroll
      for (int e = 0; e < 8; ++e) o[e] = cr[8 * jj + e] * rs;
      store8bf(dst + 8 * jj, o);
    }
    if (half == 0) {
      const u32x4* src = (const u32x4*)(PR + (size_t)tok * NPR + 4480);
#pragma unroll
      for (int jj = 0; jj < 4; ++jj) ((u32x4*)(dst + 64))[jj] = src[jj];
    }
  }
}

typedef short s16x4_t __attribute__((ext_vector_type(4)));
DI bf16x8 tr_pair(const bf16_t* p0, const bf16_t* p1) {
  const s16x4_t lo = __builtin_amdgcn_ds_read_tr16_b64_v4i16((__attribute__((address_space(3))) s16x4_t*)p0);
  const s16x4_t hi = __builtin_amdgcn_ds_read_tr16_b64_v4i16((__attribute__((address_space(3))) s16x4_t*)p1);
  return __builtin_shufflevector(lo, hi, 0, 1, 2, 3, 4, 5, 6, 7);
}

template <int DK, bool BAND>
DI void flash_loop(f32x16 (&O)[2], float& m, float& l, const bf16_t* __restrict__ qrow, const bf16_t* __restrict__ kbase,
                   size_t kstride, const bf16_t* __restrict__ vbase, size_t vstride, int ntiles, int tq, int u0, int L,
                   char* lds) {
  const int tid = threadIdx.x + opq(), lane = tid & 63, l31 = lane & 31, h2 = lane >> 5;
  constexpr int KR = DK + 8, KCH = DK / 8, KN = 64 * KCH / 256;
  constexpr int STAGE = 64 * KR * 2 + 64 * 72 * 2;
  bf16x8 qf[DK / 16];
#pragma unroll
  for (int ks = 0; ks < DK / 16; ++ks) qf[ks] = *(const bf16x8*)(qrow + 16 * ks + 8 * h2);
  u32x4 rk[KN], rv[2];
  auto gload = [&](int kt) {
#pragma unroll
    for (int i = 0; i < KN; ++i) {
      const int ci = tid + 256 * i, row = ci / KCH, c = ci % KCH;
      int rr = u0 + 64 * kt + row;
      if (BAND) rr = min(max(rr, 0), L - 1);
      rk[i] = *(const u32x4*)(kbase + (size_t)rr * kstride + c * 8);
    }
#pragma unroll
    for (int i = 0; i < 2; ++i) {
      const int ci = tid + 256 * i, row = ci >> 3, c = ci & 7;
      int rr = u0 + 64 * kt + row;
      if (BAND) rr = min(max(rr, 0), L - 1);
      rv[i] = *(const u32x4*)(vbase + (size_t)rr * vstride + c * 8);
    }
  };
  auto swrite = [&](int st) {
    bf16_t* Ks = (bf16_t*)(lds + st * STAGE);
    bf16_t* Vs = Ks + 64 * KR;
#pragma unroll
    for (int i = 0; i < KN; ++i) {
      const int ci = tid + 256 * i, row = ci / KCH, c = ci % KCH;
      *(u32x4*)(Ks + row * KR + c * 8) = rk[i];
    }
#pragma unroll
    for (int i = 0; i < 2; ++i) {
      const int ci = tid + 256 * i, row = ci >> 3, c = ci & 7;
      *(u32x4*)(Vs + row * 72 + c * 8) = rv[i];
    }
  };
  const int trq = (lane & 15) >> 2, trp = lane & 3, trblk = (lane >> 4) & 1;
  const int troff = (4 * h2 + trq) * 72 + 16 * trblk + 4 * trp;
  __syncthreads();
  gload(0);
  swrite(0);
  if (ntiles > 1) gload(1);
  for (int kt = 0; kt < ntiles; ++kt) {
    __syncthreads();
    if (kt + 1 < ntiles) swrite((kt + 1) & 1);
    if (kt + 2 < ntiles) gload(kt + 2);
    const bf16_t* Ks = (const bf16_t*)(lds + (kt & 1) * STAGE);
    const bf16_t* Vs = Ks + 64 * KR;
    f32x16 Sx[2];
#pragma unroll
    for (int j = 0; j < 2; ++j)
#pragma unroll
      for (int r = 0; r < 16; ++r) Sx[j][r] = 0.f;
#pragma unroll
    for (int ks = 0; ks < DK / 16; ++ks)
#pragma unroll
      for (int j = 0; j < 2; ++j) {
        const bf16x8 kf = *(const bf16x8*)(Ks + (32 * j + l31) * KR + 16 * ks + 8 * h2);
        Sx[j] = MFMA32(kf, qf[ks], Sx[j]);
      }
    if (BAND) {
#pragma unroll
      for (int j = 0; j < 2; ++j)
#pragma unroll
        for (int r = 0; r < 16; ++r) {
          const int u = u0 + 64 * kt + 32 * j + crow(r, h2);
          const int d = u - tq;
          const bool valid = (d <= 64) && (d >= -64) && (u >= 0) && (u < L);
          Sx[j][r] = valid ? Sx[j][r] : -1e30f;
        }
    }
    float mx = Sx[0][0];
#pragma unroll
    for (int j = 0; j < 2; ++j)
#pragma unroll
      for (int r = 0; r < 16; ++r) mx = fmaxf(mx, Sx[j][r]);
    mx = fmaxf(mx, __shfl_xor(mx, 32));
    const float mn = fmaxf(m, mx);
    const float alpha = exp2_(m - mn);
    const bool grew = mn > m;
    m = mn;
    float ls = 0.f;
#pragma unroll
    for (int j = 0; j < 2; ++j)
#pragma unroll
      for (int r = 0; r < 16; ++r) { const float pv = exp2_(Sx[j][r] - mn); Sx[j][r] = pv; ls += pv; }
    l = l * alpha + ls;
    if (__any(grew)) {
#pragma unroll
      for (int t = 0; t < 2; ++t)
#pragma unroll
        for (int r = 0; r < 16; ++r) O[t][r] *= alpha;
    }
#pragma unroll
    for (int j = 0; j < 2; ++j)
#pragma unroll
      for (int s = 0; s < 2; ++s) {
        const bf16x8 pf = pack8(Sx[j][8 * s], Sx[j][8 * s + 1], Sx[j][8 * s + 2], Sx[j][8 * s + 3], Sx[j][8 * s + 4],
                                Sx[j][8 * s + 5], Sx[j][8 * s + 6], Sx[j][8 * s + 7]);
#pragma unroll
        for (int t = 0; t < 2; ++t) {
          const bf16_t* vp = Vs + (32 * j + 16 * s) * 72 + 32 * t + troff;
          const bf16x8 vf = tr_pair(vp, vp + 8 * 72);
          O[t] = MFMA32(vf, pf, O[t]);
        }
      }
  }
}

DI void zeroO(f32x16 (&O)[2]) {
#pragma unroll
  for (int t = 0; t < 2; ++t)
#pragma unroll
    for (int r = 0; r < 16; ++r) O[t][r] = 0.f;
}

DI void store_o(bf16_t* dst, const f32x16 (&O)[2], int h2) {
#pragma unroll
  for (int t = 0; t < 2; ++t)
#pragma unroll
    for (int g = 0; g < 4; ++g) {
      u32x2 u; u.x = pack2(O[t][4 * g], O[t][4 * g + 1]); u.y = pack2(O[t][4 * g + 2], O[t][4 * g + 3]);
      *(u32x2*)(dst + 32 * t + 8 * g + 4 * h2) = u;
    }
}

__device__ void mla_item(CParams& p, int it, int S, char* lds) {
  const int tid = threadIdx.x + opq(), lane = tid & 63, w = tid >> 6, l31 = lane & 31, h2 = lane >> 5;
  const int lgq = (S == 2048) ? 4 : 7;
  const int qb = it & ((1 << lgq) - 1), bh = it >> lgq, h = bh & 3, b = bh >> 2;
  const int tokbase = b * S, gtok = tokbase + 128 * qb + 32 * w + l31;
  const bf16_t* Qb = (const bf16_t*)(p.ws + OFF_Q);
  const bf16_t* Kb = (const bf16_t*)(p.ws + OFF_K);
  const bf16_t* Vb = (const bf16_t*)(p.ws + OFF_V);
  bf16_t* Y = (bf16_t*)(p.ws + OFF_N);
  f32x16 O[2]; zeroO(O);
  float m = -1e30f, l = 0.f;
  flash_loop<96, false>(O, m, l, Qb + ((size_t)gtok * 4 + h) * 96, Kb + ((size_t)tokbase * 4 + h) * 96, 384,
                        Vb + ((size_t)tokbase * 4 + h) * 64, 256, S / 64, 0, 0, 0, lds);
  l += __shfl_xor(l, 32);
  const float il = 1.f / l;
#pragma unroll
  for (int t = 0; t < 2; ++t)
#pragma unroll
    for (int r = 0; r < 16; ++r) O[t][r] *= il;
  store_o(Y + (size_t)gtok * 1024 + h * 64, O, h2);
}

__device__ void diff_item(CParams& p, int layer, int it, int S, char* lds) {
  const int tid = threadIdx.x + opq(), lane = tid & 63, w = tid >> 6, l31 = lane & 31, h2 = lane >> 5;
  const int lgq = (S == 2048) ? 4 : 7;
  const int qb = it & ((1 << lgq) - 1), bh = it >> lgq, h = bh & 3, b = bh >> 2;
  const int tokbase = b * S, gtok = tokbase + 128 * qb + 32 * w + l31;
  const bf16_t* PR = (const bf16_t*)(p.ws + OFF_PR);
  bf16_t* Y = (bf16_t*)(p.ws + OFF_N);
  const float* lam = p.diff_lambda + layer * 128;
  float s1 = 0.f, s2 = 0.f;
  if (lane < 32) { s1 = lam[lane] * lam[32 + lane]; s2 = lam[64 + lane] * lam[96 + lane]; }
  s1 = wave_sum(s1); s2 = wave_sum(s2);
  const float lambda_init = layer ? 0.35550907f : 0.2f;
  const float lambda_full = expf(s1) - expf(s2) + lambda_init;
  f32x16 of[2]; zeroO(of);
  for (int mp = 0; mp < 2; ++mp) {
    f32x16 O[2]; zeroO(O);
    float m = -1e30f, l = 0.f;
    flash_loop<32, false>(O, m, l, PR + (size_t)gtok * NPR + C_BQ + (2 * h + mp) * 32,
                          PR + (size_t)tokbase * NPR + C_BK + (2 * h + mp) * 32, NPR,
                          PR + (size_t)tokbase * NPR + C_BV + h * 64, NPR, S / 64, 0, 0, 0, lds);
    l += __shfl_xor(l, 32);
    const float cf = (mp == 0 ? 1.f : -lambda_full) / l;
#pragma unroll
    for (int t = 0; t < 2; ++t)
#pragma unroll
      for (int r = 0; r < 16; ++r) of[t][r] += cf * O[t][r];
  }
  float ss = 0.f;
#pragma unroll
  for (int t = 0; t < 2; ++t)
#pragma unroll
    for (int r = 0; r < 16; ++r) ss += of[t][r] * of[t][r];
  ss += __shfl_xor(ss, 32);
  const float rs = rsqrtf(ss * (1.f / 64.f) + EPS) * (1.f - lambda_init);
  const float* sg = p.diff_subln + layer * 64;
#pragma unroll
  for (int t = 0; t < 2; ++t)
#pragma unroll
    for (int r = 0; r < 16; ++r) of[t][r] *= rs * sg[32 * t + crow(r, h2)];
  store_o(Y + (size_t)gtok * 1024 + 256 + h * 64, of, h2);
}

__device__ void dil_item(CParams& p, int it, int S, int B, char* lds) {
  const int tid = threadIdx.x + opq(), lane = tid & 63, w = tid >> 6, l31 = lane & 31, h2 = lane >> 5;
  const int lgS = (S == 2048) ? 11 : 14, lgB = (B == 16) ? 4 : 1;
  const int rq = it & ((1 << (lgS - 7)) - 1);
  int rest = it >> (lgS - 7);
  const int head = rest & 3; rest >>= 2;
  const int b = rest & (B - 1), g = rest >> lgB;
  const int lgd = 2 * g, dil = 1 << lgd;
  const int L = S >> lgd, lgnqb = lgS - lgd - 7;
  const int res = rq >> lgnqb, qb = rq & ((1 << lgnqb) - 1);
  const int tokbase = b * S;
  const int tq = 128 * qb + 32 * w + l31;
  const int gtok = tokbase + tq * dil + res;
  const bf16_t* PR = (const bf16_t*)(p.ws + OFF_PR);
  bf16_t* OD = (bf16_t*)(p.ws + OFF_OD);
  float* LSE = (float*)(p.ws + OFF_LSE);
  f32x16 O[2]; zeroO(O);
  float m = -1e30f, l = 0.f;
  const int hc = (g * 4 + head) * 64;
  flash_loop<64, true>(O, m, l, PR + (size_t)gtok * NPR + C_DQ + hc, PR + (size_t)(tokbase + res) * NPR + C_DK + hc,
                       (size_t)dil * NPR, PR + (size_t)(tokbase + res) * NPR + C_DV + hc, (size_t)dil * NPR, 4, tq,
                       128 * qb - 64, L, lds);
  l += __shfl_xor(l, 32);
  const float il = 1.f / l;
#pragma unroll
  for (int t = 0; t < 2; ++t)
#pragma unroll
    for (int r = 0; r < 16; ++r) O[t][r] *= il;
  store_o(OD + ((size_t)g * TG + gtok) * 256 + head * 64, O, h2);
  if (h2 == 0) LSE[((size_t)g * TG + gtok) * 4 + head] = m + __log2f(l);
}

constexpr size_t DN_QK_OFF = OFF_OD;
constexpr size_t DN_GC_OFF = OFF_OD + 32 * MiB;
constexpr size_t DN_UW_OFF = OFF_Q;

__device__ void dn_prep_item(CParams& p, int layer, int it, int S, char* lds) {
  const int tid = threadIdx.x + opq(), lane = tid & 63, w = tid >> 6, l15 = lane & 15, g4 = lane >> 4;
  const int NC = S / 64;
  const int ch = it % NC, bh = it / NC, h = bh & 3, b = bh >> 2;
  const int tokbase = b * S, s0 = ch * 64;
  const bf16_t* PR = (const bf16_t*)(p.ws + OFF_PR);
  const float* AB = (const float*)(p.ws + OFF_AB);
  bf16_t* QKg = (bf16_t*)(p.ws + DN_QK_OFF) + ((size_t)bh * NC + ch) * 8192;
  bf16_t* raw = (bf16_t*)lds;
  float* convw = (float*)(lds + 27200);
  float* RU = (float*)lds;
  float* RW = (float*)(lds + 16384);
  float* Am = (float*)(lds + 32768);
  bf16_t* Kimg = (bf16_t*)(lds + 50176);
  bf16_t* Qimg = (bf16_t*)(lds + 59392);
  float* gcs = (float*)(lds + 68608);
  float* betas = gcs + 128;
  const float* cw = p.dn_conv + (size_t)layer * 5 * 768;
  for (int ci = tid; ci < 68 * 24; ci += 256) {
    const int rr = ci / 24, c = ci % 24, seg = c >> 3, c8 = c & 7;
    const int s = s0 + rr - 2;
    u32x4 v = u32x4{0u, 0u, 0u, 0u};
    if (s >= 0 && s < S) v = *(const u32x4*)(PR + (size_t)(tokbase + s) * NPR + C_DNQKV + seg * 256 + h * 64 + c8 * 8);
    *(u32x4*)(raw + rr * 200 + seg * 64 + c8 * 8) = v;
  }
  for (int i = tid; i < 960; i += 256) {
    const int j = i / 192, c = i % 192;
    convw[i] = cw[j * 768 + (c >> 6) * 256 + h * 64 + (c & 63)];
  }
  if (tid < 128) {
    const int d = tid >> 6, pl = tid & 63;
    const int i = d ? 63 - pl : pl;
    const size_t tok = (size_t)tokbase + s0 + i;
    const float Aexp = expf(p.dn_a_log[layer * 8 + d * 4 + h]);
    const float a = AB[tok * 16 + d * 8 + h] + p.dn_dt_bias[layer * 8 + d * 4 + h];
    const float bb = AB[tok * 16 + d * 8 + 4 + h];
    const float sp = fmaxf(a, 0.f) + __logf(1.f + __expf(-fabsf(a)));
    float g = -Aexp * sp;
#pragma unroll
    for (int o = 1; o < 64; o <<= 1) { const float tv = __shfl_up(g, o); if (lane >= o) g += tv; }
    gcs[tid] = g;
    betas[tid] = sigmoidf_(bb);
    float* GC = (float*)(p.ws + DN_GC_OFF) + (((size_t)bh * 2 + d) * NC + ch) * 64;
    GC[pl] = g;
  }
  __syncthreads();
  const int pp = tid >> 2, cgp = tid & 3;
  float kv[16], vv[16];
  {
    float qv[16];
#pragma unroll
    for (int seg = 0; seg < 3; ++seg) {
      float acc[16];
#pragma unroll
      for (int c = 0; c < 16; ++c) acc[c] = 0.f;
#pragma unroll
      for (int j = 0; j < 5; ++j) {
        const bf16_t* rp = raw + (pp + j) * 200 + seg * 64 + 16 * cgp;
        const float* wp = convw + j * 192 + seg * 64 + 16 * cgp;
        const u32x4 u0 = *(const u32x4*)rp, u1 = *(const u32x4*)(rp + 8);
        const unsigned uu[8] = {u0.x, u0.y, u0.z, u0.w, u1.x, u1.y, u1.z, u1.w};
#pragma unroll
        for (int e = 0; e < 8; ++e) {
          acc[2 * e] += wp[2 * e] * __uint_as_float(uu[e] << 16);
          acc[2 * e + 1] += wp[2 * e + 1] * __uint_as_float(uu[e] & 0xffff0000u);
        }
      }
#pragma unroll
      for (int c = 0; c < 16; ++c) {
        const float sv = acc[c] * __builtin_amdgcn_rcpf(1.f + __expf(-acc[c]));
        if (seg == 0) qv[c] = sv; else if (seg == 1) kv[c] = sv; else vv[c] = sv;
      }
    }
    float sq = 0.f, sk = 0.f;
#pragma unroll
    for (int c = 0; c < 16; ++c) { sq += qv[c] * qv[c]; sk += kv[c] * kv[c]; }
    sq += __shfl_xor(sq, 1); sq += __shfl_xor(sq, 2);
    sk += __shfl_xor(sk, 1); sk += __shfl_xor(sk, 2);
    const float rq = rsqrtf(sq + EPS) * 0.125f, rk = rsqrtf(sk + EPS);
#pragma unroll
    for (int c = 0; c < 16; ++c) { qv[c] *= rq; kv[c] *= rk; }
    store8bf(Kimg + pp * 72 + 16 * cgp, kv); store8bf(Kimg + pp * 72 + 16 * cgp + 8, kv + 8);
    store8bf(Qimg + pp * 72 + 16 * cgp, qv); store8bf(Qimg + pp * 72 + 16 * cgp + 8, qv + 8);
    store8bf(QKg + pp * 64 + 16 * cgp, qv); store8bf(QKg + pp * 64 + 16 * cgp + 8, qv + 8);
    store8bf(QKg + 4096 + pp * 64 + 16 * cgp, kv); store8bf(QKg + 4096 + pp * 64 + 16 * cgp + 8, kv + 8);
  }
  for (int d = 0; d < 2; ++d) {
    __syncthreads();
    {
      const int pl = d ? 63 - pp : pp;
      const float bet = betas[d * 64 + pl], egc = __expf(gcs[d * 64 + pl]);
#pragma unroll
      for (int c = 0; c < 16; ++c) {
        RU[pl * 64 + 16 * cgp + c] = vv[c] * bet;
        RW[pl * 64 + 16 * cgp + c] = kv[c] * bet * egc;
      }
    }
    {
      f32x4 KK[4];
#pragma unroll
      for (int t = 0; t < 4; ++t) KK[t] = f32x4{0.f, 0.f, 0.f, 0.f};
      const int jl = 16 * w + l15;
      const int jrow = d ? 63 - jl : jl;
#pragma unroll
      for (int ks = 0; ks < 2; ++ks) {
        const bf16x8 bfk = *(const bf16x8*)(Kimg + jrow * 72 + 32 * ks + 8 * g4);
#pragma unroll
        for (int rt = 0; rt < 4; ++rt) {
          const int il = 16 * rt + l15;
          const int irow = d ? 63 - il : il;
          const bf16x8 afk = *(const bf16x8*)(Kimg + irow * 72 + 32 * ks + 8 * g4);
          KK[rt] = MFMA16(afk, bfk, KK[rt]);
        }
      }
      const float gcj = gcs[d * 64 + jl];
#pragma unroll
      for (int rt = 0; rt < 4; ++rt)
#pragma unroll
        for (int r = 0; r < 4; ++r) {
          const int i = 16 * rt + 4 * g4 + r;
          const float ee = __expf(fminf(gcs[d * 64 + i] - gcj, 0.f));
          Am[i * 68 + jl] = (i > jl) ? betas[d * 64 + i] * KK[rt][r] * ee : 0.f;
        }
    }
    __syncthreads();
    float xs[32];
#pragma unroll
    for (int q = 0; q < 32; ++q) xs[q] = 0.f;
    const int c = tid >> 1, half = tid & 1;
    {
      const float* Rc = (c < 64) ? (RU + c) : (RW + (c - 64));
      const float* Ah = Am + 4 * half;
#pragma unroll
      for (int i = 0; i < 64; ++i) {
        float part = 0.f;
#pragma unroll
        for (int q = 0; q < (i + 7) / 8; ++q) {
          const f32x4 a = *(const f32x4*)(Ah + i * 68 + 8 * q);
          part += a[0] * xs[4 * q] + a[1] * xs[4 * q + 1] + a[2] * xs[4 * q + 2] + a[3] * xs[4 * q + 3];
        }
        const float other = __int_as_float(__builtin_amdgcn_update_dpp(0, __float_as_int(part), 0xB1, 0xf, 0xf, true));
        const float xi = Rc[i * 64] - (part + other);
        const int loc = ((i >> 3) << 2) + (i & 3);
        if (((i >> 2) & 1) == 0) xs[loc] = (half == 0) ? xi : xs[loc];
        else xs[loc] = (half == 1) ? xi : xs[loc];
        if (i < 16 ? ((i & 7) == 7) : (i < 32 ? ((i & 3) == 3) : ((i & 1) == 1))) asm volatile("" ::: "memory");
      }
    }
    {
      bf16_t* UWg = (bf16_t*)(p.ws + DN_UW_OFF) + ((((size_t)bh * 2 + d) * NC + ch) * 8192);
      const float sgn = (c < 64) ? 1.f : -1.f;
      bf16_t* dst = UWg + ((c < 64) ? c : (4096 + c - 64));
#pragma unroll
      for (int loc = 0; loc < 32; ++loc) {
        const int i = (((loc >> 2) * 2 + half) << 2) + (loc & 3);
        dst[i * 64] = f2bf(sgn * xs[loc]);
      }
    }
  }
}

__device__ void dn_scan_chain(CParams& p, int it, int S, char* lds) {
  const int tid0 = threadIdx.x + opq();
  const int dir = it & 1, bh = it >> 1, h = bh & 3, b = bh >> 2;
  const int tokbase = b * S, NC = S / 64;
  bf16_t* OUT = (bf16_t*)(p.ws + (dir ? OFF_OB : OFF_OF));
  const bf16_t* QKg = (const bf16_t*)(p.ws + DN_QK_OFF) + (size_t)bh * NC * 8192;
  const bf16_t* UWg = (const bf16_t*)(p.ws + DN_UW_OFF) + (size_t)it * NC * 8192;
  const float* GCg = (const float*)(p.ws + DN_GC_OFF) + (size_t)it * NC * 64;
  bf16_t* Uimg = (bf16_t*)lds;
  bf16_t* Wn = Uimg + 4608;
  bf16_t* Qimg = Wn + 4608;
  bf16_t* Kimg = Qimg + 4608;
  bf16_t* Kt = Kimg + 4608;
  bf16_t* Iimg = Kt + 4608;
  float* gcs = (float*)(lds + 6 * 9216);
  f32x4 Sd[4];
#pragma unroll
  for (int t = 0; t < 4; ++t) Sd[t] = f32x4{0.f, 0.f, 0.f, 0.f};
  u32x4 ru[2], rw[2], rq[2], rk[2];
  float rg = 0.f;
  auto prefetch = [&](int cc_) {
    const int ch_ = dir ? (NC - 1 - cc_) : cc_;
    const int tp = tid0 + opq();
    const bf16_t* uw = UWg + (size_t)ch_ * 8192;
    const bf16_t* qk = QKg + (size_t)ch_ * 8192;
#pragma unroll
    for (int k = 0; k < 2; ++k) {
      const int ci = tp + 256 * k, row = ci >> 3, c8 = ci & 7;
      const int srow = dir ? 63 - row : row;
      ru[k] = *(const u32x4*)(uw + row * 64 + c8 * 8);
      rw[k] = *(const u32x4*)(uw + 4096 + row * 64 + c8 * 8);
      rq[k] = *(const u32x4*)(qk + srow * 64 + c8 * 8);
      rk[k] = *(const u32x4*)(qk + 4096 + srow * 64 + c8 * 8);
    }
    if (tp < 64) rg = GCg[(size_t)ch_ * 64 + tp];
  };
  prefetch(0);
  for (int cc = 0; cc < NC; ++cc) {
    const int tid = tid0 + opq(), lane = tid & 63, w = tid >> 6, l15 = lane & 15, g4 = lane >> 4;
    const int e_col = 16 * w + l15;
    const int ch = dir ? (NC - 1 - cc) : cc;
    const int s0 = ch * 64;
    __syncthreads();
#pragma unroll
    for (int k = 0; k < 2; ++k) {
      const int ci = tid + 256 * k, row = ci >> 3, c8 = ci & 7;
      *(u32x4*)(Uimg + row * 72 + c8 * 8) = ru[k];
      *(u32x4*)(Wn + row * 72 + c8 * 8) = rw[k];
      *(u32x4*)(Qimg + row * 72 + c8 * 8) = rq[k];
      *(u32x4*)(Kimg + row * 72 + c8 * 8) = rk[k];
      const unsigned uu[4] = {rk[k].x, rk[k].y, rk[k].z, rk[k].w};
#pragma unroll
      for (int e = 0; e < 4; ++e) {
        Kt[(8 * c8 + 2 * e) * 72 + row] = (bf16_t)(uu[e] & 0xffffu);
        Kt[(8 * c8 + 2 * e + 1) * 72 + row] = (bf16_t)(uu[e] >> 16);
      }
    }
    if (tid < 64) gcs[tid] = rg;
    if (cc + 1 < NC) prefetch(cc + 1);
    __syncthreads();
    {
      f32x4 QK[4];
#pragma unroll
      for (int t = 0; t < 4; ++t) QK[t] = f32x4{0.f, 0.f, 0.f, 0.f};
#pragma unroll
      for (int ks = 0; ks < 2; ++ks) {
        const bf16x8 bfk = *(const bf16x8*)(Kimg + (16 * w + l15) * 72 + 32 * ks + 8 * g4);
#pragma unroll
        for (int rt = 0; rt < 4; ++rt) {
          const bf16x8 afq = *(const bf16x8*)(Qimg + (16 * rt + l15) * 72 + 32 * ks + 8 * g4);
          QK[rt] = MFMA16(afq, bfk, QK[rt]);
        }
      }
      const float gcj = gcs[e_col];
#pragma unroll
      for (int rt = 0; rt < 4; ++rt)
#pragma unroll
        for (int r = 0; r < 4; ++r) {
          const int i = 16 * rt + 4 * g4 + r;
          const float ee = __expf(fminf(gcs[i] - gcj, 0.f));
          Iimg[i * 72 + e_col] = f2bf((i >= e_col) ? QK[rt][r] * ee : 0.f);
        }
    }
    __syncthreads();
    {
      bf16x8 Bs[2];
#pragma unroll
      for (int ks = 0; ks < 2; ++ks)
        Bs[ks] = pack8(Sd[2 * ks][0], Sd[2 * ks][1], Sd[2 * ks][2], Sd[2 * ks][3], Sd[2 * ks + 1][0], Sd[2 * ks + 1][1],
                       Sd[2 * ks + 1][2], Sd[2 * ks + 1][3]);
      f32x4 vn[4], qs[4], iv[4];
#pragma unroll
      for (int rt = 0; rt < 4; ++rt) {
#pragma unroll
        for (int r = 0; r < 4; ++r) vn[rt][r] = bf2f(Uimg[(16 * rt + 4 * g4 + r) * 72 + e_col]);
        qs[rt] = f32x4{0.f, 0.f, 0.f, 0.f};
        iv[rt] = f32x4{0.f, 0.f, 0.f, 0.f};
#pragma unroll
        for (int ks = 0; ks < 2; ++ks) {
          const bf16_t* wp = Wn + (16 * rt + l15) * 72 + 32 * ks + 4 * g4;
          const bf16_t* qp = Qimg + (16 * rt + l15) * 72 + 32 * ks + 4 * g4;
          vn[rt] = MFMA16(ld2x4(wp, wp + 16), Bs[ks], vn[rt]);
          qs[rt] = MFMA16(ld2x4(qp, qp + 16), Bs[ks], qs[rt]);
        }
      }
      bf16x8 Bv[2];
#pragma unroll
      for (int ks = 0; ks < 2; ++ks)
        Bv[ks] = pack8(vn[2 * ks][0], vn[2 * ks][1], vn[2 * ks][2], vn[2 * ks][3], vn[2 * ks + 1][0], vn[2 * ks + 1][1],
                       vn[2 * ks + 1][2], vn[2 * ks + 1][3]);
#pragma unroll
      for (int rt = 0; rt < 4; ++rt)
#pragma unroll
        for (int ks = 0; ks < 2; ++ks) {
          const bf16_t* ip = Iimg + (16 * rt + l15) * 72 + 32 * ks + 4 * g4;
          iv[rt] = MFMA16(ld2x4(ip, ip + 16), Bv[ks], iv[rt]);
        }
      const float gc63 = gcs[63];
#pragma unroll
      for (int rt = 0; rt < 4; ++rt)
#pragma unroll
        for (int r = 0; r < 4; ++r) {
          const int pos = 16 * rt + 4 * g4 + r;
          const float o = qs[rt][r] * __expf(gcs[pos]) + iv[rt][r];
          const int i = dir ? 63 - pos : pos;
          OUT[((size_t)tokbase + s0 + i) * 256 + h * 64 + e_col] = f2bf(o);
          vn[rt][r] *= __expf(gc63 - gcs[pos]);
        }
      bf16x8 Bv2[2];
#pragma unroll
      for (int ks = 0; ks < 2; ++ks)
        Bv2[ks] = pack8(vn[2 * ks][0], vn[2 * ks][1], vn[2 * ks][2], vn[2 * ks][3], vn[2 * ks + 1][0], vn[2 * ks + 1][1],
                        vn[2 * ks + 1][2], vn[2 * ks + 1][3]);
      const float gl = __expf(gc63);
#pragma unroll
      for (int dt = 0; dt < 4; ++dt) {
#pragma unroll
        for (int r = 0; r < 4; ++r) Sd[dt][r] *= gl;
#pragma unroll
        for (int ks = 0; ks < 2; ++ks) {
          const bf16_t* kp = Kt + (16 * dt + l15) * 72 + 32 * ks + 4 * g4;
          Sd[dt] = MFMA16(ld2x4(kp, kp + 16), Bv2[ks], Sd[dt]);
        }
      }
    }
  }
}

__device__ void phase_combine(CParams& p, int layer, const float* __restrict__ xg) {
  const int tidq = threadIdx.x + opq(); const int wave = tidq >> 6, lane = tidq & 63;
  const bf16_t* PR = (const bf16_t*)(p.ws + OFF_PR);
  const bf16_t* OD = (const bf16_t*)(p.ws + OFF_OD);
  const float* LSE = (const float*)(p.ws + OFF_LSE);
  const bf16_t* OFb = (const bf16_t*)(p.ws + OFF_OF);
  const bf16_t* OBb = (const bf16_t*)(p.ws + OFF_OB);
  bf16_t* Y = (bf16_t*)(p.ws + OFF_N);
  bf16_t* Np = (bf16_t*)(p.ws + OFF_Q);
  const float* gmix = p.norm_mix + layer * 1024;
  const float* gdn = p.dn_out_norm + layer * 64;
  const int head = lane >> 4;
  for (int r = blockIdx.x * 4 + wave; r < TG; r += gridDim.x * 4) {
    {
      float lg[3];
#pragma unroll
      for (int g = 0; g < 3; ++g) lg[g] = LSE[((size_t)g * TG + r) * 4 + head];
      const float mx = fmaxf(lg[0], fmaxf(lg[1], lg[2]));
      float wg[3], den = 0.f;
#pragma unroll
      for (int g = 0; g < 3; ++g) { wg[g] = exp2_(lg[g] - mx); den += wg[g]; }
      const float id = 1.f / den;
      float o[4] = {0.f, 0.f, 0.f, 0.f};
#pragma unroll
      for (int g = 0; g < 3; ++g) {
        const u32x2 u = ((const u32x2*)(OD + ((size_t)g * TG + r) * 256))[lane];
        const float c = wg[g] * id;
        o[0] += c * __uint_as_float(u.x << 16); o[1] += c * __uint_as_float(u.x & 0xffff0000u);
        o[2] += c * __uint_as_float(u.y << 16); o[3] += c * __uint_as_float(u.y & 0xffff0000u);
      }
      u32x2 ou; ou.x = pack2(o[0], o[1]); ou.y = pack2(o[2], o[3]);
      ((u32x2*)(Y + (size_t)r * 1024 + 768))[lane] = ou;
    }
    {
      const u32x2 uf = ((const u32x2*)(OFb + (size_t)r * 256))[lane];
      const u32x2 ub = ((const u32x2*)(OBb + (size_t)r * 256))[lane];
      const u32x2 uz = ((const u32x2*)(PR + (size_t)r * NPR + C_Z))[lane];
      float o[4], z[4];
      o[0] = __uint_as_float(uf.x << 16) + __uint_as_float(ub.x << 16);
      o[1] = __uint_as_float(uf.x & 0xffff0000u) + __uint_as_float(ub.x & 0xffff0000u);
      o[2] = __uint_as_float(uf.y << 16) + __uint_as_float(ub.y << 16);
      o[3] = __uint_as_float(uf.y & 0xffff0000u) + __uint_as_float(ub.y & 0xffff0000u);
      z[0] = __uint_as_float(uz.x << 16); z[1] = __uint_as_float(uz.x & 0xffff0000u);
      z[2] = __uint_as_float(uz.y << 16); z[3] = __uint_as_float(uz.y & 0xffff0000u);
      float ss = o[0] * o[0] + o[1] * o[1] + o[2] * o[2] + o[3] * o[3];
      ss += __shfl_xor(ss, 1); ss += __shfl_xor(ss, 2); ss += __shfl_xor(ss, 4); ss += __shfl_xor(ss, 8);
      const float rs = rsqrtf(ss * (1.f / 64.f) + EPS);
      const float4 gg = ((const float4*)gdn)[lane & 15];
      u32x2 ou;
      ou.x = pack2(o[0] * rs * gg.x * siluf_(z[0]), o[1] * rs * gg.y * siluf_(z[1]));
      ou.y = pack2(o[2] * rs * gg.z * siluf_(z[2]), o[3] * rs * gg.w * siluf_(z[3]));
      ((u32x2*)(Y + (size_t)r * 1024 + 512))[lane] = ou;
    }
    {
      const float4* xr = (const float4*)(xg + (size_t)r * 1024);
      float4 v[4];
      float ss = 0.f;
#pragma unroll
      for (int i = 0; i < 4; ++i) { v[i] = xr[lane + 64 * i]; ss += v[i].x * v[i].x + v[i].y * v[i].y + v[i].z * v[i].z + v[i].w * v[i].w; }
      ss = wave_sum(ss);
      const float rs = rsqrtf(ss * (1.f / 1024.f) + EPS);
#pragma unroll
      for (int i = 0; i < 4; ++i) {
        const float4 gg = ((const float4*)gmix)[lane + 64 * i];
        u32x2 o; o.x = pack2(v[i].x * rs * gg.x, v[i].y * rs * gg.y); o.y = pack2(v[i].z * rs * gg.z, v[i].w * rs * gg.w);
        ((u32x2*)(Np + (size_t)r * 1024))[lane + 64 * i] = o;
      }
    }
  }
}

#ifndef REP_MIX
#define REP_MIX 1
#endif
#ifndef REP_GEMM
#define REP_GEMM 1
#endif
__global__ void __launch_bounds__(256, 2) mega(Params pk) {
  extern __shared__ __attribute__((aligned(16))) char lds[];
  __shared__ int s_item;
  cg::grid_group grid = cg::this_grid();
  CParams* kp = (CParams*)__builtin_amdgcn_kernarg_segment_ptr();
#define PP_ CParams& p = *launder(kp); const bf16_t* wb = (const bf16_t*)(p.ws + OFF_WB); bf16_t* Nb = (bf16_t*)(p.ws + OFF_N); \
            bf16_t* PRb = (bf16_t*)(p.ws + OFF_PR); bf16_t* Npb = (bf16_t*)(p.ws + OFF_Q); bf16_t* PB = (bf16_t*)(p.ws + OFF_OD); \
            float* xg = p.x + (size_t)grp * TG * 1024; (void)wb; (void)Nb; (void)PRb; (void)Npb; (void)PB; (void)xg;
  { CParams& p = *launder(kp); phase_init(p, lds); }
  grid.sync();
  for (int layer = 0; layer < 2; ++layer) {
    if (layer > 0) { CParams& p = *launder(kp); phase_convert(p, layer, lds); grid.sync(); }
    for (int grp = 0; grp < 2; ++grp) {
      const int S = grp ? 2048 : 16384, B = grp ? 16 : 2;
      { PP_ phase_norm(xg, p.norm_ff1 + layer * 1024, Nb, nullptr, nullptr); }
      grid.sync();
      for (int rep = 0; rep < REP_GEMM; ++rep) {
        { PP_ phase_ffn_a(Nb, wb + W_FF1_1, wb + W_FF1_3, PRb, lds); }
        grid.sync();
      }
      { PP_ phase_gemm_resid(PRb, 2816, wb + W_FF1_2, xg, 0.5f, lds); }
      grid.sync();
      { PP_ phase_norm(xg, p.norm_mix + layer * 1024, Nb, nullptr, nullptr); }
      grid.sync();
      for (int rep = 0; rep < REP_GEMM; ++rep) {
        { PP_ phase_proj(p, Nb, wb + W_IN, S, lds); }
        grid.sync();
      }
      {
        PP_
        int* c0 = (int*)(p.ws + OFF_CNT) + (layer * 2 + grp) * 4;
        for (;;) {
          __syncthreads();
          if (threadIdx.x == 0) s_item = atomicAdd(c0, 1);
          __syncthreads();
          const int it = s_item;
          if (it >= 2048) break;
          dn_prep_item(p, layer, it, S, lds);
        }
      }
      grid.sync();
      {
        PP_
        int* c1 = (int*)(p.ws + OFF_CNT) + (layer * 2 + grp) * 4 + 1;
        const int nDN = B * 8, total = nDN + 1024;
        for (;;) {
          __syncthreads();
          if (threadIdx.x == 0) s_item = atomicAdd(c1, 1);
          __syncthreads();
          int it = s_item;
          if (it >= total) break;
          if (it < nDN) { dn_scan_chain(p, it, S, lds); continue; }
          diff_item(p, layer, it - nDN, S, lds);
        }
      }
      grid.sync();
      {
        PP_
        int* c2 = (int*)(p.ws + OFF_CNT) + (layer * 2 + grp) * 4 + 2;
        const int nDil = 3072, total = nDil + 256 * 7;
        for (;;) {
          __syncthreads();
          if (threadIdx.x == 0) s_item = atomicAdd(c2, 1);
          __syncthreads();
          int it = s_item;
          if (it >= total) break;
          if (it < nDil) { dil_item(p, it, S, B, lds); continue; }
          it -= nDil;
          mla_up_tile(p, it / 7, it % 7, S, lds);
        }
      }
      grid.sync();
      {
        PP_
        int* c3 = (int*)(p.ws + OFF_CNT) + (layer * 2 + grp) * 4 + 3;
        for (;;) {
          __syncthreads();
          if (threadIdx.x == 0) s_item = atomicAdd(c3, 1);
          __syncthreads();
          const int it = s_item;
          if (it >= 1024) break;
          mla_item(p, it, S, lds);
        }
      }
      grid.sync();
      { PP_ phase_combine(p, layer, xg); }
      grid.sync();
      for (int rep = 0; rep < REP_GEMM; ++rep) {
        { PP_ phase_merge(Npb, Nb, wb + W_G, wb + W_B, PRb, lds); }
        grid.sync();
      }
      { PP_ phase_gemm_resid(PRb, 1024, wb + W_O, xg, 1.0f, lds); }
      grid.sync();
      { PP_ phase_norm(xg, p.norm_ff2 + layer * 1024, Nb, nullptr, nullptr); }
      grid.sync();
      for (int rep = 0; rep < REP_GEMM; ++rep) {
        { PP_ phase_ffn_a(Nb, wb + W_FF2_1, wb + W_FF2_3, PRb, lds); }
        grid.sync();
      }
      { PP_ phase_gemm_resid(PRb, 2816, wb + W_FF2_2, xg, 0.5f, lds); }
      grid.sync();
      { PP_ phase_norm(xg, p.norm_ple + layer * 1024, Nb, p.p_in[grp] + (size_t)layer * TG * 256, PB); }
      grid.sync();
      { PP_ phase_ple(Nb, PB, wb + W_PG, wb + W_PP, xg, lds); }
      grid.sync();
    }
  }
  { CParams& p = *launder(kp); phase_final_norm(p.x, p.norm_final); }
}

extern "C" void kernel_launch(void* const* d_in, const int* in_sizes, int n_in, void* d_out, int out_size, void* d_ws,
                              size_t ws_size, hipStream_t stream) {
  (void)in_sizes; (void)n_in; (void)out_size;
  Params p{};
  p.x_in[0] = (const float*)d_in[0]; p.x_in[1] = (const float*)d_in[1];
  p.p_in[0] = (const float*)d_in[2]; p.p_in[1] = (const float*)d_in[3];
  p.norm_ff1 = (const float*)d_in[4]; p.ff1_w1 = (const float*)d_in[5]; p.ff1_w3 = (const float*)d_in[6];
  p.ff1_w2 = (const float*)d_in[7]; p.norm_mix = (const float*)d_in[8]; p.w_in = (const float*)d_in[9];
  p.mla_q_norm = (const float*)d_in[10]; p.mla_kv_norm = (const float*)d_in[11]; p.mla_w_uq = (const float*)d_in[12];
  p.mla_w_ukv = (const float*)d_in[13]; p.diff_lambda = (const float*)d_in[14]; p.diff_subln = (const float*)d_in[15];
  p.dn_conv = (const float*)d_in[16]; p.dn_a_log = (const float*)d_in[17]; p.dn_dt_bias = (const float*)d_in[18];
  p.dn_out_norm = (const float*)d_in[19]; p.w_branch = (const float*)d_in[20]; p.w_gate = (const float*)d_in[21];
  p.w_out = (const float*)d_in[22]; p.norm_ff2 = (const float*)d_in[23]; p.ff2_w1 = (const float*)d_in[24];
  p.ff2_w3 = (const float*)d_in[25]; p.ff2_w2 = (const float*)d_in[26]; p.norm_ple = (const float*)d_in[27];
  p.ple_gate = (const float*)d_in[28]; p.ple_proj = (const float*)d_in[29]; p.norm_final = (const float*)d_in[30];
  p.x = (float*)d_out;
  p.ws = (char*)d_ws;
  static int grid_blocks = 0;
  if (!grid_blocks) {
    int dev = 0, cus = 0, per_cu = 0;
    hipGetDevice(&dev);
    hipDeviceGetAttribute(&cus, hipDeviceAttributeMultiprocessorCount, dev);
    hipFuncSetAttribute((const void*)mega, hipFuncAttributeMaxDynamicSharedMemorySize, (int)LDS_BYTES);
    hipOccupancyMaxActiveBlocksPerMultiprocessor(&per_cu, mega, 256, LDS_BYTES);
    if (per_cu < 1) per_cu = 1;
    grid_blocks = cus * per_cu;
  }
  if (ws_size < WS_NEED) {
    fprintf(stderr, "workspace too small: %zu < %zu\n", ws_size, (size_t)WS_NEED);
    return;
  }
  void* args[] = {&p};
  hipError_t e = hipLaunchCooperativeKernel((void*)mega, dim3(grid_blocks), dim3(256), args, LDS_BYTES, stream);
  if (e != hipSuccess) fprintf(stderr, "cooperative launch failed: %s (grid %d)\n", hipGetErrorString(e), grid_blocks);
}
```

```cpp
#include <hip/hip_runtime.h>
#include <hip/hip_cooperative_groups.h>
#include <stdint.h>
#include <stdio.h>
namespace cg = cooperative_groups;

typedef unsigned short bf16_t;
using bf16x8 = __attribute__((ext_vector_type(8))) short;
using bf16x4 = __attribute__((ext_vector_type(4))) short;
using f32x16 = __attribute__((ext_vector_type(16))) float;
using f32x4 = __attribute__((ext_vector_type(4))) float;
using u32x4 = __attribute__((ext_vector_type(4))) unsigned;
using u32x2 = __attribute__((ext_vector_type(2))) unsigned;

#define DI __device__ __forceinline__
#define MFMA32(a, b, c) __builtin_amdgcn_mfma_f32_32x32x16_bf16((a), (b), (c), 0, 0, 0)
#define MFMA16(a, b, c) __builtin_amdgcn_mfma_f32_16x16x32_bf16((a), (b), (c), 0, 0, 0)

constexpr int TG = 32768;
constexpr int NPR = 4608;
constexpr float EPS = 1e-6f;
constexpr float LOG2E = 1.4426950408889634f;
constexpr int C_CQ = 0, C_CKV = 256, C_BQ = 384, C_BK = 640, C_BV = 896, C_DNQKV = 1152, C_Z = 1920,
              C_DQ = 2176, C_DK = 2944, C_DV = 3712;
constexpr size_t MiB = 1048576;
constexpr size_t OFF_WB = 0, OFF_TAB = 57 * MiB, OFF_CNT = 63 * MiB, OFF_N = 64 * MiB, OFF_PR = 128 * MiB,
                 OFF_Q = 416 * MiB, OFF_K = 440 * MiB, OFF_V = 464 * MiB, OFF_AB = 480 * MiB, OFF_OD = 482 * MiB,
                 OFF_LSE = 530 * MiB, OFF_OF = 532 * MiB, OFF_OB = 548 * MiB, WS_NEED = 564 * MiB;
constexpr size_t W_FF1_1 = 0, W_FF1_3 = 2883584, W_FF1_2 = 5767168, W_IN = 8650752, W_UQ = 13369344,
                 W_UKV = 13467648, W_G = 13533184, W_B = 17727488, W_O = 18776064, W_FF2_1 = 19824640,
                 W_FF2_3 = 22708224, W_FF2_2 = 25591808, W_PG = 28475392, W_PP = 29523968;
constexpr size_t LDS_BYTES = 78336;

struct Params {
  const float* x_in[2];
  const float* p_in[2];
  const float *norm_ff1, *ff1_w1, *ff1_w3, *ff1_w2, *norm_mix, *w_in, *mla_q_norm, *mla_kv_norm, *mla_w_uq,
      *mla_w_ukv, *diff_lambda, *diff_subln, *dn_conv, *dn_a_log, *dn_dt_bias, *dn_out_norm, *w_branch, *w_gate,
      *w_out, *norm_ff2, *ff2_w1, *ff2_w3, *ff2_w2, *norm_ple, *ple_gate, *ple_proj, *norm_final;
  float* x;
  char* ws;
};

typedef const __attribute__((address_space(4))) Params CParams;
DI CParams* launder(CParams* q) { asm volatile("" : "+s"(q)); return q; }

typedef __bf16 bf2_t __attribute__((ext_vector_type(2)));
typedef float f2_t __attribute__((ext_vector_type(2)));
DI bf16_t f2bf(float x) { return __builtin_bit_cast(bf16_t, (__bf16)x); }
DI float bf2f(bf16_t b) { return __uint_as_float(((unsigned)b) << 16); }
DI unsigned pack2(float a, float b) { f2_t v = {a, b}; return __builtin_bit_cast(unsigned, __builtin_convertvector(v, bf2_t)); }
DI float wave_sum(float v) {
#pragma unroll
  for (int o = 32; o > 0; o >>= 1) v += __shfl_xor(v, o);
  return v;
}
DI float sigmoidf_(float x) { return 1.f / (1.f + __expf(-x)); }
DI float siluf_(float x) { return x / (1.f + __expf(-x)); }
DI float exp2_(float x) { return __builtin_amdgcn_exp2f(x); }
DI int opq() { int z; asm volatile("v_mov_b32 %0, 0" : "=v"(z)); return z; }
DI int crow(int r, int h2) { return (r & 3) + 8 * (r >> 2) + 4 * h2; }
DI bf16x8 pack8(float a0, float a1, float a2, float a3, float a4, float a5, float a6, float a7) {
  u32x4 u;
  u.x = pack2(a0, a1); u.y = pack2(a2, a3); u.z = pack2(a4, a5); u.w = pack2(a6, a7);
  return __builtin_bit_cast(bf16x8, u);
}
DI bf16x8 ld2x4(const bf16_t* p0, const bf16_t* p1) {
  u32x2 a = *(const u32x2*)p0, b = *(const u32x2*)p1;
  u32x4 u; u.x = a.x; u.y = a.y; u.z = b.x; u.w = b.y;
  return __builtin_bit_cast(bf16x8, u);
}
DI void store8bf(bf16_t* dst, const float* v) {
  u32x4 u; u.x = pack2(v[0], v[1]); u.y = pack2(v[2], v[3]); u.z = pack2(v[4], v[5]); u.w = pack2(v[6], v[7]);
  *(u32x4*)dst = u;
}

struct MatDesc { const float* src; bf16_t* dst; int K, ldsrc, Ndst, map; const float* rowscale; };

DI int map_col(int map, int n) {
  if (map == 0) return n;
  if (map == 1) {
    if (n < 384) return n;
    if (n < 1920) return n + 32;
    if (n < 4480) return n + 48;
    if (n < 4512) return n - 4480 + 384;
    if (n < 4528) return n - 4512 + 1952;
    return -1;
  }
  if (n < 256) return (n >> 6) * 96 + (n & 63);
  return ((n - 256) >> 5) * 96 + 64 + ((n - 256) & 31);
}

DI MatDesc get_mat(CParams& p, int l, int id) {
  bf16_t* wb = (bf16_t*)(p.ws + OFF_WB);
  MatDesc d; d.map = 0; d.rowscale = nullptr;
  const size_t FF = (size_t)1024 * 2816;
  switch (id) {
    case 0: d.src = p.ff1_w1 + l * FF; d.dst = wb + W_FF1_1; d.K = 1024; d.ldsrc = 2816; d.Ndst = 2816; break;
    case 1: d.src = p.ff1_w3 + l * FF; d.dst = wb + W_FF1_3; d.K = 1024; d.ldsrc = 2816; d.Ndst = 2816; break;
    case 2: d.src = p.ff1_w2 + l * FF; d.dst = wb + W_FF1_2; d.K = 2816; d.ldsrc = 1024; d.Ndst = 1024; break;
    case 3: d.src = p.w_in + (size_t)l * 1024 * 4528; d.dst = wb + W_IN; d.K = 1024; d.ldsrc = 4528; d.Ndst = 4608; d.map = 1; break;
    case 4: d.src = p.mla_w_uq + (size_t)l * 256 * 384; d.dst = wb + W_UQ; d.K = 256; d.ldsrc = 384; d.Ndst = 384; d.map = 2; d.rowscale = p.mla_q_norm + l * 256; break;
    case 5: d.src = p.mla_w_ukv + (size_t)l * 128 * 512; d.dst = wb + W_UKV; d.K = 128; d.ldsrc = 512; d.Ndst = 512; d.rowscale = p.mla_kv_norm + l * 128; break;
    case 6: case 7: case 8: case 9:
      d.src = p.w_gate + (size_t)(l * 4 + id - 6) * 1048576; d.dst = wb + W_G + (size_t)(id - 6) * 1048576; d.K = 1024; d.ldsrc = 1024; d.Ndst = 1024; break;
    case 10: case 11: case 12: case 13:
      d.src = p.w_branch + (size_t)(l * 4 + id - 10) * 262144; d.dst = wb + W_B + (size_t)(id - 10) * 262144; d.K = 256; d.ldsrc = 1024; d.Ndst = 1024; break;
    case 14: d.src = p.w_out + (size_t)l * 1048576; d.dst = wb + W_O; d.K = 1024; d.ldsrc = 1024; d.Ndst = 1024; break;
    case 15: d.src = p.ff2_w1 + l * FF; d.dst = wb + W_FF2_1; d.K = 1024; d.ldsrc = 2816; d.Ndst = 2816; break;
    case 16: d.src = p.ff2_w3 + l * FF; d.dst = wb + W_FF2_3; d.K = 1024; d.ldsrc = 2816; d.Ndst = 2816; break;
    case 17: d.src = p.ff2_w2 + l * FF; d.dst = wb + W_FF2_2; d.K = 2816; d.ldsrc = 1024; d.Ndst = 1024; break;
    case 18: d.src = p.ple_gate + (size_t)l * 1048576; d.dst = wb + W_PG; d.K = 1024; d.ldsrc = 1024; d.Ndst = 1024; break;
    default: d.src = p.ple_proj + (size_t)l * 262144; d.dst = wb + W_PP; d.K = 256; d.ldsrc = 1024; d.Ndst = 1024; break;
  }
  return d;
}

__device__ void phase_convert(CParams& p, int l, char* lds) {
  float* T = (float*)lds;
  const int tid = threadIdx.x + opq();
  for (int id = 0; id < 20; ++id) {
    MatDesc d = get_mat(p, l, id);
    const int nkt = d.K >> 6, nnt = d.Ndst >> 6, nt_all = nkt * nnt;
    for (int t = blockIdx.x; t < nt_all; t += gridDim.x) {
      const int kt = t / nnt, nt = t % nnt;
      __syncthreads();
      {
        const int nl = tid & 63;
        const int sc = map_col(d.map, nt * 64 + nl);
#pragma unroll 4
        for (int i = 0; i < 16; ++i) {
          const int kl = (tid >> 6) + 4 * i;
          const int k = kt * 64 + kl;
          float v = 0.f;
          if (sc >= 0) v = d.src[(size_t)k * d.ldsrc + sc];
          if (d.rowscale) v *= d.rowscale[k];
          T[kl * 65 + nl] = v;
        }
      }
      __syncthreads();
      {
        const int kl = tid & 63;
#pragma unroll 4
        for (int i = 0; i < 16; ++i) {
          const int nl = (tid >> 6) + 4 * i;
          d.dst[(size_t)(nt * 64 + nl) * d.K + kt * 64 + kl] = f2bf(T[kl * 65 + nl]);
        }
      }
    }
  }
}

__device__ void phase_init(CParams& p, char* lds) {
  const size_t gtid = (size_t)blockIdx.x * 256 + threadIdx.x + opq(), gn = (size_t)gridDim.x * 256;
  {
    const size_t n4 = (size_t)TG * 1024 / 4;
    float4* dst = (float4*)p.x;
    const float4* s0 = (const float4*)p.x_in[0];
    const float4* s1 = (const float4*)p.x_in[1];
    for (size_t i = gtid; i < n4; i += gn) { dst[i] = s0[i]; dst[n4 + i] = s1[i]; }
  }
  {
    float2* t32 = (float2*)(p.ws + OFF_TAB);
    float2* t64 = (float2*)(p.ws + OFF_TAB + 2 * MiB);
    for (size_t i = gtid; i < (size_t)16384 * 48; i += gn) {
      const int pos = (int)(i / 48), f = (int)(i % 48);
      float inv;
      if (f < 16) inv = exp2f(-(float)f * (13.287712379549449f / 16.f));
      else inv = exp2f(-(float)(f - 16) * (13.287712379549449f / 32.f));
      const float ang = (float)pos * inv;
      const double xd = (double)ang;
      const double n = rint(xd * 0.15915494309189535);
      const float rf = (float)(xd - n * 6.283185307179586);
      float2 cs; cs.x = __cosf(rf); cs.y = __sinf(rf);
      if (f < 16) t32[(size_t)pos * 16 + f] = cs; else t64[(size_t)pos * 32 + (f - 16)] = cs;
    }
  }
  if (blockIdx.x == 0 && threadIdx.x < 64) ((int*)(p.ws + OFF_CNT))[threadIdx.x] = 0;
  phase_convert(p, 0, lds);
}

__device__ void phase_norm(const float* __restrict__ x, const float* __restrict__ g, bf16_t* __restrict__ dst,
                           const float* __restrict__ psrc, bf16_t* __restrict__ pdst) {
  const int tidq = threadIdx.x + opq(); const int wave = tidq >> 6, lane = tidq & 63;
  for (int r = blockIdx.x * 4 + wave; r < TG; r += gridDim.x * 4) {
    const float4* xr = (const float4*)(x + (size_t)r * 1024);
    float4 v[4];
    float ss = 0.f;
#pragma unroll
    for (int i = 0; i < 4; ++i) { v[i] = xr[lane + 64 * i]; ss += v[i].x * v[i].x + v[i].y * v[i].y + v[i].z * v[i].z + v[i].w * v[i].w; }
    ss = wave_sum(ss);
    const float rs = rsqrtf(ss * (1.f / 1024.f) + EPS);
#pragma unroll
    for (int i = 0; i < 4; ++i) {
      const float4 gg = ((const float4*)g)[lane + 64 * i];
      u32x2 o; o.x = pack2(v[i].x * rs * gg.x, v[i].y * rs * gg.y); o.y = pack2(v[i].z * rs * gg.z, v[i].w * rs * gg.w);
      ((u32x2*)(dst + (size_t)r * 1024))[lane + 64 * i] = o;
    }
    if (psrc) {
      const float4 pv = ((const float4*)(psrc + (size_t)r * 256))[lane];
      u32x2 o; o.x = pack2(pv.x, pv.y); o.y = pack2(pv.z, pv.w);
      ((u32x2*)(pdst + (size_t)r * 256))[lane] = o;
    }
  }
}

__device__ void phase_final_norm(float* __restrict__ x, const float* __restrict__ g) {
  const int tidq = threadIdx.x + opq(); const int wave = tidq >> 6, lane = tidq & 63;
  for (int r = blockIdx.x * 4 + wave; r < 2 * TG; r += gridDim.x * 4) {
    float4* xr = (float4*)(x + (size_t)r * 1024);
    float4 v[4];
    float ss = 0.f;
#pragma unroll
    for (int i = 0; i < 4; ++i) { v[i] = xr[lane + 64 * i]; ss += v[i].x * v[i].x + v[i].y * v[i].y + v[i].z * v[i].z + v[i].w * v[i].w; }
    ss = wave_sum(ss);
    const float rs = rsqrtf(ss * (1.f / 1024.f) + EPS);
#pragma unroll
    for (int i = 0; i < 4; ++i) {
      const float4 gg = ((const float4*)g)[lane + 64 * i];
      float4 o; o.x = v[i].x * rs * gg.x; o.y = v[i].y * rs * gg.y; o.z = v[i].z * rs * gg.z; o.w = v[i].w * rs * gg.w;
      xr[lane + 64 * i] = o;
    }
  }
}

template <int NI, int NB>
DI void gemm_main(f32x16 (&acc0)[2][NI], f32x16 (&acc1)[2][NI], const bf16_t* __restrict__ A, int lda,
                  const bf16_t* __restrict__ B0, const bf16_t* __restrict__ B1, int ldb, int K, char* lds) {
  const int tid = threadIdx.x + opq(), lane = tid & 63, w = tid >> 6, wm = w >> 1, wn = w & 1, l31 = lane & 31, h2 = lane >> 5;
  bf16_t* As = (bf16_t*)lds;
  bf16_t* B0s = As + 128 * 72;
  bf16_t* B1s = B0s + 64 * NI * 72;
  const int lr = tid >> 3, lc = (tid & 7) * 8;
  u32x4 ra[4], rb0[2 * NI], rb1[2 * NI];
  const bf16_t* ap = A + (size_t)lr * lda + lc;
  const bf16_t* bp0 = B0 + (size_t)lr * ldb + lc;
  const bf16_t* bp1 = (NB == 2) ? (B1 + (size_t)lr * ldb + lc) : B0;
#pragma unroll
  for (int i = 0; i < 4; ++i) ra[i] = *(const u32x4*)(ap + (size_t)(32 * i) * lda);
#pragma unroll
  for (int i = 0; i < 2 * NI; ++i) {
    rb0[i] = *(const u32x4*)(bp0 + (size_t)(32 * i) * ldb);
    if (NB == 2) rb1[i] = *(const u32x4*)(bp1 + (size_t)(32 * i) * ldb);
  }
  for (int k0 = 0; k0 < K; k0 += 64) {
    __syncthreads();
#pragma unroll
    for (int i = 0; i < 4; ++i) *(u32x4*)(As + (lr + 32 * i) * 72 + lc) = ra[i];
#pragma unroll
    for (int i = 0; i < 2 * NI; ++i) {
      *(u32x4*)(B0s + (lr + 32 * i) * 72 + lc) = rb0[i];
      if (NB == 2) *(u32x4*)(B1s + (lr + 32 * i) * 72 + lc) = rb1[i];
    }
    __syncthreads();
    if (k0 + 64 < K) {
      const int kn = k0 + 64;
#pragma unroll
      for (int i = 0; i < 4; ++i) ra[i] = *(const u32x4*)(ap + (size_t)(32 * i) * lda + kn);
#pragma unroll
      for (int i = 0; i < 2 * NI; ++i) {
        rb0[i] = *(const u32x4*)(bp0 + (size_t)(32 * i) * ldb + kn);
        if (NB == 2) rb1[i] = *(const u32x4*)(bp1 + (size_t)(32 * i) * ldb + kn);
      }
    }
#pragma unroll
    for (int ks = 0; ks < 4; ++ks) {
      bf16x8 af[2], bf0[NI], bf1[NI];
#pragma unroll
      for (int mi = 0; mi < 2; ++mi) af[mi] = *(const bf16x8*)(As + (64 * wm + 32 * mi + l31) * 72 + 16 * ks + 8 * h2);
#pragma unroll
      for (int ni = 0; ni < NI; ++ni) {
        bf0[ni] = *(const bf16x8*)(B0s + (32 * NI * wn + 32 * ni + l31) * 72 + 16 * ks + 8 * h2);
        if (NB == 2) bf1[ni] = *(const bf16x8*)(B1s + (32 * NI * wn + 32 * ni + l31) * 72 + 16 * ks + 8 * h2);
      }
#pragma unroll
      for (int mi = 0; mi < 2; ++mi)
#pragma unroll
        for (int ni = 0; ni < NI; ++ni) {
          acc0[mi][ni] = MFMA32(af[mi], bf0[ni], acc0[mi][ni]);
          if (NB == 2) acc1[mi][ni] = MFMA32(af[mi], bf1[ni], acc1[mi][ni]);
        }
    }
  }
}

template <int NI>
DI void zero_acc(f32x16 (&a)[2][NI]) {
#pragma unroll
  for (int mi = 0; mi < 2; ++mi)
#pragma unroll
    for (int ni = 0; ni < NI; ++ni)
#pragma unroll
      for (int r = 0; r < 16; ++r) a[mi][ni][r] = 0.f;
}

#define EPI_VARS const int tid = threadIdx.x + opq(), lane = tid & 63, w = tid >> 6, wm = w >> 1, wn = w & 1, l31 = lane & 31, h2 = lane >> 5; (void)tid; (void)lane; (void)w
#define EPI_BEGIN(NI_) _Pragma("unroll") for (int mi = 0; mi < 2; ++mi) _Pragma("unroll") for (int ni = 0; ni < NI_; ++ni) _Pragma("unroll") for (int r = 0; r < 16; ++r) { \
    const int row = 64 * wm + 32 * mi + crow(r, h2); const int col = 32 * NI_ * wn + 32 * ni + l31;
#define EPI_END }

DI bool xcd_tile(int iter, int MT, int NT, int& mt, int& nt) {
  const int x = blockIdx.x & 7, lb = blockIdx.x >> 3, nb = gridDim.x >> 3;
  const int full = NT >> 3, rem = NT & 7;
  const int per_full = full * MT, rem_tot = rem * MT;
  const int r0 = (rem_tot * x) >> 3, r1 = (rem_tot * (x + 1)) >> 3;
  const int j = lb + iter * nb;
  if (lb >= nb || j >= per_full + (r1 - r0)) return false;
  if (j < per_full) { mt = j / full; nt = x * full + j % full; }
  else { const int u = r0 + (j - per_full); nt = 8 * full + u / MT; mt = u % MT; }
  return true;
}

__device__ void phase_ffn_a(const bf16_t* __restrict__ Nb, const bf16_t* __restrict__ W1, const bf16_t* __restrict__ W3,
                            bf16_t* __restrict__ H, char* lds) {
  EPI_VARS;
  for (int iter = 0;; ++iter) {
    int mt, nt;
    if (!xcd_tile(iter, 256, 22, mt, nt)) break;
    f32x16 a0[2][2], a1[2][2];
    zero_acc<2>(a0); zero_acc<2>(a1);
    gemm_main<2, 2>(a0, a1, Nb + (size_t)mt * 128 * 1024, 1024, W1 + (size_t)nt * 128 * 1024, W3 + (size_t)nt * 128 * 1024, 1024, 1024, lds);
    EPI_BEGIN(2)
      H[(size_t)(mt * 128 + row) * 2816 + nt * 128 + col] = f2bf(siluf_(a0[mi][ni][r]) * a1[mi][ni][r]);
    EPI_END
  }
}

__device__ void phase_gemm_resid(const bf16_t* __restrict__ A, int K, const bf16_t* __restrict__ Bt, float* __restrict__ x,
                                 float scale, char* lds) {
  EPI_VARS;
  for (int iter = 0;; ++iter) {
    int mt, nt;
    if (!xcd_tile(iter, 256, 4, mt, nt)) break;
    f32x16 a0[2][4];
    zero_acc<4>(a0);
    gemm_main<4, 1>(a0, a0, A + (size_t)mt * 128 * K, K, Bt + (size_t)nt * 256 * K, nullptr, K, K, lds);
    EPI_BEGIN(4)
      float* xp = x + (size_t)(mt * 128 + row) * 1024 + nt * 256 + col;
      *xp = *xp + scale * a0[mi][ni][r];
    EPI_END
  }
}

__device__ void phase_ple(const bf16_t* __restrict__ Nb, const bf16_t* __restrict__ PB, const bf16_t* __restrict__ PG,
                          const bf16_t* __restrict__ PP, float* __restrict__ x, char* lds) {
  EPI_VARS;
  for (int iter = 0;; ++iter) {
    int mt, nt;
    if (!xcd_tile(iter, 256, 8, mt, nt)) break;
    f32x16 a0[2][2], a1[2][2];
    zero_acc<2>(a0); zero_acc<2>(a1);
    gemm_main<2, 1>(a0, a0, Nb + (size_t)mt * 128 * 1024, 1024, PG + (size_t)nt * 128 * 1024, nullptr, 1024, 1024, lds);
    gemm_main<2, 1>(a1, a1, PB + (size_t)mt * 128 * 256, 256, PP + (size_t)nt * 128 * 256, nullptr, 256, 256, lds);
    EPI_BEGIN(2)
      float* xp = x + (size_t)(mt * 128 + row) * 1024 + nt * 128 + col;
      *xp = *xp + sigmoidf_(a0[mi][ni][r]) * a1[mi][ni][r];
    EPI_END
  }
}

__device__ void phase_merge(const bf16_t* __restrict__ Np, const bf16_t* __restrict__ Y, const bf16_t* __restrict__ WG,
                            const bf16_t* __restrict__ WB, bf16_t* __restrict__ M, char* lds) {
  EPI_VARS;
  for (int iter = 0;; ++iter) {
    int mt, nt;
    if (!xcd_tile(iter, 256, 8, mt, nt)) break;
    f32x16 am[2][2];
    zero_acc<2>(am);
#pragma unroll 1
    for (int n = 0; n < 4; ++n) {
      unsigned sg[2][2][8];
      {
        f32x16 ag[2][2];
        zero_acc<2>(ag);
        gemm_main<2, 1>(ag, ag, Np + (size_t)mt * 128 * 1024, 1024, WG + (size_t)n * 1048576 + (size_t)nt * 128 * 1024, nullptr, 1024, 1024, lds);
#pragma unroll
        for (int mi = 0; mi < 2; ++mi)
#pragma unroll
          for (int ni = 0; ni < 2; ++ni)
#pragma unroll
            for (int r = 0; r < 8; ++r) sg[mi][ni][r] = pack2(sigmoidf_(ag[mi][ni][2 * r]), sigmoidf_(ag[mi][ni][2 * r + 1]));
      }
      f32x16 ab[2][2];
      zero_acc<2>(ab);
      gemm_main<2, 1>(ab, ab, Y + (size_t)mt * 128 * 1024 + n * 256, 1024, WB + (size_t)n * 262144 + (size_t)nt * 128 * 256, nullptr, 256, 256, lds);
#pragma unroll
      for (int mi = 0; mi < 2; ++mi)
#pragma unroll
        for (int ni = 0; ni < 2; ++ni)
#pragma unroll
          for (int r = 0; r < 8; ++r) {
            am[mi][ni][2 * r] += __uint_as_float(sg[mi][ni][r] << 16) * ab[mi][ni][2 * r];
            am[mi][ni][2 * r + 1] += __uint_as_float(sg[mi][ni][r] & 0xffff0000u) * ab[mi][ni][2 * r + 1];
          }
    }
    EPI_BEGIN(2)
      M[(size_t)(mt * 128 + row) * 1024 + nt * 128 + col] = f2bf(am[mi][ni][r]);
    EPI_END
  }
}

DI void rope32_out(const float* c, const float2* tab, float sc, float* o) {
#pragma unroll
  for (int i = 0; i < 16; ++i) {
    const float2 cs = tab[i];
    const float a = c[i], b = c[16 + i];
    o[i] = (a * cs.x - b * cs.y) * sc;
    o[16 + i] = (b * cs.x + a * cs.y) * sc;
  }
}

__device__ void phase_proj(CParams& p, const bf16_t* __restrict__ Nb, const bf16_t* __restrict__ WIN, int S, char* lds) {
  EPI_VARS;
  bf16_t* PR = (bf16_t*)(p.ws + OFF_PR);
  float* AB = (float*)(p.ws + OFF_AB);
  const float2* t32 = (const float2*)(p.ws + OFF_TAB);
  const float2* t64 = (const float2*)(p.ws + OFF_TAB + 2 * MiB);
  float* Ct = (float*)lds;
  for (int iter = 0;; ++iter) {
    int mt, nt2;
    if (!xcd_tile(iter, 256, 18, mt, nt2)) break;
    f32x16 a0[2][4];
    zero_acc<4>(a0);
    gemm_main<4, 1>(a0, a0, Nb + (size_t)mt * 128 * 1024, 1024, WIN + (size_t)nt2 * 256 * 1024, nullptr, 1024, 1024, lds);
   for (int hv = 0; hv < 2; ++hv) {
    const int nt = 2 * nt2 + hv;
    __syncthreads();
    if (wn == hv) {
#pragma unroll
      for (int mi = 0; mi < 2; ++mi)
#pragma unroll
        for (int ni = 0; ni < 4; ++ni)
#pragma unroll
          for (int r = 0; r < 16; ++r) Ct[(64 * wm + 32 * mi + crow(r, h2)) * 132 + 32 * ni + l31] = a0[mi][ni][r];
    }
    __syncthreads();
    const int erow = tid >> 1, half = tid & 1;
    const int tok = mt * 128 + erow, pos = tok & (S - 1);
    const float* cr = Ct + erow * 132 + 64 * half;
    bf16_t* dst = PR + (size_t)tok * NPR + nt * 128 + 64 * half;
    int type = 0; float sc = 1.f;
    if (nt == 3 || nt == 4) { type = 1; sc = 0.17677669529663687f * LOG2E; }
    else if (nt == 5 || nt == 6) { type = 1; }
    else if (nt >= 17 && nt <= 22) { type = 2; sc = 0.125f * LOG2E; }
    else if (nt >= 23 && nt <= 28) { type = 2; }
    else if (nt == 35) type = 3;
    if (type == 0) {
#pragma unroll
      for (int j = 0; j < 8; ++j) store8bf(dst + 8 * j, cr + 8 * j);
    } else if (type == 1) {
#pragma unroll
      for (int hh = 0; hh < 2; ++hh) {
        float o[32];
        rope32_out(cr + 32 * hh, t32 + (size_t)pos * 16, sc, o);
#pragma unroll
        for (int j = 0; j < 4; ++j) store8bf(dst + 32 * hh + 8 * j, o + 8 * j);
      }
    } else if (type == 2) {
      const float2* tab = t64 + (size_t)pos * 32;
#pragma unroll
      for (int j = 0; j < 4; ++j) {
        float lo[8], hi[8];
#pragma unroll
        for (int e = 0; e < 8; ++e) {
          const float2 cs = tab[8 * j + e];
          const float a = cr[8 * j + e], b = cr[32 + 8 * j + e];
          lo[e] = (a * cs.x - b * cs.y) * sc;
          hi[e] = (b * cs.x + a * cs.y) * sc;
        }
        store8bf(dst + 8 * j, lo);
        store8bf(dst + 32 + 8 * j, hi);
      }
    } else {
      if (half == 0) {
        float o[32];
        rope32_out(cr, t32 + (size_t)pos * 16, 1.f, o);
#pragma unroll
        for (int j = 0; j < 4; ++j) store8bf(dst + 8 * j, o + 8 * j);
      } else {
        const float* c2 = Ct + erow * 132 + 32;
#pragma unroll
        for (int j = 0; j < 4; ++j) {
          float4 v; v.x = c2[4 * j]; v.y = c2[4 * j + 1]; v.z = c2[4 * j + 2]; v.w = c2[4 * j + 3];
          ((float4*)(AB + (size_t)tok * 16))[j] = v;
        }
      }
    }
   }
  }
}

__device__ void mla_up_tile(CParams& p, int mt, int j, int S, char* lds) {
  EPI_VARS;
  const bf16_t* PR = (const bf16_t*)(p.ws + OFF_PR);
  const bf16_t* wb = (const bf16_t*)(p.ws + OFF_WB);
  bf16_t* Qb = (bf16_t*)(p.ws + OFF_Q);
  bf16_t* Kb = (bf16_t*)(p.ws + OFF_K);
  bf16_t* Vb = (bf16_t*)(p.ws + OFF_V);
  const float2* t32 = (const float2*)(p.ws + OFF_TAB);
  float* Ct = (float*)lds;
  float* rst = (float*)(lds + 67584);
  const bool isq = j < 3;
  const int K = isq ? 256 : 128;
  const int nt = isq ? j : j - 3;
  const bf16_t* A = PR + (size_t)mt * 128 * NPR + (isq ? C_CQ : C_CKV);
  const bf16_t* B = wb + (isq ? W_UQ : W_UKV) + (size_t)nt * 128 * K;
  const int erow = tid >> 1, half = tid & 1;
  {
    const bf16_t* ar = A + (size_t)erow * NPR + half * (K / 2);
    float ss = 0.f;
    for (int c = 0; c < K / 16; ++c) {
      const u32x4 u = *(const u32x4*)(ar + 8 * c);
      const unsigned uu[4] = {u.x, u.y, u.z, u.w};
#pragma unroll
      for (int e = 0; e < 4; ++e) {
        const float lo = __uint_as_float(uu[e] << 16), hi = __uint_as_float(uu[e] & 0xffff0000u);
        ss += lo * lo + hi * hi;
      }
    }
    ss += __shfl_xor(ss, 1);
    if (half == 0) rst[erow] = rsqrtf(ss / (float)K + EPS);
  }
  f32x16 a0[2][2];
  zero_acc<2>(a0);
  gemm_main<2, 1>(a0, a0, A, NPR, B, nullptr, K, K, lds);
  __syncthreads();
  EPI_BEGIN(2)
    Ct[row * 132 + col] = a0[mi][ni][r];
  EPI_END
  __syncthreads();
  const int tok = mt * 128 + erow, pos = tok & (S - 1);
  const float rs = rst[erow];
  const float* cr = Ct + erow * 132 + 64 * half;
  if (isq) {
    const float sc = rs * 0.10206207261596577f * LOG2E;
    if (nt < 2) {
      bf16_t* dst = Qb + ((size_t)tok * 4 + 2 * nt + half) * 96;
#pragma unroll
      for (int jj = 0; jj < 8; ++jj) {
        float o[8];
#pragma unroll
        for (int e = 0; e < 8; ++e) o[e] = cr[8 * jj + e] * sc;
        store8bf(dst + 8 * jj, o);
      }
    } else {
#pragma unroll
      for (int hh = 0; hh < 2; ++hh) {
        float o[32];
        rope32_out(cr + 32 * hh, t32 + (size_t)pos * 16, sc, o);
        bf16_t* dst = Qb + ((size_t)tok * 4 + 2 * half + hh) * 96 + 64;
#pragma unroll
        for (int jj = 0; jj < 4; ++jj) store8bf(dst + 8 * jj, o + 8 * jj);
      }
    }
  } else {
    bf16_t* dst = half == 0 ? (Kb + ((size_t)tok * 4 + nt) * 96) : (Vb + ((size_t)tok * 4 + nt) * 64);
#pragma unroll
    for (int jj = 0; jj < 8; ++jj) {
      float o[8];
#pragma unroll
      for (int e = 0; e < 8; ++e) o[e] = cr[8 * jj + e] * rs;
      store8bf(dst + 8 * jj, o);
    }
    if (half == 0) {
      const u32x4* src = (const u32x4*)(PR + (size_t)tok * NPR + 4480);
#pragma unroll
      for (int jj = 0; jj < 4; ++jj) ((u32x4*)(dst + 64))[jj] = src[jj];
    }
  }
}

typedef short s16x4_t __attribute__((ext_vector_type(4)));
DI bf16x8 tr_pair(const bf16_t* p0, const bf16_t* p1) {
  const s16x4_t lo = __builtin_amdgcn_ds_read_tr16_b64_v4i16((__attribute__((address_space(3))) s16x4_t*)p0);
  const s16x4_t hi = __builtin_amdgcn_ds_read_tr16_b64_v4i16((__attribute__((address_space(3))) s16x4_t*)p1);
  return __builtin_shufflevector(lo, hi, 0, 1, 2, 3, 4, 5, 6, 7);
}

template <int DK, bool BAND>
DI void flash_loop(f32x16 (&O)[2], float& m, float& l, const bf16_t* __restrict__ qrow, const bf16_t* __restrict__ kbase,
                   size_t kstride, const bf16_t* __restrict__ vbase, size_t vstride, int ntiles, int tq, int u0, int L,
                   char* lds) {
  const int tid = threadIdx.x + opq(), lane = tid & 63, l31 = lane & 31, h2 = lane >> 5;
  constexpr int KR = DK + 8, KCH = DK / 8, KN = 64 * KCH / 256;
  constexpr int STAGE = 64 * KR * 2 + 64 * 72 * 2;
  bf16x8 qf[DK / 16];
#pragma unroll
  for (int ks = 0; ks < DK / 16; ++ks) qf[ks] = *(const bf16x8*)(qrow + 16 * ks + 8 * h2);
  u32x4 rk[KN], rv[2];
  auto gload = [&](int kt) {
#pragma unroll
    for (int i = 0; i < KN; ++i) {
      const int ci = tid + 256 * i, row = ci / KCH, c = ci % KCH;
      int rr = u0 + 64 * kt + row;
      if (BAND) rr = min(max(rr, 0), L - 1);
      rk[i] = *(const u32x4*)(kbase + (size_t)rr * kstride + c * 8);
    }
#pragma unroll
    for (int i = 0; i < 2; ++i) {
      const int ci = tid + 256 * i, row = ci >> 3, c = ci & 7;
      int rr = u0 + 64 * kt + row;
      if (BAND) rr = min(max(rr, 0), L - 1);
      rv[i] = *(const u32x4*)(vbase + (size_t)rr * vstride + c * 8);
    }
  };
  auto swrite = [&](int st) {
    bf16_t* Ks = (bf16_t*)(lds + st * STAGE);
    bf16_t* Vs = Ks + 64 * KR;
#pragma unroll
    for (int i = 0; i < KN; ++i) {
      const int ci = tid + 256 * i, row = ci / KCH, c = ci % KCH;
      *(u32x4*)(Ks + row * KR + c * 8) = rk[i];
    }
#pragma unroll
    for (int i = 0; i < 2; ++i) {
      const int ci = tid + 256 * i, row = ci >> 3, c = ci & 7;
      *(u32x4*)(Vs + row * 72 + c * 8) = rv[i];
    }
  };
  const int trq = (lane & 15) >> 2, trp = lane & 3, trblk = (lane >> 4) & 1;
  const int troff = (4 * h2 + trq) * 72 + 16 * trblk + 4 * trp;
  __syncthreads();
  gload(0);
  swrite(0);
  if (ntiles > 1) gload(1);
  for (int kt = 0; kt < ntiles; ++kt) {
    __syncthreads();
    if (kt + 1 < ntiles) swrite((kt + 1) & 1);
    if (kt + 2 < ntiles) gload(kt + 2);
    const bf16_t* Ks = (const bf16_t*)(lds + (kt & 1) * STAGE);
    const bf16_t* Vs = Ks + 64 * KR;
    f32x16 Sx[2];
#pragma unroll
    for (int j = 0; j < 2; ++j)
#pragma unroll
      for (int r = 0; r < 16; ++r) Sx[j][r] = 0.f;
#pragma unroll
    for (int ks = 0; ks < DK / 16; ++ks)
#pragma unroll
      for (int j = 0; j < 2; ++j) {
        const bf16x8 kf = *(const bf16x8*)(Ks + (32 * j + l31) * KR + 16 * ks + 8 * h2);
        Sx[j] = MFMA32(kf, qf[ks], Sx[j]);
      }
    if (BAND) {
#pragma unroll
      for (int j = 0; j < 2; ++j)
#pragma unroll
        for (int r = 0; r < 16; ++r) {
          const int u = u0 + 64 * kt + 32 * j + crow(r, h2);
          const int d = u - tq;
          const bool valid = (d <= 64) && (d >= -64) && (u >= 0) && (u < L);
          Sx[j][r] = valid ? Sx[j][r] : -1e30f;
        }
    }
    float mx = Sx[0][0];
#pragma unroll
    for (int j = 0; j < 2; ++j)
#pragma unroll
      for (int r = 0; r < 16; ++r) mx = fmaxf(mx, Sx[j][r]);
    mx = fmaxf(mx, __shfl_xor(mx, 32));
    const float mn = fmaxf(m, mx);
    const float alpha = exp2_(m - mn);
    const bool grew = mn > m;
    m = mn;
    float ls = 0.f;
#pragma unroll
    for (int j = 0; j < 2; ++j)
#pragma unroll
      for (int r = 0; r < 16; ++r) { const float pv = exp2_(Sx[j][r] - mn); Sx[j][r] = pv; ls += pv; }
    l = l * alpha + ls;
    if (__any(grew)) {
#pragma unroll
      for (int t = 0; t < 2; ++t)
#pragma unroll
        for (int r = 0; r < 16; ++r) O[t][r] *= alpha;
    }
#pragma unroll
    for (int j = 0; j < 2; ++j)
#pragma unroll
      for (int s = 0; s < 2; ++s) {
        const bf16x8 pf = pack8(Sx[j][8 * s], Sx[j][8 * s + 1], Sx[j][8 * s + 2], Sx[j][8 * s + 3], Sx[j][8 * s + 4],
                                Sx[j][8 * s + 5], Sx[j][8 * s + 6], Sx[j][8 * s + 7]);
#pragma unroll
        for (int t = 0; t < 2; ++t) {
          const bf16_t* vp = Vs + (32 * j + 16 * s) * 72 + 32 * t + troff;
          const bf16x8 vf = tr_pair(vp, vp + 8 * 72);
          O[t] = MFMA32(vf, pf, O[t]);
        }
      }
  }
}

DI void zeroO(f32x16 (&O)[2]) {
#pragma unroll
  for (int t = 0; t < 2; ++t)
#pragma unroll
    for (int r = 0; r < 16; ++r) O[t][r] = 0.f;
}

DI void store_o(bf16_t* dst, const f32x16 (&O)[2], int h2) {
#pragma unroll
  for (int t = 0; t < 2; ++t)
#pragma unroll
    for (int g = 0; g < 4; ++g) {
      u32x2 u; u.x = pack2(O[t][4 * g], O[t][4 * g + 1]); u.y = pack2(O[t][4 * g + 2], O[t][4 * g + 3]);
      *(u32x2*)(dst + 32 * t + 8 * g + 4 * h2) = u;
    }
}

__device__ void mla_item(CParams& p, int it, int S, char* lds) {
  const int tid = threadIdx.x + opq(), lane = tid & 63, w = tid >> 6, l31 = lane & 31, h2 = lane >> 5;
  const int lgq = (S == 2048) ? 4 : 7;
  const int qb = it & ((1 << lgq) - 1), bh = it >> lgq, h = bh & 3, b = bh >> 2;
  const int tokbase = b * S, gtok = tokbase + 128 * qb + 32 * w + l31;
  const bf16_t* Qb = (const bf16_t*)(p.ws + OFF_Q);
  const bf16_t* Kb = (const bf16_t*)(p.ws + OFF_K);
  const bf16_t* Vb = (const bf16_t*)(p.ws + OFF_V);
  bf16_t* Y = (bf16_t*)(p.ws + OFF_N);
  f32x16 O[2]; zeroO(O);
  float m = -1e30f, l = 0.f;
  flash_loop<96, false>(O, m, l, Qb + ((size_t)gtok * 4 + h) * 96, Kb + ((size_t)tokbase * 4 + h) * 96, 384,
                        Vb + ((size_t)tokbase * 4 + h) * 64, 256, S / 64, 0, 0, 0, lds);
  l += __shfl_xor(l, 32);
  const float il = 1.f / l;
#pragma unroll
  for (int t = 0; t < 2; ++t)
#pragma unroll
    for (int r = 0; r < 16; ++r) O[t][r] *= il;
  store_o(Y + (size_t)gtok * 1024 + h * 64, O, h2);
}

__device__ void diff_item(CParams& p, int layer, int it, int S, char* lds) {
  const int tid = threadIdx.x + opq(), lane = tid & 63, w = tid >> 6, l31 = lane & 31, h2 = lane >> 5;
  const int lgq = (S == 2048) ? 4 : 7;
  const int qb = it & ((1 << lgq) - 1), bh = it >> lgq, h = bh & 3, b = bh >> 2;
  const int tokbase = b * S, gtok = tokbase + 128 * qb + 32 * w + l31;
  const bf16_t* PR = (const bf16_t*)(p.ws + OFF_PR);
  bf16_t* Y = (bf16_t*)(p.ws + OFF_N);
  const float* lam = p.diff_lambda + layer * 128;
  float s1 = 0.f, s2 = 0.f;
  if (lane < 32) { s1 = lam[lane] * lam[32 + lane]; s2 = lam[64 + lane] * lam[96 + lane]; }
  s1 = wave_sum(s1); s2 = wave_sum(s2);
  const float lambda_init = layer ? 0.35550907f : 0.2f;
  const float lambda_full = expf(s1) - expf(s2) + lambda_init;
  f32x16 of[2]; zeroO(of);
  for (int mp = 0; mp < 2; ++mp) {
    f32x16 O[2]; zeroO(O);
    float m = -1e30f, l = 0.f;
    flash_loop<32, false>(O, m, l, PR + (size_t)gtok * NPR + C_BQ + (2 * h + mp) * 32,
                          PR + (size_t)tokbase * NPR + C_BK + (2 * h + mp) * 32, NPR,
                          PR + (size_t)tokbase * NPR + C_BV + h * 64, NPR, S / 64, 0, 0, 0, lds);
    l += __shfl_xor(l, 32);
    const float cf = (mp == 0 ? 1.f : -lambda_full) / l;
#pragma unroll
    for (int t = 0; t < 2; ++t)
#pragma unroll
      for (int r = 0; r < 16; ++r) of[t][r] += cf * O[t][r];
  }
  float ss = 0.f;
#pragma unroll
  for (int t = 0; t < 2; ++t)
#pragma unroll
    for (int r = 0; r < 16; ++r) ss += of[t][r] * of[t][r];
  ss += __shfl_xor(ss, 32);
  const float rs = rsqrtf(ss * (1.f / 64.f) + EPS) * (1.f - lambda_init);
  const float* sg = p.diff_subln + layer * 64;
#pragma unroll
  for (int t = 0; t < 2; ++t)
#pragma unroll
    for (int r = 0; r < 16; ++r) of[t][r] *= rs * sg[32 * t + crow(r, h2)];
  store_o(Y + (size_t)gtok * 1024 + 256 + h * 64, of, h2);
}

__device__ void dil_item(CParams& p, int it, int S, int B, char* lds) {
  const int tid = threadIdx.x + opq(), lane = tid & 63, w = tid >> 6, l31 = lane & 31, h2 = lane >> 5;
  const int lgS = (S == 2048) ? 11 : 14, lgB = (B == 16) ? 4 : 1;
  const int rq = it & ((1 << (lgS - 7)) - 1);
  int rest = it >> (lgS - 7);
  const int head = rest & 3; rest >>= 2;
  const int b = rest & (B - 1), g = rest >> lgB;
  const int lgd = 2 * g, dil = 1 << lgd;
  const int L = S >> lgd, lgnqb = lgS - lgd - 7;
  const int res = rq >> lgnqb, qb = rq & ((1 << lgnqb) - 1);
  const int tokbase = b * S;
  const int tq = 128 * qb + 32 * w + l31;
  const int gtok = tokbase + tq * dil + res;
  const bf16_t* PR = (const bf16_t*)(p.ws + OFF_PR);
  bf16_t* OD = (bf16_t*)(p.ws + OFF_OD);
  float* LSE = (float*)(p.ws + OFF_LSE);
  f32x16 O[2]; zeroO(O);
  float m = -1e30f, l = 0.f;
  const int hc = (g * 4 + head) * 64;
  flash_loop<64, true>(O, m, l, PR + (size_t)gtok * NPR + C_DQ + hc, PR + (size_t)(tokbase + res) * NPR + C_DK + hc,
                       (size_t)dil * NPR, PR + (size_t)(tokbase + res) * NPR + C_DV + hc, (size_t)dil * NPR, 4, tq,
                       128 * qb - 64, L, lds);
  l += __shfl_xor(l, 32);
  const float il = 1.f / l;
#pragma unroll
  for (int t = 0; t < 2; ++t)
#pragma unroll
    for (int r = 0; r < 16; ++r) O[t][r] *= il;
  store_o(OD + ((size_t)g * TG + gtok) * 256 + head * 64, O, h2);
  if (h2 == 0) LSE[((size_t)g * TG + gtok) * 4 + head] = m + __log2f(l);
}

constexpr size_t DN_QK_OFF = OFF_OD;
constexpr size_t DN_GC_OFF = OFF_OD + 32 * MiB;
constexpr size_t DN_UW_OFF = OFF_Q;

__device__ void dn_prep_item(CParams& p, int layer, int it, int S, char* lds) {
  const int tid = threadIdx.x + opq(), lane = tid & 63, w = tid >> 6, l15 = lane & 15, g4 = lane >> 4;
  const int NC = S / 64;
  const int ch = it % NC, bh = it / NC, h = bh & 3, b = bh >> 2;
  const int tokbase = b * S, s0 = ch * 64;
  const bf16_t* PR = (const bf16_t*)(p.ws + OFF_PR);
  const float* AB = (const float*)(p.ws + OFF_AB);
  bf16_t* QKg = (bf16_t*)(p.ws + DN_QK_OFF) + ((size_t)bh * NC + ch) * 8192;
  bf16_t* raw = (bf16_t*)lds;
  float* convw = (float*)(lds + 27200);
  float* RU = (float*)lds;
  float* RW = (float*)(lds + 16384);
  float* Am = (float*)(lds + 32768);
  bf16_t* Kimg = (bf16_t*)(lds + 50176);
  bf16_t* Qimg = (bf16_t*)(lds + 59392);
  float* gcs = (float*)(lds + 68608);
  float* betas = gcs + 128;
  const float* cw = p.dn_conv + (size_t)layer * 5 * 768;
  for (int ci = tid; ci < 68 * 24; ci += 256) {
    const int rr = ci / 24, c = ci % 24, seg = c >> 3, c8 = c & 7;
    const int s = s0 + rr - 2;
    u32x4 v = u32x4{0u, 0u, 0u, 0u};
    if (s >= 0 && s < S) v = *(const u32x4*)(PR + (size_t)(tokbase + s) * NPR + C_DNQKV + seg * 256 + h * 64 + c8 * 8);
    *(u32x4*)(raw + rr * 200 + seg * 64 + c8 * 8) = v;
  }
  for (int i = tid; i < 960; i += 256) {
    const int j = i / 192, c = i % 192;
    convw[i] = cw[j * 768 + (c >> 6) * 256 + h * 64 + (c & 63)];
  }
  if (tid < 128) {
    const int d = tid >> 6, pl = tid & 63;
    const int i = d ? 63 - pl : pl;
    const size_t tok = (size_t)tokbase + s0 + i;
    const float Aexp = expf(p.dn_a_log[layer * 8 + d * 4 + h]);
    const float a = AB[tok * 16 + d * 8 + h] + p.dn_dt_bias[layer * 8 + d * 4 + h];
    const float bb = AB[tok * 16 + d * 8 + 4 + h];
    const float sp = fmaxf(a, 0.f) + __logf(1.f + __expf(-fabsf(a)));
    float g = -Aexp * sp;
#pragma unroll
    for (int o = 1; o < 64; o <<= 1) { const float tv = __shfl_up(g, o); if (lane >= o) g += tv; }
    gcs[tid] = g;
    betas[tid] = sigmoidf_(bb);
    float* GC = (float*)(p.ws + DN_GC_OFF) + (((size_t)bh * 2 + d) * NC + ch) * 64;
    GC[pl] = g;
  }
  __syncthreads();
  const int pp = tid >> 2, cgp = tid & 3;
  float kv[16], vv[16];
  {
    float qv[16];
#pragma unroll
    for (int seg = 0; seg < 3; ++seg) {
      float acc[16];
#pragma unroll
      for (int c = 0; c < 16; ++c) acc[c] = 0.f;
#pragma unroll
      for (int j = 0; j < 5; ++j) {
        const bf16_t* rp = raw + (pp + j) * 200 + seg * 64 + 16 * cgp;
        const float* wp = convw + j * 192 + seg * 64 + 16 * cgp;
        const u32x4 u0 = *(const u32x4*)rp, u1 = *(const u32x4*)(rp + 8);
        const unsigned uu[8] = {u0.x, u0.y, u0.z, u0.w, u1.x, u1.y, u1.z, u1.w};
#pragma unroll
        for (int e = 0; e < 8; ++e) {
          acc[2 * e] += wp[2 * e] * __uint_as_float(uu[e] << 16);
          acc[2 * e + 1] += wp[2 * e + 1] * __uint_as_float(uu[e] & 0xffff0000u);
        }
      }
#pragma unroll
      for (int c = 0; c < 16; ++c) {
        const float sv = acc[c] * __builtin_amdgcn_rcpf(1.f + __expf(-acc[c]));
        if (seg == 0) qv[c] = sv; else if (seg == 1) kv[c] = sv; else vv[c] = sv;
      }
    }
    float sq = 0.f, sk = 0.f;
#pragma unroll
    for (int c = 0; c < 16; ++c) { sq += qv[c] * qv[c]; sk += kv[c] * kv[c]; }
    sq += __shfl_xor(sq, 1); sq += __shfl_xor(sq, 2);
    sk += __shfl_xor(sk, 1); sk += __shfl_xor(sk, 2);
    const float rq = rsqrtf(sq + EPS) * 0.125f, rk = rsqrtf(sk + EPS);
#pragma unroll
    for (int c = 0; c < 16; ++c) { qv[c] *= rq; kv[c] *= rk; }
    store8bf(Kimg + pp * 72 + 16 * cgp, kv); store8bf(Kimg + pp * 72 + 16 * cgp + 8, kv + 8);
    store8bf(Qimg + pp * 72 + 16 * cgp, qv); store8bf(Qimg + pp * 72 + 16 * cgp + 8, qv + 8);
    store8bf(QKg + pp * 64 + 16 * cgp, qv); store8bf(QKg + pp * 64 + 16 * cgp + 8, qv + 8);
    store8bf(QKg + 4096 + pp * 64 + 16 * cgp, kv); store8bf(QKg + 4096 + pp * 64 + 16 * cgp + 8, kv + 8);
  }
  for (int d = 0; d < 2; ++d) {
    __syncthreads();
    {
      const int pl = d ? 63 - pp : pp;
      const float bet = betas[d * 64 + pl], egc = __expf(gcs[d * 64 + pl]);
#pragma unroll
      for (int c = 0; c < 16; ++c) {
        RU[pl * 64 + 16 * cgp + c] = vv[c] * bet;
        RW[pl * 64 + 16 * cgp + c] = kv[c] * bet * egc;
      }
    }
    {
      f32x4 KK[4];
#pragma unroll
      for (int t = 0; t < 4; ++t) KK[t] = f32x4{0.f, 0.f, 0.f, 0.f};
      const int jl = 16 * w + l15;
      const int jrow = d ? 63 - jl : jl;
#pragma unroll
      for (int ks = 0; ks < 2; ++ks) {
        const bf16x8 bfk = *(const bf16x8*)(Kimg + jrow * 72 + 32 * ks + 8 * g4);
#pragma unroll
        for (int rt = 0; rt < 4; ++rt) {
          const int il = 16 * rt + l15;
          const int irow = d ? 63 - il : il;
          const bf16x8 afk = *(const bf16x8*)(Kimg + irow * 72 + 32 * ks + 8 * g4);
          KK[rt] = MFMA16(afk, bfk, KK[rt]);
        }
      }
      const float gcj = gcs[d * 64 + jl];
#pragma unroll
      for (int rt = 0; rt < 4; ++rt)
#pragma unroll
        for (int r = 0; r < 4; ++r) {
          const int i = 16 * rt + 4 * g4 + r;
          const float ee = __expf(fminf(gcs[d * 64 + i] - gcj, 0.f));
          Am[i * 68 + jl] = (i > jl) ? betas[d * 64 + i] * KK[rt][r] * ee : 0.f;
        }
    }
    __syncthreads();
    float xs[32];
#pragma unroll
    for (int q = 0; q < 32; ++q) xs[q] = 0.f;
    const int c = tid >> 1, half = tid & 1;
    {
      const float* Rc = (c < 64) ? (RU + c) : (RW + (c - 64));
      const float* Ah = Am + 4 * half;
#pragma unroll
      for (int i = 0; i < 64; ++i) {
        float part = 0.f;
#pragma unroll
        for (int q = 0; q < (i + 7) / 8; ++q) {
          const f32x4 a = *(const f32x4*)(Ah + i * 68 + 8 * q);
          part += a[0] * xs[4 * q] + a[1] * xs[4 * q + 1] + a[2] * xs[4 * q + 2] + a[3] * xs[4 * q + 3];
        }
        const float other = __int_as_float(__builtin_amdgcn_update_dpp(0, __float_as_int(part), 0xB1, 0xf, 0xf, true));
        const float xi = Rc[i * 64] - (part + other);
        const int loc = ((i >> 3) << 2) + (i & 3);
        if (((i >> 2) & 1) == 0) xs[loc] = (half == 0) ? xi : xs[loc];
        else xs[loc] = (half == 1) ? xi : xs[loc];
        if (i < 16 ? ((i & 7) == 7) : (i < 32 ? ((i & 3) == 3) : ((i & 1) == 1))) asm volatile("" ::: "memory");
      }
    }
    {
      bf16_t* UWg = (bf16_t*)(p.ws + DN_UW_OFF) + ((((size_t)bh * 2 + d) * NC + ch) * 8192);
      const float sgn = (c < 64) ? 1.f : -1.f;
      bf16_t* dst = UWg + ((c < 64) ? c : (4096 + c - 64));
#pragma unroll
      for (int loc = 0; loc < 32; ++loc) {
        const int i = (((loc >> 2) * 2 + half) << 2) + (loc & 3);
        dst[i * 64] = f2bf(sgn * xs[loc]);
      }
    }
  }
}

__device__ void dn_scan_chain(CParams& p, int it, int S, char* lds) {
  const int tid0 = threadIdx.x + opq();
  const int dir = it & 1, bh = it >> 1, h = bh & 3, b = bh >> 2;
  const int tokbase = b * S, NC = S / 64;
  bf16_t* OUT = (bf16_t*)(p.ws + (dir ? OFF_OB : OFF_OF));
  const bf16_t* QKg = (const bf16_t*)(p.ws + DN_QK_OFF) + (size_t)bh * NC * 8192;
  const bf16_t* UWg = (const bf16_t*)(p.ws + DN_UW_OFF) + (size_t)it * NC * 8192;
  const float* GCg = (const float*)(p.ws + DN_GC_OFF) + (size_t)it * NC * 64;
  bf16_t* Uimg = (bf16_t*)lds;
  bf16_t* Wn = Uimg + 4608;
  bf16_t* Qimg = Wn + 4608;
  bf16_t* Kimg = Qimg + 4608;
  bf16_t* Kt = Kimg + 4608;
  bf16_t* Iimg = Kt + 4608;
  float* gcs = (float*)(lds + 6 * 9216);
  f32x4 Sd[4];
#pragma unroll
  for (int t = 0; t < 4; ++t) Sd[t] = f32x4{0.f, 0.f, 0.f, 0.f};
  u32x4 ru[2], rw[2], rq[2], rk[2];
  float rg = 0.f;
  auto prefetch = [&](int cc_) {
    const int ch_ = dir ? (NC - 1 - cc_) : cc_;
    const int tp = tid0 + opq();
    const bf16_t* uw = UWg + (size_t)ch_ * 8192;
    const bf16_t* qk = QKg + (size_t)ch_ * 8192;
#pragma unroll
    for (int k = 0; k < 2; ++k) {
      const int ci = tp + 256 * k, row = ci >> 3, c8 = ci & 7;
      const int srow = dir ? 63 - row : row;
      ru[k] = *(const u32x4*)(uw + row * 64 + c8 * 8);
      rw[k] = *(const u32x4*)(uw + 4096 + row * 64 + c8 * 8);
      rq[k] = *(const u32x4*)(qk + srow * 64 + c8 * 8);
      rk[k] = *(const u32x4*)(qk + 4096 + srow * 64 + c8 * 8);
    }
    if (tp < 64) rg = GCg[(size_t)ch_ * 64 + tp];
  };
  prefetch(0);
  for (int cc = 0; cc < NC; ++cc) {
    const int tid = tid0 + opq(), lane = tid & 63, w = tid >> 6, l15 = lane & 15, g4 = lane >> 4;
    const int e_col = 16 * w + l15;
    const int ch = dir ? (NC - 1 - cc) : cc;
    const int s0 = ch * 64;
    __syncthreads();
#pragma unroll
    for (int k = 0; k < 2; ++k) {
      const int ci = tid + 256 * k, row = ci >> 3, c8 = ci & 7;
      *(u32x4*)(Uimg + row * 72 + c8 * 8) = ru[k];
      *(u32x4*)(Wn + row * 72 + c8 * 8) = rw[k];
      *(u32x4*)(Qimg + row * 72 + c8 * 8) = rq[k];
      *(u32x4*)(Kimg + row * 72 + c8 * 8) = rk[k];
      const unsigned uu[4] = {rk[k].x, rk[k].y, rk[k].z, rk[k].w};
#pragma unroll
      for (int e = 0; e < 4; ++e) {
        Kt[(8 * c8 + 2 * e) * 72 + row] = (bf16_t)(uu[e] & 0xffffu);
        Kt[(8 * c8 + 2 * e + 1) * 72 + row] = (bf16_t)(uu[e] >> 16);
      }
    }
    if (tid < 64) gcs[tid] = rg;
    if (cc + 1 < NC) prefetch(cc + 1);
    __syncthreads();
    {
      f32x4 QK[4];
#pragma unroll
      for (int t = 0; t < 4; ++t) QK[t] = f32x4{0.f, 0.f, 0.f, 0.f};
#pragma unroll
      for (int ks = 0; ks < 2; ++ks) {
        const bf16x8 bfk = *(const bf16x8*)(Kimg + (16 * w + l15) * 72 + 32 * ks + 8 * g4);
#pragma unroll
        for (int rt = 0; rt < 4; ++rt) {
          const bf16x8 afq = *(const bf16x8*)(Qimg + (16 * rt + l15) * 72 + 32 * ks + 8 * g4);
          QK[rt] = MFMA16(afq, bfk, QK[rt]);
        }
      }
      const float gcj = gcs[e_col];
#pragma unroll
      for (int rt = 0; rt < 4; ++rt)
#pragma unroll
        for (int r = 0; r < 4; ++r) {
          const int i = 16 * rt + 4 * g4 + r;
          const float ee = __expf(fminf(gcs[i] - gcj, 0.f));
          Iimg[i * 72 + e_col] = f2bf((i >= e_col) ? QK[rt][r] * ee : 0.f);
        }
    }
    __syncthreads();
    {
      bf16x8 Bs[2];
#pragma unroll
      for (int ks = 0; ks < 2; ++ks)
        Bs[ks] = pack8(Sd[2 * ks][0], Sd[2 * ks][1], Sd[2 * ks][2], Sd[2 * ks][3], Sd[2 * ks + 1][0], Sd[2 * ks + 1][1],
                       Sd[2 * ks + 1][2], Sd[2 * ks + 1][3]);
      f32x4 vn[4], qs[4], iv[4];
#pragma unroll
      for (int rt = 0; rt < 4; ++rt) {
#pragma unroll
        for (int r = 0; r < 4; ++r) vn[rt][r] = bf2f(Uimg[(16 * rt + 4 * g4 + r) * 72 + e_col]);
        qs[rt] = f32x4{0.f, 0.f, 0.f, 0.f};
        iv[rt] = f32x4{0.f, 0.f, 0.f, 0.f};
#pragma unroll
        for (int ks = 0; ks < 2; ++ks) {
          const bf16_t* wp = Wn + (16 * rt + l15) * 72 + 32 * ks + 4 * g4;
          const bf16_t* qp = Qimg + (16 * rt + l15) * 72 + 32 * ks + 4 * g4;
          vn[rt] = MFMA16(ld2x4(wp, wp + 16), Bs[ks], vn[rt]);
          qs[rt] = MFMA16(ld2x4(qp, qp + 16), Bs[ks], qs[rt]);
        }
      }
      bf16x8 Bv[2];
#pragma unroll
      for (int ks = 0; ks < 2; ++ks)
        Bv[ks] = pack8(vn[2 * ks][0], vn[2 * ks][1], vn[2 * ks][2], vn[2 * ks][3], vn[2 * ks + 1][0], vn[2 * ks + 1][1],
                       vn[2 * ks + 1][2], vn[2 * ks + 1][3]);
#pragma unroll
      for (int rt = 0; rt < 4; ++rt)
#pragma unroll
        for (int ks = 0; ks < 2; ++ks) {
          const bf16_t* ip = Iimg + (16 * rt + l15) * 72 + 32 * ks + 4 * g4;
          iv[rt] = MFMA16(ld2x4(ip, ip + 16), Bv[ks], iv[rt]);
        }
      const float gc63 = gcs[63];
#pragma unroll
      for (int rt = 0; rt < 4; ++rt)
#pragma unroll
        for (int r = 0; r < 4; ++r) {
          const int pos = 16 * rt + 4 * g4 + r;
          const float o = qs[rt][r] * __expf(gcs[pos]) + iv[rt][r];
          const int i = dir ? 63 - pos : pos;
          OUT[((size_t)tokbase + s0 + i) * 256 + h * 64 + e_col] = f2bf(o);
          vn[rt][r] *= __expf(gc63 - gcs[pos]);
        }
      bf16x8 Bv2[2];
#pragma unroll
      for (int ks = 0; ks < 2; ++ks)
        Bv2[ks] = pack8(vn[2 * ks][0], vn[2 * ks][1], vn[2 * ks][2], vn[2 * ks][3], vn[2 * ks + 1][0], vn[2 * ks + 1][1],
                        vn[2 * ks + 1][2], vn[2 * ks + 1][3]);
      const float gl = __expf(gc63);
#pragma unroll
      for (int dt = 0; dt < 4; ++dt) {
#pragma unroll
        for (int r = 0; r < 4; ++r) Sd[dt][r] *= gl;
#pragma unroll
        for (int ks = 0; ks < 2; ++ks) {
          const bf16_t* kp = Kt + (16 * dt + l15) * 72 + 32 * ks + 4 * g4;
          Sd[dt] = MFMA16(ld2x4(kp, kp + 16), Bv2[ks], Sd[dt]);
        }
      }
    }
  }
}

__device__ void phase_combine(CParams& p, int layer, const float* __restrict__ xg) {
  const int tidq = threadIdx.x + opq(); const int wave = tidq >> 6, lane = tidq & 63;
  const bf16_t* PR = (const bf16_t*)(p.ws + OFF_PR);
  const bf16_t* OD = (const bf16_t*)(p.ws + OFF_OD);
  const float* LSE = (const float*)(p.ws + OFF_LSE);
  const bf16_t* OFb = (const bf16_t*)(p.ws + OFF_OF);
  const bf16_t* OBb = (const bf16_t*)(p.ws + OFF_OB);
  bf16_t* Y = (bf16_t*)(p.ws + OFF_N);
  bf16_t* Np = (bf16_t*)(p.ws + OFF_Q);
  const float* gmix = p.norm_mix + layer * 1024;
  const float* gdn = p.dn_out_norm + layer * 64;
  const int head = lane >> 4;
  for (int r = blockIdx.x * 4 + wave; r < TG; r += gridDim.x * 4) {
    {
      float lg[3];
#pragma unroll
      for (int g = 0; g < 3; ++g) lg[g] = LSE[((size_t)g * TG + r) * 4 + head];
      const float mx = fmaxf(lg[0], fmaxf(lg[1], lg[2]));
      float wg[3], den = 0.f;
#pragma unroll
      for (int g = 0; g < 3; ++g) { wg[g] = exp2_(lg[g] - mx); den += wg[g]; }
      const float id = 1.f / den;
      float o[4] = {0.f, 0.f, 0.f, 0.f};
#pragma unroll
      for (int g = 0; g < 3; ++g) {
        const u32x2 u = ((const u32x2*)(OD + ((size_t)g * TG + r) * 256))[lane];
        const float c = wg[g] * id;
        o[0] += c * __uint_as_float(u.x << 16); o[1] += c * __uint_as_float(u.x & 0xffff0000u);
        o[2] += c * __uint_as_float(u.y << 16); o[3] += c * __uint_as_float(u.y & 0xffff0000u);
      }
      u32x2 ou; ou.x = pack2(o[0], o[1]); ou.y = pack2(o[2], o[3]);
      ((u32x2*)(Y + (size_t)r * 1024 + 768))[lane] = ou;
    }
    {
      const u32x2 uf = ((const u32x2*)(OFb + (size_t)r * 256))[lane];
      const u32x2 ub = ((const u32x2*)(OBb + (size_t)r * 256))[lane];
      const u32x2 uz = ((const u32x2*)(PR + (size_t)r * NPR + C_Z))[lane];
      float o[4], z[4];
      o[0] = __uint_as_float(uf.x << 16) + __uint_as_float(ub.x << 16);
      o[1] = __uint_as_float(uf.x & 0xffff0000u) + __uint_as_float(ub.x & 0xffff0000u);
      o[2] = __uint_as_float(uf.y << 16) + __uint_as_float(ub.y << 16);
      o[3] = __uint_as_float(uf.y & 0xffff0000u) + __uint_as_float(ub.y & 0xffff0000u);
      z[0] = __uint_as_float(uz.x << 16); z[1] = __uint_as_float(uz.x & 0xffff0000u);
      z[2] = __uint_as_float(uz.y << 16); z[3] = __uint_as_float(uz.y & 0xffff0000u);
      float ss = o[0] * o[0] + o[1] * o[1] + o[2] * o[2] + o[3] * o[3];
      ss += __shfl_xor(ss, 1); ss += __shfl_xor(ss, 2); ss += __shfl_xor(ss, 4); ss += __shfl_xor(ss, 8);
      const float rs = rsqrtf(ss * (1.f / 64.f) + EPS);
      const float4 gg = ((const float4*)gdn)[lane & 15];
      u32x2 ou;
      ou.x = pack2(o[0] * rs * gg.x * siluf_(z[0]), o[1] * rs * gg.y * siluf_(z[1]));
      ou.y = pack2(o[2] * rs * gg.z * siluf_(z[2]), o[3] * rs * gg.w * siluf_(z[3]));
      ((u32x2*)(Y + (size_t)r * 1024 + 512))[lane] = ou;
    }
    {
      const float4* xr = (const float4*)(xg + (size_t)r * 1024);
      float4 v[4];
      float ss = 0.f;
#pragma unroll
      for (int i = 0; i < 4; ++i) { v[i] = xr[lane + 64 * i]; ss += v[i].x * v[i].x + v[i].y * v[i].y + v[i].z * v[i].z + v[i].w * v[i].w; }
      ss = wave_sum(ss);
      const float rs = rsqrtf(ss * (1.f / 1024.f) + EPS);
#pragma unroll
      for (int i = 0; i < 4; ++i) {
        const float4 gg = ((const float4*)gmix)[lane + 64 * i];
        u32x2 o; o.x = pack2(v[i].x * rs * gg.x, v[i].y * rs * gg.y); o.y = pack2(v[i].z * rs * gg.z, v[i].w * rs * gg.w);
        ((u32x2*)(Np + (size_t)r * 1024))[lane + 64 * i] = o;
      }
    }
  }
}

#define XB_TMO      128
#define XB_XCNT(j)  (256  + 64 * (j))
#define XB_XSUB(j)  (1280 + 64 * (j))
#define XB_XGEN(j)  (2304 + 64 * (j))
#define XB_TOP      3328
#define XB_TOPGEN   3392
#define XCD_BAR_WORDS 3456
#define XB_SPIN_CAP (1u << 27)
#define LAS __attribute__((address_space(3)))
constexpr size_t OFF_BAR = OFF_CNT + 65536;
DI unsigned xb_ld(unsigned* p) { return __hip_atomic_load(p, __ATOMIC_RELAXED, __HIP_MEMORY_SCOPE_AGENT); }
DI unsigned xb_add(unsigned* p, unsigned v) { return __hip_atomic_fetch_add(p, v, __ATOMIC_RELAXED, __HIP_MEMORY_SCOPE_AGENT); }
DI unsigned xb_xcc_id() { return (unsigned)__builtin_amdgcn_s_getreg((3 << 11) | 20) & 0xFu; }
#define XB_SPIN(cond, bar) do { unsigned _sp = 0; while (cond) { __builtin_amdgcn_s_sleep(1); \
    if ((++_sp & 255u) == 0u) { if (xb_ld(&(bar)[XB_TMO])) break; if (_sp > XB_SPIN_CAP) { atomicAdd(&(bar)[XB_TMO], 1u); break; } } } } while (0)
struct XcdBarrier { unsigned* bar; unsigned x; volatile LAS unsigned* st; };
DI XcdBarrier xcd_barrier_post(unsigned* bar, volatile LAS unsigned* st) {
  XcdBarrier b; b.bar = bar; b.x = xb_xcc_id(); b.st = st;
  if (threadIdx.x == 0) (void)xb_add(&bar[XB_XCNT(b.x)], 1u);
  return b;
}
DI void xcd_barrier_complete(unsigned* bar, unsigned x, unsigned& nloc, unsigned& nx) {
  const unsigned G = gridDim.x * gridDim.y * gridDim.z;
  unsigned sum, cnt, mine, sp = 0u;
  for (;;) {
    sum = 0u; cnt = 0u; mine = 0u;
#pragma unroll
    for (unsigned j = 0; j < 16; ++j) { const unsigned c = xb_ld(&bar[XB_XCNT(j)]); sum += c; cnt += (c > 0u) ? 1u : 0u; mine = (j == x) ? c : mine; }
    if (sum == G) break;
    __builtin_amdgcn_s_sleep(1);
    if ((++sp & 255u) == 0u) { if (xb_ld(&bar[XB_TMO])) break; if (sp > XB_SPIN_CAP) { atomicAdd(&bar[XB_TMO], 1u); break; } }
  }
  nloc = mine > 0u ? mine : 1u; nx = cnt > 0u ? cnt : 1u;
}
DI void xcd_barrier(const XcdBarrier& b) {
  asm volatile("s_waitcnt vmcnt(0)" ::: "memory");
  __syncthreads();
  if (threadIdx.x == 0) {
    unsigned* bar = b.bar;
    __builtin_amdgcn_s_waitcnt(0);
    unsigned nloc = b.st[0], nx = b.st[1];
    if (nloc == 0u) { xcd_barrier_complete(bar, b.x, nloc, nx); b.st[0] = nloc; b.st[1] = nx; }
    const unsigned old = xb_add(&bar[XB_XSUB(b.x)], 1u);
    const unsigned gen = old / nloc;
    if (old + 1u == (gen + 1u) * nloc) {
      __builtin_amdgcn_fence(__ATOMIC_RELEASE, "agent");
      asm volatile("s_waitcnt vmcnt(0)" ::: "memory");
      const unsigned og = xb_add(&bar[XB_TOP], 1u);
      const unsigned tg = og / nx;
      if (og + 1u == (tg + 1u) * nx) xb_add(&bar[XB_TOPGEN], 1u);
      else XB_SPIN(xb_ld(&bar[XB_TOPGEN]) == tg, bar);
      __builtin_amdgcn_fence(__ATOMIC_ACQUIRE, "agent");
      xb_add(&bar[XB_XGEN(b.x)], 1u);
      asm volatile("s_waitcnt vmcnt(0)" ::: "memory");
    } else {
      XB_SPIN(xb_ld(&bar[XB_XGEN(b.x)]) == gen, bar);
      __builtin_amdgcn_fence(__ATOMIC_ACQUIRE, "agent");
      asm volatile("s_waitcnt vmcnt(0)" ::: "memory");
    }
  }
  __syncthreads();
}

#ifndef REP_MIX
#define REP_MIX 1
#endif
#ifndef REP_GEMM
#define REP_GEMM 1
#endif
__global__ void __launch_bounds__(256, 2) mega(Params pk) {
  extern __shared__ __attribute__((aligned(16))) char lds[];
  __shared__ uint4 sh_words;
  cg::grid_group grid = cg::this_grid();
  CParams* kp = (CParams*)__builtin_amdgcn_kernarg_segment_ptr();
  if (threadIdx.x == 0) sh_words = make_uint4(0u, 0u, 0u, 0u);
  __syncthreads();
  XcdBarrier xb;
  { CParams& p = *launder(kp); xb = xcd_barrier_post((unsigned*)(p.ws + OFF_BAR), (volatile LAS unsigned*)&sh_words); }
#define s_item (((volatile int*)&sh_words)[2])
#define GSYNC() xcd_barrier(xb)
#define PP_ CParams& p = *launder(kp); const bf16_t* wb = (const bf16_t*)(p.ws + OFF_WB); bf16_t* Nb = (bf16_t*)(p.ws + OFF_N); \
            bf16_t* PRb = (bf16_t*)(p.ws + OFF_PR); bf16_t* Npb = (bf16_t*)(p.ws + OFF_Q); bf16_t* PB = (bf16_t*)(p.ws + OFF_OD); \
            float* xg = p.x + (size_t)grp * TG * 1024; (void)wb; (void)Nb; (void)PRb; (void)Npb; (void)PB; (void)xg;
  { CParams& p = *launder(kp); phase_init(p, lds); }
  grid.sync();
  for (int layer = 0; layer < 2; ++layer) {
    if (layer > 0) { CParams& p = *launder(kp); phase_convert(p, layer, lds); GSYNC(); }
    for (int grp = 0; grp < 2; ++grp) {
      const int S = grp ? 2048 : 16384, B = grp ? 16 : 2;
      { PP_ phase_norm(xg, p.norm_ff1 + layer * 1024, Nb, nullptr, nullptr); }
      GSYNC();
      for (int rep = 0; rep < REP_GEMM; ++rep) {
        { PP_ phase_ffn_a(Nb, wb + W_FF1_1, wb + W_FF1_3, PRb, lds); }
        GSYNC();
      }
      { PP_ phase_gemm_resid(PRb, 2816, wb + W_FF1_2, xg, 0.5f, lds); }
      GSYNC();
      { PP_ phase_norm(xg, p.norm_mix + layer * 1024, Nb, nullptr, nullptr); }
      GSYNC();
      for (int rep = 0; rep < REP_GEMM; ++rep) {
        { PP_ phase_proj(p, Nb, wb + W_IN, S, lds); }
        GSYNC();
      }
      {
        PP_
        int* c0 = (int*)(p.ws + OFF_CNT) + (layer * 2 + grp) * 4;
        for (;;) {
          __syncthreads();
          if (threadIdx.x == 0) s_item = atomicAdd(c0, 1);
          __syncthreads();
          const int it = s_item;
          if (it >= 2048) break;
          dn_prep_item(p, layer, it, S, lds);
        }
      }
      GSYNC();
      {
        PP_
        int* c1 = (int*)(p.ws + OFF_CNT) + (layer * 2 + grp) * 4 + 1;
        const int nDN = B * 8, total = nDN + 1024;
        for (;;) {
          __syncthreads();
          if (threadIdx.x == 0) s_item = atomicAdd(c1, 1);
          __syncthreads();
          int it = s_item;
          if (it >= total) break;
          if (it < nDN) { dn_scan_chain(p, it, S, lds); continue; }
          diff_item(p, layer, it - nDN, S, lds);
        }
      }
      GSYNC();
      {
        PP_
        int* c2 = (int*)(p.ws + OFF_CNT) + (layer * 2 + grp) * 4 + 2;
        const int nDil = 3072, total = nDil + 256 * 7;
        for (;;) {
          __syncthreads();
          if (threadIdx.x == 0) s_item = atomicAdd(c2, 1);
          __syncthreads();
          int it = s_item;
          if (it >= total) break;
          if (it < nDil) { dil_item(p, it, S, B, lds); continue; }
          it -= nDil;
          mla_up_tile(p, it / 7, it % 7, S, lds);
        }
      }
      GSYNC();
      {
        PP_
        int* c3 = (int*)(p.ws + OFF_CNT) + (layer * 2 + grp) * 4 + 3;
        for (;;) {
          __syncthreads();
          if (threadIdx.x == 0) s_item = atomicAdd(c3, 1);
          __syncthreads();
          const int it = s_item;
          if (it >= 1024) break;
          mla_item(p, it, S, lds);
        }
      }
      GSYNC();
      { PP_ phase_combine(p, layer, xg); }
      GSYNC();
      for (int rep = 0; rep < REP_GEMM; ++rep) {
        { PP_ phase_merge(Npb, Nb, wb + W_G, wb + W_B, PRb, lds); }
        GSYNC();
      }
      { PP_ phase_gemm_resid(PRb, 1024, wb + W_O, xg, 1.0f, lds); }
      GSYNC();
      { PP_ phase_norm(xg, p.norm_ff2 + layer * 1024, Nb, nullptr, nullptr); }
      GSYNC();
      for (int rep = 0; rep < REP_GEMM; ++rep) {
        { PP_ phase_ffn_a(Nb, wb + W_FF2_1, wb + W_FF2_3, PRb, lds); }
        GSYNC();
      }
      { PP_ phase_gemm_resid(PRb, 2816, wb + W_FF2_2, xg, 0.5f, lds); }
      GSYNC();
      { PP_ phase_norm(xg, p.norm_ple + layer * 1024, Nb, p.p_in[grp] + (size_t)layer * TG * 256, PB); }
      GSYNC();
      { PP_ phase_ple(Nb, PB, wb + W_PG, wb + W_PP, xg, lds); }
      GSYNC();
    }
  }
  { CParams& p = *launder(kp); phase_final_norm(p.x, p.norm_final); }
}

extern "C" void kernel_launch(void* const* d_in, const int* in_sizes, int n_in, void* d_out, int out_size, void* d_ws,
                              size_t ws_size, hipStream_t stream) {
  (void)in_sizes; (void)n_in; (void)out_size;
  Params p{};
  p.x_in[0] = (const float*)d_in[0]; p.x_in[1] = (const float*)d_in[1];
  p.p_in[0] = (const float*)d_in[2]; p.p_in[1] = (const float*)d_in[3];
  p.norm_ff1 = (const float*)d_in[4]; p.ff1_w1 = (const float*)d_in[5]; p.ff1_w3 = (const float*)d_in[6];
  p.ff1_w2 = (const float*)d_in[7]; p.norm_mix = (const float*)d_in[8]; p.w_in = (const float*)d_in[9];
  p.mla_q_norm = (const float*)d_in[10]; p.mla_kv_norm = (const float*)d_in[11]; p.mla_w_uq = (const float*)d_in[12];
  p.mla_w_ukv = (const float*)d_in[13]; p.diff_lambda = (const float*)d_in[14]; p.diff_subln = (const float*)d_in[15];
  p.dn_conv = (const float*)d_in[16]; p.dn_a_log = (const float*)d_in[17]; p.dn_dt_bias = (const float*)d_in[18];
  p.dn_out_norm = (const float*)d_in[19]; p.w_branch = (const float*)d_in[20]; p.w_gate = (const float*)d_in[21];
  p.w_out = (const float*)d_in[22]; p.norm_ff2 = (const float*)d_in[23]; p.ff2_w1 = (const float*)d_in[24];
  p.ff2_w3 = (const float*)d_in[25]; p.ff2_w2 = (const float*)d_in[26]; p.norm_ple = (const float*)d_in[27];
  p.ple_gate = (const float*)d_in[28]; p.ple_proj = (const float*)d_in[29]; p.norm_final = (const float*)d_in[30];
  p.x = (float*)d_out;
  p.ws = (char*)d_ws;
  static int grid_blocks = 0;
  if (!grid_blocks) {
    int dev = 0, cus = 0, per_cu = 0;
    hipGetDevice(&dev);
    hipDeviceGetAttribute(&cus, hipDeviceAttributeMultiprocessorCount, dev);
    hipFuncSetAttribute((const void*)mega, hipFuncAttributeMaxDynamicSharedMemorySize, (int)LDS_BYTES);
    hipOccupancyMaxActiveBlocksPerMultiprocessor(&per_cu, mega, 256, LDS_BYTES);
    if (per_cu < 1) per_cu = 1;
    grid_blocks = cus * per_cu;
  }
  if (ws_size < WS_NEED) {
    fprintf(stderr, "workspace too small: %zu < %zu\n", ws_size, (size_t)WS_NEED);
    return;
  }
  (void)hipMemsetAsync((char*)d_ws + OFF_BAR, 0, XCD_BAR_WORDS * 4, stream);
  void* args[] = {&p};
  hipError_t e = hipLaunchCooperativeKernel((void*)mega, dim3(grid_blocks), dim3(256), args, LDS_BYTES, stream);
  if (e != hipSuccess) fprintf(stderr, "cooperative launch failed: %s (grid %d)\n", hipGetErrorString(e), grid_blocks);
}
```

```cpp
#include <hip/hip_runtime.h>
#include <hip/hip_cooperative_groups.h>
#include <stdint.h>
#include <stdio.h>
namespace cg = cooperative_groups;

typedef unsigned short bf16_t;
using bf16x8 = __attribute__((ext_vector_type(8))) short;
using bf16x4 = __attribute__((ext_vector_type(4))) short;
using f32x16 = __attribute__((ext_vector_type(16))) float;
using f32x4 = __attribute__((ext_vector_type(4))) float;
using u32x4 = __attribute__((ext_vector_type(4))) unsigned;
using u32x2 = __attribute__((ext_vector_type(2))) unsigned;

#define DI __device__ __forceinline__
#define MFMA32(a, b, c) __builtin_amdgcn_mfma_f32_32x32x16_bf16((a), (b), (c), 0, 0, 0)
#define MFMA16(a, b, c) __builtin_amdgcn_mfma_f32_16x16x32_bf16((a), (b), (c), 0, 0, 0)

constexpr int TG = 32768;
constexpr int NPR = 4608;
constexpr float EPS = 1e-6f;
constexpr float LOG2E = 1.4426950408889634f;
constexpr int C_CQ = 0, C_CKV = 256, C_BQ = 384, C_BK = 640, C_BV = 896, C_DNQKV = 1152, C_Z = 1920,
              C_DQ = 2176, C_DK = 2944, C_DV = 3712;
constexpr size_t MiB = 1048576;
constexpr size_t OFF_WB = 0, OFF_TAB = 57 * MiB, OFF_CNT = 63 * MiB, OFF_N = 64 * MiB, OFF_PR = 128 * MiB,
                 OFF_Q = 416 * MiB, OFF_K = 440 * MiB, OFF_V = 464 * MiB, OFF_AB = 480 * MiB, OFF_OD = 482 * MiB,
                 OFF_LSE = 530 * MiB, OFF_OF = 532 * MiB, OFF_OB = 548 * MiB, WS_NEED = 564 * MiB;
constexpr size_t W_FF1_1 = 0, W_FF1_3 = 2883584, W_FF1_2 = 5767168, W_IN = 8650752, W_UQ = 13369344,
                 W_UKV = 13467648, W_G = 13533184, W_B = 17727488, W_O = 18776064, W_FF2_1 = 19824640,
                 W_FF2_3 = 22708224, W_FF2_2 = 25591808, W_PG = 28475392, W_PP = 29523968;
constexpr size_t LDS_BYTES = 78336;

struct Params {
  const float* x_in[2];
  const float* p_in[2];
  const float *norm_ff1, *ff1_w1, *ff1_w3, *ff1_w2, *norm_mix, *w_in, *mla_q_norm, *mla_kv_norm, *mla_w_uq,
      *mla_w_ukv, *diff_lambda, *diff_subln, *dn_conv, *dn_a_log, *dn_dt_bias, *dn_out_norm, *w_branch, *w_gate,
      *w_out, *norm_ff2, *ff2_w1, *ff2_w3, *ff2_w2, *norm_ple, *ple_gate, *ple_proj, *norm_final;
  float* x;
  char* ws;
};

typedef const __attribute__((address_space(4))) Params CParams;
DI CParams* launder(CParams* q) { asm volatile("" : "+s"(q)); return q; }

typedef __bf16 bf2_t __attribute__((ext_vector_type(2)));
typedef float f2_t __attribute__((ext_vector_type(2)));
DI bf16_t f2bf(float x) { return __builtin_bit_cast(bf16_t, (__bf16)x); }
DI float bf2f(bf16_t b) { return __uint_as_float(((unsigned)b) << 16); }
DI unsigned pack2(float a, float b) { f2_t v = {a, b}; return __builtin_bit_cast(unsigned, __builtin_convertvector(v, bf2_t)); }
DI float wave_sum(float v) {
#pragma unroll
  for (int o = 32; o > 0; o >>= 1) v += __shfl_xor(v, o);
  return v;
}
DI float sigmoidf_(float x) { return 1.f / (1.f + __expf(-x)); }
DI float siluf_(float x) { return x / (1.f + __expf(-x)); }
DI float exp2_(float x) { return __builtin_amdgcn_exp2f(x); }
DI int opq() { int z; asm volatile("v_mov_b32 %0, 0" : "=v"(z)); return z; }
DI int crow(int r, int h2) { return (r & 3) + 8 * (r >> 2) + 4 * h2; }
DI bf16x8 pack8(float a0, float a1, float a2, float a3, float a4, float a5, float a6, float a7) {
  u32x4 u;
  u.x = pack2(a0, a1); u.y = pack2(a2, a3); u.z = pack2(a4, a5); u.w = pack2(a6, a7);
  return __builtin_bit_cast(bf16x8, u);
}
DI bf16x8 ld2x4(const bf16_t* p0, const bf16_t* p1) {
  u32x2 a = *(const u32x2*)p0, b = *(const u32x2*)p1;
  u32x4 u; u.x = a.x; u.y = a.y; u.z = b.x; u.w = b.y;
  return __builtin_bit_cast(bf16x8, u);
}
DI void store8bf(bf16_t* dst, const float* v) {
  u32x4 u; u.x = pack2(v[0], v[1]); u.y = pack2(v[2], v[3]); u.z = pack2(v[4], v[5]); u.w = pack2(v[6], v[7]);
  *(u32x4*)dst = u;
}

struct MatDesc { const float* src; bf16_t* dst; int K, ldsrc, Ndst, map; const float* rowscale; };

DI int map_col(int map, int n) {
  if (map == 0) return n;
  if (map == 1) {
    if (n < 384) return n;
    if (n < 1920) return n + 32;
    if (n < 4480) return n + 48;
    if (n < 4512) return n - 4480 + 384;
    if (n < 4528) return n - 4512 + 1952;
    return -1;
  }
  if (n < 256) return (n >> 6) * 96 + (n & 63);
  return ((n - 256) >> 5) * 96 + 64 + ((n - 256) & 31);
}

DI MatDesc get_mat(CParams& p, int l, int id) {
  bf16_t* wb = (bf16_t*)(p.ws + OFF_WB);
  MatDesc d; d.map = 0; d.rowscale = nullptr;
  const size_t FF = (size_t)1024 * 2816;
  switch (id) {
    case 0: d.src = p.ff1_w1 + l * FF; d.dst = wb + W_FF1_1; d.K = 1024; d.ldsrc = 2816; d.Ndst = 2816; break;
    case 1: d.src = p.ff1_w3 + l * FF; d.dst = wb + W_FF1_3; d.K = 1024; d.ldsrc = 2816; d.Ndst = 2816; break;
    case 2: d.src = p.ff1_w2 + l * FF; d.dst = wb + W_FF1_2; d.K = 2816; d.ldsrc = 1024; d.Ndst = 1024; break;
    case 3: d.src = p.w_in + (size_t)l * 1024 * 4528; d.dst = wb + W_IN; d.K = 1024; d.ldsrc = 4528; d.Ndst = 4608; d.map = 1; break;
    case 4: d.src = p.mla_w_uq + (size_t)l * 256 * 384; d.dst = wb + W_UQ; d.K = 256; d.ldsrc = 384; d.Ndst = 384; d.map = 2; d.rowscale = p.mla_q_norm + l * 256; break;
    case 5: d.src = p.mla_w_ukv + (size_t)l * 128 * 512; d.dst = wb + W_UKV; d.K = 128; d.ldsrc = 512; d.Ndst = 512; d.rowscale = p.mla_kv_norm + l * 128; break;
    case 6: case 7: case 8: case 9:
      d.src = p.w_gate + (size_t)(l * 4 + id - 6) * 1048576; d.dst = wb + W_G + (size_t)(id - 6) * 1048576; d.K = 1024; d.ldsrc = 1024; d.Ndst = 1024; break;
    case 10: case 11: case 12: case 13:
      d.src = p.w_branch + (size_t)(l * 4 + id - 10) * 262144; d.dst = wb + W_B + (size_t)(id - 10) * 262144; d.K = 256; d.ldsrc = 1024; d.Ndst = 1024; break;
    case 14: d.src = p.w_out + (size_t)l * 1048576; d.dst = wb + W_O; d.K = 1024; d.ldsrc = 1024; d.Ndst = 1024; break;
    case 15: d.src = p.ff2_w1 + l * FF; d.dst = wb + W_FF2_1; d.K = 1024; d.ldsrc = 2816; d.Ndst = 2816; break;
    case 16: d.src = p.ff2_w3 + l * FF; d.dst = wb + W_FF2_3; d.K = 1024; d.ldsrc = 2816; d.Ndst = 2816; break;
    case 17: d.src = p.ff2_w2 + l * FF; d.dst = wb + W_FF2_2; d.K = 2816; d.ldsrc = 1024; d.Ndst = 1024; break;
    case 18: d.src = p.ple_gate + (size_t)l * 1048576; d.dst = wb + W_PG; d.K = 1024; d.ldsrc = 1024; d.Ndst = 1024; break;
    default: d.src = p.ple_proj + (size_t)l * 262144; d.dst = wb + W_PP; d.K = 256; d.ldsrc = 1024; d.Ndst = 1024; break;
  }
  return d;
}

DI void phase_convert(CParams& p, int l, char* lds) {
  float* T = (float*)lds;
  const int tid = threadIdx.x + opq();
  for (int id = 0; id < 20; ++id) {
    MatDesc d = get_mat(p, l, id);
    const int nkt = d.K >> 6, nnt = d.Ndst >> 6, nt_all = nkt * nnt;
    for (int t = blockIdx.x; t < nt_all; t += gridDim.x) {
      const int kt = t / nnt, nt = t % nnt;
      __syncthreads();
      {
        const int nl = tid & 63;
        const int sc = map_col(d.map, nt * 64 + nl);
#pragma unroll 4
        for (int i = 0; i < 16; ++i) {
          const int kl = (tid >> 6) + 4 * i;
          const int k = kt * 64 + kl;
          float v = 0.f;
          if (sc >= 0) v = d.src[(size_t)k * d.ldsrc + sc];
          if (d.rowscale) v *= d.rowscale[k];
          T[kl * 65 + nl] = v;
        }
      }
      __syncthreads();
      {
        const int kl = tid & 63;
#pragma unroll 4
        for (int i = 0; i < 16; ++i) {
          const int nl = (tid >> 6) + 4 * i;
          d.dst[(size_t)(nt * 64 + nl) * d.K + kt * 64 + kl] = f2bf(T[kl * 65 + nl]);
        }
      }
    }
  }
}

DI void phase_init(CParams& p, char* lds) {
  const size_t gtid = (size_t)blockIdx.x * 256 + threadIdx.x + opq(), gn = (size_t)gridDim.x * 256;
  {
    float2* t32 = (float2*)(p.ws + OFF_TAB);
    float2* t64 = (float2*)(p.ws + OFF_TAB + 2 * MiB);
    for (size_t i = gtid; i < (size_t)16384 * 48; i += gn) {
      const int pos = (int)(i / 48), f = (int)(i % 48);
      float inv;
      if (f < 16) inv = exp2f(-(float)f * (13.287712379549449f / 16.f));
      else inv = exp2f(-(float)(f - 16) * (13.287712379549449f / 32.f));
      const float ang = (float)pos * inv;
      const double xd = (double)ang;
      const double n = rint(xd * 0.15915494309189535);
      const float rf = (float)(xd - n * 6.283185307179586);
      float2 cs; cs.x = __cosf(rf); cs.y = __sinf(rf);
      if (f < 16) t32[(size_t)pos * 16 + f] = cs; else t64[(size_t)pos * 32 + (f - 16)] = cs;
    }
  }
  if (blockIdx.x == 0 && threadIdx.x < 64) ((int*)(p.ws + OFF_CNT))[threadIdx.x] = 0;
  phase_convert(p, 0, lds);
}

DI void phase_norm(const float* __restrict__ x, const float* __restrict__ g, bf16_t* __restrict__ dst,
                           const float* __restrict__ psrc, bf16_t* __restrict__ pdst) {
  const int tidq = threadIdx.x + opq(); const int wave = tidq >> 6, lane = tidq & 63;
  for (int r = blockIdx.x * 4 + wave; r < TG; r += gridDim.x * 4) {
    const float4* xr = (const float4*)(x + (size_t)r * 1024);
    float4 v[4];
    float ss = 0.f;
#pragma unroll
    for (int i = 0; i < 4; ++i) { v[i] = xr[lane + 64 * i]; ss += v[i].x * v[i].x + v[i].y * v[i].y + v[i].z * v[i].z + v[i].w * v[i].w; }
    ss = wave_sum(ss);
    const float rs = rsqrtf(ss * (1.f / 1024.f) + EPS);
#pragma unroll
    for (int i = 0; i < 4; ++i) {
      const float4 gg = ((const float4*)g)[lane + 64 * i];
      u32x2 o; o.x = pack2(v[i].x * rs * gg.x, v[i].y * rs * gg.y); o.y = pack2(v[i].z * rs * gg.z, v[i].w * rs * gg.w);
      ((u32x2*)(dst + (size_t)r * 1024))[lane + 64 * i] = o;
    }
    if (psrc) {
      const float4 pv = ((const float4*)(psrc + (size_t)r * 256))[lane];
      u32x2 o; o.x = pack2(pv.x, pv.y); o.y = pack2(pv.z, pv.w);
      ((u32x2*)(pdst + (size_t)r * 256))[lane] = o;
    }
  }
}

DI void phase_final_norm(float* __restrict__ x, const float* __restrict__ g) {
  const int tidq = threadIdx.x + opq(); const int wave = tidq >> 6, lane = tidq & 63;
  for (int r = blockIdx.x * 4 + wave; r < 2 * TG; r += gridDim.x * 4) {
    float4* xr = (float4*)(x + (size_t)r * 1024);
    float4 v[4];
    float ss = 0.f;
#pragma unroll
    for (int i = 0; i < 4; ++i) { v[i] = xr[lane + 64 * i]; ss += v[i].x * v[i].x + v[i].y * v[i].y + v[i].z * v[i].z + v[i].w * v[i].w; }
    ss = wave_sum(ss);
    const float rs = rsqrtf(ss * (1.f / 1024.f) + EPS);
#pragma unroll
    for (int i = 0; i < 4; ++i) {
      const float4 gg = ((const float4*)g)[lane + 64 * i];
      float4 o; o.x = v[i].x * rs * gg.x; o.y = v[i].y * rs * gg.y; o.z = v[i].z * rs * gg.z; o.w = v[i].w * rs * gg.w;
      xr[lane + 64 * i] = o;
    }
  }
}

template <int NI, int NB>
DI void gemm_main(f32x16 (&acc0)[2][NI], f32x16 (&acc1)[2][NI], const bf16_t* __restrict__ A, int lda,
                  const bf16_t* __restrict__ B0, const bf16_t* __restrict__ B1, int ldb, int K, char* lds) {
  const int tid = threadIdx.x + opq(), lane = tid & 63, w = tid >> 6, wm = w >> 1, wn = w & 1, l31 = lane & 31, h2 = lane >> 5;
  bf16_t* As = (bf16_t*)lds;
  bf16_t* B0s = As + 128 * 72;
  bf16_t* B1s = B0s + 64 * NI * 72;
  const int lr = tid >> 3, lc = (tid & 7) * 8;
  u32x4 ra[4], rb0[2 * NI], rb1[2 * NI];
  const bf16_t* ap = A + (size_t)lr * lda + lc;
  const bf16_t* bp0 = B0 + (size_t)lr * ldb + lc;
  const bf16_t* bp1 = (NB == 2) ? (B1 + (size_t)lr * ldb + lc) : B0;
#pragma unroll
  for (int i = 0; i < 4; ++i) ra[i] = *(const u32x4*)(ap + (size_t)(32 * i) * lda);
#pragma unroll
  for (int i = 0; i < 2 * NI; ++i) {
    rb0[i] = *(const u32x4*)(bp0 + (size_t)(32 * i) * ldb);
    if (NB == 2) rb1[i] = *(const u32x4*)(bp1 + (size_t)(32 * i) * ldb);
  }
  for (int k0 = 0; k0 < K; k0 += 64) {
    __syncthreads();
#pragma unroll
    for (int i = 0; i < 4; ++i) *(u32x4*)(As + (lr + 32 * i) * 72 + lc) = ra[i];
#pragma unroll
    for (int i = 0; i < 2 * NI; ++i) {
      *(u32x4*)(B0s + (lr + 32 * i) * 72 + lc) = rb0[i];
      if (NB == 2) *(u32x4*)(B1s + (lr + 32 * i) * 72 + lc) = rb1[i];
    }
    if (k0 + 64 < K) {
      const int kn = k0 + 64;
#pragma unroll
      for (int i = 0; i < 4; ++i) ra[i] = *(const u32x4*)(ap + (size_t)(32 * i) * lda + kn);
#pragma unroll
      for (int i = 0; i < 2 * NI; ++i) {
        rb0[i] = *(const u32x4*)(bp0 + (size_t)(32 * i) * ldb + kn);
        if (NB == 2) rb1[i] = *(const u32x4*)(bp1 + (size_t)(32 * i) * ldb + kn);
      }
    }
    __syncthreads();
    __builtin_amdgcn_s_setprio(1);
#pragma unroll
    for (int ks = 0; ks < 4; ++ks) {
      bf16x8 af[2], bf0[NI], bf1[NI];
#pragma unroll
      for (int mi = 0; mi < 2; ++mi) af[mi] = *(const bf16x8*)(As + (64 * wm + 32 * mi + l31) * 72 + 16 * ks + 8 * h2);
#pragma unroll
      for (int ni = 0; ni < NI; ++ni) {
        bf0[ni] = *(const bf16x8*)(B0s + (32 * NI * wn + 32 * ni + l31) * 72 + 16 * ks + 8 * h2);
        if (NB == 2) bf1[ni] = *(const bf16x8*)(B1s + (32 * NI * wn + 32 * ni + l31) * 72 + 16 * ks + 8 * h2);
      }
#pragma unroll
      for (int mi = 0; mi < 2; ++mi)
#pragma unroll
        for (int ni = 0; ni < NI; ++ni) {
          acc0[mi][ni] = MFMA32(af[mi], bf0[ni], acc0[mi][ni]);
          if (NB == 2) acc1[mi][ni] = MFMA32(af[mi], bf1[ni], acc1[mi][ni]);
        }
    }
    __builtin_amdgcn_s_setprio(0);
  }
}

template <int NI>
DI void zero_acc(f32x16 (&a)[2][NI]) {
#pragma unroll
  for (int mi = 0; mi < 2; ++mi)
#pragma unroll
    for (int ni = 0; ni < NI; ++ni)
#pragma unroll
      for (int r = 0; r < 16; ++r) a[mi][ni][r] = 0.f;
}

#define EPI_VARS const int tid = threadIdx.x + opq(), lane = tid & 63, w = tid >> 6, wm = w >> 1, wn = w & 1, l31 = lane & 31, h2 = lane >> 5; (void)tid; (void)lane; (void)w
#define EPI_BEGIN(NI_) _Pragma("unroll") for (int mi = 0; mi < 2; ++mi) _Pragma("unroll") for (int ni = 0; ni < NI_; ++ni) _Pragma("unroll") for (int r = 0; r < 16; ++r) { \
    const int row = 64 * wm + 32 * mi + crow(r, h2); const int col = 32 * NI_ * wn + 32 * ni + l31;
#define EPI_END }

DI bool xcd_tile(int iter, int MT, int NT, int& mt, int& nt) {
  const int x = blockIdx.x & 7, lb = blockIdx.x >> 3, nb = gridDim.x >> 3;
  const int full = NT >> 3, rem = NT & 7;
  const int per_full = full * MT, rem_tot = rem * MT;
  const int r0 = (rem_tot * x) >> 3, r1 = (rem_tot * (x + 1)) >> 3;
  const int j = lb + iter * nb;
  if (lb >= nb || j >= per_full + (r1 - r0)) return false;
  if (j < per_full) { mt = j / full; nt = x * full + j % full; }
  else { const int u = r0 + (j - per_full); nt = 8 * full + u / MT; mt = u % MT; }
  return true;
}

DI void phase_ffn_a(const bf16_t* __restrict__ Nb, const bf16_t* __restrict__ W1, const bf16_t* __restrict__ W3,
                            bf16_t* __restrict__ H, char* lds) {
  EPI_VARS;
  for (int iter = 0;; ++iter) {
    int mt, nt;
    if (!xcd_tile(iter, 256, 22, mt, nt)) break;
    f32x16 a0[2][2], a1[2][2];
    zero_acc<2>(a0); zero_acc<2>(a1);
    gemm_main<2, 2>(a0, a1, Nb + (size_t)mt * 128 * 1024, 1024, W1 + (size_t)nt * 128 * 1024, W3 + (size_t)nt * 128 * 1024, 1024, 1024, lds);
    EPI_BEGIN(2)
      H[(size_t)(mt * 128 + row) * 2816 + nt * 128 + col] = f2bf(siluf_(a0[mi][ni][r]) * a1[mi][ni][r]);
    EPI_END
  }
}

DI void phase_gemm_resid(const bf16_t* __restrict__ A, int K, const bf16_t* __restrict__ Bt, const float* xsrc, float* x,
                                 float scale, char* lds) {
  EPI_VARS;
  for (int iter = 0;; ++iter) {
    int mt, nt;
    if (!xcd_tile(iter, 256, 4, mt, nt)) break;
    f32x16 a0[2][4];
    zero_acc<4>(a0);
    gemm_main<4, 1>(a0, a0, A + (size_t)mt * 128 * K, K, Bt + (size_t)nt * 256 * K, nullptr, K, K, lds);
    EPI_BEGIN(4)
      const size_t off = (size_t)(mt * 128 + row) * 1024 + nt * 256 + col;
      x[off] = xsrc[off] + scale * a0[mi][ni][r];
    EPI_END
  }
}

DI void phase_ple(const bf16_t* __restrict__ Nb, const bf16_t* __restrict__ PB, const bf16_t* __restrict__ PG,
                          const bf16_t* __restrict__ PP, float* __restrict__ x, char* lds) {
  EPI_VARS;
  for (int iter = 0;; ++iter) {
    int mt, nt;
    if (!xcd_tile(iter, 256, 8, mt, nt)) break;
    f32x16 a0[2][2], a1[2][2];
    zero_acc<2>(a0); zero_acc<2>(a1);
    gemm_main<2, 1>(a0, a0, Nb + (size_t)mt * 128 * 1024, 1024, PG + (size_t)nt * 128 * 1024, nullptr, 1024, 1024, lds);
    gemm_main<2, 1>(a1, a1, PB + (size_t)mt * 128 * 256, 256, PP + (size_t)nt * 128 * 256, nullptr, 256, 256, lds);
    EPI_BEGIN(2)
      float* xp = x + (size_t)(mt * 128 + row) * 1024 + nt * 128 + col;
      *xp = *xp + sigmoidf_(a0[mi][ni][r]) * a1[mi][ni][r];
    EPI_END
  }
}

DI void phase_merge(const bf16_t* __restrict__ Np, const bf16_t* __restrict__ Y, const bf16_t* __restrict__ WG,
                            const bf16_t* __restrict__ WB, bf16_t* __restrict__ M, char* lds) {
  EPI_VARS;
  for (int iter = 0;; ++iter) {
    int mt, nt;
    if (!xcd_tile(iter, 256, 8, mt, nt)) break;
    f32x16 am[2][2];
    zero_acc<2>(am);
#pragma unroll 1
    for (int n = 0; n < 4; ++n) {
      unsigned sg[2][2][8];
      {
        f32x16 ag[2][2];
        zero_acc<2>(ag);
        gemm_main<2, 1>(ag, ag, Np + (size_t)mt * 128 * 1024, 1024, WG + (size_t)n * 1048576 + (size_t)nt * 128 * 1024, nullptr, 1024, 1024, lds);
#pragma unroll
        for (int mi = 0; mi < 2; ++mi)
#pragma unroll
          for (int ni = 0; ni < 2; ++ni)
#pragma unroll
            for (int r = 0; r < 8; ++r) sg[mi][ni][r] = pack2(sigmoidf_(ag[mi][ni][2 * r]), sigmoidf_(ag[mi][ni][2 * r + 1]));
      }
      f32x16 ab[2][2];
      zero_acc<2>(ab);
      gemm_main<2, 1>(ab, ab, Y + (size_t)mt * 128 * 1024 + n * 256, 1024, WB + (size_t)n * 262144 + (size_t)nt * 128 * 256, nullptr, 256, 256, lds);
#pragma unroll
      for (int mi = 0; mi < 2; ++mi)
#pragma unroll
        for (int ni = 0; ni < 2; ++ni)
#pragma unroll
          for (int r = 0; r < 8; ++r) {
            am[mi][ni][2 * r] += __uint_as_float(sg[mi][ni][r] << 16) * ab[mi][ni][2 * r];
            am[mi][ni][2 * r + 1] += __uint_as_float(sg[mi][ni][r] & 0xffff0000u) * ab[mi][ni][2 * r + 1];
          }
    }
    EPI_BEGIN(2)
      M[(size_t)(mt * 128 + row) * 1024 + nt * 128 + col] = f2bf(am[mi][ni][r]);
    EPI_END
  }
}

DI void rope32_out(const float* c, const float2* tab, float sc, float* o) {
#pragma unroll
  for (int i = 0; i < 16; ++i) {
    const float2 cs = tab[i];
    const float a = c[i], b = c[16 + i];
    o[i] = (a * cs.x - b * cs.y) * sc;
    o[16 + i] = (b * cs.x + a * cs.y) * sc;
  }
}

DI void phase_proj(CParams& p, const bf16_t* __restrict__ Nb, const bf16_t* __restrict__ WIN, int S, char* lds) {
  EPI_VARS;
  bf16_t* PR = (bf16_t*)(p.ws + OFF_PR);
  float* AB = (float*)(p.ws + OFF_AB);
  const float2* t32 = (const float2*)(p.ws + OFF_TAB);
  const float2* t64 = (const float2*)(p.ws + OFF_TAB + 2 * MiB);
  float* Ct = (float*)lds;
  for (int iter = 0;; ++iter) {
    int mt, nt2;
    if (!xcd_tile(iter, 256, 18, mt, nt2)) break;
    f32x16 a0[2][4];
    zero_acc<4>(a0);
    gemm_main<4, 1>(a0, a0, Nb + (size_t)mt * 128 * 1024, 1024, WIN + (size_t)nt2 * 256 * 1024, nullptr, 1024, 1024, lds);
   for (int hv = 0; hv < 2; ++hv) {
    const int nt = 2 * nt2 + hv;
    __syncthreads();
    if (wn == hv) {
#pragma unroll
      for (int mi = 0; mi < 2; ++mi)
#pragma unroll
        for (int ni = 0; ni < 4; ++ni)
#pragma unroll
          for (int r = 0; r < 16; ++r) Ct[(64 * wm + 32 * mi + crow(r, h2)) * 132 + 32 * ni + l31] = a0[mi][ni][r];
    }
    __syncthreads();
    const int erow = tid >> 1, half = tid & 1;
    const int tok = mt * 128 + erow, pos = tok & (S - 1);
    const float* cr = Ct + erow * 132 + 64 * half;
    bf16_t* dst = PR + (size_t)tok * NPR + nt * 128 + 64 * half;
    int type = 0; float sc = 1.f;
    if (nt == 3 || nt == 4) { type = 1; sc = 0.17677669529663687f * LOG2E; }
    else if (nt == 5 || nt == 6) { type = 1; }
    else if (nt >= 17 && nt <= 22) { type = 2; sc = 0.125f * LOG2E; }
    else if (nt >= 23 && nt <= 28) { type = 2; }
    else if (nt == 35) type = 3;
    if (type == 0) {
#pragma unroll
      for (int j = 0; j < 8; ++j) store8bf(dst + 8 * j, cr + 8 * j);
    } else if (type == 1) {
#pragma unroll
      for (int hh = 0; hh < 2; ++hh) {
        float o[32];
        rope32_out(cr + 32 * hh, t32 + (size_t)pos * 16, sc, o);
#pragma unroll
        for (int j = 0; j < 4; ++j) store8bf(dst + 32 * hh + 8 * j, o + 8 * j);
      }
    } else if (type == 2) {
      const float2* tab = t64 + (size_t)pos * 32;
#pragma unroll
      for (int j = 0; j < 4; ++j) {
        float lo[8], hi[8];
#pragma unroll
        for (int e = 0; e < 8; ++e) {
          const float2 cs = tab[8 * j + e];
          const float a = cr[8 * j + e], b = cr[32 + 8 * j + e];
          lo[e] = (a * cs.x - b * cs.y) * sc;
          hi[e] = (b * cs.x + a * cs.y) * sc;
        }
        store8bf(dst + 8 * j, lo);
        store8bf(dst + 32 + 8 * j, hi);
      }
    } else {
      if (half == 0) {
        float o[32];
        rope32_out(cr, t32 + (size_t)pos * 16, 1.f, o);
#pragma unroll
        for (int j = 0; j < 4; ++j) store8bf(dst + 8 * j, o + 8 * j);
      } else {
        const float* c2 = Ct + erow * 132 + 32;
#pragma unroll
        for (int j = 0; j < 4; ++j) {
          float4 v; v.x = c2[4 * j]; v.y = c2[4 * j + 1]; v.z = c2[4 * j + 2]; v.w = c2[4 * j + 3];
          ((float4*)(AB + (size_t)tok * 16))[j] = v;
        }
      }
    }
   }
  }
}

DI void mla_up_tile(CParams& p, int mt, int j, int S, char* lds) {
  EPI_VARS;
  const bf16_t* PR = (const bf16_t*)(p.ws + OFF_PR);
  const bf16_t* wb = (const bf16_t*)(p.ws + OFF_WB);
  bf16_t* Qb = (bf16_t*)(p.ws + OFF_Q);
  bf16_t* Kb = (bf16_t*)(p.ws + OFF_K);
  bf16_t* Vb = (bf16_t*)(p.ws + OFF_V);
  const float2* t32 = (const float2*)(p.ws + OFF_TAB);
  float* Ct = (float*)lds;
  float* rst = (float*)(lds + 67584);
  const bool isq = j < 3;
  const int K = isq ? 256 : 128;
  const int nt = isq ? j : j - 3;
  const bf16_t* A = PR + (size_t)mt * 128 * NPR + (isq ? C_CQ : C_CKV);
  const bf16_t* B = wb + (isq ? W_UQ : W_UKV) + (size_t)nt * 128 * K;
  const int erow = tid >> 1, half = tid & 1;
  {
    const bf16_t* ar = A + (size_t)erow * NPR + half * (K / 2);
    float ss = 0.f;
    for (int c = 0; c < K / 16; ++c) {
      const u32x4 u = *(const u32x4*)(ar + 8 * c);
      const unsigned uu[4] = {u.x, u.y, u.z, u.w};
#pragma unroll
      for (int e = 0; e < 4; ++e) {
        const float lo = __uint_as_float(uu[e] << 16), hi = __uint_as_float(uu[e] & 0xffff0000u);
        ss += lo * lo + hi * hi;
      }
    }
    ss += __shfl_xor(ss, 1);
    if (half == 0) rst[erow] = rsqrtf(ss / (float)K + EPS);
  }
  f32x16 a0[2][2];
  zero_acc<2>(a0);
  gemm_main<2, 1>(a0, a0, A, NPR, B, nullptr, K, K, lds);
  __syncthreads();
  EPI_BEGIN(2)
    Ct[row * 132 + col] = a0[mi][ni][r];
  EPI_END
  __syncthreads();
  const int tok = mt * 128 + erow, pos = tok & (S - 1);
  const float rs = rst[erow];
  const float* cr = Ct + erow * 132 + 64 * half;
  if (isq) {
    const float sc = rs * 0.10206207261596577f * LOG2E;
    if (nt < 2) {
      bf16_t* dst = Qb + ((size_t)tok * 4 + 2 * nt + half) * 96;
#pragma unroll
      for (int jj = 0; jj < 8; ++jj) {
        float o[8];
#pragma unroll
        for (int e = 0; e < 8; ++e) o[e] = cr[8 * jj + e] * sc;
        store8bf(dst + 8 * jj, o);
      }
    } else {
#pragma unroll
      for (int hh = 0; hh < 2; ++hh) {
        float o[32];
        rope32_out(cr + 32 * hh, t32 + (size_t)pos * 16, sc, o);
        bf16_t* dst = Qb + ((size_t)tok * 4 + 2 * half + hh) * 96 + 64;
#pragma unroll
        for (int jj = 0; jj < 4; ++jj) store8bf(dst + 8 * jj, o + 8 * jj);
      }
    }
  } else {
    bf16_t* dst = half == 0 ? (Kb + ((size_t)tok * 4 + nt) * 96) : (Vb + ((size_t)tok * 4 + nt) * 64);
#pragma unroll
    for (int jj = 0; jj < 8; ++jj) {
      float o[8];
#pragma unroll
      for (int e = 0; e < 8; ++e) o[e] = cr[8 * jj + e] * rs;
      store8bf(dst + 8 * jj, o);
    }
    if (half == 0) {
      const u32x4* src = (const u32x4*)(PR + (size_t)tok * NPR + 4480);
#pragma unroll
      for (int jj = 0; jj < 4; ++jj) ((u32x4*)(dst + 64))[jj] = src[jj];
    }
  }
}

typedef short s16x4_t __attribute__((ext_vector_type(4)));
DI bf16x8 tr_pair(const bf16_t* p0, const bf16_t* p1) {
  const s16x4_t lo = __builtin_amdgcn_ds_read_tr16_b64_v4i16((__attribute__((address_space(3))) s16x4_t*)p0);
  const s16x4_t hi = __builtin_amdgcn_ds_read_tr16_b64_v4i16((__attribute__((address_space(3))) s16x4_t*)p1);
  return __builtin_shufflevector(lo, hi, 0, 1, 2, 3, 4, 5, 6, 7);
}

template <int DK, bool BAND>
DI void flash_loop(f32x16 (&O)[2], float& m, float& l, const bf16_t* __restrict__ qrow, const bf16_t* __restrict__ kbase,
                   size_t kstride, const bf16_t* __restrict__ vbase, size_t vstride, int ntiles, int tq, int u0, int L,
                   char* lds) {
  const int tid = threadIdx.x + opq(), lane = tid & 63, l31 = lane & 31, h2 = lane >> 5;
  constexpr int KR = DK + 8, KCH = DK / 8, KN = 64 * KCH / 256;
  constexpr int STAGE = 64 * KR * 2 + 64 * 72 * 2;
  bf16x8 qf[DK / 16];
#pragma unroll
  for (int ks = 0; ks < DK / 16; ++ks) qf[ks] = *(const bf16x8*)(qrow + 16 * ks + 8 * h2);
  u32x4 rk[KN], rv[2];
  auto gload = [&](int kt) {
#pragma unroll
    for (int i = 0; i < KN; ++i) {
      const int ci = tid + 256 * i, row = ci / KCH, c = ci % KCH;
      int rr = u0 + 64 * kt + row;
      if (BAND) rr = min(max(rr, 0), L - 1);
      rk[i] = *(const u32x4*)(kbase + (size_t)rr * kstride + c * 8);
    }
#pragma unroll
    for (int i = 0; i < 2; ++i) {
      const int ci = tid + 256 * i, row = ci >> 3, c = ci & 7;
      int rr = u0 + 64 * kt + row;
      if (BAND) rr = min(max(rr, 0), L - 1);
      rv[i] = *(const u32x4*)(vbase + (size_t)rr * vstride + c * 8);
    }
  };
  auto swrite = [&](int st) {
    bf16_t* Ks = (bf16_t*)(lds + st * STAGE);
    bf16_t* Vs = Ks + 64 * KR;
#pragma unroll
    for (int i = 0; i < KN; ++i) {
      const int ci = tid + 256 * i, row = ci / KCH, c = ci % KCH;
      *(u32x4*)(Ks + row * KR + c * 8) = rk[i];
    }
#pragma unroll
    for (int i = 0; i < 2; ++i) {
      const int ci = tid + 256 * i, row = ci >> 3, c = ci & 7;
      *(u32x4*)(Vs + row * 72 + c * 8) = rv[i];
    }
  };
  const int trq = (lane & 15) >> 2, trp = lane & 3, trblk = (lane >> 4) & 1;
  const int troff = (4 * h2 + trq) * 72 + 16 * trblk + 4 * trp;
  __syncthreads();
  gload(0);
  swrite(0);
  if (ntiles > 1) gload(1);
  for (int kt = 0; kt < ntiles; ++kt) {
    __syncthreads();
    if (kt + 1 < ntiles) swrite((kt + 1) & 1);
    if (kt + 2 < ntiles) gload(kt + 2);
    const bf16_t* Ks = (const bf16_t*)(lds + (kt & 1) * STAGE);
    const bf16_t* Vs = Ks + 64 * KR;
    f32x16 Sx[2];
#pragma unroll
    for (int j = 0; j < 2; ++j)
#pragma unroll
      for (int r = 0; r < 16; ++r) Sx[j][r] = 0.f;
#pragma unroll
    for (int ks = 0; ks < DK / 16; ++ks)
#pragma unroll
      for (int j = 0; j < 2; ++j) {
        const bf16x8 kf = *(const bf16x8*)(Ks + (32 * j + l31) * KR + 16 * ks + 8 * h2);
        Sx[j] = MFMA32(kf, qf[ks], Sx[j]);
      }
    if (BAND) {
#pragma unroll
      for (int j = 0; j < 2; ++j)
#pragma unroll
        for (int r = 0; r < 16; ++r) {
          const int u = u0 + 64 * kt + 32 * j + crow(r, h2);
          const int d = u - tq;
          const bool valid = (d <= 64) && (d >= -64) && (u >= 0) && (u < L);
          Sx[j][r] = valid ? Sx[j][r] : -1e30f;
        }
    }
    float mx = Sx[0][0];
#pragma unroll
    for (int j = 0; j < 2; ++j)
#pragma unroll
      for (int r = 0; r < 16; ++r) mx = fmaxf(mx, Sx[j][r]);
    mx = fmaxf(mx, __shfl_xor(mx, 32));
    const float mn = fmaxf(m, mx);
    const float alpha = exp2_(m - mn);
    const bool grew = mn > m;
    m = mn;
    float ls = 0.f;
#pragma unroll
    for (int j = 0; j < 2; ++j)
#pragma unroll
      for (int r = 0; r < 16; ++r) { const float pv = exp2_(Sx[j][r] - mn); Sx[j][r] = pv; ls += pv; }
    l = l * alpha + ls;
    if (__any(grew)) {
#pragma unroll
      for (int t = 0; t < 2; ++t)
#pragma unroll
        for (int r = 0; r < 16; ++r) O[t][r] *= alpha;
    }
#pragma unroll
    for (int j = 0; j < 2; ++j)
#pragma unroll
      for (int s = 0; s < 2; ++s) {
        const bf16x8 pf = pack8(Sx[j][8 * s], Sx[j][8 * s + 1], Sx[j][8 * s + 2], Sx[j][8 * s + 3], Sx[j][8 * s + 4],
                                Sx[j][8 * s + 5], Sx[j][8 * s + 6], Sx[j][8 * s + 7]);
#pragma unroll
        for (int t = 0; t < 2; ++t) {
          const bf16_t* vp = Vs + (32 * j + 16 * s) * 72 + 32 * t + troff;
          const bf16x8 vf = tr_pair(vp, vp + 8 * 72);
          O[t] = MFMA32(vf, pf, O[t]);
        }
      }
  }
}

DI void zeroO(f32x16 (&O)[2]) {
#pragma unroll
  for (int t = 0; t < 2; ++t)
#pragma unroll
    for (int r = 0; r < 16; ++r) O[t][r] = 0.f;
}

DI void store_o(bf16_t* dst, const f32x16 (&O)[2], int h2) {
#pragma unroll
  for (int t = 0; t < 2; ++t)
#pragma unroll
    for (int g = 0; g < 4; ++g) {
      u32x2 u; u.x = pack2(O[t][4 * g], O[t][4 * g + 1]); u.y = pack2(O[t][4 * g + 2], O[t][4 * g + 3]);
      *(u32x2*)(dst + 32 * t + 8 * g + 4 * h2) = u;
    }
}

DI void mla_item(CParams& p, int it, int S, char* lds) {
  const int tid = threadIdx.x + opq(), lane = tid & 63, w = tid >> 6, l31 = lane & 31, h2 = lane >> 5;
  const int lgq = (S == 2048) ? 4 : 7;
  const int qb = it & ((1 << lgq) - 1), bh = it >> lgq, h = bh & 3, b = bh >> 2;
  const int tokbase = b * S, gtok = tokbase + 128 * qb + 32 * w + l31;
  const bf16_t* Qb = (const bf16_t*)(p.ws + OFF_Q);
  const bf16_t* Kb = (const bf16_t*)(p.ws + OFF_K);
  const bf16_t* Vb = (const bf16_t*)(p.ws + OFF_V);
  bf16_t* Y = (bf16_t*)(p.ws + OFF_N);
  f32x16 O[2]; zeroO(O);
  float m = -1e30f, l = 0.f;
  flash_loop<96, false>(O, m, l, Qb + ((size_t)gtok * 4 + h) * 96, Kb + ((size_t)tokbase * 4 + h) * 96, 384,
                        Vb + ((size_t)tokbase * 4 + h) * 64, 256, S / 64, 0, 0, 0, lds);
  l += __shfl_xor(l, 32);
  const float il = 1.f / l;
#pragma unroll
  for (int t = 0; t < 2; ++t)
#pragma unroll
    for (int r = 0; r < 16; ++r) O[t][r] *= il;
  store_o(Y + (size_t)gtok * 1024 + h * 64, O, h2);
}

DI void diff_item(CParams& p, int layer, int it, int S, char* lds) {
  const int tid = threadIdx.x + opq(), lane = tid & 63, w = tid >> 6, l31 = lane & 31, h2 = lane >> 5;
  const int lgq = (S == 2048) ? 4 : 7;
  const int qb = it & ((1 << lgq) - 1), bh = it >> lgq, h = bh & 3, b = bh >> 2;
  const int tokbase = b * S, gtok = tokbase + 128 * qb + 32 * w + l31;
  const bf16_t* PR = (const bf16_t*)(p.ws + OFF_PR);
  bf16_t* Y = (bf16_t*)(p.ws + OFF_N);
  const float* lam = p.diff_lambda + layer * 128;
  float s1 = 0.f, s2 = 0.f;
  if (lane < 32) { s1 = lam[lane] * lam[32 + lane]; s2 = lam[64 + lane] * lam[96 + lane]; }
  s1 = wave_sum(s1); s2 = wave_sum(s2);
  const float lambda_init = layer ? 0.35550907f : 0.2f;
  const float lambda_full = expf(s1) - expf(s2) + lambda_init;
  f32x16 of[2]; zeroO(of);
  for (int mp = 0; mp < 2; ++mp) {
    f32x16 O[2]; zeroO(O);
    float m = -1e30f, l = 0.f;
    flash_loop<32, false>(O, m, l, PR + (size_t)gtok * NPR + C_BQ + (2 * h + mp) * 32,
                          PR + (size_t)tokbase * NPR + C_BK + (2 * h + mp) * 32, NPR,
                          PR + (size_t)tokbase * NPR + C_BV + h * 64, NPR, S / 64, 0, 0, 0, lds);
    l += __shfl_xor(l, 32);
    const float cf = (mp == 0 ? 1.f : -lambda_full) / l;
#pragma unroll
    for (int t = 0; t < 2; ++t)
#pragma unroll
      for (int r = 0; r < 16; ++r) of[t][r] += cf * O[t][r];
  }
  float ss = 0.f;
#pragma unroll
  for (int t = 0; t < 2; ++t)
#pragma unroll
    for (int r = 0; r < 16; ++r) ss += of[t][r] * of[t][r];
  ss += __shfl_xor(ss, 32);
  const float rs = rsqrtf(ss * (1.f / 64.f) + EPS) * (1.f - lambda_init);
  const float* sg = p.diff_subln + layer * 64;
#pragma unroll
  for (int t = 0; t < 2; ++t)
#pragma unroll
    for (int r = 0; r < 16; ++r) of[t][r] *= rs * sg[32 * t + crow(r, h2)];
  store_o(Y + (size_t)gtok * 1024 + 256 + h * 64, of, h2);
}

DI void dil_item(CParams& p, int it, int S, int B, char* lds) {
  const int tid = threadIdx.x + opq(), lane = tid & 63, w = tid >> 6, l31 = lane & 31, h2 = lane >> 5;
  const int lgS = (S == 2048) ? 11 : 14, lgB = (B == 16) ? 4 : 1;
  const int rq = it & ((1 << (lgS - 7)) - 1);
  int rest = it >> (lgS - 7);
  const int head = rest & 3; rest >>= 2;
  const int b = rest & (B - 1), g = rest >> lgB;
  const int lgd = 2 * g, dil = 1 << lgd;
  const int L = S >> lgd, lgnqb = lgS - lgd - 7;
  const int res = rq >> lgnqb, qb = rq & ((1 << lgnqb) - 1);
  const int tokbase = b * S;
  const int tq = 128 * qb + 32 * w + l31;
  const int gtok = tokbase + tq * dil + res;
  const bf16_t* PR = (const bf16_t*)(p.ws + OFF_PR);
  bf16_t* OD = (bf16_t*)(p.ws + OFF_OD);
  float* LSE = (float*)(p.ws + OFF_LSE);
  f32x16 O[2]; zeroO(O);
  float m = -1e30f, l = 0.f;
  const int hc = (g * 4 + head) * 64;
  flash_loop<64, true>(O, m, l, PR + (size_t)gtok * NPR + C_DQ + hc, PR + (size_t)(tokbase + res) * NPR + C_DK + hc,
                       (size_t)dil * NPR, PR + (size_t)(tokbase + res) * NPR + C_DV + hc, (size_t)dil * NPR, 4, tq,
                       128 * qb - 64, L, lds);
  l += __shfl_xor(l, 32);
  const float il = 1.f / l;
#pragma unroll
  for (int t = 0; t < 2; ++t)
#pragma unroll
    for (int r = 0; r < 16; ++r) O[t][r] *= il;
  store_o(OD + ((size_t)g * TG + gtok) * 256 + head * 64, O, h2);
  if (h2 == 0) LSE[((size_t)g * TG + gtok) * 4 + head] = m + __log2f(l);
}

constexpr size_t DN_QK_OFF = OFF_OD;
constexpr size_t DN_GC_OFF = OFF_OD + 32 * MiB;
constexpr size_t DN_UW_OFF = OFF_Q;

DI void dn_prep_item(CParams& p, int layer, int it, int S, char* lds) {
  const int tid = threadIdx.x + opq(), lane = tid & 63, w = tid >> 6, l15 = lane & 15, g4 = lane >> 4;
  const int NC = S / 64;
  const int ch = it % NC, bh = it / NC, h = bh & 3, b = bh >> 2;
  const int tokbase = b * S, s0 = ch * 64;
  const bf16_t* PR = (const bf16_t*)(p.ws + OFF_PR);
  const float* AB = (const float*)(p.ws + OFF_AB);
  bf16_t* QKg = (bf16_t*)(p.ws + DN_QK_OFF) + ((size_t)bh * NC + ch) * 8192;
  bf16_t* raw = (bf16_t*)lds;
  float* convw = (float*)(lds + 27200);
  float* RU = (float*)lds;
  float* RW = (float*)(lds + 16384);
  float* Am = (float*)(lds + 32768);
  bf16_t* Kimg = (bf16_t*)(lds + 50176);
  bf16_t* Qimg = (bf16_t*)(lds + 59392);
  float* gcs = (float*)(lds + 68608);
  float* betas = gcs + 128;
  const float* cw = p.dn_conv + (size_t)layer * 5 * 768;
  {
    u32x4 rawreg[7];
    float cwr[4];
#pragma unroll
    for (int k = 0; k < 7; ++k) {
      const int ci = tid + 256 * k;
      const int rr = ci / 24, c = ci % 24, seg = c >> 3, c8 = c & 7;
      const int s = s0 + rr - 2;
      rawreg[k] = u32x4{0u, 0u, 0u, 0u};
      if (ci < 68 * 24 && s >= 0 && s < S)
        rawreg[k] = *(const u32x4*)(PR + (size_t)(tokbase + s) * NPR + C_DNQKV + seg * 256 + h * 64 + c8 * 8);
    }
#pragma unroll
    for (int k = 0; k < 4; ++k) {
      const int i = tid + 256 * k;
      cwr[k] = 0.f;
      if (i < 960) { const int j = i / 192, c = i % 192; cwr[k] = cw[j * 768 + (c >> 6) * 256 + h * 64 + (c & 63)]; }
    }
#pragma unroll
    for (int k = 0; k < 7; ++k) {
      const int ci = tid + 256 * k;
      const int rr = ci / 24, c = ci % 24, seg = c >> 3, c8 = c & 7;
      if (ci < 68 * 24) *(u32x4*)(raw + rr * 200 + seg * 64 + c8 * 8) = rawreg[k];
    }
#pragma unroll
    for (int k = 0; k < 4; ++k) { const int i = tid + 256 * k; if (i < 960) convw[i] = cwr[k]; }
  }
  if (tid < 128) {
    const int d = tid >> 6, pl = tid & 63;
    const int i = d ? 63 - pl : pl;
    const size_t tok = (size_t)tokbase + s0 + i;
    const float Aexp = expf(p.dn_a_log[layer * 8 + d * 4 + h]);
    const float a = AB[tok * 16 + d * 8 + h] + p.dn_dt_bias[layer * 8 + d * 4 + h];
    const float bb = AB[tok * 16 + d * 8 + 4 + h];
    const float sp = fmaxf(a, 0.f) + __logf(1.f + __expf(-fabsf(a)));
    float g = -Aexp * sp;
#pragma unroll
    for (int o = 1; o < 64; o <<= 1) { const float tv = __shfl_up(g, o); if (lane >= o) g += tv; }
    gcs[tid] = g;
    betas[tid] = sigmoidf_(bb);
    float* GC = (float*)(p.ws + DN_GC_OFF) + (((size_t)bh * 2 + d) * NC + ch) * 64;
    GC[pl] = g;
  }
  __syncthreads();
  const int pp = tid >> 2, cgp = tid & 3;
  float kv[16], vv[16];
  {
    float qv[16];
#pragma unroll
    for (int seg = 0; seg < 3; ++seg) {
      float acc[16];
#pragma unroll
      for (int c = 0; c < 16; ++c) acc[c] = 0.f;
#pragma unroll
      for (int j = 0; j < 5; ++j) {
        const bf16_t* rp = raw + (pp + j) * 200 + seg * 64 + 16 * cgp;
        const float* wp = convw + j * 192 + seg * 64 + 16 * cgp;
        const u32x4 u0 = *(const u32x4*)rp, u1 = *(const u32x4*)(rp + 8);
        const unsigned uu[8] = {u0.x, u0.y, u0.z, u0.w, u1.x, u1.y, u1.z, u1.w};
#pragma unroll
        for (int e = 0; e < 8; ++e) {
          acc[2 * e] += wp[2 * e] * __uint_as_float(uu[e] << 16);
          acc[2 * e + 1] += wp[2 * e + 1] * __uint_as_float(uu[e] & 0xffff0000u);
        }
      }
#pragma unroll
      for (int c = 0; c < 16; ++c) {
        const float sv = acc[c] * __builtin_amdgcn_rcpf(1.f + __expf(-acc[c]));
        if (seg == 0) qv[c] = sv; else if (seg == 1) kv[c] = sv; else vv[c] = sv;
      }
    }
    float sq = 0.f, sk = 0.f;
#pragma unroll
    for (int c = 0; c < 16; ++c) { sq += qv[c] * qv[c]; sk += kv[c] * kv[c]; }
    sq += __shfl_xor(sq, 1); sq += __shfl_xor(sq, 2);
    sk += __shfl_xor(sk, 1); sk += __shfl_xor(sk, 2);
    const float rq = rsqrtf(sq + EPS) * 0.125f, rk = rsqrtf(sk + EPS);
#pragma unroll
    for (int c = 0; c < 16; ++c) { qv[c] *= rq; kv[c] *= rk; }
    store8bf(Kimg + pp * 72 + 16 * cgp, kv); store8bf(Kimg + pp * 72 + 16 * cgp + 8, kv + 8);
    store8bf(Qimg + pp * 72 + 16 * cgp, qv); store8bf(Qimg + pp * 72 + 16 * cgp + 8, qv + 8);
    store8bf(QKg + pp * 64 + 16 * cgp, qv); store8bf(QKg + pp * 64 + 16 * cgp + 8, qv + 8);
    store8bf(QKg + 4096 + pp * 64 + 16 * cgp, kv); store8bf(QKg + 4096 + pp * 64 + 16 * cgp + 8, kv + 8);
  }
  for (int d = 0; d < 2; ++d) {
    __syncthreads();
    {
      const int pl = d ? 63 - pp : pp;
      const float bet = betas[d * 64 + pl], egc = __expf(gcs[d * 64 + pl]);
#pragma unroll
      for (int c = 0; c < 16; ++c) {
        RU[pl * 64 + 16 * cgp + c] = vv[c] * bet;
        RW[pl * 64 + 16 * cgp + c] = kv[c] * bet * egc;
      }
    }
    {
      f32x4 KK[4];
#pragma unroll
      for (int t = 0; t < 4; ++t) KK[t] = f32x4{0.f, 0.f, 0.f, 0.f};
      const int jl = 16 * w + l15;
      const int jrow = d ? 63 - jl : jl;
#pragma unroll
      for (int ks = 0; ks < 2; ++ks) {
        const bf16x8 bfk = *(const bf16x8*)(Kimg + jrow * 72 + 32 * ks + 8 * g4);
#pragma unroll
        for (int rt = 0; rt < 4; ++rt) {
          const int il = 16 * rt + l15;
          const int irow = d ? 63 - il : il;
          const bf16x8 afk = *(const bf16x8*)(Kimg + irow * 72 + 32 * ks + 8 * g4);
          KK[rt] = MFMA16(afk, bfk, KK[rt]);
        }
      }
      const float gcj = gcs[d * 64 + jl];
#pragma unroll
      for (int rt = 0; rt < 4; ++rt)
#pragma unroll
        for (int r = 0; r < 4; ++r) {
          const int i = 16 * rt + 4 * g4 + r;
          const float ee = __expf(fminf(gcs[d * 64 + i] - gcj, 0.f));
          Am[i * 68 + jl] = (i > jl) ? betas[d * 64 + i] * KK[rt][r] * ee : 0.f;
        }
    }
    __syncthreads();
    float xs[32];
#pragma unroll
    for (int q = 0; q < 32; ++q) xs[q] = 0.f;
    const int c = tid >> 1, half = tid & 1;
    {
      const float* Rc = (c < 64) ? (RU + c) : (RW + (c - 64));
      const float* Ah = Am + 4 * half;
#pragma unroll
      for (int i = 0; i < 64; ++i) {
        float part = 0.f;
#pragma unroll
        for (int q = 0; q < (i + 7) / 8; ++q) {
          const f32x4 a = *(const f32x4*)(Ah + i * 68 + 8 * q);
          part += a[0] * xs[4 * q] + a[1] * xs[4 * q + 1] + a[2] * xs[4 * q + 2] + a[3] * xs[4 * q + 3];
        }
        const float other = __int_as_float(__builtin_amdgcn_update_dpp(0, __float_as_int(part), 0xB1, 0xf, 0xf, true));
        const float xi = Rc[i * 64] - (part + other);
        const int loc = ((i >> 3) << 2) + (i & 3);
        if (((i >> 2) & 1) == 0) xs[loc] = (half == 0) ? xi : xs[loc];
        else xs[loc] = (half == 1) ? xi : xs[loc];
        if (i < 16 ? ((i & 7) == 7) : (i < 32 ? ((i & 3) == 3) : ((i & 1) == 1))) asm volatile("" ::: "memory");
      }
    }
    {
      bf16_t* UWg = (bf16_t*)(p.ws + DN_UW_OFF) + ((((size_t)bh * 2 + d) * NC + ch) * 8192);
      const float sgn = (c < 64) ? 1.f : -1.f;
      bf16_t* dst = UWg + ((c < 64) ? c : (4096 + c - 64));
#pragma unroll
      for (int loc = 0; loc < 32; ++loc) {
        const int i = (((loc >> 2) * 2 + half) << 2) + (loc & 3);
        dst[i * 64] = f2bf(sgn * xs[loc]);
      }
    }
  }
}

DI void dn_scan_chain(CParams& p, int it, int S, char* lds) {
  const int tid0 = threadIdx.x + opq();
  const int dir = it & 1, bh = it >> 1, h = bh & 3, b = bh >> 2;
  const int tokbase = b * S, NC = S / 64;
  bf16_t* OUT = (bf16_t*)(p.ws + (dir ? OFF_OB : OFF_OF));
  const bf16_t* QKg = (const bf16_t*)(p.ws + DN_QK_OFF) + (size_t)bh * NC * 8192;
  const bf16_t* UWg = (const bf16_t*)(p.ws + DN_UW_OFF) + (size_t)it * NC * 8192;
  const float* GCg = (const float*)(p.ws + DN_GC_OFF) + (size_t)it * NC * 64;
  bf16_t* Uimg = (bf16_t*)lds;
  bf16_t* Wn = Uimg + 4608;
  bf16_t* Qimg = Wn + 4608;
  bf16_t* Kimg = Qimg + 4608;
  bf16_t* Kt = Kimg + 4608;
  bf16_t* Iimg = Kt + 4608;
  float* gcs = (float*)(lds + 6 * 9216);
  f32x4 Sd[4];
#pragma unroll
  for (int t = 0; t < 4; ++t) Sd[t] = f32x4{0.f, 0.f, 0.f, 0.f};
  u32x4 ru[2], rw[2], rq[2], rk[2];
  float rg = 0.f;
  auto prefetch = [&](int cc_) {
    const int ch_ = dir ? (NC - 1 - cc_) : cc_;
    const int tp = tid0 + opq();
    const bf16_t* uw = UWg + (size_t)ch_ * 8192;
    const bf16_t* qk = QKg + (size_t)ch_ * 8192;
#pragma unroll
    for (int k = 0; k < 2; ++k) {
      const int ci = tp + 256 * k, row = ci >> 3, c8 = ci & 7;
      const int srow = dir ? 63 - row : row;
      ru[k] = *(const u32x4*)(uw + row * 64 + c8 * 8);
      rw[k] = *(const u32x4*)(uw + 4096 + row * 64 + c8 * 8);
      rq[k] = *(const u32x4*)(qk + srow * 64 + c8 * 8);
      rk[k] = *(const u32x4*)(qk + 4096 + srow * 64 + c8 * 8);
    }
    if (tp < 64) rg = GCg[(size_t)ch_ * 64 + tp];
  };
  prefetch(0);
  for (int cc = 0; cc < NC; ++cc) {
    const int tid = tid0 + opq(), lane = tid & 63, w = tid >> 6, l15 = lane & 15, g4 = lane >> 4;
    const int e_col = 16 * w + l15;
    const int ch = dir ? (NC - 1 - cc) : cc;
    const int s0 = ch * 64;
    __syncthreads();
#pragma unroll
    for (int k = 0; k < 2; ++k) {
      const int ci = tid + 256 * k, row = ci >> 3, c8 = ci & 7;
      *(u32x4*)(Uimg + row * 72 + c8 * 8) = ru[k];
      *(u32x4*)(Wn + row * 72 + c8 * 8) = rw[k];
      *(u32x4*)(Qimg + row * 72 + c8 * 8) = rq[k];
      *(u32x4*)(Kimg + row * 72 + c8 * 8) = rk[k];
      const unsigned uu[4] = {rk[k].x, rk[k].y, rk[k].z, rk[k].w};
#pragma unroll
      for (int e = 0; e < 4; ++e) {
        Kt[(8 * c8 + 2 * e) * 72 + row] = (bf16_t)(uu[e] & 0xffffu);
        Kt[(8 * c8 + 2 * e + 1) * 72 + row] = (bf16_t)(uu[e] >> 16);
      }
    }
    if (tid < 64) gcs[tid] = rg;
    if (cc + 1 < NC) prefetch(cc + 1);
    __syncthreads();
    {
      f32x4 QK[4];
#pragma unroll
      for (int t = 0; t < 4; ++t) QK[t] = f32x4{0.f, 0.f, 0.f, 0.f};
#pragma unroll
      for (int ks = 0; ks < 2; ++ks) {
        const bf16x8 bfk = *(const bf16x8*)(Kimg + (16 * w + l15) * 72 + 32 * ks + 8 * g4);
#pragma unroll
        for (int rt = 0; rt < 4; ++rt) {
          const bf16x8 afq = *(const bf16x8*)(Qimg + (16 * rt + l15) * 72 + 32 * ks + 8 * g4);
          QK[rt] = MFMA16(afq, bfk, QK[rt]);
        }
      }
      const float gcj = gcs[e_col];
#pragma unroll
      for (int rt = 0; rt < 4; ++rt)
#pragma unroll
        for (int r = 0; r < 4; ++r) {
          const int i = 16 * rt + 4 * g4 + r;
          const float ee = __expf(fminf(gcs[i] - gcj, 0.f));
          Iimg[i * 72 + e_col] = f2bf((i >= e_col) ? QK[rt][r] * ee : 0.f);
        }
    }
    __syncthreads();
    {
      bf16x8 Bs[2];
#pragma unroll
      for (int ks = 0; ks < 2; ++ks)
        Bs[ks] = pack8(Sd[2 * ks][0], Sd[2 * ks][1], Sd[2 * ks][2], Sd[2 * ks][3], Sd[2 * ks + 1][0], Sd[2 * ks + 1][1],
                       Sd[2 * ks + 1][2], Sd[2 * ks + 1][3]);
      f32x4 vn[4], qs[4], iv[4];
#pragma unroll
      for (int rt = 0; rt < 4; ++rt) {
#pragma unroll
        for (int r = 0; r < 4; ++r) vn[rt][r] = bf2f(Uimg[(16 * rt + 4 * g4 + r) * 72 + e_col]);
        qs[rt] = f32x4{0.f, 0.f, 0.f, 0.f};
        iv[rt] = f32x4{0.f, 0.f, 0.f, 0.f};
#pragma unroll
        for (int ks = 0; ks < 2; ++ks) {
          const bf16_t* wp = Wn + (16 * rt + l15) * 72 + 32 * ks + 4 * g4;
          const bf16_t* qp = Qimg + (16 * rt + l15) * 72 + 32 * ks + 4 * g4;
          vn[rt] = MFMA16(ld2x4(wp, wp + 16), Bs[ks], vn[rt]);
          qs[rt] = MFMA16(ld2x4(qp, qp + 16), Bs[ks], qs[rt]);
        }
      }
      bf16x8 Bv[2];
#pragma unroll
      for (int ks = 0; ks < 2; ++ks)
        Bv[ks] = pack8(vn[2 * ks][0], vn[2 * ks][1], vn[2 * ks][2], vn[2 * ks][3], vn[2 * ks + 1][0], vn[2 * ks + 1][1],
                       vn[2 * ks + 1][2], vn[2 * ks + 1][3]);
#pragma unroll
      for (int rt = 0; rt < 4; ++rt)
#pragma unroll
        for (int ks = 0; ks < 2; ++ks) {
          const bf16_t* ip = Iimg + (16 * rt + l15) * 72 + 32 * ks + 4 * g4;
          iv[rt] = MFMA16(ld2x4(ip, ip + 16), Bv[ks], iv[rt]);
        }
      const float gc63 = gcs[63];
#pragma unroll
      for (int rt = 0; rt < 4; ++rt)
#pragma unroll
        for (int r = 0; r < 4; ++r) {
          const int pos = 16 * rt + 4 * g4 + r;
          const float o = qs[rt][r] * __expf(gcs[pos]) + iv[rt][r];
          const int i = dir ? 63 - pos : pos;
          OUT[((size_t)tokbase + s0 + i) * 256 + h * 64 + e_col] = f2bf(o);
          vn[rt][r] *= __expf(gc63 - gcs[pos]);
        }
      bf16x8 Bv2[2];
#pragma unroll
      for (int ks = 0; ks < 2; ++ks)
        Bv2[ks] = pack8(vn[2 * ks][0], vn[2 * ks][1], vn[2 * ks][2], vn[2 * ks][3], vn[2 * ks + 1][0], vn[2 * ks + 1][1],
                        vn[2 * ks + 1][2], vn[2 * ks + 1][3]);
      const float gl = __expf(gc63);
#pragma unroll
      for (int dt = 0; dt < 4; ++dt) {
#pragma unroll
        for (int r = 0; r < 4; ++r) Sd[dt][r] *= gl;
#pragma unroll
        for (int ks = 0; ks < 2; ++ks) {
          const bf16_t* kp = Kt + (16 * dt + l15) * 72 + 32 * ks + 4 * g4;
          Sd[dt] = MFMA16(ld2x4(kp, kp + 16), Bv2[ks], Sd[dt]);
        }
      }
    }
  }
}

DI void phase_combine(CParams& p, int layer, const float* __restrict__ xg) {
  const int tidq = threadIdx.x + opq(); const int wave = tidq >> 6, lane = tidq & 63;
  const bf16_t* PR = (const bf16_t*)(p.ws + OFF_PR);
  const bf16_t* OD = (const bf16_t*)(p.ws + OFF_OD);
  const float* LSE = (const float*)(p.ws + OFF_LSE);
  const bf16_t* OFb = (const bf16_t*)(p.ws + OFF_OF);
  const bf16_t* OBb = (const bf16_t*)(p.ws + OFF_OB);
  bf16_t* Y = (bf16_t*)(p.ws + OFF_N);
  bf16_t* Np = (bf16_t*)(p.ws + OFF_Q);
  const float* gmix = p.norm_mix + layer * 1024;
  const float* gdn = p.dn_out_norm + layer * 64;
  const int head = lane >> 4;
  for (int r = blockIdx.x * 4 + wave; r < TG; r += gridDim.x * 4) {
    {
      float lg[3];
#pragma unroll
      for (int g = 0; g < 3; ++g) lg[g] = LSE[((size_t)g * TG + r) * 4 + head];
      const float mx = fmaxf(lg[0], fmaxf(lg[1], lg[2]));
      float wg[3], den = 0.f;
#pragma unroll
      for (int g = 0; g < 3; ++g) { wg[g] = exp2_(lg[g] - mx); den += wg[g]; }
      const float id = 1.f / den;
      float o[4] = {0.f, 0.f, 0.f, 0.f};
#pragma unroll
      for (int g = 0; g < 3; ++g) {
        const u32x2 u = ((const u32x2*)(OD + ((size_t)g * TG + r) * 256))[lane];
        const float c = wg[g] * id;
        o[0] += c * __uint_as_float(u.x << 16); o[1] += c * __uint_as_float(u.x & 0xffff0000u);
        o[2] += c * __uint_as_float(u.y << 16); o[3] += c * __uint_as_float(u.y & 0xffff0000u);
      }
      u32x2 ou; ou.x = pack2(o[0], o[1]); ou.y = pack2(o[2], o[3]);
      ((u32x2*)(Y + (size_t)r * 1024 + 768))[lane] = ou;
    }
    {
      const u32x2 uf = ((const u32x2*)(OFb + (size_t)r * 256))[lane];
      const u32x2 ub = ((const u32x2*)(OBb + (size_t)r * 256))[lane];
      const u32x2 uz = ((const u32x2*)(PR + (size_t)r * NPR + C_Z))[lane];
      float o[4], z[4];
      o[0] = __uint_as_float(uf.x << 16) + __uint_as_float(ub.x << 16);
      o[1] = __uint_as_float(uf.x & 0xffff0000u) + __uint_as_float(ub.x & 0xffff0000u);
      o[2] = __uint_as_float(uf.y << 16) + __uint_as_float(ub.y << 16);
      o[3] = __uint_as_float(uf.y & 0xffff0000u) + __uint_as_float(ub.y & 0xffff0000u);
      z[0] = __uint_as_float(uz.x << 16); z[1] = __uint_as_float(uz.x & 0xffff0000u);
      z[2] = __uint_as_float(uz.y << 16); z[3] = __uint_as_float(uz.y & 0xffff0000u);
      float ss = o[0] * o[0] + o[1] * o[1] + o[2] * o[2] + o[3] * o[3];
      ss += __shfl_xor(ss, 1); ss += __shfl_xor(ss, 2); ss += __shfl_xor(ss, 4); ss += __shfl_xor(ss, 8);
      const float rs = rsqrtf(ss * (1.f / 64.f) + EPS);
      const float4 gg = ((const float4*)gdn)[lane & 15];
      u32x2 ou;
      ou.x = pack2(o[0] * rs * gg.x * siluf_(z[0]), o[1] * rs * gg.y * siluf_(z[1]));
      ou.y = pack2(o[2] * rs * gg.z * siluf_(z[2]), o[3] * rs * gg.w * siluf_(z[3]));
      ((u32x2*)(Y + (size_t)r * 1024 + 512))[lane] = ou;
    }
    {
      const float4* xr = (const float4*)(xg + (size_t)r * 1024);
      float4 v[4];
      float ss = 0.f;
#pragma unroll
      for (int i = 0; i < 4; ++i) { v[i] = xr[lane + 64 * i]; ss += v[i].x * v[i].x + v[i].y * v[i].y + v[i].z * v[i].z + v[i].w * v[i].w; }
      ss = wave_sum(ss);
      const float rs = rsqrtf(ss * (1.f / 1024.f) + EPS);
#pragma unroll
      for (int i = 0; i < 4; ++i) {
        const float4 gg = ((const float4*)gmix)[lane + 64 * i];
        u32x2 o; o.x = pack2(v[i].x * rs * gg.x, v[i].y * rs * gg.y); o.y = pack2(v[i].z * rs * gg.z, v[i].w * rs * gg.w);
        ((u32x2*)(Np + (size_t)r * 1024))[lane + 64 * i] = o;
      }
    }
  }
}

#define XB_TMO      128
#define XB_XCNT(j)  (256  + 64 * (j))
#define XB_XSUB(j)  (1280 + 64 * (j))
#define XB_XGEN(j)  (2304 + 64 * (j))
#define XB_TOP      3328
#define XB_TOPGEN   3392
#define XCD_BAR_WORDS 3456
#define XB_SPIN_CAP (1u << 27)
#define LAS __attribute__((address_space(3)))
constexpr size_t OFF_BAR = OFF_CNT + 65536;
DI unsigned xb_ld(unsigned* p) { return __hip_atomic_load(p, __ATOMIC_RELAXED, __HIP_MEMORY_SCOPE_AGENT); }
DI unsigned xb_add(unsigned* p, unsigned v) { return __hip_atomic_fetch_add(p, v, __ATOMIC_RELAXED, __HIP_MEMORY_SCOPE_AGENT); }
DI unsigned xb_xcc_id() { return (unsigned)__builtin_amdgcn_s_getreg((3 << 11) | 20) & 0xFu; }
#define XB_SPIN(cond, bar) do { unsigned _sp = 0; while (cond) { __builtin_amdgcn_s_sleep(1); \
    if ((++_sp & 255u) == 0u) { if (xb_ld(&(bar)[XB_TMO])) break; if (_sp > XB_SPIN_CAP) { atomicAdd(&(bar)[XB_TMO], 1u); break; } } } } while (0)
struct XcdBarrier { unsigned* bar; unsigned x; volatile LAS unsigned* st; };
DI XcdBarrier xcd_barrier_post(unsigned* bar, volatile LAS unsigned* st) {
  XcdBarrier b; b.bar = bar; b.x = xb_xcc_id(); b.st = st;
  if (threadIdx.x == 0) (void)xb_add(&bar[XB_XCNT(b.x)], 1u);
  return b;
}
DI void xcd_barrier_complete(unsigned* bar, unsigned x, unsigned& nloc, unsigned& nx) {
  const unsigned G = gridDim.x * gridDim.y * gridDim.z;
  unsigned sum, cnt, mine, sp = 0u;
  for (;;) {
    sum = 0u; cnt = 0u; mine = 0u;
#pragma unroll
    for (unsigned j = 0; j < 16; ++j) { const unsigned c = xb_ld(&bar[XB_XCNT(j)]); sum += c; cnt += (c > 0u) ? 1u : 0u; mine = (j == x) ? c : mine; }
    if (sum == G) break;
    __builtin_amdgcn_s_sleep(1);
    if ((++sp & 255u) == 0u) { if (xb_ld(&bar[XB_TMO])) break; if (sp > XB_SPIN_CAP) { atomicAdd(&bar[XB_TMO], 1u); break; } }
  }
  nloc = mine > 0u ? mine : 1u; nx = cnt > 0u ? cnt : 1u;
}
DI void xcd_barrier(const XcdBarrier& b) {
  asm volatile("s_waitcnt vmcnt(0)" ::: "memory");
  __syncthreads();
  if (threadIdx.x == 0) {
    unsigned* bar = b.bar;
    __builtin_amdgcn_s_waitcnt(0);
    unsigned nloc = b.st[0], nx = b.st[1];
    if (nloc == 0u) { xcd_barrier_complete(bar, b.x, nloc, nx); b.st[0] = nloc; b.st[1] = nx; }
    const unsigned old = xb_add(&bar[XB_XSUB(b.x)], 1u);
    const unsigned gen = old / nloc;
    if (old + 1u == (gen + 1u) * nloc) {
      __builtin_amdgcn_fence(__ATOMIC_RELEASE, "agent");
      asm volatile("s_waitcnt vmcnt(0)" ::: "memory");
      const unsigned og = xb_add(&bar[XB_TOP], 1u);
      const unsigned tg = og / nx;
      if (og + 1u == (tg + 1u) * nx) xb_add(&bar[XB_TOPGEN], 1u);
      else XB_SPIN(xb_ld(&bar[XB_TOPGEN]) == tg, bar);
      __builtin_amdgcn_fence(__ATOMIC_ACQUIRE, "agent");
      xb_add(&bar[XB_XGEN(b.x)], 1u);
      asm volatile("s_waitcnt vmcnt(0)" ::: "memory");
    } else {
      XB_SPIN(xb_ld(&bar[XB_XGEN(b.x)]) == gen, bar);
      __builtin_amdgcn_fence(__ATOMIC_ACQUIRE, "agent");
      asm volatile("s_waitcnt vmcnt(0)" ::: "memory");
    }
  }
  __syncthreads();
}

#ifndef REP_MIX
#define REP_MIX 1
#endif
#ifndef REP_GEMM
#define REP_GEMM 1
#endif
__global__ void __launch_bounds__(256, 2) mega(Params pk) {
  extern __shared__ __attribute__((aligned(16))) char lds[];
  __shared__ uint4 sh_words;
  cg::grid_group grid = cg::this_grid();
  CParams* kp = (CParams*)__builtin_amdgcn_kernarg_segment_ptr();
  if (threadIdx.x == 0) sh_words = make_uint4(0u, 0u, 0u, 0u);
  __syncthreads();
  XcdBarrier xb;
  { CParams& p = *launder(kp); xb = xcd_barrier_post((unsigned*)(p.ws + OFF_BAR), (volatile LAS unsigned*)&sh_words); }
#define s_item (((volatile int*)&sh_words)[2])
#define GSYNC() xcd_barrier(xb)
#define PP_ CParams& p = *launder(kp); const bf16_t* wb = (const bf16_t*)(p.ws + OFF_WB); bf16_t* Nb = (bf16_t*)(p.ws + OFF_N); \
            bf16_t* PRb = (bf16_t*)(p.ws + OFF_PR); bf16_t* Npb = (bf16_t*)(p.ws + OFF_Q); bf16_t* PB = (bf16_t*)(p.ws + OFF_OD); \
            float* xg = p.x + (size_t)grp * TG * 1024; (void)wb; (void)Nb; (void)PRb; (void)Npb; (void)PB; (void)xg;
  { CParams& p = *launder(kp); phase_init(p, lds); }
  grid.sync();
  for (int layer = 0; layer < 2; ++layer) {
    if (layer > 0) { CParams& p = *launder(kp); phase_convert(p, layer, lds); GSYNC(); }
    for (int grp = 0; grp < 2; ++grp) {
      const int S = grp ? 2048 : 16384, B = grp ? 16 : 2;
      const float* xsrc0 = nullptr;
      { CParams& p = *launder(kp); xsrc0 = layer == 0 ? p.x_in[grp] : p.x + (size_t)grp * TG * 1024; }
      { PP_ phase_norm(xsrc0, p.norm_ff1 + layer * 1024, Nb, nullptr, nullptr); }
      GSYNC();
      for (int rep = 0; rep < REP_GEMM; ++rep) {
        { PP_ phase_ffn_a(Nb, wb + W_FF1_1, wb + W_FF1_3, PRb, lds); }
        GSYNC();
      }
      { PP_ phase_gemm_resid(PRb, 2816, wb + W_FF1_2, xsrc0, xg, 0.5f, lds); }
      GSYNC();
      { PP_ phase_norm(xg, p.norm_mix + layer * 1024, Nb, nullptr, nullptr); }
      GSYNC();
      for (int rep = 0; rep < REP_GEMM; ++rep) {
        { PP_ phase_proj(p, Nb, wb + W_IN, S, lds); }
        GSYNC();
      }
      {
        PP_
        int* c0 = (int*)(p.ws + OFF_CNT) + (layer * 2 + grp) * 4;
        for (;;) {
          __syncthreads();
          if (threadIdx.x == 0) s_item = atomicAdd(c0, 1);
          __syncthreads();
          const int it = s_item;
          if (it >= 2048) break;
          dn_prep_item(p, layer, it, S, lds);
        }
      }
      GSYNC();
      {
        PP_
        int* c1 = (int*)(p.ws + OFF_CNT) + (layer * 2 + grp) * 4 + 1;
        const int nDN = B * 8, total = nDN + 1024;
        for (;;) {
          __syncthreads();
          if (threadIdx.x == 0) s_item = atomicAdd(c1, 1);
          __syncthreads();
          int it = s_item;
          if (it >= total) break;
          if (it < nDN) { dn_scan_chain(p, it, S, lds); continue; }
          diff_item(p, layer, it - nDN, S, lds);
        }
      }
      GSYNC();
      {
        PP_
        int* c2 = (int*)(p.ws + OFF_CNT) + (layer * 2 + grp) * 4 + 2;
        const int nDil = 3072, total = nDil + 256 * 7;
        for (;;) {
          __syncthreads();
          if (threadIdx.x == 0) s_item = atomicAdd(c2, 1);
          __syncthreads();
          int it = s_item;
          if (it >= total) break;
          if (it < nDil) { dil_item(p, it, S, B, lds); continue; }
          it -= nDil;
          mla_up_tile(p, it / 7, it % 7, S, lds);
        }
      }
      GSYNC();
      {
        PP_
        int* c3 = (int*)(p.ws + OFF_CNT) + (layer * 2 + grp) * 4 + 3;
        for (;;) {
          __syncthreads();
          if (threadIdx.x == 0) s_item = atomicAdd(c3, 1);
          __syncthreads();
          const int it = s_item;
          if (it >= 1024) break;
          mla_item(p, it, S, lds);
        }
      }
      GSYNC();
      { PP_ phase_combine(p, layer, xg); }
      GSYNC();
      for (int rep = 0; rep < REP_GEMM; ++rep) {
        { PP_ phase_merge(Npb, Nb, wb + W_G, wb + W_B, PRb, lds); }
        GSYNC();
      }
      { PP_ phase_gemm_resid(PRb, 1024, wb + W_O, xg, xg, 1.0f, lds); }
      GSYNC();
      { PP_ phase_norm(xg, p.norm_ff2 + layer * 1024, Nb, nullptr, nullptr); }
      GSYNC();
      for (int rep = 0; rep < REP_GEMM; ++rep) {
        { PP_ phase_ffn_a(Nb, wb + W_FF2_1, wb + W_FF2_3, PRb, lds); }
        GSYNC();
      }
      { PP_ phase_gemm_resid(PRb, 2816, wb + W_FF2_2, xg, xg, 0.5f, lds); }
      GSYNC();
      { PP_ phase_norm(xg, p.norm_ple + layer * 1024, Nb, p.p_in[grp] + (size_t)layer * TG * 256, PB); }
      GSYNC();
      { PP_ phase_ple(Nb, PB, wb + W_PG, wb + W_PP, xg, lds); }
      GSYNC();
    }
  }
  { CParams& p = *launder(kp); phase_final_norm(p.x, p.norm_final); }
}

extern "C" void kernel_launch(void* const* d_in, const int* in_sizes, int n_in, void* d_out, int out_size, void* d_ws,
                              size_t ws_size, hipStream_t stream) {
  (void)in_sizes; (void)n_in; (void)out_size;
  Params p{};
  p.x_in[0] = (const float*)d_in[0]; p.x_in[1] = (const float*)d_in[1];
  p.p_in[0] = (const float*)d_in[2]; p.p_in[1] = (const float*)d_in[3];
  p.norm_ff1 = (const float*)d_in[4]; p.ff1_w1 = (const float*)d_in[5]; p.ff1_w3 = (const float*)d_in[6];
  p.ff1_w2 = (const float*)d_in[7]; p.norm_mix = (const float*)d_in[8]; p.w_in = (const float*)d_in[9];
  p.mla_q_norm = (const float*)d_in[10]; p.mla_kv_norm = (const float*)d_in[11]; p.mla_w_uq = (const float*)d_in[12];
  p.mla_w_ukv = (const float*)d_in[13]; p.diff_lambda = (const float*)d_in[14]; p.diff_subln = (const float*)d_in[15];
  p.dn_conv = (const float*)d_in[16]; p.dn_a_log = (const float*)d_in[17]; p.dn_dt_bias = (const float*)d_in[18];
  p.dn_out_norm = (const float*)d_in[19]; p.w_branch = (const float*)d_in[20]; p.w_gate = (const float*)d_in[21];
  p.w_out = (const float*)d_in[22]; p.norm_ff2 = (const float*)d_in[23]; p.ff2_w1 = (const float*)d_in[24];
  p.ff2_w3 = (const float*)d_in[25]; p.ff2_w2 = (const float*)d_in[26]; p.norm_ple = (const float*)d_in[27];
  p.ple_gate = (const float*)d_in[28]; p.ple_proj = (const float*)d_in[29]; p.norm_final = (const float*)d_in[30];
  p.x = (float*)d_out;
  p.ws = (char*)d_ws;
  static int grid_blocks = 0;
  if (!grid_blocks) {
    int dev = 0, cus = 0, per_cu = 0;
    hipGetDevice(&dev);
    hipDeviceGetAttribute(&cus, hipDeviceAttributeMultiprocessorCount, dev);
    hipFuncSetAttribute((const void*)mega, hipFuncAttributeMaxDynamicSharedMemorySize, (int)LDS_BYTES);
    hipOccupancyMaxActiveBlocksPerMultiprocessor(&per_cu, mega, 256, LDS_BYTES);
    if (per_cu < 1) per_cu = 1;
    grid_blocks = cus * per_cu;
  }
  if (ws_size < WS_NEED) {
    fprintf(stderr, "workspace too small: %zu < %zu\n", ws_size, (size_t)WS_NEED);
    return;
  }
  (void)hipMemsetAsync((char*)d_ws + OFF_BAR, 0, XCD_BAR_WORDS * 4, stream);
  void* args[] = {&p};
  hipError_t e = hipLaunchCooperativeKernel((void*)mega, dim3(grid_blocks), dim3(256), args, LDS_BYTES, stream);
  if (e != hipSuccess) fprintf(stderr, "cooperative launch failed: %s (grid %d)\n", hipGetErrorString(e), grid_blocks);
}
```

```cpp
#include <hip/hip_runtime.h>
#include <hip/hip_cooperative_groups.h>
#include <stdint.h>
#include <stdio.h>
namespace cg = cooperative_groups;

typedef unsigned short bf16_t;
using bf16x8 = __attribute__((ext_vector_type(8))) short;
using bf16x4 = __attribute__((ext_vector_type(4))) short;
using f32x16 = __attribute__((ext_vector_type(16))) float;
using f32x4 = __attribute__((ext_vector_type(4))) float;
using u32x4 = __attribute__((ext_vector_type(4))) unsigned;
using u32x2 = __attribute__((ext_vector_type(2))) unsigned;

#define DI __device__ __forceinline__
#define MFMA32(a, b, c) __builtin_amdgcn_mfma_f32_32x32x16_bf16((a), (b), (c), 0, 0, 0)
#define MFMA16(a, b, c) __builtin_amdgcn_mfma_f32_16x16x32_bf16((a), (b), (c), 0, 0, 0)

constexpr int TG = 32768;
constexpr int NPR = 4608;
constexpr float EPS = 1e-6f;
constexpr float LOG2E = 1.4426950408889634f;
constexpr int C_CQ = 0, C_CKV = 256, C_BQ = 384, C_BK = 640, C_BV = 896, C_DNQKV = 1152, C_Z = 1920,
              C_DQ = 2176, C_DK = 2944, C_DV = 3712;
constexpr size_t MiB = 1048576;
constexpr size_t OFF_WB = 0, OFF_TAB = 57 * MiB, OFF_CNT = 63 * MiB, OFF_N = 64 * MiB, OFF_PR = 128 * MiB,
                 OFF_Q = 416 * MiB, OFF_K = 440 * MiB, OFF_V = 464 * MiB, OFF_AB = 480 * MiB, OFF_OD = 482 * MiB,
                 OFF_LSE = 530 * MiB, OFF_OF = 532 * MiB, OFF_OB = 548 * MiB, WS_NEED = 564 * MiB;
constexpr size_t W_FF1_1 = 0, W_FF1_3 = 2883584, W_FF1_2 = 5767168, W_IN = 8650752, W_UQ = 13369344,
                 W_UKV = 13467648, W_G = 13533184, W_B = 17727488, W_O = 18776064, W_FF2_1 = 19824640,
                 W_FF2_3 = 22708224, W_FF2_2 = 25591808, W_PG = 28475392, W_PP = 29523968;
constexpr size_t LDS_BYTES = 78336;

struct Params {
  const float* x_in[2];
  const float* p_in[2];
  const float *norm_ff1, *ff1_w1, *ff1_w3, *ff1_w2, *norm_mix, *w_in, *mla_q_norm, *mla_kv_norm, *mla_w_uq,
      *mla_w_ukv, *diff_lambda, *diff_subln, *dn_conv, *dn_a_log, *dn_dt_bias, *dn_out_norm, *w_branch, *w_gate,
      *w_out, *norm_ff2, *ff2_w1, *ff2_w3, *ff2_w2, *norm_ple, *ple_gate, *ple_proj, *norm_final;
  float* x;
  char* ws;
  long long big_ws;
};

typedef const __attribute__((address_space(4))) Params CParams;
DI CParams* launder(CParams* q) { asm volatile("" : "+s"(q)); return q; }

typedef __bf16 bf2_t __attribute__((ext_vector_type(2)));
typedef float f2_t __attribute__((ext_vector_type(2)));
DI bf16_t f2bf(float x) { return __builtin_bit_cast(bf16_t, (__bf16)x); }
DI float bf2f(bf16_t b) { return __uint_as_float(((unsigned)b) << 16); }
DI unsigned pack2(float a, float b) { f2_t v = {a, b}; return __builtin_bit_cast(unsigned, __builtin_convertvector(v, bf2_t)); }
DI float wave_sum(float v) {
#pragma unroll
  for (int o = 32; o > 0; o >>= 1) v += __shfl_xor(v, o);
  return v;
}
DI float sigmoidf_(float x) { return 1.f / (1.f + __expf(-x)); }
DI float siluf_(float x) { return x / (1.f + __expf(-x)); }
DI float exp2_(float x) { return __builtin_amdgcn_exp2f(x); }
DI int opq() { int z; asm volatile("v_mov_b32 %0, 0" : "=v"(z)); return z; }
DI int crow(int r, int h2) { return (r & 3) + 8 * (r >> 2) + 4 * h2; }
DI bf16x8 pack8(float a0, float a1, float a2, float a3, float a4, float a5, float a6, float a7) {
  u32x4 u;
  u.x = pack2(a0, a1); u.y = pack2(a2, a3); u.z = pack2(a4, a5); u.w = pack2(a6, a7);
  return __builtin_bit_cast(bf16x8, u);
}
DI bf16x8 ld2x4(const bf16_t* p0, const bf16_t* p1) {
  u32x2 a = *(const u32x2*)p0, b = *(const u32x2*)p1;
  u32x4 u; u.x = a.x; u.y = a.y; u.z = b.x; u.w = b.y;
  return __builtin_bit_cast(bf16x8, u);
}
DI void store8bf(bf16_t* dst, const float* v) {
  u32x4 u; u.x = pack2(v[0], v[1]); u.y = pack2(v[2], v[3]); u.z = pack2(v[4], v[5]); u.w = pack2(v[6], v[7]);
  *(u32x4*)dst = u;
}

struct MatDesc { const float* src; bf16_t* dst; int K, ldsrc, Ndst, map; const float* rowscale; };

DI int map_col(int map, int n) {
  if (map == 0) return n;
  if (map == 1) {
    if (n < 384) return n;
    if (n < 1920) return n + 32;
    if (n < 4480) return n + 48;
    if (n < 4512) return n - 4480 + 384;
    if (n < 4528) return n - 4512 + 1952;
    return -1;
  }
  if (n < 256) return (n >> 6) * 96 + (n & 63);
  return ((n - 256) >> 5) * 96 + 64 + ((n - 256) & 31);
}

DI MatDesc get_mat(CParams& p, int l, int id) {
  bf16_t* wb = (bf16_t*)(p.ws + OFF_WB);
  MatDesc d; d.map = 0; d.rowscale = nullptr;
  const size_t FF = (size_t)1024 * 2816;
  switch (id) {
    case 0: d.src = p.ff1_w1 + l * FF; d.dst = wb + W_FF1_1; d.K = 1024; d.ldsrc = 2816; d.Ndst = 2816; break;
    case 1: d.src = p.ff1_w3 + l * FF; d.dst = wb + W_FF1_3; d.K = 1024; d.ldsrc = 2816; d.Ndst = 2816; break;
    case 2: d.src = p.ff1_w2 + l * FF; d.dst = wb + W_FF1_2; d.K = 2816; d.ldsrc = 1024; d.Ndst = 1024; break;
    case 3: d.src = p.w_in + (size_t)l * 1024 * 4528; d.dst = wb + W_IN; d.K = 1024; d.ldsrc = 4528; d.Ndst = 4608; d.map = 1; break;
    case 4: d.src = p.mla_w_uq + (size_t)l * 256 * 384; d.dst = wb + W_UQ; d.K = 256; d.ldsrc = 384; d.Ndst = 384; d.map = 2; d.rowscale = p.mla_q_norm + l * 256; break;
    case 5: d.src = p.mla_w_ukv + (size_t)l * 128 * 512; d.dst = wb + W_UKV; d.K = 128; d.ldsrc = 512; d.Ndst = 512; d.rowscale = p.mla_kv_norm + l * 128; break;
    case 6: case 7: case 8: case 9:
      d.src = p.w_gate + (size_t)(l * 4 + id - 6) * 1048576; d.dst = wb + W_G + (size_t)(id - 6) * 1048576; d.K = 1024; d.ldsrc = 1024; d.Ndst = 1024; break;
    case 10: case 11: case 12: case 13:
      d.src = p.w_branch + (size_t)(l * 4 + id - 10) * 262144; d.dst = wb + W_B + (size_t)(id - 10) * 262144; d.K = 256; d.ldsrc = 1024; d.Ndst = 1024; break;
    case 14: d.src = p.w_out + (size_t)l * 1048576; d.dst = wb + W_O; d.K = 1024; d.ldsrc = 1024; d.Ndst = 1024; break;
    case 15: d.src = p.ff2_w1 + l * FF; d.dst = wb + W_FF2_1; d.K = 1024; d.ldsrc = 2816; d.Ndst = 2816; break;
    case 16: d.src = p.ff2_w3 + l * FF; d.dst = wb + W_FF2_3; d.K = 1024; d.ldsrc = 2816; d.Ndst = 2816; break;
    case 17: d.src = p.ff2_w2 + l * FF; d.dst = wb + W_FF2_2; d.K = 2816; d.ldsrc = 1024; d.Ndst = 1024; break;
    case 18: d.src = p.ple_gate + (size_t)l * 1048576; d.dst = wb + W_PG; d.K = 1024; d.ldsrc = 1024; d.Ndst = 1024; break;
    default: d.src = p.ple_proj + (size_t)l * 262144; d.dst = wb + W_PP; d.K = 256; d.ldsrc = 1024; d.Ndst = 1024; break;
  }
  return d;
}

DI void phase_convert(CParams& p, int l, char* lds) {
  float* T = (float*)lds;
  const int tid = threadIdx.x + opq();
  for (int id = 0; id < 20; ++id) {
    MatDesc d = get_mat(p, l, id);
    const int nkt = d.K >> 6, nnt = d.Ndst >> 6, nt_all = nkt * nnt;
    for (int t = blockIdx.x; t < nt_all; t += gridDim.x) {
      const int kt = t / nnt, nt = t % nnt;
      __syncthreads();
      {
        const int nl = tid & 63;
        const int sc = map_col(d.map, nt * 64 + nl);
#pragma unroll 4
        for (int i = 0; i < 16; ++i) {
          const int kl = (tid >> 6) + 4 * i;
          const int k = kt * 64 + kl;
          float v = 0.f;
          if (sc >= 0) v = d.src[(size_t)k * d.ldsrc + sc];
          if (d.rowscale) v *= d.rowscale[k];
          T[kl * 65 + nl] = v;
        }
      }
      __syncthreads();
      {
        const int kl = tid & 63;
#pragma unroll 4
        for (int i = 0; i < 16; ++i) {
          const int nl = (tid >> 6) + 4 * i;
          d.dst[(size_t)(nt * 64 + nl) * d.K + kt * 64 + kl] = f2bf(T[kl * 65 + nl]);
        }
      }
    }
  }
}

DI void phase_init(CParams& p, char* lds) {
  const size_t gtid = (size_t)blockIdx.x * 256 + threadIdx.x + opq(), gn = (size_t)gridDim.x * 256;
  {
    float2* t32 = (float2*)(p.ws + OFF_TAB);
    float2* t64 = (float2*)(p.ws + OFF_TAB + 2 * MiB);
    for (size_t i = gtid; i < (size_t)16384 * 48; i += gn) {
      const int pos = (int)(i / 48), f = (int)(i % 48);
      float inv;
      if (f < 16) inv = exp2f(-(float)f * (13.287712379549449f / 16.f));
      else inv = exp2f(-(float)(f - 16) * (13.287712379549449f / 32.f));
      const float ang = (float)pos * inv;
      const double xd = (double)ang;
      const double n = rint(xd * 0.15915494309189535);
      const float rf = (float)(xd - n * 6.283185307179586);
      float2 cs; cs.x = __cosf(rf); cs.y = __sinf(rf);
      if (f < 16) t32[(size_t)pos * 16 + f] = cs; else t64[(size_t)pos * 32 + (f - 16)] = cs;
    }
  }
  if (blockIdx.x == 0 && threadIdx.x < 64) ((int*)(p.ws + OFF_CNT))[threadIdx.x] = 0;
  phase_convert(p, 0, lds);
}

DI void phase_norm(const float* __restrict__ x, const float* __restrict__ g, bf16_t* __restrict__ dst,
                           const float* __restrict__ psrc, bf16_t* __restrict__ pdst) {
  const int tidq = threadIdx.x + opq(); const int wave = tidq >> 6, lane = tidq & 63;
  for (int r = blockIdx.x * 4 + wave; r < TG; r += gridDim.x * 4) {
    const float4* xr = (const float4*)(x + (size_t)r * 1024);
    float4 v[4];
    float ss = 0.f;
#pragma unroll
    for (int i = 0; i < 4; ++i) { v[i] = xr[lane + 64 * i]; ss += v[i].x * v[i].x + v[i].y * v[i].y + v[i].z * v[i].z + v[i].w * v[i].w; }
    ss = wave_sum(ss);
    const float rs = rsqrtf(ss * (1.f / 1024.f) + EPS);
#pragma unroll
    for (int i = 0; i < 4; ++i) {
      const float4 gg = ((const float4*)g)[lane + 64 * i];
      u32x2 o; o.x = pack2(v[i].x * rs * gg.x, v[i].y * rs * gg.y); o.y = pack2(v[i].z * rs * gg.z, v[i].w * rs * gg.w);
      ((u32x2*)(dst + (size_t)r * 1024))[lane + 64 * i] = o;
    }
    if (psrc) {
      const float4 pv = ((const float4*)(psrc + (size_t)r * 256))[lane];
      u32x2 o; o.x = pack2(pv.x, pv.y); o.y = pack2(pv.z, pv.w);
      ((u32x2*)(pdst + (size_t)r * 256))[lane] = o;
    }
  }
}

DI void phase_final_norm(float* __restrict__ x, const float* __restrict__ g) {
  const int tidq = threadIdx.x + opq(); const int wave = tidq >> 6, lane = tidq & 63;
  for (int r = blockIdx.x * 4 + wave; r < 2 * TG; r += gridDim.x * 4) {
    float4* xr = (float4*)(x + (size_t)r * 1024);
    float4 v[4];
    float ss = 0.f;
#pragma unroll
    for (int i = 0; i < 4; ++i) { v[i] = xr[lane + 64 * i]; ss += v[i].x * v[i].x + v[i].y * v[i].y + v[i].z * v[i].z + v[i].w * v[i].w; }
    ss = wave_sum(ss);
    const float rs = rsqrtf(ss * (1.f / 1024.f) + EPS);
#pragma unroll
    for (int i = 0; i < 4; ++i) {
      const float4 gg = ((const float4*)g)[lane + 64 * i];
      float4 o; o.x = v[i].x * rs * gg.x; o.y = v[i].y * rs * gg.y; o.z = v[i].z * rs * gg.z; o.w = v[i].w * rs * gg.w;
      xr[lane + 64 * i] = o;
    }
  }
}

template <int NI, int NB>
DI void gemm_main(f32x16 (&acc0)[2][NI], f32x16 (&acc1)[2][NI], const bf16_t* __restrict__ A, int lda,
                  const bf16_t* __restrict__ B0, const bf16_t* __restrict__ B1, int ldb, int K, char* lds) {
  const int tid = threadIdx.x + opq(), lane = tid & 63, w = tid >> 6, wm = w >> 1, wn = w & 1, l31 = lane & 31, h2 = lane >> 5;
  bf16_t* As = (bf16_t*)lds;
  bf16_t* B0s = As + 128 * 72;
  bf16_t* B1s = B0s + 64 * NI * 72;
  const int lr = tid >> 3, lc = (tid & 7) * 8;
  u32x4 ra[4], rb0[2 * NI], rb1[2 * NI];
  const bf16_t* ap = A + (size_t)lr * lda + lc;
  const bf16_t* bp0 = B0 + (size_t)lr * ldb + lc;
  const bf16_t* bp1 = (NB == 2) ? (B1 + (size_t)lr * ldb + lc) : B0;
#pragma unroll
  for (int i = 0; i < 4; ++i) ra[i] = *(const u32x4*)(ap + (size_t)(32 * i) * lda);
#pragma unroll
  for (int i = 0; i < 2 * NI; ++i) {
    rb0[i] = *(const u32x4*)(bp0 + (size_t)(32 * i) * ldb);
    if (NB == 2) rb1[i] = *(const u32x4*)(bp1 + (size_t)(32 * i) * ldb);
  }
  for (int k0 = 0; k0 < K; k0 += 64) {
    __syncthreads();
#pragma unroll
    for (int i = 0; i < 4; ++i) *(u32x4*)(As + (lr + 32 * i) * 72 + lc) = ra[i];
#pragma unroll
    for (int i = 0; i < 2 * NI; ++i) {
      *(u32x4*)(B0s + (lr + 32 * i) * 72 + lc) = rb0[i];
      if (NB == 2) *(u32x4*)(B1s + (lr + 32 * i) * 72 + lc) = rb1[i];
    }
    if (k0 + 64 < K) {
      const int kn = k0 + 64;
#pragma unroll
      for (int i = 0; i < 4; ++i) ra[i] = *(const u32x4*)(ap + (size_t)(32 * i) * lda + kn);
#pragma unroll
      for (int i = 0; i < 2 * NI; ++i) {
        rb0[i] = *(const u32x4*)(bp0 + (size_t)(32 * i) * ldb + kn);
        if (NB == 2) rb1[i] = *(const u32x4*)(bp1 + (size_t)(32 * i) * ldb + kn);
      }
    }
    __syncthreads();
    __builtin_amdgcn_s_setprio(1);
#pragma unroll
    for (int ks = 0; ks < 4; ++ks) {
      bf16x8 af[2], bf0[NI], bf1[NI];
#pragma unroll
      for (int mi = 0; mi < 2; ++mi) af[mi] = *(const bf16x8*)(As + (64 * wm + 32 * mi + l31) * 72 + 16 * ks + 8 * h2);
#pragma unroll
      for (int ni = 0; ni < NI; ++ni) {
        bf0[ni] = *(const bf16x8*)(B0s + (32 * NI * wn + 32 * ni + l31) * 72 + 16 * ks + 8 * h2);
        if (NB == 2) bf1[ni] = *(const bf16x8*)(B1s + (32 * NI * wn + 32 * ni + l31) * 72 + 16 * ks + 8 * h2);
      }
#pragma unroll
      for (int mi = 0; mi < 2; ++mi)
#pragma unroll
        for (int ni = 0; ni < NI; ++ni) {
          acc0[mi][ni] = MFMA32(af[mi], bf0[ni], acc0[mi][ni]);
          if (NB == 2) acc1[mi][ni] = MFMA32(af[mi], bf1[ni], acc1[mi][ni]);
        }
    }
    __builtin_amdgcn_s_setprio(0);
  }
}

template <int NI>
DI void zero_acc(f32x16 (&a)[2][NI]) {
#pragma unroll
  for (int mi = 0; mi < 2; ++mi)
#pragma unroll
    for (int ni = 0; ni < NI; ++ni)
#pragma unroll
      for (int r = 0; r < 16; ++r) a[mi][ni][r] = 0.f;
}

#define EPI_VARS const int tid = threadIdx.x + opq(), lane = tid & 63, w = tid >> 6, wm = w >> 1, wn = w & 1, l31 = lane & 31, h2 = lane >> 5; (void)tid; (void)lane; (void)w
#define EPI_BEGIN(NI_) _Pragma("unroll") for (int mi = 0; mi < 2; ++mi) _Pragma("unroll") for (int ni = 0; ni < NI_; ++ni) _Pragma("unroll") for (int r = 0; r < 16; ++r) { \
    const int row = 64 * wm + 32 * mi + crow(r, h2); const int col = 32 * NI_ * wn + 32 * ni + l31;
#define EPI_END }

DI bool xcd_tile(int iter, int MT, int NT, int& mt, int& nt) {
  const int x = blockIdx.x & 7, lb = blockIdx.x >> 3, nb = gridDim.x >> 3;
  const int full = NT >> 3, rem = NT & 7;
  const int per_full = full * MT, rem_tot = rem * MT;
  const int r0 = (rem_tot * x) >> 3, r1 = (rem_tot * (x + 1)) >> 3;
  const int j = lb + iter * nb;
  if (lb >= nb || j >= per_full + (r1 - r0)) return false;
  if (j < per_full) { mt = j / full; nt = x * full + j % full; }
  else { const int u = r0 + (j - per_full); nt = 8 * full + u / MT; mt = u % MT; }
  return true;
}

DI void phase_ffn_a(const bf16_t* __restrict__ Nb, const bf16_t* __restrict__ W1, const bf16_t* __restrict__ W3,
                            bf16_t* __restrict__ H, char* lds) {
  EPI_VARS;
  for (int iter = 0;; ++iter) {
    int mt, nt;
    if (!xcd_tile(iter, 256, 22, mt, nt)) break;
    f32x16 a0[2][2], a1[2][2];
    zero_acc<2>(a0); zero_acc<2>(a1);
    gemm_main<2, 2>(a0, a1, Nb + (size_t)mt * 128 * 1024, 1024, W1 + (size_t)nt * 128 * 1024, W3 + (size_t)nt * 128 * 1024, 1024, 1024, lds);
    EPI_BEGIN(2)
      H[(size_t)(mt * 128 + row) * 2816 + nt * 128 + col] = f2bf(siluf_(a0[mi][ni][r]) * a1[mi][ni][r]);
    EPI_END
  }
}

DI void phase_gemm_resid(const bf16_t* __restrict__ A, int K, const bf16_t* __restrict__ Bt, const float* xsrc, float* x,
                                 float scale, char* lds) {
  EPI_VARS;
  for (int iter = 0;; ++iter) {
    int mt, nt;
    if (!xcd_tile(iter, 256, 4, mt, nt)) break;
    f32x16 a0[2][4];
    zero_acc<4>(a0);
    gemm_main<4, 1>(a0, a0, A + (size_t)mt * 128 * K, K, Bt + (size_t)nt * 256 * K, nullptr, K, K, lds);
    EPI_BEGIN(4)
      const size_t off = (size_t)(mt * 128 + row) * 1024 + nt * 256 + col;
      x[off] = xsrc[off] + scale * a0[mi][ni][r];
    EPI_END
  }
}

DI void phase_ple(const bf16_t* __restrict__ Nb, const bf16_t* __restrict__ PB, const bf16_t* __restrict__ PG,
                          const bf16_t* __restrict__ PP, float* __restrict__ x, char* lds) {
  EPI_VARS;
  for (int iter = 0;; ++iter) {
    int mt, nt;
    if (!xcd_tile(iter, 256, 8, mt, nt)) break;
    f32x16 a0[2][2], a1[2][2];
    zero_acc<2>(a0); zero_acc<2>(a1);
    gemm_main<2, 1>(a0, a0, Nb + (size_t)mt * 128 * 1024, 1024, PG + (size_t)nt * 128 * 1024, nullptr, 1024, 1024, lds);
    gemm_main<2, 1>(a1, a1, PB + (size_t)mt * 128 * 256, 256, PP + (size_t)nt * 128 * 256, nullptr, 256, 256, lds);
    EPI_BEGIN(2)
      float* xp = x + (size_t)(mt * 128 + row) * 1024 + nt * 128 + col;
      *xp = *xp + sigmoidf_(a0[mi][ni][r]) * a1[mi][ni][r];
    EPI_END
  }
}

DI void phase_merge(const bf16_t* __restrict__ Np, const bf16_t* __restrict__ Y, const bf16_t* __restrict__ WG,
                            const bf16_t* __restrict__ WB, bf16_t* __restrict__ M, char* lds) {
  EPI_VARS;
  for (int iter = 0;; ++iter) {
    int mt, nt;
    if (!xcd_tile(iter, 256, 8, mt, nt)) break;
    f32x16 am[2][2];
    zero_acc<2>(am);
#pragma unroll 1
    for (int n = 0; n < 4; ++n) {
      unsigned sg[2][2][8];
      {
        f32x16 ag[2][2];
        zero_acc<2>(ag);
        gemm_main<2, 1>(ag, ag, Np + (size_t)mt * 128 * 1024, 1024, WG + (size_t)n * 1048576 + (size_t)nt * 128 * 1024, nullptr, 1024, 1024, lds);
#pragma unroll
        for (int mi = 0; mi < 2; ++mi)
#pragma unroll
          for (int ni = 0; ni < 2; ++ni)
#pragma unroll
            for (int r = 0; r < 8; ++r) sg[mi][ni][r] = pack2(sigmoidf_(ag[mi][ni][2 * r]), sigmoidf_(ag[mi][ni][2 * r + 1]));
      }
      f32x16 ab[2][2];
      zero_acc<2>(ab);
      gemm_main<2, 1>(ab, ab, Y + (size_t)mt * 128 * 1024 + n * 256, 1024, WB + (size_t)n * 262144 + (size_t)nt * 128 * 256, nullptr, 256, 256, lds);
#pragma unroll
      for (int mi = 0; mi < 2; ++mi)
#pragma unroll
        for (int ni = 0; ni < 2; ++ni)
#pragma unroll
          for (int r = 0; r < 8; ++r) {
            am[mi][ni][2 * r] += __uint_as_float(sg[mi][ni][r] << 16) * ab[mi][ni][2 * r];
            am[mi][ni][2 * r + 1] += __uint_as_float(sg[mi][ni][r] & 0xffff0000u) * ab[mi][ni][2 * r + 1];
          }
    }
    EPI_BEGIN(2)
      M[(size_t)(mt * 128 + row) * 1024 + nt * 128 + col] = f2bf(am[mi][ni][r]);
    EPI_END
  }
}

DI void rope32_out(const float* c, const float2* tab, float sc, float* o) {
#pragma unroll
  for (int i = 0; i < 16; ++i) {
    const float2 cs = tab[i];
    const float a = c[i], b = c[16 + i];
    o[i] = (a * cs.x - b * cs.y) * sc;
    o[16 + i] = (b * cs.x + a * cs.y) * sc;
  }
}

DI void phase_proj(CParams& p, const bf16_t* __restrict__ Nb, const bf16_t* __restrict__ WIN, int S, char* lds) {
  EPI_VARS;
  bf16_t* PR = (bf16_t*)(p.ws + OFF_PR);
  float* AB = (float*)(p.ws + OFF_AB);
  const float2* t32 = (const float2*)(p.ws + OFF_TAB);
  const float2* t64 = (const float2*)(p.ws + OFF_TAB + 2 * MiB);
  float* Ct = (float*)lds;
  for (int iter = 0;; ++iter) {
    int mt, nt2;
    if (!xcd_tile(iter, 256, 18, mt, nt2)) break;
    f32x16 a0[2][4];
    zero_acc<4>(a0);
    gemm_main<4, 1>(a0, a0, Nb + (size_t)mt * 128 * 1024, 1024, WIN + (size_t)nt2 * 256 * 1024, nullptr, 1024, 1024, lds);
   for (int hv = 0; hv < 2; ++hv) {
    const int nt = 2 * nt2 + hv;
    __syncthreads();
    if (wn == hv) {
#pragma unroll
      for (int mi = 0; mi < 2; ++mi)
#pragma unroll
        for (int ni = 0; ni < 4; ++ni)
#pragma unroll
          for (int r = 0; r < 16; ++r) Ct[(64 * wm + 32 * mi + crow(r, h2)) * 132 + 32 * ni + l31] = a0[mi][ni][r];
    }
    __syncthreads();
    const int erow = tid >> 1, half = tid & 1;
    const int tok = mt * 128 + erow, pos = tok & (S - 1);
    const float* cr = Ct + erow * 132 + 64 * half;
    bf16_t* dst = PR + (size_t)tok * NPR + nt * 128 + 64 * half;
    int type = 0; float sc = 1.f;
    if (nt == 3 || nt == 4) { type = 1; sc = 0.17677669529663687f * LOG2E; }
    else if (nt == 5 || nt == 6) { type = 1; }
    else if (nt >= 17 && nt <= 22) { type = 2; sc = 0.125f * LOG2E; }
    else if (nt >= 23 && nt <= 28) { type = 2; }
    else if (nt == 35) type = 3;
    if (type == 0) {
#pragma unroll
      for (int j = 0; j < 8; ++j) store8bf(dst + 8 * j, cr + 8 * j);
    } else if (type == 1) {
#pragma unroll
      for (int hh = 0; hh < 2; ++hh) {
        float o[32];
        rope32_out(cr + 32 * hh, t32 + (size_t)pos * 16, sc, o);
#pragma unroll
        for (int j = 0; j < 4; ++j) store8bf(dst + 32 * hh + 8 * j, o + 8 * j);
      }
    } else if (type == 2) {
      const float2* tab = t64 + (size_t)pos * 32;
#pragma unroll
      for (int j = 0; j < 4; ++j) {
        float lo[8], hi[8];
#pragma unroll
        for (int e = 0; e < 8; ++e) {
          const float2 cs = tab[8 * j + e];
          const float a = cr[8 * j + e], b = cr[32 + 8 * j + e];
          lo[e] = (a * cs.x - b * cs.y) * sc;
          hi[e] = (b * cs.x + a * cs.y) * sc;
        }
        store8bf(dst + 8 * j, lo);
        store8bf(dst + 32 + 8 * j, hi);
      }
    } else {
      if (half == 0) {
        float o[32];
        rope32_out(cr, t32 + (size_t)pos * 16, 1.f, o);
#pragma unroll
        for (int j = 0; j < 4; ++j) store8bf(dst + 8 * j, o + 8 * j);
      } else {
        const float* c2 = Ct + erow * 132 + 32;
#pragma unroll
        for (int j = 0; j < 4; ++j) {
          float4 v; v.x = c2[4 * j]; v.y = c2[4 * j + 1]; v.z = c2[4 * j + 2]; v.w = c2[4 * j + 3];
          ((float4*)(AB + (size_t)tok * 16))[j] = v;
        }
      }
    }
   }
  }
}

DI void mla_up_tile(CParams& p, int mt, int j, int S, char* lds) {
  EPI_VARS;
  const bf16_t* PR = (const bf16_t*)(p.ws + OFF_PR);
  const bf16_t* wb = (const bf16_t*)(p.ws + OFF_WB);
  bf16_t* Qb = (bf16_t*)(p.ws + OFF_Q);
  bf16_t* Kb = (bf16_t*)(p.ws + OFF_K);
  bf16_t* Vb = (bf16_t*)(p.ws + OFF_V);
  const float2* t32 = (const float2*)(p.ws + OFF_TAB);
  float* Ct = (float*)lds;
  float* rst = (float*)(lds + 67584);
  const bool isq = j < 3;
  const int K = isq ? 256 : 128;
  const int nt = isq ? j : j - 3;
  const bf16_t* A = PR + (size_t)mt * 128 * NPR + (isq ? C_CQ : C_CKV);
  const bf16_t* B = wb + (isq ? W_UQ : W_UKV) + (size_t)nt * 128 * K;
  const int erow = tid >> 1, half = tid & 1;
  {
    const bf16_t* ar = A + (size_t)erow * NPR + half * (K / 2);
    float ss = 0.f;
    for (int c = 0; c < K / 16; ++c) {
      const u32x4 u = *(const u32x4*)(ar + 8 * c);
      const unsigned uu[4] = {u.x, u.y, u.z, u.w};
#pragma unroll
      for (int e = 0; e < 4; ++e) {
        const float lo = __uint_as_float(uu[e] << 16), hi = __uint_as_float(uu[e] & 0xffff0000u);
        ss += lo * lo + hi * hi;
      }
    }
    ss += __shfl_xor(ss, 1);
    if (half == 0) rst[erow] = rsqrtf(ss / (float)K + EPS);
  }
  f32x16 a0[2][2];
  zero_acc<2>(a0);
  gemm_main<2, 1>(a0, a0, A, NPR, B, nullptr, K, K, lds);
  __syncthreads();
  EPI_BEGIN(2)
    Ct[row * 132 + col] = a0[mi][ni][r];
  EPI_END
  __syncthreads();
  const int tok = mt * 128 + erow, pos = tok & (S - 1);
  const float rs = rst[erow];
  const float* cr = Ct + erow * 132 + 64 * half;
  if (isq) {
    const float sc = rs * 0.10206207261596577f * LOG2E;
    if (nt < 2) {
      bf16_t* dst = Qb + ((size_t)tok * 4 + 2 * nt + half) * 96;
#pragma unroll
      for (int jj = 0; jj < 8; ++jj) {
        float o[8];
#pragma unroll
        for (int e = 0; e < 8; ++e) o[e] = cr[8 * jj + e] * sc;
        store8bf(dst + 8 * jj, o);
      }
    } else {
#pragma unroll
      for (int hh = 0; hh < 2; ++hh) {
        float o[32];
        rope32_out(cr + 32 * hh, t32 + (size_t)pos * 16, sc, o);
        bf16_t* dst = Qb + ((size_t)tok * 4 + 2 * half + hh) * 96 + 64;
#pragma unroll
        for (int jj = 0; jj < 4; ++jj) store8bf(dst + 8 * jj, o + 8 * jj);
      }
    }
  } else {
    bf16_t* dst = half == 0 ? (Kb + ((size_t)tok * 4 + nt) * 96) : (Vb + ((size_t)tok * 4 + nt) * 64);
#pragma unroll
    for (int jj = 0; jj < 8; ++jj) {
      float o[8];
#pragma unroll
      for (int e = 0; e < 8; ++e) o[e] = cr[8 * jj + e] * rs;
      store8bf(dst + 8 * jj, o);
    }
    if (half == 0) {
      const u32x4* src = (const u32x4*)(PR + (size_t)tok * NPR + 4480);
#pragma unroll
      for (int jj = 0; jj < 4; ++jj) ((u32x4*)(dst + 64))[jj] = src[jj];
    }
  }
}

typedef short s16x4_t __attribute__((ext_vector_type(4)));
DI bf16x8 tr_pair(const bf16_t* p0, const bf16_t* p1) {
  const s16x4_t lo = __builtin_amdgcn_ds_read_tr16_b64_v4i16((__attribute__((address_space(3))) s16x4_t*)p0);
  const s16x4_t hi = __builtin_amdgcn_ds_read_tr16_b64_v4i16((__attribute__((address_space(3))) s16x4_t*)p1);
  return __builtin_shufflevector(lo, hi, 0, 1, 2, 3, 4, 5, 6, 7);
}

template <int DK, bool BAND>
DI void flash_loop(f32x16 (&O)[2], float& m, float& l, const bf16_t* __restrict__ qrow, const bf16_t* __restrict__ kbase,
                   size_t kstride, const bf16_t* __restrict__ vbase, size_t vstride, int ntiles, int tq, int u0, int L,
                   char* lds) {
  const int tid = threadIdx.x + opq(), lane = tid & 63, l31 = lane & 31, h2 = lane >> 5;
  constexpr int KR = DK + 8, KCH = DK / 8, KN = 64 * KCH / 256;
  constexpr int STAGE = 64 * KR * 2 + 64 * 72 * 2;
  bf16x8 qf[DK / 16];
#pragma unroll
  for (int ks = 0; ks < DK / 16; ++ks) qf[ks] = *(const bf16x8*)(qrow + 16 * ks + 8 * h2);
  u32x4 rk[KN], rv[2];
  auto gload = [&](int kt) {
#pragma unroll
    for (int i = 0; i < KN; ++i) {
      const int ci = tid + 256 * i, row = ci / KCH, c = ci % KCH;
      int rr = u0 + 64 * kt + row;
      if (BAND) rr = min(max(rr, 0), L - 1);
      rk[i] = *(const u32x4*)(kbase + (size_t)rr * kstride + c * 8);
    }
#pragma unroll
    for (int i = 0; i < 2; ++i) {
      const int ci = tid + 256 * i, row = ci >> 3, c = ci & 7;
      int rr = u0 + 64 * kt + row;
      if (BAND) rr = min(max(rr, 0), L - 1);
      rv[i] = *(const u32x4*)(vbase + (size_t)rr * vstride + c * 8);
    }
  };
  auto swrite = [&](int st) {
    bf16_t* Ks = (bf16_t*)(lds + st * STAGE);
    bf16_t* Vs = Ks + 64 * KR;
#pragma unroll
    for (int i = 0; i < KN; ++i) {
      const int ci = tid + 256 * i, row = ci / KCH, c = ci % KCH;
      *(u32x4*)(Ks + row * KR + c * 8) = rk[i];
    }
#pragma unroll
    for (int i = 0; i < 2; ++i) {
      const int ci = tid + 256 * i, row = ci >> 3, c = ci & 7;
      *(u32x4*)(Vs + row * 72 + c * 8) = rv[i];
    }
  };
  const int trq = (lane & 15) >> 2, trp = lane & 3, trblk = (lane >> 4) & 1;
  const int troff = (4 * h2 + trq) * 72 + 16 * trblk + 4 * trp;
  __syncthreads();
  gload(0);
  swrite(0);
  if (ntiles > 1) gload(1);
  for (int kt = 0; kt < ntiles; ++kt) {
    __syncthreads();
    if (kt + 1 < ntiles) swrite((kt + 1) & 1);
    if (kt + 2 < ntiles) gload(kt + 2);
    const bf16_t* Ks = (const bf16_t*)(lds + (kt & 1) * STAGE);
    const bf16_t* Vs = Ks + 64 * KR;
    f32x16 Sx[2];
#pragma unroll
    for (int j = 0; j < 2; ++j)
#pragma unroll
      for (int r = 0; r < 16; ++r) Sx[j][r] = 0.f;
#pragma unroll
    for (int ks = 0; ks < DK / 16; ++ks)
#pragma unroll
      for (int j = 0; j < 2; ++j) {
        const bf16x8 kf = *(const bf16x8*)(Ks + (32 * j + l31) * KR + 16 * ks + 8 * h2);
        Sx[j] = MFMA32(kf, qf[ks], Sx[j]);
      }
    if (BAND) {
#pragma unroll
      for (int j = 0; j < 2; ++j)
#pragma unroll
        for (int r = 0; r < 16; ++r) {
          const int u = u0 + 64 * kt + 32 * j + crow(r, h2);
          const int d = u - tq;
          const bool valid = (d <= 64) && (d >= -64) && (u >= 0) && (u < L);
          Sx[j][r] = valid ? Sx[j][r] : -1e30f;
        }
    }
    float mx = Sx[0][0];
#pragma unroll
    for (int j = 0; j < 2; ++j)
#pragma unroll
      for (int r = 0; r < 16; ++r) mx = fmaxf(mx, Sx[j][r]);
    mx = fmaxf(mx, __shfl_xor(mx, 32));
    const float mn = fmaxf(m, mx);
    const float alpha = exp2_(m - mn);
    const bool grew = mn > m;
    m = mn;
    float ls = 0.f;
#pragma unroll
    for (int j = 0; j < 2; ++j)
#pragma unroll
      for (int r = 0; r < 16; ++r) { const float pv = exp2_(Sx[j][r] - mn); Sx[j][r] = pv; ls += pv; }
    l = l * alpha + ls;
    if (__any(grew)) {
#pragma unroll
      for (int t = 0; t < 2; ++t)
#pragma unroll
        for (int r = 0; r < 16; ++r) O[t][r] *= alpha;
    }
#pragma unroll
    for (int j = 0; j < 2; ++j)
#pragma unroll
      for (int s = 0; s < 2; ++s) {
        const bf16x8 pf = pack8(Sx[j][8 * s], Sx[j][8 * s + 1], Sx[j][8 * s + 2], Sx[j][8 * s + 3], Sx[j][8 * s + 4],
                                Sx[j][8 * s + 5], Sx[j][8 * s + 6], Sx[j][8 * s + 7]);
#pragma unroll
        for (int t = 0; t < 2; ++t) {
          const bf16_t* vp = Vs + (32 * j + 16 * s) * 72 + 32 * t + troff;
          const bf16x8 vf = tr_pair(vp, vp + 8 * 72);
          O[t] = MFMA32(vf, pf, O[t]);
        }
      }
  }
}

DI void flash_loop_diff(f32x16 (&O0)[2], f32x16 (&O1)[2], float& m0, float& l0, float& m1, float& l1,
                        const bf16_t* __restrict__ qrow, const bf16_t* __restrict__ kbase, size_t kstride,
                        const bf16_t* __restrict__ vbase, size_t vstride, int ntiles, char* lds) {
  const int tid = threadIdx.x + opq(), lane = tid & 63, l31 = lane & 31, h2 = lane >> 5;
  constexpr int KR = 72;
  constexpr int STAGE = 64 * KR * 2 + 64 * 72 * 2;
  bf16x8 qf0[2], qf1[2];
#pragma unroll
  for (int ks = 0; ks < 2; ++ks) {
    qf0[ks] = *(const bf16x8*)(qrow + 16 * ks + 8 * h2);
    qf1[ks] = *(const bf16x8*)(qrow + 32 + 16 * ks + 8 * h2);
  }
  u32x4 rk[2], rv[2];
  auto gload = [&](int kt) {
#pragma unroll
    for (int i = 0; i < 2; ++i) {
      const int ci = tid + 256 * i, row = ci >> 3, c = ci & 7;
      const int rr = 64 * kt + row;
      rk[i] = *(const u32x4*)(kbase + (size_t)rr * kstride + c * 8);
      rv[i] = *(const u32x4*)(vbase + (size_t)rr * vstride + c * 8);
    }
  };
  auto swrite = [&](int st) {
    bf16_t* Ks = (bf16_t*)(lds + st * STAGE);
    bf16_t* Vs = Ks + 64 * KR;
#pragma unroll
    for (int i = 0; i < 2; ++i) {
      const int ci = tid + 256 * i, row = ci >> 3, c = ci & 7;
      *(u32x4*)(Ks + row * KR + c * 8) = rk[i];
      *(u32x4*)(Vs + row * 72 + c * 8) = rv[i];
    }
  };
  const int trq = (lane & 15) >> 2, trp = lane & 3, trblk = (lane >> 4) & 1;
  const int troff = (4 * h2 + trq) * 72 + 16 * trblk + 4 * trp;
  __syncthreads();
  gload(0);
  swrite(0);
  if (ntiles > 1) gload(1);
  for (int kt = 0; kt < ntiles; ++kt) {
    __syncthreads();
    if (kt + 1 < ntiles) swrite((kt + 1) & 1);
    if (kt + 2 < ntiles) gload(kt + 2);
    const bf16_t* Ks = (const bf16_t*)(lds + (kt & 1) * STAGE);
    const bf16_t* Vs = Ks + 64 * KR;
    bf16x8 pf[2][2][2];
#pragma unroll
    for (int mp = 0; mp < 2; ++mp) {
      f32x16 Sx[2];
#pragma unroll
      for (int j = 0; j < 2; ++j)
#pragma unroll
        for (int r = 0; r < 16; ++r) Sx[j][r] = 0.f;
#pragma unroll
      for (int ks = 0; ks < 2; ++ks)
#pragma unroll
        for (int j = 0; j < 2; ++j) {
          const bf16x8 kf = *(const bf16x8*)(Ks + (32 * j + l31) * KR + 32 * mp + 16 * ks + 8 * h2);
          Sx[j] = MFMA32(kf, mp == 0 ? qf0[ks] : qf1[ks], Sx[j]);
        }
      float& m = mp == 0 ? m0 : m1;
      float& l = mp == 0 ? l0 : l1;
      float mx = Sx[0][0];
#pragma unroll
      for (int j = 0; j < 2; ++j)
#pragma unroll
        for (int r = 0; r < 16; ++r) mx = fmaxf(mx, Sx[j][r]);
      mx = fmaxf(mx, __shfl_xor(mx, 32));
      const float mn = fmaxf(m, mx);
      const float alpha = exp2_(m - mn);
      const bool grew = mn > m;
      m = mn;
      float ls = 0.f;
#pragma unroll
      for (int j = 0; j < 2; ++j)
#pragma unroll
        for (int r = 0; r < 16; ++r) { const float pv = exp2_(Sx[j][r] - mn); Sx[j][r] = pv; ls += pv; }
      l = l * alpha + ls;
      if (__any(grew)) {
#pragma unroll
        for (int t = 0; t < 2; ++t)
#pragma unroll
          for (int r = 0; r < 16; ++r) { if (mp == 0) O0[t][r] *= alpha; else O1[t][r] *= alpha; }
      }
#pragma unroll
      for (int j = 0; j < 2; ++j)
#pragma unroll
        for (int s = 0; s < 2; ++s)
          pf[mp][j][s] = pack8(Sx[j][8 * s], Sx[j][8 * s + 1], Sx[j][8 * s + 2], Sx[j][8 * s + 3], Sx[j][8 * s + 4],
                               Sx[j][8 * s + 5], Sx[j][8 * s + 6], Sx[j][8 * s + 7]);
    }
#pragma unroll
    for (int j = 0; j < 2; ++j)
#pragma unroll
      for (int s = 0; s < 2; ++s)
#pragma unroll
        for (int t = 0; t < 2; ++t) {
          const bf16_t* vp = Vs + (32 * j + 16 * s) * 72 + 32 * t + troff;
          const bf16x8 vf = tr_pair(vp, vp + 8 * 72);
          O0[t] = MFMA32(vf, pf[0][j][s], O0[t]);
          O1[t] = MFMA32(vf, pf[1][j][s], O1[t]);
        }
  }
}

DI void zeroO(f32x16 (&O)[2]) {
#pragma unroll
  for (int t = 0; t < 2; ++t)
#pragma unroll
    for (int r = 0; r < 16; ++r) O[t][r] = 0.f;
}

DI void store_o(bf16_t* dst, const f32x16 (&O)[2], int h2) {
#pragma unroll
  for (int t = 0; t < 2; ++t)
#pragma unroll
    for (int g = 0; g < 4; ++g) {
      u32x2 u; u.x = pack2(O[t][4 * g], O[t][4 * g + 1]); u.y = pack2(O[t][4 * g + 2], O[t][4 * g + 3]);
      *(u32x2*)(dst + 32 * t + 8 * g + 4 * h2) = u;
    }
}

DI void mla_item(CParams& p, int it, int S, char* lds) {
  const int tid = threadIdx.x + opq(), lane = tid & 63, w = tid >> 6, l31 = lane & 31, h2 = lane >> 5;
  const int lgq = (S == 2048) ? 4 : 7;
  const int qb = it & ((1 << lgq) - 1), bh = it >> lgq, h = bh & 3, b = bh >> 2;
  const int tokbase = b * S, gtok = tokbase + 128 * qb + 32 * w + l31;
  const bf16_t* Qb = (const bf16_t*)(p.ws + OFF_Q);
  const bf16_t* Kb = (const bf16_t*)(p.ws + OFF_K);
  const bf16_t* Vb = (const bf16_t*)(p.ws + OFF_V);
  bf16_t* Y = (bf16_t*)(p.ws + OFF_N);
  f32x16 O[2]; zeroO(O);
  float m = -1e30f, l = 0.f;
  flash_loop<96, false>(O, m, l, Qb + ((size_t)gtok * 4 + h) * 96, Kb + ((size_t)tokbase * 4 + h) * 96, 384,
                        Vb + ((size_t)tokbase * 4 + h) * 64, 256, S / 64, 0, 0, 0, lds);
  l += __shfl_xor(l, 32);
  const float il = 1.f / l;
#pragma unroll
  for (int t = 0; t < 2; ++t)
#pragma unroll
    for (int r = 0; r < 16; ++r) O[t][r] *= il;
  store_o(Y + (size_t)gtok * 1024 + h * 64, O, h2);
}

DI void diff_item(CParams& p, int layer, int it, int S, char* lds) {
  const int tid = threadIdx.x + opq(), lane = tid & 63, w = tid >> 6, l31 = lane & 31, h2 = lane >> 5;
  const int lgq = (S == 2048) ? 4 : 7;
  const int qb = it & ((1 << lgq) - 1), bh = it >> lgq, h = bh & 3, b = bh >> 2;
  const int tokbase = b * S, gtok = tokbase + 128 * qb + 32 * w + l31;
  const bf16_t* PR = (const bf16_t*)(p.ws + OFF_PR);
  bf16_t* Y = (bf16_t*)(p.ws + OFF_N);
  const float* lam = p.diff_lambda + layer * 128;
  float s1 = 0.f, s2 = 0.f;
  if (lane < 32) { s1 = lam[lane] * lam[32 + lane]; s2 = lam[64 + lane] * lam[96 + lane]; }
  s1 = wave_sum(s1); s2 = wave_sum(s2);
  const float lambda_init = layer ? 0.35550907f : 0.2f;
  const float lambda_full = expf(s1) - expf(s2) + lambda_init;
  f32x16 of[2], O1[2];
  zeroO(of); zeroO(O1);
  {
    float m0 = -1e30f, l0 = 0.f, m1 = -1e30f, l1 = 0.f;
    flash_loop_diff(of, O1, m0, l0, m1, l1, PR + (size_t)gtok * NPR + C_BQ + (2 * h) * 32,
                    PR + (size_t)tokbase * NPR + C_BK + (2 * h) * 32, NPR, PR + (size_t)tokbase * NPR + C_BV + h * 64, NPR,
                    S / 64, lds);
    l0 += __shfl_xor(l0, 32);
    l1 += __shfl_xor(l1, 32);
    const float c0 = 1.f / l0, c1 = -lambda_full / l1;
#pragma unroll
    for (int t = 0; t < 2; ++t)
#pragma unroll
      for (int r = 0; r < 16; ++r) of[t][r] = c0 * of[t][r] + c1 * O1[t][r];
  }
  float ss = 0.f;
#pragma unroll
  for (int t = 0; t < 2; ++t)
#pragma unroll
    for (int r = 0; r < 16; ++r) ss += of[t][r] * of[t][r];
  ss += __shfl_xor(ss, 32);
  const float rs = rsqrtf(ss * (1.f / 64.f) + EPS) * (1.f - lambda_init);
  const float* sg = p.diff_subln + layer * 64;
#pragma unroll
  for (int t = 0; t < 2; ++t)
#pragma unroll
    for (int r = 0; r < 16; ++r) of[t][r] *= rs * sg[32 * t + crow(r, h2)];
  store_o(Y + (size_t)gtok * 1024 + 256 + h * 64, of, h2);
}

DI void dil_item(CParams& p, int it, int S, int B, char* lds) {
  const int tid = threadIdx.x + opq(), lane = tid & 63, w = tid >> 6, l31 = lane & 31, h2 = lane >> 5;
  const int lgS = (S == 2048) ? 11 : 14, lgB = (B == 16) ? 4 : 1;
  const int rq = it & ((1 << (lgS - 7)) - 1);
  int rest = it >> (lgS - 7);
  const int head = rest & 3; rest >>= 2;
  const int b = rest & (B - 1), g = rest >> lgB;
  const int lgd = 2 * g, dil = 1 << lgd;
  const int L = S >> lgd, lgnqb = lgS - lgd - 7;
  const int res = rq >> lgnqb, qb = rq & ((1 << lgnqb) - 1);
  const int tokbase = b * S;
  const int tq = 128 * qb + 32 * w + l31;
  const int gtok = tokbase + tq * dil + res;
  const bf16_t* PR = (const bf16_t*)(p.ws + OFF_PR);
  bf16_t* OD = (bf16_t*)(p.ws + OFF_OD);
  float* LSE = (float*)(p.ws + OFF_LSE);
  f32x16 O[2]; zeroO(O);
  float m = -1e30f, l = 0.f;
  const int hc = (g * 4 + head) * 64;
  flash_loop<64, true>(O, m, l, PR + (size_t)gtok * NPR + C_DQ + hc, PR + (size_t)(tokbase + res) * NPR + C_DK + hc,
                       (size_t)dil * NPR, PR + (size_t)(tokbase + res) * NPR + C_DV + hc, (size_t)dil * NPR, 4, tq,
                       128 * qb - 64, L, lds);
  l += __shfl_xor(l, 32);
  const float il = 1.f / l;
#pragma unroll
  for (int t = 0; t < 2; ++t)
#pragma unroll
    for (int r = 0; r < 16; ++r) O[t][r] *= il;
  store_o(OD + ((size_t)g * TG + gtok) * 256 + head * 64, O, h2);
  if (h2 == 0) LSE[((size_t)g * TG + gtok) * 4 + head] = m + __log2f(l);
}

constexpr size_t OFF_X2 = 564 * MiB, WS_BIG = 597 * MiB;
#define DN_QK_OFF (p.big_ws ? OFF_X2 : OFF_OD)
#define DN_GC_OFF ((p.big_ws ? OFF_X2 : OFF_OD) + 32 * MiB)
constexpr size_t DN_UW_OFF = OFF_Q;

DI void dn_prep_item(CParams& p, int layer, int it, int S, char* lds) {
  const int tid = threadIdx.x + opq(), lane = tid & 63, w = tid >> 6, l15 = lane & 15, g4 = lane >> 4;
  const int NC = S / 64;
  const int ch = it % NC, bh = it / NC, h = bh & 3, b = bh >> 2;
  const int tokbase = b * S, s0 = ch * 64;
  const bf16_t* PR = (const bf16_t*)(p.ws + OFF_PR);
  const float* AB = (const float*)(p.ws + OFF_AB);
  bf16_t* QKg = (bf16_t*)(p.ws + DN_QK_OFF) + ((size_t)bh * NC + ch) * 8192;
  bf16_t* raw = (bf16_t*)lds;
  float* convw = (float*)(lds + 27200);
  float* RU = (float*)lds;
  float* RW = (float*)(lds + 16384);
  float* Am = (float*)(lds + 32768);
  bf16_t* Kimg = (bf16_t*)(lds + 50176);
  bf16_t* Qimg = (bf16_t*)(lds + 59392);
  float* gcs = (float*)(lds + 68608);
  float* betas = gcs + 128;
  const float* cw = p.dn_conv + (size_t)layer * 5 * 768;
  {
    u32x4 rawreg[7];
    float cwr[4];
#pragma unroll
    for (int k = 0; k < 7; ++k) {
      const int ci = tid + 256 * k;
      const int rr = ci / 24, c = ci % 24, seg = c >> 3, c8 = c & 7;
      const int s = s0 + rr - 2;
      rawreg[k] = u32x4{0u, 0u, 0u, 0u};
      if (ci < 68 * 24 && s >= 0 && s < S)
        rawreg[k] = *(const u32x4*)(PR + (size_t)(tokbase + s) * NPR + C_DNQKV + seg * 256 + h * 64 + c8 * 8);
    }
#pragma unroll
    for (int k = 0; k < 4; ++k) {
      const int i = tid + 256 * k;
      cwr[k] = 0.f;
      if (i < 960) { const int j = i / 192, c = i % 192; cwr[k] = cw[j * 768 + (c >> 6) * 256 + h * 64 + (c & 63)]; }
    }
#pragma unroll
    for (int k = 0; k < 7; ++k) {
      const int ci = tid + 256 * k;
      const int rr = ci / 24, c = ci % 24, seg = c >> 3, c8 = c & 7;
      if (ci < 68 * 24) *(u32x4*)(raw + rr * 200 + seg * 64 + c8 * 8) = rawreg[k];
    }
#pragma unroll
    for (int k = 0; k < 4; ++k) { const int i = tid + 256 * k; if (i < 960) convw[i] = cwr[k]; }
  }
  if (tid < 128) {
    const int d = tid >> 6, pl = tid & 63;
    const int i = d ? 63 - pl : pl;
    const size_t tok = (size_t)tokbase + s0 + i;
    const float Aexp = expf(p.dn_a_log[layer * 8 + d * 4 + h]);
    const float a = AB[tok * 16 + d * 8 + h] + p.dn_dt_bias[layer * 8 + d * 4 + h];
    const float bb = AB[tok * 16 + d * 8 + 4 + h];
    const float sp = fmaxf(a, 0.f) + __logf(1.f + __expf(-fabsf(a)));
    float g = -Aexp * sp;
#pragma unroll
    for (int o = 1; o < 64; o <<= 1) { const float tv = __shfl_up(g, o); if (lane >= o) g += tv; }
    gcs[tid] = g;
    betas[tid] = sigmoidf_(bb);
    float* GC = (float*)(p.ws + DN_GC_OFF) + (((size_t)bh * 2 + d) * NC + ch) * 64;
    GC[pl] = g;
  }
  __syncthreads();
  const int pp = tid >> 2, cgp = tid & 3;
  float kv[16], vv[16];
  {
    float qv[16];
#pragma unroll
    for (int seg = 0; seg < 3; ++seg) {
      float acc[16];
#pragma unroll
      for (int c = 0; c < 16; ++c) acc[c] = 0.f;
#pragma unroll
      for (int j = 0; j < 5; ++j) {
        const bf16_t* rp = raw + (pp + j) * 200 + seg * 64 + 16 * cgp;
        const float* wp = convw + j * 192 + seg * 64 + 16 * cgp;
        const u32x4 u0 = *(const u32x4*)rp, u1 = *(const u32x4*)(rp + 8);
        const unsigned uu[8] = {u0.x, u0.y, u0.z, u0.w, u1.x, u1.y, u1.z, u1.w};
#pragma unroll
        for (int e = 0; e < 8; ++e) {
          acc[2 * e] += wp[2 * e] * __uint_as_float(uu[e] << 16);
          acc[2 * e + 1] += wp[2 * e + 1] * __uint_as_float(uu[e] & 0xffff0000u);
        }
      }
#pragma unroll
      for (int c = 0; c < 16; ++c) {
        const float sv = acc[c] * __builtin_amdgcn_rcpf(1.f + __expf(-acc[c]));
        if (seg == 0) qv[c] = sv; else if (seg == 1) kv[c] = sv; else vv[c] = sv;
      }
    }
    float sq = 0.f, sk = 0.f;
#pragma unroll
    for (int c = 0; c < 16; ++c) { sq += qv[c] * qv[c]; sk += kv[c] * kv[c]; }
    sq += __shfl_xor(sq, 1); sq += __shfl_xor(sq, 2);
    sk += __shfl_xor(sk, 1); sk += __shfl_xor(sk, 2);
    const float rq = rsqrtf(sq + EPS) * 0.125f, rk = rsqrtf(sk + EPS);
#pragma unroll
    for (int c = 0; c < 16; ++c) { qv[c] *= rq; kv[c] *= rk; }
    store8bf(Kimg + pp * 72 + 16 * cgp, kv); store8bf(Kimg + pp * 72 + 16 * cgp + 8, kv + 8);
    store8bf(Qimg + pp * 72 + 16 * cgp, qv); store8bf(Qimg + pp * 72 + 16 * cgp + 8, qv + 8);
    store8bf(QKg + pp * 64 + 16 * cgp, qv); store8bf(QKg + pp * 64 + 16 * cgp + 8, qv + 8);
    store8bf(QKg + 4096 + pp * 64 + 16 * cgp, kv); store8bf(QKg + 4096 + pp * 64 + 16 * cgp + 8, kv + 8);
  }
  for (int d = 0; d < 2; ++d) {
    __syncthreads();
    {
      const int pl = d ? 63 - pp : pp;
      const float bet = betas[d * 64 + pl], egc = __expf(gcs[d * 64 + pl]);
#pragma unroll
      for (int c = 0; c < 16; ++c) {
        RU[pl * 64 + 16 * cgp + c] = vv[c] * bet;
        RW[pl * 64 + 16 * cgp + c] = kv[c] * bet * egc;
      }
    }
    {
      f32x4 KK[4];
#pragma unroll
      for (int t = 0; t < 4; ++t) KK[t] = f32x4{0.f, 0.f, 0.f, 0.f};
      const int jl = 16 * w + l15;
      const int jrow = d ? 63 - jl : jl;
#pragma unroll
      for (int ks = 0; ks < 2; ++ks) {
        const bf16x8 bfk = *(const bf16x8*)(Kimg + jrow * 72 + 32 * ks + 8 * g4);
#pragma unroll
        for (int rt = 0; rt < 4; ++rt) {
          const int il = 16 * rt + l15;
          const int irow = d ? 63 - il : il;
          const bf16x8 afk = *(const bf16x8*)(Kimg + irow * 72 + 32 * ks + 8 * g4);
          KK[rt] = MFMA16(afk, bfk, KK[rt]);
        }
      }
      const float gcj = gcs[d * 64 + jl];
#pragma unroll
      for (int rt = 0; rt < 4; ++rt)
#pragma unroll
        for (int r = 0; r < 4; ++r) {
          const int i = 16 * rt + 4 * g4 + r;
          const float ee = __expf(fminf(gcs[d * 64 + i] - gcj, 0.f));
          Am[i * 68 + jl] = (i > jl) ? betas[d * 64 + i] * KK[rt][r] * ee : 0.f;
        }
    }
    __syncthreads();
    float xs[32];
#pragma unroll
    for (int q = 0; q < 32; ++q) xs[q] = 0.f;
    const int c = tid >> 1, half = tid & 1;
    {
      const float* Rc = (c < 64) ? (RU + c) : (RW + (c - 64));
      const float* Ah = Am + 4 * half;
#pragma unroll
      for (int i = 0; i < 64; ++i) {
        float part = 0.f;
#pragma unroll
        for (int q = 0; q < (i + 7) / 8; ++q) {
          const f32x4 a = *(const f32x4*)(Ah + i * 68 + 8 * q);
          part += a[0] * xs[4 * q] + a[1] * xs[4 * q + 1] + a[2] * xs[4 * q + 2] + a[3] * xs[4 * q + 3];
        }
        const float other = __int_as_float(__builtin_amdgcn_update_dpp(0, __float_as_int(part), 0xB1, 0xf, 0xf, true));
        const float xi = Rc[i * 64] - (part + other);
        const int loc = ((i >> 3) << 2) + (i & 3);
        if (((i >> 2) & 1) == 0) xs[loc] = (half == 0) ? xi : xs[loc];
        else xs[loc] = (half == 1) ? xi : xs[loc];
        if (i < 16 ? ((i & 7) == 7) : (i < 32 ? ((i & 3) == 3) : ((i & 1) == 1))) asm volatile("" ::: "memory");
      }
    }
    {
      bf16_t* UWg = (bf16_t*)(p.ws + DN_UW_OFF) + ((((size_t)bh * 2 + d) * NC + ch) * 8192);
      const float sgn = (c < 64) ? 1.f : -1.f;
      bf16_t* dst = UWg + ((c < 64) ? c : (4096 + c - 64));
#pragma unroll
      for (int loc = 0; loc < 32; ++loc) {
        const int i = (((loc >> 2) * 2 + half) << 2) + (loc & 3);
        dst[i * 64] = f2bf(sgn * xs[loc]);
      }
    }
  }
}

DI void dn_scan_chain(CParams& p, int it, int S, char* lds) {
  const int tid0 = threadIdx.x + opq();
  const int dir = it & 1, bh = it >> 1, h = bh & 3, b = bh >> 2;
  const int tokbase = b * S, NC = S / 64;
  bf16_t* OUT = (bf16_t*)(p.ws + (dir ? OFF_OB : OFF_OF));
  const bf16_t* QKg = (const bf16_t*)(p.ws + DN_QK_OFF) + (size_t)bh * NC * 8192;
  const bf16_t* UWg = (const bf16_t*)(p.ws + DN_UW_OFF) + (size_t)it * NC * 8192;
  const float* GCg = (const float*)(p.ws + DN_GC_OFF) + (size_t)it * NC * 64;
  bf16_t* Uimg = (bf16_t*)lds;
  bf16_t* Wn = Uimg + 4608;
  bf16_t* Qimg = Wn + 4608;
  bf16_t* Kimg = Qimg + 4608;
  bf16_t* Kt = Kimg + 4608;
  bf16_t* Iimg = Kt + 4608;
  float* gcs = (float*)(lds + 6 * 9216);
  f32x4 Sd[4];
#pragma unroll
  for (int t = 0; t < 4; ++t) Sd[t] = f32x4{0.f, 0.f, 0.f, 0.f};
  u32x4 ru[2], rw[2], rq[2], rk[2];
  float rg = 0.f;
  auto prefetch = [&](int cc_) {
    const int ch_ = dir ? (NC - 1 - cc_) : cc_;
    const int tp = tid0 + opq();
    const bf16_t* uw = UWg + (size_t)ch_ * 8192;
    const bf16_t* qk = QKg + (size_t)ch_ * 8192;
#pragma unroll
    for (int k = 0; k < 2; ++k) {
      const int ci = tp + 256 * k, row = ci >> 3, c8 = ci & 7;
      const int srow = dir ? 63 - row : row;
      ru[k] = *(const u32x4*)(uw + row * 64 + c8 * 8);
      rw[k] = *(const u32x4*)(uw + 4096 + row * 64 + c8 * 8);
      rq[k] = *(const u32x4*)(qk + srow * 64 + c8 * 8);
      rk[k] = *(const u32x4*)(qk + 4096 + srow * 64 + c8 * 8);
    }
    if (tp < 64) rg = GCg[(size_t)ch_ * 64 + tp];
  };
  prefetch(0);
  for (int cc = 0; cc < NC; ++cc) {
    const int tid = tid0 + opq(), lane = tid & 63, w = tid >> 6, l15 = lane & 15, g4 = lane >> 4;
    const int e_col = 16 * w + l15;
    const int ch = dir ? (NC - 1 - cc) : cc;
    const int s0 = ch * 64;
    __syncthreads();
#pragma unroll
    for (int k = 0; k < 2; ++k) {
      const int ci = tid + 256 * k, row = ci >> 3, c8 = ci & 7;
      *(u32x4*)(Uimg + row * 72 + c8 * 8) = ru[k];
      *(u32x4*)(Wn + row * 72 + c8 * 8) = rw[k];
      *(u32x4*)(Qimg + row * 72 + c8 * 8) = rq[k];
      *(u32x4*)(Kimg + row * 72 + c8 * 8) = rk[k];
      const unsigned uu[4] = {rk[k].x, rk[k].y, rk[k].z, rk[k].w};
#pragma unroll
      for (int e = 0; e < 4; ++e) {
        Kt[(8 * c8 + 2 * e) * 72 + row] = (bf16_t)(uu[e] & 0xffffu);
        Kt[(8 * c8 + 2 * e + 1) * 72 + row] = (bf16_t)(uu[e] >> 16);
      }
    }
    if (tid < 64) gcs[tid] = rg;
    if (cc + 1 < NC) prefetch(cc + 1);
    __syncthreads();
    {
      f32x4 QK[4];
#pragma unroll
      for (int t = 0; t < 4; ++t) QK[t] = f32x4{0.f, 0.f, 0.f, 0.f};
#pragma unroll
      for (int ks = 0; ks < 2; ++ks) {
        const bf16x8 bfk = *(const bf16x8*)(Kimg + (16 * w + l15) * 72 + 32 * ks + 8 * g4);
#pragma unroll
        for (int rt = 0; rt < 4; ++rt) {
          const bf16x8 afq = *(const bf16x8*)(Qimg + (16 * rt + l15) * 72 + 32 * ks + 8 * g4);
          QK[rt] = MFMA16(afq, bfk, QK[rt]);
        }
      }
      const float gcj = gcs[e_col];
#pragma unroll
      for (int rt = 0; rt < 4; ++rt)
#pragma unroll
        for (int r = 0; r < 4; ++r) {
          const int i = 16 * rt + 4 * g4 + r;
          const float ee = __expf(fminf(gcs[i] - gcj, 0.f));
          Iimg[i * 72 + e_col] = f2bf((i >= e_col) ? QK[rt][r] * ee : 0.f);
        }
    }
    __syncthreads();
    {
      bf16x8 Bs[2];
#pragma unroll
      for (int ks = 0; ks < 2; ++ks)
        Bs[ks] = pack8(Sd[2 * ks][0], Sd[2 * ks][1], Sd[2 * ks][2], Sd[2 * ks][3], Sd[2 * ks + 1][0], Sd[2 * ks + 1][1],
                       Sd[2 * ks + 1][2], Sd[2 * ks + 1][3]);
      f32x4 vn[4], qs[4], iv[4];
#pragma unroll
      for (int rt = 0; rt < 4; ++rt) {
#pragma unroll
        for (int r = 0; r < 4; ++r) vn[rt][r] = bf2f(Uimg[(16 * rt + 4 * g4 + r) * 72 + e_col]);
        qs[rt] = f32x4{0.f, 0.f, 0.f, 0.f};
        iv[rt] = f32x4{0.f, 0.f, 0.f, 0.f};
#pragma unroll
        for (int ks = 0; ks < 2; ++ks) {
          const bf16_t* wp = Wn + (16 * rt + l15) * 72 + 32 * ks + 4 * g4;
          const bf16_t* qp = Qimg + (16 * rt + l15) * 72 + 32 * ks + 4 * g4;
          vn[rt] = MFMA16(ld2x4(wp, wp + 16), Bs[ks], vn[rt]);
          qs[rt] = MFMA16(ld2x4(qp, qp + 16), Bs[ks], qs[rt]);
        }
      }
      bf16x8 Bv[2];
#pragma unroll
      for (int ks = 0; ks < 2; ++ks)
        Bv[ks] = pack8(vn[2 * ks][0], vn[2 * ks][1], vn[2 * ks][2], vn[2 * ks][3], vn[2 * ks + 1][0], vn[2 * ks + 1][1],
                       vn[2 * ks + 1][2], vn[2 * ks + 1][3]);
#pragma unroll
      for (int rt = 0; rt < 4; ++rt)
#pragma unroll
        for (int ks = 0; ks < 2; ++ks) {
          const bf16_t* ip = Iimg + (16 * rt + l15) * 72 + 32 * ks + 4 * g4;
          iv[rt] = MFMA16(ld2x4(ip, ip + 16), Bv[ks], iv[rt]);
        }
      const float gc63 = gcs[63];
#pragma unroll
      for (int rt = 0; rt < 4; ++rt)
#pragma unroll
        for (int r = 0; r < 4; ++r) {
          const int pos = 16 * rt + 4 * g4 + r;
          const float o = qs[rt][r] * __expf(gcs[pos]) + iv[rt][r];
          const int i = dir ? 63 - pos : pos;
          OUT[((size_t)tokbase + s0 + i) * 256 + h * 64 + e_col] = f2bf(o);
          vn[rt][r] *= __expf(gc63 - gcs[pos]);
        }
      bf16x8 Bv2[2];
#pragma unroll
      for (int ks = 0; ks < 2; ++ks)
        Bv2[ks] = pack8(vn[2 * ks][0], vn[2 * ks][1], vn[2 * ks][2], vn[2 * ks][3], vn[2 * ks + 1][0], vn[2 * ks + 1][1],
                        vn[2 * ks + 1][2], vn[2 * ks + 1][3]);
      const float gl = __expf(gc63);
#pragma unroll
      for (int dt = 0; dt < 4; ++dt) {
#pragma unroll
        for (int r = 0; r < 4; ++r) Sd[dt][r] *= gl;
#pragma unroll
        for (int ks = 0; ks < 2; ++ks) {
          const bf16_t* kp = Kt + (16 * dt + l15) * 72 + 32 * ks + 4 * g4;
          Sd[dt] = MFMA16(ld2x4(kp, kp + 16), Bv2[ks], Sd[dt]);
        }
      }
    }
  }
}

DI void phase_combine(CParams& p, int layer, const float* __restrict__ xg) {
  const int tidq = threadIdx.x + opq(); const int wave = tidq >> 6, lane = tidq & 63;
  const bf16_t* PR = (const bf16_t*)(p.ws + OFF_PR);
  const bf16_t* OD = (const bf16_t*)(p.ws + OFF_OD);
  const float* LSE = (const float*)(p.ws + OFF_LSE);
  const bf16_t* OFb = (const bf16_t*)(p.ws + OFF_OF);
  const bf16_t* OBb = (const bf16_t*)(p.ws + OFF_OB);
  bf16_t* Y = (bf16_t*)(p.ws + OFF_N);
  bf16_t* Np = (bf16_t*)(p.ws + OFF_Q);
  const float* gmix = p.norm_mix + layer * 1024;
  const float* gdn = p.dn_out_norm + layer * 64;
  const int head = lane >> 4;
  for (int r = blockIdx.x * 4 + wave; r < TG; r += gridDim.x * 4) {
    {
      float lg[3];
#pragma unroll
      for (int g = 0; g < 3; ++g) lg[g] = LSE[((size_t)g * TG + r) * 4 + head];
      const float mx = fmaxf(lg[0], fmaxf(lg[1], lg[2]));
      float wg[3], den = 0.f;
#pragma unroll
      for (int g = 0; g < 3; ++g) { wg[g] = exp2_(lg[g] - mx); den += wg[g]; }
      const float id = 1.f / den;
      float o[4] = {0.f, 0.f, 0.f, 0.f};
#pragma unroll
      for (int g = 0; g < 3; ++g) {
        const u32x2 u = ((const u32x2*)(OD + ((size_t)g * TG + r) * 256))[lane];
        const float c = wg[g] * id;
        o[0] += c * __uint_as_float(u.x << 16); o[1] += c * __uint_as_float(u.x & 0xffff0000u);
        o[2] += c * __uint_as_float(u.y << 16); o[3] += c * __uint_as_float(u.y & 0xffff0000u);
      }
      u32x2 ou; ou.x = pack2(o[0], o[1]); ou.y = pack2(o[2], o[3]);
      ((u32x2*)(Y + (size_t)r * 1024 + 768))[lane] = ou;
    }
    {
      const u32x2 uf = ((const u32x2*)(OFb + (size_t)r * 256))[lane];
      const u32x2 ub = ((const u32x2*)(OBb + (size_t)r * 256))[lane];
      const u32x2 uz = ((const u32x2*)(PR + (size_t)r * NPR + C_Z))[lane];
      float o[4], z[4];
      o[0] = __uint_as_float(uf.x << 16) + __uint_as_float(ub.x << 16);
      o[1] = __uint_as_float(uf.x & 0xffff0000u) + __uint_as_float(ub.x & 0xffff0000u);
      o[2] = __uint_as_float(uf.y << 16) + __uint_as_float(ub.y << 16);
      o[3] = __uint_as_float(uf.y & 0xffff0000u) + __uint_as_float(ub.y & 0xffff0000u);
      z[0] = __uint_as_float(uz.x << 16); z[1] = __uint_as_float(uz.x & 0xffff0000u);
      z[2] = __uint_as_float(uz.y << 16); z[3] = __uint_as_float(uz.y & 0xffff0000u);
      float ss = o[0] * o[0] + o[1] * o[1] + o[2] * o[2] + o[3] * o[3];
      ss += __shfl_xor(ss, 1); ss += __shfl_xor(ss, 2); ss += __shfl_xor(ss, 4); ss += __shfl_xor(ss, 8);
      const float rs = rsqrtf(ss * (1.f / 64.f) + EPS);
      const float4 gg = ((const float4*)gdn)[lane & 15];
      u32x2 ou;
      ou.x = pack2(o[0] * rs * gg.x * siluf_(z[0]), o[1] * rs * gg.y * siluf_(z[1]));
      ou.y = pack2(o[2] * rs * gg.z * siluf_(z[2]), o[3] * rs * gg.w * siluf_(z[3]));
      ((u32x2*)(Y + (size_t)r * 1024 + 512))[lane] = ou;
    }
    {
      const float4* xr = (const float4*)(xg + (size_t)r * 1024);
      float4 v[4];
      float ss = 0.f;
#pragma unroll
      for (int i = 0; i < 4; ++i) { v[i] = xr[lane + 64 * i]; ss += v[i].x * v[i].x + v[i].y * v[i].y + v[i].z * v[i].z + v[i].w * v[i].w; }
      ss = wave_sum(ss);
      const float rs = rsqrtf(ss * (1.f / 1024.f) + EPS);
#pragma unroll
      for (int i = 0; i < 4; ++i) {
        const float4 gg = ((const float4*)gmix)[lane + 64 * i];
        u32x2 o; o.x = pack2(v[i].x * rs * gg.x, v[i].y * rs * gg.y); o.y = pack2(v[i].z * rs * gg.z, v[i].w * rs * gg.w);
        ((u32x2*)(Np + (size_t)r * 1024))[lane + 64 * i] = o;
      }
    }
  }
}

#define XB_TMO      128
#define XB_XCNT(j)  (256  + 64 * (j))
#define XB_XSUB(j)  (1280 + 64 * (j))
#define XB_XGEN(j)  (2304 + 64 * (j))
#define XB_TOP      3328
#define XB_TOPGEN   3392
#define XCD_BAR_WORDS 3456
#define XB_SPIN_CAP (1u << 27)
#define LAS __attribute__((address_space(3)))
constexpr size_t OFF_BAR = OFF_CNT + 65536;
DI unsigned xb_ld(unsigned* p) { return __hip_atomic_load(p, __ATOMIC_RELAXED, __HIP_MEMORY_SCOPE_AGENT); }
DI unsigned xb_add(unsigned* p, unsigned v) { return __hip_atomic_fetch_add(p, v, __ATOMIC_RELAXED, __HIP_MEMORY_SCOPE_AGENT); }
DI unsigned xb_xcc_id() { return (unsigned)__builtin_amdgcn_s_getreg((3 << 11) | 20) & 0xFu; }
#define XB_SPIN(cond, bar) do { unsigned _sp = 0; while (cond) { __builtin_amdgcn_s_sleep(1); \
    if ((++_sp & 255u) == 0u) { if (xb_ld(&(bar)[XB_TMO])) break; if (_sp > XB_SPIN_CAP) { atomicAdd(&(bar)[XB_TMO], 1u); break; } } } } while (0)
struct XcdBarrier { unsigned* bar; unsigned x; volatile LAS unsigned* st; };
DI XcdBarrier xcd_barrier_post(unsigned* bar, volatile LAS unsigned* st) {
  XcdBarrier b; b.bar = bar; b.x = xb_xcc_id(); b.st = st;
  if (threadIdx.x == 0) (void)xb_add(&bar[XB_XCNT(b.x)], 1u);
  return b;
}
DI void xcd_barrier_complete(unsigned* bar, unsigned x, unsigned& nloc, unsigned& nx) {
  const unsigned G = gridDim.x * gridDim.y * gridDim.z;
  unsigned sum, cnt, mine, sp = 0u;
  for (;;) {
    sum = 0u; cnt = 0u; mine = 0u;
#pragma unroll
    for (unsigned j = 0; j < 16; ++j) { const unsigned c = xb_ld(&bar[XB_XCNT(j)]); sum += c; cnt += (c > 0u) ? 1u : 0u; mine = (j == x) ? c : mine; }
    if (sum == G) break;
    __builtin_amdgcn_s_sleep(1);
    if ((++sp & 255u) == 0u) { if (xb_ld(&bar[XB_TMO])) break; if (sp > XB_SPIN_CAP) { atomicAdd(&bar[XB_TMO], 1u); break; } }
  }
  nloc = mine > 0u ? mine : 1u; nx = cnt > 0u ? cnt : 1u;
}
DI void xcd_barrier(const XcdBarrier& b) {
  asm volatile("s_waitcnt vmcnt(0)" ::: "memory");
  __syncthreads();
  if (threadIdx.x == 0) {
    unsigned* bar = b.bar;
    __builtin_amdgcn_s_waitcnt(0);
    unsigned nloc = b.st[0], nx = b.st[1];
    if (nloc == 0u) { xcd_barrier_complete(bar, b.x, nloc, nx); b.st[0] = nloc; b.st[1] = nx; }
    const unsigned old = xb_add(&bar[XB_XSUB(b.x)], 1u);
    const unsigned gen = old / nloc;
    if (old + 1u == (gen + 1u) * nloc) {
      __builtin_amdgcn_fence(__ATOMIC_RELEASE, "agent");
      asm volatile("s_waitcnt vmcnt(0)" ::: "memory");
      const unsigned og = xb_add(&bar[XB_TOP], 1u);
      const unsigned tg = og / nx;
      if (og + 1u == (tg + 1u) * nx) xb_add(&bar[XB_TOPGEN], 1u);
      else XB_SPIN(xb_ld(&bar[XB_TOPGEN]) == tg, bar);
      __builtin_amdgcn_fence(__ATOMIC_ACQUIRE, "agent");
      xb_add(&bar[XB_XGEN(b.x)], 1u);
      asm volatile("s_waitcnt vmcnt(0)" ::: "memory");
    } else {
      XB_SPIN(xb_ld(&bar[XB_XGEN(b.x)]) == gen, bar);
      __builtin_amdgcn_fence(__ATOMIC_ACQUIRE, "agent");
      asm volatile("s_waitcnt vmcnt(0)" ::: "memory");
    }
  }
  __syncthreads();
}

#ifndef REP_MIX
#define REP_MIX 1
#endif
#ifndef REP_GEMM
#define REP_GEMM 1
#endif
__global__ void __launch_bounds__(256, 2) mega(Params pk) {
  extern __shared__ __attribute__((aligned(16))) char lds[];
  __shared__ uint4 sh_words;
  cg::grid_group grid = cg::this_grid();
  CParams* kp = (CParams*)__builtin_amdgcn_kernarg_segment_ptr();
  if (threadIdx.x == 0) sh_words = make_uint4(0u, 0u, 0u, 0u);
  __syncthreads();
  XcdBarrier xb;
  { CParams& p = *launder(kp); xb = xcd_barrier_post((unsigned*)(p.ws + OFF_BAR), (volatile LAS unsigned*)&sh_words); }
#define s_item (((volatile int*)&sh_words)[2])
#define GSYNC() xcd_barrier(xb)
#define PP_ CParams& p = *launder(kp); const bf16_t* wb = (const bf16_t*)(p.ws + OFF_WB); bf16_t* Nb = (bf16_t*)(p.ws + OFF_N); \
            bf16_t* PRb = (bf16_t*)(p.ws + OFF_PR); bf16_t* Npb = (bf16_t*)(p.ws + OFF_Q); bf16_t* PB = (bf16_t*)(p.ws + OFF_OD); \
            float* xg = p.x + (size_t)grp * TG * 1024; (void)wb; (void)Nb; (void)PRb; (void)Npb; (void)PB; (void)xg;
  { CParams& p = *launder(kp); phase_init(p, lds); }
  grid.sync();
  for (int layer = 0; layer < 2; ++layer) {
    if (layer > 0) { CParams& p = *launder(kp); phase_convert(p, layer, lds); GSYNC(); }
    for (int grp = 0; grp < 2; ++grp) {
      const int S = grp ? 2048 : 16384, B = grp ? 16 : 2;
      const float* xsrc0 = nullptr;
      { CParams& p = *launder(kp); xsrc0 = layer == 0 ? p.x_in[grp] : p.x + (size_t)grp * TG * 1024; }
      { PP_ phase_norm(xsrc0, p.norm_ff1 + layer * 1024, Nb, nullptr, nullptr); }
      GSYNC();
      for (int rep = 0; rep < REP_GEMM; ++rep) {
        { PP_ phase_ffn_a(Nb, wb + W_FF1_1, wb + W_FF1_3, PRb, lds); }
        GSYNC();
      }
      { PP_ phase_gemm_resid(PRb, 2816, wb + W_FF1_2, xsrc0, xg, 0.5f, lds); }
      GSYNC();
      { PP_ phase_norm(xg, p.norm_mix + layer * 1024, Nb, nullptr, nullptr); }
      GSYNC();
      for (int rep = 0; rep < REP_GEMM; ++rep) {
        { PP_ phase_proj(p, Nb, wb + W_IN, S, lds); }
        GSYNC();
      }
      {
        PP_
        int* c0 = (int*)(p.ws + OFF_CNT) + (layer * 2 + grp) * 4;
        for (;;) {
          __syncthreads();
          if (threadIdx.x == 0) s_item = atomicAdd(c0, 1);
          __syncthreads();
          const int it = s_item;
          if (it >= 2048) break;
          dn_prep_item(p, layer, it, S, lds);
        }
      }
      GSYNC();
      {
        PP_
        int* c1 = (int*)(p.ws + OFF_CNT) + (layer * 2 + grp) * 4 + 1;
        const int nDN = B * 8, nDilX2 = p.big_ws ? 3072 : 0, total = nDN + 1024 + nDilX2;
        for (;;) {
          __syncthreads();
          if (threadIdx.x == 0) s_item = atomicAdd(c1, 1);
          __syncthreads();
          int it = s_item;
          if (it >= total) break;
          if (it < nDN) { dn_scan_chain(p, it, S, lds); continue; }
          it -= nDN;
          if (it < 1024) { diff_item(p, layer, it, S, lds); continue; }
          dil_item(p, it - 1024, S, B, lds);
        }
      }
      GSYNC();
      {
        PP_
        int* c2 = (int*)(p.ws + OFF_CNT) + (layer * 2 + grp) * 4 + 2;
        const int nDil = p.big_ws ? 0 : 3072, total = nDil + 256 * 7;
        for (;;) {
          __syncthreads();
          if (threadIdx.x == 0) s_item = atomicAdd(c2, 1);
          __syncthreads();
          int it = s_item;
          if (it >= total) break;
          if (it < nDil) { dil_item(p, it, S, B, lds); continue; }
          it -= nDil;
          mla_up_tile(p, it / 7, it % 7, S, lds);
        }
      }
      GSYNC();
      {
        PP_
        int* c3 = (int*)(p.ws + OFF_CNT) + (layer * 2 + grp) * 4 + 3;
        for (;;) {
          __syncthreads();
          if (threadIdx.x == 0) s_item = atomicAdd(c3, 1);
          __syncthreads();
          const int it = s_item;
          if (it >= 1024) break;
          mla_item(p, it, S, lds);
        }
      }
      GSYNC();
      { PP_ phase_combine(p, layer, xg); }
      GSYNC();
      for (int rep = 0; rep < REP_GEMM; ++rep) {
        { PP_ phase_merge(Npb, Nb, wb + W_G, wb + W_B, PRb, lds); }
        GSYNC();
      }
      { PP_ phase_gemm_resid(PRb, 1024, wb + W_O, xg, xg, 1.0f, lds); }
      GSYNC();
      { PP_ phase_norm(xg, p.norm_ff2 + layer * 1024, Nb, nullptr, nullptr); }
      GSYNC();
      for (int rep = 0; rep < REP_GEMM; ++rep) {
        { PP_ phase_ffn_a(Nb, wb + W_FF2_1, wb + W_FF2_3, PRb, lds); }
        GSYNC();
      }
      { PP_ phase_gemm_resid(PRb, 2816, wb + W_FF2_2, xg, xg, 0.5f, lds); }
      GSYNC();
      { PP_ phase_norm(xg, p.norm_ple + layer * 1024, Nb, p.p_in[grp] + (size_t)layer * TG * 256, PB); }
      GSYNC();
      { PP_ phase_ple(Nb, PB, wb + W_PG, wb + W_PP, xg, lds); }
      GSYNC();
    }
  }
  { CParams& p = *launder(kp); phase_final_norm(p.x, p.norm_final); }
}

extern "C" void kernel_launch(void* const* d_in, const int* in_sizes, int n_in, void* d_out, int out_size, void* d_ws,
                              size_t ws_size, hipStream_t stream) {
  (void)in_sizes; (void)n_in; (void)out_size;
  Params p{};
  p.x_in[0] = (const float*)d_in[0]; p.x_in[1] = (const float*)d_in[1];
  p.p_in[0] = (const float*)d_in[2]; p.p_in[1] = (const float*)d_in[3];
  p.norm_ff1 = (const float*)d_in[4]; p.ff1_w1 = (const float*)d_in[5]; p.ff1_w3 = (const float*)d_in[6];
  p.ff1_w2 = (const float*)d_in[7]; p.norm_mix = (const float*)d_in[8]; p.w_in = (const float*)d_in[9];
  p.mla_q_norm = (const float*)d_in[10]; p.mla_kv_norm = (const float*)d_in[11]; p.mla_w_uq = (const float*)d_in[12];
  p.mla_w_ukv = (const float*)d_in[13]; p.diff_lambda = (const float*)d_in[14]; p.diff_subln = (const float*)d_in[15];
  p.dn_conv = (const float*)d_in[16]; p.dn_a_log = (const float*)d_in[17]; p.dn_dt_bias = (const float*)d_in[18];
  p.dn_out_norm = (const float*)d_in[19]; p.w_branch = (const float*)d_in[20]; p.w_gate = (const float*)d_in[21];
  p.w_out = (const float*)d_in[22]; p.norm_ff2 = (const float*)d_in[23]; p.ff2_w1 = (const float*)d_in[24];
  p.ff2_w3 = (const float*)d_in[25]; p.ff2_w2 = (const float*)d_in[26]; p.norm_ple = (const float*)d_in[27];
  p.ple_gate = (const float*)d_in[28]; p.ple_proj = (const float*)d_in[29]; p.norm_final = (const float*)d_in[30];
  p.x = (float*)d_out;
  p.ws = (char*)d_ws;
  p.big_ws = (ws_size >= WS_BIG) ? 1 : 0;
  static int grid_blocks = 0;
  if (!grid_blocks) {
    int dev = 0, cus = 0, per_cu = 0;
    hipGetDevice(&dev);
    hipDeviceGetAttribute(&cus, hipDeviceAttributeMultiprocessorCount, dev);
    hipFuncSetAttribute((const void*)mega, hipFuncAttributeMaxDynamicSharedMemorySize, (int)LDS_BYTES);
    hipOccupancyMaxActiveBlocksPerMultiprocessor(&per_cu, mega, 256, LDS_BYTES);
    if (per_cu < 1) per_cu = 1;
    grid_blocks = cus * per_cu;
  }
  if (ws_size < WS_NEED) {
    fprintf(stderr, "workspace too small: %zu < %zu\n", ws_size, (size_t)WS_NEED);
    return;
  }
  (void)hipMemsetAsync((char*)d_ws + OFF_BAR, 0, XCD_BAR_WORDS * 4, stream);
  void* args[] = {&p};
  hipError_t e = hipLaunchCooperativeKernel((void*)mega, dim3(grid_blocks), dim3(256), args, LDS_BYTES, stream);
  if (e != hipSuccess) fprintf(stderr, "cooperative launch failed: %s (grid %d)\n", hipGetErrorString(e), grid_blocks);
}
```

```cpp
#include <hip/hip_runtime.h>
#include <hip/hip_cooperative_groups.h>
#include <stdint.h>
#include <stdio.h>
namespace cg = cooperative_groups;

typedef unsigned short bf16_t;
using bf16x8 = __attribute__((ext_vector_type(8))) short;
using bf16x4 = __attribute__((ext_vector_type(4))) short;
using f32x16 = __attribute__((ext_vector_type(16))) float;
using f32x4 = __attribute__((ext_vector_type(4))) float;
using u32x4 = __attribute__((ext_vector_type(4))) unsigned;
using u32x2 = __attribute__((ext_vector_type(2))) unsigned;

#define DI __device__ __forceinline__
#define MFMA32(a, b, c) __builtin_amdgcn_mfma_f32_32x32x16_bf16((a), (b), (c), 0, 0, 0)
#define MFMA16(a, b, c) __builtin_amdgcn_mfma_f32_16x16x32_bf16((a), (b), (c), 0, 0, 0)

constexpr int TG = 32768;
constexpr int NPR = 4608;
constexpr float EPS = 1e-6f;
constexpr float LOG2E = 1.4426950408889634f;
constexpr int C_CQ = 0, C_CKV = 256, C_BQ = 384, C_BK = 640, C_BV = 896, C_DNQKV = 1152, C_Z = 1920,
              C_DQ = 2176, C_DK = 2944, C_DV = 3712;
constexpr size_t MiB = 1048576;
constexpr size_t OFF_WB = 0, OFF_TAB = 57 * MiB, OFF_CNT = 63 * MiB, OFF_N = 64 * MiB, OFF_PR = 128 * MiB,
                 OFF_Q = 416 * MiB, OFF_K = 440 * MiB, OFF_V = 464 * MiB, OFF_AB = 480 * MiB, OFF_OD = 482 * MiB,
                 OFF_LSE = 530 * MiB, OFF_OF = 532 * MiB, OFF_OB = 548 * MiB, WS_NEED = 564 * MiB;
constexpr size_t W_FF1_1 = 0, W_FF1_3 = 2883584, W_FF1_2 = 5767168, W_IN = 8650752, W_UQ = 13369344,
                 W_UKV = 13467648, W_G = 13533184, W_B = 17727488, W_O = 18776064, W_FF2_1 = 19824640,
                 W_FF2_3 = 22708224, W_FF2_2 = 25591808, W_PG = 28475392, W_PP = 29523968;
constexpr size_t LDS_BYTES = 78336;

struct Params {
  const float* x_in[2];
  const float* p_in[2];
  const float *norm_ff1, *ff1_w1, *ff1_w3, *ff1_w2, *norm_mix, *w_in, *mla_q_norm, *mla_kv_norm, *mla_w_uq,
      *mla_w_ukv, *diff_lambda, *diff_subln, *dn_conv, *dn_a_log, *dn_dt_bias, *dn_out_norm, *w_branch, *w_gate,
      *w_out, *norm_ff2, *ff2_w1, *ff2_w3, *ff2_w2, *norm_ple, *ple_gate, *ple_proj, *norm_final;
  float* x;
  char* ws;
  long long big_ws;
};

typedef const __attribute__((address_space(4))) Params CParams;
DI CParams* launder(CParams* q) { asm volatile("" : "+s"(q)); return q; }

typedef __bf16 bf2_t __attribute__((ext_vector_type(2)));
typedef float f2_t __attribute__((ext_vector_type(2)));
DI bf16_t f2bf(float x) { return __builtin_bit_cast(bf16_t, (__bf16)x); }
DI float bf2f(bf16_t b) { return __uint_as_float(((unsigned)b) << 16); }
DI unsigned pack2(float a, float b) { f2_t v = {a, b}; return __builtin_bit_cast(unsigned, __builtin_convertvector(v, bf2_t)); }
DI float wave_sum(float v) {
#pragma unroll
  for (int o = 32; o > 0; o >>= 1) v += __shfl_xor(v, o);
  return v;
}
DI float sigmoidf_(float x) { return 1.f / (1.f + __expf(-x)); }
DI float siluf_(float x) { return x / (1.f + __expf(-x)); }
DI float exp2_(float x) { return __builtin_amdgcn_exp2f(x); }
DI int opq() { int z; asm volatile("v_mov_b32 %0, 0" : "=v"(z)); return z; }
DI float xhalf_max(float v) {
  const auto r = __builtin_amdgcn_permlane32_swap(__float_as_uint(v), __float_as_uint(v), false, false);
  return fmaxf(__uint_as_float(r[0]), __uint_as_float(r[1]));
}
DI int crow(int r, int h2) { return (r & 3) + 8 * (r >> 2) + 4 * h2; }
DI bf16x8 pack8(float a0, float a1, float a2, float a3, float a4, float a5, float a6, float a7) {
  u32x4 u;
  u.x = pack2(a0, a1); u.y = pack2(a2, a3); u.z = pack2(a4, a5); u.w = pack2(a6, a7);
  return __builtin_bit_cast(bf16x8, u);
}
DI bf16x8 ld2x4(const bf16_t* p0, const bf16_t* p1) {
  u32x2 a = *(const u32x2*)p0, b = *(const u32x2*)p1;
  u32x4 u; u.x = a.x; u.y = a.y; u.z = b.x; u.w = b.y;
  return __builtin_bit_cast(bf16x8, u);
}
DI void store8bf(bf16_t* dst, const float* v) {
  u32x4 u; u.x = pack2(v[0], v[1]); u.y = pack2(v[2], v[3]); u.z = pack2(v[4], v[5]); u.w = pack2(v[6], v[7]);
  *(u32x4*)dst = u;
}

struct MatDesc { const float* src; bf16_t* dst; int K, ldsrc, Ndst, map; const float* rowscale; };

DI int map_col(int map, int n) {
  if (map == 0) return n;
  if (map == 1) {
    if (n < 384) return n;
    if (n < 1920) return n + 32;
    if (n < 4480) return n + 48;
    if (n < 4512) return n - 4480 + 384;
    if (n < 4528) return n - 4512 + 1952;
    return -1;
  }
  if (n < 256) return (n >> 6) * 96 + (n & 63);
  return ((n - 256) >> 5) * 96 + 64 + ((n - 256) & 31);
}

DI MatDesc get_mat(CParams& p, int l, int id) {
  bf16_t* wb = (bf16_t*)(p.ws + OFF_WB);
  MatDesc d; d.map = 0; d.rowscale = nullptr;
  const size_t FF = (size_t)1024 * 2816;
  switch (id) {
    case 0: d.src = p.ff1_w1 + l * FF; d.dst = wb + W_FF1_1; d.K = 1024; d.ldsrc = 2816; d.Ndst = 2816; break;
    case 1: d.src = p.ff1_w3 + l * FF; d.dst = wb + W_FF1_3; d.K = 1024; d.ldsrc = 2816; d.Ndst = 2816; break;
    case 2: d.src = p.ff1_w2 + l * FF; d.dst = wb + W_FF1_2; d.K = 2816; d.ldsrc = 1024; d.Ndst = 1024; break;
    case 3: d.src = p.w_in + (size_t)l * 1024 * 4528; d.dst = wb + W_IN; d.K = 1024; d.ldsrc = 4528; d.Ndst = 4608; d.map = 1; break;
    case 4: d.src = p.mla_w_uq + (size_t)l * 256 * 384; d.dst = wb + W_UQ; d.K = 256; d.ldsrc = 384; d.Ndst = 384; d.map = 2; d.rowscale = p.mla_q_norm + l * 256; break;
    case 5: d.src = p.mla_w_ukv + (size_t)l * 128 * 512; d.dst = wb + W_UKV; d.K = 128; d.ldsrc = 512; d.Ndst = 512; d.rowscale = p.mla_kv_norm + l * 128; break;
    case 6: case 7: case 8: case 9:
      d.src = p.w_gate + (size_t)(l * 4 + id - 6) * 1048576; d.dst = wb + W_G + (size_t)(id - 6) * 1048576; d.K = 1024; d.ldsrc = 1024; d.Ndst = 1024; break;
    case 10: case 11: case 12: case 13:
      d.src = p.w_branch + (size_t)(l * 4 + id - 10) * 262144; d.dst = wb + W_B + (size_t)(id - 10) * 262144; d.K = 256; d.ldsrc = 1024; d.Ndst = 1024; break;
    case 14: d.src = p.w_out + (size_t)l * 1048576; d.dst = wb + W_O; d.K = 1024; d.ldsrc = 1024; d.Ndst = 1024; break;
    case 15: d.src = p.ff2_w1 + l * FF; d.dst = wb + W_FF2_1; d.K = 1024; d.ldsrc = 2816; d.Ndst = 2816; break;
    case 16: d.src = p.ff2_w3 + l * FF; d.dst = wb + W_FF2_3; d.K = 1024; d.ldsrc = 2816; d.Ndst = 2816; break;
    case 17: d.src = p.ff2_w2 + l * FF; d.dst = wb + W_FF2_2; d.K = 2816; d.ldsrc = 1024; d.Ndst = 1024; break;
    case 18: d.src = p.ple_gate + (size_t)l * 1048576; d.dst = wb + W_PG; d.K = 1024; d.ldsrc = 1024; d.Ndst = 1024; break;
    default: d.src = p.ple_proj + (size_t)l * 262144; d.dst = wb + W_PP; d.K = 256; d.ldsrc = 1024; d.Ndst = 1024; break;
  }
  return d;
}

DI void phase_convert(CParams& p, int l, char* lds) {
  float* T = (float*)lds;
  const int tid = threadIdx.x + opq();
  for (int id = 0; id < 20; ++id) {
    MatDesc d = get_mat(p, l, id);
    const int nkt = d.K >> 6, nnt = d.Ndst >> 6, nt_all = nkt * nnt;
    for (int t = blockIdx.x; t < nt_all; t += gridDim.x) {
      const int kt = t / nnt, nt = t % nnt;
      __syncthreads();
      {
        const int nl = tid & 63;
        const int sc = map_col(d.map, nt * 64 + nl);
#pragma unroll 4
        for (int i = 0; i < 16; ++i) {
          const int kl = (tid >> 6) + 4 * i;
          const int k = kt * 64 + kl;
          float v = 0.f;
          if (sc >= 0) v = d.src[(size_t)k * d.ldsrc + sc];
          if (d.rowscale) v *= d.rowscale[k];
          T[kl * 65 + nl] = v;
        }
      }
      __syncthreads();
      {
        const int kl = tid & 63;
#pragma unroll 4
        for (int i = 0; i < 16; ++i) {
          const int nl = (tid >> 6) + 4 * i;
          d.dst[(size_t)(nt * 64 + nl) * d.K + kt * 64 + kl] = f2bf(T[kl * 65 + nl]);
        }
      }
    }
  }
}

DI void phase_init(CParams& p, char* lds) {
  const size_t gtid = (size_t)blockIdx.x * 256 + threadIdx.x + opq(), gn = (size_t)gridDim.x * 256;
  {
    float2* t32 = (float2*)(p.ws + OFF_TAB);
    float2* t64 = (float2*)(p.ws + OFF_TAB + 2 * MiB);
    for (size_t i = gtid; i < (size_t)16384 * 48; i += gn) {
      const int pos = (int)(i / 48), f = (int)(i % 48);
      float inv;
      if (f < 16) inv = exp2f(-(float)f * (13.287712379549449f / 16.f));
      else inv = exp2f(-(float)(f - 16) * (13.287712379549449f / 32.f));
      const float ang = (float)pos * inv;
      const double xd = (double)ang;
      const double n = rint(xd * 0.15915494309189535);
      const float rf = (float)(xd - n * 6.283185307179586);
      float2 cs; cs.x = __cosf(rf); cs.y = __sinf(rf);
      if (f < 16) t32[(size_t)pos * 16 + f] = cs; else t64[(size_t)pos * 32 + (f - 16)] = cs;
    }
  }
  if (blockIdx.x == 0) ((int*)(p.ws + OFF_CNT))[threadIdx.x] = 0;
  phase_convert(p, 0, lds);
}

DI void phase_norm(const float* __restrict__ x, const float* __restrict__ g, bf16_t* __restrict__ dst,
                           const float* __restrict__ psrc, bf16_t* __restrict__ pdst) {
  const int tidq = threadIdx.x + opq(); const int wave = tidq >> 6, lane = tidq & 63;
  for (int r = blockIdx.x * 4 + wave; r < TG; r += gridDim.x * 4) {
    const float4* xr = (const float4*)(x + (size_t)r * 1024);
    float4 v[4];
    float ss = 0.f;
#pragma unroll
    for (int i = 0; i < 4; ++i) { v[i] = xr[lane + 64 * i]; ss += v[i].x * v[i].x + v[i].y * v[i].y + v[i].z * v[i].z + v[i].w * v[i].w; }
    ss = wave_sum(ss);
    const float rs = rsqrtf(ss * (1.f / 1024.f) + EPS);
#pragma unroll
    for (int i = 0; i < 4; ++i) {
      const float4 gg = ((const float4*)g)[lane + 64 * i];
      u32x2 o; o.x = pack2(v[i].x * rs * gg.x, v[i].y * rs * gg.y); o.y = pack2(v[i].z * rs * gg.z, v[i].w * rs * gg.w);
      ((u32x2*)(dst + (size_t)r * 1024))[lane + 64 * i] = o;
    }
    if (psrc) {
      const float4 pv = ((const float4*)(psrc + (size_t)r * 256))[lane];
      u32x2 o; o.x = pack2(pv.x, pv.y); o.y = pack2(pv.z, pv.w);
      ((u32x2*)(pdst + (size_t)r * 256))[lane] = o;
    }
  }
}

DI void phase_final_norm(float* __restrict__ x, const float* __restrict__ g) {
  const int tidq = threadIdx.x + opq(); const int wave = tidq >> 6, lane = tidq & 63;
  for (int r = blockIdx.x * 4 + wave; r < 2 * TG; r += gridDim.x * 4) {
    float4* xr = (float4*)(x + (size_t)r * 1024);
    float4 v[4];
    float ss = 0.f;
#pragma unroll
    for (int i = 0; i < 4; ++i) { v[i] = xr[lane + 64 * i]; ss += v[i].x * v[i].x + v[i].y * v[i].y + v[i].z * v[i].z + v[i].w * v[i].w; }
    ss = wave_sum(ss);
    const float rs = rsqrtf(ss * (1.f / 1024.f) + EPS);
#pragma unroll
    for (int i = 0; i < 4; ++i) {
      const float4 gg = ((const float4*)g)[lane + 64 * i];
      float4 o; o.x = v[i].x * rs * gg.x; o.y = v[i].y * rs * gg.y; o.z = v[i].z * rs * gg.z; o.w = v[i].w * rs * gg.w;
      xr[lane + 64 * i] = o;
    }
  }
}

template <int NI, int NB>
DI void gemm_main(f32x16 (&acc0)[2][NI], f32x16 (&acc1)[2][NI], const bf16_t* __restrict__ A, int lda,
                  const bf16_t* __restrict__ B0, const bf16_t* __restrict__ B1, int ldb, int K, char* lds) {
  const int tid = threadIdx.x + opq(), lane = tid & 63, w = tid >> 6, wm = w >> 1, wn = w & 1, l31 = lane & 31, h2 = lane >> 5;
  bf16_t* As = (bf16_t*)lds;
  bf16_t* B0s = As + 128 * 72;
  bf16_t* B1s = B0s + 64 * NI * 72;
  const int lr = tid >> 3, lc = (tid & 7) * 8;
  u32x4 ra[4], rb0[2 * NI], rb1[2 * NI];
  const bf16_t* ap = A + (size_t)lr * lda + lc;
  const bf16_t* bp0 = B0 + (size_t)lr * ldb + lc;
  const bf16_t* bp1 = (NB == 2) ? (B1 + (size_t)lr * ldb + lc) : B0;
#pragma unroll
  for (int i = 0; i < 4; ++i) ra[i] = *(const u32x4*)(ap + (size_t)(32 * i) * lda);
#pragma unroll
  for (int i = 0; i < 2 * NI; ++i) {
    rb0[i] = *(const u32x4*)(bp0 + (size_t)(32 * i) * ldb);
    if (NB == 2) rb1[i] = *(const u32x4*)(bp1 + (size_t)(32 * i) * ldb);
  }
  for (int k0 = 0; k0 < K; k0 += 64) {
    __syncthreads();
#pragma unroll
    for (int i = 0; i < 4; ++i) *(u32x4*)(As + (lr + 32 * i) * 72 + lc) = ra[i];
#pragma unroll
    for (int i = 0; i < 2 * NI; ++i) {
      *(u32x4*)(B0s + (lr + 32 * i) * 72 + lc) = rb0[i];
      if (NB == 2) *(u32x4*)(B1s + (lr + 32 * i) * 72 + lc) = rb1[i];
    }
    if (k0 + 64 < K) {
      const int kn = k0 + 64;
#pragma unroll
      for (int i = 0; i < 4; ++i) ra[i] = *(const u32x4*)(ap + (size_t)(32 * i) * lda + kn);
#pragma unroll
      for (int i = 0; i < 2 * NI; ++i) {
        rb0[i] = *(const u32x4*)(bp0 + (size_t)(32 * i) * ldb + kn);
        if (NB == 2) rb1[i] = *(const u32x4*)(bp1 + (size_t)(32 * i) * ldb + kn);
      }
    }
    __syncthreads();
    __builtin_amdgcn_s_setprio(1);
#pragma unroll
    for (int ks = 0; ks < 4; ++ks) {
      bf16x8 af[2], bf0[NI], bf1[NI];
#pragma unroll
      for (int mi = 0; mi < 2; ++mi) af[mi] = *(const bf16x8*)(As + (64 * wm + 32 * mi + l31) * 72 + 16 * ks + 8 * h2);
#pragma unroll
      for (int ni = 0; ni < NI; ++ni) {
        bf0[ni] = *(const bf16x8*)(B0s + (32 * NI * wn + 32 * ni + l31) * 72 + 16 * ks + 8 * h2);
        if (NB == 2) bf1[ni] = *(const bf16x8*)(B1s + (32 * NI * wn + 32 * ni + l31) * 72 + 16 * ks + 8 * h2);
      }
#pragma unroll
      for (int mi = 0; mi < 2; ++mi)
#pragma unroll
        for (int ni = 0; ni < NI; ++ni) {
          acc0[mi][ni] = MFMA32(af[mi], bf0[ni], acc0[mi][ni]);
          if (NB == 2) acc1[mi][ni] = MFMA32(af[mi], bf1[ni], acc1[mi][ni]);
        }
    }
    __builtin_amdgcn_s_setprio(0);
  }
}

template <int NI>
DI void zero_acc(f32x16 (&a)[2][NI]) {
#pragma unroll
  for (int mi = 0; mi < 2; ++mi)
#pragma unroll
    for (int ni = 0; ni < NI; ++ni)
#pragma unroll
      for (int r = 0; r < 16; ++r) a[mi][ni][r] = 0.f;
}

#define EPI_VARS const int tid = threadIdx.x + opq(), lane = tid & 63, w = tid >> 6, wm = w >> 1, wn = w & 1, l31 = lane & 31, h2 = lane >> 5; (void)tid; (void)lane; (void)w
#define EPI_BEGIN(NI_) _Pragma("unroll") for (int mi = 0; mi < 2; ++mi) _Pragma("unroll") for (int ni = 0; ni < NI_; ++ni) _Pragma("unroll") for (int r = 0; r < 16; ++r) { \
    const int row = 64 * wm + 32 * mi + crow(r, h2); const int col = 32 * NI_ * wn + 32 * ni + l31;
#define EPI_END }

DI bool xcd_tile(int iter, int MT, int NT, int& mt, int& nt) {
  const int x = blockIdx.x & 7, lb = blockIdx.x >> 3, nb = gridDim.x >> 3;
  const int full = NT >> 3, rem = NT & 7;
  const int per_full = full * MT, rem_tot = rem * MT;
  const int r0 = (rem_tot * x) >> 3, r1 = (rem_tot * (x + 1)) >> 3;
  const int j = lb + iter * nb;
  if (lb >= nb || j >= per_full + (r1 - r0)) return false;
  if (j < per_full) { mt = j / full; nt = x * full + j % full; }
  else { const int u = r0 + (j - per_full); nt = 8 * full + u / MT; mt = u % MT; }
  return true;
}

DI void phase_ffn_a(const bf16_t* __restrict__ Nb, const bf16_t* __restrict__ W1, const bf16_t* __restrict__ W3,
                            bf16_t* __restrict__ H, char* lds) {
  EPI_VARS;
  for (int iter = 0;; ++iter) {
    int mt, nt;
    if (!xcd_tile(iter, 256, 22, mt, nt)) break;
    f32x16 a0[2][2], a1[2][2];
    zero_acc<2>(a0); zero_acc<2>(a1);
    gemm_main<2, 2>(a0, a1, Nb + (size_t)mt * 128 * 1024, 1024, W1 + (size_t)nt * 128 * 1024, W3 + (size_t)nt * 128 * 1024, 1024, 1024, lds);
    EPI_BEGIN(2)
      H[(size_t)(mt * 128 + row) * 2816 + nt * 128 + col] = f2bf(siluf_(a0[mi][ni][r]) * a1[mi][ni][r]);
    EPI_END
  }
}

DI void phase_gemm_resid(const bf16_t* __restrict__ A, int K, const bf16_t* __restrict__ Bt, const float* xsrc, float* x,
                                 float scale, char* lds) {
  EPI_VARS;
  for (int iter = 0;; ++iter) {
    int mt, nt;
    if (!xcd_tile(iter, 256, 4, mt, nt)) break;
    f32x16 a0[2][4];
    zero_acc<4>(a0);
    gemm_main<4, 1>(a0, a0, A + (size_t)mt * 128 * K, K, Bt + (size_t)nt * 256 * K, nullptr, K, K, lds);
    EPI_BEGIN(4)
      const size_t off = (size_t)(mt * 128 + row) * 1024 + nt * 256 + col;
      x[off] = xsrc[off] + scale * a0[mi][ni][r];
    EPI_END
  }
}

DI void phase_ple(const bf16_t* __restrict__ Nb, const bf16_t* __restrict__ PB, const bf16_t* __restrict__ PG,
                          const bf16_t* __restrict__ PP, float* __restrict__ x, char* lds) {
  EPI_VARS;
  for (int iter = 0;; ++iter) {
    int mt, nt;
    if (!xcd_tile(iter, 256, 8, mt, nt)) break;
    f32x16 a0[2][2], a1[2][2];
    zero_acc<2>(a0); zero_acc<2>(a1);
    gemm_main<2, 1>(a0, a0, Nb + (size_t)mt * 128 * 1024, 1024, PG + (size_t)nt * 128 * 1024, nullptr, 1024, 1024, lds);
    gemm_main<2, 1>(a1, a1, PB + (size_t)mt * 128 * 256, 256, PP + (size_t)nt * 128 * 256, nullptr, 256, 256, lds);
    EPI_BEGIN(2)
      float* xp = x + (size_t)(mt * 128 + row) * 1024 + nt * 128 + col;
      *xp = *xp + sigmoidf_(a0[mi][ni][r]) * a1[mi][ni][r];
    EPI_END
  }
}

DI void phase_merge(const bf16_t* __restrict__ Np, const bf16_t* __restrict__ Y, const bf16_t* __restrict__ WG,
                            const bf16_t* __restrict__ WB, bf16_t* __restrict__ M, char* lds) {
  EPI_VARS;
  for (int iter = 0;; ++iter) {
    int mt, nt;
    if (!xcd_tile(iter, 256, 8, mt, nt)) break;
    f32x16 am[2][2];
    zero_acc<2>(am);
#pragma unroll 1
    for (int n = 0; n < 4; ++n) {
      unsigned sg[2][2][8];
      {
        f32x16 ag[2][2];
        zero_acc<2>(ag);
        gemm_main<2, 1>(ag, ag, Np + (size_t)mt * 128 * 1024, 1024, WG + (size_t)n * 1048576 + (size_t)nt * 128 * 1024, nullptr, 1024, 1024, lds);
#pragma unroll
        for (int mi = 0; mi < 2; ++mi)
#pragma unroll
          for (int ni = 0; ni < 2; ++ni)
#pragma unroll
            for (int r = 0; r < 8; ++r) sg[mi][ni][r] = pack2(sigmoidf_(ag[mi][ni][2 * r]), sigmoidf_(ag[mi][ni][2 * r + 1]));
      }
      f32x16 ab[2][2];
      zero_acc<2>(ab);
      gemm_main<2, 1>(ab, ab, Y + (size_t)mt * 128 * 1024 + n * 256, 1024, WB + (size_t)n * 262144 + (size_t)nt * 128 * 256, nullptr, 256, 256, lds);
#pragma unroll
      for (int mi = 0; mi < 2; ++mi)
#pragma unroll
        for (int ni = 0; ni < 2; ++ni)
#pragma unroll
          for (int r = 0; r < 8; ++r) {
            am[mi][ni][2 * r] += __uint_as_float(sg[mi][ni][r] << 16) * ab[mi][ni][2 * r];
            am[mi][ni][2 * r + 1] += __uint_as_float(sg[mi][ni][r] & 0xffff0000u) * ab[mi][ni][2 * r + 1];
          }
    }
    EPI_BEGIN(2)
      M[(size_t)(mt * 128 + row) * 1024 + nt * 128 + col] = f2bf(am[mi][ni][r]);
    EPI_END
  }
}

DI void rope32_out(const float* c, const float2* tab, float sc, float* o) {
#pragma unroll
  for (int i = 0; i < 16; ++i) {
    const float2 cs = tab[i];
    const float a = c[i], b = c[16 + i];
    o[i] = (a * cs.x - b * cs.y) * sc;
    o[16 + i] = (b * cs.x + a * cs.y) * sc;
  }
}

DI void phase_proj(CParams& p, const bf16_t* __restrict__ Nb, const bf16_t* __restrict__ WIN, int S, char* lds) {
  EPI_VARS;
  bf16_t* PR = (bf16_t*)(p.ws + OFF_PR);
  float* AB = (float*)(p.ws + OFF_AB);
  const float2* t32 = (const float2*)(p.ws + OFF_TAB);
  const float2* t64 = (const float2*)(p.ws + OFF_TAB + 2 * MiB);
  float* Ct = (float*)lds;
  for (int iter = 0;; ++iter) {
    int mt, nt2;
    if (!xcd_tile(iter, 256, 18, mt, nt2)) break;
    f32x16 a0[2][4];
    zero_acc<4>(a0);
    gemm_main<4, 1>(a0, a0, Nb + (size_t)mt * 128 * 1024, 1024, WIN + (size_t)nt2 * 256 * 1024, nullptr, 1024, 1024, lds);
   for (int hv = 0; hv < 2; ++hv) {
    const int nt = 2 * nt2 + hv;
    __syncthreads();
    if (wn == hv) {
#pragma unroll
      for (int mi = 0; mi < 2; ++mi)
#pragma unroll
        for (int ni = 0; ni < 4; ++ni)
#pragma unroll
          for (int r = 0; r < 16; ++r) Ct[(64 * wm + 32 * mi + crow(r, h2)) * 132 + 32 * ni + l31] = a0[mi][ni][r];
    }
    __syncthreads();
    const int erow = tid >> 1, half = tid & 1;
    const int tok = mt * 128 + erow, pos = tok & (S - 1);
    const float* cr = Ct + erow * 132 + 64 * half;
    bf16_t* dst = PR + (size_t)tok * NPR + nt * 128 + 64 * half;
    int type = 0; float sc = 1.f;
    if (nt == 3 || nt == 4) { type = 1; sc = 0.17677669529663687f * LOG2E; }
    else if (nt == 5 || nt == 6) { type = 1; }
    else if (nt >= 17 && nt <= 22) { type = 2; sc = 0.125f * LOG2E; }
    else if (nt >= 23 && nt <= 28) { type = 2; }
    else if (nt == 35) type = 3;
    if (type == 0) {
#pragma unroll
      for (int j = 0; j < 8; ++j) store8bf(dst + 8 * j, cr + 8 * j);
    } else if (type == 1) {
#pragma unroll
      for (int hh = 0; hh < 2; ++hh) {
        float o[32];
        rope32_out(cr + 32 * hh, t32 + (size_t)pos * 16, sc, o);
#pragma unroll
        for (int j = 0; j < 4; ++j) store8bf(dst + 32 * hh + 8 * j, o + 8 * j);
      }
    } else if (type == 2) {
      const float2* tab = t64 + (size_t)pos * 32;
#pragma unroll
      for (int j = 0; j < 4; ++j) {
        float lo[8], hi[8];
#pragma unroll
        for (int e = 0; e < 8; ++e) {
          const float2 cs = tab[8 * j + e];
          const float a = cr[8 * j + e], b = cr[32 + 8 * j + e];
          lo[e] = (a * cs.x - b * cs.y) * sc;
          hi[e] = (b * cs.x + a * cs.y) * sc;
        }
        store8bf(dst + 8 * j, lo);
        store8bf(dst + 32 + 8 * j, hi);
      }
    } else {
      if (half == 0) {
        float o[32];
        rope32_out(cr, t32 + (size_t)pos * 16, 1.f, o);
#pragma unroll
        for (int j = 0; j < 4; ++j) store8bf(dst + 8 * j, o + 8 * j);
      } else {
        const float* c2 = Ct + erow * 132 + 32;
#pragma unroll
        for (int j = 0; j < 4; ++j) {
          float4 v; v.x = c2[4 * j]; v.y = c2[4 * j + 1]; v.z = c2[4 * j + 2]; v.w = c2[4 * j + 3];
          ((float4*)(AB + (size_t)tok * 16))[j] = v;
        }
      }
    }
   }
  }
}

DI void mla_up_tile(CParams& p, int mt, int j, int S, char* lds) {
  EPI_VARS;
  const bf16_t* PR = (const bf16_t*)(p.ws + OFF_PR);
  const bf16_t* wb = (const bf16_t*)(p.ws + OFF_WB);
  bf16_t* Qb = (bf16_t*)(p.ws + OFF_Q);
  bf16_t* Kb = (bf16_t*)(p.ws + OFF_K);
  bf16_t* Vb = (bf16_t*)(p.ws + OFF_V);
  const float2* t32 = (const float2*)(p.ws + OFF_TAB);
  float* Ct = (float*)lds;
  float* rst = (float*)(lds + 67584);
  const bool isq = j < 3;
  const int K = isq ? 256 : 128;
  const int nt = isq ? j : j - 3;
  const bf16_t* A = PR + (size_t)mt * 128 * NPR + (isq ? C_CQ : C_CKV);
  const bf16_t* B = wb + (isq ? W_UQ : W_UKV) + (size_t)nt * 128 * K;
  const int erow = tid >> 1, half = tid & 1;
  {
    const bf16_t* ar = A + (size_t)erow * NPR + half * (K / 2);
    float ss = 0.f;
    for (int c = 0; c < K / 16; ++c) {
      const u32x4 u = *(const u32x4*)(ar + 8 * c);
      const unsigned uu[4] = {u.x, u.y, u.z, u.w};
#pragma unroll
      for (int e = 0; e < 4; ++e) {
        const float lo = __uint_as_float(uu[e] << 16), hi = __uint_as_float(uu[e] & 0xffff0000u);
        ss += lo * lo + hi * hi;
      }
    }
    ss += __shfl_xor(ss, 1);
    if (half == 0) rst[erow] = rsqrtf(ss / (float)K + EPS);
  }
  f32x16 a0[2][2];
  zero_acc<2>(a0);
  gemm_main<2, 1>(a0, a0, A, NPR, B, nullptr, K, K, lds);
  __syncthreads();
  EPI_BEGIN(2)
    Ct[row * 132 + col] = a0[mi][ni][r];
  EPI_END
  __syncthreads();
  const int tok = mt * 128 + erow, pos = tok & (S - 1);
  const float rs = rst[erow];
  const float* cr = Ct + erow * 132 + 64 * half;
  if (isq) {
    const float sc = rs * 0.10206207261596577f * LOG2E;
    if (nt < 2) {
      bf16_t* dst = Qb + ((size_t)tok * 4 + 2 * nt + half) * 96;
#pragma unroll
      for (int jj = 0; jj < 8; ++jj) {
        float o[8];
#pragma unroll
        for (int e = 0; e < 8; ++e) o[e] = cr[8 * jj + e] * sc;
        store8bf(dst + 8 * jj, o);
      }
    } else {
#pragma unroll
      for (int hh = 0; hh < 2; ++hh) {
        float o[32];
        rope32_out(cr + 32 * hh, t32 + (size_t)pos * 16, sc, o);
        bf16_t* dst = Qb + ((size_t)tok * 4 + 2 * half + hh) * 96 + 64;
#pragma unroll
        for (int jj = 0; jj < 4; ++jj) store8bf(dst + 8 * jj, o + 8 * jj);
      }
    }
  } else {
    bf16_t* dst = half == 0 ? (Kb + ((size_t)tok * 4 + nt) * 96) : (Vb + ((size_t)tok * 4 + nt) * 64);
#pragma unroll
    for (int jj = 0; jj < 8; ++jj) {
      float o[8];
#pragma unroll
      for (int e = 0; e < 8; ++e) o[e] = cr[8 * jj + e] * rs;
      store8bf(dst + 8 * jj, o);
    }
    if (half == 0) {
      const u32x4* src = (const u32x4*)(PR + (size_t)tok * NPR + 4480);
#pragma unroll
      for (int jj = 0; jj < 4; ++jj) ((u32x4*)(dst + 64))[jj] = src[jj];
    }
  }
}

typedef short s16x4_t __attribute__((ext_vector_type(4)));
DI bf16x8 tr_pair(const bf16_t* p0, const bf16_t* p1) {
  const s16x4_t lo = __builtin_amdgcn_ds_read_tr16_b64_v4i16((__attribute__((address_space(3))) s16x4_t*)p0);
  const s16x4_t hi = __builtin_amdgcn_ds_read_tr16_b64_v4i16((__attribute__((address_space(3))) s16x4_t*)p1);
  return __builtin_shufflevector(lo, hi, 0, 1, 2, 3, 4, 5, 6, 7);
}

template <int DK, bool BAND>
DI void flash_loop(f32x16 (&O)[2], float& m, float& l, const bf16_t* __restrict__ qrow, const bf16_t* __restrict__ kbase,
                   size_t kstride, const bf16_t* __restrict__ vbase, size_t vstride, int ntiles, int tq, int u0, int L,
                   char* lds) {
  const int tid = threadIdx.x + opq(), lane = tid & 63, l31 = lane & 31, h2 = lane >> 5;
  constexpr int KR = DK + 8, KCH = DK / 8, KN = 64 * KCH / 256;
  constexpr int STAGE = 64 * KR * 2 + 64 * 72 * 2;
  bf16x8 qf[DK / 16];
#pragma unroll
  for (int ks = 0; ks < DK / 16; ++ks) qf[ks] = *(const bf16x8*)(qrow + 16 * ks + 8 * h2);
  u32x4 rk[KN], rv[2];
  auto gload = [&](int kt) {
#pragma unroll
    for (int i = 0; i < KN; ++i) {
      const int ci = tid + 256 * i, row = ci / KCH, c = ci % KCH;
      int rr = u0 + 64 * kt + row;
      if (BAND) rr = min(max(rr, 0), L - 1);
      rk[i] = *(const u32x4*)(kbase + (size_t)rr * kstride + c * 8);
    }
#pragma unroll
    for (int i = 0; i < 2; ++i) {
      const int ci = tid + 256 * i, row = ci >> 3, c = ci & 7;
      int rr = u0 + 64 * kt + row;
      if (BAND) rr = min(max(rr, 0), L - 1);
      rv[i] = *(const u32x4*)(vbase + (size_t)rr * vstride + c * 8);
    }
  };
  auto swrite = [&](int st) {
    bf16_t* Ks = (bf16_t*)(lds + st * STAGE);
    bf16_t* Vs = Ks + 64 * KR;
#pragma unroll
    for (int i = 0; i < KN; ++i) {
      const int ci = tid + 256 * i, row = ci / KCH, c = ci % KCH;
      *(u32x4*)(Ks + row * KR + c * 8) = rk[i];
    }
#pragma unroll
    for (int i = 0; i < 2; ++i) {
      const int ci = tid + 256 * i, row = ci >> 3, c = ci & 7;
      *(u32x4*)(Vs + row * 72 + c * 8) = rv[i];
    }
  };
  const int trq = (lane & 15) >> 2, trp = lane & 3, trblk = (lane >> 4) & 1;
  const int troff = (4 * h2 + trq) * 72 + 16 * trblk + 4 * trp;
  __syncthreads();
  gload(0);
  swrite(0);
  if (ntiles > 1) gload(1);
  for (int kt = 0; kt < ntiles; ++kt) {
    __syncthreads();
    if (kt + 1 < ntiles) swrite((kt + 1) & 1);
    if (kt + 2 < ntiles) gload(kt + 2);
    const bf16_t* Ks = (const bf16_t*)(lds + (kt & 1) * STAGE);
    const bf16_t* Vs = Ks + 64 * KR;
    f32x16 Sx[2];
#pragma unroll
    for (int j = 0; j < 2; ++j)
#pragma unroll
      for (int r = 0; r < 16; ++r) Sx[j][r] = 0.f;
#pragma unroll
    for (int ks = 0; ks < DK / 16; ++ks)
#pragma unroll
      for (int j = 0; j < 2; ++j) {
        const bf16x8 kf = *(const bf16x8*)(Ks + (32 * j + l31) * KR + 16 * ks + 8 * h2);
        Sx[j] = MFMA32(kf, qf[ks], Sx[j]);
      }
    if (BAND) {
#pragma unroll
      for (int j = 0; j < 2; ++j)
#pragma unroll
        for (int r = 0; r < 16; ++r) {
          const int u = u0 + 64 * kt + 32 * j + crow(r, h2);
          const int d = u - tq;
          const bool valid = (d <= 64) && (d >= -64) && (u >= 0) && (u < L);
          Sx[j][r] = valid ? Sx[j][r] : -1e30f;
        }
    }
    float mx = Sx[0][0];
#pragma unroll
    for (int j = 0; j < 2; ++j)
#pragma unroll
      for (int r = 0; r < 16; ++r) mx = fmaxf(mx, Sx[j][r]);
    mx = xhalf_max(mx);
    const float mn = fmaxf(m, mx);
    const float alpha = exp2_(m - mn);
    const bool grew = mn > m;
    m = mn;
    float ls = 0.f;
#pragma unroll
    for (int j = 0; j < 2; ++j)
#pragma unroll
      for (int r = 0; r < 16; ++r) { const float pv = exp2_(Sx[j][r] - mn); Sx[j][r] = pv; ls += pv; }
    l = l * alpha + ls;
    if (__any(grew)) {
#pragma unroll
      for (int t = 0; t < 2; ++t)
#pragma unroll
        for (int r = 0; r < 16; ++r) O[t][r] *= alpha;
    }
#pragma unroll
    for (int j = 0; j < 2; ++j)
#pragma unroll
      for (int s = 0; s < 2; ++s) {
        const bf16x8 pf = pack8(Sx[j][8 * s], Sx[j][8 * s + 1], Sx[j][8 * s + 2], Sx[j][8 * s + 3], Sx[j][8 * s + 4],
                                Sx[j][8 * s + 5], Sx[j][8 * s + 6], Sx[j][8 * s + 7]);
#pragma unroll
        for (int t = 0; t < 2; ++t) {
          const bf16_t* vp = Vs + (32 * j + 16 * s) * 72 + 32 * t + troff;
          const bf16x8 vf = tr_pair(vp, vp + 8 * 72);
          O[t] = MFMA32(vf, pf, O[t]);
        }
      }
  }
}

DI void flash_loop_diff(f32x16 (&O0)[2], f32x16 (&O1)[2], float& m0, float& l0, float& m1, float& l1,
                        const bf16_t* __restrict__ qrow, const bf16_t* __restrict__ kbase, size_t kstride,
                        const bf16_t* __restrict__ vbase, size_t vstride, int ntiles, char* lds) {
  const int tid = threadIdx.x + opq(), lane = tid & 63, l31 = lane & 31, h2 = lane >> 5;
  constexpr int KR = 72;
  constexpr int STAGE = 64 * KR * 2 + 64 * 72 * 2;
  bf16x8 qf0[2], qf1[2];
#pragma unroll
  for (int ks = 0; ks < 2; ++ks) {
    qf0[ks] = *(const bf16x8*)(qrow + 16 * ks + 8 * h2);
    qf1[ks] = *(const bf16x8*)(qrow + 32 + 16 * ks + 8 * h2);
  }
  u32x4 rk[2], rv[2];
  auto gload = [&](int kt) {
#pragma unroll
    for (int i = 0; i < 2; ++i) {
      const int ci = tid + 256 * i, row = ci >> 3, c = ci & 7;
      const int rr = 64 * kt + row;
      rk[i] = *(const u32x4*)(kbase + (size_t)rr * kstride + c * 8);
      rv[i] = *(const u32x4*)(vbase + (size_t)rr * vstride + c * 8);
    }
  };
  auto swrite = [&](int st) {
    bf16_t* Ks = (bf16_t*)(lds + st * STAGE);
    bf16_t* Vs = Ks + 64 * KR;
#pragma unroll
    for (int i = 0; i < 2; ++i) {
      const int ci = tid + 256 * i, row = ci >> 3, c = ci & 7;
      *(u32x4*)(Ks + row * KR + c * 8) = rk[i];
      *(u32x4*)(Vs + row * 72 + c * 8) = rv[i];
    }
  };
  const int trq = (lane & 15) >> 2, trp = lane & 3, trblk = (lane >> 4) & 1;
  const int troff = (4 * h2 + trq) * 72 + 16 * trblk + 4 * trp;
  __syncthreads();
  gload(0);
  swrite(0);
  if (ntiles > 1) gload(1);
  for (int kt = 0; kt < ntiles; ++kt) {
    __syncthreads();
    if (kt + 1 < ntiles) swrite((kt + 1) & 1);
    if (kt + 2 < ntiles) gload(kt + 2);
    const bf16_t* Ks = (const bf16_t*)(lds + (kt & 1) * STAGE);
    const bf16_t* Vs = Ks + 64 * KR;
    bf16x8 pf[2][2][2];
#pragma unroll
    for (int mp = 0; mp < 2; ++mp) {
      f32x16 Sx[2];
#pragma unroll
      for (int j = 0; j < 2; ++j)
#pragma unroll
        for (int r = 0; r < 16; ++r) Sx[j][r] = 0.f;
#pragma unroll
      for (int ks = 0; ks < 2; ++ks)
#pragma unroll
        for (int j = 0; j < 2; ++j) {
          const bf16x8 kf = *(const bf16x8*)(Ks + (32 * j + l31) * KR + 32 * mp + 16 * ks + 8 * h2);
          Sx[j] = MFMA32(kf, mp == 0 ? qf0[ks] : qf1[ks], Sx[j]);
        }
      float& m = mp == 0 ? m0 : m1;
      float& l = mp == 0 ? l0 : l1;
      float mx = Sx[0][0];
#pragma unroll
      for (int j = 0; j < 2; ++j)
#pragma unroll
        for (int r = 0; r < 16; ++r) mx = fmaxf(mx, Sx[j][r]);
      mx = xhalf_max(mx);
      const float mn = fmaxf(m, mx);
      const float alpha = exp2_(m - mn);
      const bool grew = mn > m;
      m = mn;
      float ls = 0.f;
#pragma unroll
      for (int j = 0; j < 2; ++j)
#pragma unroll
        for (int r = 0; r < 16; ++r) { const float pv = exp2_(Sx[j][r] - mn); Sx[j][r] = pv; ls += pv; }
      l = l * alpha + ls;
      if (__any(grew)) {
#pragma unroll
        for (int t = 0; t < 2; ++t)
#pragma unroll
          for (int r = 0; r < 16; ++r) { if (mp == 0) O0[t][r] *= alpha; else O1[t][r] *= alpha; }
      }
#pragma unroll
      for (int j = 0; j < 2; ++j)
#pragma unroll
        for (int s = 0; s < 2; ++s)
          pf[mp][j][s] = pack8(Sx[j][8 * s], Sx[j][8 * s + 1], Sx[j][8 * s + 2], Sx[j][8 * s + 3], Sx[j][8 * s + 4],
                               Sx[j][8 * s + 5], Sx[j][8 * s + 6], Sx[j][8 * s + 7]);
    }
#pragma unroll
    for (int j = 0; j < 2; ++j)
#pragma unroll
      for (int s = 0; s < 2; ++s)
#pragma unroll
        for (int t = 0; t < 2; ++t) {
          const bf16_t* vp = Vs + (32 * j + 16 * s) * 72 + 32 * t + troff;
          const bf16x8 vf = tr_pair(vp, vp + 8 * 72);
          O0[t] = MFMA32(vf, pf[0][j][s], O0[t]);
          O1[t] = MFMA32(vf, pf[1][j][s], O1[t]);
        }
  }
}

DI void zeroO(f32x16 (&O)[2]) {
#pragma unroll
  for (int t = 0; t < 2; ++t)
#pragma unroll
    for (int r = 0; r < 16; ++r) O[t][r] = 0.f;
}

DI void store_o(bf16_t* dst, const f32x16 (&O)[2], int h2) {
#pragma unroll
  for (int t = 0; t < 2; ++t)
#pragma unroll
    for (int g = 0; g < 4; ++g) {
      u32x2 u; u.x = pack2(O[t][4 * g], O[t][4 * g + 1]); u.y = pack2(O[t][4 * g + 2], O[t][4 * g + 3]);
      *(u32x2*)(dst + 32 * t + 8 * g + 4 * h2) = u;
    }
}

DI void mla_item(CParams& p, int it, int S, char* lds) {
  const int tid = threadIdx.x + opq(), lane = tid & 63, w = tid >> 6, l31 = lane & 31, h2 = lane >> 5;
  const int lgq = (S == 2048) ? 4 : 7;
  const int qb = it & ((1 << lgq) - 1), bh = it >> lgq, h = bh & 3, b = bh >> 2;
  const int tokbase = b * S, gtok = tokbase + 128 * qb + 32 * w + l31;
  const bf16_t* Qb = (const bf16_t*)(p.ws + OFF_Q);
  const bf16_t* Kb = (const bf16_t*)(p.ws + OFF_K);
  const bf16_t* Vb = (const bf16_t*)(p.ws + OFF_V);
  bf16_t* Y = (bf16_t*)(p.ws + OFF_N);
  f32x16 O[2]; zeroO(O);
  float m = -1e30f, l = 0.f;
  flash_loop<96, false>(O, m, l, Qb + ((size_t)gtok * 4 + h) * 96, Kb + ((size_t)tokbase * 4 + h) * 96, 384,
                        Vb + ((size_t)tokbase * 4 + h) * 64, 256, S / 64, 0, 0, 0, lds);
  l += __shfl_xor(l, 32);
  const float il = 1.f / l;
#pragma unroll
  for (int t = 0; t < 2; ++t)
#pragma unroll
    for (int r = 0; r < 16; ++r) O[t][r] *= il;
  store_o(Y + (size_t)gtok * 1024 + h * 64, O, h2);
}

DI void diff_item(CParams& p, int layer, int it, int S, char* lds) {
  const int tid = threadIdx.x + opq(), lane = tid & 63, w = tid >> 6, l31 = lane & 31, h2 = lane >> 5;
  const int lgq = (S == 2048) ? 4 : 7;
  const int qb = it & ((1 << lgq) - 1), bh = it >> lgq, h = bh & 3, b = bh >> 2;
  const int tokbase = b * S, gtok = tokbase + 128 * qb + 32 * w + l31;
  const bf16_t* PR = (const bf16_t*)(p.ws + OFF_PR);
  bf16_t* Y = (bf16_t*)(p.ws + OFF_N);
  const float* lam = p.diff_lambda + layer * 128;
  float s1 = 0.f, s2 = 0.f;
  if (lane < 32) { s1 = lam[lane] * lam[32 + lane]; s2 = lam[64 + lane] * lam[96 + lane]; }
  s1 = wave_sum(s1); s2 = wave_sum(s2);
  const float lambda_init = layer ? 0.35550907f : 0.2f;
  const float lambda_full = expf(s1) - expf(s2) + lambda_init;
  f32x16 of[2], O1[2];
  zeroO(of); zeroO(O1);
  {
    float m0 = -1e30f, l0 = 0.f, m1 = -1e30f, l1 = 0.f;
    flash_loop_diff(of, O1, m0, l0, m1, l1, PR + (size_t)gtok * NPR + C_BQ + (2 * h) * 32,
                    PR + (size_t)tokbase * NPR + C_BK + (2 * h) * 32, NPR, PR + (size_t)tokbase * NPR + C_BV + h * 64, NPR,
                    S / 64, lds);
    l0 += __shfl_xor(l0, 32);
    l1 += __shfl_xor(l1, 32);
    const float c0 = 1.f / l0, c1 = -lambda_full / l1;
#pragma unroll
    for (int t = 0; t < 2; ++t)
#pragma unroll
      for (int r = 0; r < 16; ++r) of[t][r] = c0 * of[t][r] + c1 * O1[t][r];
  }
  float ss = 0.f;
#pragma unroll
  for (int t = 0; t < 2; ++t)
#pragma unroll
    for (int r = 0; r < 16; ++r) ss += of[t][r] * of[t][r];
  ss += __shfl_xor(ss, 32);
  const float rs = rsqrtf(ss * (1.f / 64.f) + EPS) * (1.f - lambda_init);
  const float* sg = p.diff_subln + layer * 64;
#pragma unroll
  for (int t = 0; t < 2; ++t)
#pragma unroll
    for (int r = 0; r < 16; ++r) of[t][r] *= rs * sg[32 * t + crow(r, h2)];
  store_o(Y + (size_t)gtok * 1024 + 256 + h * 64, of, h2);
}

DI void dil_item(CParams& p, int it, int S, int B, char* lds) {
  const int tid = threadIdx.x + opq(), lane = tid & 63, w = tid >> 6, l31 = lane & 31, h2 = lane >> 5;
  const int lgS = (S == 2048) ? 11 : 14, lgB = (B == 16) ? 4 : 1;
  const int rq = it & ((1 << (lgS - 7)) - 1);
  int rest = it >> (lgS - 7);
  const int head = rest & 3; rest >>= 2;
  const int b = rest & (B - 1), g = rest >> lgB;
  const int lgd = 2 * g, dil = 1 << lgd;
  const int L = S >> lgd, lgnqb = lgS - lgd - 7;
  const int res = rq >> lgnqb, qb = rq & ((1 << lgnqb) - 1);
  const int tokbase = b * S;
  const int tq = 128 * qb + 32 * w + l31;
  const int gtok = tokbase + tq * dil + res;
  const bf16_t* PR = (const bf16_t*)(p.ws + OFF_PR);
  bf16_t* OD = (bf16_t*)(p.ws + OFF_OD);
  float* LSE = (float*)(p.ws + OFF_LSE);
  f32x16 O[2]; zeroO(O);
  float m = -1e30f, l = 0.f;
  const int hc = (g * 4 + head) * 64;
  flash_loop<64, true>(O, m, l, PR + (size_t)gtok * NPR + C_DQ + hc, PR + (size_t)(tokbase + res) * NPR + C_DK + hc,
                       (size_t)dil * NPR, PR + (size_t)(tokbase + res) * NPR + C_DV + hc, (size_t)dil * NPR, 4, tq,
                       128 * qb - 64, L, lds);
  l += __shfl_xor(l, 32);
  const float il = 1.f / l;
#pragma unroll
  for (int t = 0; t < 2; ++t)
#pragma unroll
    for (int r = 0; r < 16; ++r) O[t][r] *= il;
  store_o(OD + ((size_t)g * TG + gtok) * 256 + head * 64, O, h2);
  if (h2 == 0) LSE[((size_t)g * TG + gtok) * 4 + head] = m + __log2f(l);
}

constexpr size_t OFF_X2 = 564 * MiB, WS_BIG = 597 * MiB;
#define DN_QK_OFF (p.big_ws ? OFF_X2 : OFF_OD)
#define DN_GC_OFF ((p.big_ws ? OFF_X2 : OFF_OD) + 32 * MiB)
constexpr size_t DN_UW_OFF = OFF_Q;

DI void dn_prep_item(CParams& p, int layer, int it, int S, char* lds) {
  const int tid = threadIdx.x + opq(), lane = tid & 63, w = tid >> 6, l15 = lane & 15, g4 = lane >> 4;
  const int NC = S / 64;
  const int ch = it % NC, bh = it / NC, h = bh & 3, b = bh >> 2;
  const int tokbase = b * S, s0 = ch * 64;
  const bf16_t* PR = (const bf16_t*)(p.ws + OFF_PR);
  const float* AB = (const float*)(p.ws + OFF_AB);
  bf16_t* QKg = (bf16_t*)(p.ws + DN_QK_OFF) + ((size_t)bh * NC + ch) * 8192;
  bf16_t* raw = (bf16_t*)lds;
  float* convw = (float*)(lds + 27200);
  float* RU = (float*)lds;
  float* RW = (float*)(lds + 16384);
  float* Am = (float*)(lds + 32768);
  bf16_t* Kimg = (bf16_t*)(lds + 50176);
  bf16_t* Qimg = (bf16_t*)(lds + 59392);
  float* gcs = (float*)(lds + 68608);
  float* betas = gcs + 128;
  const float* cw = p.dn_conv + (size_t)layer * 5 * 768;
  {
    u32x4 rawreg[7];
    float cwr[4];
#pragma unroll
    for (int k = 0; k < 7; ++k) {
      const int ci = tid + 256 * k;
      const int rr = ci / 24, c = ci % 24, seg = c >> 3, c8 = c & 7;
      const int s = s0 + rr - 2;
      rawreg[k] = u32x4{0u, 0u, 0u, 0u};
      if (ci < 68 * 24 && s >= 0 && s < S)
        rawreg[k] = *(const u32x4*)(PR + (size_t)(tokbase + s) * NPR + C_DNQKV + seg * 256 + h * 64 + c8 * 8);
    }
#pragma unroll
    for (int k = 0; k < 4; ++k) {
      const int i = tid + 256 * k;
      cwr[k] = 0.f;
      if (i < 960) { const int j = i / 192, c = i % 192; cwr[k] = cw[j * 768 + (c >> 6) * 256 + h * 64 + (c & 63)]; }
    }
#pragma unroll
    for (int k = 0; k < 7; ++k) {
      const int ci = tid + 256 * k;
      const int rr = ci / 24, c = ci % 24, seg = c >> 3, c8 = c & 7;
      if (ci < 68 * 24) *(u32x4*)(raw + rr * 200 + seg * 64 + c8 * 8) = rawreg[k];
    }
#pragma unroll
    for (int k = 0; k < 4; ++k) { const int i = tid + 256 * k; if (i < 960) convw[i] = cwr[k]; }
  }
  if (tid < 128) {
    const int d = tid >> 6, pl = tid & 63;
    const int i = d ? 63 - pl : pl;
    const size_t tok = (size_t)tokbase + s0 + i;
    const float Aexp = expf(p.dn_a_log[layer * 8 + d * 4 + h]);
    const float a = AB[tok * 16 + d * 8 + h] + p.dn_dt_bias[layer * 8 + d * 4 + h];
    const float bb = AB[tok * 16 + d * 8 + 4 + h];
    const float sp = fmaxf(a, 0.f) + __logf(1.f + __expf(-fabsf(a)));
    float g = -Aexp * sp;
#pragma unroll
    for (int o = 1; o < 64; o <<= 1) { const float tv = __shfl_up(g, o); if (lane >= o) g += tv; }
    gcs[tid] = g;
    betas[tid] = sigmoidf_(bb);
    float* GC = (float*)(p.ws + DN_GC_OFF) + (((size_t)bh * 2 + d) * NC + ch) * 64;
    GC[pl] = g;
  }
  __syncthreads();
  const int pp = tid >> 2, cgp = tid & 3;
  float kv[16], vv[16];
  {
    float qv[16];
#pragma unroll
    for (int seg = 0; seg < 3; ++seg) {
      float acc[16];
#pragma unroll
      for (int c = 0; c < 16; ++c) acc[c] = 0.f;
#pragma unroll
      for (int j = 0; j < 5; ++j) {
        const bf16_t* rp = raw + (pp + j) * 200 + seg * 64 + 16 * cgp;
        const float* wp = convw + j * 192 + seg * 64 + 16 * cgp;
        const u32x4 u0 = *(const u32x4*)rp, u1 = *(const u32x4*)(rp + 8);
        const unsigned uu[8] = {u0.x, u0.y, u0.z, u0.w, u1.x, u1.y, u1.z, u1.w};
#pragma unroll
        for (int e = 0; e < 8; ++e) {
          acc[2 * e] += wp[2 * e] * __uint_as_float(uu[e] << 16);
          acc[2 * e + 1] += wp[2 * e + 1] * __uint_as_float(uu[e] & 0xffff0000u);
        }
      }
#pragma unroll
      for (int c = 0; c < 16; ++c) {
        const float sv = acc[c] * __builtin_amdgcn_rcpf(1.f + __expf(-acc[c]));
        if (seg == 0) qv[c] = sv; else if (seg == 1) kv[c] = sv; else vv[c] = sv;
      }
    }
    float sq = 0.f, sk = 0.f;
#pragma unroll
    for (int c = 0; c < 16; ++c) { sq += qv[c] * qv[c]; sk += kv[c] * kv[c]; }
    sq += __shfl_xor(sq, 1); sq += __shfl_xor(sq, 2);
    sk += __shfl_xor(sk, 1); sk += __shfl_xor(sk, 2);
    const float rq = rsqrtf(sq + EPS) * 0.125f, rk = rsqrtf(sk + EPS);
#pragma unroll
    for (int c = 0; c < 16; ++c) { qv[c] *= rq; kv[c] *= rk; }
    store8bf(Kimg + pp * 72 + 16 * cgp, kv); store8bf(Kimg + pp * 72 + 16 * cgp + 8, kv + 8);
    store8bf(Qimg + pp * 72 + 16 * cgp, qv); store8bf(Qimg + pp * 72 + 16 * cgp + 8, qv + 8);
    store8bf(QKg + pp * 64 + 16 * cgp, qv); store8bf(QKg + pp * 64 + 16 * cgp + 8, qv + 8);
    store8bf(QKg + 4096 + pp * 64 + 16 * cgp, kv); store8bf(QKg + 4096 + pp * 64 + 16 * cgp + 8, kv + 8);
  }
  for (int d = 0; d < 2; ++d) {
    __syncthreads();
    {
      const int pl = d ? 63 - pp : pp;
      const float bet = betas[d * 64 + pl], egc = __expf(gcs[d * 64 + pl]);
#pragma unroll
      for (int c = 0; c < 16; ++c) {
        RU[pl * 64 + 16 * cgp + c] = vv[c] * bet;
        RW[pl * 64 + 16 * cgp + c] = kv[c] * bet * egc;
      }
    }
    {
      f32x4 KK[4];
#pragma unroll
      for (int t = 0; t < 4; ++t) KK[t] = f32x4{0.f, 0.f, 0.f, 0.f};
      const int jl = 16 * w + l15;
      const int jrow = d ? 63 - jl : jl;
#pragma unroll
      for (int ks = 0; ks < 2; ++ks) {
        const bf16x8 bfk = *(const bf16x8*)(Kimg + jrow * 72 + 32 * ks + 8 * g4);
#pragma unroll
        for (int rt = 0; rt < 4; ++rt) {
          const int il = 16 * rt + l15;
          const int irow = d ? 63 - il : il;
          const bf16x8 afk = *(const bf16x8*)(Kimg + irow * 72 + 32 * ks + 8 * g4);
          KK[rt] = MFMA16(afk, bfk, KK[rt]);
        }
      }
      const float gcj = gcs[d * 64 + jl];
#pragma unroll
      for (int rt = 0; rt < 4; ++rt)
#pragma unroll
        for (int r = 0; r < 4; ++r) {
          const int i = 16 * rt + 4 * g4 + r;
          const float ee = __expf(fminf(gcs[d * 64 + i] - gcj, 0.f));
          Am[i * 68 + jl] = (i > jl) ? betas[d * 64 + i] * KK[rt][r] * ee : 0.f;
        }
    }
    __syncthreads();
    float xs[32];
#pragma unroll
    for (int q = 0; q < 32; ++q) xs[q] = 0.f;
    const int c = tid >> 1, half = tid & 1;
    {
      const float* Rc = (c < 64) ? (RU + c) : (RW + (c - 64));
      const float* Ah = Am + 4 * half;
#pragma unroll
      for (int i = 0; i < 64; ++i) {
        float part = 0.f;
#pragma unroll
        for (int q = 0; q < (i + 7) / 8; ++q) {
          const f32x4 a = *(const f32x4*)(Ah + i * 68 + 8 * q);
          part += a[0] * xs[4 * q] + a[1] * xs[4 * q + 1] + a[2] * xs[4 * q + 2] + a[3] * xs[4 * q + 3];
        }
        const float other = __int_as_float(__builtin_amdgcn_update_dpp(0, __float_as_int(part), 0xB1, 0xf, 0xf, true));
        const float xi = Rc[i * 64] - (part + other);
        const int loc = ((i >> 3) << 2) + (i & 3);
        if (((i >> 2) & 1) == 0) xs[loc] = (half == 0) ? xi : xs[loc];
        else xs[loc] = (half == 1) ? xi : xs[loc];
        if (i < 16 ? ((i & 7) == 7) : (i < 32 ? ((i & 3) == 3) : ((i & 1) == 1))) asm volatile("" ::: "memory");
      }
    }
    {
      bf16_t* UWg = (bf16_t*)(p.ws + DN_UW_OFF) + ((((size_t)bh * 2 + d) * NC + ch) * 8192);
      const float sgn = (c < 64) ? 1.f : -1.f;
      bf16_t* dst = UWg + ((c < 64) ? c : (4096 + c - 64));
#pragma unroll
      for (int loc = 0; loc < 32; ++loc) {
        const int i = (((loc >> 2) * 2 + half) << 2) + (loc & 3);
        dst[i * 64] = f2bf(sgn * xs[loc]);
      }
    }
  }
}

DI void dn_scan_chain(CParams& p, int it, int S, char* lds) {
  __builtin_amdgcn_s_setprio(3);
  const int tid0 = threadIdx.x + opq();
  const int dir = it & 1, bh = it >> 1, h = bh & 3, b = bh >> 2;
  const int tokbase = b * S, NC = S / 64;
  bf16_t* OUT = (bf16_t*)(p.ws + (dir ? OFF_OB : OFF_OF));
  const bf16_t* QKg = (const bf16_t*)(p.ws + DN_QK_OFF) + (size_t)bh * NC * 8192;
  const bf16_t* UWg = (const bf16_t*)(p.ws + DN_UW_OFF) + (size_t)it * NC * 8192;
  const float* GCg = (const float*)(p.ws + DN_GC_OFF) + (size_t)it * NC * 64;
  bf16_t* Uimg = (bf16_t*)lds;
  bf16_t* Wn = Uimg + 4608;
  bf16_t* Qimg = Wn + 4608;
  bf16_t* Kimg = Qimg + 4608;
  bf16_t* Kt = Kimg + 4608;
  bf16_t* Iimg = Kt + 4608;
  float* gcs = (float*)(lds + 6 * 9216);
  f32x4 Sd[4];
#pragma unroll
  for (int t = 0; t < 4; ++t) Sd[t] = f32x4{0.f, 0.f, 0.f, 0.f};
  u32x4 ru[2], rw[2], rq[2], rk[2];
  float rg = 0.f;
  auto prefetch = [&](int cc_) {
    const int ch_ = dir ? (NC - 1 - cc_) : cc_;
    const int tp = tid0 + opq();
    const bf16_t* uw = UWg + (size_t)ch_ * 8192;
    const bf16_t* qk = QKg + (size_t)ch_ * 8192;
#pragma unroll
    for (int k = 0; k < 2; ++k) {
      const int ci = tp + 256 * k, row = ci >> 3, c8 = ci & 7;
      const int srow = dir ? 63 - row : row;
      ru[k] = *(const u32x4*)(uw + row * 64 + c8 * 8);
      rw[k] = *(const u32x4*)(uw + 4096 + row * 64 + c8 * 8);
      rq[k] = *(const u32x4*)(qk + srow * 64 + c8 * 8);
      rk[k] = *(const u32x4*)(qk + 4096 + srow * 64 + c8 * 8);
    }
    if (tp < 64) rg = GCg[(size_t)ch_ * 64 + tp];
  };
  prefetch(0);
  for (int cc = 0; cc < NC; ++cc) {
    const int tid = tid0 + opq(), lane = tid & 63, w = tid >> 6, l15 = lane & 15, g4 = lane >> 4;
    const int e_col = 16 * w + l15;
    const int ch = dir ? (NC - 1 - cc) : cc;
    const int s0 = ch * 64;
    __syncthreads();
#pragma unroll
    for (int k = 0; k < 2; ++k) {
      const int ci = tid + 256 * k, row = ci >> 3, c8 = ci & 7;
      *(u32x4*)(Uimg + row * 72 + c8 * 8) = ru[k];
      *(u32x4*)(Wn + row * 72 + c8 * 8) = rw[k];
      *(u32x4*)(Qimg + row * 72 + c8 * 8) = rq[k];
      *(u32x4*)(Kimg + row * 72 + c8 * 8) = rk[k];
      const unsigned uu[4] = {rk[k].x, rk[k].y, rk[k].z, rk[k].w};
#pragma unroll
      for (int e = 0; e < 4; ++e) {
        Kt[(8 * c8 + 2 * e) * 72 + row] = (bf16_t)(uu[e] & 0xffffu);
        Kt[(8 * c8 + 2 * e + 1) * 72 + row] = (bf16_t)(uu[e] >> 16);
      }
    }
    if (tid < 64) gcs[tid] = rg;
    if (cc + 1 < NC) prefetch(cc + 1);
    __syncthreads();
    {
      f32x4 QK[4];
#pragma unroll
      for (int t = 0; t < 4; ++t) QK[t] = f32x4{0.f, 0.f, 0.f, 0.f};
#pragma unroll
      for (int ks = 0; ks < 2; ++ks) {
        const bf16x8 bfk = *(const bf16x8*)(Kimg + (16 * w + l15) * 72 + 32 * ks + 8 * g4);
#pragma unroll
        for (int rt = 0; rt < 4; ++rt) {
          const bf16x8 afq = *(const bf16x8*)(Qimg + (16 * rt + l15) * 72 + 32 * ks + 8 * g4);
          QK[rt] = MFMA16(afq, bfk, QK[rt]);
        }
      }
      const float gcj = gcs[e_col];
#pragma unroll
      for (int rt = 0; rt < 4; ++rt)
#pragma unroll
        for (int r = 0; r < 4; ++r) {
          const int i = 16 * rt + 4 * g4 + r;
          const float ee = __expf(fminf(gcs[i] - gcj, 0.f));
          Iimg[i * 72 + e_col] = f2bf((i >= e_col) ? QK[rt][r] * ee : 0.f);
        }
    }
    __syncthreads();
    {
      bf16x8 Bs[2];
#pragma unroll
      for (int ks = 0; ks < 2; ++ks)
        Bs[ks] = pack8(Sd[2 * ks][0], Sd[2 * ks][1], Sd[2 * ks][2], Sd[2 * ks][3], Sd[2 * ks + 1][0], Sd[2 * ks + 1][1],
                       Sd[2 * ks + 1][2], Sd[2 * ks + 1][3]);
      f32x4 vn[4], qs[4], iv[4];
#pragma unroll
      for (int rt = 0; rt < 4; ++rt) {
#pragma unroll
        for (int r = 0; r < 4; ++r) vn[rt][r] = bf2f(Uimg[(16 * rt + 4 * g4 + r) * 72 + e_col]);
        qs[rt] = f32x4{0.f, 0.f, 0.f, 0.f};
        iv[rt] = f32x4{0.f, 0.f, 0.f, 0.f};
#pragma unroll
        for (int ks = 0; ks < 2; ++ks) {
          const bf16_t* wp = Wn + (16 * rt + l15) * 72 + 32 * ks + 4 * g4;
          const bf16_t* qp = Qimg + (16 * rt + l15) * 72 + 32 * ks + 4 * g4;
          vn[rt] = MFMA16(ld2x4(wp, wp + 16), Bs[ks], vn[rt]);
          qs[rt] = MFMA16(ld2x4(qp, qp + 16), Bs[ks], qs[rt]);
        }
      }
      bf16x8 Bv[2];
#pragma unroll
      for (int ks = 0; ks < 2; ++ks)
        Bv[ks] = pack8(vn[2 * ks][0], vn[2 * ks][1], vn[2 * ks][2], vn[2 * ks][3], vn[2 * ks + 1][0], vn[2 * ks + 1][1],
                       vn[2 * ks + 1][2], vn[2 * ks + 1][3]);
#pragma unroll
      for (int rt = 0; rt < 4; ++rt)
#pragma unroll
        for (int ks = 0; ks < 2; ++ks) {
          const bf16_t* ip = Iimg + (16 * rt + l15) * 72 + 32 * ks + 4 * g4;
          iv[rt] = MFMA16(ld2x4(ip, ip + 16), Bv[ks], iv[rt]);
        }
      const float gc63 = gcs[63];
#pragma unroll
      for (int rt = 0; rt < 4; ++rt)
#pragma unroll
        for (int r = 0; r < 4; ++r) {
          const int pos = 16 * rt + 4 * g4 + r;
          const float o = qs[rt][r] * __expf(gcs[pos]) + iv[rt][r];
          const int i = dir ? 63 - pos : pos;
          OUT[((size_t)tokbase + s0 + i) * 256 + h * 64 + e_col] = f2bf(o);
          vn[rt][r] *= __expf(gc63 - gcs[pos]);
        }
      bf16x8 Bv2[2];
#pragma unroll
      for (int ks = 0; ks < 2; ++ks)
        Bv2[ks] = pack8(vn[2 * ks][0], vn[2 * ks][1], vn[2 * ks][2], vn[2 * ks][3], vn[2 * ks + 1][0], vn[2 * ks + 1][1],
                        vn[2 * ks + 1][2], vn[2 * ks + 1][3]);
      const float gl = __expf(gc63);
#pragma unroll
      for (int dt = 0; dt < 4; ++dt) {
#pragma unroll
        for (int r = 0; r < 4; ++r) Sd[dt][r] *= gl;
#pragma unroll
        for (int ks = 0; ks < 2; ++ks) {
          const bf16_t* kp = Kt + (16 * dt + l15) * 72 + 32 * ks + 4 * g4;
          Sd[dt] = MFMA16(ld2x4(kp, kp + 16), Bv2[ks], Sd[dt]);
        }
      }
    }
  }
  __builtin_amdgcn_s_setprio(0);
}

DI void phase_combine(CParams& p, int layer, const float* __restrict__ xg) {
  const int tidq = threadIdx.x + opq(); const int wave = tidq >> 6, lane = tidq & 63;
  const bf16_t* PR = (const bf16_t*)(p.ws + OFF_PR);
  const bf16_t* OD = (const bf16_t*)(p.ws + OFF_OD);
  const float* LSE = (const float*)(p.ws + OFF_LSE);
  const bf16_t* OFb = (const bf16_t*)(p.ws + OFF_OF);
  const bf16_t* OBb = (const bf16_t*)(p.ws + OFF_OB);
  bf16_t* Y = (bf16_t*)(p.ws + OFF_N);
  bf16_t* Np = (bf16_t*)(p.ws + OFF_Q);
  const float* gmix = p.norm_mix + layer * 1024;
  const float* gdn = p.dn_out_norm + layer * 64;
  const int head = lane >> 4;
  for (int r = blockIdx.x * 4 + wave; r < TG; r += gridDim.x * 4) {
    {
      float lg[3];
#pragma unroll
      for (int g = 0; g < 3; ++g) lg[g] = LSE[((size_t)g * TG + r) * 4 + head];
      const float mx = fmaxf(lg[0], fmaxf(lg[1], lg[2]));
      float wg[3], den = 0.f;
#pragma unroll
      for (int g = 0; g < 3; ++g) { wg[g] = exp2_(lg[g] - mx); den += wg[g]; }
      const float id = 1.f / den;
      float o[4] = {0.f, 0.f, 0.f, 0.f};
#pragma unroll
      for (int g = 0; g < 3; ++g) {
        const u32x2 u = ((const u32x2*)(OD + ((size_t)g * TG + r) * 256))[lane];
        const float c = wg[g] * id;
        o[0] += c * __uint_as_float(u.x << 16); o[1] += c * __uint_as_float(u.x & 0xffff0000u);
        o[2] += c * __uint_as_float(u.y << 16); o[3] += c * __uint_as_float(u.y & 0xffff0000u);
      }
      u32x2 ou; ou.x = pack2(o[0], o[1]); ou.y = pack2(o[2], o[3]);
      ((u32x2*)(Y + (size_t)r * 1024 + 768))[lane] = ou;
    }
    {
      const u32x2 uf = ((const u32x2*)(OFb + (size_t)r * 256))[lane];
      const u32x2 ub = ((const u32x2*)(OBb + (size_t)r * 256))[lane];
      const u32x2 uz = ((const u32x2*)(PR + (size_t)r * NPR + C_Z))[lane];
      float o[4], z[4];
      o[0] = __uint_as_float(uf.x << 16) + __uint_as_float(ub.x << 16);
      o[1] = __uint_as_float(uf.x & 0xffff0000u) + __uint_as_float(ub.x & 0xffff0000u);
      o[2] = __uint_as_float(uf.y << 16) + __uint_as_float(ub.y << 16);
      o[3] = __uint_as_float(uf.y & 0xffff0000u) + __uint_as_float(ub.y & 0xffff0000u);
      z[0] = __uint_as_float(uz.x << 16); z[1] = __uint_as_float(uz.x & 0xffff0000u);
      z[2] = __uint_as_float(uz.y << 16); z[3] = __uint_as_float(uz.y & 0xffff0000u);
      float ss = o[0] * o[0] + o[1] * o[1] + o[2] * o[2] + o[3] * o[3];
      ss += __shfl_xor(ss, 1); ss += __shfl_xor(ss, 2); ss += __shfl_xor(ss, 4); ss += __shfl_xor(ss, 8);
      const float rs = rsqrtf(ss * (1.f / 64.f) + EPS);
      const float4 gg = ((const float4*)gdn)[lane & 15];
      u32x2 ou;
      ou.x = pack2(o[0] * rs * gg.x * siluf_(z[0]), o[1] * rs * gg.y * siluf_(z[1]));
      ou.y = pack2(o[2] * rs * gg.z * siluf_(z[2]), o[3] * rs * gg.w * siluf_(z[3]));
      ((u32x2*)(Y + (size_t)r * 1024 + 512))[lane] = ou;
    }
    {
      const float4* xr = (const float4*)(xg + (size_t)r * 1024);
      float4 v[4];
      float ss = 0.f;
#pragma unroll
      for (int i = 0; i < 4; ++i) { v[i] = xr[lane + 64 * i]; ss += v[i].x * v[i].x + v[i].y * v[i].y + v[i].z * v[i].z + v[i].w * v[i].w; }
      ss = wave_sum(ss);
      const float rs = rsqrtf(ss * (1.f / 1024.f) + EPS);
#pragma unroll
      for (int i = 0; i < 4; ++i) {
        const float4 gg = ((const float4*)gmix)[lane + 64 * i];
        u32x2 o; o.x = pack2(v[i].x * rs * gg.x, v[i].y * rs * gg.y); o.y = pack2(v[i].z * rs * gg.z, v[i].w * rs * gg.w);
        ((u32x2*)(Np + (size_t)r * 1024))[lane + 64 * i] = o;
      }
    }
  }
}

#define XB_TMO      128
#define XB_XCNT(j)  (256  + 64 * (j))
#define XB_XSUB(j)  (1280 + 64 * (j))
#define XB_XGEN(j)  (2304 + 64 * (j))
#define XB_TOP      3328
#define XB_TOPGEN   3392
#define XCD_BAR_WORDS 3456
#define XB_SPIN_CAP (1u << 27)
#define LAS __attribute__((address_space(3)))
constexpr size_t OFF_BAR = OFF_CNT + 65536;
DI unsigned xb_ld(unsigned* p) { return __hip_atomic_load(p, __ATOMIC_RELAXED, __HIP_MEMORY_SCOPE_AGENT); }
DI unsigned xb_add(unsigned* p, unsigned v) { return __hip_atomic_fetch_add(p, v, __ATOMIC_RELAXED, __HIP_MEMORY_SCOPE_AGENT); }
DI unsigned xb_xcc_id() { return (unsigned)__builtin_amdgcn_s_getreg((3 << 11) | 20) & 0xFu; }
#define XB_SPIN(cond, bar) do { unsigned _sp = 0; while (cond) { __builtin_amdgcn_s_sleep(1); \
    if ((++_sp & 255u) == 0u) { if (xb_ld(&(bar)[XB_TMO])) break; if (_sp > XB_SPIN_CAP) { atomicAdd(&(bar)[XB_TMO], 1u); break; } } } } while (0)
struct XcdBarrier { unsigned* bar; unsigned x; volatile LAS unsigned* st; };
DI XcdBarrier xcd_barrier_post(unsigned* bar, volatile LAS unsigned* st) {
  XcdBarrier b; b.bar = bar; b.x = xb_xcc_id(); b.st = st;
  if (threadIdx.x == 0) (void)xb_add(&bar[XB_XCNT(b.x)], 1u);
  return b;
}
DI void xcd_barrier_complete(unsigned* bar, unsigned x, unsigned& nloc, unsigned& nx) {
  const unsigned G = gridDim.x * gridDim.y * gridDim.z;
  unsigned sum, cnt, mine, sp = 0u;
  for (;;) {
    sum = 0u; cnt = 0u; mine = 0u;
#pragma unroll
    for (unsigned j = 0; j < 16; ++j) { const unsigned c = xb_ld(&bar[XB_XCNT(j)]); sum += c; cnt += (c > 0u) ? 1u : 0u; mine = (j == x) ? c : mine; }
    if (sum == G) break;
    __builtin_amdgcn_s_sleep(1);
    if ((++sp & 255u) == 0u) { if (xb_ld(&bar[XB_TMO])) break; if (sp > XB_SPIN_CAP) { atomicAdd(&bar[XB_TMO], 1u); break; } }
  }
  nloc = mine > 0u ? mine : 1u; nx = cnt > 0u ? cnt : 1u;
}
DI void xcd_barrier(const XcdBarrier& b) {
  asm volatile("s_waitcnt vmcnt(0)" ::: "memory");
  __syncthreads();
  if (threadIdx.x == 0) {
    unsigned* bar = b.bar;
    __builtin_amdgcn_s_waitcnt(0);
    unsigned nloc = b.st[0], nx = b.st[1];
    if (nloc == 0u) { xcd_barrier_complete(bar, b.x, nloc, nx); b.st[0] = nloc; b.st[1] = nx; }
    const unsigned old = xb_add(&bar[XB_XSUB(b.x)], 1u);
    const unsigned gen = old / nloc;
    if (old + 1u == (gen + 1u) * nloc) {
      __builtin_amdgcn_fence(__ATOMIC_RELEASE, "agent");
      asm volatile("s_waitcnt vmcnt(0)" ::: "memory");
      const unsigned og = xb_add(&bar[XB_TOP], 1u);
      const unsigned tg = og / nx;
      if (og + 1u == (tg + 1u) * nx) xb_add(&bar[XB_TOPGEN], 1u);
      else XB_SPIN(xb_ld(&bar[XB_TOPGEN]) == tg, bar);
      __builtin_amdgcn_fence(__ATOMIC_ACQUIRE, "agent");
      xb_add(&bar[XB_XGEN(b.x)], 1u);
      asm volatile("s_waitcnt vmcnt(0)" ::: "memory");
    } else {
      XB_SPIN(xb_ld(&bar[XB_XGEN(b.x)]) == gen, bar);
      __builtin_amdgcn_fence(__ATOMIC_ACQUIRE, "agent");
      asm volatile("s_waitcnt vmcnt(0)" ::: "memory");
    }
  }
  __syncthreads();
}

#ifndef REP_MIX
#define REP_MIX 1
#endif
#ifndef REP_GEMM
#define REP_GEMM 1
#endif
__global__ void __launch_bounds__(256, 2) mega(Params pk) {
  extern __shared__ __attribute__((aligned(16))) char lds[];
  __shared__ uint4 sh_words;
  cg::grid_group grid = cg::this_grid();
  CParams* kp = (CParams*)__builtin_amdgcn_kernarg_segment_ptr();
  if (threadIdx.x == 0) sh_words = make_uint4(0u, 0u, 0u, 0u);
  __syncthreads();
  XcdBarrier xb;
  { CParams& p = *launder(kp); xb = xcd_barrier_post((unsigned*)(p.ws + OFF_BAR), (volatile LAS unsigned*)&sh_words); }
#define s_item (((volatile int*)&sh_words)[2])
#define GSYNC() xcd_barrier(xb)
#define PP_ CParams& p = *launder(kp); const bf16_t* wb = (const bf16_t*)(p.ws + OFF_WB); bf16_t* Nb = (bf16_t*)(p.ws + OFF_N); \
            bf16_t* PRb = (bf16_t*)(p.ws + OFF_PR); bf16_t* Npb = (bf16_t*)(p.ws + OFF_Q); bf16_t* PB = (bf16_t*)(p.ws + OFF_OD); \
            float* xg = p.x + (size_t)grp * TG * 1024; (void)wb; (void)Nb; (void)PRb; (void)Npb; (void)PB; (void)xg;
  { CParams& p = *launder(kp); phase_init(p, lds); }
  grid.sync();
  for (int layer = 0; layer < 2; ++layer) {
    if (layer > 0) { CParams& p = *launder(kp); phase_convert(p, layer, lds); GSYNC(); }
    for (int grp = 0; grp < 2; ++grp) {
      const int S = grp ? 2048 : 16384, B = grp ? 16 : 2;
      const float* xsrc0 = nullptr;
      { CParams& p = *launder(kp); xsrc0 = layer == 0 ? p.x_in[grp] : p.x + (size_t)grp * TG * 1024; }
      { PP_ phase_norm(xsrc0, p.norm_ff1 + layer * 1024, Nb, nullptr, nullptr); }
      GSYNC();
      for (int rep = 0; rep < REP_GEMM; ++rep) {
        { PP_ phase_ffn_a(Nb, wb + W_FF1_1, wb + W_FF1_3, PRb, lds); }
        GSYNC();
      }
      { PP_ phase_gemm_resid(PRb, 2816, wb + W_FF1_2, xsrc0, xg, 0.5f, lds); }
      GSYNC();
      { PP_ phase_norm(xg, p.norm_mix + layer * 1024, Nb, nullptr, nullptr); }
      GSYNC();
      for (int rep = 0; rep < REP_GEMM; ++rep) {
        { PP_ phase_proj(p, Nb, wb + W_IN, S, lds); }
        GSYNC();
      }
      {
        PP_
        int* c0 = (int*)(p.ws + OFF_CNT) + (layer * 2 + grp) * 4;
        for (;;) {
          __syncthreads();
          if (threadIdx.x == 0) s_item = atomicAdd(c0, 1);
          __syncthreads();
          const int it = s_item;
          if (it >= 2048) break;
          dn_prep_item(p, layer, it, S, lds);
        }
      }
      GSYNC();
      {
        PP_
        int* cb = (int*)(p.ws + OFF_CNT) + 64 + (layer * 2 + grp) * 32;
        const int nDN = B * 8, nDil = p.big_ws ? 3072 : 0;
        const int lgq = grp ? 4 : 7;
        for (;;) {
          __syncthreads();
          if (threadIdx.x == 0) s_item = atomicAdd(cb, 1);
          __syncthreads();
          const int it = s_item;
          if (it >= nDN) break;
          dn_scan_chain(p, it, S, lds);
        }
        for (int xo = 0; xo < 8; ++xo) {
          const int xq = (blockIdx.x + xo) & 7;
          for (;;) {
            __syncthreads();
            if (threadIdx.x == 0) s_item = atomicAdd(cb + 8 + xq, 1);
            __syncthreads();
            const int j = s_item;
            if (j >= 128) break;
            const int pair = xq + 8 * (j >> lgq), qb = j & ((1 << lgq) - 1);
            diff_item(p, layer, (pair << lgq) + qb, S, lds);
          }
        }
        for (;;) {
          __syncthreads();
          if (threadIdx.x == 0) s_item = atomicAdd(cb + 1, 1);
          __syncthreads();
          const int it = s_item;
          if (it >= nDil) break;
          dil_item(p, it, S, B, lds);
        }
      }
      GSYNC();
      {
        PP_
        int* c2 = (int*)(p.ws + OFF_CNT) + (layer * 2 + grp) * 4 + 2;
        const int nDil = p.big_ws ? 0 : 3072, total = nDil + 256 * 7;
        for (;;) {
          __syncthreads();
          if (threadIdx.x == 0) s_item = atomicAdd(c2, 1);
          __syncthreads();
          int it = s_item;
          if (it >= total) break;
          if (it < nDil) { dil_item(p, it, S, B, lds); continue; }
          it -= nDil;
          mla_up_tile(p, it / 7, it % 7, S, lds);
        }
      }
      GSYNC();
      {
        PP_
        int* cb = (int*)(p.ws + OFF_CNT) + 64 + (layer * 2 + grp) * 32 + 16;
        const int lgq = grp ? 4 : 7;
        for (int xo = 0; xo < 8; ++xo) {
          const int xq = (blockIdx.x + xo) & 7;
          for (;;) {
            __syncthreads();
            if (threadIdx.x == 0) s_item = atomicAdd(cb + xq, 1);
            __syncthreads();
            const int j = s_item;
            if (j >= 128) break;
            const int pair = xq + 8 * (j >> lgq), qb = j & ((1 << lgq) - 1);
            mla_item(p, (pair << lgq) + qb, S, lds);
          }
        }
      }
      GSYNC();
      { PP_ phase_combine(p, layer, xg); }
      GSYNC();
      for (int rep = 0; rep < REP_GEMM; ++rep) {
        { PP_ phase_merge(Npb, Nb, wb + W_G, wb + W_B, PRb, lds); }
        GSYNC();
      }
      { PP_ phase_gemm_resid(PRb, 1024, wb + W_O, xg, xg, 1.0f, lds); }
      GSYNC();
      { PP_ phase_norm(xg, p.norm_ff2 + layer * 1024, Nb, nullptr, nullptr); }
      GSYNC();
      for (int rep = 0; rep < REP_GEMM; ++rep) {
        { PP_ phase_ffn_a(Nb, wb + W_FF2_1, wb + W_FF2_3, PRb, lds); }
        GSYNC();
      }
      { PP_ phase_gemm_resid(PRb, 2816, wb + W_FF2_2, xg, xg, 0.5f, lds); }
      GSYNC();
      { PP_ phase_norm(xg, p.norm_ple + layer * 1024, Nb, p.p_in[grp] + (size_t)layer * TG * 256, PB); }
      GSYNC();
      { PP_ phase_ple(Nb, PB, wb + W_PG, wb + W_PP, xg, lds); }
      GSYNC();
    }
  }
  { CParams& p = *launder(kp); phase_final_norm(p.x, p.norm_final); }
}

extern "C" void kernel_launch(void* const* d_in, const int* in_sizes, int n_in, void* d_out, int out_size, void* d_ws,
                              size_t ws_size, hipStream_t stream) {
  (void)in_sizes; (void)n_in; (void)out_size;
  Params p{};
  p.x_in[0] = (const float*)d_in[0]; p.x_in[1] = (const float*)d_in[1];
  p.p_in[0] = (const float*)d_in[2]; p.p_in[1] = (const float*)d_in[3];
  p.norm_ff1 = (const float*)d_in[4]; p.ff1_w1 = (const float*)d_in[5]; p.ff1_w3 = (const float*)d_in[6];
  p.ff1_w2 = (const float*)d_in[7]; p.norm_mix = (const float*)d_in[8]; p.w_in = (const float*)d_in[9];
  p.mla_q_norm = (const float*)d_in[10]; p.mla_kv_norm = (const float*)d_in[11]; p.mla_w_uq = (const float*)d_in[12];
  p.mla_w_ukv = (const float*)d_in[13]; p.diff_lambda = (const float*)d_in[14]; p.diff_subln = (const float*)d_in[15];
  p.dn_conv = (const float*)d_in[16]; p.dn_a_log = (const float*)d_in[17]; p.dn_dt_bias = (const float*)d_in[18];
  p.dn_out_norm = (const float*)d_in[19]; p.w_branch = (const float*)d_in[20]; p.w_gate = (const float*)d_in[21];
  p.w_out = (const float*)d_in[22]; p.norm_ff2 = (const float*)d_in[23]; p.ff2_w1 = (const float*)d_in[24];
  p.ff2_w3 = (const float*)d_in[25]; p.ff2_w2 = (const float*)d_in[26]; p.norm_ple = (const float*)d_in[27];
  p.ple_gate = (const float*)d_in[28]; p.ple_proj = (const float*)d_in[29]; p.norm_final = (const float*)d_in[30];
  p.x = (float*)d_out;
  p.ws = (char*)d_ws;
  p.big_ws = (ws_size >= WS_BIG) ? 1 : 0;
  static int grid_blocks = 0;
  if (!grid_blocks) {
    int dev = 0, cus = 0, per_cu = 0;
    hipGetDevice(&dev);
    hipDeviceGetAttribute(&cus, hipDeviceAttributeMultiprocessorCount, dev);
    hipFuncSetAttribute((const void*)mega, hipFuncAttributeMaxDynamicSharedMemorySize, (int)LDS_BYTES);
    hipOccupancyMaxActiveBlocksPerMultiprocessor(&per_cu, mega, 256, LDS_BYTES);
    if (per_cu < 1) per_cu = 1;
    grid_blocks = cus * per_cu;
  }
  if (ws_size < WS_NEED) {
    fprintf(stderr, "workspace too small: %zu < %zu\n", ws_size, (size_t)WS_NEED);
    return;
  }
  (void)hipMemsetAsync((char*)d_ws + OFF_BAR, 0, XCD_BAR_WORDS * 4, stream);
  void* args[] = {&p};
  hipError_t e = hipLaunchCooperativeKernel((void*)mega, dim3(grid_blocks), dim3(256), args, LDS_BYTES, stream);
  if (e != hipSuccess) fprintf(stderr, "cooperative launch failed: %s (grid %d)\n", hipGetErrorString(e), grid_blocks);
}
```

```cpp
#include <hip/hip_runtime.h>
#include <hip/hip_cooperative_groups.h>
#include <stdint.h>
#include <stdio.h>
namespace cg = cooperative_groups;

typedef unsigned short bf16_t;
using bf16x8 = __attribute__((ext_vector_type(8))) short;
using bf16x4 = __attribute__((ext_vector_type(4))) short;
using f32x16 = __attribute__((ext_vector_type(16))) float;
using f32x4 = __attribute__((ext_vector_type(4))) float;
using u32x4 = __attribute__((ext_vector_type(4))) unsigned;
using u32x2 = __attribute__((ext_vector_type(2))) unsigned;

#define DI __device__ __forceinline__
#define MFMA32(a, b, c) __builtin_amdgcn_mfma_f32_32x32x16_bf16((a), (b), (c), 0, 0, 0)
#define MFMA16(a, b, c) __builtin_amdgcn_mfma_f32_16x16x32_bf16((a), (b), (c), 0, 0, 0)

constexpr int TG = 32768;
constexpr int NPR = 4608;
constexpr float EPS = 1e-6f;
constexpr float LOG2E = 1.4426950408889634f;
constexpr int C_CQ = 0, C_CKV = 256, C_BQ = 384, C_BK = 640, C_BV = 896, C_DNQKV = 1152, C_Z = 1920,
              C_DQ = 2176, C_DK = 2944, C_DV = 3712;
constexpr size_t MiB = 1048576;
constexpr size_t OFF_WB = 0, OFF_TAB = 57 * MiB, OFF_CNT = 63 * MiB, OFF_N = 64 * MiB, OFF_PR = 128 * MiB,
                 OFF_Q = 416 * MiB, OFF_K = 440 * MiB, OFF_V = 464 * MiB, OFF_AB = 480 * MiB, OFF_OD = 482 * MiB,
                 OFF_LSE = 530 * MiB, OFF_OF = 532 * MiB, OFF_OB = 548 * MiB, WS_NEED = 564 * MiB;
constexpr size_t W_FF1_1 = 0, W_FF1_3 = 2883584, W_FF1_2 = 5767168, W_IN = 8650752, W_UQ = 13369344,
                 W_UKV = 13467648, W_G = 13533184, W_B = 17727488, W_O = 18776064, W_FF2_1 = 19824640,
                 W_FF2_3 = 22708224, W_FF2_2 = 25591808, W_PG = 28475392, W_PP = 29523968;
constexpr size_t LDS_BYTES = 78336;

struct Params {
  const float* x_in[2];
  const float* p_in[2];
  const float *norm_ff1, *ff1_w1, *ff1_w3, *ff1_w2, *norm_mix, *w_in, *mla_q_norm, *mla_kv_norm, *mla_w_uq,
      *mla_w_ukv, *diff_lambda, *diff_subln, *dn_conv, *dn_a_log, *dn_dt_bias, *dn_out_norm, *w_branch, *w_gate,
      *w_out, *norm_ff2, *ff2_w1, *ff2_w3, *ff2_w2, *norm_ple, *ple_gate, *ple_proj, *norm_final;
  float* x;
  char* ws;
  long long big_ws;
};

typedef const __attribute__((address_space(4))) Params CParams;
DI CParams* launder(CParams* q) { asm volatile("" : "+s"(q)); return q; }

typedef __bf16 bf2_t __attribute__((ext_vector_type(2)));
typedef float f2_t __attribute__((ext_vector_type(2)));
DI bf16_t f2bf(float x) { return __builtin_bit_cast(bf16_t, (__bf16)x); }
DI float bf2f(bf16_t b) { return __uint_as_float(((unsigned)b) << 16); }
DI unsigned pack2(float a, float b) { f2_t v = {a, b}; return __builtin_bit_cast(unsigned, __builtin_convertvector(v, bf2_t)); }
DI float wave_sum(float v) {
#pragma unroll
  for (int o = 32; o > 0; o >>= 1) v += __shfl_xor(v, o);
  return v;
}
DI float sigmoidf_(float x) { return 1.f / (1.f + __expf(-x)); }
DI float siluf_(float x) { return x / (1.f + __expf(-x)); }
DI float exp2_(float x) { return __builtin_amdgcn_exp2f(x); }
DI int opq() { int z; asm volatile("v_mov_b32 %0, 0" : "=v"(z)); return z; }
DI float xhalf_max(float v) {
  const auto r = __builtin_amdgcn_permlane32_swap(__float_as_uint(v), __float_as_uint(v), false, false);
  return fmaxf(__uint_as_float(r[0]), __uint_as_float(r[1]));
}
DI int crow(int r, int h2) { return (r & 3) + 8 * (r >> 2) + 4 * h2; }
DI bf16x8 pack8(float a0, float a1, float a2, float a3, float a4, float a5, float a6, float a7) {
  u32x4 u;
  u.x = pack2(a0, a1); u.y = pack2(a2, a3); u.z = pack2(a4, a5); u.w = pack2(a6, a7);
  return __builtin_bit_cast(bf16x8, u);
}
DI bf16x8 ld2x4(const bf16_t* p0, const bf16_t* p1) {
  u32x2 a = *(const u32x2*)p0, b = *(const u32x2*)p1;
  u32x4 u; u.x = a.x; u.y = a.y; u.z = b.x; u.w = b.y;
  return __builtin_bit_cast(bf16x8, u);
}
DI void store8bf(bf16_t* dst, const float* v) {
  u32x4 u; u.x = pack2(v[0], v[1]); u.y = pack2(v[2], v[3]); u.z = pack2(v[4], v[5]); u.w = pack2(v[6], v[7]);
  *(u32x4*)dst = u;
}

struct MatDesc { const float* src; bf16_t* dst; int K, ldsrc, Ndst, map; const float* rowscale; };

DI int map_col(int map, int n) {
  if (map == 0) return n;
  if (map == 1) {
    if (n < 384) return n;
    if (n < 1920) return n + 32;
    if (n < 4480) return n + 48;
    if (n < 4512) return n - 4480 + 384;
    if (n < 4528) return n - 4512 + 1952;
    return -1;
  }
  if (n < 256) return (n >> 6) * 96 + (n & 63);
  return ((n - 256) >> 5) * 96 + 64 + ((n - 256) & 31);
}

DI MatDesc get_mat(CParams& p, int l, int id) {
  bf16_t* wb = (bf16_t*)(p.ws + OFF_WB);
  MatDesc d; d.map = 0; d.rowscale = nullptr;
  const size_t FF = (size_t)1024 * 2816;
  switch (id) {
    case 0: d.src = p.ff1_w1 + l * FF; d.dst = wb + W_FF1_1; d.K = 1024; d.ldsrc = 2816; d.Ndst = 2816; break;
    case 1: d.src = p.ff1_w3 + l * FF; d.dst = wb + W_FF1_3; d.K = 1024; d.ldsrc = 2816; d.Ndst = 2816; break;
    case 2: d.src = p.ff1_w2 + l * FF; d.dst = wb + W_FF1_2; d.K = 2816; d.ldsrc = 1024; d.Ndst = 1024; break;
    case 3: d.src = p.w_in + (size_t)l * 1024 * 4528; d.dst = wb + W_IN; d.K = 1024; d.ldsrc = 4528; d.Ndst = 4608; d.map = 1; break;
    case 4: d.src = p.mla_w_uq + (size_t)l * 256 * 384; d.dst = wb + W_UQ; d.K = 256; d.ldsrc = 384; d.Ndst = 384; d.map = 2; d.rowscale = p.mla_q_norm + l * 256; break;
    case 5: d.src = p.mla_w_ukv + (size_t)l * 128 * 512; d.dst = wb + W_UKV; d.K = 128; d.ldsrc = 512; d.Ndst = 512; d.rowscale = p.mla_kv_norm + l * 128; break;
    case 6: case 7: case 8: case 9:
      d.src = p.w_gate + (size_t)(l * 4 + id - 6) * 1048576; d.dst = wb + W_G + (size_t)(id - 6) * 1048576; d.K = 1024; d.ldsrc = 1024; d.Ndst = 1024; break;
    case 10: case 11: case 12: case 13:
      d.src = p.w_branch + (size_t)(l * 4 + id - 10) * 262144; d.dst = wb + W_B + (size_t)(id - 10) * 262144; d.K = 256; d.ldsrc = 1024; d.Ndst = 1024; break;
    case 14: d.src = p.w_out + (size_t)l * 1048576; d.dst = wb + W_O; d.K = 1024; d.ldsrc = 1024; d.Ndst = 1024; break;
    case 15: d.src = p.ff2_w1 + l * FF; d.dst = wb + W_FF2_1; d.K = 1024; d.ldsrc = 2816; d.Ndst = 2816; break;
    case 16: d.src = p.ff2_w3 + l * FF; d.dst = wb + W_FF2_3; d.K = 1024; d.ldsrc = 2816; d.Ndst = 2816; break;
    case 17: d.src = p.ff2_w2 + l * FF; d.dst = wb + W_FF2_2; d.K = 2816; d.ldsrc = 1024; d.Ndst = 1024; break;
    case 18: d.src = p.ple_gate + (size_t)l * 1048576; d.dst = wb + W_PG; d.K = 1024; d.ldsrc = 1024; d.Ndst = 1024; break;
    default: d.src = p.ple_proj + (size_t)l * 262144; d.dst = wb + W_PP; d.K = 256; d.ldsrc = 1024; d.Ndst = 1024; break;
  }
  return d;
}

DI void phase_convert(CParams& p, int l, char* lds) {
  float* T = (float*)lds;
  const int tid = threadIdx.x + opq();
  for (int id = 0; id < 20; ++id) {
    MatDesc d = get_mat(p, l, id);
    const int nkt = d.K >> 6, nnt = d.Ndst >> 6, nt_all = nkt * nnt;
    for (int t = blockIdx.x; t < nt_all; t += gridDim.x) {
      const int kt = t / nnt, nt = t % nnt;
      __syncthreads();
      {
        const int nl = tid & 63;
        const int sc = map_col(d.map, nt * 64 + nl);
#pragma unroll 4
        for (int i = 0; i < 16; ++i) {
          const int kl = (tid >> 6) + 4 * i;
          const int k = kt * 64 + kl;
          float v = 0.f;
          if (sc >= 0) v = d.src[(size_t)k * d.ldsrc + sc];
          if (d.rowscale) v *= d.rowscale[k];
          T[kl * 65 + nl] = v;
        }
      }
      __syncthreads();
      {
        const int kl = tid & 63;
#pragma unroll 4
        for (int i = 0; i < 16; ++i) {
          const int nl = (tid >> 6) + 4 * i;
          d.dst[(size_t)(nt * 64 + nl) * d.K + kt * 64 + kl] = f2bf(T[kl * 65 + nl]);
        }
      }
    }
  }
}

DI void phase_init(CParams& p, char* lds) {
  const size_t gtid = (size_t)blockIdx.x * 256 + threadIdx.x + opq(), gn = (size_t)gridDim.x * 256;
  {
    float2* t32 = (float2*)(p.ws + OFF_TAB);
    float2* t64 = (float2*)(p.ws + OFF_TAB + 2 * MiB);
    for (size_t i = gtid; i < (size_t)16384 * 48; i += gn) {
      const int pos = (int)(i / 48), f = (int)(i % 48);
      float inv;
      if (f < 16) inv = exp2f(-(float)f * (13.287712379549449f / 16.f));
      else inv = exp2f(-(float)(f - 16) * (13.287712379549449f / 32.f));
      const float ang = (float)pos * inv;
      const double xd = (double)ang;
      const double n = rint(xd * 0.15915494309189535);
      const float rf = (float)(xd - n * 6.283185307179586);
      float2 cs; cs.x = __cosf(rf); cs.y = __sinf(rf);
      if (f < 16) t32[(size_t)pos * 16 + f] = cs; else t64[(size_t)pos * 32 + (f - 16)] = cs;
    }
  }
  if (blockIdx.x == 0) ((int*)(p.ws + OFF_CNT))[threadIdx.x] = 0;
  phase_convert(p, 0, lds);
}

DI void phase_norm(const float* __restrict__ x, const float* __restrict__ g, bf16_t* __restrict__ dst,
                           const float* __restrict__ psrc, bf16_t* __restrict__ pdst) {
  const int tidq = threadIdx.x + opq(); const int wave = tidq >> 6, lane = tidq & 63;
  for (int r = blockIdx.x * 4 + wave; r < TG; r += gridDim.x * 4) {
    const float4* xr = (const float4*)(x + (size_t)r * 1024);
    float4 v[4];
    float ss = 0.f;
#pragma unroll
    for (int i = 0; i < 4; ++i) { v[i] = xr[lane + 64 * i]; ss += v[i].x * v[i].x + v[i].y * v[i].y + v[i].z * v[i].z + v[i].w * v[i].w; }
    ss = wave_sum(ss);
    const float rs = rsqrtf(ss * (1.f / 1024.f) + EPS);
#pragma unroll
    for (int i = 0; i < 4; ++i) {
      const float4 gg = ((const float4*)g)[lane + 64 * i];
      u32x2 o; o.x = pack2(v[i].x * rs * gg.x, v[i].y * rs * gg.y); o.y = pack2(v[i].z * rs * gg.z, v[i].w * rs * gg.w);
      ((u32x2*)(dst + (size_t)r * 1024))[lane + 64 * i] = o;
    }
    if (psrc) {
      const float4 pv = ((const float4*)(psrc + (size_t)r * 256))[lane];
      u32x2 o; o.x = pack2(pv.x, pv.y); o.y = pack2(pv.z, pv.w);
      ((u32x2*)(pdst + (size_t)r * 256))[lane] = o;
    }
  }
}

DI void phase_final_norm(float* __restrict__ x, const float* __restrict__ g) {
  const int tidq = threadIdx.x + opq(); const int wave = tidq >> 6, lane = tidq & 63;
  for (int r = blockIdx.x * 4 + wave; r < 2 * TG; r += gridDim.x * 4) {
    float4* xr = (float4*)(x + (size_t)r * 1024);
    float4 v[4];
    float ss = 0.f;
#pragma unroll
    for (int i = 0; i < 4; ++i) { v[i] = xr[lane + 64 * i]; ss += v[i].x * v[i].x + v[i].y * v[i].y + v[i].z * v[i].z + v[i].w * v[i].w; }
    ss = wave_sum(ss);
    const float rs = rsqrtf(ss * (1.f / 1024.f) + EPS);
#pragma unroll
    for (int i = 0; i < 4; ++i) {
      const float4 gg = ((const float4*)g)[lane + 64 * i];
      float4 o; o.x = v[i].x * rs * gg.x; o.y = v[i].y * rs * gg.y; o.z = v[i].z * rs * gg.z; o.w = v[i].w * rs * gg.w;
      xr[lane + 64 * i] = o;
    }
  }
}

template <int NI, int NB>
DI void gemm_main(f32x16 (&acc0)[2][NI], f32x16 (&acc1)[2][NI], const bf16_t* __restrict__ A, int lda,
                  const bf16_t* __restrict__ B0, const bf16_t* __restrict__ B1, int ldb, int K, char* lds) {
  const int tid = threadIdx.x + opq(), lane = tid & 63, w = tid >> 6, wm = w >> 1, wn = w & 1, l31 = lane & 31, h2 = lane >> 5;
  bf16_t* As = (bf16_t*)lds;
  bf16_t* B0s = As + 128 * 72;
  bf16_t* B1s = B0s + 64 * NI * 72;
  const int lr = tid >> 3, lc = (tid & 7) * 8;
  u32x4 ra[4], rb0[2 * NI], rb1[2 * NI];
  const bf16_t* ap = A + (size_t)lr * lda + lc;
  const bf16_t* bp0 = B0 + (size_t)lr * ldb + lc;
  const bf16_t* bp1 = (NB == 2) ? (B1 + (size_t)lr * ldb + lc) : B0;
#pragma unroll
  for (int i = 0; i < 4; ++i) ra[i] = *(const u32x4*)(ap + (size_t)(32 * i) * lda);
#pragma unroll
  for (int i = 0; i < 2 * NI; ++i) {
    rb0[i] = *(const u32x4*)(bp0 + (size_t)(32 * i) * ldb);
    if (NB == 2) rb1[i] = *(const u32x4*)(bp1 + (size_t)(32 * i) * ldb);
  }
  for (int k0 = 0; k0 < K; k0 += 64) {
    __syncthreads();
#pragma unroll
    for (int i = 0; i < 4; ++i) *(u32x4*)(As + (lr + 32 * i) * 72 + lc) = ra[i];
#pragma unroll
    for (int i = 0; i < 2 * NI; ++i) {
      *(u32x4*)(B0s + (lr + 32 * i) * 72 + lc) = rb0[i];
      if (NB == 2) *(u32x4*)(B1s + (lr + 32 * i) * 72 + lc) = rb1[i];
    }
    if (k0 + 64 < K) {
      const int kn = k0 + 64;
#pragma unroll
      for (int i = 0; i < 4; ++i) ra[i] = *(const u32x4*)(ap + (size_t)(32 * i) * lda + kn);
#pragma unroll
      for (int i = 0; i < 2 * NI; ++i) {
        rb0[i] = *(const u32x4*)(bp0 + (size_t)(32 * i) * ldb + kn);
        if (NB == 2) rb1[i] = *(const u32x4*)(bp1 + (size_t)(32 * i) * ldb + kn);
      }
    }
    __syncthreads();
    __builtin_amdgcn_s_setprio(1);
#pragma unroll
    for (int ks = 0; ks < 4; ++ks) {
      bf16x8 af[2], bf0[NI], bf1[NI];
#pragma unroll
      for (int mi = 0; mi < 2; ++mi) af[mi] = *(const bf16x8*)(As + (64 * wm + 32 * mi + l31) * 72 + 16 * ks + 8 * h2);
#pragma unroll
      for (int ni = 0; ni < NI; ++ni) {
        bf0[ni] = *(const bf16x8*)(B0s + (32 * NI * wn + 32 * ni + l31) * 72 + 16 * ks + 8 * h2);
        if (NB == 2) bf1[ni] = *(const bf16x8*)(B1s + (32 * NI * wn + 32 * ni + l31) * 72 + 16 * ks + 8 * h2);
      }
#pragma unroll
      for (int mi = 0; mi < 2; ++mi)
#pragma unroll
        for (int ni = 0; ni < NI; ++ni) {
          acc0[mi][ni] = MFMA32(af[mi], bf0[ni], acc0[mi][ni]);
          if (NB == 2) acc1[mi][ni] = MFMA32(af[mi], bf1[ni], acc1[mi][ni]);
        }
    }
    __builtin_amdgcn_s_setprio(0);
  }
}

template <int NI>
DI void zero_acc(f32x16 (&a)[2][NI]) {
#pragma unroll
  for (int mi = 0; mi < 2; ++mi)
#pragma unroll
    for (int ni = 0; ni < NI; ++ni)
#pragma unroll
      for (int r = 0; r < 16; ++r) a[mi][ni][r] = 0.f;
}

#define EPI_VARS const int tid = threadIdx.x + opq(), lane = tid & 63, w = tid >> 6, wm = w >> 1, wn = w & 1, l31 = lane & 31, h2 = lane >> 5; (void)tid; (void)lane; (void)w
#define EPI_BEGIN(NI_) _Pragma("unroll") for (int mi = 0; mi < 2; ++mi) _Pragma("unroll") for (int ni = 0; ni < NI_; ++ni) _Pragma("unroll") for (int r = 0; r < 16; ++r) { \
    const int row = 64 * wm + 32 * mi + crow(r, h2); const int col = 32 * NI_ * wn + 32 * ni + l31;
#define EPI_END }

DI bool xcd_tile(int iter, int MT, int NT, int& mt, int& nt) {
  const int x = blockIdx.x & 7, lb = blockIdx.x >> 3, nb = gridDim.x >> 3;
  const int full = NT >> 3, rem = NT & 7;
  const int per_full = full * MT, rem_tot = rem * MT;
  const int r0 = (rem_tot * x) >> 3, r1 = (rem_tot * (x + 1)) >> 3;
  const int j = lb + iter * nb;
  if (lb >= nb || j >= per_full + (r1 - r0)) return false;
  if (j < per_full) { mt = j / full; nt = x * full + j % full; }
  else { const int u = r0 + (j - per_full); nt = 8 * full + u / MT; mt = u % MT; }
  return true;
}

DI void phase_ffn_a(const bf16_t* __restrict__ Nb, const bf16_t* __restrict__ W1, const bf16_t* __restrict__ W3,
                            bf16_t* __restrict__ H, char* lds) {
  EPI_VARS;
  for (int iter = 0;; ++iter) {
    int mt, nt;
    if (!xcd_tile(iter, 256, 22, mt, nt)) break;
    f32x16 a0[2][2], a1[2][2];
    zero_acc<2>(a0); zero_acc<2>(a1);
    gemm_main<2, 2>(a0, a1, Nb + (size_t)mt * 128 * 1024, 1024, W1 + (size_t)nt * 128 * 1024, W3 + (size_t)nt * 128 * 1024, 1024, 1024, lds);
    EPI_BEGIN(2)
      H[(size_t)(mt * 128 + row) * 2816 + nt * 128 + col] = f2bf(siluf_(a0[mi][ni][r]) * a1[mi][ni][r]);
    EPI_END
  }
}

DI void phase_gemm_resid(const bf16_t* __restrict__ A, int K, const bf16_t* __restrict__ Bt, const float* xsrc, float* x,
                                 float scale, char* lds) {
  EPI_VARS;
  for (int iter = 0;; ++iter) {
    int mt, nt;
    if (!xcd_tile(iter, 256, 4, mt, nt)) break;
    f32x16 a0[2][4];
    zero_acc<4>(a0);
    gemm_main<4, 1>(a0, a0, A + (size_t)mt * 128 * K, K, Bt + (size_t)nt * 256 * K, nullptr, K, K, lds);
    EPI_BEGIN(4)
      const size_t off = (size_t)(mt * 128 + row) * 1024 + nt * 256 + col;
      x[off] = xsrc[off] + scale * a0[mi][ni][r];
    EPI_END
  }
}

DI void phase_ple(const bf16_t* __restrict__ Nb, const bf16_t* __restrict__ PB, const bf16_t* __restrict__ PG,
                          const bf16_t* __restrict__ PP, float* __restrict__ x, char* lds) {
  EPI_VARS;
  for (int iter = 0;; ++iter) {
    int mt, nt;
    if (!xcd_tile(iter, 256, 8, mt, nt)) break;
    f32x16 a0[2][2], a1[2][2];
    zero_acc<2>(a0); zero_acc<2>(a1);
    gemm_main<2, 1>(a0, a0, Nb + (size_t)mt * 128 * 1024, 1024, PG + (size_t)nt * 128 * 1024, nullptr, 1024, 1024, lds);
    gemm_main<2, 1>(a1, a1, PB + (size_t)mt * 128 * 256, 256, PP + (size_t)nt * 128 * 256, nullptr, 256, 256, lds);
    EPI_BEGIN(2)
      float* xp = x + (size_t)(mt * 128 + row) * 1024 + nt * 128 + col;
      *xp = *xp + sigmoidf_(a0[mi][ni][r]) * a1[mi][ni][r];
    EPI_END
  }
}

DI void phase_merge(const bf16_t* __restrict__ Np, const bf16_t* __restrict__ Y, const bf16_t* __restrict__ WG,
                            const bf16_t* __restrict__ WB, bf16_t* __restrict__ M, char* lds) {
  EPI_VARS;
  for (int iter = 0;; ++iter) {
    int mt, nt;
    if (!xcd_tile(iter, 256, 8, mt, nt)) break;
    f32x16 am[2][2];
    zero_acc<2>(am);
#pragma unroll 1
    for (int n = 0; n < 4; ++n) {
      unsigned sg[2][2][8];
      {
        f32x16 ag[2][2];
        zero_acc<2>(ag);
        gemm_main<2, 1>(ag, ag, Np + (size_t)mt * 128 * 1024, 1024, WG + (size_t)n * 1048576 + (size_t)nt * 128 * 1024, nullptr, 1024, 1024, lds);
#pragma unroll
        for (int mi = 0; mi < 2; ++mi)
#pragma unroll
          for (int ni = 0; ni < 2; ++ni)
#pragma unroll
            for (int r = 0; r < 8; ++r) sg[mi][ni][r] = pack2(sigmoidf_(ag[mi][ni][2 * r]), sigmoidf_(ag[mi][ni][2 * r + 1]));
      }
      f32x16 ab[2][2];
      zero_acc<2>(ab);
      gemm_main<2, 1>(ab, ab, Y + (size_t)mt * 128 * 1024 + n * 256, 1024, WB + (size_t)n * 262144 + (size_t)nt * 128 * 256, nullptr, 256, 256, lds);
#pragma unroll
      for (int mi = 0; mi < 2; ++mi)
#pragma unroll
        for (int ni = 0; ni < 2; ++ni)
#pragma unroll
          for (int r = 0; r < 8; ++r) {
            am[mi][ni][2 * r] += __uint_as_float(sg[mi][ni][r] << 16) * ab[mi][ni][2 * r];
            am[mi][ni][2 * r + 1] += __uint_as_float(sg[mi][ni][r] & 0xffff0000u) * ab[mi][ni][2 * r + 1];
          }
    }
    EPI_BEGIN(2)
      M[(size_t)(mt * 128 + row) * 1024 + nt * 128 + col] = f2bf(am[mi][ni][r]);
    EPI_END
  }
}

DI void rope32_out(const float* c, const float2* tab, float sc, float* o) {
#pragma unroll
  for (int i = 0; i < 16; ++i) {
    const float2 cs = tab[i];
    const float a = c[i], b = c[16 + i];
    o[i] = (a * cs.x - b * cs.y) * sc;
    o[16 + i] = (b * cs.x + a * cs.y) * sc;
  }
}

DI void phase_proj(CParams& p, const bf16_t* __restrict__ Nb, const bf16_t* __restrict__ WIN, int S, char* lds) {
  EPI_VARS;
  bf16_t* PR = (bf16_t*)(p.ws + OFF_PR);
  float* AB = (float*)(p.ws + OFF_AB);
  const float2* t32 = (const float2*)(p.ws + OFF_TAB);
  const float2* t64 = (const float2*)(p.ws + OFF_TAB + 2 * MiB);
  float* Ct = (float*)lds;
  for (int iter = 0;; ++iter) {
    int mt, nt2;
    if (!xcd_tile(iter, 256, 18, mt, nt2)) break;
    f32x16 a0[2][4];
    zero_acc<4>(a0);
    gemm_main<4, 1>(a0, a0, Nb + (size_t)mt * 128 * 1024, 1024, WIN + (size_t)nt2 * 256 * 1024, nullptr, 1024, 1024, lds);
   for (int hv = 0; hv < 2; ++hv) {
    const int nt = 2 * nt2 + hv;
    __syncthreads();
    if (wn == hv) {
#pragma unroll
      for (int mi = 0; mi < 2; ++mi)
#pragma unroll
        for (int ni = 0; ni < 4; ++ni)
#pragma unroll
          for (int r = 0; r < 16; ++r) Ct[(64 * wm + 32 * mi + crow(r, h2)) * 132 + 32 * ni + l31] = a0[mi][ni][r];
    }
    __syncthreads();
    const int erow = tid >> 1, half = tid & 1;
    const int tok = mt * 128 + erow, pos = tok & (S - 1);
    const float* cr = Ct + erow * 132 + 64 * half;
    bf16_t* dst = PR + (size_t)tok * NPR + nt * 128 + 64 * half;
    int type = 0; float sc = 1.f;
    if (nt == 3 || nt == 4) { type = 1; sc = 0.17677669529663687f * LOG2E; }
    else if (nt == 5 || nt == 6) { type = 1; }
    else if (nt >= 17 && nt <= 22) { type = 2; sc = 0.125f * LOG2E; }
    else if (nt >= 23 && nt <= 28) { type = 2; }
    else if (nt == 35) type = 3;
    if (type == 0) {
#pragma unroll
      for (int j = 0; j < 8; ++j) store8bf(dst + 8 * j, cr + 8 * j);
    } else if (type == 1) {
#pragma unroll
      for (int hh = 0; hh < 2; ++hh) {
        float o[32];
        rope32_out(cr + 32 * hh, t32 + (size_t)pos * 16, sc, o);
#pragma unroll
        for (int j = 0; j < 4; ++j) store8bf(dst + 32 * hh + 8 * j, o + 8 * j);
      }
    } else if (type == 2) {
      const float2* tab = t64 + (size_t)pos * 32;
#pragma unroll
      for (int j = 0; j < 4; ++j) {
        float lo[8], hi[8];
#pragma unroll
        for (int e = 0; e < 8; ++e) {
          const float2 cs = tab[8 * j + e];
          const float a = cr[8 * j + e], b = cr[32 + 8 * j + e];
          lo[e] = (a * cs.x - b * cs.y) * sc;
          hi[e] = (b * cs.x + a * cs.y) * sc;
        }
        store8bf(dst + 8 * j, lo);
        store8bf(dst + 32 + 8 * j, hi);
      }
    } else {
      if (half == 0) {
        float o[32];
        rope32_out(cr, t32 + (size_t)pos * 16, 1.f, o);
#pragma unroll
        for (int j = 0; j < 4; ++j) store8bf(dst + 8 * j, o + 8 * j);
      } else {
        const float* c2 = Ct + erow * 132 + 32;
#pragma unroll
        for (int j = 0; j < 4; ++j) {
          float4 v; v.x = c2[4 * j]; v.y = c2[4 * j + 1]; v.z = c2[4 * j + 2]; v.w = c2[4 * j + 3];
          ((float4*)(AB + (size_t)tok * 16))[j] = v;
        }
      }
    }
   }
  }
}

DI void mla_up_tile(CParams& p, int mt, int j, int S, char* lds) {
  EPI_VARS;
  const bf16_t* PR = (const bf16_t*)(p.ws + OFF_PR);
  const bf16_t* wb = (const bf16_t*)(p.ws + OFF_WB);
  bf16_t* Qb = (bf16_t*)(p.ws + OFF_Q);
  bf16_t* Kb = (bf16_t*)(p.ws + OFF_K);
  bf16_t* Vb = (bf16_t*)(p.ws + OFF_V);
  const float2* t32 = (const float2*)(p.ws + OFF_TAB);
  float* Ct = (float*)lds;
  float* rst = (float*)(lds + 67584);
  const bool isq = j < 3;
  const int K = isq ? 256 : 128;
  const int nt = isq ? j : j - 3;
  const bf16_t* A = PR + (size_t)mt * 128 * NPR + (isq ? C_CQ : C_CKV);
  const bf16_t* B = wb + (isq ? W_UQ : W_UKV) + (size_t)nt * 128 * K;
  const int erow = tid >> 1, half = tid & 1;
  {
    const bf16_t* ar = A + (size_t)erow * NPR + half * (K / 2);
    float ss = 0.f;
    for (int c = 0; c < K / 16; ++c) {
      const u32x4 u = *(const u32x4*)(ar + 8 * c);
      const unsigned uu[4] = {u.x, u.y, u.z, u.w};
#pragma unroll
      for (int e = 0; e < 4; ++e) {
        const float lo = __uint_as_float(uu[e] << 16), hi = __uint_as_float(uu[e] & 0xffff0000u);
        ss += lo * lo + hi * hi;
      }
    }
    ss += __shfl_xor(ss, 1);
    if (half == 0) rst[erow] = rsqrtf(ss / (float)K + EPS);
  }
  f32x16 a0[2][2];
  zero_acc<2>(a0);
  gemm_main<2, 1>(a0, a0, A, NPR, B, nullptr, K, K, lds);
  __syncthreads();
  EPI_BEGIN(2)
    Ct[row * 132 + col] = a0[mi][ni][r];
  EPI_END
  __syncthreads();
  const int tok = mt * 128 + erow, pos = tok & (S - 1);
  const float rs = rst[erow];
  const float* cr = Ct + erow * 132 + 64 * half;
  if (isq) {
    const float sc = rs * 0.10206207261596577f * LOG2E;
    if (nt < 2) {
      bf16_t* dst = Qb + ((size_t)tok * 4 + 2 * nt + half) * 96;
#pragma unroll
      for (int jj = 0; jj < 8; ++jj) {
        float o[8];
#pragma unroll
        for (int e = 0; e < 8; ++e) o[e] = cr[8 * jj + e] * sc;
        store8bf(dst + 8 * jj, o);
      }
    } else {
#pragma unroll
      for (int hh = 0; hh < 2; ++hh) {
        float o[32];
        rope32_out(cr + 32 * hh, t32 + (size_t)pos * 16, sc, o);
        bf16_t* dst = Qb + ((size_t)tok * 4 + 2 * half + hh) * 96 + 64;
#pragma unroll
        for (int jj = 0; jj < 4; ++jj) store8bf(dst + 8 * jj, o + 8 * jj);
      }
    }
  } else {
    bf16_t* dst = half == 0 ? (Kb + ((size_t)tok * 4 + nt) * 96) : (Vb + ((size_t)tok * 4 + nt) * 64);
#pragma unroll
    for (int jj = 0; jj < 8; ++jj) {
      float o[8];
#pragma unroll
      for (int e = 0; e < 8; ++e) o[e] = cr[8 * jj + e] * rs;
      store8bf(dst + 8 * jj, o);
    }
    if (half == 0) {
      const u32x4* src = (const u32x4*)(PR + (size_t)tok * NPR + 4480);
#pragma unroll
      for (int jj = 0; jj < 4; ++jj) ((u32x4*)(dst + 64))[jj] = src[jj];
    }
  }
}

typedef short s16x4_t __attribute__((ext_vector_type(4)));
DI bf16x8 tr_pair(const bf16_t* p0, const bf16_t* p1) {
  const s16x4_t lo = __builtin_amdgcn_ds_read_tr16_b64_v4i16((__attribute__((address_space(3))) s16x4_t*)p0);
  const s16x4_t hi = __builtin_amdgcn_ds_read_tr16_b64_v4i16((__attribute__((address_space(3))) s16x4_t*)p1);
  return __builtin_shufflevector(lo, hi, 0, 1, 2, 3, 4, 5, 6, 7);
}

template <int DK, bool BAND>
DI void flash_loop(f32x16 (&O)[2], float& m, float& l, const bf16_t* __restrict__ qrow, const bf16_t* __restrict__ kbase,
                   size_t kstride, const bf16_t* __restrict__ vbase, size_t vstride, int ntiles, int tq, int u0, int L,
                   char* lds) {
  const int tid = threadIdx.x + opq(), lane = tid & 63, l31 = lane & 31, h2 = lane >> 5;
  constexpr int KR = DK + 8, KCH = DK / 8, KN = 64 * KCH / 256;
  constexpr int STAGE = 64 * KR * 2 + 64 * 72 * 2;
  bf16x8 qf[DK / 16];
#pragma unroll
  for (int ks = 0; ks < DK / 16; ++ks) qf[ks] = *(const bf16x8*)(qrow + 16 * ks + 8 * h2);
  u32x4 rkA[KN], rvA[2], rkB[KN], rvB[2];
  auto gload = [&](int kt, u32x4 (&rk)[KN], u32x4 (&rv)[2]) {
#pragma unroll
    for (int i = 0; i < KN; ++i) {
      const int ci = tid + 256 * i, row = ci / KCH, c = ci % KCH;
      int rr = u0 + 64 * kt + row;
      if (BAND) rr = min(max(rr, 0), L - 1);
      rk[i] = *(const u32x4*)(kbase + (size_t)rr * kstride + c * 8);
    }
#pragma unroll
    for (int i = 0; i < 2; ++i) {
      const int ci = tid + 256 * i, row = ci >> 3, c = ci & 7;
      int rr = u0 + 64 * kt + row;
      if (BAND) rr = min(max(rr, 0), L - 1);
      rv[i] = *(const u32x4*)(vbase + (size_t)rr * vstride + c * 8);
    }
  };
  auto swrite = [&](int st, const u32x4 (&rk)[KN], const u32x4 (&rv)[2]) {
    bf16_t* Ks = (bf16_t*)(lds + st * STAGE);
    bf16_t* Vs = Ks + 64 * KR;
#pragma unroll
    for (int i = 0; i < KN; ++i) {
      const int ci = tid + 256 * i, row = ci / KCH, c = ci % KCH;
      *(u32x4*)(Ks + row * KR + c * 8) = rk[i];
    }
#pragma unroll
    for (int i = 0; i < 2; ++i) {
      const int ci = tid + 256 * i, row = ci >> 3, c = ci & 7;
      *(u32x4*)(Vs + row * 72 + c * 8) = rv[i];
    }
  };
  const int trq = (lane & 15) >> 2, trp = lane & 3, trblk = (lane >> 4) & 1;
  const int troff = (4 * h2 + trq) * 72 + 16 * trblk + 4 * trp;
  __syncthreads();
  gload(0, rkA, rvA);
  swrite(0, rkA, rvA);
  gload(1, rkA, rvA);
  if (ntiles > 2) gload(2, rkB, rvB);
  for (int kt2 = 0; kt2 < ntiles; kt2 += 2)
#pragma unroll
  for (int par = 0; par < 2; ++par) {
    const int kt = kt2 + par;
    __syncthreads();
    if (par == 0) {
      if (kt + 1 < ntiles) swrite((kt + 1) & 1, rkA, rvA);
      if (kt + 3 < ntiles) gload(kt + 3, rkA, rvA);
    } else {
      if (kt + 1 < ntiles) swrite((kt + 1) & 1, rkB, rvB);
      if (kt + 3 < ntiles) gload(kt + 3, rkB, rvB);
    }
    const bf16_t* Ks = (const bf16_t*)(lds + (kt & 1) * STAGE);
    const bf16_t* Vs = Ks + 64 * KR;
    f32x16 Sx[2];
#pragma unroll
    for (int j = 0; j < 2; ++j)
#pragma unroll
      for (int r = 0; r < 16; ++r) Sx[j][r] = 0.f;
#pragma unroll
    for (int ks = 0; ks < DK / 16; ++ks)
#pragma unroll
      for (int j = 0; j < 2; ++j) {
        const bf16x8 kf = *(const bf16x8*)(Ks + (32 * j + l31) * KR + 16 * ks + 8 * h2);
        Sx[j] = MFMA32(kf, qf[ks], Sx[j]);
      }
    if (BAND) {
#pragma unroll
      for (int j = 0; j < 2; ++j)
#pragma unroll
        for (int r = 0; r < 16; ++r) {
          const int u = u0 + 64 * kt + 32 * j + crow(r, h2);
          const int d = u - tq;
          const bool valid = (d <= 64) && (d >= -64) && (u >= 0) && (u < L);
          Sx[j][r] = valid ? Sx[j][r] : -1e30f;
        }
    }
    float mx = Sx[0][0];
#pragma unroll
    for (int j = 0; j < 2; ++j)
#pragma unroll
      for (int r = 0; r < 16; ++r) mx = fmaxf(mx, Sx[j][r]);
    mx = xhalf_max(mx);
    const float mn = fmaxf(m, mx);
    const float alpha = exp2_(m - mn);
    const bool grew = mn > m;
    m = mn;
    float ls = 0.f;
#pragma unroll
    for (int j = 0; j < 2; ++j)
#pragma unroll
      for (int r = 0; r < 16; ++r) { const float pv = exp2_(Sx[j][r] - mn); Sx[j][r] = pv; ls += pv; }
    l = l * alpha + ls;
    if (__any(grew)) {
#pragma unroll
      for (int t = 0; t < 2; ++t)
#pragma unroll
        for (int r = 0; r < 16; ++r) O[t][r] *= alpha;
    }
#pragma unroll
    for (int j = 0; j < 2; ++j)
#pragma unroll
      for (int s = 0; s < 2; ++s) {
        const bf16x8 pf = pack8(Sx[j][8 * s], Sx[j][8 * s + 1], Sx[j][8 * s + 2], Sx[j][8 * s + 3], Sx[j][8 * s + 4],
                                Sx[j][8 * s + 5], Sx[j][8 * s + 6], Sx[j][8 * s + 7]);
#pragma unroll
        for (int t = 0; t < 2; ++t) {
          const bf16_t* vp = Vs + (32 * j + 16 * s) * 72 + 32 * t + troff;
          const bf16x8 vf = tr_pair(vp, vp + 8 * 72);
          O[t] = MFMA32(vf, pf, O[t]);
        }
      }
  }
}

DI void flash_loop_diff(f32x16 (&O0)[2], f32x16 (&O1)[2], float& m0, float& l0, float& m1, float& l1,
                        const bf16_t* __restrict__ qrow, const bf16_t* __restrict__ kbase, size_t kstride,
                        const bf16_t* __restrict__ vbase, size_t vstride, int ntiles, char* lds) {
  const int tid = threadIdx.x + opq(), lane = tid & 63, l31 = lane & 31, h2 = lane >> 5;
  constexpr int KR = 72;
  constexpr int STAGE = 64 * KR * 2 + 64 * 72 * 2;
  bf16x8 qf0[2], qf1[2];
#pragma unroll
  for (int ks = 0; ks < 2; ++ks) {
    qf0[ks] = *(const bf16x8*)(qrow + 16 * ks + 8 * h2);
    qf1[ks] = *(const bf16x8*)(qrow + 32 + 16 * ks + 8 * h2);
  }
  u32x4 rk[2], rv[2];
  auto gload = [&](int kt) {
#pragma unroll
    for (int i = 0; i < 2; ++i) {
      const int ci = tid + 256 * i, row = ci >> 3, c = ci & 7;
      const int rr = 64 * kt + row;
      rk[i] = *(const u32x4*)(kbase + (size_t)rr * kstride + c * 8);
      rv[i] = *(const u32x4*)(vbase + (size_t)rr * vstride + c * 8);
    }
  };
  auto swrite = [&](int st) {
    bf16_t* Ks = (bf16_t*)(lds + st * STAGE);
    bf16_t* Vs = Ks + 64 * KR;
#pragma unroll
    for (int i = 0; i < 2; ++i) {
      const int ci = tid + 256 * i, row = ci >> 3, c = ci & 7;
      *(u32x4*)(Ks + row * KR + c * 8) = rk[i];
      *(u32x4*)(Vs + row * 72 + c * 8) = rv[i];
    }
  };
  const int trq = (lane & 15) >> 2, trp = lane & 3, trblk = (lane >> 4) & 1;
  const int troff = (4 * h2 + trq) * 72 + 16 * trblk + 4 * trp;
  __syncthreads();
  gload(0);
  swrite(0);
  if (ntiles > 1) gload(1);
  for (int kt = 0; kt < ntiles; ++kt) {
    __syncthreads();
    if (kt + 1 < ntiles) swrite((kt + 1) & 1);
    if (kt + 2 < ntiles) gload(kt + 2);
    const bf16_t* Ks = (const bf16_t*)(lds + (kt & 1) * STAGE);
    const bf16_t* Vs = Ks + 64 * KR;
    bf16x8 pf[2][2][2];
#pragma unroll
    for (int mp = 0; mp < 2; ++mp) {
      f32x16 Sx[2];
#pragma unroll
      for (int j = 0; j < 2; ++j)
#pragma unroll
        for (int r = 0; r < 16; ++r) Sx[j][r] = 0.f;
#pragma unroll
      for (int ks = 0; ks < 2; ++ks)
#pragma unroll
        for (int j = 0; j < 2; ++j) {
          const bf16x8 kf = *(const bf16x8*)(Ks + (32 * j + l31) * KR + 32 * mp + 16 * ks + 8 * h2);
          Sx[j] = MFMA32(kf, mp == 0 ? qf0[ks] : qf1[ks], Sx[j]);
        }
      float& m = mp == 0 ? m0 : m1;
      float& l = mp == 0 ? l0 : l1;
      float mx = Sx[0][0];
#pragma unroll
      for (int j = 0; j < 2; ++j)
#pragma unroll
        for (int r = 0; r < 16; ++r) mx = fmaxf(mx, Sx[j][r]);
      mx = xhalf_max(mx);
      const float mn = fmaxf(m, mx);
      const float alpha = exp2_(m - mn);
      const bool grew = mn > m;
      m = mn;
      float ls = 0.f;
#pragma unroll
      for (int j = 0; j < 2; ++j)
#pragma unroll
        for (int r = 0; r < 16; ++r) { const float pv = exp2_(Sx[j][r] - mn); Sx[j][r] = pv; ls += pv; }
      l = l * alpha + ls;
      if (__any(grew)) {
#pragma unroll
        for (int t = 0; t < 2; ++t)
#pragma unroll
          for (int r = 0; r < 16; ++r) { if (mp == 0) O0[t][r] *= alpha; else O1[t][r] *= alpha; }
      }
#pragma unroll
      for (int j = 0; j < 2; ++j)
#pragma unroll
        for (int s = 0; s < 2; ++s)
          pf[mp][j][s] = pack8(Sx[j][8 * s], Sx[j][8 * s + 1], Sx[j][8 * s + 2], Sx[j][8 * s + 3], Sx[j][8 * s + 4],
                               Sx[j][8 * s + 5], Sx[j][8 * s + 6], Sx[j][8 * s + 7]);
    }
#pragma unroll
    for (int j = 0; j < 2; ++j)
#pragma unroll
      for (int s = 0; s < 2; ++s)
#pragma unroll
        for (int t = 0; t < 2; ++t) {
          const bf16_t* vp = Vs + (32 * j + 16 * s) * 72 + 32 * t + troff;
          const bf16x8 vf = tr_pair(vp, vp + 8 * 72);
          O0[t] = MFMA32(vf, pf[0][j][s], O0[t]);
          O1[t] = MFMA32(vf, pf[1][j][s], O1[t]);
        }
  }
}

DI void zeroO(f32x16 (&O)[2]) {
#pragma unroll
  for (int t = 0; t < 2; ++t)
#pragma unroll
    for (int r = 0; r < 16; ++r) O[t][r] = 0.f;
}

DI void store_o(bf16_t* dst, const f32x16 (&O)[2], int h2) {
#pragma unroll
  for (int t = 0; t < 2; ++t)
#pragma unroll
    for (int g = 0; g < 4; ++g) {
      u32x2 u; u.x = pack2(O[t][4 * g], O[t][4 * g + 1]); u.y = pack2(O[t][4 * g + 2], O[t][4 * g + 3]);
      *(u32x2*)(dst + 32 * t + 8 * g + 4 * h2) = u;
    }
}

DI void mla_item(CParams& p, int it, int S, char* lds) {
  const int tid = threadIdx.x + opq(), lane = tid & 63, w = tid >> 6, l31 = lane & 31, h2 = lane >> 5;
  const int lgq = (S == 2048) ? 4 : 7;
  const int qb = it & ((1 << lgq) - 1), bh = it >> lgq, h = bh & 3, b = bh >> 2;
  const int tokbase = b * S, gtok = tokbase + 128 * qb + 32 * w + l31;
  const bf16_t* Qb = (const bf16_t*)(p.ws + OFF_Q);
  const bf16_t* Kb = (const bf16_t*)(p.ws + OFF_K);
  const bf16_t* Vb = (const bf16_t*)(p.ws + OFF_V);
  bf16_t* Y = (bf16_t*)(p.ws + OFF_N);
  f32x16 O[2]; zeroO(O);
  float m = -1e30f, l = 0.f;
  flash_loop<96, false>(O, m, l, Qb + ((size_t)gtok * 4 + h) * 96, Kb + ((size_t)tokbase * 4 + h) * 96, 384,
                        Vb + ((size_t)tokbase * 4 + h) * 64, 256, S / 64, 0, 0, 0, lds);
  l += __shfl_xor(l, 32);
  const float il = 1.f / l;
#pragma unroll
  for (int t = 0; t < 2; ++t)
#pragma unroll
    for (int r = 0; r < 16; ++r) O[t][r] *= il;
  store_o(Y + (size_t)gtok * 1024 + h * 64, O, h2);
}

DI void diff_item(CParams& p, int layer, int it, int S, char* lds) {
  const int tid = threadIdx.x + opq(), lane = tid & 63, w = tid >> 6, l31 = lane & 31, h2 = lane >> 5;
  const int lgq = (S == 2048) ? 4 : 7;
  const int qb = it & ((1 << lgq) - 1), bh = it >> lgq, h = bh & 3, b = bh >> 2;
  const int tokbase = b * S, gtok = tokbase + 128 * qb + 32 * w + l31;
  const bf16_t* PR = (const bf16_t*)(p.ws + OFF_PR);
  bf16_t* Y = (bf16_t*)(p.ws + OFF_N);
  const float* lam = p.diff_lambda + layer * 128;
  float s1 = 0.f, s2 = 0.f;
  if (lane < 32) { s1 = lam[lane] * lam[32 + lane]; s2 = lam[64 + lane] * lam[96 + lane]; }
  s1 = wave_sum(s1); s2 = wave_sum(s2);
  const float lambda_init = layer ? 0.35550907f : 0.2f;
  const float lambda_full = expf(s1) - expf(s2) + lambda_init;
  f32x16 of[2], O1[2];
  zeroO(of); zeroO(O1);
  {
    float m0 = -1e30f, l0 = 0.f, m1 = -1e30f, l1 = 0.f;
    flash_loop_diff(of, O1, m0, l0, m1, l1, PR + (size_t)gtok * NPR + C_BQ + (2 * h) * 32,
                    PR + (size_t)tokbase * NPR + C_BK + (2 * h) * 32, NPR, PR + (size_t)tokbase * NPR + C_BV + h * 64, NPR,
                    S / 64, lds);
    l0 += __shfl_xor(l0, 32);
    l1 += __shfl_xor(l1, 32);
    const float c0 = 1.f / l0, c1 = -lambda_full / l1;
#pragma unroll
    for (int t = 0; t < 2; ++t)
#pragma unroll
      for (int r = 0; r < 16; ++r) of[t][r] = c0 * of[t][r] + c1 * O1[t][r];
  }
  float ss = 0.f;
#pragma unroll
  for (int t = 0; t < 2; ++t)
#pragma unroll
    for (int r = 0; r < 16; ++r) ss += of[t][r] * of[t][r];
  ss += __shfl_xor(ss, 32);
  const float rs = rsqrtf(ss * (1.f / 64.f) + EPS) * (1.f - lambda_init);
  const float* sg = p.diff_subln + layer * 64;
#pragma unroll
  for (int t = 0; t < 2; ++t)
#pragma unroll
    for (int r = 0; r < 16; ++r) of[t][r] *= rs * sg[32 * t + crow(r, h2)];
  store_o(Y + (size_t)gtok * 1024 + 256 + h * 64, of, h2);
}

DI void dil_item(CParams& p, int it, int S, int B, char* lds) {
  const int tid = threadIdx.x + opq(), lane = tid & 63, w = tid >> 6, l31 = lane & 31, h2 = lane >> 5;
  const int lgS = (S == 2048) ? 11 : 14, lgB = (B == 16) ? 4 : 1;
  const int rq = it & ((1 << (lgS - 7)) - 1);
  int rest = it >> (lgS - 7);
  const int head = rest & 3; rest >>= 2;
  const int b = rest & (B - 1), g = rest >> lgB;
  const int lgd = 2 * g, dil = 1 << lgd;
  const int L = S >> lgd, lgnqb = lgS - lgd - 7;
  const int res = rq >> lgnqb, qb = rq & ((1 << lgnqb) - 1);
  const int tokbase = b * S;
  const int tq = 128 * qb + 32 * w + l31;
  const int gtok = tokbase + tq * dil + res;
  const bf16_t* PR = (const bf16_t*)(p.ws + OFF_PR);
  bf16_t* OD = (bf16_t*)(p.ws + OFF_OD);
  float* LSE = (float*)(p.ws + OFF_LSE);
  f32x16 O[2]; zeroO(O);
  float m = -1e30f, l = 0.f;
  const int hc = (g * 4 + head) * 64;
  flash_loop<64, true>(O, m, l, PR + (size_t)gtok * NPR + C_DQ + hc, PR + (size_t)(tokbase + res) * NPR + C_DK + hc,
                       (size_t)dil * NPR, PR + (size_t)(tokbase + res) * NPR + C_DV + hc, (size_t)dil * NPR, 4, tq,
                       128 * qb - 64, L, lds);
  l += __shfl_xor(l, 32);
  const float il = 1.f / l;
#pragma unroll
  for (int t = 0; t < 2; ++t)
#pragma unroll
    for (int r = 0; r < 16; ++r) O[t][r] *= il;
  store_o(OD + ((size_t)g * TG + gtok) * 256 + head * 64, O, h2);
  if (h2 == 0) LSE[((size_t)g * TG + gtok) * 4 + head] = m + __log2f(l);
}

constexpr size_t OFF_X2 = 564 * MiB, WS_BIG = 597 * MiB;
#define DN_QK_OFF (p.big_ws ? OFF_X2 : OFF_OD)
#define DN_GC_OFF ((p.big_ws ? OFF_X2 : OFF_OD) + 32 * MiB)
constexpr size_t DN_UW_OFF = OFF_Q;

DI void dn_prep_item(CParams& p, int layer, int it, int S, char* lds) {
  const int tid = threadIdx.x + opq(), lane = tid & 63, w = tid >> 6, l15 = lane & 15, g4 = lane >> 4;
  const int NC = S / 64;
  const int ch = it % NC, bh = it / NC, h = bh & 3, b = bh >> 2;
  const int tokbase = b * S, s0 = ch * 64;
  const bf16_t* PR = (const bf16_t*)(p.ws + OFF_PR);
  const float* AB = (const float*)(p.ws + OFF_AB);
  bf16_t* QKg = (bf16_t*)(p.ws + DN_QK_OFF) + ((size_t)bh * NC + ch) * 8192;
  bf16_t* raw = (bf16_t*)lds;
  float* convw = (float*)(lds + 27200);
  float* RU = (float*)lds;
  float* RW = (float*)(lds + 16384);
  float* Am = (float*)(lds + 32768);
  bf16_t* Kimg = (bf16_t*)(lds + 50176);
  bf16_t* Qimg = (bf16_t*)(lds + 59392);
  float* gcs = (float*)(lds + 68608);
  float* betas = gcs + 128;
  const float* cw = p.dn_conv + (size_t)layer * 5 * 768;
  {
    u32x4 rawreg[7];
    float cwr[4];
#pragma unroll
    for (int k = 0; k < 7; ++k) {
      const int ci = tid + 256 * k;
      const int rr = ci / 24, c = ci % 24, seg = c >> 3, c8 = c & 7;
      const int s = s0 + rr - 2;
      rawreg[k] = u32x4{0u, 0u, 0u, 0u};
      if (ci < 68 * 24 && s >= 0 && s < S)
        rawreg[k] = *(const u32x4*)(PR + (size_t)(tokbase + s) * NPR + C_DNQKV + seg * 256 + h * 64 + c8 * 8);
    }
#pragma unroll
    for (int k = 0; k < 4; ++k) {
      const int i = tid + 256 * k;
      cwr[k] = 0.f;
      if (i < 960) { const int j = i / 192, c = i % 192; cwr[k] = cw[j * 768 + (c >> 6) * 256 + h * 64 + (c & 63)]; }
    }
#pragma unroll
    for (int k = 0; k < 7; ++k) {
      const int ci = tid + 256 * k;
      const int rr = ci / 24, c = ci % 24, seg = c >> 3, c8 = c & 7;
      if (ci < 68 * 24) *(u32x4*)(raw + rr * 200 + seg * 64 + c8 * 8) = rawreg[k];
    }
#pragma unroll
    for (int k = 0; k < 4; ++k) { const int i = tid + 256 * k; if (i < 960) convw[i] = cwr[k]; }
  }
  if (tid < 128) {
    const int d = tid >> 6, pl = tid & 63;
    const int i = d ? 63 - pl : pl;
    const size_t tok = (size_t)tokbase + s0 + i;
    const float Aexp = expf(p.dn_a_log[layer * 8 + d * 4 + h]);
    const float a = AB[tok * 16 + d * 8 + h] + p.dn_dt_bias[layer * 8 + d * 4 + h];
    const float bb = AB[tok * 16 + d * 8 + 4 + h];
    const float sp = fmaxf(a, 0.f) + __logf(1.f + __expf(-fabsf(a)));
    float g = -Aexp * sp;
#pragma unroll
    for (int o = 1; o < 64; o <<= 1) { const float tv = __shfl_up(g, o); if (lane >= o) g += tv; }
    gcs[tid] = g;
    betas[tid] = sigmoidf_(bb);
    float* GC = (float*)(p.ws + DN_GC_OFF) + (((size_t)bh * 2 + d) * NC + ch) * 64;
    GC[pl] = g;
  }
  __syncthreads();
  const int pp = tid >> 2, cgp = tid & 3;
  float kv[16], vv[16];
  {
    float qv[16];
#pragma unroll
    for (int seg = 0; seg < 3; ++seg) {
      float acc[16];
#pragma unroll
      for (int c = 0; c < 16; ++c) acc[c] = 0.f;
#pragma unroll
      for (int j = 0; j < 5; ++j) {
        const bf16_t* rp = raw + (pp + j) * 200 + seg * 64 + 16 * cgp;
        const float* wp = convw + j * 192 + seg * 64 + 16 * cgp;
        const u32x4 u0 = *(const u32x4*)rp, u1 = *(const u32x4*)(rp + 8);
        const unsigned uu[8] = {u0.x, u0.y, u0.z, u0.w, u1.x, u1.y, u1.z, u1.w};
#pragma unroll
        for (int e = 0; e < 8; ++e) {
          acc[2 * e] += wp[2 * e] * __uint_as_float(uu[e] << 16);
          acc[2 * e + 1] += wp[2 * e + 1] * __uint_as_float(uu[e] & 0xffff0000u);
        }
      }
#pragma unroll
      for (int c = 0; c < 16; ++c) {
        const float sv = acc[c] * __builtin_amdgcn_rcpf(1.f + __expf(-acc[c]));
        if (seg == 0) qv[c] = sv; else if (seg == 1) kv[c] = sv; else vv[c] = sv;
      }
    }
    float sq = 0.f, sk = 0.f;
#pragma unroll
    for (int c = 0; c < 16; ++c) { sq += qv[c] * qv[c]; sk += kv[c] * kv[c]; }
    sq += __shfl_xor(sq, 1); sq += __shfl_xor(sq, 2);
    sk += __shfl_xor(sk, 1); sk += __shfl_xor(sk, 2);
    const float rq = rsqrtf(sq + EPS) * 0.125f, rk = rsqrtf(sk + EPS);
#pragma unroll
    for (int c = 0; c < 16; ++c) { qv[c] *= rq; kv[c] *= rk; }
    store8bf(Kimg + pp * 72 + 16 * cgp, kv); store8bf(Kimg + pp * 72 + 16 * cgp + 8, kv + 8);
    store8bf(Qimg + pp * 72 + 16 * cgp, qv); store8bf(Qimg + pp * 72 + 16 * cgp + 8, qv + 8);
    store8bf(QKg + pp * 64 + 16 * cgp, qv); store8bf(QKg + pp * 64 + 16 * cgp + 8, qv + 8);
    store8bf(QKg + 4096 + pp * 64 + 16 * cgp, kv); store8bf(QKg + 4096 + pp * 64 + 16 * cgp + 8, kv + 8);
  }
  for (int d = 0; d < 2; ++d) {
    __syncthreads();
    {
      const int pl = d ? 63 - pp : pp;
      const float bet = betas[d * 64 + pl], egc = __expf(gcs[d * 64 + pl]);
#pragma unroll
      for (int c = 0; c < 16; ++c) {
        RU[pl * 64 + 16 * cgp + c] = vv[c] * bet;
        RW[pl * 64 + 16 * cgp + c] = kv[c] * bet * egc;
      }
    }
    {
      f32x4 KK[4];
#pragma unroll
      for (int t = 0; t < 4; ++t) KK[t] = f32x4{0.f, 0.f, 0.f, 0.f};
      const int jl = 16 * w + l15;
      const int jrow = d ? 63 - jl : jl;
#pragma unroll
      for (int ks = 0; ks < 2; ++ks) {
        const bf16x8 bfk = *(const bf16x8*)(Kimg + jrow * 72 + 32 * ks + 8 * g4);
#pragma unroll
        for (int rt = 0; rt < 4; ++rt) {
          const int il = 16 * rt + l15;
          const int irow = d ? 63 - il : il;
          const bf16x8 afk = *(const bf16x8*)(Kimg + irow * 72 + 32 * ks + 8 * g4);
          KK[rt] = MFMA16(afk, bfk, KK[rt]);
        }
      }
      const float gcj = gcs[d * 64 + jl];
#pragma unroll
      for (int rt = 0; rt < 4; ++rt)
#pragma unroll
        for (int r = 0; r < 4; ++r) {
          const int i = 16 * rt + 4 * g4 + r;
          const float ee = __expf(fminf(gcs[d * 64 + i] - gcj, 0.f));
          Am[i * 68 + jl] = (i > jl) ? betas[d * 64 + i] * KK[rt][r] * ee : 0.f;
        }
    }
    __syncthreads();
    float xs[32];
#pragma unroll
    for (int q = 0; q < 32; ++q) xs[q] = 0.f;
    const int c = tid >> 1, half = tid & 1;
    {
      const float* Rc = (c < 64) ? (RU + c) : (RW + (c - 64));
      const float* Ah = Am + 4 * half;
#pragma unroll
      for (int i = 0; i < 64; ++i) {
        float part = 0.f;
#pragma unroll
        for (int q = 0; q < (i + 7) / 8; ++q) {
          const f32x4 a = *(const f32x4*)(Ah + i * 68 + 8 * q);
          part += a[0] * xs[4 * q] + a[1] * xs[4 * q + 1] + a[2] * xs[4 * q + 2] + a[3] * xs[4 * q + 3];
        }
        const float other = __int_as_float(__builtin_amdgcn_update_dpp(0, __float_as_int(part), 0xB1, 0xf, 0xf, true));
        const float xi = Rc[i * 64] - (part + other);
        const int loc = ((i >> 3) << 2) + (i & 3);
        if (((i >> 2) & 1) == 0) xs[loc] = (half == 0) ? xi : xs[loc];
        else xs[loc] = (half == 1) ? xi : xs[loc];
        if (i < 16 ? ((i & 7) == 7) : (i < 32 ? ((i & 3) == 3) : ((i & 1) == 1))) asm volatile("" ::: "memory");
      }
    }
    {
      bf16_t* UWg = (bf16_t*)(p.ws + DN_UW_OFF) + ((((size_t)bh * 2 + d) * NC + ch) * 8192);
      const float sgn = (c < 64) ? 1.f : -1.f;
      bf16_t* dst = UWg + ((c < 64) ? c : (4096 + c - 64));
#pragma unroll
      for (int loc = 0; loc < 32; ++loc) {
        const int i = (((loc >> 2) * 2 + half) << 2) + (loc & 3);
        dst[i * 64] = f2bf(sgn * xs[loc]);
      }
    }
  }
}

DI void dn_scan_chain(CParams& p, int it, int S, char* lds) {
  __builtin_amdgcn_s_setprio(3);
  const int tid0 = threadIdx.x + opq();
  const int dir = it & 1, bh = it >> 1, h = bh & 3, b = bh >> 2;
  const int tokbase = b * S, NC = S / 64;
  bf16_t* OUT = (bf16_t*)(p.ws + (dir ? OFF_OB : OFF_OF));
  const bf16_t* QKg = (const bf16_t*)(p.ws + DN_QK_OFF) + (size_t)bh * NC * 8192;
  const bf16_t* UWg = (const bf16_t*)(p.ws + DN_UW_OFF) + (size_t)it * NC * 8192;
  const float* GCg = (const float*)(p.ws + DN_GC_OFF) + (size_t)it * NC * 64;
  bf16_t* Uimg = (bf16_t*)lds;
  bf16_t* Wn = Uimg + 4608;
  bf16_t* Qimg = Wn + 4608;
  bf16_t* Kimg = Qimg + 4608;
  bf16_t* Kt = Kimg + 4608;
  bf16_t* Iimg = Kt + 4608;
  float* gcs = (float*)(lds + 6 * 9216);
  f32x4 Sd[4];
#pragma unroll
  for (int t = 0; t < 4; ++t) Sd[t] = f32x4{0.f, 0.f, 0.f, 0.f};
  u32x4 ru[2], rw[2], rq[2], rk[2];
  float rg = 0.f;
  auto prefetch = [&](int cc_) {
    const int ch_ = dir ? (NC - 1 - cc_) : cc_;
    const int tp = tid0 + opq();
    const bf16_t* uw = UWg + (size_t)ch_ * 8192;
    const bf16_t* qk = QKg + (size_t)ch_ * 8192;
#pragma unroll
    for (int k = 0; k < 2; ++k) {
      const int ci = tp + 256 * k, row = ci >> 3, c8 = ci & 7;
      const int srow = dir ? 63 - row : row;
      ru[k] = *(const u32x4*)(uw + row * 64 + c8 * 8);
      rw[k] = *(const u32x4*)(uw + 4096 + row * 64 + c8 * 8);
      rq[k] = *(const u32x4*)(qk + srow * 64 + c8 * 8);
      rk[k] = *(const u32x4*)(qk + 4096 + srow * 64 + c8 * 8);
    }
    if (tp < 64) rg = GCg[(size_t)ch_ * 64 + tp];
  };
  prefetch(0);
  for (int cc = 0; cc < NC; ++cc) {
    const int tid = tid0 + opq(), lane = tid & 63, w = tid >> 6, l15 = lane & 15, g4 = lane >> 4;
    const int e_col = 16 * w + l15;
    const int ch = dir ? (NC - 1 - cc) : cc;
    const int s0 = ch * 64;
    __syncthreads();
#pragma unroll
    for (int k = 0; k < 2; ++k) {
      const int ci = tid + 256 * k, row = ci >> 3, c8 = ci & 7;
      *(u32x4*)(Uimg + row * 72 + c8 * 8) = ru[k];
      *(u32x4*)(Wn + row * 72 + c8 * 8) = rw[k];
      *(u32x4*)(Qimg + row * 72 + c8 * 8) = rq[k];
      *(u32x4*)(Kimg + row * 72 + c8 * 8) = rk[k];
      const unsigned uu[4] = {rk[k].x, rk[k].y, rk[k].z, rk[k].w};
#pragma unroll
      for (int e = 0; e < 4; ++e) {
        Kt[(8 * c8 + 2 * e) * 72 + row] = (bf16_t)(uu[e] & 0xffffu);
        Kt[(8 * c8 + 2 * e + 1) * 72 + row] = (bf16_t)(uu[e] >> 16);
      }
    }
    if (tid < 64) gcs[tid] = rg;
    if (cc + 1 < NC) prefetch(cc + 1);
    __syncthreads();
    {
      f32x4 QK[4];
#pragma unroll
      for (int t = 0; t < 4; ++t) QK[t] = f32x4{0.f, 0.f, 0.f, 0.f};
#pragma unroll
      for (int ks = 0; ks < 2; ++ks) {
        const bf16x8 bfk = *(const bf16x8*)(Kimg + (16 * w + l15) * 72 + 32 * ks + 8 * g4);
#pragma unroll
        for (int rt = 0; rt < 4; ++rt) {
          const bf16x8 afq = *(const bf16x8*)(Qimg + (16 * rt + l15) * 72 + 32 * ks + 8 * g4);
          QK[rt] = MFMA16(afq, bfk, QK[rt]);
        }
      }
      const float gcj = gcs[e_col];
#pragma unroll
      for (int rt = 0; rt < 4; ++rt)
#pragma unroll
        for (int r = 0; r < 4; ++r) {
          const int i = 16 * rt + 4 * g4 + r;
          const float ee = __expf(fminf(gcs[i] - gcj, 0.f));
          Iimg[i * 72 + e_col] = f2bf((i >= e_col) ? QK[rt][r] * ee : 0.f);
        }
    }
    __syncthreads();
    {
      bf16x8 Bs[2];
#pragma unroll
      for (int ks = 0; ks < 2; ++ks)
        Bs[ks] = pack8(Sd[2 * ks][0], Sd[2 * ks][1], Sd[2 * ks][2], Sd[2 * ks][3], Sd[2 * ks + 1][0], Sd[2 * ks + 1][1],
                       Sd[2 * ks + 1][2], Sd[2 * ks + 1][3]);
      f32x4 vn[4], qs[4], iv[4];
#pragma unroll
      for (int rt = 0; rt < 4; ++rt) {
#pragma unroll
        for (int r = 0; r < 4; ++r) vn[rt][r] = bf2f(Uimg[(16 * rt + 4 * g4 + r) * 72 + e_col]);
        qs[rt] = f32x4{0.f, 0.f, 0.f, 0.f};
        iv[rt] = f32x4{0.f, 0.f, 0.f, 0.f};
#pragma unroll
        for (int ks = 0; ks < 2; ++ks) {
          const bf16_t* wp = Wn + (16 * rt + l15) * 72 + 32 * ks + 4 * g4;
          const bf16_t* qp = Qimg + (16 * rt + l15) * 72 + 32 * ks + 4 * g4;
          vn[rt] = MFMA16(ld2x4(wp, wp + 16), Bs[ks], vn[rt]);
          qs[rt] = MFMA16(ld2x4(qp, qp + 16), Bs[ks], qs[rt]);
        }
      }
      bf16x8 Bv[2];
#pragma unroll
      for (int ks = 0; ks < 2; ++ks)
        Bv[ks] = pack8(vn[2 * ks][0], vn[2 * ks][1], vn[2 * ks][2], vn[2 * ks][3], vn[2 * ks + 1][0], vn[2 * ks + 1][1],
                       vn[2 * ks + 1][2], vn[2 * ks + 1][3]);
#pragma unroll
      for (int rt = 0; rt < 4; ++rt)
#pragma unroll
        for (int ks = 0; ks < 2; ++ks) {
          const bf16_t* ip = Iimg + (16 * rt + l15) * 72 + 32 * ks + 4 * g4;
          iv[rt] = MFMA16(ld2x4(ip, ip + 16), Bv[ks], iv[rt]);
        }
      const float gc63 = gcs[63];
#pragma unroll
      for (int rt = 0; rt < 4; ++rt)
#pragma unroll
        for (int r = 0; r < 4; ++r) {
          const int pos = 16 * rt + 4 * g4 + r;
          const float o = qs[rt][r] * __expf(gcs[pos]) + iv[rt][r];
          const int i = dir ? 63 - pos : pos;
          OUT[((size_t)tokbase + s0 + i) * 256 + h * 64 + e_col] = f2bf(o);
          vn[rt][r] *= __expf(gc63 - gcs[pos]);
        }
      bf16x8 Bv2[2];
#pragma unroll
      for (int ks = 0; ks < 2; ++ks)
        Bv2[ks] = pack8(vn[2 * ks][0], vn[2 * ks][1], vn[2 * ks][2], vn[2 * ks][3], vn[2 * ks + 1][0], vn[2 * ks + 1][1],
                        vn[2 * ks + 1][2], vn[2 * ks + 1][3]);
      const float gl = __expf(gc63);
#pragma unroll
      for (int dt = 0; dt < 4; ++dt) {
#pragma unroll
        for (int r = 0; r < 4; ++r) Sd[dt][r] *= gl;
#pragma unroll
        for (int ks = 0; ks < 2; ++ks) {
          const bf16_t* kp = Kt + (16 * dt + l15) * 72 + 32 * ks + 4 * g4;
          Sd[dt] = MFMA16(ld2x4(kp, kp + 16), Bv2[ks], Sd[dt]);
        }
      }
    }
  }
  __builtin_amdgcn_s_setprio(0);
}

DI void phase_combine(CParams& p, int layer, const float* __restrict__ xg) {
  const int tidq = threadIdx.x + opq(); const int wave = tidq >> 6, lane = tidq & 63;
  const bf16_t* PR = (const bf16_t*)(p.ws + OFF_PR);
  const bf16_t* OD = (const bf16_t*)(p.ws + OFF_OD);
  const float* LSE = (const float*)(p.ws + OFF_LSE);
  const bf16_t* OFb = (const bf16_t*)(p.ws + OFF_OF);
  const bf16_t* OBb = (const bf16_t*)(p.ws + OFF_OB);
  bf16_t* Y = (bf16_t*)(p.ws + OFF_N);
  bf16_t* Np = (bf16_t*)(p.ws + OFF_Q);
  const float* gmix = p.norm_mix + layer * 1024;
  const float* gdn = p.dn_out_norm + layer * 64;
  const int head = lane >> 4;
  for (int r = blockIdx.x * 4 + wave; r < TG; r += gridDim.x * 4) {
    {
      float lg[3];
#pragma unroll
      for (int g = 0; g < 3; ++g) lg[g] = LSE[((size_t)g * TG + r) * 4 + head];
      const float mx = fmaxf(lg[0], fmaxf(lg[1], lg[2]));
      float wg[3], den = 0.f;
#pragma unroll
      for (int g = 0; g < 3; ++g) { wg[g] = exp2_(lg[g] - mx); den += wg[g]; }
      const float id = 1.f / den;
      float o[4] = {0.f, 0.f, 0.f, 0.f};
#pragma unroll
      for (int g = 0; g < 3; ++g) {
        const u32x2 u = ((const u32x2*)(OD + ((size_t)g * TG + r) * 256))[lane];
        const float c = wg[g] * id;
        o[0] += c * __uint_as_float(u.x << 16); o[1] += c * __uint_as_float(u.x & 0xffff0000u);
        o[2] += c * __uint_as_float(u.y << 16); o[3] += c * __uint_as_float(u.y & 0xffff0000u);
      }
      u32x2 ou; ou.x = pack2(o[0], o[1]); ou.y = pack2(o[2], o[3]);
      ((u32x2*)(Y + (size_t)r * 1024 + 768))[lane] = ou;
    }
    {
      const u32x2 uf = ((const u32x2*)(OFb + (size_t)r * 256))[lane];
      const u32x2 ub = ((const u32x2*)(OBb + (size_t)r * 256))[lane];
      const u32x2 uz = ((const u32x2*)(PR + (size_t)r * NPR + C_Z))[lane];
      float o[4], z[4];
      o[0] = __uint_as_float(uf.x << 16) + __uint_as_float(ub.x << 16);
      o[1] = __uint_as_float(uf.x & 0xffff0000u) + __uint_as_float(ub.x & 0xffff0000u);
      o[2] = __uint_as_float(uf.y << 16) + __uint_as_float(ub.y << 16);
      o[3] = __uint_as_float(uf.y & 0xffff0000u) + __uint_as_float(ub.y & 0xffff0000u);
      z[0] = __uint_as_float(uz.x << 16); z[1] = __uint_as_float(uz.x & 0xffff0000u);
      z[2] = __uint_as_float(uz.y << 16); z[3] = __uint_as_float(uz.y & 0xffff0000u);
      float ss = o[0] * o[0] + o[1] * o[1] + o[2] * o[2] + o[3] * o[3];
      ss += __shfl_xor(ss, 1); ss += __shfl_xor(ss, 2); ss += __shfl_xor(ss, 4); ss += __shfl_xor(ss, 8);
      const float rs = rsqrtf(ss * (1.f / 64.f) + EPS);
      const float4 gg = ((const float4*)gdn)[lane & 15];
      u32x2 ou;
      ou.x = pack2(o[0] * rs * gg.x * siluf_(z[0]), o[1] * rs * gg.y * siluf_(z[1]));
      ou.y = pack2(o[2] * rs * gg.z * siluf_(z[2]), o[3] * rs * gg.w * siluf_(z[3]));
      ((u32x2*)(Y + (size_t)r * 1024 + 512))[lane] = ou;
    }
    {
      const float4* xr = (const float4*)(xg + (size_t)r * 1024);
      float4 v[4];
      float ss = 0.f;
#pragma unroll
      for (int i = 0; i < 4; ++i) { v[i] = xr[lane + 64 * i]; ss += v[i].x * v[i].x + v[i].y * v[i].y + v[i].z * v[i].z + v[i].w * v[i].w; }
      ss = wave_sum(ss);
      const float rs = rsqrtf(ss * (1.f / 1024.f) + EPS);
#pragma unroll
      for (int i = 0; i < 4; ++i) {
        const float4 gg = ((const float4*)gmix)[lane + 64 * i];
        u32x2 o; o.x = pack2(v[i].x * rs * gg.x, v[i].y * rs * gg.y); o.y = pack2(v[i].z * rs * gg.z, v[i].w * rs * gg.w);
        ((u32x2*)(Np + (size_t)r * 1024))[lane + 64 * i] = o;
      }
    }
  }
}

#define XB_TMO      128
#define XB_XCNT(j)  (256  + 64 * (j))
#define XB_XSUB(j)  (1280 + 64 * (j))
#define XB_XGEN(j)  (2304 + 64 * (j))
#define XB_TOP      3328
#define XB_TOPGEN   3392
#define XCD_BAR_WORDS 3456
#define XB_SPIN_CAP (1u << 27)
#define LAS __attribute__((address_space(3)))
constexpr size_t OFF_BAR = OFF_CNT + 65536;
DI unsigned xb_ld(unsigned* p) { return __hip_atomic_load(p, __ATOMIC_RELAXED, __HIP_MEMORY_SCOPE_AGENT); }
DI unsigned xb_add(unsigned* p, unsigned v) { return __hip_atomic_fetch_add(p, v, __ATOMIC_RELAXED, __HIP_MEMORY_SCOPE_AGENT); }
DI unsigned xb_xcc_id() { return (unsigned)__builtin_amdgcn_s_getreg((3 << 11) | 20) & 0xFu; }
#define XB_SPIN(cond, bar) do { unsigned _sp = 0; while (cond) { __builtin_amdgcn_s_sleep(1); \
    if ((++_sp & 255u) == 0u) { if (xb_ld(&(bar)[XB_TMO])) break; if (_sp > XB_SPIN_CAP) { atomicAdd(&(bar)[XB_TMO], 1u); break; } } } } while (0)
struct XcdBarrier { unsigned* bar; unsigned x; volatile LAS unsigned* st; };
DI XcdBarrier xcd_barrier_post(unsigned* bar, volatile LAS unsigned* st) {
  XcdBarrier b; b.bar = bar; b.x = xb_xcc_id(); b.st = st;
  if (threadIdx.x == 0) (void)xb_add(&bar[XB_XCNT(b.x)], 1u);
  return b;
}
DI void xcd_barrier_complete(unsigned* bar, unsigned x, unsigned& nloc, unsigned& nx) {
  const unsigned G = gridDim.x * gridDim.y * gridDim.z;
  unsigned sum, cnt, mine, sp = 0u;
  for (;;) {
    sum = 0u; cnt = 0u; mine = 0u;
#pragma unroll
    for (unsigned j = 0; j < 16; ++j) { const unsigned c = xb_ld(&bar[XB_XCNT(j)]); sum += c; cnt += (c > 0u) ? 1u : 0u; mine = (j == x) ? c : mine; }
    if (sum == G) break;
    __builtin_amdgcn_s_sleep(1);
    if ((++sp & 255u) == 0u) { if (xb_ld(&bar[XB_TMO])) break; if (sp > XB_SPIN_CAP) { atomicAdd(&bar[XB_TMO], 1u); break; } }
  }
  nloc = mine > 0u ? mine : 1u; nx = cnt > 0u ? cnt : 1u;
}
DI void xcd_barrier(const XcdBarrier& b) {
  asm volatile("s_waitcnt vmcnt(0)" ::: "memory");
  __syncthreads();
  if (threadIdx.x == 0) {
    unsigned* bar = b.bar;
    __builtin_amdgcn_s_waitcnt(0);
    unsigned nloc = b.st[0], nx = b.st[1];
    if (nloc == 0u) { xcd_barrier_complete(bar, b.x, nloc, nx); b.st[0] = nloc; b.st[1] = nx; }
    const unsigned old = xb_add(&bar[XB_XSUB(b.x)], 1u);
    const unsigned gen = old / nloc;
    if (old + 1u == (gen + 1u) * nloc) {
      __builtin_amdgcn_fence(__ATOMIC_RELEASE, "agent");
      asm volatile("s_waitcnt vmcnt(0)" ::: "memory");
      const unsigned og = xb_add(&bar[XB_TOP], 1u);
      const unsigned tg = og / nx;
      if (og + 1u == (tg + 1u) * nx) xb_add(&bar[XB_TOPGEN], 1u);
      else XB_SPIN(xb_ld(&bar[XB_TOPGEN]) == tg, bar);
      __builtin_amdgcn_fence(__ATOMIC_ACQUIRE, "agent");
      xb_add(&bar[XB_XGEN(b.x)], 1u);
      asm volatile("s_waitcnt vmcnt(0)" ::: "memory");
    } else {
      XB_SPIN(xb_ld(&bar[XB_XGEN(b.x)]) == gen, bar);
      __builtin_amdgcn_fence(__ATOMIC_ACQUIRE, "agent");
      asm volatile("s_waitcnt vmcnt(0)" ::: "memory");
    }
  }
  __syncthreads();
}

#ifndef REP_MIX
#define REP_MIX 1
#endif
#ifndef REP_GEMM
#define REP_GEMM 1
#endif
__global__ void __launch_bounds__(256, 2) mega(Params pk) {
  extern __shared__ __attribute__((aligned(16))) char lds[];
  __shared__ uint4 sh_words;
  cg::grid_group grid = cg::this_grid();
  CParams* kp = (CParams*)__builtin_amdgcn_kernarg_segment_ptr();
  if (threadIdx.x == 0) sh_words = make_uint4(0u, 0u, 0u, 0u);
  __syncthreads();
  XcdBarrier xb;
  { CParams& p = *launder(kp); xb = xcd_barrier_post((unsigned*)(p.ws + OFF_BAR), (volatile LAS unsigned*)&sh_words); }
#define s_item (((volatile int*)&sh_words)[2])
#define GSYNC() xcd_barrier(xb)
#define PP_ CParams& p = *launder(kp); const bf16_t* wb = (const bf16_t*)(p.ws + OFF_WB); bf16_t* Nb = (bf16_t*)(p.ws + OFF_N); \
            bf16_t* PRb = (bf16_t*)(p.ws + OFF_PR); bf16_t* Npb = (bf16_t*)(p.ws + OFF_Q); bf16_t* PB = (bf16_t*)(p.ws + OFF_OD); \
            float* xg = p.x + (size_t)grp * TG * 1024; (void)wb; (void)Nb; (void)PRb; (void)Npb; (void)PB; (void)xg;
  { CParams& p = *launder(kp); phase_init(p, lds); phase_norm(p.x_in[0], p.norm_ff1, (bf16_t*)(p.ws + OFF_Q), nullptr, nullptr); }
  grid.sync();
  for (int layer = 0; layer < 2; ++layer) {
    if (layer > 0) { CParams& p = *launder(kp); phase_convert(p, layer, lds); GSYNC(); }
    for (int grp = 0; grp < 2; ++grp) {
      const int S = grp ? 2048 : 16384, B = grp ? 16 : 2;
      const float* xsrc0 = nullptr;
      { CParams& p = *launder(kp); xsrc0 = layer == 0 ? p.x_in[grp] : p.x + (size_t)grp * TG * 1024; }
      for (int rep = 0; rep < REP_GEMM; ++rep) {
        { PP_ phase_ffn_a(Npb, wb + W_FF1_1, wb + W_FF1_3, PRb, lds); }
        GSYNC();
      }
      { PP_ phase_gemm_resid(PRb, 2816, wb + W_FF1_2, xsrc0, xg, 0.5f, lds); }
      GSYNC();
      { PP_ phase_norm(xg, p.norm_mix + layer * 1024, Nb, nullptr, nullptr); }
      GSYNC();
      for (int rep = 0; rep < REP_GEMM; ++rep) {
        { PP_ phase_proj(p, Nb, wb + W_IN, S, lds); }
        GSYNC();
      }
      {
        PP_
        int* c0 = (int*)(p.ws + OFF_CNT) + (layer * 2 + grp) * 4;
        for (;;) {
          __syncthreads();
          if (threadIdx.x == 0) s_item = atomicAdd(c0, 1);
          __syncthreads();
          const int it = s_item;
          if (it >= 2048) break;
          dn_prep_item(p, layer, it, S, lds);
        }
      }
      GSYNC();
      {
        PP_
        int* cb = (int*)(p.ws + OFF_CNT) + 64 + (layer * 2 + grp) * 32;
        const int nDN = B * 8, nDil = p.big_ws ? 3072 : 0;
        const int lgq = grp ? 4 : 7;
        for (;;) {
          __syncthreads();
          if (threadIdx.x == 0) s_item = atomicAdd(cb, 1);
          __syncthreads();
          const int it = s_item;
          if (it >= nDN) break;
          dn_scan_chain(p, it, S, lds);
        }
        for (int xo = 0; xo < 8; ++xo) {
          const int xq = (blockIdx.x + xo) & 7;
          for (;;) {
            __syncthreads();
            if (threadIdx.x == 0) s_item = atomicAdd(cb + 8 + xq, 1);
            __syncthreads();
            const int j = s_item;
            if (j >= 128) break;
            const int pair = xq + 8 * (j >> lgq), qb = j & ((1 << lgq) - 1);
            diff_item(p, layer, (pair << lgq) + qb, S, lds);
          }
        }
        for (;;) {
          __syncthreads();
          if (threadIdx.x == 0) s_item = atomicAdd(cb + 1, 1);
          __syncthreads();
          const int it = s_item;
          if (it >= nDil) break;
          dil_item(p, it, S, B, lds);
        }
      }
      GSYNC();
      {
        PP_
        int* c2 = (int*)(p.ws + OFF_CNT) + (layer * 2 + grp) * 4 + 2;
        const int nDil = p.big_ws ? 0 : 3072, total = nDil + 256 * 7;
        for (;;) {
          __syncthreads();
          if (threadIdx.x == 0) s_item = atomicAdd(c2, 1);
          __syncthreads();
          int it = s_item;
          if (it >= total) break;
          if (it < nDil) { dil_item(p, it, S, B, lds); continue; }
          it -= nDil;
          mla_up_tile(p, it / 7, it % 7, S, lds);
        }
      }
      GSYNC();
      {
        PP_
        int* cb = (int*)(p.ws + OFF_CNT) + 64 + (layer * 2 + grp) * 32 + 16;
        const int lgq = grp ? 4 : 7;
        for (int xo = 0; xo < 8; ++xo) {
          const int xq = (blockIdx.x + xo) & 7;
          for (;;) {
            __syncthreads();
            if (threadIdx.x == 0) s_item = atomicAdd(cb + xq, 1);
            __syncthreads();
            const int j = s_item;
            if (j >= 128) break;
            const int pair = xq + 8 * (j >> lgq), qb = j & ((1 << lgq) - 1);
            mla_item(p, (pair << lgq) + qb, S, lds);
          }
        }
      }
      GSYNC();
      { PP_ phase_combine(p, layer, xg); }
      GSYNC();
      for (int rep = 0; rep < REP_GEMM; ++rep) {
        { PP_ phase_merge(Npb, Nb, wb + W_G, wb + W_B, PRb, lds); }
        GSYNC();
      }
      { PP_ phase_gemm_resid(PRb, 1024, wb + W_O, xg, xg, 1.0f, lds); }
      GSYNC();
      { PP_ phase_norm(xg, p.norm_ff2 + layer * 1024, Nb, nullptr, nullptr); }
      GSYNC();
      for (int rep = 0; rep < REP_GEMM; ++rep) {
        { PP_ phase_ffn_a(Nb, wb + W_FF2_1, wb + W_FF2_3, PRb, lds); }
        GSYNC();
      }
      { PP_ phase_gemm_resid(PRb, 2816, wb + W_FF2_2, xg, xg, 0.5f, lds); }
      GSYNC();
      { PP_ phase_norm(xg, p.norm_ple + layer * 1024, Nb, p.p_in[grp] + (size_t)layer * TG * 256, PB); }
      GSYNC();
      {
        PP_
        phase_ple(Nb, PB, wb + W_PG, wb + W_PP, xg, lds);
        const int nl = grp ? layer + 1 : layer, ng = grp ^ 1;
        if (nl < 2) phase_norm(nl == 0 ? p.x_in[ng] : p.x + (size_t)ng * TG * 1024, p.norm_ff1 + nl * 1024, Npb, nullptr, nullptr);
      }
      GSYNC();
    }
  }
  { CParams& p = *launder(kp); phase_final_norm(p.x, p.norm_final); }
}

extern "C" void kernel_launch(void* const* d_in, const int* in_sizes, int n_in, void* d_out, int out_size, void* d_ws,
                              size_t ws_size, hipStream_t stream) {
  (void)in_sizes; (void)n_in; (void)out_size;
  Params p{};
  p.x_in[0] = (const float*)d_in[0]; p.x_in[1] = (const float*)d_in[1];
  p.p_in[0] = (const float*)d_in[2]; p.p_in[1] = (const float*)d_in[3];
  p.norm_ff1 = (const float*)d_in[4]; p.ff1_w1 = (const float*)d_in[5]; p.ff1_w3 = (const float*)d_in[6];
  p.ff1_w2 = (const float*)d_in[7]; p.norm_mix = (const float*)d_in[8]; p.w_in = (const float*)d_in[9];
  p.mla_q_norm = (const float*)d_in[10]; p.mla_kv_norm = (const float*)d_in[11]; p.mla_w_uq = (const float*)d_in[12];
  p.mla_w_ukv = (const float*)d_in[13]; p.diff_lambda = (const float*)d_in[14]; p.diff_subln = (const float*)d_in[15];
  p.dn_conv = (const float*)d_in[16]; p.dn_a_log = (const float*)d_in[17]; p.dn_dt_bias = (const float*)d_in[18];
  p.dn_out_norm = (const float*)d_in[19]; p.w_branch = (const float*)d_in[20]; p.w_gate = (const float*)d_in[21];
  p.w_out = (const float*)d_in[22]; p.norm_ff2 = (const float*)d_in[23]; p.ff2_w1 = (const float*)d_in[24];
  p.ff2_w3 = (const float*)d_in[25]; p.ff2_w2 = (const float*)d_in[26]; p.norm_ple = (const float*)d_in[27];
  p.ple_gate = (const float*)d_in[28]; p.ple_proj = (const float*)d_in[29]; p.norm_final = (const float*)d_in[30];
  p.x = (float*)d_out;
  p.ws = (char*)d_ws;
  p.big_ws = (ws_size >= WS_BIG) ? 1 : 0;
  static int grid_blocks = 0;
  if (!grid_blocks) {
    int dev = 0, cus = 0, per_cu = 0;
    hipGetDevice(&dev);
    hipDeviceGetAttribute(&cus, hipDeviceAttributeMultiprocessorCount, dev);
    hipFuncSetAttribute((const void*)mega, hipFuncAttributeMaxDynamicSharedMemorySize, (int)LDS_BYTES);
    hipOccupancyMaxActiveBlocksPerMultiprocessor(&per_cu, mega, 256, LDS_BYTES);
    if (per_cu < 1) per_cu = 1;
    grid_blocks = cus * per_cu;
  }
  if (ws_size < WS_NEED) {
    fprintf(stderr, "workspace too small: %zu < %zu\n", ws_size, (size_t)WS_NEED);
    return;
  }
  (void)hipMemsetAsync((char*)d_ws + OFF_BAR, 0, XCD_BAR_WORDS * 4, stream);
  void* args[] = {&p};
  hipError_t e = hipLaunchCooperativeKernel((void*)mega, dim3(grid_blocks), dim3(256), args, LDS_BYTES, stream);
  if (e != hipSuccess) fprintf(stderr, "cooperative launch failed: %s (grid %d)\n", hipGetErrorString(e), grid_blocks);
}
```

```cpp
#include <hip/hip_runtime.h>
#include <hip/hip_cooperative_groups.h>
#include <stdint.h>
#include <stdio.h>
namespace cg = cooperative_groups;

typedef unsigned short bf16_t;
using bf16x8 = __attribute__((ext_vector_type(8))) short;
using bf16x4 = __attribute__((ext_vector_type(4))) short;
using f32x16 = __attribute__((ext_vector_type(16))) float;
using f32x4 = __attribute__((ext_vector_type(4))) float;
using u32x4 = __attribute__((ext_vector_type(4))) unsigned;
using u32x2 = __attribute__((ext_vector_type(2))) unsigned;

#define DI __device__ __forceinline__
#define MFMA32(a, b, c) __builtin_amdgcn_mfma_f32_32x32x16_bf16((a), (b), (c), 0, 0, 0)
#define MFMA16(a, b, c) __builtin_amdgcn_mfma_f32_16x16x32_bf16((a), (b), (c), 0, 0, 0)

constexpr int TG = 32768;
constexpr int NPR = 4608;
constexpr float EPS = 1e-6f;
constexpr float LOG2E = 1.4426950408889634f;
constexpr int C_CQ = 0, C_CKV = 256, C_BQ = 384, C_BK = 640, C_BV = 896, C_DNQKV = 1152, C_Z = 1920,
              C_DQ = 2176, C_DK = 2944, C_DV = 3712;
constexpr size_t MiB = 1048576;
constexpr size_t OFF_WB = 0, OFF_TAB = 57 * MiB, OFF_CNT = 63 * MiB, OFF_N = 64 * MiB, OFF_PR = 128 * MiB,
                 OFF_Q = 416 * MiB, OFF_K = 440 * MiB, OFF_V = 464 * MiB, OFF_AB = 480 * MiB, OFF_OD = 482 * MiB,
                 OFF_LSE = 530 * MiB, OFF_OF = 532 * MiB, OFF_OB = 548 * MiB, WS_NEED = 564 * MiB;
constexpr size_t W_FF1_1 = 0, W_FF1_3 = 2883584, W_FF1_2 = 5767168, W_IN = 8650752, W_UQ = 13369344,
                 W_UKV = 13467648, W_G = 13533184, W_B = 17727488, W_O = 18776064, W_FF2_1 = 19824640,
                 W_FF2_3 = 22708224, W_FF2_2 = 25591808, W_PG = 28475392, W_PP = 29523968;
constexpr size_t LDS_BYTES = 78336;

struct Params {
  const float* x_in[2];
  const float* p_in[2];
  const float *norm_ff1, *ff1_w1, *ff1_w3, *ff1_w2, *norm_mix, *w_in, *mla_q_norm, *mla_kv_norm, *mla_w_uq,
      *mla_w_ukv, *diff_lambda, *diff_subln, *dn_conv, *dn_a_log, *dn_dt_bias, *dn_out_norm, *w_branch, *w_gate,
      *w_out, *norm_ff2, *ff2_w1, *ff2_w3, *ff2_w2, *norm_ple, *ple_gate, *ple_proj, *norm_final;
  float* x;
  char* ws;
  long long big_ws;
};

typedef const __attribute__((address_space(4))) Params CParams;
DI CParams* launder(CParams* q) { asm volatile("" : "+s"(q)); return q; }

typedef __bf16 bf2_t __attribute__((ext_vector_type(2)));
typedef float f2_t __attribute__((ext_vector_type(2)));
DI bf16_t f2bf(float x) { return __builtin_bit_cast(bf16_t, (__bf16)x); }
DI float bf2f(bf16_t b) { return __uint_as_float(((unsigned)b) << 16); }
DI unsigned pack2(float a, float b) { f2_t v = {a, b}; return __builtin_bit_cast(unsigned, __builtin_convertvector(v, bf2_t)); }
DI float wave_sum(float v) {
#pragma unroll
  for (int o = 32; o > 0; o >>= 1) v += __shfl_xor(v, o);
  return v;
}
DI float sigmoidf_(float x) { return __builtin_amdgcn_rcpf(1.f + __expf(-x)); }
DI float siluf_(float x) { return x * __builtin_amdgcn_rcpf(1.f + __expf(-x)); }
DI float exp2_(float x) { return __builtin_amdgcn_exp2f(x); }
DI int opq() { int z; asm volatile("v_mov_b32 %0, 0" : "=v"(z)); return z; }
DI float xhalf_max(float v) {
  const auto r = __builtin_amdgcn_permlane32_swap(__float_as_uint(v), __float_as_uint(v), false, false);
  return fmaxf(__uint_as_float(r[0]), __uint_as_float(r[1]));
}
DI int crow(int r, int h2) { return (r & 3) + 8 * (r >> 2) + 4 * h2; }
DI bf16x8 pack8(float a0, float a1, float a2, float a3, float a4, float a5, float a6, float a7) {
  u32x4 u;
  u.x = pack2(a0, a1); u.y = pack2(a2, a3); u.z = pack2(a4, a5); u.w = pack2(a6, a7);
  return __builtin_bit_cast(bf16x8, u);
}
DI bf16x8 ld2x4(const bf16_t* p0, const bf16_t* p1) {
  u32x2 a = *(const u32x2*)p0, b = *(const u32x2*)p1;
  u32x4 u; u.x = a.x; u.y = a.y; u.z = b.x; u.w = b.y;
  return __builtin_bit_cast(bf16x8, u);
}
DI void store8bf(bf16_t* dst, const float* v) {
  u32x4 u; u.x = pack2(v[0], v[1]); u.y = pack2(v[2], v[3]); u.z = pack2(v[4], v[5]); u.w = pack2(v[6], v[7]);
  *(u32x4*)dst = u;
}

struct MatDesc { const float* src; bf16_t* dst; int K, ldsrc, Ndst, map; const float* rowscale; };

DI int map_col(int map, int n) {
  if (map == 0) return n;
  if (map == 1) {
    if (n < 384) return n;
    if (n < 1920) return n + 32;
    if (n < 4480) return n + 48;
    if (n < 4512) return n - 4480 + 384;
    if (n < 4528) return n - 4512 + 1952;
    return -1;
  }
  if (n < 256) return (n >> 6) * 96 + (n & 63);
  return ((n - 256) >> 5) * 96 + 64 + ((n - 256) & 31);
}

DI MatDesc get_mat(CParams& p, int l, int id) {
  bf16_t* wb = (bf16_t*)(p.ws + OFF_WB);
  MatDesc d; d.map = 0; d.rowscale = nullptr;
  const size_t FF = (size_t)1024 * 2816;
  switch (id) {
    case 0: d.src = p.ff1_w1 + l * FF; d.dst = wb + W_FF1_1; d.K = 1024; d.ldsrc = 2816; d.Ndst = 2816; break;
    case 1: d.src = p.ff1_w3 + l * FF; d.dst = wb + W_FF1_3; d.K = 1024; d.ldsrc = 2816; d.Ndst = 2816; break;
    case 2: d.src = p.ff1_w2 + l * FF; d.dst = wb + W_FF1_2; d.K = 2816; d.ldsrc = 1024; d.Ndst = 1024; break;
    case 3: d.src = p.w_in + (size_t)l * 1024 * 4528; d.dst = wb + W_IN; d.K = 1024; d.ldsrc = 4528; d.Ndst = 4608; d.map = 1; break;
    case 4: d.src = p.mla_w_uq + (size_t)l * 256 * 384; d.dst = wb + W_UQ; d.K = 256; d.ldsrc = 384; d.Ndst = 384; d.map = 2; d.rowscale = p.mla_q_norm + l * 256; break;
    case 5: d.src = p.mla_w_ukv + (size_t)l * 128 * 512; d.dst = wb + W_UKV; d.K = 128; d.ldsrc = 512; d.Ndst = 512; d.rowscale = p.mla_kv_norm + l * 128; break;
    case 6: case 7: case 8: case 9:
      d.src = p.w_gate + (size_t)(l * 4 + id - 6) * 1048576; d.dst = wb + W_G + (size_t)(id - 6) * 1048576; d.K = 1024; d.ldsrc = 1024; d.Ndst = 1024; break;
    case 10: case 11: case 12: case 13:
      d.src = p.w_branch + (size_t)(l * 4 + id - 10) * 262144; d.dst = wb + W_B + (size_t)(id - 10) * 262144; d.K = 256; d.ldsrc = 1024; d.Ndst = 1024; break;
    case 14: d.src = p.w_out + (size_t)l * 1048576; d.dst = wb + W_O; d.K = 1024; d.ldsrc = 1024; d.Ndst = 1024; break;
    case 15: d.src = p.ff2_w1 + l * FF; d.dst = wb + W_FF2_1; d.K = 1024; d.ldsrc = 2816; d.Ndst = 2816; break;
    case 16: d.src = p.ff2_w3 + l * FF; d.dst = wb + W_FF2_3; d.K = 1024; d.ldsrc = 2816; d.Ndst = 2816; break;
    case 17: d.src = p.ff2_w2 + l * FF; d.dst = wb + W_FF2_2; d.K = 2816; d.ldsrc = 1024; d.Ndst = 1024; break;
    case 18: d.src = p.ple_gate + (size_t)l * 1048576; d.dst = wb + W_PG; d.K = 1024; d.ldsrc = 1024; d.Ndst = 1024; break;
    default: d.src = p.ple_proj + (size_t)l * 262144; d.dst = wb + W_PP; d.K = 256; d.ldsrc = 1024; d.Ndst = 1024; break;
  }
  return d;
}

DI void phase_convert(CParams& p, int l, char* lds) {
  float* T = (float*)lds;
  const int tid = threadIdx.x + opq();
  for (int id = 0; id < 20; ++id) {
    MatDesc d = get_mat(p, l, id);
    const int nkt = d.K >> 6, nnt = d.Ndst >> 6, nt_all = nkt * nnt;
    for (int t = blockIdx.x; t < nt_all; t += gridDim.x) {
      const int kt = t / nnt, nt = t % nnt;
      __syncthreads();
      {
        const int nl = tid & 63;
        const int sc = map_col(d.map, nt * 64 + nl);
#pragma unroll 4
        for (int i = 0; i < 16; ++i) {
          const int kl = (tid >> 6) + 4 * i;
          const int k = kt * 64 + kl;
          float v = 0.f;
          if (sc >= 0) v = d.src[(size_t)k * d.ldsrc + sc];
          if (d.rowscale) v *= d.rowscale[k];
          T[kl * 65 + nl] = v;
        }
      }
      __syncthreads();
      {
        const int kl = tid & 63;
#pragma unroll 4
        for (int i = 0; i < 16; ++i) {
          const int nl = (tid >> 6) + 4 * i;
          d.dst[(size_t)(nt * 64 + nl) * d.K + kt * 64 + kl] = f2bf(T[kl * 65 + nl]);
        }
      }
    }
  }
}

DI void phase_init(CParams& p, char* lds) {
  const size_t gtid = (size_t)blockIdx.x * 256 + threadIdx.x + opq(), gn = (size_t)gridDim.x * 256;
  {
    float2* t32 = (float2*)(p.ws + OFF_TAB);
    float2* t64 = (float2*)(p.ws + OFF_TAB + 2 * MiB);
    for (size_t i = gtid; i < (size_t)16384 * 48; i += gn) {
      const int pos = (int)(i / 48), f = (int)(i % 48);
      float inv;
      if (f < 16) inv = exp2f(-(float)f * (13.287712379549449f / 16.f));
      else inv = exp2f(-(float)(f - 16) * (13.287712379549449f / 32.f));
      const float ang = (float)pos * inv;
      const double xd = (double)ang;
      const double n = rint(xd * 0.15915494309189535);
      const float rf = (float)(xd - n * 6.283185307179586);
      float2 cs; cs.x = __cosf(rf); cs.y = __sinf(rf);
      if (f < 16) t32[(size_t)pos * 16 + f] = cs; else t64[(size_t)pos * 32 + (f - 16)] = cs;
    }
  }
  if (blockIdx.x == 0) ((int*)(p.ws + OFF_CNT))[threadIdx.x] = 0;
  phase_convert(p, 0, lds);
}

DI void phase_norm(const float* __restrict__ x, const float* __restrict__ g, bf16_t* __restrict__ dst,
                           const float* __restrict__ psrc, bf16_t* __restrict__ pdst) {
  const int tidq = threadIdx.x + opq(); const int wave = tidq >> 6, lane = tidq & 63;
  for (int r = blockIdx.x * 4 + wave; r < TG; r += gridDim.x * 4) {
    const float4* xr = (const float4*)(x + (size_t)r * 1024);
    float4 v[4];
    float ss = 0.f;
#pragma unroll
    for (int i = 0; i < 4; ++i) { v[i] = xr[lane + 64 * i]; ss += v[i].x * v[i].x + v[i].y * v[i].y + v[i].z * v[i].z + v[i].w * v[i].w; }
    ss = wave_sum(ss);
    const float rs = rsqrtf(ss * (1.f / 1024.f) + EPS);
#pragma unroll
    for (int i = 0; i < 4; ++i) {
      const float4 gg = ((const float4*)g)[lane + 64 * i];
      u32x2 o; o.x = pack2(v[i].x * rs * gg.x, v[i].y * rs * gg.y); o.y = pack2(v[i].z * rs * gg.z, v[i].w * rs * gg.w);
      ((u32x2*)(dst + (size_t)r * 1024))[lane + 64 * i] = o;
    }
    if (psrc) {
      const float4 pv = ((const float4*)(psrc + (size_t)r * 256))[lane];
      u32x2 o; o.x = pack2(pv.x, pv.y); o.y = pack2(pv.z, pv.w);
      ((u32x2*)(pdst + (size_t)r * 256))[lane] = o;
    }
  }
}

DI void phase_final_norm(float* __restrict__ x, const float* __restrict__ g) {
  const int tidq = threadIdx.x + opq(); const int wave = tidq >> 6, lane = tidq & 63;
  for (int r = blockIdx.x * 4 + wave; r < 2 * TG; r += gridDim.x * 4) {
    float4* xr = (float4*)(x + (size_t)r * 1024);
    float4 v[4];
    float ss = 0.f;
#pragma unroll
    for (int i = 0; i < 4; ++i) { v[i] = xr[lane + 64 * i]; ss += v[i].x * v[i].x + v[i].y * v[i].y + v[i].z * v[i].z + v[i].w * v[i].w; }
    ss = wave_sum(ss);
    const float rs = rsqrtf(ss * (1.f / 1024.f) + EPS);
#pragma unroll
    for (int i = 0; i < 4; ++i) {
      const float4 gg = ((const float4*)g)[lane + 64 * i];
      float4 o; o.x = v[i].x * rs * gg.x; o.y = v[i].y * rs * gg.y; o.z = v[i].z * rs * gg.z; o.w = v[i].w * rs * gg.w;
      xr[lane + 64 * i] = o;
    }
  }
}

template <int NI, int NB>
DI void gemm_main(f32x16 (&acc0)[2][NI], f32x16 (&acc1)[2][NI], const bf16_t* __restrict__ A, int lda,
                  const bf16_t* __restrict__ B0, const bf16_t* __restrict__ B1, int ldb, int K, char* lds) {
  const int tid = threadIdx.x + opq(), lane = tid & 63, w = tid >> 6, wm = w >> 1, wn = w & 1, l31 = lane & 31, h2 = lane >> 5;
  bf16_t* As = (bf16_t*)lds;
  bf16_t* B0s = As + 128 * 72;
  bf16_t* B1s = B0s + 64 * NI * 72;
  const int lr = tid >> 3, lc = (tid & 7) * 8;
  u32x4 ra[4], rb0[2 * NI], rb1[2 * NI];
  const bf16_t* ap = A + (size_t)lr * lda + lc;
  const bf16_t* bp0 = B0 + (size_t)lr * ldb + lc;
  const bf16_t* bp1 = (NB == 2) ? (B1 + (size_t)lr * ldb + lc) : B0;
#pragma unroll
  for (int i = 0; i < 4; ++i) ra[i] = *(const u32x4*)(ap + (size_t)(32 * i) * lda);
#pragma unroll
  for (int i = 0; i < 2 * NI; ++i) {
    rb0[i] = *(const u32x4*)(bp0 + (size_t)(32 * i) * ldb);
    if (NB == 2) rb1[i] = *(const u32x4*)(bp1 + (size_t)(32 * i) * ldb);
  }
  for (int k0 = 0; k0 < K; k0 += 64) {
    __syncthreads();
#pragma unroll
    for (int i = 0; i < 4; ++i) *(u32x4*)(As + (lr + 32 * i) * 72 + lc) = ra[i];
#pragma unroll
    for (int i = 0; i < 2 * NI; ++i) {
      *(u32x4*)(B0s + (lr + 32 * i) * 72 + lc) = rb0[i];
      if (NB == 2) *(u32x4*)(B1s + (lr + 32 * i) * 72 + lc) = rb1[i];
    }
    if (k0 + 64 < K) {
      const int kn = k0 + 64;
#pragma unroll
      for (int i = 0; i < 4; ++i) ra[i] = *(const u32x4*)(ap + (size_t)(32 * i) * lda + kn);
#pragma unroll
      for (int i = 0; i < 2 * NI; ++i) {
        rb0[i] = *(const u32x4*)(bp0 + (size_t)(32 * i) * ldb + kn);
        if (NB == 2) rb1[i] = *(const u32x4*)(bp1 + (size_t)(32 * i) * ldb + kn);
      }
    }
    __syncthreads();
    __builtin_amdgcn_s_setprio(1);
#pragma unroll
    for (int ks = 0; ks < 4; ++ks) {
      bf16x8 af[2], bf0[NI], bf1[NI];
#pragma unroll
      for (int mi = 0; mi < 2; ++mi) af[mi] = *(const bf16x8*)(As + (64 * wm + 32 * mi + l31) * 72 + 16 * ks + 8 * h2);
#pragma unroll
      for (int ni = 0; ni < NI; ++ni) {
        bf0[ni] = *(const bf16x8*)(B0s + (32 * NI * wn + 32 * ni + l31) * 72 + 16 * ks + 8 * h2);
        if (NB == 2) bf1[ni] = *(const bf16x8*)(B1s + (32 * NI * wn + 32 * ni + l31) * 72 + 16 * ks + 8 * h2);
      }
#pragma unroll
      for (int mi = 0; mi < 2; ++mi)
#pragma unroll
        for (int ni = 0; ni < NI; ++ni) {
          acc0[mi][ni] = MFMA32(af[mi], bf0[ni], acc0[mi][ni]);
          if (NB == 2) acc1[mi][ni] = MFMA32(af[mi], bf1[ni], acc1[mi][ni]);
        }
    }
    __builtin_amdgcn_s_setprio(0);
  }
}

template <int NI>
DI void zero_acc(f32x16 (&a)[2][NI]) {
#pragma unroll
  for (int mi = 0; mi < 2; ++mi)
#pragma unroll
    for (int ni = 0; ni < NI; ++ni)
#pragma unroll
      for (int r = 0; r < 16; ++r) a[mi][ni][r] = 0.f;
}

#define EPI_VARS const int tid = threadIdx.x + opq(), lane = tid & 63, w = tid >> 6, wm = w >> 1, wn = w & 1, l31 = lane & 31, h2 = lane >> 5; (void)tid; (void)lane; (void)w
#define EPI_BEGIN(NI_) _Pragma("unroll") for (int mi = 0; mi < 2; ++mi) _Pragma("unroll") for (int ni = 0; ni < NI_; ++ni) _Pragma("unroll") for (int r = 0; r < 16; ++r) { \
    const int row = 64 * wm + 32 * mi + crow(r, h2); const int col = 32 * NI_ * wn + 32 * ni + l31;
#define EPI_END }

DI bool xcd_tile(int iter, int MT, int NT, int& mt, int& nt) {
  const int x = blockIdx.x & 7, lb = blockIdx.x >> 3, nb = gridDim.x >> 3;
  const int full = NT >> 3, rem = NT & 7;
  const int per_full = full * MT, rem_tot = rem * MT;
  const int r0 = (rem_tot * x) >> 3, r1 = (rem_tot * (x + 1)) >> 3;
  const int j = lb + iter * nb;
  if (lb >= nb || j >= per_full + (r1 - r0)) return false;
  if (j < per_full) { mt = j / full; nt = x * full + j % full; }
  else { const int u = r0 + (j - per_full); nt = 8 * full + u / MT; mt = u % MT; }
  return true;
}

DI void phase_ffn_a(const bf16_t* __restrict__ Nb, const bf16_t* __restrict__ W1, const bf16_t* __restrict__ W3,
                            bf16_t* __restrict__ H, char* lds) {
  EPI_VARS;
  for (int iter = 0;; ++iter) {
    int mt, nt;
    if (!xcd_tile(iter, 256, 22, mt, nt)) break;
    f32x16 a0[2][2], a1[2][2];
    zero_acc<2>(a0); zero_acc<2>(a1);
    gemm_main<2, 2>(a0, a1, Nb + (size_t)mt * 128 * 1024, 1024, W1 + (size_t)nt * 128 * 1024, W3 + (size_t)nt * 128 * 1024, 1024, 1024, lds);
    EPI_BEGIN(2)
      H[(size_t)(mt * 128 + row) * 2816 + nt * 128 + col] = f2bf(siluf_(a0[mi][ni][r]) * a1[mi][ni][r]);
    EPI_END
  }
}

DI void phase_gemm_resid(const bf16_t* __restrict__ A, int K, const bf16_t* __restrict__ Bt, const float* xsrc, float* x,
                                 float scale, char* lds) {
  EPI_VARS;
  for (int iter = 0;; ++iter) {
    int mt, nt;
    if (!xcd_tile(iter, 256, 4, mt, nt)) break;
    f32x16 a0[2][4];
    zero_acc<4>(a0);
    gemm_main<4, 1>(a0, a0, A + (size_t)mt * 128 * K, K, Bt + (size_t)nt * 256 * K, nullptr, K, K, lds);
    EPI_BEGIN(4)
      const size_t off = (size_t)(mt * 128 + row) * 1024 + nt * 256 + col;
      x[off] = xsrc[off] + scale * a0[mi][ni][r];
    EPI_END
  }
}

DI void phase_ple(const bf16_t* __restrict__ Nb, const bf16_t* __restrict__ PB, const bf16_t* __restrict__ PG,
                          const bf16_t* __restrict__ PP, float* __restrict__ x, char* lds) {
  EPI_VARS;
  for (int iter = 0;; ++iter) {
    int mt, nt;
    if (!xcd_tile(iter, 256, 8, mt, nt)) break;
    f32x16 a0[2][2], a1[2][2];
    zero_acc<2>(a0); zero_acc<2>(a1);
    gemm_main<2, 1>(a0, a0, Nb + (size_t)mt * 128 * 1024, 1024, PG + (size_t)nt * 128 * 1024, nullptr, 1024, 1024, lds);
    gemm_main<2, 1>(a1, a1, PB + (size_t)mt * 128 * 256, 256, PP + (size_t)nt * 128 * 256, nullptr, 256, 256, lds);
    EPI_BEGIN(2)
      float* xp = x + (size_t)(mt * 128 + row) * 1024 + nt * 128 + col;
      *xp = *xp + sigmoidf_(a0[mi][ni][r]) * a1[mi][ni][r];
    EPI_END
  }
}

DI void phase_merge(const bf16_t* __restrict__ Np, const bf16_t* __restrict__ Y, const bf16_t* __restrict__ WG,
                            const bf16_t* __restrict__ WB, bf16_t* __restrict__ M, char* lds) {
  EPI_VARS;
  for (int iter = 0;; ++iter) {
    int mt, nt;
    if (!xcd_tile(iter, 256, 8, mt, nt)) break;
    f32x16 am[2][2];
    zero_acc<2>(am);
#pragma unroll 1
    for (int n = 0; n < 4; ++n) {
      unsigned sg[2][2][8];
      {
        f32x16 ag[2][2];
        zero_acc<2>(ag);
        gemm_main<2, 1>(ag, ag, Np + (size_t)mt * 128 * 1024, 1024, WG + (size_t)n * 1048576 + (size_t)nt * 128 * 1024, nullptr, 1024, 1024, lds);
#pragma unroll
        for (int mi = 0; mi < 2; ++mi)
#pragma unroll
          for (int ni = 0; ni < 2; ++ni)
#pragma unroll
            for (int r = 0; r < 8; ++r) sg[mi][ni][r] = pack2(sigmoidf_(ag[mi][ni][2 * r]), sigmoidf_(ag[mi][ni][2 * r + 1]));
      }
      f32x16 ab[2][2];
      zero_acc<2>(ab);
      gemm_main<2, 1>(ab, ab, Y + (size_t)mt * 128 * 1024 + n * 256, 1024, WB + (size_t)n * 262144 + (size_t)nt * 128 * 256, nullptr, 256, 256, lds);
#pragma unroll
      for (int mi = 0; mi < 2; ++mi)
#pragma unroll
        for (int ni = 0; ni < 2; ++ni)
#pragma unroll
          for (int r = 0; r < 8; ++r) {
            am[mi][ni][2 * r] += __uint_as_float(sg[mi][ni][r] << 16) * ab[mi][ni][2 * r];
            am[mi][ni][2 * r + 1] += __uint_as_float(sg[mi][ni][r] & 0xffff0000u) * ab[mi][ni][2 * r + 1];
          }
    }
    EPI_BEGIN(2)
      M[(size_t)(mt * 128 + row) * 1024 + nt * 128 + col] = f2bf(am[mi][ni][r]);
    EPI_END
  }
}

DI void rope32_out(const float* c, const float2* tab, float sc, float* o) {
#pragma unroll
  for (int i = 0; i < 16; ++i) {
    const float2 cs = tab[i];
    const float a = c[i], b = c[16 + i];
    o[i] = (a * cs.x - b * cs.y) * sc;
    o[16 + i] = (b * cs.x + a * cs.y) * sc;
  }
}

DI void phase_proj(CParams& p, const bf16_t* __restrict__ Nb, const bf16_t* __restrict__ WIN, int S, char* lds) {
  EPI_VARS;
  bf16_t* PR = (bf16_t*)(p.ws + OFF_PR);
  float* AB = (float*)(p.ws + OFF_AB);
  const float2* t32 = (const float2*)(p.ws + OFF_TAB);
  const float2* t64 = (const float2*)(p.ws + OFF_TAB + 2 * MiB);
  float* Ct = (float*)lds;
  for (int iter = 0;; ++iter) {
    int mt, nt2;
    if (!xcd_tile(iter, 256, 18, mt, nt2)) break;
    f32x16 a0[2][4];
    zero_acc<4>(a0);
    gemm_main<4, 1>(a0, a0, Nb + (size_t)mt * 128 * 1024, 1024, WIN + (size_t)nt2 * 256 * 1024, nullptr, 1024, 1024, lds);
   for (int hv = 0; hv < 2; ++hv) {
    const int nt = 2 * nt2 + hv;
    __syncthreads();
    if (wn == hv) {
#pragma unroll
      for (int mi = 0; mi < 2; ++mi)
#pragma unroll
        for (int ni = 0; ni < 4; ++ni)
#pragma unroll
          for (int r = 0; r < 16; ++r) Ct[(64 * wm + 32 * mi + crow(r, h2)) * 132 + 32 * ni + l31] = a0[mi][ni][r];
    }
    __syncthreads();
    const int erow = tid >> 1, half = tid & 1;
    const int tok = mt * 128 + erow, pos = tok & (S - 1);
    const float* cr = Ct + erow * 132 + 64 * half;
    bf16_t* dst = PR + (size_t)tok * NPR + nt * 128 + 64 * half;
    int type = 0; float sc = 1.f;
    if (nt == 3 || nt == 4) { type = 1; sc = 0.17677669529663687f * LOG2E; }
    else if (nt == 5 || nt == 6) { type = 1; }
    else if (nt >= 17 && nt <= 22) { type = 2; sc = 0.125f * LOG2E; }
    else if (nt >= 23 && nt <= 28) { type = 2; }
    else if (nt == 35) type = 3;
    if (type == 0) {
#pragma unroll
      for (int j = 0; j < 8; ++j) store8bf(dst + 8 * j, cr + 8 * j);
    } else if (type == 1) {
#pragma unroll
      for (int hh = 0; hh < 2; ++hh) {
        float o[32];
        rope32_out(cr + 32 * hh, t32 + (size_t)pos * 16, sc, o);
#pragma unroll
        for (int j = 0; j < 4; ++j) store8bf(dst + 32 * hh + 8 * j, o + 8 * j);
      }
    } else if (type == 2) {
      const float2* tab = t64 + (size_t)pos * 32;
#pragma unroll
      for (int j = 0; j < 4; ++j) {
        float lo[8], hi[8];
#pragma unroll
        for (int e = 0; e < 8; ++e) {
          const float2 cs = tab[8 * j + e];
          const float a = cr[8 * j + e], b = cr[32 + 8 * j + e];
          lo[e] = (a * cs.x - b * cs.y) * sc;
          hi[e] = (b * cs.x + a * cs.y) * sc;
        }
        store8bf(dst + 8 * j, lo);
        store8bf(dst + 32 + 8 * j, hi);
      }
    } else {
      if (half == 0) {
        float o[32];
        rope32_out(cr, t32 + (size_t)pos * 16, 1.f, o);
#pragma unroll
        for (int j = 0; j < 4; ++j) store8bf(dst + 8 * j, o + 8 * j);
      } else {
        const float* c2 = Ct + erow * 132 + 32;
#pragma unroll
        for (int j = 0; j < 4; ++j) {
          float4 v; v.x = c2[4 * j]; v.y = c2[4 * j + 1]; v.z = c2[4 * j + 2]; v.w = c2[4 * j + 3];
          ((float4*)(AB + (size_t)tok * 16))[j] = v;
        }
      }
    }
   }
  }
}

DI void mla_up_tile(CParams& p, int mt, int j, int S, char* lds) {
  EPI_VARS;
  const bf16_t* PR = (const bf16_t*)(p.ws + OFF_PR);
  const bf16_t* wb = (const bf16_t*)(p.ws + OFF_WB);
  bf16_t* Qb = (bf16_t*)(p.ws + OFF_Q);
  bf16_t* Kb = (bf16_t*)(p.ws + OFF_K);
  bf16_t* Vb = (bf16_t*)(p.ws + OFF_V);
  const float2* t32 = (const float2*)(p.ws + OFF_TAB);
  float* Ct = (float*)lds;
  float* rst = (float*)(lds + 67584);
  const bool isq = j < 3;
  const int K = isq ? 256 : 128;
  const int nt = isq ? j : j - 3;
  const bf16_t* A = PR + (size_t)mt * 128 * NPR + (isq ? C_CQ : C_CKV);
  const bf16_t* B = wb + (isq ? W_UQ : W_UKV) + (size_t)nt * 128 * K;
  const int erow = tid >> 1, half = tid & 1;
  {
    const bf16_t* ar = A + (size_t)erow * NPR + half * (K / 2);
    float ss = 0.f;
    for (int c = 0; c < K / 16; ++c) {
      const u32x4 u = *(const u32x4*)(ar + 8 * c);
      const unsigned uu[4] = {u.x, u.y, u.z, u.w};
#pragma unroll
      for (int e = 0; e < 4; ++e) {
        const float lo = __uint_as_float(uu[e] << 16), hi = __uint_as_float(uu[e] & 0xffff0000u);
        ss += lo * lo + hi * hi;
      }
    }
    ss += __shfl_xor(ss, 1);
    if (half == 0) rst[erow] = rsqrtf(ss / (float)K + EPS);
  }
  f32x16 a0[2][2];
  zero_acc<2>(a0);
  gemm_main<2, 1>(a0, a0, A, NPR, B, nullptr, K, K, lds);
  __syncthreads();
  EPI_BEGIN(2)
    Ct[row * 132 + col] = a0[mi][ni][r];
  EPI_END
  __syncthreads();
  const int tok = mt * 128 + erow, pos = tok & (S - 1);
  const float rs = rst[erow];
  const float* cr = Ct + erow * 132 + 64 * half;
  if (isq) {
    const float sc = rs * 0.10206207261596577f * LOG2E;
    if (nt < 2) {
      bf16_t* dst = Qb + ((size_t)tok * 4 + 2 * nt + half) * 96;
#pragma unroll
      for (int jj = 0; jj < 8; ++jj) {
        float o[8];
#pragma unroll
        for (int e = 0; e < 8; ++e) o[e] = cr[8 * jj + e] * sc;
        store8bf(dst + 8 * jj, o);
      }
    } else {
#pragma unroll
      for (int hh = 0; hh < 2; ++hh) {
        float o[32];
        rope32_out(cr + 32 * hh, t32 + (size_t)pos * 16, sc, o);
        bf16_t* dst = Qb + ((size_t)tok * 4 + 2 * half + hh) * 96 + 64;
#pragma unroll
        for (int jj = 0; jj < 4; ++jj) store8bf(dst + 8 * jj, o + 8 * jj);
      }
    }
  } else {
    bf16_t* dst = half == 0 ? (Kb + ((size_t)tok * 4 + nt) * 96) : (Vb + ((size_t)tok * 4 + nt) * 64);
#pragma unroll
    for (int jj = 0; jj < 8; ++jj) {
      float o[8];
#pragma unroll
      for (int e = 0; e < 8; ++e) o[e] = cr[8 * jj + e] * rs;
      store8bf(dst + 8 * jj, o);
    }
    if (half == 0) {
      const u32x4* src = (const u32x4*)(PR + (size_t)tok * NPR + 4480);
#pragma unroll
      for (int jj = 0; jj < 4; ++jj) ((u32x4*)(dst + 64))[jj] = src[jj];
    }
  }
}

typedef short s16x4_t __attribute__((ext_vector_type(4)));
DI bf16x8 tr_pair(const bf16_t* p0, const bf16_t* p1) {
  const s16x4_t lo = __builtin_amdgcn_ds_read_tr16_b64_v4i16((__attribute__((address_space(3))) s16x4_t*)p0);
  const s16x4_t hi = __builtin_amdgcn_ds_read_tr16_b64_v4i16((__attribute__((address_space(3))) s16x4_t*)p1);
  return __builtin_shufflevector(lo, hi, 0, 1, 2, 3, 4, 5, 6, 7);
}

template <int DK, bool BAND>
DI void flash_loop(f32x16 (&O)[2], float& m, float& l, const bf16_t* __restrict__ qrow, const bf16_t* __restrict__ kbase,
                   size_t kstride, const bf16_t* __restrict__ vbase, size_t vstride, int ntiles, int tq, int u0, int L,
                   char* lds) {
  const int tid = threadIdx.x + opq(), lane = tid & 63, l31 = lane & 31, h2 = lane >> 5;
  constexpr int KR = DK + 8, KCH = DK / 8, KN = 64 * KCH / 256;
  constexpr int STAGE = 64 * KR * 2 + 64 * 72 * 2;
  bf16x8 qf[DK / 16];
#pragma unroll
  for (int ks = 0; ks < DK / 16; ++ks) qf[ks] = *(const bf16x8*)(qrow + 16 * ks + 8 * h2);
  u32x4 rkA[KN], rvA[2], rkB[KN], rvB[2];
  auto gload = [&](int kt, u32x4 (&rk)[KN], u32x4 (&rv)[2]) {
#pragma unroll
    for (int i = 0; i < KN; ++i) {
      const int ci = tid + 256 * i, row = ci / KCH, c = ci % KCH;
      int rr = u0 + 64 * kt + row;
      if (BAND) rr = min(max(rr, 0), L - 1);
      rk[i] = *(const u32x4*)(kbase + (size_t)rr * kstride + c * 8);
    }
#pragma unroll
    for (int i = 0; i < 2; ++i) {
      const int ci = tid + 256 * i, row = ci >> 3, c = ci & 7;
      int rr = u0 + 64 * kt + row;
      if (BAND) rr = min(max(rr, 0), L - 1);
      rv[i] = *(const u32x4*)(vbase + (size_t)rr * vstride + c * 8);
    }
  };
  auto swrite = [&](int st, const u32x4 (&rk)[KN], const u32x4 (&rv)[2]) {
    bf16_t* Ks = (bf16_t*)(lds + st * STAGE);
    bf16_t* Vs = Ks + 64 * KR;
#pragma unroll
    for (int i = 0; i < KN; ++i) {
      const int ci = tid + 256 * i, row = ci / KCH, c = ci % KCH;
      *(u32x4*)(Ks + row * KR + c * 8) = rk[i];
    }
#pragma unroll
    for (int i = 0; i < 2; ++i) {
      const int ci = tid + 256 * i, row = ci >> 3, c = ci & 7;
      *(u32x4*)(Vs + row * 72 + c * 8) = rv[i];
    }
  };
  const int trq = (lane & 15) >> 2, trp = lane & 3, trblk = (lane >> 4) & 1;
  const int troff = (4 * h2 + trq) * 72 + 16 * trblk + 4 * trp;
  __syncthreads();
  gload(0, rkA, rvA);
  swrite(0, rkA, rvA);
  gload(1, rkA, rvA);
  if (ntiles > 2) gload(2, rkB, rvB);
  for (int kt2 = 0; kt2 < ntiles; kt2 += 2)
#pragma unroll
  for (int par = 0; par < 2; ++par) {
    const int kt = kt2 + par;
    __syncthreads();
    if (par == 0) {
      if (kt + 1 < ntiles) swrite((kt + 1) & 1, rkA, rvA);
      if (kt + 3 < ntiles) gload(kt + 3, rkA, rvA);
    } else {
      if (kt + 1 < ntiles) swrite((kt + 1) & 1, rkB, rvB);
      if (kt + 3 < ntiles) gload(kt + 3, rkB, rvB);
    }
    const bf16_t* Ks = (const bf16_t*)(lds + (kt & 1) * STAGE);
    const bf16_t* Vs = Ks + 64 * KR;
    f32x16 Sx[2];
#pragma unroll
    for (int j = 0; j < 2; ++j)
#pragma unroll
      for (int r = 0; r < 16; ++r) Sx[j][r] = 0.f;
#pragma unroll
    for (int ks = 0; ks < DK / 16; ++ks)
#pragma unroll
      for (int j = 0; j < 2; ++j) {
        const bf16x8 kf = *(const bf16x8*)(Ks + (32 * j + l31) * KR + 16 * ks + 8 * h2);
        Sx[j] = MFMA32(kf, qf[ks], Sx[j]);
      }
    if (BAND) {
#pragma unroll
      for (int j = 0; j < 2; ++j)
#pragma unroll
        for (int r = 0; r < 16; ++r) {
          const int u = u0 + 64 * kt + 32 * j + crow(r, h2);
          const int d = u - tq;
          const bool valid = (d <= 64) && (d >= -64) && (u >= 0) && (u < L);
          Sx[j][r] = valid ? Sx[j][r] : -1e30f;
        }
    }
    float mx = Sx[0][0];
#pragma unroll
    for (int j = 0; j < 2; ++j)
#pragma unroll
      for (int r = 0; r < 16; ++r) mx = fmaxf(mx, Sx[j][r]);
    mx = xhalf_max(mx);
    const float mn = fmaxf(m, mx);
    const float alpha = exp2_(m - mn);
    const bool grew = mn > m;
    m = mn;
    float ls = 0.f;
#pragma unroll
    for (int j = 0; j < 2; ++j)
#pragma unroll
      for (int r = 0; r < 16; ++r) { const float pv = exp2_(Sx[j][r] - mn); Sx[j][r] = pv; ls += pv; }
    l = l * alpha + ls;
    if (__any(grew)) {
#pragma unroll
      for (int t = 0; t < 2; ++t)
#pragma unroll
        for (int r = 0; r < 16; ++r) O[t][r] *= alpha;
    }
#pragma unroll
    for (int j = 0; j < 2; ++j)
#pragma unroll
      for (int s = 0; s < 2; ++s) {
        const bf16x8 pf = pack8(Sx[j][8 * s], Sx[j][8 * s + 1], Sx[j][8 * s + 2], Sx[j][8 * s + 3], Sx[j][8 * s + 4],
                                Sx[j][8 * s + 5], Sx[j][8 * s + 6], Sx[j][8 * s + 7]);
#pragma unroll
        for (int t = 0; t < 2; ++t) {
          const bf16_t* vp = Vs + (32 * j + 16 * s) * 72 + 32 * t + troff;
          const bf16x8 vf = tr_pair(vp, vp + 8 * 72);
          O[t] = MFMA32(vf, pf, O[t]);
        }
      }
  }
}

DI void flash_loop_diff(f32x16 (&O0)[2], f32x16 (&O1)[2], float& m0, float& l0, float& m1, float& l1,
                        const bf16_t* __restrict__ qrow, const bf16_t* __restrict__ kbase, size_t kstride,
                        const bf16_t* __restrict__ vbase, size_t vstride, int ntiles, char* lds) {
  const int tid = threadIdx.x + opq(), lane = tid & 63, l31 = lane & 31, h2 = lane >> 5;
  constexpr int KR = 72;
  constexpr int STAGE = 64 * KR * 2 + 64 * 72 * 2;
  bf16x8 qf0[2], qf1[2];
#pragma unroll
  for (int ks = 0; ks < 2; ++ks) {
    qf0[ks] = *(const bf16x8*)(qrow + 16 * ks + 8 * h2);
    qf1[ks] = *(const bf16x8*)(qrow + 32 + 16 * ks + 8 * h2);
  }
  u32x4 rk[2], rv[2];
  auto gload = [&](int kt) {
#pragma unroll
    for (int i = 0; i < 2; ++i) {
      const int ci = tid + 256 * i, row = ci >> 3, c = ci & 7;
      const int rr = 64 * kt + row;
      rk[i] = *(const u32x4*)(kbase + (size_t)rr * kstride + c * 8);
      rv[i] = *(const u32x4*)(vbase + (size_t)rr * vstride + c * 8);
    }
  };
  auto swrite = [&](int st) {
    bf16_t* Ks = (bf16_t*)(lds + st * STAGE);
    bf16_t* Vs = Ks + 64 * KR;
#pragma unroll
    for (int i = 0; i < 2; ++i) {
      const int ci = tid + 256 * i, row = ci >> 3, c = ci & 7;
      *(u32x4*)(Ks + row * KR + c * 8) = rk[i];
      *(u32x4*)(Vs + row * 72 + c * 8) = rv[i];
    }
  };
  const int trq = (lane & 15) >> 2, trp = lane & 3, trblk = (lane >> 4) & 1;
  const int troff = (4 * h2 + trq) * 72 + 16 * trblk + 4 * trp;
  __syncthreads();
  gload(0);
  swrite(0);
  if (ntiles > 1) gload(1);
  for (int kt = 0; kt < ntiles; ++kt) {
    __syncthreads();
    if (kt + 1 < ntiles) swrite((kt + 1) & 1);
    if (kt + 2 < ntiles) gload(kt + 2);
    const bf16_t* Ks = (const bf16_t*)(lds + (kt & 1) * STAGE);
    const bf16_t* Vs = Ks + 64 * KR;
    bf16x8 pf[2][2][2];
#pragma unroll
    for (int mp = 0; mp < 2; ++mp) {
      f32x16 Sx[2];
#pragma unroll
      for (int j = 0; j < 2; ++j)
#pragma unroll
        for (int r = 0; r < 16; ++r) Sx[j][r] = 0.f;
#pragma unroll
      for (int ks = 0; ks < 2; ++ks)
#pragma unroll
        for (int j = 0; j < 2; ++j) {
          const bf16x8 kf = *(const bf16x8*)(Ks + (32 * j + l31) * KR + 32 * mp + 16 * ks + 8 * h2);
          Sx[j] = MFMA32(kf, mp == 0 ? qf0[ks] : qf1[ks], Sx[j]);
        }
      float& m = mp == 0 ? m0 : m1;
      float& l = mp == 0 ? l0 : l1;
      float mx = Sx[0][0];
#pragma unroll
      for (int j = 0; j < 2; ++j)
#pragma unroll
        for (int r = 0; r < 16; ++r) mx = fmaxf(mx, Sx[j][r]);
      mx = xhalf_max(mx);
      const float mn = fmaxf(m, mx);
      const float alpha = exp2_(m - mn);
      const bool grew = mn > m;
      m = mn;
      float ls = 0.f;
#pragma unroll
      for (int j = 0; j < 2; ++j)
#pragma unroll
        for (int r = 0; r < 16; ++r) { const float pv = exp2_(Sx[j][r] - mn); Sx[j][r] = pv; ls += pv; }
      l = l * alpha + ls;
      if (__any(grew)) {
#pragma unroll
        for (int t = 0; t < 2; ++t)
#pragma unroll
          for (int r = 0; r < 16; ++r) { if (mp == 0) O0[t][r] *= alpha; else O1[t][r] *= alpha; }
      }
#pragma unroll
      for (int j = 0; j < 2; ++j)
#pragma unroll
        for (int s = 0; s < 2; ++s)
          pf[mp][j][s] = pack8(Sx[j][8 * s], Sx[j][8 * s + 1], Sx[j][8 * s + 2], Sx[j][8 * s + 3], Sx[j][8 * s + 4],
                               Sx[j][8 * s + 5], Sx[j][8 * s + 6], Sx[j][8 * s + 7]);
    }
#pragma unroll
    for (int j = 0; j < 2; ++j)
#pragma unroll
      for (int s = 0; s < 2; ++s)
#pragma unroll
        for (int t = 0; t < 2; ++t) {
          const bf16_t* vp = Vs + (32 * j + 16 * s) * 72 + 32 * t + troff;
          const bf16x8 vf = tr_pair(vp, vp + 8 * 72);
          O0[t] = MFMA32(vf, pf[0][j][s], O0[t]);
          O1[t] = MFMA32(vf, pf[1][j][s], O1[t]);
        }
  }
}

DI void zeroO(f32x16 (&O)[2]) {
#pragma unroll
  for (int t = 0; t < 2; ++t)
#pragma unroll
    for (int r = 0; r < 16; ++r) O[t][r] = 0.f;
}

DI void store_o(bf16_t* dst, const f32x16 (&O)[2], int h2) {
#pragma unroll
  for (int t = 0; t < 2; ++t)
#pragma unroll
    for (int g = 0; g < 4; ++g) {
      u32x2 u; u.x = pack2(O[t][4 * g], O[t][4 * g + 1]); u.y = pack2(O[t][4 * g + 2], O[t][4 * g + 3]);
      *(u32x2*)(dst + 32 * t + 8 * g + 4 * h2) = u;
    }
}

DI void mla_item(CParams& p, int it, int S, char* lds) {
  const int tid = threadIdx.x + opq(), lane = tid & 63, w = tid >> 6, l31 = lane & 31, h2 = lane >> 5;
  const int lgq = (S == 2048) ? 4 : 7;
  const int qb = it & ((1 << lgq) - 1), bh = it >> lgq, h = bh & 3, b = bh >> 2;
  const int tokbase = b * S, gtok = tokbase + 128 * qb + 32 * w + l31;
  const bf16_t* Qb = (const bf16_t*)(p.ws + OFF_Q);
  const bf16_t* Kb = (const bf16_t*)(p.ws + OFF_K);
  const bf16_t* Vb = (const bf16_t*)(p.ws + OFF_V);
  bf16_t* Y = (bf16_t*)(p.ws + OFF_N);
  f32x16 O[2]; zeroO(O);
  float m = -1e30f, l = 0.f;
  flash_loop<96, false>(O, m, l, Qb + ((size_t)gtok * 4 + h) * 96, Kb + ((size_t)tokbase * 4 + h) * 96, 384,
                        Vb + ((size_t)tokbase * 4 + h) * 64, 256, S / 64, 0, 0, 0, lds);
  l += __shfl_xor(l, 32);
  const float il = 1.f / l;
#pragma unroll
  for (int t = 0; t < 2; ++t)
#pragma unroll
    for (int r = 0; r < 16; ++r) O[t][r] *= il;
  store_o(Y + (size_t)gtok * 1024 + h * 64, O, h2);
}

DI void diff_item(CParams& p, int layer, int it, int S, char* lds) {
  const int tid = threadIdx.x + opq(), lane = tid & 63, w = tid >> 6, l31 = lane & 31, h2 = lane >> 5;
  const int lgq = (S == 2048) ? 4 : 7;
  const int qb = it & ((1 << lgq) - 1), bh = it >> lgq, h = bh & 3, b = bh >> 2;
  const int tokbase = b * S, gtok = tokbase + 128 * qb + 32 * w + l31;
  const bf16_t* PR = (const bf16_t*)(p.ws + OFF_PR);
  bf16_t* Y = (bf16_t*)(p.ws + OFF_N);
  const float* lam = p.diff_lambda + layer * 128;
  float s1 = 0.f, s2 = 0.f;
  if (lane < 32) { s1 = lam[lane] * lam[32 + lane]; s2 = lam[64 + lane] * lam[96 + lane]; }
  s1 = wave_sum(s1); s2 = wave_sum(s2);
  const float lambda_init = layer ? 0.35550907f : 0.2f;
  const float lambda_full = expf(s1) - expf(s2) + lambda_init;
  f32x16 of[2], O1[2];
  zeroO(of); zeroO(O1);
  {
    float m0 = -1e30f, l0 = 0.f, m1 = -1e30f, l1 = 0.f;
    flash_loop_diff(of, O1, m0, l0, m1, l1, PR + (size_t)gtok * NPR + C_BQ + (2 * h) * 32,
                    PR + (size_t)tokbase * NPR + C_BK + (2 * h) * 32, NPR, PR + (size_t)tokbase * NPR + C_BV + h * 64, NPR,
                    S / 64, lds);
    l0 += __shfl_xor(l0, 32);
    l1 += __shfl_xor(l1, 32);
    const float c0 = 1.f / l0, c1 = -lambda_full / l1;
#pragma unroll
    for (int t = 0; t < 2; ++t)
#pragma unroll
      for (int r = 0; r < 16; ++r) of[t][r] = c0 * of[t][r] + c1 * O1[t][r];
  }
  float ss = 0.f;
#pragma unroll
  for (int t = 0; t < 2; ++t)
#pragma unroll
    for (int r = 0; r < 16; ++r) ss += of[t][r] * of[t][r];
  ss += __shfl_xor(ss, 32);
  const float rs = rsqrtf(ss * (1.f / 64.f) + EPS) * (1.f - lambda_init);
  const float* sg = p.diff_subln + layer * 64;
#pragma unroll
  for (int t = 0; t < 2; ++t)
#pragma unroll
    for (int r = 0; r < 16; ++r) of[t][r] *= rs * sg[32 * t + crow(r, h2)];
  store_o(Y + (size_t)gtok * 1024 + 256 + h * 64, of, h2);
}

DI void dil_item(CParams& p, int it, int S, int B, char* lds) {
  const int tid = threadIdx.x + opq(), lane = tid & 63, w = tid >> 6, l31 = lane & 31, h2 = lane >> 5;
  const int lgS = (S == 2048) ? 11 : 14, lgB = (B == 16) ? 4 : 1;
  const int rq = it & ((1 << (lgS - 7)) - 1);
  int rest = it >> (lgS - 7);
  const int head = rest & 3; rest >>= 2;
  const int b = rest & (B - 1), g = rest >> lgB;
  const int lgd = 2 * g, dil = 1 << lgd;
  const int L = S >> lgd, lgnqb = lgS - lgd - 7;
  const int res = rq >> lgnqb, qb = rq & ((1 << lgnqb) - 1);
  const int tokbase = b * S;
  const int tq = 128 * qb + 32 * w + l31;
  const int gtok = tokbase + tq * dil + res;
  const bf16_t* PR = (const bf16_t*)(p.ws + OFF_PR);
  bf16_t* OD = (bf16_t*)(p.ws + OFF_OD);
  float* LSE = (float*)(p.ws + OFF_LSE);
  f32x16 O[2]; zeroO(O);
  float m = -1e30f, l = 0.f;
  const int hc = (g * 4 + head) * 64;
  flash_loop<64, true>(O, m, l, PR + (size_t)gtok * NPR + C_DQ + hc, PR + (size_t)(tokbase + res) * NPR + C_DK + hc,
                       (size_t)dil * NPR, PR + (size_t)(tokbase + res) * NPR + C_DV + hc, (size_t)dil * NPR, 4, tq,
                       128 * qb - 64, L, lds);
  l += __shfl_xor(l, 32);
  const float il = 1.f / l;
#pragma unroll
  for (int t = 0; t < 2; ++t)
#pragma unroll
    for (int r = 0; r < 16; ++r) O[t][r] *= il;
  store_o(OD + ((size_t)g * TG + gtok) * 256 + head * 64, O, h2);
  if (h2 == 0) LSE[((size_t)g * TG + gtok) * 4 + head] = m + __log2f(l);
}

constexpr size_t OFF_X2 = 564 * MiB, WS_BIG = 597 * MiB;
#define DN_QK_OFF (p.big_ws ? OFF_X2 : OFF_OD)
#define DN_GC_OFF ((p.big_ws ? OFF_X2 : OFF_OD) + 32 * MiB)
constexpr size_t DN_UW_OFF = OFF_Q;

DI void dn_prep_item(CParams& p, int layer, int it, int S, char* lds) {
  const int tid = threadIdx.x + opq(), lane = tid & 63, w = tid >> 6, l15 = lane & 15, g4 = lane >> 4;
  const int NC = S / 64;
  const int ch = it % NC, bh = it / NC, h = bh & 3, b = bh >> 2;
  const int tokbase = b * S, s0 = ch * 64;
  const bf16_t* PR = (const bf16_t*)(p.ws + OFF_PR);
  const float* AB = (const float*)(p.ws + OFF_AB);
  bf16_t* QKg = (bf16_t*)(p.ws + DN_QK_OFF) + ((size_t)bh * NC + ch) * 8192;
  bf16_t* raw = (bf16_t*)lds;
  float* convw = (float*)(lds + 27200);
  float* RU = (float*)lds;
  float* RW = (float*)(lds + 16384);
  float* Am = (float*)(lds + 32768);
  bf16_t* Kimg = (bf16_t*)(lds + 50176);
  bf16_t* Qimg = (bf16_t*)(lds + 59392);
  float* gcs = (float*)(lds + 68608);
  float* betas = gcs + 128;
  const float* cw = p.dn_conv + (size_t)layer * 5 * 768;
  {
    u32x4 rawreg[7];
    float cwr[4];
#pragma unroll
    for (int k = 0; k < 7; ++k) {
      const int ci = tid + 256 * k;
      const int rr = ci / 24, c = ci % 24, seg = c >> 3, c8 = c & 7;
      const int s = s0 + rr - 2;
      rawreg[k] = u32x4{0u, 0u, 0u, 0u};
      if (ci < 68 * 24 && s >= 0 && s < S)
        rawreg[k] = *(const u32x4*)(PR + (size_t)(tokbase + s) * NPR + C_DNQKV + seg * 256 + h * 64 + c8 * 8);
    }
#pragma unroll
    for (int k = 0; k < 4; ++k) {
      const int i = tid + 256 * k;
      cwr[k] = 0.f;
      if (i < 960) { const int j = i / 192, c = i % 192; cwr[k] = cw[j * 768 + (c >> 6) * 256 + h * 64 + (c & 63)]; }
    }
#pragma unroll
    for (int k = 0; k < 7; ++k) {
      const int ci = tid + 256 * k;
      const int rr = ci / 24, c = ci % 24, seg = c >> 3, c8 = c & 7;
      if (ci < 68 * 24) *(u32x4*)(raw + rr * 200 + seg * 64 + c8 * 8) = rawreg[k];
    }
#pragma unroll
    for (int k = 0; k < 4; ++k) { const int i = tid + 256 * k; if (i < 960) convw[i] = cwr[k]; }
  }
  if (tid < 128) {
    const int d = tid >> 6, pl = tid & 63;
    const int i = d ? 63 - pl : pl;
    const size_t tok = (size_t)tokbase + s0 + i;
    const float Aexp = expf(p.dn_a_log[layer * 8 + d * 4 + h]);
    const float a = AB[tok * 16 + d * 8 + h] + p.dn_dt_bias[layer * 8 + d * 4 + h];
    const float bb = AB[tok * 16 + d * 8 + 4 + h];
    const float sp = fmaxf(a, 0.f) + __logf(1.f + __expf(-fabsf(a)));
    float g = -Aexp * sp;
#pragma unroll
    for (int o = 1; o < 64; o <<= 1) { const float tv = __shfl_up(g, o); if (lane >= o) g += tv; }
    gcs[tid] = g;
    betas[tid] = sigmoidf_(bb);
    float* GC = (float*)(p.ws + DN_GC_OFF) + (((size_t)bh * 2 + d) * NC + ch) * 64;
    GC[pl] = g;
  }
  __syncthreads();
  const int pp = tid >> 2, cgp = tid & 3;
  float kv[16], vv[16];
  {
    float qv[16];
#pragma unroll
    for (int seg = 0; seg < 3; ++seg) {
      float acc[16];
#pragma unroll
      for (int c = 0; c < 16; ++c) acc[c] = 0.f;
#pragma unroll
      for (int j = 0; j < 5; ++j) {
        const bf16_t* rp = raw + (pp + j) * 200 + seg * 64 + 16 * cgp;
        const float* wp = convw + j * 192 + seg * 64 + 16 * cgp;
        const u32x4 u0 = *(const u32x4*)rp, u1 = *(const u32x4*)(rp + 8);
        const unsigned uu[8] = {u0.x, u0.y, u0.z, u0.w, u1.x, u1.y, u1.z, u1.w};
#pragma unroll
        for (int e = 0; e < 8; ++e) {
          acc[2 * e] += wp[2 * e] * __uint_as_float(uu[e] << 16);
          acc[2 * e + 1] += wp[2 * e + 1] * __uint_as_float(uu[e] & 0xffff0000u);
        }
      }
#pragma unroll
      for (int c = 0; c < 16; ++c) {
        const float sv = acc[c] * __builtin_amdgcn_rcpf(1.f + __expf(-acc[c]));
        if (seg == 0) qv[c] = sv; else if (seg == 1) kv[c] = sv; else vv[c] = sv;
      }
    }
    float sq = 0.f, sk = 0.f;
#pragma unroll
    for (int c = 0; c < 16; ++c) { sq += qv[c] * qv[c]; sk += kv[c] * kv[c]; }
    sq += __shfl_xor(sq, 1); sq += __shfl_xor(sq, 2);
    sk += __shfl_xor(sk, 1); sk += __shfl_xor(sk, 2);
    const float rq = rsqrtf(sq + EPS) * 0.125f, rk = rsqrtf(sk + EPS);
#pragma unroll
    for (int c = 0; c < 16; ++c) { qv[c] *= rq; kv[c] *= rk; }
    store8bf(Kimg + pp * 72 + 16 * cgp, kv); store8bf(Kimg + pp * 72 + 16 * cgp + 8, kv + 8);
    store8bf(Qimg + pp * 72 + 16 * cgp, qv); store8bf(Qimg + pp * 72 + 16 * cgp + 8, qv + 8);
    store8bf(QKg + pp * 64 + 16 * cgp, qv); store8bf(QKg + pp * 64 + 16 * cgp + 8, qv + 8);
    store8bf(QKg + 4096 + pp * 64 + 16 * cgp, kv); store8bf(QKg + 4096 + pp * 64 + 16 * cgp + 8, kv + 8);
  }
  for (int d = 0; d < 2; ++d) {
    __syncthreads();
    {
      const int pl = d ? 63 - pp : pp;
      const float bet = betas[d * 64 + pl], egc = __expf(gcs[d * 64 + pl]);
#pragma unroll
      for (int c = 0; c < 16; ++c) {
        RU[pl * 64 + 16 * cgp + c] = vv[c] * bet;
        RW[pl * 64 + 16 * cgp + c] = kv[c] * bet * egc;
      }
    }
    {
      f32x4 KK[4];
#pragma unroll
      for (int t = 0; t < 4; ++t) KK[t] = f32x4{0.f, 0.f, 0.f, 0.f};
      const int jl = 16 * w + l15;
      const int jrow = d ? 63 - jl : jl;
#pragma unroll
      for (int ks = 0; ks < 2; ++ks) {
        const bf16x8 bfk = *(const bf16x8*)(Kimg + jrow * 72 + 32 * ks + 8 * g4);
#pragma unroll
        for (int rt = 0; rt < 4; ++rt) {
          const int il = 16 * rt + l15;
          const int irow = d ? 63 - il : il;
          const bf16x8 afk = *(const bf16x8*)(Kimg + irow * 72 + 32 * ks + 8 * g4);
          KK[rt] = MFMA16(afk, bfk, KK[rt]);
        }
      }
      const float gcj = gcs[d * 64 + jl];
#pragma unroll
      for (int rt = 0; rt < 4; ++rt)
#pragma unroll
        for (int r = 0; r < 4; ++r) {
          const int i = 16 * rt + 4 * g4 + r;
          const float ee = __expf(fminf(gcs[d * 64 + i] - gcj, 0.f));
          Am[i * 68 + jl] = (i > jl) ? betas[d * 64 + i] * KK[rt][r] * ee : 0.f;
        }
    }
    __syncthreads();
    float xs[32];
#pragma unroll
    for (int q = 0; q < 32; ++q) xs[q] = 0.f;
    const int c = tid >> 1, half = tid & 1;
    {
      const float* Rc = (c < 64) ? (RU + c) : (RW + (c - 64));
      const float* Ah = Am + 4 * half;
#pragma unroll
      for (int i = 0; i < 64; ++i) {
        float part = 0.f;
#pragma unroll
        for (int q = 0; q < (i + 7) / 8; ++q) {
          const f32x4 a = *(const f32x4*)(Ah + i * 68 + 8 * q);
          part += a[0] * xs[4 * q] + a[1] * xs[4 * q + 1] + a[2] * xs[4 * q + 2] + a[3] * xs[4 * q + 3];
        }
        const float other = __int_as_float(__builtin_amdgcn_update_dpp(0, __float_as_int(part), 0xB1, 0xf, 0xf, true));
        const float xi = Rc[i * 64] - (part + other);
        const int loc = ((i >> 3) << 2) + (i & 3);
        if (((i >> 2) & 1) == 0) xs[loc] = (half == 0) ? xi : xs[loc];
        else xs[loc] = (half == 1) ? xi : xs[loc];
        if (i < 16 ? ((i & 7) == 7) : (i < 32 ? ((i & 3) == 3) : ((i & 1) == 1))) asm volatile("" ::: "memory");
      }
    }
    {
      bf16_t* UWg = (bf16_t*)(p.ws + DN_UW_OFF) + ((((size_t)bh * 2 + d) * NC + ch) * 8192);
      const float sgn = (c < 64) ? 1.f : -1.f;
      bf16_t* dst = UWg + ((c < 64) ? c : (4096 + c - 64));
#pragma unroll
      for (int loc = 0; loc < 32; ++loc) {
        const int i = (((loc >> 2) * 2 + half) << 2) + (loc & 3);
        dst[i * 64] = f2bf(sgn * xs[loc]);
      }
    }
  }
}

DI void dn_scan_chain(CParams& p, int it, int S, char* lds) {
  __builtin_amdgcn_s_setprio(3);
  const int tid0 = threadIdx.x + opq();
  const int dir = it & 1, bh = it >> 1, h = bh & 3, b = bh >> 2;
  const int tokbase = b * S, NC = S / 64;
  bf16_t* OUT = (bf16_t*)(p.ws + (dir ? OFF_OB : OFF_OF));
  const bf16_t* QKg = (const bf16_t*)(p.ws + DN_QK_OFF) + (size_t)bh * NC * 8192;
  const bf16_t* UWg = (const bf16_t*)(p.ws + DN_UW_OFF) + (size_t)it * NC * 8192;
  const float* GCg = (const float*)(p.ws + DN_GC_OFF) + (size_t)it * NC * 64;
  bf16_t* Uimg = (bf16_t*)lds;
  bf16_t* Wn = Uimg + 4608;
  bf16_t* Qimg = Wn + 4608;
  bf16_t* Kimg = Qimg + 4608;
  bf16_t* Kt = Kimg + 4608;
  bf16_t* Iimg = Kt + 4608;
  float* gcs = (float*)(lds + 6 * 9216);
  f32x4 Sd[4];
#pragma unroll
  for (int t = 0; t < 4; ++t) Sd[t] = f32x4{0.f, 0.f, 0.f, 0.f};
  u32x4 ru[2], rw[2], rq[2], rk[2];
  float rg = 0.f;
  auto prefetch = [&](int cc_) {
    const int ch_ = dir ? (NC - 1 - cc_) : cc_;
    const int tp = tid0 + opq();
    const bf16_t* uw = UWg + (size_t)ch_ * 8192;
    const bf16_t* qk = QKg + (size_t)ch_ * 8192;
#pragma unroll
    for (int k = 0; k < 2; ++k) {
      const int ci = tp + 256 * k, row = ci >> 3, c8 = ci & 7;
      const int srow = dir ? 63 - row : row;
      ru[k] = *(const u32x4*)(uw + row * 64 + c8 * 8);
      rw[k] = *(const u32x4*)(uw + 4096 + row * 64 + c8 * 8);
      rq[k] = *(const u32x4*)(qk + srow * 64 + c8 * 8);
      rk[k] = *(const u32x4*)(qk + 4096 + srow * 64 + c8 * 8);
    }
    if (tp < 64) rg = GCg[(size_t)ch_ * 64 + tp];
  };
  prefetch(0);
  for (int cc = 0; cc < NC; ++cc) {
    const int tid = tid0 + opq(), lane = tid & 63, w = tid >> 6, l15 = lane & 15, g4 = lane >> 4;
    const int e_col = 16 * w + l15;
    const int ch = dir ? (NC - 1 - cc) : cc;
    const int s0 = ch * 64;
    __syncthreads();
#pragma unroll
    for (int k = 0; k < 2; ++k) {
      const int ci = tid + 256 * k, row = ci >> 3, c8 = ci & 7;
      *(u32x4*)(Uimg + row * 72 + c8 * 8) = ru[k];
      *(u32x4*)(Wn + row * 72 + c8 * 8) = rw[k];
      *(u32x4*)(Qimg + row * 72 + c8 * 8) = rq[k];
      *(u32x4*)(Kimg + row * 72 + c8 * 8) = rk[k];
      const unsigned uu[4] = {rk[k].x, rk[k].y, rk[k].z, rk[k].w};
#pragma unroll
      for (int e = 0; e < 4; ++e) {
        Kt[(8 * c8 + 2 * e) * 72 + row] = (bf16_t)(uu[e] & 0xffffu);
        Kt[(8 * c8 + 2 * e + 1) * 72 + row] = (bf16_t)(uu[e] >> 16);
      }
    }
    if (tid < 64) gcs[tid] = rg;
    if (cc + 1 < NC) prefetch(cc + 1);
    __syncthreads();
    {
      f32x4 QK[4];
#pragma unroll
      for (int t = 0; t < 4; ++t) QK[t] = f32x4{0.f, 0.f, 0.f, 0.f};
#pragma unroll
      for (int ks = 0; ks < 2; ++ks) {
        const bf16x8 bfk = *(const bf16x8*)(Kimg + (16 * w + l15) * 72 + 32 * ks + 8 * g4);
#pragma unroll
        for (int rt = 0; rt < 4; ++rt) {
          const bf16x8 afq = *(const bf16x8*)(Qimg + (16 * rt + l15) * 72 + 32 * ks + 8 * g4);
          QK[rt] = MFMA16(afq, bfk, QK[rt]);
        }
      }
      const float gcj = gcs[e_col];
#pragma unroll
      for (int rt = 0; rt < 4; ++rt)
#pragma unroll
        for (int r = 0; r < 4; ++r) {
          const int i = 16 * rt + 4 * g4 + r;
          const float ee = __expf(fminf(gcs[i] - gcj, 0.f));
          Iimg[i * 72 + e_col] = f2bf((i >= e_col) ? QK[rt][r] * ee : 0.f);
        }
    }
    __syncthreads();
    {
      bf16x8 Bs[2];
#pragma unroll
      for (int ks = 0; ks < 2; ++ks)
        Bs[ks] = pack8(Sd[2 * ks][0], Sd[2 * ks][1], Sd[2 * ks][2], Sd[2 * ks][3], Sd[2 * ks + 1][0], Sd[2 * ks + 1][1],
                       Sd[2 * ks + 1][2], Sd[2 * ks + 1][3]);
      f32x4 vn[4], qs[4], iv[4];
#pragma unroll
      for (int rt = 0; rt < 4; ++rt) {
#pragma unroll
        for (int r = 0; r < 4; ++r) vn[rt][r] = bf2f(Uimg[(16 * rt + 4 * g4 + r) * 72 + e_col]);
        qs[rt] = f32x4{0.f, 0.f, 0.f, 0.f};
        iv[rt] = f32x4{0.f, 0.f, 0.f, 0.f};
#pragma unroll
        for (int ks = 0; ks < 2; ++ks) {
          const bf16_t* wp = Wn + (16 * rt + l15) * 72 + 32 * ks + 4 * g4;
          const bf16_t* qp = Qimg + (16 * rt + l15) * 72 + 32 * ks + 4 * g4;
          vn[rt] = MFMA16(ld2x4(wp, wp + 16), Bs[ks], vn[rt]);
          qs[rt] = MFMA16(ld2x4(qp, qp + 16), Bs[ks], qs[rt]);
        }
      }
      bf16x8 Bv[2];
#pragma unroll
      for (int ks = 0; ks < 2; ++ks)
        Bv[ks] = pack8(vn[2 * ks][0], vn[2 * ks][1], vn[2 * ks][2], vn[2 * ks][3], vn[2 * ks + 1][0], vn[2 * ks + 1][1],
                       vn[2 * ks + 1][2], vn[2 * ks + 1][3]);
#pragma unroll
      for (int rt = 0; rt < 4; ++rt)
#pragma unroll
        for (int ks = 0; ks < 2; ++ks) {
          const bf16_t* ip = Iimg + (16 * rt + l15) * 72 + 32 * ks + 4 * g4;
          iv[rt] = MFMA16(ld2x4(ip, ip + 16), Bv[ks], iv[rt]);
        }
      const float gc63 = gcs[63];
#pragma unroll
      for (int rt = 0; rt < 4; ++rt)
#pragma unroll
        for (int r = 0; r < 4; ++r) {
          const int pos = 16 * rt + 4 * g4 + r;
          const float o = qs[rt][r] * __expf(gcs[pos]) + iv[rt][r];
          const int i = dir ? 63 - pos : pos;
          OUT[((size_t)tokbase + s0 + i) * 256 + h * 64 + e_col] = f2bf(o);
          vn[rt][r] *= __expf(gc63 - gcs[pos]);
        }
      bf16x8 Bv2[2];
#pragma unroll
      for (int ks = 0; ks < 2; ++ks)
        Bv2[ks] = pack8(vn[2 * ks][0], vn[2 * ks][1], vn[2 * ks][2], vn[2 * ks][3], vn[2 * ks + 1][0], vn[2 * ks + 1][1],
                        vn[2 * ks + 1][2], vn[2 * ks + 1][3]);
      const float gl = __expf(gc63);
#pragma unroll
      for (int dt = 0; dt < 4; ++dt) {
#pragma unroll
        for (int r = 0; r < 4; ++r) Sd[dt][r] *= gl;
#pragma unroll
        for (int ks = 0; ks < 2; ++ks) {
          const bf16_t* kp = Kt + (16 * dt + l15) * 72 + 32 * ks + 4 * g4;
          Sd[dt] = MFMA16(ld2x4(kp, kp + 16), Bv2[ks], Sd[dt]);
        }
      }
    }
  }
  __builtin_amdgcn_s_setprio(0);
}

DI void phase_combine(CParams& p, int layer, const float* __restrict__ xg) {
  const int tidq = threadIdx.x + opq(); const int wave = tidq >> 6, lane = tidq & 63;
  const bf16_t* PR = (const bf16_t*)(p.ws + OFF_PR);
  const bf16_t* OD = (const bf16_t*)(p.ws + OFF_OD);
  const float* LSE = (const float*)(p.ws + OFF_LSE);
  const bf16_t* OFb = (const bf16_t*)(p.ws + OFF_OF);
  const bf16_t* OBb = (const bf16_t*)(p.ws + OFF_OB);
  bf16_t* Y = (bf16_t*)(p.ws + OFF_N);
  bf16_t* Np = (bf16_t*)(p.ws + OFF_Q);
  const float* gmix = p.norm_mix + layer * 1024;
  const float* gdn = p.dn_out_norm + layer * 64;
  const int head = lane >> 4;
  for (int r = blockIdx.x * 4 + wave; r < TG; r += gridDim.x * 4) {
    {
      float lg[3];
#pragma unroll
      for (int g = 0; g < 3; ++g) lg[g] = LSE[((size_t)g * TG + r) * 4 + head];
      const float mx = fmaxf(lg[0], fmaxf(lg[1], lg[2]));
      float wg[3], den = 0.f;
#pragma unroll
      for (int g = 0; g < 3; ++g) { wg[g] = exp2_(lg[g] - mx); den += wg[g]; }
      const float id = 1.f / den;
      float o[4] = {0.f, 0.f, 0.f, 0.f};
#pragma unroll
      for (int g = 0; g < 3; ++g) {
        const u32x2 u = ((const u32x2*)(OD + ((size_t)g * TG + r) * 256))[lane];
        const float c = wg[g] * id;
        o[0] += c * __uint_as_float(u.x << 16); o[1] += c * __uint_as_float(u.x & 0xffff0000u);
        o[2] += c * __uint_as_float(u.y << 16); o[3] += c * __uint_as_float(u.y & 0xffff0000u);
      }
      u32x2 ou; ou.x = pack2(o[0], o[1]); ou.y = pack2(o[2], o[3]);
      ((u32x2*)(Y + (size_t)r * 1024 + 768))[lane] = ou;
    }
    {
      const u32x2 uf = ((const u32x2*)(OFb + (size_t)r * 256))[lane];
      const u32x2 ub = ((const u32x2*)(OBb + (size_t)r * 256))[lane];
      const u32x2 uz = ((const u32x2*)(PR + (size_t)r * NPR + C_Z))[lane];
      float o[4], z[4];
      o[0] = __uint_as_float(uf.x << 16) + __uint_as_float(ub.x << 16);
      o[1] = __uint_as_float(uf.x & 0xffff0000u) + __uint_as_float(ub.x & 0xffff0000u);
      o[2] = __uint_as_float(uf.y << 16) + __uint_as_float(ub.y << 16);
      o[3] = __uint_as_float(uf.y & 0xffff0000u) + __uint_as_float(ub.y & 0xffff0000u);
      z[0] = __uint_as_float(uz.x << 16); z[1] = __uint_as_float(uz.x & 0xffff0000u);
      z[2] = __uint_as_float(uz.y << 16); z[3] = __uint_as_float(uz.y & 0xffff0000u);
      float ss = o[0] * o[0] + o[1] * o[1] + o[2] * o[2] + o[3] * o[3];
      ss += __shfl_xor(ss, 1); ss += __shfl_xor(ss, 2); ss += __shfl_xor(ss, 4); ss += __shfl_xor(ss, 8);
      const float rs = rsqrtf(ss * (1.f / 64.f) + EPS);
      const float4 gg = ((const float4*)gdn)[lane & 15];
      u32x2 ou;
      ou.x = pack2(o[0] * rs * gg.x * siluf_(z[0]), o[1] * rs * gg.y * siluf_(z[1]));
      ou.y = pack2(o[2] * rs * gg.z * siluf_(z[2]), o[3] * rs * gg.w * siluf_(z[3]));
      ((u32x2*)(Y + (size_t)r * 1024 + 512))[lane] = ou;
    }
    {
      const float4* xr = (const float4*)(xg + (size_t)r * 1024);
      float4 v[4];
      float ss = 0.f;
#pragma unroll
      for (int i = 0; i < 4; ++i) { v[i] = xr[lane + 64 * i]; ss += v[i].x * v[i].x + v[i].y * v[i].y + v[i].z * v[i].z + v[i].w * v[i].w; }
      ss = wave_sum(ss);
      const float rs = rsqrtf(ss * (1.f / 1024.f) + EPS);
#pragma unroll
      for (int i = 0; i < 4; ++i) {
        const float4 gg = ((const float4*)gmix)[lane + 64 * i];
        u32x2 o; o.x = pack2(v[i].x * rs * gg.x, v[i].y * rs * gg.y); o.y = pack2(v[i].z * rs * gg.z, v[i].w * rs * gg.w);
        ((u32x2*)(Np + (size_t)r * 1024))[lane + 64 * i] = o;
      }
    }
  }
}

#define XB_TMO      128
#define XB_XCNT(j)  (256  + 64 * (j))
#define XB_XSUB(j)  (1280 + 64 * (j))
#define XB_XGEN(j)  (2304 + 64 * (j))
#define XB_TOP      3328
#define XB_TOPGEN   3392
#define XCD_BAR_WORDS 3456
#define XB_SPIN_CAP (1u << 27)
#define LAS __attribute__((address_space(3)))
constexpr size_t OFF_BAR = OFF_CNT + 65536;
DI unsigned xb_ld(unsigned* p) { return __hip_atomic_load(p, __ATOMIC_RELAXED, __HIP_MEMORY_SCOPE_AGENT); }
DI unsigned xb_add(unsigned* p, unsigned v) { return __hip_atomic_fetch_add(p, v, __ATOMIC_RELAXED, __HIP_MEMORY_SCOPE_AGENT); }
DI unsigned xb_xcc_id() { return (unsigned)__builtin_amdgcn_s_getreg((3 << 11) | 20) & 0xFu; }
#define XB_SPIN(cond, bar) do { unsigned _sp = 0; while (cond) { __builtin_amdgcn_s_sleep(1); \
    if ((++_sp & 255u) == 0u) { if (xb_ld(&(bar)[XB_TMO])) break; if (_sp > XB_SPIN_CAP) { atomicAdd(&(bar)[XB_TMO], 1u); break; } } } } while (0)
struct XcdBarrier { unsigned* bar; unsigned x; volatile LAS unsigned* st; };
DI XcdBarrier xcd_barrier_post(unsigned* bar, volatile LAS unsigned* st) {
  XcdBarrier b; b.bar = bar; b.x = xb_xcc_id(); b.st = st;
  if (threadIdx.x == 0) (void)xb_add(&bar[XB_XCNT(b.x)], 1u);
  return b;
}
DI void xcd_barrier_complete(unsigned* bar, unsigned x, unsigned& nloc, unsigned& nx) {
  const unsigned G = gridDim.x * gridDim.y * gridDim.z;
  unsigned sum, cnt, mine, sp = 0u;
  for (;;) {
    sum = 0u; cnt = 0u; mine = 0u;
#pragma unroll
    for (unsigned j = 0; j < 16; ++j) { const unsigned c = xb_ld(&bar[XB_XCNT(j)]); sum += c; cnt += (c > 0u) ? 1u : 0u; mine = (j == x) ? c : mine; }
    if (sum == G) break;
    __builtin_amdgcn_s_sleep(1);
    if ((++sp & 255u) == 0u) { if (xb_ld(&bar[XB_TMO])) break; if (sp > XB_SPIN_CAP) { atomicAdd(&bar[XB_TMO], 1u); break; } }
  }
  nloc = mine > 0u ? mine : 1u; nx = cnt > 0u ? cnt : 1u;
}
DI void xcd_barrier(const XcdBarrier& b) {
  asm volatile("s_waitcnt vmcnt(0)" ::: "memory");
  __syncthreads();
  if (threadIdx.x == 0) {
    unsigned* bar = b.bar;
    __builtin_amdgcn_s_waitcnt(0);
    unsigned nloc = b.st[0], nx = b.st[1];
    if (nloc == 0u) { xcd_barrier_complete(bar, b.x, nloc, nx); b.st[0] = nloc; b.st[1] = nx; }
    const unsigned old = xb_add(&bar[XB_XSUB(b.x)], 1u);
    const unsigned gen = old / nloc;
    if (old + 1u == (gen + 1u) * nloc) {
      __builtin_amdgcn_fence(__ATOMIC_RELEASE, "agent");
      asm volatile("s_waitcnt vmcnt(0)" ::: "memory");
      const unsigned og = xb_add(&bar[XB_TOP], 1u);
      const unsigned tg = og / nx;
      if (og + 1u == (tg + 1u) * nx) xb_add(&bar[XB_TOPGEN], 1u);
      else XB_SPIN(xb_ld(&bar[XB_TOPGEN]) == tg, bar);
      __builtin_amdgcn_fence(__ATOMIC_ACQUIRE, "agent");
      xb_add(&bar[XB_XGEN(b.x)], 1u);
      asm volatile("s_waitcnt vmcnt(0)" ::: "memory");
    } else {
      XB_SPIN(xb_ld(&bar[XB_XGEN(b.x)]) == gen, bar);
      __builtin_amdgcn_fence(__ATOMIC_ACQUIRE, "agent");
      asm volatile("s_waitcnt vmcnt(0)" ::: "memory");
    }
  }
  __syncthreads();
}

#ifndef REP_MIX
#define REP_MIX 1
#endif
#ifndef REP_GEMM
#define REP_GEMM 1
#endif
__global__ void __launch_bounds__(256, 2) mega(Params pk) {
  extern __shared__ __attribute__((aligned(16))) char lds[];
  __shared__ uint4 sh_words;
  cg::grid_group grid = cg::this_grid();
  CParams* kp = (CParams*)__builtin_amdgcn_kernarg_segment_ptr();
  if (threadIdx.x == 0) sh_words = make_uint4(0u, 0u, 0u, 0u);
  __syncthreads();
  XcdBarrier xb;
  { CParams& p = *launder(kp); xb = xcd_barrier_post((unsigned*)(p.ws + OFF_BAR), (volatile LAS unsigned*)&sh_words); }
#define s_item (((volatile int*)&sh_words)[2])
#define GSYNC() xcd_barrier(xb)
#define PP_ CParams& p = *launder(kp); const bf16_t* wb = (const bf16_t*)(p.ws + OFF_WB); bf16_t* Nb = (bf16_t*)(p.ws + OFF_N); \
            bf16_t* PRb = (bf16_t*)(p.ws + OFF_PR); bf16_t* Npb = (bf16_t*)(p.ws + OFF_Q); bf16_t* PB = (bf16_t*)(p.ws + OFF_OD); \
            float* xg = p.x + (size_t)grp * TG * 1024; (void)wb; (void)Nb; (void)PRb; (void)Npb; (void)PB; (void)xg;
  { CParams& p = *launder(kp); phase_init(p, lds); phase_norm(p.x_in[0], p.norm_ff1, (bf16_t*)(p.ws + OFF_Q), nullptr, nullptr); }
  grid.sync();
  for (int layer = 0; layer < 2; ++layer) {
    if (layer > 0) { CParams& p = *launder(kp); phase_convert(p, layer, lds); GSYNC(); }
    for (int grp = 0; grp < 2; ++grp) {
      const int S = grp ? 2048 : 16384, B = grp ? 16 : 2;
      const float* xsrc0 = nullptr;
      { CParams& p = *launder(kp); xsrc0 = layer == 0 ? p.x_in[grp] : p.x + (size_t)grp * TG * 1024; }
      for (int rep = 0; rep < REP_GEMM; ++rep) {
        { PP_ phase_ffn_a(Npb, wb + W_FF1_1, wb + W_FF1_3, PRb, lds); }
        GSYNC();
      }
      { PP_ phase_gemm_resid(PRb, 2816, wb + W_FF1_2, xsrc0, xg, 0.5f, lds); }
      GSYNC();
      { PP_ phase_norm(xg, p.norm_mix + layer * 1024, Nb, nullptr, nullptr); }
      GSYNC();
      for (int rep = 0; rep < REP_GEMM; ++rep) {
        { PP_ phase_proj(p, Nb, wb + W_IN, S, lds); }
        GSYNC();
      }
      {
        PP_
        int* c0 = (int*)(p.ws + OFF_CNT) + (layer * 2 + grp) * 4;
        for (;;) {
          __syncthreads();
          if (threadIdx.x == 0) s_item = atomicAdd(c0, 1);
          __syncthreads();
          const int it = s_item;
          if (it >= 2048) break;
          dn_prep_item(p, layer, it, S, lds);
        }
      }
      GSYNC();
      {
        PP_
        int* cb = (int*)(p.ws + OFF_CNT) + 64 + (layer * 2 + grp) * 32;
        const int nDN = B * 8, nDil = p.big_ws ? 3072 : 0;
        const int lgq = grp ? 4 : 7;
        for (;;) {
          __syncthreads();
          if (threadIdx.x == 0) s_item = atomicAdd(cb, 1);
          __syncthreads();
          const int it = s_item;
          if (it >= nDN) break;
          dn_scan_chain(p, it, S, lds);
        }
        for (int xo = 0; xo < 8; ++xo) {
          const int xq = (blockIdx.x + xo) & 7;
          for (;;) {
            __syncthreads();
            if (threadIdx.x == 0) s_item = atomicAdd(cb + 8 + xq, 1);
            __syncthreads();
            const int j = s_item;
            if (j >= 128) break;
            const int pair = xq + 8 * (j >> lgq), qb = j & ((1 << lgq) - 1);
            diff_item(p, layer, (pair << lgq) + qb, S, lds);
          }
        }
        for (;;) {
          __syncthreads();
          if (threadIdx.x == 0) s_item = atomicAdd(cb + 1, 1);
          __syncthreads();
          const int it = s_item;
          if (it >= nDil) break;
          dil_item(p, it, S, B, lds);
        }
      }
      GSYNC();
      {
        PP_
        int* c2 = (int*)(p.ws + OFF_CNT) + (layer * 2 + grp) * 4 + 2;
        const int nDil = p.big_ws ? 0 : 3072, total = nDil + 256 * 7;
        for (;;) {
          __syncthreads();
          if (threadIdx.x == 0) s_item = atomicAdd(c2, 1);
          __syncthreads();
          int it = s_item;
          if (it >= total) break;
          if (it < nDil) { dil_item(p, it, S, B, lds); continue; }
          it -= nDil;
          mla_up_tile(p, it / 7, it % 7, S, lds);
        }
      }
      GSYNC();
      {
        PP_
        int* cb = (int*)(p.ws + OFF_CNT) + 64 + (layer * 2 + grp) * 32 + 16;
        const int lgq = grp ? 4 : 7;
        for (int xo = 0; xo < 8; ++xo) {
          const int xq = (blockIdx.x + xo) & 7;
          for (;;) {
            __syncthreads();
            if (threadIdx.x == 0) s_item = atomicAdd(cb + xq, 1);
            __syncthreads();
            const int j = s_item;
            if (j >= 128) break;
            const int pair = xq + 8 * (j >> lgq), qb = j & ((1 << lgq) - 1);
            mla_item(p, (pair << lgq) + qb, S, lds);
          }
        }
      }
      GSYNC();
      { PP_ phase_combine(p, layer, xg); }
      GSYNC();
      for (int rep = 0; rep < REP_GEMM; ++rep) {
        { PP_ phase_merge(Npb, Nb, wb + W_G, wb + W_B, PRb, lds); }
        GSYNC();
      }
      { PP_ phase_gemm_resid(PRb, 1024, wb + W_O, xg, xg, 1.0f, lds); }
      GSYNC();
      { PP_ phase_norm(xg, p.norm_ff2 + layer * 1024, Nb, nullptr, nullptr); }
      GSYNC();
      for (int rep = 0; rep < REP_GEMM; ++rep) {
        { PP_ phase_ffn_a(Nb, wb + W_FF2_1, wb + W_FF2_3, PRb, lds); }
        GSYNC();
      }
      { PP_ phase_gemm_resid(PRb, 2816, wb + W_FF2_2, xg, xg, 0.5f, lds); }
      GSYNC();
      { PP_ phase_norm(xg, p.norm_ple + layer * 1024, Nb, p.p_in[grp] + (size_t)layer * TG * 256, PB); }
      GSYNC();
      {
        PP_
        phase_ple(Nb, PB, wb + W_PG, wb + W_PP, xg, lds);
        const int nl = grp ? layer + 1 : layer, ng = grp ^ 1;
        if (nl < 2) phase_norm(nl == 0 ? p.x_in[ng] : p.x + (size_t)ng * TG * 1024, p.norm_ff1 + nl * 1024, Npb, nullptr, nullptr);
      }
      GSYNC();
    }
  }
  { CParams& p = *launder(kp); phase_final_norm(p.x, p.norm_final); }
}

extern "C" void kernel_launch(void* const* d_in, const int* in_sizes, int n_in, void* d_out, int out_size, void* d_ws,
                              size_t ws_size, hipStream_t stream) {
  (void)in_sizes; (void)n_in; (void)out_size;
  Params p{};
  p.x_in[0] = (const float*)d_in[0]; p.x_in[1] = (const float*)d_in[1];
  p.p_in[0] = (const float*)d_in[2]; p.p_in[1] = (const float*)d_in[3];
  p.norm_ff1 = (const float*)d_in[4]; p.ff1_w1 = (const float*)d_in[5]; p.ff1_w3 = (const float*)d_in[6];
  p.ff1_w2 = (const float*)d_in[7]; p.norm_mix = (const float*)d_in[8]; p.w_in = (const float*)d_in[9];
  p.mla_q_norm = (const float*)d_in[10]; p.mla_kv_norm = (const float*)d_in[11]; p.mla_w_uq = (const float*)d_in[12];
  p.mla_w_ukv = (const float*)d_in[13]; p.diff_lambda = (const float*)d_in[14]; p.diff_subln = (const float*)d_in[15];
  p.dn_conv = (const float*)d_in[16]; p.dn_a_log = (const float*)d_in[17]; p.dn_dt_bias = (const float*)d_in[18];
  p.dn_out_norm = (const float*)d_in[19]; p.w_branch = (const float*)d_in[20]; p.w_gate = (const float*)d_in[21];
  p.w_out = (const float*)d_in[22]; p.norm_ff2 = (const float*)d_in[23]; p.ff2_w1 = (const float*)d_in[24];
  p.ff2_w3 = (const float*)d_in[25]; p.ff2_w2 = (const float*)d_in[26]; p.norm_ple = (const float*)d_in[27];
  p.ple_gate = (const float*)d_in[28]; p.ple_proj = (const float*)d_in[29]; p.norm_final = (const float*)d_in[30];
  p.x = (float*)d_out;
  p.ws = (char*)d_ws;
  p.big_ws = (ws_size >= WS_BIG) ? 1 : 0;
  static int grid_blocks = 0;
  if (!grid_blocks) {
    int dev = 0, cus = 0, per_cu = 0;
    hipGetDevice(&dev);
    hipDeviceGetAttribute(&cus, hipDeviceAttributeMultiprocessorCount, dev);
    hipFuncSetAttribute((const void*)mega, hipFuncAttributeMaxDynamicSharedMemorySize, (int)LDS_BYTES);
    hipOccupancyMaxActiveBlocksPerMultiprocessor(&per_cu, mega, 256, LDS_BYTES);
    if (per_cu < 1) per_cu = 1;
    grid_blocks = cus * per_cu;
  }
  if (ws_size < WS_NEED) {
    fprintf(stderr, "workspace too small: %zu < %zu\n", ws_size, (size_t)WS_NEED);
    return;
  }
  (void)hipMemsetAsync((char*)d_ws + OFF_BAR, 0, XCD_BAR_WORDS * 4, stream);
  void* args[] = {&p};
  hipError_t e = hipLaunchCooperativeKernel((void*)mega, dim3(grid_blocks), dim3(256), args, LDS_BYTES, stream);
  if (e != hipSuccess) fprintf(stderr, "cooperative launch failed: %s (grid %d)\n", hipGetErrorString(e), grid_blocks);
}
```

```cpp
#include <hip/hip_runtime.h>
#include <hip/hip_cooperative_groups.h>
#include <stdint.h>
#include <stdio.h>
namespace cg = cooperative_groups;

typedef unsigned short bf16_t;
using bf16x8 = __attribute__((ext_vector_type(8))) short;
using bf16x4 = __attribute__((ext_vector_type(4))) short;
using f32x16 = __attribute__((ext_vector_type(16))) float;
using f32x4 = __attribute__((ext_vector_type(4))) float;
using u32x4 = __attribute__((ext_vector_type(4))) unsigned;
using u32x2 = __attribute__((ext_vector_type(2))) unsigned;

#define DI __device__ __forceinline__
#define MFMA32(a, b, c) __builtin_amdgcn_mfma_f32_32x32x16_bf16((a), (b), (c), 0, 0, 0)
#define MFMA16(a, b, c) __builtin_amdgcn_mfma_f32_16x16x32_bf16((a), (b), (c), 0, 0, 0)

constexpr int TG = 32768;
constexpr int NPR = 4608;
constexpr float EPS = 1e-6f;
constexpr float LOG2E = 1.4426950408889634f;
constexpr int C_CQ = 0, C_CKV = 256, C_BQ = 384, C_BK = 640, C_BV = 896, C_DNQKV = 1152, C_Z = 1920,
              C_DQ = 2176, C_DK = 2944, C_DV = 3712;
constexpr size_t MiB = 1048576;
constexpr size_t OFF_WB = 0, OFF_TAB = 57 * MiB, OFF_CNT = 63 * MiB, OFF_N = 64 * MiB, OFF_PR = 128 * MiB,
                 OFF_Q = 416 * MiB, OFF_K = 440 * MiB, OFF_V = 464 * MiB, OFF_AB = 480 * MiB, OFF_OD = 482 * MiB,
                 OFF_LSE = 530 * MiB, OFF_OF = 532 * MiB, OFF_OB = 548 * MiB, WS_NEED = 564 * MiB;
constexpr size_t W_FF1_1 = 0, W_FF1_3 = 2883584, W_FF1_2 = 5767168, W_IN = 8650752, W_UQ = 13369344,
                 W_UKV = 13467648, W_G = 13533184, W_B = 17727488, W_O = 18776064, W_FF2_1 = 19824640,
                 W_FF2_3 = 22708224, W_FF2_2 = 25591808, W_PG = 28475392, W_PP = 29523968;
constexpr size_t LDS_BYTES = 78336;

struct Params {
  const float* x_in[2];
  const float* p_in[2];
  const float *norm_ff1, *ff1_w1, *ff1_w3, *ff1_w2, *norm_mix, *w_in, *mla_q_norm, *mla_kv_norm, *mla_w_uq,
      *mla_w_ukv, *diff_lambda, *diff_subln, *dn_conv, *dn_a_log, *dn_dt_bias, *dn_out_norm, *w_branch, *w_gate,
      *w_out, *norm_ff2, *ff2_w1, *ff2_w3, *ff2_w2, *norm_ple, *ple_gate, *ple_proj, *norm_final;
  float* x;
  char* ws;
  long long big_ws;
};

typedef const __attribute__((address_space(4))) Params CParams;
DI CParams* launder(CParams* q) { asm volatile("" : "+s"(q)); return q; }

typedef __bf16 bf2_t __attribute__((ext_vector_type(2)));
typedef float f2_t __attribute__((ext_vector_type(2)));
DI bf16_t f2bf(float x) { return __builtin_bit_cast(bf16_t, (__bf16)x); }
DI float bf2f(bf16_t b) { return __uint_as_float(((unsigned)b) << 16); }
DI unsigned pack2(float a, float b) { f2_t v = {a, b}; return __builtin_bit_cast(unsigned, __builtin_convertvector(v, bf2_t)); }
DI float wave_sum(float v) {
#pragma unroll
  for (int o = 32; o > 0; o >>= 1) v += __shfl_xor(v, o);
  return v;
}
DI float sigmoidf_(float x) { return __builtin_amdgcn_rcpf(1.f + __expf(-x)); }
DI float siluf_(float x) { return x * __builtin_amdgcn_rcpf(1.f + __expf(-x)); }
DI float exp2_(float x) { return __builtin_amdgcn_exp2f(x); }
DI int opq() { int z; asm volatile("v_mov_b32 %0, 0" : "=v"(z)); return z; }
DI float xhalf_max(float v) {
  const auto r = __builtin_amdgcn_permlane32_swap(__float_as_uint(v), __float_as_uint(v), false, false);
  return fmaxf(__uint_as_float(r[0]), __uint_as_float(r[1]));
}
DI int crow(int r, int h2) { return (r & 3) + 8 * (r >> 2) + 4 * h2; }
DI bf16x8 pack8(float a0, float a1, float a2, float a3, float a4, float a5, float a6, float a7) {
  u32x4 u;
  u.x = pack2(a0, a1); u.y = pack2(a2, a3); u.z = pack2(a4, a5); u.w = pack2(a6, a7);
  return __builtin_bit_cast(bf16x8, u);
}
DI bf16x8 ld2x4(const bf16_t* p0, const bf16_t* p1) {
  u32x2 a = *(const u32x2*)p0, b = *(const u32x2*)p1;
  u32x4 u; u.x = a.x; u.y = a.y; u.z = b.x; u.w = b.y;
  return __builtin_bit_cast(bf16x8, u);
}
DI void store8bf(bf16_t* dst, const float* v) {
  u32x4 u; u.x = pack2(v[0], v[1]); u.y = pack2(v[2], v[3]); u.z = pack2(v[4], v[5]); u.w = pack2(v[6], v[7]);
  *(u32x4*)dst = u;
}

struct MatDesc { const float* src; bf16_t* dst; int K, ldsrc, Ndst, map; const float* rowscale; };

DI int map_col(int map, int n) {
  if (map == 0) return n;
  if (map == 1) {
    if (n < 384) return n;
    if (n < 1920) return n + 32;
    if (n < 4480) return n + 48;
    if (n < 4512) return n - 4480 + 384;
    if (n < 4528) return n - 4512 + 1952;
    return -1;
  }
  if (n < 256) return (n >> 6) * 96 + (n & 63);
  return ((n - 256) >> 5) * 96 + 64 + ((n - 256) & 31);
}

DI MatDesc get_mat(CParams& p, int l, int id) {
  bf16_t* wb = (bf16_t*)(p.ws + OFF_WB);
  MatDesc d; d.map = 0; d.rowscale = nullptr;
  const size_t FF = (size_t)1024 * 2816;
  switch (id) {
    case 0: d.src = p.ff1_w1 + l * FF; d.dst = wb + W_FF1_1; d.K = 1024; d.ldsrc = 2816; d.Ndst = 2816; break;
    case 1: d.src = p.ff1_w3 + l * FF; d.dst = wb + W_FF1_3; d.K = 1024; d.ldsrc = 2816; d.Ndst = 2816; break;
    case 2: d.src = p.ff1_w2 + l * FF; d.dst = wb + W_FF1_2; d.K = 2816; d.ldsrc = 1024; d.Ndst = 1024; break;
    case 3: d.src = p.w_in + (size_t)l * 1024 * 4528; d.dst = wb + W_IN; d.K = 1024; d.ldsrc = 4528; d.Ndst = 4608; d.map = 1; break;
    case 4: d.src = p.mla_w_uq + (size_t)l * 256 * 384; d.dst = wb + W_UQ; d.K = 256; d.ldsrc = 384; d.Ndst = 384; d.map = 2; d.rowscale = p.mla_q_norm + l * 256; break;
    case 5: d.src = p.mla_w_ukv + (size_t)l * 128 * 512; d.dst = wb + W_UKV; d.K = 128; d.ldsrc = 512; d.Ndst = 512; d.rowscale = p.mla_kv_norm + l * 128; break;
    case 6: case 7: case 8: case 9:
      d.src = p.w_gate + (size_t)(l * 4 + id - 6) * 1048576; d.dst = wb + W_G + (size_t)(id - 6) * 1048576; d.K = 1024; d.ldsrc = 1024; d.Ndst = 1024; break;
    case 10: case 11: case 12: case 13:
      d.src = p.w_branch + (size_t)(l * 4 + id - 10) * 262144; d.dst = wb + W_B + (size_t)(id - 10) * 262144; d.K = 256; d.ldsrc = 1024; d.Ndst = 1024; break;
    case 14: d.src = p.w_out + (size_t)l * 1048576; d.dst = wb + W_O; d.K = 1024; d.ldsrc = 1024; d.Ndst = 1024; break;
    case 15: d.src = p.ff2_w1 + l * FF; d.dst = wb + W_FF2_1; d.K = 1024; d.ldsrc = 2816; d.Ndst = 2816; break;
    case 16: d.src = p.ff2_w3 + l * FF; d.dst = wb + W_FF2_3; d.K = 1024; d.ldsrc = 2816; d.Ndst = 2816; break;
    case 17: d.src = p.ff2_w2 + l * FF; d.dst = wb + W_FF2_2; d.K = 2816; d.ldsrc = 1024; d.Ndst = 1024; break;
    case 18: d.src = p.ple_gate + (size_t)l * 1048576; d.dst = wb + W_PG; d.K = 1024; d.ldsrc = 1024; d.Ndst = 1024; break;
    default: d.src = p.ple_proj + (size_t)l * 262144; d.dst = wb + W_PP; d.K = 256; d.ldsrc = 1024; d.Ndst = 1024; break;
  }
  return d;
}

DI void phase_convert(CParams& p, int l, char* lds) {
  float* T = (float*)lds;
  const int tid = threadIdx.x + opq();
  for (int id = 0; id < 20; ++id) {
    MatDesc d = get_mat(p, l, id);
    const int nkt = d.K >> 6, nnt = d.Ndst >> 6, nt_all = nkt * nnt;
    for (int t = blockIdx.x; t < nt_all; t += gridDim.x) {
      const int kt = t / nnt, nt = t % nnt;
      __syncthreads();
      {
        const int nl = tid & 63;
        const int sc = map_col(d.map, nt * 64 + nl);
#pragma unroll 4
        for (int i = 0; i < 16; ++i) {
          const int kl = (tid >> 6) + 4 * i;
          const int k = kt * 64 + kl;
          float v = 0.f;
          if (sc >= 0) v = d.src[(size_t)k * d.ldsrc + sc];
          if (d.rowscale) v *= d.rowscale[k];
          T[kl * 65 + nl] = v;
        }
      }
      __syncthreads();
      {
        const int kl = tid & 63;
#pragma unroll 4
        for (int i = 0; i < 16; ++i) {
          const int nl = (tid >> 6) + 4 * i;
          d.dst[(size_t)(nt * 64 + nl) * d.K + kt * 64 + kl] = f2bf(T[kl * 65 + nl]);
        }
      }
    }
  }
}

DI void phase_init(CParams& p, char* lds) {
  const size_t gtid = (size_t)blockIdx.x * 256 + threadIdx.x + opq(), gn = (size_t)gridDim.x * 256;
  {
    float2* t32 = (float2*)(p.ws + OFF_TAB);
    float2* t64 = (float2*)(p.ws + OFF_TAB + 2 * MiB);
    for (size_t i = gtid; i < (size_t)16384 * 48; i += gn) {
      const int pos = (int)(i / 48), f = (int)(i % 48);
      float inv;
      if (f < 16) inv = exp2f(-(float)f * (13.287712379549449f / 16.f));
      else inv = exp2f(-(float)(f - 16) * (13.287712379549449f / 32.f));
      const float ang = (float)pos * inv;
      const double xd = (double)ang;
      const double n = rint(xd * 0.15915494309189535);
      const float rf = (float)(xd - n * 6.283185307179586);
      float2 cs; cs.x = __cosf(rf); cs.y = __sinf(rf);
      if (f < 16) t32[(size_t)pos * 16 + f] = cs; else t64[(size_t)pos * 32 + (f - 16)] = cs;
    }
  }
  if (blockIdx.x == 0) ((int*)(p.ws + OFF_CNT))[threadIdx.x] = 0;
  phase_convert(p, 0, lds);
}

DI void phase_norm(const float* __restrict__ x, const float* __restrict__ g, bf16_t* __restrict__ dst,
                           const float* __restrict__ psrc, bf16_t* __restrict__ pdst) {
  const int tidq = threadIdx.x + opq(); const int wave = tidq >> 6, lane = tidq & 63;
  for (int r = blockIdx.x * 4 + wave; r < TG; r += gridDim.x * 4) {
    const float4* xr = (const float4*)(x + (size_t)r * 1024);
    float4 v[4];
    float ss = 0.f;
#pragma unroll
    for (int i = 0; i < 4; ++i) { v[i] = xr[lane + 64 * i]; ss += v[i].x * v[i].x + v[i].y * v[i].y + v[i].z * v[i].z + v[i].w * v[i].w; }
    ss = wave_sum(ss);
    const float rs = rsqrtf(ss * (1.f / 1024.f) + EPS);
#pragma unroll
    for (int i = 0; i < 4; ++i) {
      const float4 gg = ((const float4*)g)[lane + 64 * i];
      u32x2 o; o.x = pack2(v[i].x * rs * gg.x, v[i].y * rs * gg.y); o.y = pack2(v[i].z * rs * gg.z, v[i].w * rs * gg.w);
      ((u32x2*)(dst + (size_t)r * 1024))[lane + 64 * i] = o;
    }
    if (psrc) {
      const float4 pv = ((const float4*)(psrc + (size_t)r * 256))[lane];
      u32x2 o; o.x = pack2(pv.x, pv.y); o.y = pack2(pv.z, pv.w);
      ((u32x2*)(pdst + (size_t)r * 256))[lane] = o;
    }
  }
}

DI void phase_final_norm(float* __restrict__ x, const float* __restrict__ g) {
  const int tidq = threadIdx.x + opq(); const int wave = tidq >> 6, lane = tidq & 63;
  for (int r = blockIdx.x * 4 + wave; r < 2 * TG; r += gridDim.x * 4) {
    float4* xr = (float4*)(x + (size_t)r * 1024);
    float4 v[4];
    float ss = 0.f;
#pragma unroll
    for (int i = 0; i < 4; ++i) { v[i] = xr[lane + 64 * i]; ss += v[i].x * v[i].x + v[i].y * v[i].y + v[i].z * v[i].z + v[i].w * v[i].w; }
    ss = wave_sum(ss);
    const float rs = rsqrtf(ss * (1.f / 1024.f) + EPS);
#pragma unroll
    for (int i = 0; i < 4; ++i) {
      const float4 gg = ((const float4*)g)[lane + 64 * i];
      float4 o; o.x = v[i].x * rs * gg.x; o.y = v[i].y * rs * gg.y; o.z = v[i].z * rs * gg.z; o.w = v[i].w * rs * gg.w;
      xr[lane + 64 * i] = o;
    }
  }
}

template <int NI, int NB>
DI void gemm_main(f32x16 (&acc0)[2][NI], f32x16 (&acc1)[2][NI], const bf16_t* __restrict__ A, int lda,
                  const bf16_t* __restrict__ B0, const bf16_t* __restrict__ B1, int ldb, int K, char* lds) {
  const int tid = threadIdx.x + opq(), lane = tid & 63, w = tid >> 6, wm = w >> 1, wn = w & 1, l31 = lane & 31, h2 = lane >> 5;
  bf16_t* As = (bf16_t*)lds;
  bf16_t* B0s = As + 128 * 72;
  bf16_t* B1s = B0s + 64 * NI * 72;
  const int lr = tid >> 3, lc = (tid & 7) * 8;
  u32x4 ra[4], rb0[2 * NI], rb1[2 * NI];
  const bf16_t* ap = A + (size_t)lr * lda + lc;
  const bf16_t* bp0 = B0 + (size_t)lr * ldb + lc;
  const bf16_t* bp1 = (NB == 2) ? (B1 + (size_t)lr * ldb + lc) : B0;
#pragma unroll
  for (int i = 0; i < 4; ++i) ra[i] = *(const u32x4*)(ap + (size_t)(32 * i) * lda);
#pragma unroll
  for (int i = 0; i < 2 * NI; ++i) {
    rb0[i] = *(const u32x4*)(bp0 + (size_t)(32 * i) * ldb);
    if (NB == 2) rb1[i] = *(const u32x4*)(bp1 + (size_t)(32 * i) * ldb);
  }
  for (int k0 = 0; k0 < K; k0 += 64) {
    __syncthreads();
#pragma unroll
    for (int i = 0; i < 4; ++i) *(u32x4*)(As + (lr + 32 * i) * 72 + lc) = ra[i];
#pragma unroll
    for (int i = 0; i < 2 * NI; ++i) {
      *(u32x4*)(B0s + (lr + 32 * i) * 72 + lc) = rb0[i];
      if (NB == 2) *(u32x4*)(B1s + (lr + 32 * i) * 72 + lc) = rb1[i];
    }
    if (k0 + 64 < K) {
      const int kn = k0 + 64;
#pragma unroll
      for (int i = 0; i < 4; ++i) ra[i] = *(const u32x4*)(ap + (size_t)(32 * i) * lda + kn);
#pragma unroll
      for (int i = 0; i < 2 * NI; ++i) {
        rb0[i] = *(const u32x4*)(bp0 + (size_t)(32 * i) * ldb + kn);
        if (NB == 2) rb1[i] = *(const u32x4*)(bp1 + (size_t)(32 * i) * ldb + kn);
      }
    }
    __syncthreads();
    __builtin_amdgcn_s_setprio(1);
#pragma unroll
    for (int ks = 0; ks < 4; ++ks) {
      bf16x8 af[2], bf0[NI], bf1[NI];
#pragma unroll
      for (int mi = 0; mi < 2; ++mi) af[mi] = *(const bf16x8*)(As + (64 * wm + 32 * mi + l31) * 72 + 16 * ks + 8 * h2);
#pragma unroll
      for (int ni = 0; ni < NI; ++ni) {
        bf0[ni] = *(const bf16x8*)(B0s + (32 * NI * wn + 32 * ni + l31) * 72 + 16 * ks + 8 * h2);
        if (NB == 2) bf1[ni] = *(const bf16x8*)(B1s + (32 * NI * wn + 32 * ni + l31) * 72 + 16 * ks + 8 * h2);
      }
#pragma unroll
      for (int mi = 0; mi < 2; ++mi)
#pragma unroll
        for (int ni = 0; ni < NI; ++ni) {
          acc0[mi][ni] = MFMA32(af[mi], bf0[ni], acc0[mi][ni]);
          if (NB == 2) acc1[mi][ni] = MFMA32(af[mi], bf1[ni], acc1[mi][ni]);
        }
    }
    __builtin_amdgcn_s_setprio(0);
  }
}

template <int NI>
DI void zero_acc(f32x16 (&a)[2][NI]) {
#pragma unroll
  for (int mi = 0; mi < 2; ++mi)
#pragma unroll
    for (int ni = 0; ni < NI; ++ni)
#pragma unroll
      for (int r = 0; r < 16; ++r) a[mi][ni][r] = 0.f;
}

#define EPI_VARS const int tid = threadIdx.x + opq(), lane = tid & 63, w = tid >> 6, wm = w >> 1, wn = w & 1, l31 = lane & 31, h2 = lane >> 5; (void)tid; (void)lane; (void)w
#define EPI_BEGIN(NI_) _Pragma("unroll") for (int mi = 0; mi < 2; ++mi) _Pragma("unroll") for (int ni = 0; ni < NI_; ++ni) _Pragma("unroll") for (int r = 0; r < 16; ++r) { \
    const int row = 64 * wm + 32 * mi + crow(r, h2); const int col = 32 * NI_ * wn + 32 * ni + l31;
#define EPI_END }

DI bool xcd_tile(int iter, int MT, int NT, int& mt, int& nt) {
  const int x = blockIdx.x & 7, lb = blockIdx.x >> 3, nb = gridDim.x >> 3;
  if (NT == 8) {
    const int j = lb + iter * nb;
    if (lb >= nb || j >= MT) return false;
    mt = (x & 1) * (MT >> 1) + (j >> 1);
    nt = 2 * (x >> 1) + (j & 1);
    return true;
  }
  const int full = NT >> 3, rem = NT & 7;
  const int per_full = full * MT, rem_tot = rem * MT;
  const int r0 = (rem_tot * x) >> 3, r1 = (rem_tot * (x + 1)) >> 3;
  const int j = lb + iter * nb;
  if (lb >= nb || j >= per_full + (r1 - r0)) return false;
  if (j < per_full) { mt = j / full; nt = x * full + j % full; }
  else { const int u = r0 + (j - per_full); nt = 8 * full + u / MT; mt = u % MT; }
  return true;
}

DI void phase_ffn_a(const bf16_t* __restrict__ Nb, const bf16_t* __restrict__ W1, const bf16_t* __restrict__ W3,
                            bf16_t* __restrict__ H, char* lds) {
  EPI_VARS;
  for (int iter = 0;; ++iter) {
    int mt, nt;
    if (!xcd_tile(iter, 256, 22, mt, nt)) break;
    f32x16 a0[2][2], a1[2][2];
    zero_acc<2>(a0); zero_acc<2>(a1);
    gemm_main<2, 2>(a0, a1, Nb + (size_t)mt * 128 * 1024, 1024, W1 + (size_t)nt * 128 * 1024, W3 + (size_t)nt * 128 * 1024, 1024, 1024, lds);
    EPI_BEGIN(2)
      H[(size_t)(mt * 128 + row) * 2816 + nt * 128 + col] = f2bf(siluf_(a0[mi][ni][r]) * a1[mi][ni][r]);
    EPI_END
  }
}

DI void phase_gemm_resid(const bf16_t* __restrict__ A, int K, const bf16_t* __restrict__ Bt, const float* xsrc, float* x,
                                 float scale, char* lds) {
  EPI_VARS;
  for (int iter = 0;; ++iter) {
    int mt, nt;
    if (!xcd_tile(iter, 256, 4, mt, nt)) break;
    f32x16 a0[2][4];
    zero_acc<4>(a0);
    gemm_main<4, 1>(a0, a0, A + (size_t)mt * 128 * K, K, Bt + (size_t)nt * 256 * K, nullptr, K, K, lds);
    EPI_BEGIN(4)
      const size_t off = (size_t)(mt * 128 + row) * 1024 + nt * 256 + col;
      x[off] = xsrc[off] + scale * a0[mi][ni][r];
    EPI_END
  }
}

DI void phase_ple(const bf16_t* __restrict__ Nb, const bf16_t* __restrict__ PB, const bf16_t* __restrict__ PG,
                          const bf16_t* __restrict__ PP, float* __restrict__ x, char* lds) {
  EPI_VARS;
  for (int iter = 0;; ++iter) {
    int mt, nt;
    if (!xcd_tile(iter, 256, 8, mt, nt)) break;
    f32x16 a0[2][2], a1[2][2];
    zero_acc<2>(a0); zero_acc<2>(a1);
    gemm_main<2, 1>(a0, a0, Nb + (size_t)mt * 128 * 1024, 1024, PG + (size_t)nt * 128 * 1024, nullptr, 1024, 1024, lds);
    gemm_main<2, 1>(a1, a1, PB + (size_t)mt * 128 * 256, 256, PP + (size_t)nt * 128 * 256, nullptr, 256, 256, lds);
    EPI_BEGIN(2)
      float* xp = x + (size_t)(mt * 128 + row) * 1024 + nt * 128 + col;
      *xp = *xp + sigmoidf_(a0[mi][ni][r]) * a1[mi][ni][r];
    EPI_END
  }
}

DI void phase_merge(const bf16_t* __restrict__ Np, const bf16_t* __restrict__ Y, const bf16_t* __restrict__ WG,
                            const bf16_t* __restrict__ WB, bf16_t* __restrict__ M, char* lds) {
  EPI_VARS;
  for (int iter = 0;; ++iter) {
    int mt, nt;
    if (!xcd_tile(iter, 256, 8, mt, nt)) break;
    f32x16 am[2][2];
    zero_acc<2>(am);
#pragma unroll 1
    for (int n = 0; n < 4; ++n) {
      unsigned sg[2][2][8];
      {
        f32x16 ag[2][2];
        zero_acc<2>(ag);
        gemm_main<2, 1>(ag, ag, Np + (size_t)mt * 128 * 1024, 1024, WG + (size_t)n * 1048576 + (size_t)nt * 128 * 1024, nullptr, 1024, 1024, lds);
#pragma unroll
        for (int mi = 0; mi < 2; ++mi)
#pragma unroll
          for (int ni = 0; ni < 2; ++ni)
#pragma unroll
            for (int r = 0; r < 8; ++r) sg[mi][ni][r] = pack2(sigmoidf_(ag[mi][ni][2 * r]), sigmoidf_(ag[mi][ni][2 * r + 1]));
      }
      f32x16 ab[2][2];
      zero_acc<2>(ab);
      gemm_main<2, 1>(ab, ab, Y + (size_t)mt * 128 * 1024 + n * 256, 1024, WB + (size_t)n * 262144 + (size_t)nt * 128 * 256, nullptr, 256, 256, lds);
#pragma unroll
      for (int mi = 0; mi < 2; ++mi)
#pragma unroll
        for (int ni = 0; ni < 2; ++ni)
#pragma unroll
          for (int r = 0; r < 8; ++r) {
            am[mi][ni][2 * r] += __uint_as_float(sg[mi][ni][r] << 16) * ab[mi][ni][2 * r];
            am[mi][ni][2 * r + 1] += __uint_as_float(sg[mi][ni][r] & 0xffff0000u) * ab[mi][ni][2 * r + 1];
          }
    }
    EPI_BEGIN(2)
      M[(size_t)(mt * 128 + row) * 1024 + nt * 128 + col] = f2bf(am[mi][ni][r]);
    EPI_END
  }
}

DI void rope32_out(const float* c, const float2* tab, float sc, float* o) {
#pragma unroll
  for (int i = 0; i < 16; ++i) {
    const float2 cs = tab[i];
    const float a = c[i], b = c[16 + i];
    o[i] = (a * cs.x - b * cs.y) * sc;
    o[16 + i] = (b * cs.x + a * cs.y) * sc;
  }
}

DI void phase_proj(CParams& p, const bf16_t* __restrict__ Nb, const bf16_t* __restrict__ WIN, int S, char* lds) {
  EPI_VARS;
  bf16_t* PR = (bf16_t*)(p.ws + OFF_PR);
  float* AB = (float*)(p.ws + OFF_AB);
  const float2* t32 = (const float2*)(p.ws + OFF_TAB);
  const float2* t64 = (const float2*)(p.ws + OFF_TAB + 2 * MiB);
  float* Ct = (float*)lds;
  for (int iter = 0;; ++iter) {
    int mt, nt2;
    if (!xcd_tile(iter, 256, 18, mt, nt2)) break;
    f32x16 a0[2][4];
    zero_acc<4>(a0);
    gemm_main<4, 1>(a0, a0, Nb + (size_t)mt * 128 * 1024, 1024, WIN + (size_t)nt2 * 256 * 1024, nullptr, 1024, 1024, lds);
   for (int hv = 0; hv < 2; ++hv) {
    const int nt = 2 * nt2 + hv;
    __syncthreads();
    if (wn == hv) {
#pragma unroll
      for (int mi = 0; mi < 2; ++mi)
#pragma unroll
        for (int ni = 0; ni < 4; ++ni)
#pragma unroll
          for (int r = 0; r < 16; ++r) Ct[(64 * wm + 32 * mi + crow(r, h2)) * 132 + 32 * ni + l31] = a0[mi][ni][r];
    }
    __syncthreads();
    const int erow = tid >> 1, half = tid & 1;
    const int tok = mt * 128 + erow, pos = tok & (S - 1);
    const float* cr = Ct + erow * 132 + 64 * half;
    bf16_t* dst = PR + (size_t)tok * NPR + nt * 128 + 64 * half;
    int type = 0; float sc = 1.f;
    if (nt == 3 || nt == 4) { type = 1; sc = 0.17677669529663687f * LOG2E; }
    else if (nt == 5 || nt == 6) { type = 1; }
    else if (nt >= 17 && nt <= 22) { type = 2; sc = 0.125f * LOG2E; }
    else if (nt >= 23 && nt <= 28) { type = 2; }
    else if (nt == 35) type = 3;
    if (type == 0) {
#pragma unroll
      for (int j = 0; j < 8; ++j) store8bf(dst + 8 * j, cr + 8 * j);
    } else if (type == 1) {
#pragma unroll
      for (int hh = 0; hh < 2; ++hh) {
        float o[32];
        rope32_out(cr + 32 * hh, t32 + (size_t)pos * 16, sc, o);
#pragma unroll
        for (int j = 0; j < 4; ++j) store8bf(dst + 32 * hh + 8 * j, o + 8 * j);
      }
    } else if (type == 2) {
      const float2* tab = t64 + (size_t)pos * 32;
#pragma unroll
      for (int j = 0; j < 4; ++j) {
        float lo[8], hi[8];
#pragma unroll
        for (int e = 0; e < 8; ++e) {
          const float2 cs = tab[8 * j + e];
          const float a = cr[8 * j + e], b = cr[32 + 8 * j + e];
          lo[e] = (a * cs.x - b * cs.y) * sc;
          hi[e] = (b * cs.x + a * cs.y) * sc;
        }
        store8bf(dst + 8 * j, lo);
        store8bf(dst + 32 + 8 * j, hi);
      }
    } else {
      if (half == 0) {
        float o[32];
        rope32_out(cr, t32 + (size_t)pos * 16, 1.f, o);
#pragma unroll
        for (int j = 0; j < 4; ++j) store8bf(dst + 8 * j, o + 8 * j);
      } else {
        const float* c2 = Ct + erow * 132 + 32;
#pragma unroll
        for (int j = 0; j < 4; ++j) {
          float4 v; v.x = c2[4 * j]; v.y = c2[4 * j + 1]; v.z = c2[4 * j + 2]; v.w = c2[4 * j + 3];
          ((float4*)(AB + (size_t)tok * 16))[j] = v;
        }
      }
    }
   }
  }
}

DI void mla_up_tile(CParams& p, int mt, int j, int S, char* lds) {
  EPI_VARS;
  const bf16_t* PR = (const bf16_t*)(p.ws + OFF_PR);
  const bf16_t* wb = (const bf16_t*)(p.ws + OFF_WB);
  bf16_t* Qb = (bf16_t*)(p.ws + OFF_Q);
  bf16_t* Kb = (bf16_t*)(p.ws + OFF_K);
  bf16_t* Vb = (bf16_t*)(p.ws + OFF_V);
  const float2* t32 = (const float2*)(p.ws + OFF_TAB);
  float* Ct = (float*)lds;
  float* rst = (float*)(lds + 67584);
  const bool isq = j < 3;
  const int K = isq ? 256 : 128;
  const int nt = isq ? j : j - 3;
  const bf16_t* A = PR + (size_t)mt * 128 * NPR + (isq ? C_CQ : C_CKV);
  const bf16_t* B = wb + (isq ? W_UQ : W_UKV) + (size_t)nt * 128 * K;
  const int erow = tid >> 1, half = tid & 1;
  {
    const bf16_t* ar = A + (size_t)erow * NPR + half * (K / 2);
    float ss = 0.f;
    for (int c = 0; c < K / 16; ++c) {
      const u32x4 u = *(const u32x4*)(ar + 8 * c);
      const unsigned uu[4] = {u.x, u.y, u.z, u.w};
#pragma unroll
      for (int e = 0; e < 4; ++e) {
        const float lo = __uint_as_float(uu[e] << 16), hi = __uint_as_float(uu[e] & 0xffff0000u);
        ss += lo * lo + hi * hi;
      }
    }
    ss += __shfl_xor(ss, 1);
    if (half == 0) rst[erow] = rsqrtf(ss / (float)K + EPS);
  }
  f32x16 a0[2][2];
  zero_acc<2>(a0);
  gemm_main<2, 1>(a0, a0, A, NPR, B, nullptr, K, K, lds);
  __syncthreads();
  EPI_BEGIN(2)
    Ct[row * 132 + col] = a0[mi][ni][r];
  EPI_END
  __syncthreads();
  const int tok = mt * 128 + erow, pos = tok & (S - 1);
  const float rs = rst[erow];
  const float* cr = Ct + erow * 132 + 64 * half;
  if (isq) {
    const float sc = rs * 0.10206207261596577f * LOG2E;
    if (nt < 2) {
      bf16_t* dst = Qb + ((size_t)tok * 4 + 2 * nt + half) * 96;
#pragma unroll
      for (int jj = 0; jj < 8; ++jj) {
        float o[8];
#pragma unroll
        for (int e = 0; e < 8; ++e) o[e] = cr[8 * jj + e] * sc;
        store8bf(dst + 8 * jj, o);
      }
    } else {
#pragma unroll
      for (int hh = 0; hh < 2; ++hh) {
        float o[32];
        rope32_out(cr + 32 * hh, t32 + (size_t)pos * 16, sc, o);
        bf16_t* dst = Qb + ((size_t)tok * 4 + 2 * half + hh) * 96 + 64;
#pragma unroll
        for (int jj = 0; jj < 4; ++jj) store8bf(dst + 8 * jj, o + 8 * jj);
      }
    }
  } else {
    bf16_t* dst = half == 0 ? (Kb + ((size_t)tok * 4 + nt) * 96) : (Vb + ((size_t)tok * 4 + nt) * 64);
#pragma unroll
    for (int jj = 0; jj < 8; ++jj) {
      float o[8];
#pragma unroll
      for (int e = 0; e < 8; ++e) o[e] = cr[8 * jj + e] * rs;
      store8bf(dst + 8 * jj, o);
    }
    if (half == 0) {
      const u32x4* src = (const u32x4*)(PR + (size_t)tok * NPR + 4480);
#pragma unroll
      for (int jj = 0; jj < 4; ++jj) ((u32x4*)(dst + 64))[jj] = src[jj];
    }
  }
}

typedef short s16x4_t __attribute__((ext_vector_type(4)));
DI bf16x8 tr_pair(const bf16_t* p0, const bf16_t* p1) {
  const s16x4_t lo = __builtin_amdgcn_ds_read_tr16_b64_v4i16((__attribute__((address_space(3))) s16x4_t*)p0);
  const s16x4_t hi = __builtin_amdgcn_ds_read_tr16_b64_v4i16((__attribute__((address_space(3))) s16x4_t*)p1);
  return __builtin_shufflevector(lo, hi, 0, 1, 2, 3, 4, 5, 6, 7);
}

template <int DK, bool BAND>
DI void flash_loop(f32x16 (&O)[2], float& m, float& l, const bf16_t* __restrict__ qrow, const bf16_t* __restrict__ kbase,
                   size_t kstride, const bf16_t* __restrict__ vbase, size_t vstride, int ntiles, int tq, int u0, int L,
                   char* lds) {
  const int tid = threadIdx.x + opq(), lane = tid & 63, l31 = lane & 31, h2 = lane >> 5;
  constexpr int KR = DK + 8, KCH = DK / 8, KN = 64 * KCH / 256;
  constexpr int STAGE = 64 * KR * 2 + 64 * 72 * 2;
  bf16x8 qf[DK / 16];
#pragma unroll
  for (int ks = 0; ks < DK / 16; ++ks) qf[ks] = *(const bf16x8*)(qrow + 16 * ks + 8 * h2);
  u32x4 rkA[KN], rvA[2], rkB[KN], rvB[2];
  auto gload = [&](int kt, u32x4 (&rk)[KN], u32x4 (&rv)[2]) {
#pragma unroll
    for (int i = 0; i < KN; ++i) {
      const int ci = tid + 256 * i, row = ci / KCH, c = ci % KCH;
      int rr = u0 + 64 * kt + row;
      if (BAND) rr = min(max(rr, 0), L - 1);
      rk[i] = *(const u32x4*)(kbase + (size_t)rr * kstride + c * 8);
    }
#pragma unroll
    for (int i = 0; i < 2; ++i) {
      const int ci = tid + 256 * i, row = ci >> 3, c = ci & 7;
      int rr = u0 + 64 * kt + row;
      if (BAND) rr = min(max(rr, 0), L - 1);
      rv[i] = *(const u32x4*)(vbase + (size_t)rr * vstride + c * 8);
    }
  };
  auto swrite = [&](int st, const u32x4 (&rk)[KN], const u32x4 (&rv)[2]) {
    bf16_t* Ks = (bf16_t*)(lds + st * STAGE);
    bf16_t* Vs = Ks + 64 * KR;
#pragma unroll
    for (int i = 0; i < KN; ++i) {
      const int ci = tid + 256 * i, row = ci / KCH, c = ci % KCH;
      *(u32x4*)(Ks + row * KR + c * 8) = rk[i];
    }
#pragma unroll
    for (int i = 0; i < 2; ++i) {
      const int ci = tid + 256 * i, row = ci >> 3, c = ci & 7;
      *(u32x4*)(Vs + row * 72 + c * 8) = rv[i];
    }
  };
  const int trq = (lane & 15) >> 2, trp = lane & 3, trblk = (lane >> 4) & 1;
  const int troff = (4 * h2 + trq) * 72 + 16 * trblk + 4 * trp;
  __syncthreads();
  gload(0, rkA, rvA);
  swrite(0, rkA, rvA);
  gload(1, rkA, rvA);
  if (ntiles > 2) gload(2, rkB, rvB);
  for (int kt2 = 0; kt2 < ntiles; kt2 += 2)
#pragma unroll
  for (int par = 0; par < 2; ++par) {
    const int kt = kt2 + par;
    __syncthreads();
    if (par == 0) {
      if (kt + 1 < ntiles) swrite((kt + 1) & 1, rkA, rvA);
      if (kt + 3 < ntiles) gload(kt + 3, rkA, rvA);
    } else {
      if (kt + 1 < ntiles) swrite((kt + 1) & 1, rkB, rvB);
      if (kt + 3 < ntiles) gload(kt + 3, rkB, rvB);
    }
    const bf16_t* Ks = (const bf16_t*)(lds + (kt & 1) * STAGE);
    const bf16_t* Vs = Ks + 64 * KR;
    f32x16 Sx[2];
#pragma unroll
    for (int j = 0; j < 2; ++j)
#pragma unroll
      for (int r = 0; r < 16; ++r) Sx[j][r] = 0.f;
#pragma unroll
    for (int ks = 0; ks < DK / 16; ++ks)
#pragma unroll
      for (int j = 0; j < 2; ++j) {
        const bf16x8 kf = *(const bf16x8*)(Ks + (32 * j + l31) * KR + 16 * ks + 8 * h2);
        Sx[j] = MFMA32(kf, qf[ks], Sx[j]);
      }
    if (BAND) {
#pragma unroll
      for (int j = 0; j < 2; ++j)
#pragma unroll
        for (int r = 0; r < 16; ++r) {
          const int u = u0 + 64 * kt + 32 * j + crow(r, h2);
          const int d = u - tq;
          const bool valid = (d <= 64) && (d >= -64) && (u >= 0) && (u < L);
          Sx[j][r] = valid ? Sx[j][r] : -1e30f;
        }
    }
    float mx = Sx[0][0];
#pragma unroll
    for (int j = 0; j < 2; ++j)
#pragma unroll
      for (int r = 0; r < 16; ++r) mx = fmaxf(mx, Sx[j][r]);
    mx = xhalf_max(mx);
    const float mn = fmaxf(m, mx);
    const float alpha = exp2_(m - mn);
    const bool grew = mn > m;
    m = mn;
    float ls = 0.f;
#pragma unroll
    for (int j = 0; j < 2; ++j)
#pragma unroll
      for (int r = 0; r < 16; ++r) { const float pv = exp2_(Sx[j][r] - mn); Sx[j][r] = pv; ls += pv; }
    l = l * alpha + ls;
    if (__any(grew)) {
#pragma unroll
      for (int t = 0; t < 2; ++t)
#pragma unroll
        for (int r = 0; r < 16; ++r) O[t][r] *= alpha;
    }
#pragma unroll
    for (int j = 0; j < 2; ++j)
#pragma unroll
      for (int s = 0; s < 2; ++s) {
        const bf16x8 pf = pack8(Sx[j][8 * s], Sx[j][8 * s + 1], Sx[j][8 * s + 2], Sx[j][8 * s + 3], Sx[j][8 * s + 4],
                                Sx[j][8 * s + 5], Sx[j][8 * s + 6], Sx[j][8 * s + 7]);
#pragma unroll
        for (int t = 0; t < 2; ++t) {
          const bf16_t* vp = Vs + (32 * j + 16 * s) * 72 + 32 * t + troff;
          const bf16x8 vf = tr_pair(vp, vp + 8 * 72);
          O[t] = MFMA32(vf, pf, O[t]);
        }
      }
  }
}

DI void flash_loop_diff(f32x16 (&O0)[2], f32x16 (&O1)[2], float& m0, float& l0, float& m1, float& l1,
                        const bf16_t* __restrict__ qrow, const bf16_t* __restrict__ kbase, size_t kstride,
                        const bf16_t* __restrict__ vbase, size_t vstride, int ntiles, char* lds) {
  const int tid = threadIdx.x + opq(), lane = tid & 63, l31 = lane & 31, h2 = lane >> 5;
  constexpr int KR = 72;
  constexpr int STAGE = 64 * KR * 2 + 64 * 72 * 2;
  bf16x8 qf0[2], qf1[2];
#pragma unroll
  for (int ks = 0; ks < 2; ++ks) {
    qf0[ks] = *(const bf16x8*)(qrow + 16 * ks + 8 * h2);
    qf1[ks] = *(const bf16x8*)(qrow + 32 + 16 * ks + 8 * h2);
  }
  u32x4 rk[2], rv[2];
  auto gload = [&](int kt) {
#pragma unroll
    for (int i = 0; i < 2; ++i) {
      const int ci = tid + 256 * i, row = ci >> 3, c = ci & 7;
      const int rr = 64 * kt + row;
      rk[i] = *(const u32x4*)(kbase + (size_t)rr * kstride + c * 8);
      rv[i] = *(const u32x4*)(vbase + (size_t)rr * vstride + c * 8);
    }
  };
  auto swrite = [&](int st) {
    bf16_t* Ks = (bf16_t*)(lds + st * STAGE);
    bf16_t* Vs = Ks + 64 * KR;
#pragma unroll
    for (int i = 0; i < 2; ++i) {
      const int ci = tid + 256 * i, row = ci >> 3, c = ci & 7;
      *(u32x4*)(Ks + row * KR + c * 8) = rk[i];
      *(u32x4*)(Vs + row * 72 + c * 8) = rv[i];
    }
  };
  const int trq = (lane & 15) >> 2, trp = lane & 3, trblk = (lane >> 4) & 1;
  const int troff = (4 * h2 + trq) * 72 + 16 * trblk + 4 * trp;
  __syncthreads();
  gload(0);
  swrite(0);
  if (ntiles > 1) gload(1);
  for (int kt = 0; kt < ntiles; ++kt) {
    __syncthreads();
    if (kt + 1 < ntiles) swrite((kt + 1) & 1);
    if (kt + 2 < ntiles) gload(kt + 2);
    const bf16_t* Ks = (const bf16_t*)(lds + (kt & 1) * STAGE);
    const bf16_t* Vs = Ks + 64 * KR;
    bf16x8 pf[2][2][2];
#pragma unroll
    for (int mp = 0; mp < 2; ++mp) {
      f32x16 Sx[2];
#pragma unroll
      for (int j = 0; j < 2; ++j)
#pragma unroll
        for (int r = 0; r < 16; ++r) Sx[j][r] = 0.f;
#pragma unroll
      for (int ks = 0; ks < 2; ++ks)
#pragma unroll
        for (int j = 0; j < 2; ++j) {
          const bf16x8 kf = *(const bf16x8*)(Ks + (32 * j + l31) * KR + 32 * mp + 16 * ks + 8 * h2);
          Sx[j] = MFMA32(kf, mp == 0 ? qf0[ks] : qf1[ks], Sx[j]);
        }
      float& m = mp == 0 ? m0 : m1;
      float& l = mp == 0 ? l0 : l1;
      float mx = Sx[0][0];
#pragma unroll
      for (int j = 0; j < 2; ++j)
#pragma unroll
        for (int r = 0; r < 16; ++r) mx = fmaxf(mx, Sx[j][r]);
      mx = xhalf_max(mx);
      const float mn = fmaxf(m, mx);
      const float alpha = exp2_(m - mn);
      const bool grew = mn > m;
      m = mn;
      float ls = 0.f;
#pragma unroll
      for (int j = 0; j < 2; ++j)
#pragma unroll
        for (int r = 0; r < 16; ++r) { const float pv = exp2_(Sx[j][r] - mn); Sx[j][r] = pv; ls += pv; }
      l = l * alpha + ls;
      if (__any(grew)) {
#pragma unroll
        for (int t = 0; t < 2; ++t)
#pragma unroll
          for (int r = 0; r < 16; ++r) { if (mp == 0) O0[t][r] *= alpha; else O1[t][r] *= alpha; }
      }
#pragma unroll
      for (int j = 0; j < 2; ++j)
#pragma unroll
        for (int s = 0; s < 2; ++s)
          pf[mp][j][s] = pack8(Sx[j][8 * s], Sx[j][8 * s + 1], Sx[j][8 * s + 2], Sx[j][8 * s + 3], Sx[j][8 * s + 4],
                               Sx[j][8 * s + 5], Sx[j][8 * s + 6], Sx[j][8 * s + 7]);
    }
#pragma unroll
    for (int j = 0; j < 2; ++j)
#pragma unroll
      for (int s = 0; s < 2; ++s)
#pragma unroll
        for (int t = 0; t < 2; ++t) {
          const bf16_t* vp = Vs + (32 * j + 16 * s) * 72 + 32 * t + troff;
          const bf16x8 vf = tr_pair(vp, vp + 8 * 72);
          O0[t] = MFMA32(vf, pf[0][j][s], O0[t]);
          O1[t] = MFMA32(vf, pf[1][j][s], O1[t]);
        }
  }
}

DI void zeroO(f32x16 (&O)[2]) {
#pragma unroll
  for (int t = 0; t < 2; ++t)
#pragma unroll
    for (int r = 0; r < 16; ++r) O[t][r] = 0.f;
}

DI void store_o(bf16_t* dst, const f32x16 (&O)[2], int h2) {
#pragma unroll
  for (int t = 0; t < 2; ++t)
#pragma unroll
    for (int g = 0; g < 4; ++g) {
      u32x2 u; u.x = pack2(O[t][4 * g], O[t][4 * g + 1]); u.y = pack2(O[t][4 * g + 2], O[t][4 * g + 3]);
      *(u32x2*)(dst + 32 * t + 8 * g + 4 * h2) = u;
    }
}

DI void mla_item(CParams& p, int it, int S, char* lds) {
  const int tid = threadIdx.x + opq(), lane = tid & 63, w = tid >> 6, l31 = lane & 31, h2 = lane >> 5;
  const int lgq = (S == 2048) ? 4 : 7;
  const int qb = it & ((1 << lgq) - 1), bh = it >> lgq, h = bh & 3, b = bh >> 2;
  const int tokbase = b * S, gtok = tokbase + 128 * qb + 32 * w + l31;
  const bf16_t* Qb = (const bf16_t*)(p.ws + OFF_Q);
  const bf16_t* Kb = (const bf16_t*)(p.ws + OFF_K);
  const bf16_t* Vb = (const bf16_t*)(p.ws + OFF_V);
  bf16_t* Y = (bf16_t*)(p.ws + OFF_N);
  f32x16 O[2]; zeroO(O);
  float m = -1e30f, l = 0.f;
  flash_loop<96, false>(O, m, l, Qb + ((size_t)gtok * 4 + h) * 96, Kb + ((size_t)tokbase * 4 + h) * 96, 384,
                        Vb + ((size_t)tokbase * 4 + h) * 64, 256, S / 64, 0, 0, 0, lds);
  l += __shfl_xor(l, 32);
  const float il = 1.f / l;
#pragma unroll
  for (int t = 0; t < 2; ++t)
#pragma unroll
    for (int r = 0; r < 16; ++r) O[t][r] *= il;
  store_o(Y + (size_t)gtok * 1024 + h * 64, O, h2);
}

DI void diff_item(CParams& p, int layer, int it, int S, char* lds) {
  const int tid = threadIdx.x + opq(), lane = tid & 63, w = tid >> 6, l31 = lane & 31, h2 = lane >> 5;
  const int lgq = (S == 2048) ? 4 : 7;
  const int qb = it & ((1 << lgq) - 1), bh = it >> lgq, h = bh & 3, b = bh >> 2;
  const int tokbase = b * S, gtok = tokbase + 128 * qb + 32 * w + l31;
  const bf16_t* PR = (const bf16_t*)(p.ws + OFF_PR);
  bf16_t* Y = (bf16_t*)(p.ws + OFF_N);
  const float* lam = p.diff_lambda + layer * 128;
  float s1 = 0.f, s2 = 0.f;
  if (lane < 32) { s1 = lam[lane] * lam[32 + lane]; s2 = lam[64 + lane] * lam[96 + lane]; }
  s1 = wave_sum(s1); s2 = wave_sum(s2);
  const float lambda_init = layer ? 0.35550907f : 0.2f;
  const float lambda_full = expf(s1) - expf(s2) + lambda_init;
  f32x16 of[2], O1[2];
  zeroO(of); zeroO(O1);
  {
    float m0 = -1e30f, l0 = 0.f, m1 = -1e30f, l1 = 0.f;
    flash_loop_diff(of, O1, m0, l0, m1, l1, PR + (size_t)gtok * NPR + C_BQ + (2 * h) * 32,
                    PR + (size_t)tokbase * NPR + C_BK + (2 * h) * 32, NPR, PR + (size_t)tokbase * NPR + C_BV + h * 64, NPR,
                    S / 64, lds);
    l0 += __shfl_xor(l0, 32);
    l1 += __shfl_xor(l1, 32);
    const float c0 = 1.f / l0, c1 = -lambda_full / l1;
#pragma unroll
    for (int t = 0; t < 2; ++t)
#pragma unroll
      for (int r = 0; r < 16; ++r) of[t][r] = c0 * of[t][r] + c1 * O1[t][r];
  }
  float ss = 0.f;
#pragma unroll
  for (int t = 0; t < 2; ++t)
#pragma unroll
    for (int r = 0; r < 16; ++r) ss += of[t][r] * of[t][r];
  ss += __shfl_xor(ss, 32);
  const float rs = rsqrtf(ss * (1.f / 64.f) + EPS) * (1.f - lambda_init);
  const float* sg = p.diff_subln + layer * 64;
#pragma unroll
  for (int t = 0; t < 2; ++t)
#pragma unroll
    for (int r = 0; r < 16; ++r) of[t][r] *= rs * sg[32 * t + crow(r, h2)];
  store_o(Y + (size_t)gtok * 1024 + 256 + h * 64, of, h2);
}

DI void dil_item(CParams& p, int it, int S, int B, char* lds) {
  const int tid = threadIdx.x + opq(), lane = tid & 63, w = tid >> 6, l31 = lane & 31, h2 = lane >> 5;
  const int lgS = (S == 2048) ? 11 : 14, lgB = (B == 16) ? 4 : 1;
  const int rq = it & ((1 << (lgS - 7)) - 1);
  int rest = it >> (lgS - 7);
  const int head = rest & 3; rest >>= 2;
  const int b = rest & (B - 1), g = rest >> lgB;
  const int lgd = 2 * g, dil = 1 << lgd;
  const int L = S >> lgd, lgnqb = lgS - lgd - 7;
  const int res = rq >> lgnqb, qb = rq & ((1 << lgnqb) - 1);
  const int tokbase = b * S;
  const int tq = 128 * qb + 32 * w + l31;
  const int gtok = tokbase + tq * dil + res;
  const bf16_t* PR = (const bf16_t*)(p.ws + OFF_PR);
  bf16_t* OD = (bf16_t*)(p.ws + OFF_OD);
  float* LSE = (float*)(p.ws + OFF_LSE);
  f32x16 O[2]; zeroO(O);
  float m = -1e30f, l = 0.f;
  const int hc = (g * 4 + head) * 64;
  flash_loop<64, true>(O, m, l, PR + (size_t)gtok * NPR + C_DQ + hc, PR + (size_t)(tokbase + res) * NPR + C_DK + hc,
                       (size_t)dil * NPR, PR + (size_t)(tokbase + res) * NPR + C_DV + hc, (size_t)dil * NPR, 4, tq,
                       128 * qb - 64, L, lds);
  l += __shfl_xor(l, 32);
  const float il = 1.f / l;
#pragma unroll
  for (int t = 0; t < 2; ++t)
#pragma unroll
    for (int r = 0; r < 16; ++r) O[t][r] *= il;
  store_o(OD + ((size_t)g * TG + gtok) * 256 + head * 64, O, h2);
  if (h2 == 0) LSE[((size_t)g * TG + gtok) * 4 + head] = m + __log2f(l);
}

constexpr size_t OFF_X2 = 564 * MiB, WS_BIG = 597 * MiB;
#define DN_QK_OFF (p.big_ws ? OFF_X2 : OFF_OD)
#define DN_GC_OFF ((p.big_ws ? OFF_X2 : OFF_OD) + 32 * MiB)
constexpr size_t DN_UW_OFF = OFF_Q;

DI void dn_prep_item(CParams& p, int layer, int it, int S, char* lds) {
  const int tid = threadIdx.x + opq(), lane = tid & 63, w = tid >> 6, l15 = lane & 15, g4 = lane >> 4;
  const int NC = S / 64;
  const int ch = it % NC, bh = it / NC, h = bh & 3, b = bh >> 2;
  const int tokbase = b * S, s0 = ch * 64;
  const bf16_t* PR = (const bf16_t*)(p.ws + OFF_PR);
  const float* AB = (const float*)(p.ws + OFF_AB);
  bf16_t* QKg = (bf16_t*)(p.ws + DN_QK_OFF) + ((size_t)bh * NC + ch) * 8192;
  bf16_t* raw = (bf16_t*)lds;
  float* convw = (float*)(lds + 27200);
  float* RU = (float*)lds;
  float* RW = (float*)(lds + 16384);
  float* Am = (float*)(lds + 32768);
  bf16_t* Kimg = (bf16_t*)(lds + 50176);
  bf16_t* Qimg = (bf16_t*)(lds + 59392);
  float* gcs = (float*)(lds + 68608);
  float* betas = gcs + 128;
  const float* cw = p.dn_conv + (size_t)layer * 5 * 768;
  {
    u32x4 rawreg[7];
    float cwr[4];
#pragma unroll
    for (int k = 0; k < 7; ++k) {
      const int ci = tid + 256 * k;
      const int rr = ci / 24, c = ci % 24, seg = c >> 3, c8 = c & 7;
      const int s = s0 + rr - 2;
      rawreg[k] = u32x4{0u, 0u, 0u, 0u};
      if (ci < 68 * 24 && s >= 0 && s < S)
        rawreg[k] = *(const u32x4*)(PR + (size_t)(tokbase + s) * NPR + C_DNQKV + seg * 256 + h * 64 + c8 * 8);
    }
#pragma unroll
    for (int k = 0; k < 4; ++k) {
      const int i = tid + 256 * k;
      cwr[k] = 0.f;
      if (i < 960) { const int j = i / 192, c = i % 192; cwr[k] = cw[j * 768 + (c >> 6) * 256 + h * 64 + (c & 63)]; }
    }
#pragma unroll
    for (int k = 0; k < 7; ++k) {
      const int ci = tid + 256 * k;
      const int rr = ci / 24, c = ci % 24, seg = c >> 3, c8 = c & 7;
      if (ci < 68 * 24) *(u32x4*)(raw + rr * 200 + seg * 64 + c8 * 8) = rawreg[k];
    }
#pragma unroll
    for (int k = 0; k < 4; ++k) { const int i = tid + 256 * k; if (i < 960) convw[i] = cwr[k]; }
  }
  if (tid < 128) {
    const int d = tid >> 6, pl = tid & 63;
    const int i = d ? 63 - pl : pl;
    const size_t tok = (size_t)tokbase + s0 + i;
    const float Aexp = expf(p.dn_a_log[layer * 8 + d * 4 + h]);
    const float a = AB[tok * 16 + d * 8 + h] + p.dn_dt_bias[layer * 8 + d * 4 + h];
    const float bb = AB[tok * 16 + d * 8 + 4 + h];
    const float sp = fmaxf(a, 0.f) + __logf(1.f + __expf(-fabsf(a)));
    float g = -Aexp * sp;
#pragma unroll
    for (int o = 1; o < 64; o <<= 1) { const float tv = __shfl_up(g, o); if (lane >= o) g += tv; }
    gcs[tid] = g;
    betas[tid] = sigmoidf_(bb);
    float* GC = (float*)(p.ws + DN_GC_OFF) + (((size_t)bh * 2 + d) * NC + ch) * 64;
    GC[pl] = g;
  }
  __syncthreads();
  const int pp = tid >> 2, cgp = tid & 3;
  float kv[16], vv[16];
  {
    float qv[16];
#pragma unroll
    for (int seg = 0; seg < 3; ++seg) {
      float acc[16];
#pragma unroll
      for (int c = 0; c < 16; ++c) acc[c] = 0.f;
#pragma unroll
      for (int j = 0; j < 5; ++j) {
        const bf16_t* rp = raw + (pp + j) * 200 + seg * 64 + 16 * cgp;
        const float* wp = convw + j * 192 + seg * 64 + 16 * cgp;
        const u32x4 u0 = *(const u32x4*)rp, u1 = *(const u32x4*)(rp + 8);
        const unsigned uu[8] = {u0.x, u0.y, u0.z, u0.w, u1.x, u1.y, u1.z, u1.w};
#pragma unroll
        for (int e = 0; e < 8; ++e) {
          acc[2 * e] += wp[2 * e] * __uint_as_float(uu[e] << 16);
          acc[2 * e + 1] += wp[2 * e + 1] * __uint_as_float(uu[e] & 0xffff0000u);
        }
      }
#pragma unroll
      for (int c = 0; c < 16; ++c) {
        const float sv = acc[c] * __builtin_amdgcn_rcpf(1.f + __expf(-acc[c]));
        if (seg == 0) qv[c] = sv; else if (seg == 1) kv[c] = sv; else vv[c] = sv;
      }
    }
    float sq = 0.f, sk = 0.f;
#pragma unroll
    for (int c = 0; c < 16; ++c) { sq += qv[c] * qv[c]; sk += kv[c] * kv[c]; }
    sq += __shfl_xor(sq, 1); sq += __shfl_xor(sq, 2);
    sk += __shfl_xor(sk, 1); sk += __shfl_xor(sk, 2);
    const float rq = rsqrtf(sq + EPS) * 0.125f, rk = rsqrtf(sk + EPS);
#pragma unroll
    for (int c = 0; c < 16; ++c) { qv[c] *= rq; kv[c] *= rk; }
    store8bf(Kimg + pp * 72 + 16 * cgp, kv); store8bf(Kimg + pp * 72 + 16 * cgp + 8, kv + 8);
    store8bf(Qimg + pp * 72 + 16 * cgp, qv); store8bf(Qimg + pp * 72 + 16 * cgp + 8, qv + 8);
    store8bf(QKg + pp * 64 + 16 * cgp, qv); store8bf(QKg + pp * 64 + 16 * cgp + 8, qv + 8);
    store8bf(QKg + 4096 + pp * 64 + 16 * cgp, kv); store8bf(QKg + 4096 + pp * 64 + 16 * cgp + 8, kv + 8);
  }
  for (int d = 0; d < 2; ++d) {
    __syncthreads();
    {
      const int pl = d ? 63 - pp : pp;
      const float bet = betas[d * 64 + pl], egc = __expf(gcs[d * 64 + pl]);
#pragma unroll
      for (int c = 0; c < 16; ++c) {
        RU[pl * 64 + 16 * cgp + c] = vv[c] * bet;
        RW[pl * 64 + 16 * cgp + c] = kv[c] * bet * egc;
      }
    }
    {
      f32x4 KK[4];
#pragma unroll
      for (int t = 0; t < 4; ++t) KK[t] = f32x4{0.f, 0.f, 0.f, 0.f};
      const int jl = 16 * w + l15;
      const int jrow = d ? 63 - jl : jl;
#pragma unroll
      for (int ks = 0; ks < 2; ++ks) {
        const bf16x8 bfk = *(const bf16x8*)(Kimg + jrow * 72 + 32 * ks + 8 * g4);
#pragma unroll
        for (int rt = 0; rt < 4; ++rt) {
          const int il = 16 * rt + l15;
          const int irow = d ? 63 - il : il;
          const bf16x8 afk = *(const bf16x8*)(Kimg + irow * 72 + 32 * ks + 8 * g4);
          KK[rt] = MFMA16(afk, bfk, KK[rt]);
        }
      }
      const float gcj = gcs[d * 64 + jl];
#pragma unroll
      for (int rt = 0; rt < 4; ++rt)
#pragma unroll
        for (int r = 0; r < 4; ++r) {
          const int i = 16 * rt + 4 * g4 + r;
          const float ee = __expf(fminf(gcs[d * 64 + i] - gcj, 0.f));
          Am[i * 68 + jl] = (i > jl) ? betas[d * 64 + i] * KK[rt][r] * ee : 0.f;
        }
    }
    __syncthreads();
    float xs[32];
#pragma unroll
    for (int q = 0; q < 32; ++q) xs[q] = 0.f;
    const int c = tid >> 1, half = tid & 1;
    {
      const float* Rc = (c < 64) ? (RU + c) : (RW + (c - 64));
      const float* Ah = Am + 4 * half;
#pragma unroll
      for (int i = 0; i < 64; ++i) {
        float part = 0.f;
#pragma unroll
        for (int q = 0; q < (i + 7) / 8; ++q) {
          const f32x4 a = *(const f32x4*)(Ah + i * 68 + 8 * q);
          part += a[0] * xs[4 * q] + a[1] * xs[4 * q + 1] + a[2] * xs[4 * q + 2] + a[3] * xs[4 * q + 3];
        }
        const float other = __int_as_float(__builtin_amdgcn_update_dpp(0, __float_as_int(part), 0xB1, 0xf, 0xf, true));
        const float xi = Rc[i * 64] - (part + other);
        const int loc = ((i >> 3) << 2) + (i & 3);
        if (((i >> 2) & 1) == 0) xs[loc] = (half == 0) ? xi : xs[loc];
        else xs[loc] = (half == 1) ? xi : xs[loc];
        if (i < 16 ? ((i & 7) == 7) : (i < 32 ? ((i & 3) == 3) : ((i & 1) == 1))) asm volatile("" ::: "memory");
      }
    }
    {
      bf16_t* UWg = (bf16_t*)(p.ws + DN_UW_OFF) + ((((size_t)bh * 2 + d) * NC + ch) * 8192);
      const float sgn = (c < 64) ? 1.f : -1.f;
      bf16_t* dst = UWg + ((c < 64) ? c : (4096 + c - 64));
#pragma unroll
      for (int loc = 0; loc < 32; ++loc) {
        const int i = (((loc >> 2) * 2 + half) << 2) + (loc & 3);
        dst[i * 64] = f2bf(sgn * xs[loc]);
      }
    }
  }
}

DI void dn_scan_chain(CParams& p, int it, int S, char* lds) {
  __builtin_amdgcn_s_setprio(3);
  const int tid0 = threadIdx.x + opq();
  const int dir = it & 1, bh = it >> 1, h = bh & 3, b = bh >> 2;
  const int tokbase = b * S, NC = S / 64;
  bf16_t* OUT = (bf16_t*)(p.ws + (dir ? OFF_OB : OFF_OF));
  const bf16_t* QKg = (const bf16_t*)(p.ws + DN_QK_OFF) + (size_t)bh * NC * 8192;
  const bf16_t* UWg = (const bf16_t*)(p.ws + DN_UW_OFF) + (size_t)it * NC * 8192;
  const float* GCg = (const float*)(p.ws + DN_GC_OFF) + (size_t)it * NC * 64;
  bf16_t* Uimg = (bf16_t*)lds;
  bf16_t* Wn = Uimg + 4608;
  bf16_t* Qimg = Wn + 4608;
  bf16_t* Kimg = Qimg + 4608;
  bf16_t* Kt = Kimg + 4608;
  bf16_t* Iimg = Kt + 4608;
  float* gcs = (float*)(lds + 6 * 9216);
  f32x4 Sd[4];
#pragma unroll
  for (int t = 0; t < 4; ++t) Sd[t] = f32x4{0.f, 0.f, 0.f, 0.f};
  u32x4 ru[2], rw[2], rq[2], rk[2];
  float rg = 0.f;
  auto prefetch = [&](int cc_) {
    const int ch_ = dir ? (NC - 1 - cc_) : cc_;
    const int tp = tid0 + opq();
    const bf16_t* uw = UWg + (size_t)ch_ * 8192;
    const bf16_t* qk = QKg + (size_t)ch_ * 8192;
#pragma unroll
    for (int k = 0; k < 2; ++k) {
      const int ci = tp + 256 * k, row = ci >> 3, c8 = ci & 7;
      const int srow = dir ? 63 - row : row;
      ru[k] = *(const u32x4*)(uw + row * 64 + c8 * 8);
      rw[k] = *(const u32x4*)(uw + 4096 + row * 64 + c8 * 8);
      rq[k] = *(const u32x4*)(qk + srow * 64 + c8 * 8);
      rk[k] = *(const u32x4*)(qk + 4096 + srow * 64 + c8 * 8);
    }
    if (tp < 64) rg = GCg[(size_t)ch_ * 64 + tp];
  };
  prefetch(0);
  for (int cc = 0; cc < NC; ++cc) {
    const int tid = tid0 + opq(), lane = tid & 63, w = tid >> 6, l15 = lane & 15, g4 = lane >> 4;
    const int e_col = 16 * w + l15;
    const int ch = dir ? (NC - 1 - cc) : cc;
    const int s0 = ch * 64;
    __syncthreads();
#pragma unroll
    for (int k = 0; k < 2; ++k) {
      const int ci = tid + 256 * k, row = ci >> 3, c8 = ci & 7;
      *(u32x4*)(Uimg + row * 72 + c8 * 8) = ru[k];
      *(u32x4*)(Wn + row * 72 + c8 * 8) = rw[k];
      *(u32x4*)(Qimg + row * 72 + c8 * 8) = rq[k];
      *(u32x4*)(Kimg + row * 72 + c8 * 8) = rk[k];
      const unsigned uu[4] = {rk[k].x, rk[k].y, rk[k].z, rk[k].w};
#pragma unroll
      for (int e = 0; e < 4; ++e) {
        Kt[(8 * c8 + 2 * e) * 72 + row] = (bf16_t)(uu[e] & 0xffffu);
        Kt[(8 * c8 + 2 * e + 1) * 72 + row] = (bf16_t)(uu[e] >> 16);
      }
    }
    if (tid < 64) gcs[tid] = rg;
    if (cc + 1 < NC) prefetch(cc + 1);
    __syncthreads();
    {
      f32x4 QK[4];
#pragma unroll
      for (int t = 0; t < 4; ++t) QK[t] = f32x4{0.f, 0.f, 0.f, 0.f};
#pragma unroll
      for (int ks = 0; ks < 2; ++ks) {
        const bf16x8 bfk = *(const bf16x8*)(Kimg + (16 * w + l15) * 72 + 32 * ks + 8 * g4);
#pragma unroll
        for (int rt = 0; rt < 4; ++rt) {
          const bf16x8 afq = *(const bf16x8*)(Qimg + (16 * rt + l15) * 72 + 32 * ks + 8 * g4);
          QK[rt] = MFMA16(afq, bfk, QK[rt]);
        }
      }
      const float gcj = gcs[e_col];
#pragma unroll
      for (int rt = 0; rt < 4; ++rt)
#pragma unroll
        for (int r = 0; r < 4; ++r) {
          const int i = 16 * rt + 4 * g4 + r;
          const float ee = __expf(fminf(gcs[i] - gcj, 0.f));
          Iimg[i * 72 + e_col] = f2bf((i >= e_col) ? QK[rt][r] * ee : 0.f);
        }
    }
    __syncthreads();
    {
      bf16x8 Bs[2];
#pragma unroll
      for (int ks = 0; ks < 2; ++ks)
        Bs[ks] = pack8(Sd[2 * ks][0], Sd[2 * ks][1], Sd[2 * ks][2], Sd[2 * ks][3], Sd[2 * ks + 1][0], Sd[2 * ks + 1][1],
                       Sd[2 * ks + 1][2], Sd[2 * ks + 1][3]);
      f32x4 vn[4], qs[4], iv[4];
#pragma unroll
      for (int rt = 0; rt < 4; ++rt) {
#pragma unroll
        for (int r = 0; r < 4; ++r) vn[rt][r] = bf2f(Uimg[(16 * rt + 4 * g4 + r) * 72 + e_col]);
        qs[rt] = f32x4{0.f, 0.f, 0.f, 0.f};
        iv[rt] = f32x4{0.f, 0.f, 0.f, 0.f};
#pragma unroll
        for (int ks = 0; ks < 2; ++ks) {
          const bf16_t* wp = Wn + (16 * rt + l15) * 72 + 32 * ks + 4 * g4;
          const bf16_t* qp = Qimg + (16 * rt + l15) * 72 + 32 * ks + 4 * g4;
          vn[rt] = MFMA16(ld2x4(wp, wp + 16), Bs[ks], vn[rt]);
          qs[rt] = MFMA16(ld2x4(qp, qp + 16), Bs[ks], qs[rt]);
        }
      }
      bf16x8 Bv[2];
#pragma unroll
      for (int ks = 0; ks < 2; ++ks)
        Bv[ks] = pack8(vn[2 * ks][0], vn[2 * ks][1], vn[2 * ks][2], vn[2 * ks][3], vn[2 * ks + 1][0], vn[2 * ks + 1][1],
                       vn[2 * ks + 1][2], vn[2 * ks + 1][3]);
#pragma unroll
      for (int rt = 0; rt < 4; ++rt)
#pragma unroll
        for (int ks = 0; ks < 2; ++ks) {
          const bf16_t* ip = Iimg + (16 * rt + l15) * 72 + 32 * ks + 4 * g4;
          iv[rt] = MFMA16(ld2x4(ip, ip + 16), Bv[ks], iv[rt]);
        }
      const float gc63 = gcs[63];
#pragma unroll
      for (int rt = 0; rt < 4; ++rt)
#pragma unroll
        for (int r = 0; r < 4; ++r) {
          const int pos = 16 * rt + 4 * g4 + r;
          const float o = qs[rt][r] * __expf(gcs[pos]) + iv[rt][r];
          const int i = dir ? 63 - pos : pos;
          OUT[((size_t)tokbase + s0 + i) * 256 + h * 64 + e_col] = f2bf(o);
          vn[rt][r] *= __expf(gc63 - gcs[pos]);
        }
      bf16x8 Bv2[2];
#pragma unroll
      for (int ks = 0; ks < 2; ++ks)
        Bv2[ks] = pack8(vn[2 * ks][0], vn[2 * ks][1], vn[2 * ks][2], vn[2 * ks][3], vn[2 * ks + 1][0], vn[2 * ks + 1][1],
                        vn[2 * ks + 1][2], vn[2 * ks + 1][3]);
      const float gl = __expf(gc63);
#pragma unroll
      for (int dt = 0; dt < 4; ++dt) {
#pragma unroll
        for (int r = 0; r < 4; ++r) Sd[dt][r] *= gl;
#pragma unroll
        for (int ks = 0; ks < 2; ++ks) {
          const bf16_t* kp = Kt + (16 * dt + l15) * 72 + 32 * ks + 4 * g4;
          Sd[dt] = MFMA16(ld2x4(kp, kp + 16), Bv2[ks], Sd[dt]);
        }
      }
    }
  }
  __builtin_amdgcn_s_setprio(0);
}

DI void phase_combine(CParams& p, int layer, const float* __restrict__ xg) {
  const int tidq = threadIdx.x + opq(); const int wave = tidq >> 6, lane = tidq & 63;
  const bf16_t* PR = (const bf16_t*)(p.ws + OFF_PR);
  const bf16_t* OD = (const bf16_t*)(p.ws + OFF_OD);
  const float* LSE = (const float*)(p.ws + OFF_LSE);
  const bf16_t* OFb = (const bf16_t*)(p.ws + OFF_OF);
  const bf16_t* OBb = (const bf16_t*)(p.ws + OFF_OB);
  bf16_t* Y = (bf16_t*)(p.ws + OFF_N);
  bf16_t* Np = (bf16_t*)(p.ws + OFF_Q);
  const float* gmix = p.norm_mix + layer * 1024;
  const float* gdn = p.dn_out_norm + layer * 64;
  const int head = lane >> 4;
  for (int r = blockIdx.x * 4 + wave; r < TG; r += gridDim.x * 4) {
    {
      float lg[3];
#pragma unroll
      for (int g = 0; g < 3; ++g) lg[g] = LSE[((size_t)g * TG + r) * 4 + head];
      const float mx = fmaxf(lg[0], fmaxf(lg[1], lg[2]));
      float wg[3], den = 0.f;
#pragma unroll
      for (int g = 0; g < 3; ++g) { wg[g] = exp2_(lg[g] - mx); den += wg[g]; }
      const float id = 1.f / den;
      float o[4] = {0.f, 0.f, 0.f, 0.f};
#pragma unroll
      for (int g = 0; g < 3; ++g) {
        const u32x2 u = ((const u32x2*)(OD + ((size_t)g * TG + r) * 256))[lane];
        const float c = wg[g] * id;
        o[0] += c * __uint_as_float(u.x << 16); o[1] += c * __uint_as_float(u.x & 0xffff0000u);
        o[2] += c * __uint_as_float(u.y << 16); o[3] += c * __uint_as_float(u.y & 0xffff0000u);
      }
      u32x2 ou; ou.x = pack2(o[0], o[1]); ou.y = pack2(o[2], o[3]);
      ((u32x2*)(Y + (size_t)r * 1024 + 768))[lane] = ou;
    }
    {
      const u32x2 uf = ((const u32x2*)(OFb + (size_t)r * 256))[lane];
      const u32x2 ub = ((const u32x2*)(OBb + (size_t)r * 256))[lane];
      const u32x2 uz = ((const u32x2*)(PR + (size_t)r * NPR + C_Z))[lane];
      float o[4], z[4];
      o[0] = __uint_as_float(uf.x << 16) + __uint_as_float(ub.x << 16);
      o[1] = __uint_as_float(uf.x & 0xffff0000u) + __uint_as_float(ub.x & 0xffff0000u);
      o[2] = __uint_as_float(uf.y << 16) + __uint_as_float(ub.y << 16);
      o[3] = __uint_as_float(uf.y & 0xffff0000u) + __uint_as_float(ub.y & 0xffff0000u);
      z[0] = __uint_as_float(uz.x << 16); z[1] = __uint_as_float(uz.x & 0xffff0000u);
      z[2] = __uint_as_float(uz.y << 16); z[3] = __uint_as_float(uz.y & 0xffff0000u);
      float ss = o[0] * o[0] + o[1] * o[1] + o[2] * o[2] + o[3] * o[3];
      ss += __shfl_xor(ss, 1); ss += __shfl_xor(ss, 2); ss += __shfl_xor(ss, 4); ss += __shfl_xor(ss, 8);
      const float rs = rsqrtf(ss * (1.f / 64.f) + EPS);
      const float4 gg = ((const float4*)gdn)[lane & 15];
      u32x2 ou;
      ou.x = pack2(o[0] * rs * gg.x * siluf_(z[0]), o[1] * rs * gg.y * siluf_(z[1]));
      ou.y = pack2(o[2] * rs * gg.z * siluf_(z[2]), o[3] * rs * gg.w * siluf_(z[3]));
      ((u32x2*)(Y + (size_t)r * 1024 + 512))[lane] = ou;
    }
    {
      const float4* xr = (const float4*)(xg + (size_t)r * 1024);
      float4 v[4];
      float ss = 0.f;
#pragma unroll
      for (int i = 0; i < 4; ++i) { v[i] = xr[lane + 64 * i]; ss += v[i].x * v[i].x + v[i].y * v[i].y + v[i].z * v[i].z + v[i].w * v[i].w; }
      ss = wave_sum(ss);
      const float rs = rsqrtf(ss * (1.f / 1024.f) + EPS);
#pragma unroll
      for (int i = 0; i < 4; ++i) {
        const float4 gg = ((const float4*)gmix)[lane + 64 * i];
        u32x2 o; o.x = pack2(v[i].x * rs * gg.x, v[i].y * rs * gg.y); o.y = pack2(v[i].z * rs * gg.z, v[i].w * rs * gg.w);
        ((u32x2*)(Np + (size_t)r * 1024))[lane + 64 * i] = o;
      }
    }
  }
}

#define XB_TMO      128
#define XB_XCNT(j)  (256  + 64 * (j))
#define XB_XSUB(j)  (1280 + 64 * (j))
#define XB_XGEN(j)  (2304 + 64 * (j))
#define XB_TOP      3328
#define XB_TOPGEN   3392
#define XCD_BAR_WORDS 3456
#define XB_SPIN_CAP (1u << 27)
#define LAS __attribute__((address_space(3)))
constexpr size_t OFF_BAR = OFF_CNT + 65536;
DI unsigned xb_ld(unsigned* p) { return __hip_atomic_load(p, __ATOMIC_RELAXED, __HIP_MEMORY_SCOPE_AGENT); }
DI unsigned xb_add(unsigned* p, unsigned v) { return __hip_atomic_fetch_add(p, v, __ATOMIC_RELAXED, __HIP_MEMORY_SCOPE_AGENT); }
DI unsigned xb_xcc_id() { return (unsigned)__builtin_amdgcn_s_getreg((3 << 11) | 20) & 0xFu; }
#define XB_SPIN(cond, bar) do { unsigned _sp = 0; while (cond) { __builtin_amdgcn_s_sleep(1); \
    if ((++_sp & 255u) == 0u) { if (xb_ld(&(bar)[XB_TMO])) break; if (_sp > XB_SPIN_CAP) { atomicAdd(&(bar)[XB_TMO], 1u); break; } } } } while (0)
struct XcdBarrier { unsigned* bar; unsigned x; volatile LAS unsigned* st; };
DI XcdBarrier xcd_barrier_post(unsigned* bar, volatile LAS unsigned* st) {
  XcdBarrier b; b.bar = bar; b.x = xb_xcc_id(); b.st = st;
  if (threadIdx.x == 0) (void)xb_add(&bar[XB_XCNT(b.x)], 1u);
  return b;
}
DI void xcd_barrier_complete(unsigned* bar, unsigned x, unsigned& nloc, unsigned& nx) {
  const unsigned G = gridDim.x * gridDim.y * gridDim.z;
  unsigned sum, cnt, mine, sp = 0u;
  for (;;) {
    sum = 0u; cnt = 0u; mine = 0u;
#pragma unroll
    for (unsigned j = 0; j < 16; ++j) { const unsigned c = xb_ld(&bar[XB_XCNT(j)]); sum += c; cnt += (c > 0u) ? 1u : 0u; mine = (j == x) ? c : mine; }
    if (sum == G) break;
    __builtin_amdgcn_s_sleep(1);
    if ((++sp & 255u) == 0u) { if (xb_ld(&bar[XB_TMO])) break; if (sp > XB_SPIN_CAP) { atomicAdd(&bar[XB_TMO], 1u); break; } }
  }
  nloc = mine > 0u ? mine : 1u; nx = cnt > 0u ? cnt : 1u;
}
DI void xcd_barrier(const XcdBarrier& b) {
  asm volatile("s_waitcnt vmcnt(0)" ::: "memory");
  __syncthreads();
  if (threadIdx.x == 0) {
    unsigned* bar = b.bar;
    __builtin_amdgcn_s_waitcnt(0);
    unsigned nloc = b.st[0], nx = b.st[1];
    if (nloc == 0u) { xcd_barrier_complete(bar, b.x, nloc, nx); b.st[0] = nloc; b.st[1] = nx; }
    const unsigned old = xb_add(&bar[XB_XSUB(b.x)], 1u);
    const unsigned gen = old / nloc;
    if (old + 1u == (gen + 1u) * nloc) {
      __builtin_amdgcn_fence(__ATOMIC_RELEASE, "agent");
      asm volatile("s_waitcnt vmcnt(0)" ::: "memory");
      const unsigned og = xb_add(&bar[XB_TOP], 1u);
      const unsigned tg = og / nx;
      if (og + 1u == (tg + 1u) * nx) xb_add(&bar[XB_TOPGEN], 1u);
      else XB_SPIN(xb_ld(&bar[XB_TOPGEN]) == tg, bar);
      __builtin_amdgcn_fence(__ATOMIC_ACQUIRE, "agent");
      xb_add(&bar[XB_XGEN(b.x)], 1u);
      asm volatile("s_waitcnt vmcnt(0)" ::: "memory");
    } else {
      XB_SPIN(xb_ld(&bar[XB_XGEN(b.x)]) == gen, bar);
      __builtin_amdgcn_fence(__ATOMIC_ACQUIRE, "agent");
      asm volatile("s_waitcnt vmcnt(0)" ::: "memory");
    }
  }
  __syncthreads();
}

#ifndef REP_MIX
#define REP_MIX 1
#endif
#ifndef REP_GEMM
#define REP_GEMM 1
#endif
__global__ void __launch_bounds__(256, 2) mega(Params pk) {
  extern __shared__ __attribute__((aligned(16))) char lds[];
  __shared__ uint4 sh_words;
  cg::grid_group grid = cg::this_grid();
  CParams* kp = (CParams*)__builtin_amdgcn_kernarg_segment_ptr();
  if (threadIdx.x == 0) sh_words = make_uint4(0u, 0u, 0u, 0u);
  __syncthreads();
  XcdBarrier xb;
  { CParams& p = *launder(kp); xb = xcd_barrier_post((unsigned*)(p.ws + OFF_BAR), (volatile LAS unsigned*)&sh_words); }
#define s_item (((volatile int*)&sh_words)[2])
#define GSYNC() xcd_barrier(xb)
#define PP_ CParams& p = *launder(kp); const bf16_t* wb = (const bf16_t*)(p.ws + OFF_WB); bf16_t* Nb = (bf16_t*)(p.ws + OFF_N); \
            bf16_t* PRb = (bf16_t*)(p.ws + OFF_PR); bf16_t* Npb = (bf16_t*)(p.ws + OFF_Q); bf16_t* PB = (bf16_t*)(p.ws + OFF_OD); \
            float* xg = p.x + (size_t)grp * TG * 1024; (void)wb; (void)Nb; (void)PRb; (void)Npb; (void)PB; (void)xg;
  { CParams& p = *launder(kp); phase_init(p, lds); phase_norm(p.x_in[0], p.norm_ff1, (bf16_t*)(p.ws + OFF_Q), nullptr, nullptr); }
  grid.sync();
  for (int layer = 0; layer < 2; ++layer) {
    if (layer > 0) { CParams& p = *launder(kp); phase_convert(p, layer, lds); GSYNC(); }
    for (int grp = 0; grp < 2; ++grp) {
      const int S = grp ? 2048 : 16384, B = grp ? 16 : 2;
      const float* xsrc0 = nullptr;
      { CParams& p = *launder(kp); xsrc0 = layer == 0 ? p.x_in[grp] : p.x + (size_t)grp * TG * 1024; }
      for (int rep = 0; rep < REP_GEMM; ++rep) {
        { PP_ phase_ffn_a(Npb, wb + W_FF1_1, wb + W_FF1_3, PRb, lds); }
        GSYNC();
      }
      { PP_ phase_gemm_resid(PRb, 2816, wb + W_FF1_2, xsrc0, xg, 0.5f, lds); }
      GSYNC();
      { PP_ phase_norm(xg, p.norm_mix + layer * 1024, Nb, nullptr, nullptr); }
      GSYNC();
      for (int rep = 0; rep < REP_GEMM; ++rep) {
        { PP_ phase_proj(p, Nb, wb + W_IN, S, lds); }
        GSYNC();
      }
      {
        PP_
        int* c0 = (int*)(p.ws + OFF_CNT) + (layer * 2 + grp) * 4;
        for (;;) {
          __syncthreads();
          if (threadIdx.x == 0) s_item = atomicAdd(c0, 1);
          __syncthreads();
          const int it = s_item;
          if (it >= 2048) break;
          dn_prep_item(p, layer, it, S, lds);
        }
      }
      GSYNC();
      {
        PP_
        int* cb = (int*)(p.ws + OFF_CNT) + 64 + (layer * 2 + grp) * 32;
        const int nDN = B * 8, nDil = p.big_ws ? 3072 : 0;
        const int lgq = grp ? 4 : 7;
        for (;;) {
          __syncthreads();
          if (threadIdx.x == 0) s_item = atomicAdd(cb, 1);
          __syncthreads();
          const int it = s_item;
          if (it >= nDN) break;
          dn_scan_chain(p, it, S, lds);
        }
        for (int xo = 0; xo < 8; ++xo) {
          const int xq = (blockIdx.x + xo) & 7;
          for (;;) {
            __syncthreads();
            if (threadIdx.x == 0) s_item = atomicAdd(cb + 8 + xq, 1);
            __syncthreads();
            const int j = s_item;
            if (j >= 128) break;
            const int pair = xq + 8 * (j >> lgq), qb = j & ((1 << lgq) - 1);
            diff_item(p, layer, (pair << lgq) + qb, S, lds);
          }
        }
        for (;;) {
          __syncthreads();
          if (threadIdx.x == 0) s_item = atomicAdd(cb + 1, 1);
          __syncthreads();
          const int it = s_item;
          if (it >= nDil) break;
          dil_item(p, it, S, B, lds);
        }
      }
      GSYNC();
      {
        PP_
        int* c2 = (int*)(p.ws + OFF_CNT) + (layer * 2 + grp) * 4 + 2;
        const int nDil = p.big_ws ? 0 : 3072, total = nDil + 256 * 7;
        for (;;) {
          __syncthreads();
          if (threadIdx.x == 0) s_item = atomicAdd(c2, 1);
          __syncthreads();
          int it = s_item;
          if (it >= total) break;
          if (it < nDil) { dil_item(p, it, S, B, lds); continue; }
          it -= nDil;
          mla_up_tile(p, it / 7, it % 7, S, lds);
        }
      }
      GSYNC();
      {
        PP_
        int* cb = (int*)(p.ws + OFF_CNT) + 64 + (layer * 2 + grp) * 32 + 16;
        const int lgq = grp ? 4 : 7;
        for (int xo = 0; xo < 8; ++xo) {
          const int xq = (blockIdx.x + xo) & 7;
          for (;;) {
            __syncthreads();
            if (threadIdx.x == 0) s_item = atomicAdd(cb + xq, 1);
            __syncthreads();
            const int j = s_item;
            if (j >= 128) break;
            const int pair = xq + 8 * (j >> lgq), qb = j & ((1 << lgq) - 1);
            mla_item(p, (pair << lgq) + qb, S, lds);
          }
        }
      }
      GSYNC();
      { PP_ phase_combine(p, layer, xg); }
      GSYNC();
      for (int rep = 0; rep < REP_GEMM; ++rep) {
        { PP_ phase_merge(Npb, Nb, wb + W_G, wb + W_B, PRb, lds); }
        GSYNC();
      }
      { PP_ phase_gemm_resid(PRb, 1024, wb + W_O, xg, xg, 1.0f, lds); }
      GSYNC();
      { PP_ phase_norm(xg, p.norm_ff2 + layer * 1024, Nb, nullptr, nullptr); }
      GSYNC();
      for (int rep = 0; rep < REP_GEMM; ++rep) {
        { PP_ phase_ffn_a(Nb, wb + W_FF2_1, wb + W_FF2_3, PRb, lds); }
        GSYNC();
      }
      { PP_ phase_gemm_resid(PRb, 2816, wb + W_FF2_2, xg, xg, 0.5f, lds); }
      GSYNC();
      { PP_ phase_norm(xg, p.norm_ple + layer * 1024, Nb, p.p_in[grp] + (size_t)layer * TG * 256, PB); }
      GSYNC();
      {
        PP_
        phase_ple(Nb, PB, wb + W_PG, wb + W_PP, xg, lds);
        const int nl = grp ? layer + 1 : layer, ng = grp ^ 1;
        if (nl < 2) phase_norm(nl == 0 ? p.x_in[ng] : p.x + (size_t)ng * TG * 1024, p.norm_ff1 + nl * 1024, Npb, nullptr, nullptr);
      }
      GSYNC();
    }
  }
  { CParams& p = *launder(kp); phase_final_norm(p.x, p.norm_final); }
}

extern "C" void kernel_launch(void* const* d_in, const int* in_sizes, int n_in, void* d_out, int out_size, void* d_ws,
                              size_t ws_size, hipStream_t stream) {
  (void)in_sizes; (void)n_in; (void)out_size;
  Params p{};
  p.x_in[0] = (const float*)d_in[0]; p.x_in[1] = (const float*)d_in[1];
  p.p_in[0] = (const float*)d_in[2]; p.p_in[1] = (const float*)d_in[3];
  p.norm_ff1 = (const float*)d_in[4]; p.ff1_w1 = (const float*)d_in[5]; p.ff1_w3 = (const float*)d_in[6];
  p.ff1_w2 = (const float*)d_in[7]; p.norm_mix = (const float*)d_in[8]; p.w_in = (const float*)d_in[9];
  p.mla_q_norm = (const float*)d_in[10]; p.mla_kv_norm = (const float*)d_in[11]; p.mla_w_uq = (const float*)d_in[12];
  p.mla_w_ukv = (const float*)d_in[13]; p.diff_lambda = (const float*)d_in[14]; p.diff_subln = (const float*)d_in[15];
  p.dn_conv = (const float*)d_in[16]; p.dn_a_log = (const float*)d_in[17]; p.dn_dt_bias = (const float*)d_in[18];
  p.dn_out_norm = (const float*)d_in[19]; p.w_branch = (const float*)d_in[20]; p.w_gate = (const float*)d_in[21];
  p.w_out = (const float*)d_in[22]; p.norm_ff2 = (const float*)d_in[23]; p.ff2_w1 = (const float*)d_in[24];
  p.ff2_w3 = (const float*)d_in[25]; p.ff2_w2 = (const float*)d_in[26]; p.norm_ple = (const float*)d_in[27];
  p.ple_gate = (const float*)d_in[28]; p.ple_proj = (const float*)d_in[29]; p.norm_final = (const float*)d_in[30];
  p.x = (float*)d_out;
  p.ws = (char*)d_ws;
  p.big_ws = (ws_size >= WS_BIG) ? 1 : 0;
  static int grid_blocks = 0;
  if (!grid_blocks) {
    int dev = 0, cus = 0, per_cu = 0;
    hipGetDevice(&dev);
    hipDeviceGetAttribute(&cus, hipDeviceAttributeMultiprocessorCount, dev);
    hipFuncSetAttribute((const void*)mega, hipFuncAttributeMaxDynamicSharedMemorySize, (int)LDS_BYTES);
    hipOccupancyMaxActiveBlocksPerMultiprocessor(&per_cu, mega, 256, LDS_BYTES);
    if (per_cu < 1) per_cu = 1;
    grid_blocks = cus * per_cu;
  }
  if (ws_size < WS_NEED) {
    fprintf(stderr, "workspace too small: %zu < %zu\n", ws_size, (size_t)WS_NEED);
    return;
  }
  (void)hipMemsetAsync((char*)d_ws + OFF_BAR, 0, XCD_BAR_WORDS * 4, stream);
  void* args[] = {&p};
  hipError_t e = hipLaunchCooperativeKernel((void*)mega, dim3(grid_blocks), dim3(256), args, LDS_BYTES, stream);
  if (e != hipSuccess) fprintf(stderr, "cooperative launch failed: %s (grid %d)\n", hipGetErrorString(e), grid_blocks);
}
```

```cpp
#include <hip/hip_runtime.h>
#include <hip/hip_cooperative_groups.h>
#include <stdint.h>
#include <stdio.h>
namespace cg = cooperative_groups;

typedef unsigned short bf16_t;
using bf16x8 = __attribute__((ext_vector_type(8))) short;
using bf16x4 = __attribute__((ext_vector_type(4))) short;
using f32x16 = __attribute__((ext_vector_type(16))) float;
using f32x4 = __attribute__((ext_vector_type(4))) float;
using u32x4 = __attribute__((ext_vector_type(4))) unsigned;
using u32x2 = __attribute__((ext_vector_type(2))) unsigned;

#define DI __device__ __forceinline__
#define MFMA32(a, b, c) __builtin_amdgcn_mfma_f32_32x32x16_bf16((a), (b), (c), 0, 0, 0)
#define MFMA16(a, b, c) __builtin_amdgcn_mfma_f32_16x16x32_bf16((a), (b), (c), 0, 0, 0)

constexpr int TG = 32768;
constexpr int NPR = 4608;
constexpr float EPS = 1e-6f;
constexpr float LOG2E = 1.4426950408889634f;
constexpr int C_CQ = 0, C_CKV = 256, C_BQ = 384, C_BK = 640, C_BV = 896, C_DNQKV = 1152, C_Z = 1920,
              C_DQ = 2176, C_DK = 2944, C_DV = 3712;
constexpr size_t MiB = 1048576;
constexpr size_t OFF_WB = 0, OFF_TAB = 57 * MiB, OFF_CNT = 63 * MiB, OFF_N = 64 * MiB, OFF_PR = 128 * MiB,
                 OFF_Q = 416 * MiB, OFF_K = 440 * MiB, OFF_V = 464 * MiB, OFF_AB = 480 * MiB, OFF_OD = 482 * MiB,
                 OFF_LSE = 530 * MiB, OFF_OF = 532 * MiB, OFF_OB = 548 * MiB, WS_NEED = 564 * MiB;
constexpr size_t W_FF1_1 = 0, W_FF1_3 = 2883584, W_FF1_2 = 5767168, W_IN = 8650752, W_UQ = 13369344,
                 W_UKV = 13467648, W_G = 13533184, W_B = 17727488, W_O = 18776064, W_FF2_1 = 19824640,
                 W_FF2_3 = 22708224, W_FF2_2 = 25591808, W_PG = 28475392, W_PP = 29523968;
constexpr size_t LDS_BYTES = 78336;

struct Params {
  const float* x_in[2];
  const float* p_in[2];
  const float *norm_ff1, *ff1_w1, *ff1_w3, *ff1_w2, *norm_mix, *w_in, *mla_q_norm, *mla_kv_norm, *mla_w_uq,
      *mla_w_ukv, *diff_lambda, *diff_subln, *dn_conv, *dn_a_log, *dn_dt_bias, *dn_out_norm, *w_branch, *w_gate,
      *w_out, *norm_ff2, *ff2_w1, *ff2_w3, *ff2_w2, *norm_ple, *ple_gate, *ple_proj, *norm_final;
  float* x;
  char* ws;
  long long big_ws;
};

typedef const __attribute__((address_space(4))) Params CParams;
DI CParams* launder(CParams* q) { asm volatile("" : "+s"(q)); return q; }

typedef __bf16 bf2_t __attribute__((ext_vector_type(2)));
typedef float f2_t __attribute__((ext_vector_type(2)));
DI bf16_t f2bf(float x) { return __builtin_bit_cast(bf16_t, (__bf16)x); }
DI float bf2f(bf16_t b) { return __uint_as_float(((unsigned)b) << 16); }
DI unsigned pack2(float a, float b) { f2_t v = {a, b}; return __builtin_bit_cast(unsigned, __builtin_convertvector(v, bf2_t)); }
DI float wave_sum(float v) {
#pragma unroll
  for (int o = 32; o > 0; o >>= 1) v += __shfl_xor(v, o);
  return v;
}
DI float sigmoidf_(float x) { return __builtin_amdgcn_rcpf(1.f + __expf(-x)); }
DI float siluf_(float x) { return x * __builtin_amdgcn_rcpf(1.f + __expf(-x)); }
DI float exp2_(float x) { return __builtin_amdgcn_exp2f(x); }
DI int opq() { int z; asm volatile("v_mov_b32 %0, 0" : "=v"(z)); return z; }
DI float xhalf_max(float v) {
  const auto r = __builtin_amdgcn_permlane32_swap(__float_as_uint(v), __float_as_uint(v), false, false);
  return fmaxf(__uint_as_float(r[0]), __uint_as_float(r[1]));
}
DI int crow(int r, int h2) { return (r & 3) + 8 * (r >> 2) + 4 * h2; }
DI bf16x8 pack8(float a0, float a1, float a2, float a3, float a4, float a5, float a6, float a7) {
  u32x4 u;
  u.x = pack2(a0, a1); u.y = pack2(a2, a3); u.z = pack2(a4, a5); u.w = pack2(a6, a7);
  return __builtin_bit_cast(bf16x8, u);
}
DI bf16x8 ld2x4(const bf16_t* p0, const bf16_t* p1) {
  u32x2 a = *(const u32x2*)p0, b = *(const u32x2*)p1;
  u32x4 u; u.x = a.x; u.y = a.y; u.z = b.x; u.w = b.y;
  return __builtin_bit_cast(bf16x8, u);
}
DI void store8bf(bf16_t* dst, const float* v) {
  u32x4 u; u.x = pack2(v[0], v[1]); u.y = pack2(v[2], v[3]); u.z = pack2(v[4], v[5]); u.w = pack2(v[6], v[7]);
  *(u32x4*)dst = u;
}

struct MatDesc { const float* src; bf16_t* dst; int K, ldsrc, Ndst, map; const float* rowscale; };

DI int map_col(int map, int n) {
  if (map == 0) return n;
  if (map == 1) {
    if (n < 384) return n;
    if (n < 1920) return n + 32;
    if (n < 4480) return n + 48;
    if (n < 4512) return n - 4480 + 384;
    if (n < 4528) return n - 4512 + 1952;
    return -1;
  }
  if (n < 256) return (n >> 6) * 96 + (n & 63);
  return ((n - 256) >> 5) * 96 + 64 + ((n - 256) & 31);
}

DI MatDesc get_mat(CParams& p, int l, int id) {
  bf16_t* wb = (bf16_t*)(p.ws + OFF_WB);
  MatDesc d; d.map = 0; d.rowscale = nullptr;
  const size_t FF = (size_t)1024 * 2816;
  switch (id) {
    case 0: d.src = p.ff1_w1 + l * FF; d.dst = wb + W_FF1_1; d.K = 1024; d.ldsrc = 2816; d.Ndst = 2816; break;
    case 1: d.src = p.ff1_w3 + l * FF; d.dst = wb + W_FF1_3; d.K = 1024; d.ldsrc = 2816; d.Ndst = 2816; break;
    case 2: d.src = p.ff1_w2 + l * FF; d.dst = wb + W_FF1_2; d.K = 2816; d.ldsrc = 1024; d.Ndst = 1024; break;
    case 3: d.src = p.w_in + (size_t)l * 1024 * 4528; d.dst = wb + W_IN; d.K = 1024; d.ldsrc = 4528; d.Ndst = 4608; d.map = 1; break;
    case 4: d.src = p.mla_w_uq + (size_t)l * 256 * 384; d.dst = wb + W_UQ; d.K = 256; d.ldsrc = 384; d.Ndst = 384; d.map = 2; d.rowscale = p.mla_q_norm + l * 256; break;
    case 5: d.src = p.mla_w_ukv + (size_t)l * 128 * 512; d.dst = wb + W_UKV; d.K = 128; d.ldsrc = 512; d.Ndst = 512; d.rowscale = p.mla_kv_norm + l * 128; break;
    case 6: case 7: case 8: case 9:
      d.src = p.w_gate + (size_t)(l * 4 + id - 6) * 1048576; d.dst = wb + W_G + (size_t)(id - 6) * 1048576; d.K = 1024; d.ldsrc = 1024; d.Ndst = 1024; break;
    case 10: case 11: case 12: case 13:
      d.src = p.w_branch + (size_t)(l * 4 + id - 10) * 262144; d.dst = wb + W_B + (size_t)(id - 10) * 262144; d.K = 256; d.ldsrc = 1024; d.Ndst = 1024; break;
    case 14: d.src = p.w_out + (size_t)l * 1048576; d.dst = wb + W_O; d.K = 1024; d.ldsrc = 1024; d.Ndst = 1024; break;
    case 15: d.src = p.ff2_w1 + l * FF; d.dst = wb + W_FF2_1; d.K = 1024; d.ldsrc = 2816; d.Ndst = 2816; break;
    case 16: d.src = p.ff2_w3 + l * FF; d.dst = wb + W_FF2_3; d.K = 1024; d.ldsrc = 2816; d.Ndst = 2816; break;
    case 17: d.src = p.ff2_w2 + l * FF; d.dst = wb + W_FF2_2; d.K = 2816; d.ldsrc = 1024; d.Ndst = 1024; break;
    case 18: d.src = p.ple_gate + (size_t)l * 1048576; d.dst = wb + W_PG; d.K = 1024; d.ldsrc = 1024; d.Ndst = 1024; break;
    default: d.src = p.ple_proj + (size_t)l * 262144; d.dst = wb + W_PP; d.K = 256; d.ldsrc = 1024; d.Ndst = 1024; break;
  }
  return d;
}

DI void phase_convert(CParams& p, int l, char* lds) {
  float* T = (float*)lds;
  const int tid = threadIdx.x + opq();
  for (int id = 0; id < 20; ++id) {
    MatDesc d = get_mat(p, l, id);
    const int nkt = d.K >> 6, nnt = d.Ndst >> 6, nt_all = nkt * nnt;
    for (int t = blockIdx.x; t < nt_all; t += gridDim.x) {
      const int kt = t / nnt, nt = t % nnt;
      __syncthreads();
      {
        const int nl = tid & 63;
        const int sc = map_col(d.map, nt * 64 + nl);
#pragma unroll 4
        for (int i = 0; i < 16; ++i) {
          const int kl = (tid >> 6) + 4 * i;
          const int k = kt * 64 + kl;
          float v = 0.f;
          if (sc >= 0) v = d.src[(size_t)k * d.ldsrc + sc];
          if (d.rowscale) v *= d.rowscale[k];
          T[kl * 65 + nl] = v;
        }
      }
      __syncthreads();
      {
        const int kl = tid & 63;
#pragma unroll 4
        for (int i = 0; i < 16; ++i) {
          const int nl = (tid >> 6) + 4 * i;
          d.dst[(size_t)(nt * 64 + nl) * d.K + kt * 64 + kl] = f2bf(T[kl * 65 + nl]);
        }
      }
    }
  }
}

DI void phase_init(CParams& p, char* lds) {
  const size_t gtid = (size_t)blockIdx.x * 256 + threadIdx.x + opq(), gn = (size_t)gridDim.x * 256;
  {
    float2* t32 = (float2*)(p.ws + OFF_TAB);
    float2* t64 = (float2*)(p.ws + OFF_TAB + 2 * MiB);
    for (size_t i = gtid; i < (size_t)16384 * 48; i += gn) {
      const int pos = (int)(i / 48), f = (int)(i % 48);
      float inv;
      if (f < 16) inv = exp2f(-(float)f * (13.287712379549449f / 16.f));
      else inv = exp2f(-(float)(f - 16) * (13.287712379549449f / 32.f));
      const float ang = (float)pos * inv;
      const double xd = (double)ang;
      const double n = rint(xd * 0.15915494309189535);
      const float rf = (float)(xd - n * 6.283185307179586);
      float2 cs; cs.x = __cosf(rf); cs.y = __sinf(rf);
      if (f < 16) t32[(size_t)pos * 16 + f] = cs; else t64[(size_t)pos * 32 + (f - 16)] = cs;
    }
  }
  if (blockIdx.x == 0) ((int*)(p.ws + OFF_CNT))[threadIdx.x] = 0;
  phase_convert(p, 0, lds);
}

DI void phase_norm(const float* __restrict__ x, const float* __restrict__ g, bf16_t* __restrict__ dst,
                           const float* __restrict__ psrc, bf16_t* __restrict__ pdst) {
  const int tidq = threadIdx.x + opq(); const int wave = tidq >> 6, lane = tidq & 63;
  for (int r = blockIdx.x * 4 + wave; r < TG; r += gridDim.x * 4) {
    const float4* xr = (const float4*)(x + (size_t)r * 1024);
    float4 v[4];
    float ss = 0.f;
#pragma unroll
    for (int i = 0; i < 4; ++i) { v[i] = xr[lane + 64 * i]; ss += v[i].x * v[i].x + v[i].y * v[i].y + v[i].z * v[i].z + v[i].w * v[i].w; }
    ss = wave_sum(ss);
    const float rs = rsqrtf(ss * (1.f / 1024.f) + EPS);
#pragma unroll
    for (int i = 0; i < 4; ++i) {
      const float4 gg = ((const float4*)g)[lane + 64 * i];
      u32x2 o; o.x = pack2(v[i].x * rs * gg.x, v[i].y * rs * gg.y); o.y = pack2(v[i].z * rs * gg.z, v[i].w * rs * gg.w);
      ((u32x2*)(dst + (size_t)r * 1024))[lane + 64 * i] = o;
    }
    if (psrc) {
      const float4 pv = ((const float4*)(psrc + (size_t)r * 256))[lane];
      u32x2 o; o.x = pack2(pv.x, pv.y); o.y = pack2(pv.z, pv.w);
      ((u32x2*)(pdst + (size_t)r * 256))[lane] = o;
    }
  }
}

DI void phase_final_norm(float* __restrict__ x, const float* __restrict__ g) {
  const int tidq = threadIdx.x + opq(); const int wave = tidq >> 6, lane = tidq & 63;
  for (int r = blockIdx.x * 4 + wave; r < 2 * TG; r += gridDim.x * 4) {
    float4* xr = (float4*)(x + (size_t)r * 1024);
    float4 v[4];
    float ss = 0.f;
#pragma unroll
    for (int i = 0; i < 4; ++i) { v[i] = xr[lane + 64 * i]; ss += v[i].x * v[i].x + v[i].y * v[i].y + v[i].z * v[i].z + v[i].w * v[i].w; }
    ss = wave_sum(ss);
    const float rs = rsqrtf(ss * (1.f / 1024.f) + EPS);
#pragma unroll
    for (int i = 0; i < 4; ++i) {
      const float4 gg = ((const float4*)g)[lane + 64 * i];
      float4 o; o.x = v[i].x * rs * gg.x; o.y = v[i].y * rs * gg.y; o.z = v[i].z * rs * gg.z; o.w = v[i].w * rs * gg.w;
      xr[lane + 64 * i] = o;
    }
  }
}

template <int NI, int NB, bool SWAP = false>
DI void gemm_main(f32x16 (&acc0)[2][NI], f32x16 (&acc1)[2][NI], const bf16_t* __restrict__ A, int lda,
                  const bf16_t* __restrict__ B0, const bf16_t* __restrict__ B1, int ldb, int K, char* lds) {
  const int tid = threadIdx.x + opq(), lane = tid & 63, w = tid >> 6, wm = w >> 1, wn = w & 1, l31 = lane & 31, h2 = lane >> 5;
  bf16_t* As = (bf16_t*)lds;
  bf16_t* B0s = As + 128 * 72;
  bf16_t* B1s = B0s + 64 * NI * 72;
  const int lr = tid >> 3, lc = (tid & 7) * 8;
  u32x4 ra[4], rb0[2 * NI], rb1[2 * NI];
  const bf16_t* ap = A + (size_t)lr * lda + lc;
  const bf16_t* bp0 = B0 + (size_t)lr * ldb + lc;
  const bf16_t* bp1 = (NB == 2) ? (B1 + (size_t)lr * ldb + lc) : B0;
#pragma unroll
  for (int i = 0; i < 4; ++i) ra[i] = *(const u32x4*)(ap + (size_t)(32 * i) * lda);
#pragma unroll
  for (int i = 0; i < 2 * NI; ++i) {
    rb0[i] = *(const u32x4*)(bp0 + (size_t)(32 * i) * ldb);
    if (NB == 2) rb1[i] = *(const u32x4*)(bp1 + (size_t)(32 * i) * ldb);
  }
  for (int k0 = 0; k0 < K; k0 += 64) {
    __syncthreads();
#pragma unroll
    for (int i = 0; i < 4; ++i) *(u32x4*)(As + (lr + 32 * i) * 72 + lc) = ra[i];
#pragma unroll
    for (int i = 0; i < 2 * NI; ++i) {
      *(u32x4*)(B0s + (lr + 32 * i) * 72 + lc) = rb0[i];
      if (NB == 2) *(u32x4*)(B1s + (lr + 32 * i) * 72 + lc) = rb1[i];
    }
    if (k0 + 64 < K) {
      const int kn = k0 + 64;
#pragma unroll
      for (int i = 0; i < 4; ++i) ra[i] = *(const u32x4*)(ap + (size_t)(32 * i) * lda + kn);
#pragma unroll
      for (int i = 0; i < 2 * NI; ++i) {
        rb0[i] = *(const u32x4*)(bp0 + (size_t)(32 * i) * ldb + kn);
        if (NB == 2) rb1[i] = *(const u32x4*)(bp1 + (size_t)(32 * i) * ldb + kn);
      }
    }
    __syncthreads();
    __builtin_amdgcn_s_setprio(1);
#pragma unroll
    for (int ks = 0; ks < 4; ++ks) {
      bf16x8 af[2], bf0[NI], bf1[NI];
#pragma unroll
      for (int mi = 0; mi < 2; ++mi) af[mi] = *(const bf16x8*)(As + (64 * wm + 32 * mi + l31) * 72 + 16 * ks + 8 * h2);
#pragma unroll
      for (int ni = 0; ni < NI; ++ni) {
        bf0[ni] = *(const bf16x8*)(B0s + (32 * NI * wn + 32 * ni + l31) * 72 + 16 * ks + 8 * h2);
        if (NB == 2) bf1[ni] = *(const bf16x8*)(B1s + (32 * NI * wn + 32 * ni + l31) * 72 + 16 * ks + 8 * h2);
      }
#pragma unroll
      for (int mi = 0; mi < 2; ++mi)
#pragma unroll
        for (int ni = 0; ni < NI; ++ni) {
          acc0[mi][ni] = SWAP ? MFMA32(bf0[ni], af[mi], acc0[mi][ni]) : MFMA32(af[mi], bf0[ni], acc0[mi][ni]);
          if (NB == 2) acc1[mi][ni] = SWAP ? MFMA32(bf1[ni], af[mi], acc1[mi][ni]) : MFMA32(af[mi], bf1[ni], acc1[mi][ni]);
        }
    }
    __builtin_amdgcn_s_setprio(0);
  }
}

template <int NI>
DI void zero_acc(f32x16 (&a)[2][NI]) {
#pragma unroll
  for (int mi = 0; mi < 2; ++mi)
#pragma unroll
    for (int ni = 0; ni < NI; ++ni)
#pragma unroll
      for (int r = 0; r < 16; ++r) a[mi][ni][r] = 0.f;
}

#define EPI_VARS const int tid = threadIdx.x + opq(), lane = tid & 63, w = tid >> 6, wm = w >> 1, wn = w & 1, l31 = lane & 31, h2 = lane >> 5; (void)tid; (void)lane; (void)w
#define EPI_BEGIN(NI_) _Pragma("unroll") for (int mi = 0; mi < 2; ++mi) _Pragma("unroll") for (int ni = 0; ni < NI_; ++ni) _Pragma("unroll") for (int r = 0; r < 16; ++r) { \
    const int row = 64 * wm + 32 * mi + crow(r, h2); const int col = 32 * NI_ * wn + 32 * ni + l31;
#define EPI_END }

DI bool xcd_tile(int iter, int MT, int NT, int& mt, int& nt) {
  const int x = blockIdx.x & 7, lb = blockIdx.x >> 3, nb = gridDim.x >> 3;
  if (NT == 8) {
    const int j = lb + iter * nb;
    if (lb >= nb || j >= MT) return false;
    mt = (x & 1) * (MT >> 1) + (j >> 1);
    nt = 2 * (x >> 1) + (j & 1);
    return true;
  }
  const int full = NT >> 3, rem = NT & 7;
  const int per_full = full * MT, rem_tot = rem * MT;
  const int r0 = (rem_tot * x) >> 3, r1 = (rem_tot * (x + 1)) >> 3;
  const int j = lb + iter * nb;
  if (lb >= nb || j >= per_full + (r1 - r0)) return false;
  if (j < per_full) { mt = j / full; nt = x * full + j % full; }
  else { const int u = r0 + (j - per_full); nt = 8 * full + u / MT; mt = u % MT; }
  return true;
}

DI void phase_ffn_a(const bf16_t* __restrict__ Nb, const bf16_t* __restrict__ W1, const bf16_t* __restrict__ W3,
                            bf16_t* __restrict__ H, char* lds) {
  EPI_VARS;
  for (int iter = 0;; ++iter) {
    int mt, nt;
    if (!xcd_tile(iter, 256, 22, mt, nt)) break;
    f32x16 a0[2][2], a1[2][2];
    zero_acc<2>(a0); zero_acc<2>(a1);
    gemm_main<2, 2, true>(a0, a1, Nb + (size_t)mt * 128 * 1024, 1024, W1 + (size_t)nt * 128 * 1024, W3 + (size_t)nt * 128 * 1024, 1024, 1024, lds);
#pragma unroll
    for (int mi = 0; mi < 2; ++mi)
#pragma unroll
      for (int ni = 0; ni < 2; ++ni) {
        bf16_t* hp = H + (size_t)(mt * 128 + 64 * wm + 32 * mi + l31) * 2816 + nt * 128 + 64 * wn + 32 * ni + 4 * h2;
#pragma unroll
        for (int g = 0; g < 4; ++g) {
          u32x2 o;
          o.x = pack2(siluf_(a0[mi][ni][4 * g]) * a1[mi][ni][4 * g], siluf_(a0[mi][ni][4 * g + 1]) * a1[mi][ni][4 * g + 1]);
          o.y = pack2(siluf_(a0[mi][ni][4 * g + 2]) * a1[mi][ni][4 * g + 2], siluf_(a0[mi][ni][4 * g + 3]) * a1[mi][ni][4 * g + 3]);
          *(u32x2*)(hp + 8 * g) = o;
        }
      }
  }
}

DI void phase_gemm_resid(const bf16_t* __restrict__ A, int K, const bf16_t* __restrict__ Bt, const float* xsrc, float* x,
                                 float scale, char* lds) {
  EPI_VARS;
  for (int iter = 0;; ++iter) {
    int mt, nt;
    if (!xcd_tile(iter, 256, 4, mt, nt)) break;
    f32x16 a0[2][4];
    zero_acc<4>(a0);
    gemm_main<4, 1, true>(a0, a0, A + (size_t)mt * 128 * K, K, Bt + (size_t)nt * 256 * K, nullptr, K, K, lds);
#pragma unroll
    for (int mi = 0; mi < 2; ++mi)
#pragma unroll
      for (int ni = 0; ni < 4; ++ni) {
        float4 xs[4];
        const size_t base = (size_t)(mt * 128 + 64 * wm + 32 * mi + l31) * 1024 + nt * 256 + 128 * wn + 32 * ni + 4 * h2;
#pragma unroll
        for (int g = 0; g < 4; ++g) xs[g] = *(const float4*)(xsrc + base + 8 * g);
#pragma unroll
        for (int g = 0; g < 4; ++g) {
          float4 o;
          o.x = xs[g].x + scale * a0[mi][ni][4 * g];
          o.y = xs[g].y + scale * a0[mi][ni][4 * g + 1];
          o.z = xs[g].z + scale * a0[mi][ni][4 * g + 2];
          o.w = xs[g].w + scale * a0[mi][ni][4 * g + 3];
          *(float4*)(x + base + 8 * g) = o;
        }
      }
  }
}

DI void phase_ple(const bf16_t* __restrict__ Nb, const bf16_t* __restrict__ PB, const bf16_t* __restrict__ PG,
                          const bf16_t* __restrict__ PP, float* __restrict__ x, char* lds) {
  EPI_VARS;
  for (int iter = 0;; ++iter) {
    int mt, nt;
    if (!xcd_tile(iter, 256, 8, mt, nt)) break;
    f32x16 a0[2][2], a1[2][2];
    zero_acc<2>(a0); zero_acc<2>(a1);
    gemm_main<2, 1, true>(a0, a0, Nb + (size_t)mt * 128 * 1024, 1024, PG + (size_t)nt * 128 * 1024, nullptr, 1024, 1024, lds);
    gemm_main<2, 1, true>(a1, a1, PB + (size_t)mt * 128 * 256, 256, PP + (size_t)nt * 128 * 256, nullptr, 256, 256, lds);
#pragma unroll
    for (int mi = 0; mi < 2; ++mi)
#pragma unroll
      for (int ni = 0; ni < 2; ++ni) {
        float* xp = x + (size_t)(mt * 128 + 64 * wm + 32 * mi + l31) * 1024 + nt * 128 + 64 * wn + 32 * ni + 4 * h2;
        float4 xs[4];
#pragma unroll
        for (int g = 0; g < 4; ++g) xs[g] = *(const float4*)(xp + 8 * g);
#pragma unroll
        for (int g = 0; g < 4; ++g) {
          float4 o;
          o.x = xs[g].x + sigmoidf_(a0[mi][ni][4 * g]) * a1[mi][ni][4 * g];
          o.y = xs[g].y + sigmoidf_(a0[mi][ni][4 * g + 1]) * a1[mi][ni][4 * g + 1];
          o.z = xs[g].z + sigmoidf_(a0[mi][ni][4 * g + 2]) * a1[mi][ni][4 * g + 2];
          o.w = xs[g].w + sigmoidf_(a0[mi][ni][4 * g + 3]) * a1[mi][ni][4 * g + 3];
          *(float4*)(xp + 8 * g) = o;
        }
      }
  }
}

DI void phase_merge(const bf16_t* __restrict__ Np, const bf16_t* __restrict__ Y, const bf16_t* __restrict__ WG,
                            const bf16_t* __restrict__ WB, bf16_t* __restrict__ M, char* lds) {
  EPI_VARS;
  for (int iter = 0;; ++iter) {
    int mt, nt;
    if (!xcd_tile(iter, 256, 8, mt, nt)) break;
    f32x16 am[2][2];
    zero_acc<2>(am);
#pragma unroll 1
    for (int n = 0; n < 4; ++n) {
      unsigned sg[2][2][8];
      {
        f32x16 ag[2][2];
        zero_acc<2>(ag);
        gemm_main<2, 1, true>(ag, ag, Np + (size_t)mt * 128 * 1024, 1024, WG + (size_t)n * 1048576 + (size_t)nt * 128 * 1024, nullptr, 1024, 1024, lds);
#pragma unroll
        for (int mi = 0; mi < 2; ++mi)
#pragma unroll
          for (int ni = 0; ni < 2; ++ni)
#pragma unroll
            for (int r = 0; r < 8; ++r) sg[mi][ni][r] = pack2(sigmoidf_(ag[mi][ni][2 * r]), sigmoidf_(ag[mi][ni][2 * r + 1]));
      }
      f32x16 ab[2][2];
      zero_acc<2>(ab);
      gemm_main<2, 1, true>(ab, ab, Y + (size_t)mt * 128 * 1024 + n * 256, 1024, WB + (size_t)n * 262144 + (size_t)nt * 128 * 256, nullptr, 256, 256, lds);
#pragma unroll
      for (int mi = 0; mi < 2; ++mi)
#pragma unroll
        for (int ni = 0; ni < 2; ++ni)
#pragma unroll
          for (int r = 0; r < 8; ++r) {
            am[mi][ni][2 * r] += __uint_as_float(sg[mi][ni][r] << 16) * ab[mi][ni][2 * r];
            am[mi][ni][2 * r + 1] += __uint_as_float(sg[mi][ni][r] & 0xffff0000u) * ab[mi][ni][2 * r + 1];
          }
    }
#pragma unroll
    for (int mi = 0; mi < 2; ++mi)
#pragma unroll
      for (int ni = 0; ni < 2; ++ni) {
        bf16_t* mp = M + (size_t)(mt * 128 + 64 * wm + 32 * mi + l31) * 1024 + nt * 128 + 64 * wn + 32 * ni + 4 * h2;
#pragma unroll
        for (int g = 0; g < 4; ++g) {
          u32x2 o;
          o.x = pack2(am[mi][ni][4 * g], am[mi][ni][4 * g + 1]);
          o.y = pack2(am[mi][ni][4 * g + 2], am[mi][ni][4 * g + 3]);
          *(u32x2*)(mp + 8 * g) = o;
        }
      }
  }
}

DI void rope32_out(const float* c, const float2* tab, float sc, float* o) {
#pragma unroll
  for (int i = 0; i < 16; ++i) {
    const float2 cs = tab[i];
    const float a = c[i], b = c[16 + i];
    o[i] = (a * cs.x - b * cs.y) * sc;
    o[16 + i] = (b * cs.x + a * cs.y) * sc;
  }
}

DI void phase_proj(CParams& p, const bf16_t* __restrict__ Nb, const bf16_t* __restrict__ WIN, int S, char* lds) {
  EPI_VARS;
  bf16_t* PR = (bf16_t*)(p.ws + OFF_PR);
  float* AB = (float*)(p.ws + OFF_AB);
  const float2* t32 = (const float2*)(p.ws + OFF_TAB);
  const float2* t64 = (const float2*)(p.ws + OFF_TAB + 2 * MiB);
  float* Ct = (float*)lds;
  for (int iter = 0;; ++iter) {
    int mt, nt2;
    if (!xcd_tile(iter, 256, 18, mt, nt2)) break;
    f32x16 a0[2][4];
    zero_acc<4>(a0);
    gemm_main<4, 1>(a0, a0, Nb + (size_t)mt * 128 * 1024, 1024, WIN + (size_t)nt2 * 256 * 1024, nullptr, 1024, 1024, lds);
   for (int hv = 0; hv < 2; ++hv) {
    const int nt = 2 * nt2 + hv;
    __syncthreads();
    if (wn == hv) {
#pragma unroll
      for (int mi = 0; mi < 2; ++mi)
#pragma unroll
        for (int ni = 0; ni < 4; ++ni)
#pragma unroll
          for (int r = 0; r < 16; ++r) Ct[(64 * wm + 32 * mi + crow(r, h2)) * 132 + 32 * ni + l31] = a0[mi][ni][r];
    }
    __syncthreads();
    const int erow = tid >> 1, half = tid & 1;
    const int tok = mt * 128 + erow, pos = tok & (S - 1);
    const float* cr = Ct + erow * 132 + 64 * half;
    bf16_t* dst = PR + (size_t)tok * NPR + nt * 128 + 64 * half;
    int type = 0; float sc = 1.f;
    if (nt == 3 || nt == 4) { type = 1; sc = 0.17677669529663687f * LOG2E; }
    else if (nt == 5 || nt == 6) { type = 1; }
    else if (nt >= 17 && nt <= 22) { type = 2; sc = 0.125f * LOG2E; }
    else if (nt >= 23 && nt <= 28) { type = 2; }
    else if (nt == 35) type = 3;
    if (type == 0) {
#pragma unroll
      for (int j = 0; j < 8; ++j) store8bf(dst + 8 * j, cr + 8 * j);
    } else if (type == 1) {
#pragma unroll
      for (int hh = 0; hh < 2; ++hh) {
        float o[32];
        rope32_out(cr + 32 * hh, t32 + (size_t)pos * 16, sc, o);
#pragma unroll
        for (int j = 0; j < 4; ++j) store8bf(dst + 32 * hh + 8 * j, o + 8 * j);
      }
    } else if (type == 2) {
      const float2* tab = t64 + (size_t)pos * 32;
#pragma unroll
      for (int j = 0; j < 4; ++j) {
        float lo[8], hi[8];
#pragma unroll
        for (int e = 0; e < 8; ++e) {
          const float2 cs = tab[8 * j + e];
          const float a = cr[8 * j + e], b = cr[32 + 8 * j + e];
          lo[e] = (a * cs.x - b * cs.y) * sc;
          hi[e] = (b * cs.x + a * cs.y) * sc;
        }
        store8bf(dst + 8 * j, lo);
        store8bf(dst + 32 + 8 * j, hi);
      }
    } else {
      if (half == 0) {
        float o[32];
        rope32_out(cr, t32 + (size_t)pos * 16, 1.f, o);
#pragma unroll
        for (int j = 0; j < 4; ++j) store8bf(dst + 8 * j, o + 8 * j);
      } else {
        const float* c2 = Ct + erow * 132 + 32;
#pragma unroll
        for (int j = 0; j < 4; ++j) {
          float4 v; v.x = c2[4 * j]; v.y = c2[4 * j + 1]; v.z = c2[4 * j + 2]; v.w = c2[4 * j + 3];
          ((float4*)(AB + (size_t)tok * 16))[j] = v;
        }
      }
    }
   }
  }
}

DI void mla_up_tile(CParams& p, int mt, int j, int S, char* lds) {
  EPI_VARS;
  const bf16_t* PR = (const bf16_t*)(p.ws + OFF_PR);
  const bf16_t* wb = (const bf16_t*)(p.ws + OFF_WB);
  bf16_t* Qb = (bf16_t*)(p.ws + OFF_Q);
  bf16_t* Kb = (bf16_t*)(p.ws + OFF_K);
  bf16_t* Vb = (bf16_t*)(p.ws + OFF_V);
  const float2* t32 = (const float2*)(p.ws + OFF_TAB);
  float* Ct = (float*)lds;
  float* rst = (float*)(lds + 67584);
  const bool isq = j < 3;
  const int K = isq ? 256 : 128;
  const int nt = isq ? j : j - 3;
  const bf16_t* A = PR + (size_t)mt * 128 * NPR + (isq ? C_CQ : C_CKV);
  const bf16_t* B = wb + (isq ? W_UQ : W_UKV) + (size_t)nt * 128 * K;
  const int erow = tid >> 1, half = tid & 1;
  {
    const bf16_t* ar = A + (size_t)erow * NPR + half * (K / 2);
    float ss = 0.f;
    for (int c = 0; c < K / 16; ++c) {
      const u32x4 u = *(const u32x4*)(ar + 8 * c);
      const unsigned uu[4] = {u.x, u.y, u.z, u.w};
#pragma unroll
      for (int e = 0; e < 4; ++e) {
        const float lo = __uint_as_float(uu[e] << 16), hi = __uint_as_float(uu[e] & 0xffff0000u);
        ss += lo * lo + hi * hi;
      }
    }
    ss += __shfl_xor(ss, 1);
    if (half == 0) rst[erow] = rsqrtf(ss / (float)K + EPS);
  }
  f32x16 a0[2][2];
  zero_acc<2>(a0);
  gemm_main<2, 1>(a0, a0, A, NPR, B, nullptr, K, K, lds);
  __syncthreads();
  EPI_BEGIN(2)
    Ct[row * 132 + col] = a0[mi][ni][r];
  EPI_END
  __syncthreads();
  const int tok = mt * 128 + erow, pos = tok & (S - 1);
  const float rs = rst[erow];
  const float* cr = Ct + erow * 132 + 64 * half;
  if (isq) {
    const float sc = rs * 0.10206207261596577f * LOG2E;
    if (nt < 2) {
      bf16_t* dst = Qb + ((size_t)tok * 4 + 2 * nt + half) * 96;
#pragma unroll
      for (int jj = 0; jj < 8; ++jj) {
        float o[8];
#pragma unroll
        for (int e = 0; e < 8; ++e) o[e] = cr[8 * jj + e] * sc;
        store8bf(dst + 8 * jj, o);
      }
    } else {
#pragma unroll
      for (int hh = 0; hh < 2; ++hh) {
        float o[32];
        rope32_out(cr + 32 * hh, t32 + (size_t)pos * 16, sc, o);
        bf16_t* dst = Qb + ((size_t)tok * 4 + 2 * half + hh) * 96 + 64;
#pragma unroll
        for (int jj = 0; jj < 4; ++jj) store8bf(dst + 8 * jj, o + 8 * jj);
      }
    }
  } else {
    bf16_t* dst = half == 0 ? (Kb + ((size_t)tok * 4 + nt) * 96) : (Vb + ((size_t)tok * 4 + nt) * 64);
#pragma unroll
    for (int jj = 0; jj < 8; ++jj) {
      float o[8];
#pragma unroll
      for (int e = 0; e < 8; ++e) o[e] = cr[8 * jj + e] * rs;
      store8bf(dst + 8 * jj, o);
    }
    if (half == 0) {
      const u32x4* src = (const u32x4*)(PR + (size_t)tok * NPR + 4480);
#pragma unroll
      for (int jj = 0; jj < 4; ++jj) ((u32x4*)(dst + 64))[jj] = src[jj];
    }
  }
}

typedef short s16x4_t __attribute__((ext_vector_type(4)));
DI bf16x8 tr_pair(const bf16_t* p0, const bf16_t* p1) {
  const s16x4_t lo = __builtin_amdgcn_ds_read_tr16_b64_v4i16((__attribute__((address_space(3))) s16x4_t*)p0);
  const s16x4_t hi = __builtin_amdgcn_ds_read_tr16_b64_v4i16((__attribute__((address_space(3))) s16x4_t*)p1);
  return __builtin_shufflevector(lo, hi, 0, 1, 2, 3, 4, 5, 6, 7);
}

template <int DK, bool BAND>
DI void flash_loop(f32x16 (&O)[2], float& m, float& l, const bf16_t* __restrict__ qrow, const bf16_t* __restrict__ kbase,
                   size_t kstride, const bf16_t* __restrict__ vbase, size_t vstride, int ntiles, int tq, int u0, int L,
                   char* lds) {
  const int tid = threadIdx.x + opq(), lane = tid & 63, l31 = lane & 31, h2 = lane >> 5;
  constexpr int KR = DK + 8, KCH = DK / 8, KN = 64 * KCH / 256;
  constexpr int STAGE = 64 * KR * 2 + 64 * 72 * 2;
  bf16x8 qf[DK / 16];
#pragma unroll
  for (int ks = 0; ks < DK / 16; ++ks) qf[ks] = *(const bf16x8*)(qrow + 16 * ks + 8 * h2);
  u32x4 rkA[KN], rvA[2], rkB[KN], rvB[2];
  auto gload = [&](int kt, u32x4 (&rk)[KN], u32x4 (&rv)[2]) {
#pragma unroll
    for (int i = 0; i < KN; ++i) {
      const int ci = tid + 256 * i, row = ci / KCH, c = ci % KCH;
      int rr = u0 + 64 * kt + row;
      if (BAND) rr = min(max(rr, 0), L - 1);
      rk[i] = *(const u32x4*)(kbase + (size_t)rr * kstride + c * 8);
    }
#pragma unroll
    for (int i = 0; i < 2; ++i) {
      const int ci = tid + 256 * i, row = ci >> 3, c = ci & 7;
      int rr = u0 + 64 * kt + row;
      if (BAND) rr = min(max(rr, 0), L - 1);
      rv[i] = *(const u32x4*)(vbase + (size_t)rr * vstride + c * 8);
    }
  };
  auto swrite = [&](int st, const u32x4 (&rk)[KN], const u32x4 (&rv)[2]) {
    bf16_t* Ks = (bf16_t*)(lds + st * STAGE);
    bf16_t* Vs = Ks + 64 * KR;
#pragma unroll
    for (int i = 0; i < KN; ++i) {
      const int ci = tid + 256 * i, row = ci / KCH, c = ci % KCH;
      *(u32x4*)(Ks + row * KR + c * 8) = rk[i];
    }
#pragma unroll
    for (int i = 0; i < 2; ++i) {
      const int ci = tid + 256 * i, row = ci >> 3, c = ci & 7;
      *(u32x4*)(Vs + row * 72 + c * 8) = rv[i];
    }
  };
  const int trq = (lane & 15) >> 2, trp = lane & 3, trblk = (lane >> 4) & 1;
  const int troff = (4 * h2 + trq) * 72 + 16 * trblk + 4 * trp;
  __syncthreads();
  gload(0, rkA, rvA);
  swrite(0, rkA, rvA);
  gload(1, rkA, rvA);
  if (ntiles > 2) gload(2, rkB, rvB);
  for (int kt2 = 0; kt2 < ntiles; kt2 += 2)
#pragma unroll
  for (int par = 0; par < 2; ++par) {
    const int kt = kt2 + par;
    __syncthreads();
    if (par == 0) {
      if (kt + 1 < ntiles) swrite((kt + 1) & 1, rkA, rvA);
      if (kt + 3 < ntiles) gload(kt + 3, rkA, rvA);
    } else {
      if (kt + 1 < ntiles) swrite((kt + 1) & 1, rkB, rvB);
      if (kt + 3 < ntiles) gload(kt + 3, rkB, rvB);
    }
    const bf16_t* Ks = (const bf16_t*)(lds + (kt & 1) * STAGE);
    const bf16_t* Vs = Ks + 64 * KR;
    f32x16 Sx[2];
#pragma unroll
    for (int j = 0; j < 2; ++j)
#pragma unroll
      for (int r = 0; r < 16; ++r) Sx[j][r] = 0.f;
#pragma unroll
    for (int ks = 0; ks < DK / 16; ++ks)
#pragma unroll
      for (int j = 0; j < 2; ++j) {
        const bf16x8 kf = *(const bf16x8*)(Ks + (32 * j + l31) * KR + 16 * ks + 8 * h2);
        Sx[j] = MFMA32(kf, qf[ks], Sx[j]);
      }
    if (BAND) {
#pragma unroll
      for (int j = 0; j < 2; ++j)
#pragma unroll
        for (int r = 0; r < 16; ++r) {
          const int u = u0 + 64 * kt + 32 * j + crow(r, h2);
          const int d = u - tq;
          const bool valid = (d <= 64) && (d >= -64) && (u >= 0) && (u < L);
          Sx[j][r] = valid ? Sx[j][r] : -1e30f;
        }
    }
    float mx = Sx[0][0];
#pragma unroll
    for (int j = 0; j < 2; ++j)
#pragma unroll
      for (int r = 0; r < 16; ++r) mx = fmaxf(mx, Sx[j][r]);
    mx = xhalf_max(mx);
    const float mn = fmaxf(m, mx);
    const float alpha = exp2_(m - mn);
    const bool grew = mn > m;
    m = mn;
    float ls = 0.f;
#pragma unroll
    for (int j = 0; j < 2; ++j)
#pragma unroll
      for (int r = 0; r < 16; ++r) { const float pv = exp2_(Sx[j][r] - mn); Sx[j][r] = pv; ls += pv; }
    l = l * alpha + ls;
    if (__any(grew)) {
#pragma unroll
      for (int t = 0; t < 2; ++t)
#pragma unroll
        for (int r = 0; r < 16; ++r) O[t][r] *= alpha;
    }
#pragma unroll
    for (int j = 0; j < 2; ++j)
#pragma unroll
      for (int s = 0; s < 2; ++s) {
        const bf16x8 pf = pack8(Sx[j][8 * s], Sx[j][8 * s + 1], Sx[j][8 * s + 2], Sx[j][8 * s + 3], Sx[j][8 * s + 4],
                                Sx[j][8 * s + 5], Sx[j][8 * s + 6], Sx[j][8 * s + 7]);
#pragma unroll
        for (int t = 0; t < 2; ++t) {
          const bf16_t* vp = Vs + (32 * j + 16 * s) * 72 + 32 * t + troff;
          const bf16x8 vf = tr_pair(vp, vp + 8 * 72);
          O[t] = MFMA32(vf, pf, O[t]);
        }
      }
  }
}

DI void flash_loop_diff(f32x16 (&O0)[2], f32x16 (&O1)[2], float& m0, float& l0, float& m1, float& l1,
                        const bf16_t* __restrict__ qrow, const bf16_t* __restrict__ kbase, size_t kstride,
                        const bf16_t* __restrict__ vbase, size_t vstride, int ntiles, char* lds) {
  const int tid = threadIdx.x + opq(), lane = tid & 63, l31 = lane & 31, h2 = lane >> 5;
  constexpr int KR = 72;
  constexpr int STAGE = 64 * KR * 2 + 64 * 72 * 2;
  bf16x8 qf0[2], qf1[2];
#pragma unroll
  for (int ks = 0; ks < 2; ++ks) {
    qf0[ks] = *(const bf16x8*)(qrow + 16 * ks + 8 * h2);
    qf1[ks] = *(const bf16x8*)(qrow + 32 + 16 * ks + 8 * h2);
  }
  u32x4 rk[2], rv[2];
  auto gload = [&](int kt) {
#pragma unroll
    for (int i = 0; i < 2; ++i) {
      const int ci = tid + 256 * i, row = ci >> 3, c = ci & 7;
      const int rr = 64 * kt + row;
      rk[i] = *(const u32x4*)(kbase + (size_t)rr * kstride + c * 8);
      rv[i] = *(const u32x4*)(vbase + (size_t)rr * vstride + c * 8);
    }
  };
  auto swrite = [&](int st) {
    bf16_t* Ks = (bf16_t*)(lds + st * STAGE);
    bf16_t* Vs = Ks + 64 * KR;
#pragma unroll
    for (int i = 0; i < 2; ++i) {
      const int ci = tid + 256 * i, row = ci >> 3, c = ci & 7;
      *(u32x4*)(Ks + row * KR + c * 8) = rk[i];
      *(u32x4*)(Vs + row * 72 + c * 8) = rv[i];
    }
  };
  const int trq = (lane & 15) >> 2, trp = lane & 3, trblk = (lane >> 4) & 1;
  const int troff = (4 * h2 + trq) * 72 + 16 * trblk + 4 * trp;
  __syncthreads();
  gload(0);
  swrite(0);
  if (ntiles > 1) gload(1);
  for (int kt = 0; kt < ntiles; ++kt) {
    __syncthreads();
    if (kt + 1 < ntiles) swrite((kt + 1) & 1);
    if (kt + 2 < ntiles) gload(kt + 2);
    const bf16_t* Ks = (const bf16_t*)(lds + (kt & 1) * STAGE);
    const bf16_t* Vs = Ks + 64 * KR;
    bf16x8 pf[2][2][2];
#pragma unroll
    for (int mp = 0; mp < 2; ++mp) {
      f32x16 Sx[2];
#pragma unroll
      for (int j = 0; j < 2; ++j)
#pragma unroll
        for (int r = 0; r < 16; ++r) Sx[j][r] = 0.f;
#pragma unroll
      for (int ks = 0; ks < 2; ++ks)
#pragma unroll
        for (int j = 0; j < 2; ++j) {
          const bf16x8 kf = *(const bf16x8*)(Ks + (32 * j + l31) * KR + 32 * mp + 16 * ks + 8 * h2);
          Sx[j] = MFMA32(kf, mp == 0 ? qf0[ks] : qf1[ks], Sx[j]);
        }
      float& m = mp == 0 ? m0 : m1;
      float& l = mp == 0 ? l0 : l1;
      float mx = Sx[0][0];
#pragma unroll
      for (int j = 0; j < 2; ++j)
#pragma unroll
        for (int r = 0; r < 16; ++r) mx = fmaxf(mx, Sx[j][r]);
      mx = xhalf_max(mx);
      const float mn = fmaxf(m, mx);
      const float alpha = exp2_(m - mn);
      const bool grew = mn > m;
      m = mn;
      float ls = 0.f;
#pragma unroll
      for (int j = 0; j < 2; ++j)
#pragma unroll
        for (int r = 0; r < 16; ++r) { const float pv = exp2_(Sx[j][r] - mn); Sx[j][r] = pv; ls += pv; }
      l = l * alpha + ls;
      if (__any(grew)) {
#pragma unroll
        for (int t = 0; t < 2; ++t)
#pragma unroll
          for (int r = 0; r < 16; ++r) { if (mp == 0) O0[t][r] *= alpha; else O1[t][r] *= alpha; }
      }
#pragma unroll
      for (int j = 0; j < 2; ++j)
#pragma unroll
        for (int s = 0; s < 2; ++s)
          pf[mp][j][s] = pack8(Sx[j][8 * s], Sx[j][8 * s + 1], Sx[j][8 * s + 2], Sx[j][8 * s + 3], Sx[j][8 * s + 4],
                               Sx[j][8 * s + 5], Sx[j][8 * s + 6], Sx[j][8 * s + 7]);
    }
#pragma unroll
    for (int j = 0; j < 2; ++j)
#pragma unroll
      for (int s = 0; s < 2; ++s)
#pragma unroll
        for (int t = 0; t < 2; ++t) {
          const bf16_t* vp = Vs + (32 * j + 16 * s) * 72 + 32 * t + troff;
          const bf16x8 vf = tr_pair(vp, vp + 8 * 72);
          O0[t] = MFMA32(vf, pf[0][j][s], O0[t]);
          O1[t] = MFMA32(vf, pf[1][j][s], O1[t]);
        }
  }
}

DI void zeroO(f32x16 (&O)[2]) {
#pragma unroll
  for (int t = 0; t < 2; ++t)
#pragma unroll
    for (int r = 0; r < 16; ++r) O[t][r] = 0.f;
}

DI void store_o(bf16_t* dst, const f32x16 (&O)[2], int h2) {
#pragma unroll
  for (int t = 0; t < 2; ++t)
#pragma unroll
    for (int g = 0; g < 4; ++g) {
      u32x2 u; u.x = pack2(O[t][4 * g], O[t][4 * g + 1]); u.y = pack2(O[t][4 * g + 2], O[t][4 * g + 3]);
      *(u32x2*)(dst + 32 * t + 8 * g + 4 * h2) = u;
    }
}

DI void mla_item(CParams& p, int it, int S, char* lds) {
  const int tid = threadIdx.x + opq(), lane = tid & 63, w = tid >> 6, l31 = lane & 31, h2 = lane >> 5;
  const int lgq = (S == 2048) ? 4 : 7;
  const int qb = it & ((1 << lgq) - 1), bh = it >> lgq, h = bh & 3, b = bh >> 2;
  const int tokbase = b * S, gtok = tokbase + 128 * qb + 32 * w + l31;
  const bf16_t* Qb = (const bf16_t*)(p.ws + OFF_Q);
  const bf16_t* Kb = (const bf16_t*)(p.ws + OFF_K);
  const bf16_t* Vb = (const bf16_t*)(p.ws + OFF_V);
  bf16_t* Y = (bf16_t*)(p.ws + OFF_N);
  f32x16 O[2]; zeroO(O);
  float m = -1e30f, l = 0.f;
  flash_loop<96, false>(O, m, l, Qb + ((size_t)gtok * 4 + h) * 96, Kb + ((size_t)tokbase * 4 + h) * 96, 384,
                        Vb + ((size_t)tokbase * 4 + h) * 64, 256, S / 64, 0, 0, 0, lds);
  l += __shfl_xor(l, 32);
  const float il = 1.f / l;
#pragma unroll
  for (int t = 0; t < 2; ++t)
#pragma unroll
    for (int r = 0; r < 16; ++r) O[t][r] *= il;
  store_o(Y + (size_t)gtok * 1024 + h * 64, O, h2);
}

DI void diff_item(CParams& p, int layer, int it, int S, char* lds) {
  const int tid = threadIdx.x + opq(), lane = tid & 63, w = tid >> 6, l31 = lane & 31, h2 = lane >> 5;
  const int lgq = (S == 2048) ? 4 : 7;
  const int qb = it & ((1 << lgq) - 1), bh = it >> lgq, h = bh & 3, b = bh >> 2;
  const int tokbase = b * S, gtok = tokbase + 128 * qb + 32 * w + l31;
  const bf16_t* PR = (const bf16_t*)(p.ws + OFF_PR);
  bf16_t* Y = (bf16_t*)(p.ws + OFF_N);
  const float* lam = p.diff_lambda + layer * 128;
  float s1 = 0.f, s2 = 0.f;
  if (lane < 32) { s1 = lam[lane] * lam[32 + lane]; s2 = lam[64 + lane] * lam[96 + lane]; }
  s1 = wave_sum(s1); s2 = wave_sum(s2);
  const float lambda_init = layer ? 0.35550907f : 0.2f;
  const float lambda_full = expf(s1) - expf(s2) + lambda_init;
  f32x16 of[2], O1[2];
  zeroO(of); zeroO(O1);
  {
    float m0 = -1e30f, l0 = 0.f, m1 = -1e30f, l1 = 0.f;
    flash_loop_diff(of, O1, m0, l0, m1, l1, PR + (size_t)gtok * NPR + C_BQ + (2 * h) * 32,
                    PR + (size_t)tokbase * NPR + C_BK + (2 * h) * 32, NPR, PR + (size_t)tokbase * NPR + C_BV + h * 64, NPR,
                    S / 64, lds);
    l0 += __shfl_xor(l0, 32);
    l1 += __shfl_xor(l1, 32);
    const float c0 = 1.f / l0, c1 = -lambda_full / l1;
#pragma unroll
    for (int t = 0; t < 2; ++t)
#pragma unroll
      for (int r = 0; r < 16; ++r) of[t][r] = c0 * of[t][r] + c1 * O1[t][r];
  }
  float ss = 0.f;
#pragma unroll
  for (int t = 0; t < 2; ++t)
#pragma unroll
    for (int r = 0; r < 16; ++r) ss += of[t][r] * of[t][r];
  ss += __shfl_xor(ss, 32);
  const float rs = rsqrtf(ss * (1.f / 64.f) + EPS) * (1.f - lambda_init);
  const float* sg = p.diff_subln + layer * 64;
#pragma unroll
  for (int t = 0; t < 2; ++t)
#pragma unroll
    for (int r = 0; r < 16; ++r) of[t][r] *= rs * sg[32 * t + crow(r, h2)];
  store_o(Y + (size_t)gtok * 1024 + 256 + h * 64, of, h2);
}

DI void dil_item(CParams& p, int it, int S, int B, char* lds) {
  const int tid = threadIdx.x + opq(), lane = tid & 63, w = tid >> 6, l31 = lane & 31, h2 = lane >> 5;
  const int lgS = (S == 2048) ? 11 : 14, lgB = (B == 16) ? 4 : 1;
  const int rq = it & ((1 << (lgS - 7)) - 1);
  int rest = it >> (lgS - 7);
  const int head = rest & 3; rest >>= 2;
  const int b = rest & (B - 1), g = rest >> lgB;
  const int lgd = 2 * g, dil = 1 << lgd;
  const int L = S >> lgd, lgnqb = lgS - lgd - 7;
  const int res = rq >> lgnqb, qb = rq & ((1 << lgnqb) - 1);
  const int tokbase = b * S;
  const int tq = 128 * qb + 32 * w + l31;
  const int gtok = tokbase + tq * dil + res;
  const bf16_t* PR = (const bf16_t*)(p.ws + OFF_PR);
  bf16_t* OD = (bf16_t*)(p.ws + OFF_OD);
  float* LSE = (float*)(p.ws + OFF_LSE);
  f32x16 O[2]; zeroO(O);
  float m = -1e30f, l = 0.f;
  const int hc = (g * 4 + head) * 64;
  flash_loop<64, true>(O, m, l, PR + (size_t)gtok * NPR + C_DQ + hc, PR + (size_t)(tokbase + res) * NPR + C_DK + hc,
                       (size_t)dil * NPR, PR + (size_t)(tokbase + res) * NPR + C_DV + hc, (size_t)dil * NPR, 4, tq,
                       128 * qb - 64, L, lds);
  l += __shfl_xor(l, 32);
  const float il = 1.f / l;
#pragma unroll
  for (int t = 0; t < 2; ++t)
#pragma unroll
    for (int r = 0; r < 16; ++r) O[t][r] *= il;
  store_o(OD + ((size_t)g * TG + gtok) * 256 + head * 64, O, h2);
  if (h2 == 0) LSE[((size_t)g * TG + gtok) * 4 + head] = m + __log2f(l);
}

constexpr size_t OFF_X2 = 564 * MiB, WS_BIG = 597 * MiB;
#define DN_QK_OFF (p.big_ws ? OFF_X2 : OFF_OD)
#define DN_GC_OFF ((p.big_ws ? OFF_X2 : OFF_OD) + 32 * MiB)
constexpr size_t DN_UW_OFF = OFF_Q;

DI void dn_prep_item(CParams& p, int layer, int it, int S, char* lds) {
  const int tid = threadIdx.x + opq(), lane = tid & 63, w = tid >> 6, l15 = lane & 15, g4 = lane >> 4;
  const int NC = S / 64;
  const int ch = it % NC, bh = it / NC, h = bh & 3, b = bh >> 2;
  const int tokbase = b * S, s0 = ch * 64;
  const bf16_t* PR = (const bf16_t*)(p.ws + OFF_PR);
  const float* AB = (const float*)(p.ws + OFF_AB);
  bf16_t* QKg = (bf16_t*)(p.ws + DN_QK_OFF) + ((size_t)bh * NC + ch) * 8192;
  bf16_t* raw = (bf16_t*)lds;
  float* convw = (float*)(lds + 27200);
  float* RU = (float*)lds;
  float* RW = (float*)(lds + 16384);
  float* Am = (float*)(lds + 32768);
  bf16_t* Kimg = (bf16_t*)(lds + 50176);
  bf16_t* Qimg = (bf16_t*)(lds + 59392);
  float* gcs = (float*)(lds + 68608);
  float* betas = gcs + 128;
  const float* cw = p.dn_conv + (size_t)layer * 5 * 768;
  {
    u32x4 rawreg[7];
    float cwr[4];
#pragma unroll
    for (int k = 0; k < 7; ++k) {
      const int ci = tid + 256 * k;
      const int rr = ci / 24, c = ci % 24, seg = c >> 3, c8 = c & 7;
      const int s = s0 + rr - 2;
      rawreg[k] = u32x4{0u, 0u, 0u, 0u};
      if (ci < 68 * 24 && s >= 0 && s < S)
        rawreg[k] = *(const u32x4*)(PR + (size_t)(tokbase + s) * NPR + C_DNQKV + seg * 256 + h * 64 + c8 * 8);
    }
#pragma unroll
    for (int k = 0; k < 4; ++k) {
      const int i = tid + 256 * k;
      cwr[k] = 0.f;
      if (i < 960) { const int j = i / 192, c = i % 192; cwr[k] = cw[j * 768 + (c >> 6) * 256 + h * 64 + (c & 63)]; }
    }
#pragma unroll
    for (int k = 0; k < 7; ++k) {
      const int ci = tid + 256 * k;
      const int rr = ci / 24, c = ci % 24, seg = c >> 3, c8 = c & 7;
      if (ci < 68 * 24) *(u32x4*)(raw + rr * 200 + seg * 64 + c8 * 8) = rawreg[k];
    }
#pragma unroll
    for (int k = 0; k < 4; ++k) { const int i = tid + 256 * k; if (i < 960) convw[i] = cwr[k]; }
  }
  if (tid < 128) {
    const int d = tid >> 6, pl = tid & 63;
    const int i = d ? 63 - pl : pl;
    const size_t tok = (size_t)tokbase + s0 + i;
    const float Aexp = expf(p.dn_a_log[layer * 8 + d * 4 + h]);
    const float a = AB[tok * 16 + d * 8 + h] + p.dn_dt_bias[layer * 8 + d * 4 + h];
    const float bb = AB[tok * 16 + d * 8 + 4 + h];
    const float sp = fmaxf(a, 0.f) + __logf(1.f + __expf(-fabsf(a)));
    float g = -Aexp * sp;
#pragma unroll
    for (int o = 1; o < 64; o <<= 1) { const float tv = __shfl_up(g, o); if (lane >= o) g += tv; }
    gcs[tid] = g;
    betas[tid] = sigmoidf_(bb);
    float* GC = (float*)(p.ws + DN_GC_OFF) + (((size_t)bh * 2 + d) * NC + ch) * 64;
    GC[pl] = g;
  }
  __syncthreads();
  const int pp = tid >> 2, cgp = tid & 3;
  float kv[16], vv[16];
  {
    float qv[16];
#pragma unroll
    for (int seg = 0; seg < 3; ++seg) {
      float acc[16];
#pragma unroll
      for (int c = 0; c < 16; ++c) acc[c] = 0.f;
#pragma unroll
      for (int j = 0; j < 5; ++j) {
        const bf16_t* rp = raw + (pp + j) * 200 + seg * 64 + 16 * cgp;
        const float* wp = convw + j * 192 + seg * 64 + 16 * cgp;
        const u32x4 u0 = *(const u32x4*)rp, u1 = *(const u32x4*)(rp + 8);
        const unsigned uu[8] = {u0.x, u0.y, u0.z, u0.w, u1.x, u1.y, u1.z, u1.w};
#pragma unroll
        for (int e = 0; e < 8; ++e) {
          acc[2 * e] += wp[2 * e] * __uint_as_float(uu[e] << 16);
          acc[2 * e + 1] += wp[2 * e + 1] * __uint_as_float(uu[e] & 0xffff0000u);
        }
      }
#pragma unroll
      for (int c = 0; c < 16; ++c) {
        const float sv = acc[c] * __builtin_amdgcn_rcpf(1.f + __expf(-acc[c]));
        if (seg == 0) qv[c] = sv; else if (seg == 1) kv[c] = sv; else vv[c] = sv;
      }
    }
    float sq = 0.f, sk = 0.f;
#pragma unroll
    for (int c = 0; c < 16; ++c) { sq += qv[c] * qv[c]; sk += kv[c] * kv[c]; }
    sq += __shfl_xor(sq, 1); sq += __shfl_xor(sq, 2);
    sk += __shfl_xor(sk, 1); sk += __shfl_xor(sk, 2);
    const float rq = rsqrtf(sq + EPS) * 0.125f, rk = rsqrtf(sk + EPS);
#pragma unroll
    for (int c = 0; c < 16; ++c) { qv[c] *= rq; kv[c] *= rk; }
    store8bf(Kimg + pp * 72 + 16 * cgp, kv); store8bf(Kimg + pp * 72 + 16 * cgp + 8, kv + 8);
    store8bf(Qimg + pp * 72 + 16 * cgp, qv); store8bf(Qimg + pp * 72 + 16 * cgp + 8, qv + 8);
    store8bf(QKg + pp * 64 + 16 * cgp, qv); store8bf(QKg + pp * 64 + 16 * cgp + 8, qv + 8);
    store8bf(QKg + 4096 + pp * 64 + 16 * cgp, kv); store8bf(QKg + 4096 + pp * 64 + 16 * cgp + 8, kv + 8);
  }
  for (int d = 0; d < 2; ++d) {
    __syncthreads();
    {
      const int pl = d ? 63 - pp : pp;
      const float bet = betas[d * 64 + pl], egc = __expf(gcs[d * 64 + pl]);
#pragma unroll
      for (int c = 0; c < 16; ++c) {
        RU[pl * 64 + 16 * cgp + c] = vv[c] * bet;
        RW[pl * 64 + 16 * cgp + c] = kv[c] * bet * egc;
      }
    }
    {
      f32x4 KK[4];
#pragma unroll
      for (int t = 0; t < 4; ++t) KK[t] = f32x4{0.f, 0.f, 0.f, 0.f};
      const int jl = 16 * w + l15;
      const int jrow = d ? 63 - jl : jl;
#pragma unroll
      for (int ks = 0; ks < 2; ++ks) {
        const bf16x8 bfk = *(const bf16x8*)(Kimg + jrow * 72 + 32 * ks + 8 * g4);
#pragma unroll
        for (int rt = 0; rt < 4; ++rt) {
          const int il = 16 * rt + l15;
          const int irow = d ? 63 - il : il;
          const bf16x8 afk = *(const bf16x8*)(Kimg + irow * 72 + 32 * ks + 8 * g4);
          KK[rt] = MFMA16(afk, bfk, KK[rt]);
        }
      }
      const float gcj = gcs[d * 64 + jl];
#pragma unroll
      for (int rt = 0; rt < 4; ++rt)
#pragma unroll
        for (int r = 0; r < 4; ++r) {
          const int i = 16 * rt + 4 * g4 + r;
          const float ee = __expf(fminf(gcs[d * 64 + i] - gcj, 0.f));
          Am[i * 68 + jl] = (i > jl) ? betas[d * 64 + i] * KK[rt][r] * ee : 0.f;
        }
    }
    __syncthreads();
    float xs[32];
#pragma unroll
    for (int q = 0; q < 32; ++q) xs[q] = 0.f;
    const int c = tid >> 1, half = tid & 1;
    {
      const float* Rc = (c < 64) ? (RU + c) : (RW + (c - 64));
      const float* Ah = Am + 4 * half;
#pragma unroll
      for (int i = 0; i < 64; ++i) {
        float part = 0.f;
#pragma unroll
        for (int q = 0; q < (i + 7) / 8; ++q) {
          const f32x4 a = *(const f32x4*)(Ah + i * 68 + 8 * q);
          part += a[0] * xs[4 * q] + a[1] * xs[4 * q + 1] + a[2] * xs[4 * q + 2] + a[3] * xs[4 * q + 3];
        }
        const float other = __int_as_float(__builtin_amdgcn_update_dpp(0, __float_as_int(part), 0xB1, 0xf, 0xf, true));
        const float xi = Rc[i * 64] - (part + other);
        const int loc = ((i >> 3) << 2) + (i & 3);
        if (((i >> 2) & 1) == 0) xs[loc] = (half == 0) ? xi : xs[loc];
        else xs[loc] = (half == 1) ? xi : xs[loc];
        if (i < 16 ? ((i & 7) == 7) : (i < 32 ? ((i & 3) == 3) : ((i & 1) == 1))) asm volatile("" ::: "memory");
      }
    }
    {
      bf16_t* UWg = (bf16_t*)(p.ws + DN_UW_OFF) + ((((size_t)bh * 2 + d) * NC + ch) * 8192);
      const float sgn = (c < 64) ? 1.f : -1.f;
      bf16_t* dst = UWg + ((c < 64) ? c : (4096 + c - 64));
#pragma unroll
      for (int loc = 0; loc < 32; ++loc) {
        const int i = (((loc >> 2) * 2 + half) << 2) + (loc & 3);
        dst[i * 64] = f2bf(sgn * xs[loc]);
      }
    }
  }
}

DI void dn_scan_chain(CParams& p, int it, int S, char* lds) {
  __builtin_amdgcn_s_setprio(3);
  const int tid0 = threadIdx.x + opq();
  const int dir = it & 1, bh = it >> 1, h = bh & 3, b = bh >> 2;
  const int tokbase = b * S, NC = S / 64;
  bf16_t* OUT = (bf16_t*)(p.ws + (dir ? OFF_OB : OFF_OF));
  const bf16_t* QKg = (const bf16_t*)(p.ws + DN_QK_OFF) + (size_t)bh * NC * 8192;
  const bf16_t* UWg = (const bf16_t*)(p.ws + DN_UW_OFF) + (size_t)it * NC * 8192;
  const float* GCg = (const float*)(p.ws + DN_GC_OFF) + (size_t)it * NC * 64;
  bf16_t* Uimg = (bf16_t*)lds;
  bf16_t* Wn = Uimg + 4608;
  bf16_t* Qimg = Wn + 4608;
  bf16_t* Kimg = Qimg + 4608;
  bf16_t* Kt = Kimg + 4608;
  bf16_t* Iimg = Kt + 4608;
  float* gcs = (float*)(lds + 6 * 9216);
  f32x4 Sd[4];
#pragma unroll
  for (int t = 0; t < 4; ++t) Sd[t] = f32x4{0.f, 0.f, 0.f, 0.f};
  u32x4 ru[2], rw[2], rq[2], rk[2];
  float rg = 0.f;
  auto prefetch = [&](int cc_) {
    const int ch_ = dir ? (NC - 1 - cc_) : cc_;
    const int tp = tid0 + opq();
    const bf16_t* uw = UWg + (size_t)ch_ * 8192;
    const bf16_t* qk = QKg + (size_t)ch_ * 8192;
#pragma unroll
    for (int k = 0; k < 2; ++k) {
      const int ci = tp + 256 * k, row = ci >> 3, c8 = ci & 7;
      const int srow = dir ? 63 - row : row;
      ru[k] = *(const u32x4*)(uw + row * 64 + c8 * 8);
      rw[k] = *(const u32x4*)(uw + 4096 + row * 64 + c8 * 8);
      rq[k] = *(const u32x4*)(qk + srow * 64 + c8 * 8);
      rk[k] = *(const u32x4*)(qk + 4096 + srow * 64 + c8 * 8);
    }
    if (tp < 64) rg = GCg[(size_t)ch_ * 64 + tp];
  };
  prefetch(0);
  for (int cc = 0; cc < NC; ++cc) {
    const int tid = tid0 + opq(), lane = tid & 63, w = tid >> 6, l15 = lane & 15, g4 = lane >> 4;
    const int e_col = 16 * w + l15;
    const int ch = dir ? (NC - 1 - cc) : cc;
    const int s0 = ch * 64;
    __syncthreads();
#pragma unroll
    for (int k = 0; k < 2; ++k) {
      const int ci = tid + 256 * k, row = ci >> 3, c8 = ci & 7;
      *(u32x4*)(Uimg + row * 72 + c8 * 8) = ru[k];
      *(u32x4*)(Wn + row * 72 + c8 * 8) = rw[k];
      *(u32x4*)(Qimg + row * 72 + c8 * 8) = rq[k];
      *(u32x4*)(Kimg + row * 72 + c8 * 8) = rk[k];
      const unsigned uu[4] = {rk[k].x, rk[k].y, rk[k].z, rk[k].w};
#pragma unroll
      for (int e = 0; e < 4; ++e) {
        Kt[(8 * c8 + 2 * e) * 72 + row] = (bf16_t)(uu[e] & 0xffffu);
        Kt[(8 * c8 + 2 * e + 1) * 72 + row] = (bf16_t)(uu[e] >> 16);
      }
    }
    if (tid < 64) gcs[tid] = rg;
    if (cc + 1 < NC) prefetch(cc + 1);
    __syncthreads();
    {
      f32x4 QK[4];
#pragma unroll
      for (int t = 0; t < 4; ++t) QK[t] = f32x4{0.f, 0.f, 0.f, 0.f};
#pragma unroll
      for (int ks = 0; ks < 2; ++ks) {
        const bf16x8 bfk = *(const bf16x8*)(Kimg + (16 * w + l15) * 72 + 32 * ks + 8 * g4);
#pragma unroll
        for (int rt = 0; rt < 4; ++rt) {
          const bf16x8 afq = *(const bf16x8*)(Qimg + (16 * rt + l15) * 72 + 32 * ks + 8 * g4);
          QK[rt] = MFMA16(afq, bfk, QK[rt]);
        }
      }
      const float gcj = gcs[e_col];
#pragma unroll
      for (int rt = 0; rt < 4; ++rt)
#pragma unroll
        for (int r = 0; r < 4; ++r) {
          const int i = 16 * rt + 4 * g4 + r;
          const float ee = __expf(fminf(gcs[i] - gcj, 0.f));
          Iimg[i * 72 + e_col] = f2bf((i >= e_col) ? QK[rt][r] * ee : 0.f);
        }
    }
    __syncthreads();
    {
      bf16x8 Bs[2];
#pragma unroll
      for (int ks = 0; ks < 2; ++ks)
        Bs[ks] = pack8(Sd[2 * ks][0], Sd[2 * ks][1], Sd[2 * ks][2], Sd[2 * ks][3], Sd[2 * ks + 1][0], Sd[2 * ks + 1][1],
                       Sd[2 * ks + 1][2], Sd[2 * ks + 1][3]);
      f32x4 vn[4], qs[4], iv[4];
#pragma unroll
      for (int rt = 0; rt < 4; ++rt) {
#pragma unroll
        for (int r = 0; r < 4; ++r) vn[rt][r] = bf2f(Uimg[(16 * rt + 4 * g4 + r) * 72 + e_col]);
        qs[rt] = f32x4{0.f, 0.f, 0.f, 0.f};
        iv[rt] = f32x4{0.f, 0.f, 0.f, 0.f};
#pragma unroll
        for (int ks = 0; ks < 2; ++ks) {
          const bf16_t* wp = Wn + (16 * rt + l15) * 72 + 32 * ks + 4 * g4;
          const bf16_t* qp = Qimg + (16 * rt + l15) * 72 + 32 * ks + 4 * g4;
          vn[rt] = MFMA16(ld2x4(wp, wp + 16), Bs[ks], vn[rt]);
          qs[rt] = MFMA16(ld2x4(qp, qp + 16), Bs[ks], qs[rt]);
        }
      }
      bf16x8 Bv[2];
#pragma unroll
      for (int ks = 0; ks < 2; ++ks)
        Bv[ks] = pack8(vn[2 * ks][0], vn[2 * ks][1], vn[2 * ks][2], vn[2 * ks][3], vn[2 * ks + 1][0], vn[2 * ks + 1][1],
                       vn[2 * ks + 1][2], vn[2 * ks + 1][3]);
#pragma unroll
      for (int rt = 0; rt < 4; ++rt)
#pragma unroll
        for (int ks = 0; ks < 2; ++ks) {
          const bf16_t* ip = Iimg + (16 * rt + l15) * 72 + 32 * ks + 4 * g4;
          iv[rt] = MFMA16(ld2x4(ip, ip + 16), Bv[ks], iv[rt]);
        }
      const float gc63 = gcs[63];
#pragma unroll
      for (int rt = 0; rt < 4; ++rt)
#pragma unroll
        for (int r = 0; r < 4; ++r) {
          const int pos = 16 * rt + 4 * g4 + r;
          const float o = qs[rt][r] * __expf(gcs[pos]) + iv[rt][r];
          const int i = dir ? 63 - pos : pos;
          OUT[((size_t)tokbase + s0 + i) * 256 + h * 64 + e_col] = f2bf(o);
          vn[rt][r] *= __expf(gc63 - gcs[pos]);
        }
      bf16x8 Bv2[2];
#pragma unroll
      for (int ks = 0; ks < 2; ++ks)
        Bv2[ks] = pack8(vn[2 * ks][0], vn[2 * ks][1], vn[2 * ks][2], vn[2 * ks][3], vn[2 * ks + 1][0], vn[2 * ks + 1][1],
                        vn[2 * ks + 1][2], vn[2 * ks + 1][3]);
      const float gl = __expf(gc63);
#pragma unroll
      for (int dt = 0; dt < 4; ++dt) {
#pragma unroll
        for (int r = 0; r < 4; ++r) Sd[dt][r] *= gl;
#pragma unroll
        for (int ks = 0; ks < 2; ++ks) {
          const bf16_t* kp = Kt + (16 * dt + l15) * 72 + 32 * ks + 4 * g4;
          Sd[dt] = MFMA16(ld2x4(kp, kp + 16), Bv2[ks], Sd[dt]);
        }
      }
    }
  }
  __builtin_amdgcn_s_setprio(0);
}

DI void phase_combine(CParams& p, int layer, const float* __restrict__ xg) {
  const int tidq = threadIdx.x + opq(); const int wave = tidq >> 6, lane = tidq & 63;
  const bf16_t* PR = (const bf16_t*)(p.ws + OFF_PR);
  const bf16_t* OD = (const bf16_t*)(p.ws + OFF_OD);
  const float* LSE = (const float*)(p.ws + OFF_LSE);
  const bf16_t* OFb = (const bf16_t*)(p.ws + OFF_OF);
  const bf16_t* OBb = (const bf16_t*)(p.ws + OFF_OB);
  bf16_t* Y = (bf16_t*)(p.ws + OFF_N);
  bf16_t* Np = (bf16_t*)(p.ws + OFF_Q);
  const float* gmix = p.norm_mix + layer * 1024;
  const float* gdn = p.dn_out_norm + layer * 64;
  const int head = lane >> 4;
  for (int r = blockIdx.x * 4 + wave; r < TG; r += gridDim.x * 4) {
    {
      float lg[3];
#pragma unroll
      for (int g = 0; g < 3; ++g) lg[g] = LSE[((size_t)g * TG + r) * 4 + head];
      const float mx = fmaxf(lg[0], fmaxf(lg[1], lg[2]));
      float wg[3], den = 0.f;
#pragma unroll
      for (int g = 0; g < 3; ++g) { wg[g] = exp2_(lg[g] - mx); den += wg[g]; }
      const float id = 1.f / den;
      float o[4] = {0.f, 0.f, 0.f, 0.f};
#pragma unroll
      for (int g = 0; g < 3; ++g) {
        const u32x2 u = ((const u32x2*)(OD + ((size_t)g * TG + r) * 256))[lane];
        const float c = wg[g] * id;
        o[0] += c * __uint_as_float(u.x << 16); o[1] += c * __uint_as_float(u.x & 0xffff0000u);
        o[2] += c * __uint_as_float(u.y << 16); o[3] += c * __uint_as_float(u.y & 0xffff0000u);
      }
      u32x2 ou; ou.x = pack2(o[0], o[1]); ou.y = pack2(o[2], o[3]);
      ((u32x2*)(Y + (size_t)r * 1024 + 768))[lane] = ou;
    }
    {
      const u32x2 uf = ((const u32x2*)(OFb + (size_t)r * 256))[lane];
      const u32x2 ub = ((const u32x2*)(OBb + (size_t)r * 256))[lane];
      const u32x2 uz = ((const u32x2*)(PR + (size_t)r * NPR + C_Z))[lane];
      float o[4], z[4];
      o[0] = __uint_as_float(uf.x << 16) + __uint_as_float(ub.x << 16);
      o[1] = __uint_as_float(uf.x & 0xffff0000u) + __uint_as_float(ub.x & 0xffff0000u);
      o[2] = __uint_as_float(uf.y << 16) + __uint_as_float(ub.y << 16);
      o[3] = __uint_as_float(uf.y & 0xffff0000u) + __uint_as_float(ub.y & 0xffff0000u);
      z[0] = __uint_as_float(uz.x << 16); z[1] = __uint_as_float(uz.x & 0xffff0000u);
      z[2] = __uint_as_float(uz.y << 16); z[3] = __uint_as_float(uz.y & 0xffff0000u);
      float ss = o[0] * o[0] + o[1] * o[1] + o[2] * o[2] + o[3] * o[3];
      ss += __shfl_xor(ss, 1); ss += __shfl_xor(ss, 2); ss += __shfl_xor(ss, 4); ss += __shfl_xor(ss, 8);
      const float rs = rsqrtf(ss * (1.f / 64.f) + EPS);
      const float4 gg = ((const float4*)gdn)[lane & 15];
      u32x2 ou;
      ou.x = pack2(o[0] * rs * gg.x * siluf_(z[0]), o[1] * rs * gg.y * siluf_(z[1]));
      ou.y = pack2(o[2] * rs * gg.z * siluf_(z[2]), o[3] * rs * gg.w * siluf_(z[3]));
      ((u32x2*)(Y + (size_t)r * 1024 + 512))[lane] = ou;
    }
    {
      const float4* xr = (const float4*)(xg + (size_t)r * 1024);
      float4 v[4];
      float ss = 0.f;
#pragma unroll
      for (int i = 0; i < 4; ++i) { v[i] = xr[lane + 64 * i]; ss += v[i].x * v[i].x + v[i].y * v[i].y + v[i].z * v[i].z + v[i].w * v[i].w; }
      ss = wave_sum(ss);
      const float rs = rsqrtf(ss * (1.f / 1024.f) + EPS);
#pragma unroll
      for (int i = 0; i < 4; ++i) {
        const float4 gg = ((const float4*)gmix)[lane + 64 * i];
        u32x2 o; o.x = pack2(v[i].x * rs * gg.x, v[i].y * rs * gg.y); o.y = pack2(v[i].z * rs * gg.z, v[i].w * rs * gg.w);
        ((u32x2*)(Np + (size_t)r * 1024))[lane + 64 * i] = o;
      }
    }
  }
}

#define XB_TMO      128
#define XB_XCNT(j)  (256  + 64 * (j))
#define XB_XSUB(j)  (1280 + 64 * (j))
#define XB_XGEN(j)  (2304 + 64 * (j))
#define XB_TOP      3328
#define XB_TOPGEN   3392
#define XCD_BAR_WORDS 3456
#define XB_SPIN_CAP (1u << 27)
#define LAS __attribute__((address_space(3)))
constexpr size_t OFF_BAR = OFF_CNT + 65536;
DI unsigned xb_ld(unsigned* p) { return __hip_atomic_load(p, __ATOMIC_RELAXED, __HIP_MEMORY_SCOPE_AGENT); }
DI unsigned xb_add(unsigned* p, unsigned v) { return __hip_atomic_fetch_add(p, v, __ATOMIC_RELAXED, __HIP_MEMORY_SCOPE_AGENT); }
DI unsigned xb_xcc_id() { return (unsigned)__builtin_amdgcn_s_getreg((3 << 11) | 20) & 0xFu; }
#define XB_SPIN(cond, bar) do { unsigned _sp = 0; while (cond) { __builtin_amdgcn_s_sleep(1); \
    if ((++_sp & 255u) == 0u) { if (xb_ld(&(bar)[XB_TMO])) break; if (_sp > XB_SPIN_CAP) { atomicAdd(&(bar)[XB_TMO], 1u); break; } } } } while (0)
struct XcdBarrier { unsigned* bar; unsigned x; volatile LAS unsigned* st; };
DI XcdBarrier xcd_barrier_post(unsigned* bar, volatile LAS unsigned* st) {
  XcdBarrier b; b.bar = bar; b.x = xb_xcc_id(); b.st = st;
  if (threadIdx.x == 0) (void)xb_add(&bar[XB_XCNT(b.x)], 1u);
  return b;
}
DI void xcd_barrier_complete(unsigned* bar, unsigned x, unsigned& nloc, unsigned& nx) {
  const unsigned G = gridDim.x * gridDim.y * gridDim.z;
  unsigned sum, cnt, mine, sp = 0u;
  for (;;) {
    sum = 0u; cnt = 0u; mine = 0u;
#pragma unroll
    for (unsigned j = 0; j < 16; ++j) { const unsigned c = xb_ld(&bar[XB_XCNT(j)]); sum += c; cnt += (c > 0u) ? 1u : 0u; mine = (j == x) ? c : mine; }
    if (sum == G) break;
    __builtin_amdgcn_s_sleep(1);
    if ((++sp & 255u) == 0u) { if (xb_ld(&bar[XB_TMO])) break; if (sp > XB_SPIN_CAP) { atomicAdd(&bar[XB_TMO], 1u); break; } }
  }
  nloc = mine > 0u ? mine : 1u; nx = cnt > 0u ? cnt : 1u;
}
DI void xcd_barrier(const XcdBarrier& b) {
  asm volatile("s_waitcnt vmcnt(0)" ::: "memory");
  __syncthreads();
  if (threadIdx.x == 0) {
    unsigned* bar = b.bar;
    __builtin_amdgcn_s_waitcnt(0);
    unsigned nloc = b.st[0], nx = b.st[1];
    if (nloc == 0u) { xcd_barrier_complete(bar, b.x, nloc, nx); b.st[0] = nloc; b.st[1] = nx; }
    const unsigned old = xb_add(&bar[XB_XSUB(b.x)], 1u);
    const unsigned gen = old / nloc;
    if (old + 1u == (gen + 1u) * nloc) {
      __builtin_amdgcn_fence(__ATOMIC_RELEASE, "agent");
      asm volatile("s_waitcnt vmcnt(0)" ::: "memory");
      const unsigned og = xb_add(&bar[XB_TOP], 1u);
      const unsigned tg = og / nx;
      if (og + 1u == (tg + 1u) * nx) xb_add(&bar[XB_TOPGEN], 1u);
      else XB_SPIN(xb_ld(&bar[XB_TOPGEN]) == tg, bar);
      __builtin_amdgcn_fence(__ATOMIC_ACQUIRE, "agent");
      xb_add(&bar[XB_XGEN(b.x)], 1u);
      asm volatile("s_waitcnt vmcnt(0)" ::: "memory");
    } else {
      XB_SPIN(xb_ld(&bar[XB_XGEN(b.x)]) == gen, bar);
      __builtin_amdgcn_fence(__ATOMIC_ACQUIRE, "agent");
      asm volatile("s_waitcnt vmcnt(0)" ::: "memory");
    }
  }
  __syncthreads();
}

#ifndef REP_MIX
#define REP_MIX 1
#endif
#ifndef REP_GEMM
#define REP_GEMM 1
#endif
__global__ void __launch_bounds__(256, 2) mega(Params pk) {
  extern __shared__ __attribute__((aligned(16))) char lds[];
  __shared__ uint4 sh_words;
  cg::grid_group grid = cg::this_grid();
  CParams* kp = (CParams*)__builtin_amdgcn_kernarg_segment_ptr();
  if (threadIdx.x == 0) sh_words = make_uint4(0u, 0u, 0u, 0u);
  __syncthreads();
  XcdBarrier xb;
  { CParams& p = *launder(kp); xb = xcd_barrier_post((unsigned*)(p.ws + OFF_BAR), (volatile LAS unsigned*)&sh_words); }
#define s_item (((volatile int*)&sh_words)[2])
#define GSYNC() xcd_barrier(xb)
#define PP_ CParams& p = *launder(kp); const bf16_t* wb = (const bf16_t*)(p.ws + OFF_WB); bf16_t* Nb = (bf16_t*)(p.ws + OFF_N); \
            bf16_t* PRb = (bf16_t*)(p.ws + OFF_PR); bf16_t* Npb = (bf16_t*)(p.ws + OFF_Q); bf16_t* PB = (bf16_t*)(p.ws + OFF_OD); \
            float* xg = p.x + (size_t)grp * TG * 1024; (void)wb; (void)Nb; (void)PRb; (void)Npb; (void)PB; (void)xg;
  { CParams& p = *launder(kp); phase_init(p, lds); phase_norm(p.x_in[0], p.norm_ff1, (bf16_t*)(p.ws + OFF_Q), nullptr, nullptr); }
  grid.sync();
  for (int layer = 0; layer < 2; ++layer) {
    if (layer > 0) { CParams& p = *launder(kp); phase_convert(p, layer, lds); GSYNC(); }
    for (int grp = 0; grp < 2; ++grp) {
      const int S = grp ? 2048 : 16384, B = grp ? 16 : 2;
      const float* xsrc0 = nullptr;
      { CParams& p = *launder(kp); xsrc0 = layer == 0 ? p.x_in[grp] : p.x + (size_t)grp * TG * 1024; }
      for (int rep = 0; rep < REP_GEMM; ++rep) {
        { PP_ phase_ffn_a(Npb, wb + W_FF1_1, wb + W_FF1_3, PRb, lds); }
        GSYNC();
      }
      { PP_ phase_gemm_resid(PRb, 2816, wb + W_FF1_2, xsrc0, xg, 0.5f, lds); }
      GSYNC();
      { PP_ phase_norm(xg, p.norm_mix + layer * 1024, Nb, nullptr, nullptr); }
      GSYNC();
      for (int rep = 0; rep < REP_GEMM; ++rep) {
        { PP_ phase_proj(p, Nb, wb + W_IN, S, lds); }
        GSYNC();
      }
      {
        PP_
        int* c0 = (int*)(p.ws + OFF_CNT) + (layer * 2 + grp) * 4;
        for (;;) {
          __syncthreads();
          if (threadIdx.x == 0) s_item = atomicAdd(c0, 1);
          __syncthreads();
          const int it = s_item;
          if (it >= 2048) break;
          dn_prep_item(p, layer, it, S, lds);
        }
      }
      GSYNC();
      {
        PP_
        int* cb = (int*)(p.ws + OFF_CNT) + 64 + (layer * 2 + grp) * 32;
        const int nDN = B * 8, nDil = p.big_ws ? 3072 : 0;
        const int lgq = grp ? 4 : 7;
        for (;;) {
          __syncthreads();
          if (threadIdx.x == 0) s_item = atomicAdd(cb, 1);
          __syncthreads();
          const int it = s_item;
          if (it >= nDN) break;
          dn_scan_chain(p, it, S, lds);
        }
        for (int xo = 0; xo < 8; ++xo) {
          const int xq = (blockIdx.x + xo) & 7;
          for (;;) {
            __syncthreads();
            if (threadIdx.x == 0) s_item = atomicAdd(cb + 8 + xq, 1);
            __syncthreads();
            const int j = s_item;
            if (j >= 128) break;
            const int pair = xq + 8 * (j >> lgq), qb = j & ((1 << lgq) - 1);
            diff_item(p, layer, (pair << lgq) + qb, S, lds);
          }
        }
        for (;;) {
          __syncthreads();
          if (threadIdx.x == 0) s_item = atomicAdd(cb + 1, 1);
          __syncthreads();
          const int it = s_item;
          if (it >= nDil) break;
          dil_item(p, it, S, B, lds);
        }
      }
      GSYNC();
      {
        PP_
        int* c2 = (int*)(p.ws + OFF_CNT) + (layer * 2 + grp) * 4 + 2;
        const int nDil = p.big_ws ? 0 : 3072, total = nDil + 256 * 7;
        for (;;) {
          __syncthreads();
          if (threadIdx.x == 0) s_item = atomicAdd(c2, 1);
          __syncthreads();
          int it = s_item;
          if (it >= total) break;
          if (it < nDil) { dil_item(p, it, S, B, lds); continue; }
          it -= nDil;
          mla_up_tile(p, it / 7, it % 7, S, lds);
        }
      }
      GSYNC();
      {
        PP_
        int* cb = (int*)(p.ws + OFF_CNT) + 64 + (layer * 2 + grp) * 32 + 16;
        const int lgq = grp ? 4 : 7;
        for (int xo = 0; xo < 8; ++xo) {
          const int xq = (blockIdx.x + xo) & 7;
          for (;;) {
            __syncthreads();
            if (threadIdx.x == 0) s_item = atomicAdd(cb + xq, 1);
            __syncthreads();
            const int j = s_item;
            if (j >= 128) break;
            const int pair = xq + 8 * (j >> lgq), qb = j & ((1 << lgq) - 1);
            mla_item(p, (pair << lgq) + qb, S, lds);
          }
        }
      }
      GSYNC();
      { PP_ phase_combine(p, layer, xg); }
      GSYNC();
      for (int rep = 0; rep < REP_GEMM; ++rep) {
        { PP_ phase_merge(Npb, Nb, wb + W_G, wb + W_B, PRb, lds); }
        GSYNC();
      }
      { PP_ phase_gemm_resid(PRb, 1024, wb + W_O, xg, xg, 1.0f, lds); }
      GSYNC();
      { PP_ phase_norm(xg, p.norm_ff2 + layer * 1024, Nb, nullptr, nullptr); }
      GSYNC();
      for (int rep = 0; rep < REP_GEMM; ++rep) {
        { PP_ phase_ffn_a(Nb, wb + W_FF2_1, wb + W_FF2_3, PRb, lds); }
        GSYNC();
      }
      { PP_ phase_gemm_resid(PRb, 2816, wb + W_FF2_2, xg, xg, 0.5f, lds); }
      GSYNC();
      { PP_ phase_norm(xg, p.norm_ple + layer * 1024, Nb, p.p_in[grp] + (size_t)layer * TG * 256, PB); }
      GSYNC();
      {
        PP_
        phase_ple(Nb, PB, wb + W_PG, wb + W_PP, xg, lds);
        const int nl = grp ? layer + 1 : layer, ng = grp ^ 1;
        if (nl < 2) phase_norm(nl == 0 ? p.x_in[ng] : p.x + (size_t)ng * TG * 1024, p.norm_ff1 + nl * 1024, Npb, nullptr, nullptr);
      }
      GSYNC();
    }
  }
  { CParams& p = *launder(kp); phase_final_norm(p.x, p.norm_final); }
}

extern "C" void kernel_launch(void* const* d_in, const int* in_sizes, int n_in, void* d_out, int out_size, void* d_ws,
                              size_t ws_size, hipStream_t stream) {
  (void)in_sizes; (void)n_in; (void)out_size;
  Params p{};
  p.x_in[0] = (const float*)d_in[0]; p.x_in[1] = (const float*)d_in[1];
  p.p_in[0] = (const float*)d_in[2]; p.p_in[1] = (const float*)d_in[3];
  p.norm_ff1 = (const float*)d_in[4]; p.ff1_w1 = (const float*)d_in[5]; p.ff1_w3 = (const float*)d_in[6];
  p.ff1_w2 = (const float*)d_in[7]; p.norm_mix = (const float*)d_in[8]; p.w_in = (const float*)d_in[9];
  p.mla_q_norm = (const float*)d_in[10]; p.mla_kv_norm = (const float*)d_in[11]; p.mla_w_uq = (const float*)d_in[12];
  p.mla_w_ukv = (const float*)d_in[13]; p.diff_lambda = (const float*)d_in[14]; p.diff_subln = (const float*)d_in[15];
  p.dn_conv = (const float*)d_in[16]; p.dn_a_log = (const float*)d_in[17]; p.dn_dt_bias = (const float*)d_in[18];
  p.dn_out_norm = (const float*)d_in[19]; p.w_branch = (const float*)d_in[20]; p.w_gate = (const float*)d_in[21];
  p.w_out = (const float*)d_in[22]; p.norm_ff2 = (const float*)d_in[23]; p.ff2_w1 = (const float*)d_in[24];
  p.ff2_w3 = (const float*)d_in[25]; p.ff2_w2 = (const float*)d_in[26]; p.norm_ple = (const float*)d_in[27];
  p.ple_gate = (const float*)d_in[28]; p.ple_proj = (const float*)d_in[29]; p.norm_final = (const float*)d_in[30];
  p.x = (float*)d_out;
  p.ws = (char*)d_ws;
  p.big_ws = (ws_size >= WS_BIG) ? 1 : 0;
  static int grid_blocks = 0;
  if (!grid_blocks) {
    int dev = 0, cus = 0, per_cu = 0;
    hipGetDevice(&dev);
    hipDeviceGetAttribute(&cus, hipDeviceAttributeMultiprocessorCount, dev);
    hipFuncSetAttribute((const void*)mega, hipFuncAttributeMaxDynamicSharedMemorySize, (int)LDS_BYTES);
    hipOccupancyMaxActiveBlocksPerMultiprocessor(&per_cu, mega, 256, LDS_BYTES);
    if (per_cu < 1) per_cu = 1;
    grid_blocks = cus * per_cu;
  }
  if (ws_size < WS_NEED) {
    fprintf(stderr, "workspace too small: %zu < %zu\n", ws_size, (size_t)WS_NEED);
    return;
  }
  (void)hipMemsetAsync((char*)d_ws + OFF_BAR, 0, XCD_BAR_WORDS * 4, stream);
  void* args[] = {&p};
  hipError_t e = hipLaunchCooperativeKernel((void*)mega, dim3(grid_blocks), dim3(256), args, LDS_BYTES, stream);
  if (e != hipSuccess) fprintf(stderr, "cooperative launch failed: %s (grid %d)\n", hipGetErrorString(e), grid_blocks);
}
```

```cpp
#include <hip/hip_runtime.h>
#include <hip/hip_cooperative_groups.h>
#include <stdint.h>
#include <stdio.h>
namespace cg = cooperative_groups;

typedef unsigned short bf16_t;
using bf16x8 = __attribute__((ext_vector_type(8))) short;
using bf16x4 = __attribute__((ext_vector_type(4))) short;
using f32x16 = __attribute__((ext_vector_type(16))) float;
using f32x4 = __attribute__((ext_vector_type(4))) float;
using u32x4 = __attribute__((ext_vector_type(4))) unsigned;
using u32x2 = __attribute__((ext_vector_type(2))) unsigned;

#define DI __device__ __forceinline__
#define MFMA32(a, b, c) __builtin_amdgcn_mfma_f32_32x32x16_bf16((a), (b), (c), 0, 0, 0)
#define MFMA16(a, b, c) __builtin_amdgcn_mfma_f32_16x16x32_bf16((a), (b), (c), 0, 0, 0)

constexpr int TG = 32768;
constexpr int NPR = 4608;
constexpr float EPS = 1e-6f;
constexpr float LOG2E = 1.4426950408889634f;
constexpr float DEFER_THR = 8.f;
constexpr int C_CQ = 0, C_CKV = 256, C_BQ = 384, C_BK = 640, C_BV = 896, C_DNQKV = 1152, C_Z = 1920,
              C_DQ = 2176, C_DK = 2944, C_DV = 3712;
constexpr size_t MiB = 1048576;
constexpr size_t OFF_WB = 0, OFF_TAB = 57 * MiB, OFF_CNT = 63 * MiB, OFF_N = 64 * MiB, OFF_PR = 128 * MiB,
                 OFF_Q = 416 * MiB, OFF_K = 440 * MiB, OFF_V = 464 * MiB, OFF_AB = 480 * MiB, OFF_OD = 482 * MiB,
                 OFF_LSE = 530 * MiB, OFF_OF = 532 * MiB, OFF_OB = 548 * MiB, WS_NEED = 564 * MiB;
constexpr size_t W_FF1_1 = 0, W_FF1_3 = 2883584, W_FF1_2 = 5767168, W_IN = 8650752, W_UQ = 13369344,
                 W_UKV = 13467648, W_G = 13533184, W_B = 17727488, W_O = 18776064, W_FF2_1 = 19824640,
                 W_FF2_3 = 22708224, W_FF2_2 = 25591808, W_PG = 28475392, W_PP = 29523968;
constexpr size_t LDS_BYTES = 78336;

struct Params {
  const float* x_in[2];
  const float* p_in[2];
  const float *norm_ff1, *ff1_w1, *ff1_w3, *ff1_w2, *norm_mix, *w_in, *mla_q_norm, *mla_kv_norm, *mla_w_uq,
      *mla_w_ukv, *diff_lambda, *diff_subln, *dn_conv, *dn_a_log, *dn_dt_bias, *dn_out_norm, *w_branch, *w_gate,
      *w_out, *norm_ff2, *ff2_w1, *ff2_w3, *ff2_w2, *norm_ple, *ple_gate, *ple_proj, *norm_final;
  float* x;
  char* ws;
  long long big_ws;
};

typedef const __attribute__((address_space(4))) Params CParams;
DI CParams* launder(CParams* q) { asm volatile("" : "+s"(q)); return q; }

typedef __bf16 bf2_t __attribute__((ext_vector_type(2)));
typedef float f2_t __attribute__((ext_vector_type(2)));
DI bf16_t f2bf(float x) { return __builtin_bit_cast(bf16_t, (__bf16)x); }
DI float bf2f(bf16_t b) { return __uint_as_float(((unsigned)b) << 16); }
DI unsigned pack2(float a, float b) { f2_t v = {a, b}; return __builtin_bit_cast(unsigned, __builtin_convertvector(v, bf2_t)); }
DI float wave_sum(float v) {
#pragma unroll
  for (int o = 32; o > 0; o >>= 1) v += __shfl_xor(v, o);
  return v;
}
DI float sigmoidf_(float x) { return __builtin_amdgcn_rcpf(1.f + __expf(-x)); }
DI float siluf_(float x) { return x * __builtin_amdgcn_rcpf(1.f + __expf(-x)); }
DI float exp2_(float x) { return __builtin_amdgcn_exp2f(x); }
DI int opq() { int z; asm volatile("v_mov_b32 %0, 0" : "=v"(z)); return z; }
DI float xhalf_max(float v) {
  const auto r = __builtin_amdgcn_permlane32_swap(__float_as_uint(v), __float_as_uint(v), false, false);
  return fmaxf(__uint_as_float(r[0]), __uint_as_float(r[1]));
}
DI int crow(int r, int h2) { return (r & 3) + 8 * (r >> 2) + 4 * h2; }
DI bf16x8 pack8(float a0, float a1, float a2, float a3, float a4, float a5, float a6, float a7) {
  u32x4 u;
  u.x = pack2(a0, a1); u.y = pack2(a2, a3); u.z = pack2(a4, a5); u.w = pack2(a6, a7);
  return __builtin_bit_cast(bf16x8, u);
}
DI bf16x8 ld2x4(const bf16_t* p0, const bf16_t* p1) {
  u32x2 a = *(const u32x2*)p0, b = *(const u32x2*)p1;
  u32x4 u; u.x = a.x; u.y = a.y; u.z = b.x; u.w = b.y;
  return __builtin_bit_cast(bf16x8, u);
}
DI void store8bf(bf16_t* dst, const float* v) {
  u32x4 u; u.x = pack2(v[0], v[1]); u.y = pack2(v[2], v[3]); u.z = pack2(v[4], v[5]); u.w = pack2(v[6], v[7]);
  *(u32x4*)dst = u;
}

struct MatDesc { const float* src; bf16_t* dst; int K, ldsrc, Ndst, map; const float* rowscale; };

DI int map_col(int map, int n) {
  if (map == 0) return n;
  if (map == 1) {
    if (n < 384) return n;
    if (n < 1920) return n + 32;
    if (n < 4480) return n + 48;
    if (n < 4512) return n - 4480 + 384;
    if (n < 4528) return n - 4512 + 1952;
    return -1;
  }
  if (n < 256) return (n >> 6) * 96 + (n & 63);
  return ((n - 256) >> 5) * 96 + 64 + ((n - 256) & 31);
}

DI MatDesc get_mat(CParams& p, int l, int id) {
  bf16_t* wb = (bf16_t*)(p.ws + OFF_WB);
  MatDesc d; d.map = 0; d.rowscale = nullptr;
  const size_t FF = (size_t)1024 * 2816;
  switch (id) {
    case 0: d.src = p.ff1_w1 + l * FF; d.dst = wb + W_FF1_1; d.K = 1024; d.ldsrc = 2816; d.Ndst = 2816; break;
    case 1: d.src = p.ff1_w3 + l * FF; d.dst = wb + W_FF1_3; d.K = 1024; d.ldsrc = 2816; d.Ndst = 2816; break;
    case 2: d.src = p.ff1_w2 + l * FF; d.dst = wb + W_FF1_2; d.K = 2816; d.ldsrc = 1024; d.Ndst = 1024; break;
    case 3: d.src = p.w_in + (size_t)l * 1024 * 4528; d.dst = wb + W_IN; d.K = 1024; d.ldsrc = 4528; d.Ndst = 4608; d.map = 1; break;
    case 4: d.src = p.mla_w_uq + (size_t)l * 256 * 384; d.dst = wb + W_UQ; d.K = 256; d.ldsrc = 384; d.Ndst = 384; d.map = 2; d.rowscale = p.mla_q_norm + l * 256; break;
    case 5: d.src = p.mla_w_ukv + (size_t)l * 128 * 512; d.dst = wb + W_UKV; d.K = 128; d.ldsrc = 512; d.Ndst = 512; d.rowscale = p.mla_kv_norm + l * 128; break;
    case 6: case 7: case 8: case 9:
      d.src = p.w_gate + (size_t)(l * 4 + id - 6) * 1048576; d.dst = wb + W_G + (size_t)(id - 6) * 1048576; d.K = 1024; d.ldsrc = 1024; d.Ndst = 1024; break;
    case 10: case 11: case 12: case 13:
      d.src = p.w_branch + (size_t)(l * 4 + id - 10) * 262144; d.dst = wb + W_B + (size_t)(id - 10) * 262144; d.K = 256; d.ldsrc = 1024; d.Ndst = 1024; break;
    case 14: d.src = p.w_out + (size_t)l * 1048576; d.dst = wb + W_O; d.K = 1024; d.ldsrc = 1024; d.Ndst = 1024; break;
    case 15: d.src = p.ff2_w1 + l * FF; d.dst = wb + W_FF2_1; d.K = 1024; d.ldsrc = 2816; d.Ndst = 2816; break;
    case 16: d.src = p.ff2_w3 + l * FF; d.dst = wb + W_FF2_3; d.K = 1024; d.ldsrc = 2816; d.Ndst = 2816; break;
    case 17: d.src = p.ff2_w2 + l * FF; d.dst = wb + W_FF2_2; d.K = 2816; d.ldsrc = 1024; d.Ndst = 1024; break;
    case 18: d.src = p.ple_gate + (size_t)l * 1048576; d.dst = wb + W_PG; d.K = 1024; d.ldsrc = 1024; d.Ndst = 1024; break;
    default: d.src = p.ple_proj + (size_t)l * 262144; d.dst = wb + W_PP; d.K = 256; d.ldsrc = 1024; d.Ndst = 1024; break;
  }
  return d;
}

DI void phase_convert(CParams& p, int l, char* lds) {
  float* T = (float*)lds;
  const int tid = threadIdx.x + opq();
  for (int id = 0; id < 20; ++id) {
    MatDesc d = get_mat(p, l, id);
    const int nkt = d.K >> 6, nnt = d.Ndst >> 6, nt_all = nkt * nnt;
    for (int t = blockIdx.x; t < nt_all; t += gridDim.x) {
      const int kt = t / nnt, nt = t % nnt;
      __syncthreads();
      {
        const int nl = tid & 63;
        const int sc = map_col(d.map, nt * 64 + nl);
#pragma unroll 4
        for (int i = 0; i < 16; ++i) {
          const int kl = (tid >> 6) + 4 * i;
          const int k = kt * 64 + kl;
          float v = 0.f;
          if (sc >= 0) v = d.src[(size_t)k * d.ldsrc + sc];
          if (d.rowscale) v *= d.rowscale[k];
          T[kl * 65 + nl] = v;
        }
      }
      __syncthreads();
      {
        const int kl = tid & 63;
#pragma unroll 4
        for (int i = 0; i < 16; ++i) {
          const int nl = (tid >> 6) + 4 * i;
          d.dst[(size_t)(nt * 64 + nl) * d.K + kt * 64 + kl] = f2bf(T[kl * 65 + nl]);
        }
      }
    }
  }
}

DI void phase_init(CParams& p, char* lds) {
  const size_t gtid = (size_t)blockIdx.x * 256 + threadIdx.x + opq(), gn = (size_t)gridDim.x * 256;
  {
    float2* t32 = (float2*)(p.ws + OFF_TAB);
    float2* t64 = (float2*)(p.ws + OFF_TAB + 2 * MiB);
    for (size_t i = gtid; i < (size_t)16384 * 48; i += gn) {
      const int pos = (int)(i / 48), f = (int)(i % 48);
      float inv;
      if (f < 16) inv = exp2f(-(float)f * (13.287712379549449f / 16.f));
      else inv = exp2f(-(float)(f - 16) * (13.287712379549449f / 32.f));
      const float ang = (float)pos * inv;
      const double xd = (double)ang;
      const double n = rint(xd * 0.15915494309189535);
      const float rf = (float)(xd - n * 6.283185307179586);
      float2 cs; cs.x = __cosf(rf); cs.y = __sinf(rf);
      if (f < 16) t32[(size_t)pos * 16 + f] = cs; else t64[(size_t)pos * 32 + (f - 16)] = cs;
    }
  }
  if (blockIdx.x == 0) ((int*)(p.ws + OFF_CNT))[threadIdx.x] = 0;
  phase_convert(p, 0, lds);
}

DI void phase_norm(const float* __restrict__ x, const float* __restrict__ g, bf16_t* __restrict__ dst,
                           const float* __restrict__ psrc, bf16_t* __restrict__ pdst) {
  const int tidq = threadIdx.x + opq(); const int wave = tidq >> 6, lane = tidq & 63;
  for (int r = blockIdx.x * 4 + wave; r < TG; r += gridDim.x * 4) {
    const float4* xr = (const float4*)(x + (size_t)r * 1024);
    float4 v[4];
    float ss = 0.f;
#pragma unroll
    for (int i = 0; i < 4; ++i) { v[i] = xr[lane + 64 * i]; ss += v[i].x * v[i].x + v[i].y * v[i].y + v[i].z * v[i].z + v[i].w * v[i].w; }
    ss = wave_sum(ss);
    const float rs = rsqrtf(ss * (1.f / 1024.f) + EPS);
#pragma unroll
    for (int i = 0; i < 4; ++i) {
      const float4 gg = ((const float4*)g)[lane + 64 * i];
      u32x2 o; o.x = pack2(v[i].x * rs * gg.x, v[i].y * rs * gg.y); o.y = pack2(v[i].z * rs * gg.z, v[i].w * rs * gg.w);
      ((u32x2*)(dst + (size_t)r * 1024))[lane + 64 * i] = o;
    }
    if (psrc) {
      const float4 pv = ((const float4*)(psrc + (size_t)r * 256))[lane];
      u32x2 o; o.x = pack2(pv.x, pv.y); o.y = pack2(pv.z, pv.w);
      ((u32x2*)(pdst + (size_t)r * 256))[lane] = o;
    }
  }
}

DI void phase_final_norm(float* __restrict__ x, const float* __restrict__ g) {
  const int tidq = threadIdx.x + opq(); const int wave = tidq >> 6, lane = tidq & 63;
  for (int r = blockIdx.x * 4 + wave; r < 2 * TG; r += gridDim.x * 4) {
    float4* xr = (float4*)(x + (size_t)r * 1024);
    float4 v[4];
    float ss = 0.f;
#pragma unroll
    for (int i = 0; i < 4; ++i) { v[i] = xr[lane + 64 * i]; ss += v[i].x * v[i].x + v[i].y * v[i].y + v[i].z * v[i].z + v[i].w * v[i].w; }
    ss = wave_sum(ss);
    const float rs = rsqrtf(ss * (1.f / 1024.f) + EPS);
#pragma unroll
    for (int i = 0; i < 4; ++i) {
      const float4 gg = ((const float4*)g)[lane + 64 * i];
      float4 o; o.x = v[i].x * rs * gg.x; o.y = v[i].y * rs * gg.y; o.z = v[i].z * rs * gg.z; o.w = v[i].w * rs * gg.w;
      xr[lane + 64 * i] = o;
    }
  }
}

template <int NI, int NB, bool SWAP = false>
DI void gemm_main(f32x16 (&acc0)[2][NI], f32x16 (&acc1)[2][NI], const bf16_t* __restrict__ A, int lda,
                  const bf16_t* __restrict__ B0, const bf16_t* __restrict__ B1, int ldb, int K, char* lds) {
  const int tid = threadIdx.x + opq(), lane = tid & 63, w = tid >> 6, wm = w >> 1, wn = w & 1, l31 = lane & 31, h2 = lane >> 5;
  bf16_t* As = (bf16_t*)lds;
  bf16_t* B0s = As + 128 * 72;
  bf16_t* B1s = B0s + 64 * NI * 72;
  const int lr = tid >> 3, lc = (tid & 7) * 8;
  u32x4 ra[4], rb0[2 * NI], rb1[2 * NI];
  const bf16_t* ap = A + (size_t)lr * lda + lc;
  const bf16_t* bp0 = B0 + (size_t)lr * ldb + lc;
  const bf16_t* bp1 = (NB == 2) ? (B1 + (size_t)lr * ldb + lc) : B0;
#pragma unroll
  for (int i = 0; i < 4; ++i) ra[i] = *(const u32x4*)(ap + (size_t)(32 * i) * lda);
#pragma unroll
  for (int i = 0; i < 2 * NI; ++i) {
    rb0[i] = *(const u32x4*)(bp0 + (size_t)(32 * i) * ldb);
    if (NB == 2) rb1[i] = *(const u32x4*)(bp1 + (size_t)(32 * i) * ldb);
  }
  for (int k0 = 0; k0 < K; k0 += 64) {
    __syncthreads();
#pragma unroll
    for (int i = 0; i < 4; ++i) *(u32x4*)(As + (lr + 32 * i) * 72 + lc) = ra[i];
#pragma unroll
    for (int i = 0; i < 2 * NI; ++i) {
      *(u32x4*)(B0s + (lr + 32 * i) * 72 + lc) = rb0[i];
      if (NB == 2) *(u32x4*)(B1s + (lr + 32 * i) * 72 + lc) = rb1[i];
    }
    if (k0 + 64 < K) {
      const int kn = k0 + 64;
#pragma unroll
      for (int i = 0; i < 4; ++i) ra[i] = *(const u32x4*)(ap + (size_t)(32 * i) * lda + kn);
#pragma unroll
      for (int i = 0; i < 2 * NI; ++i) {
        rb0[i] = *(const u32x4*)(bp0 + (size_t)(32 * i) * ldb + kn);
        if (NB == 2) rb1[i] = *(const u32x4*)(bp1 + (size_t)(32 * i) * ldb + kn);
      }
    }
    __syncthreads();
    __builtin_amdgcn_s_setprio(1);
#pragma unroll
    for (int ks = 0; ks < 4; ++ks) {
      bf16x8 af[2], bf0[NI], bf1[NI];
#pragma unroll
      for (int mi = 0; mi < 2; ++mi) af[mi] = *(const bf16x8*)(As + (64 * wm + 32 * mi + l31) * 72 + 16 * ks + 8 * h2);
#pragma unroll
      for (int ni = 0; ni < NI; ++ni) {
        bf0[ni] = *(const bf16x8*)(B0s + (32 * NI * wn + 32 * ni + l31) * 72 + 16 * ks + 8 * h2);
        if (NB == 2) bf1[ni] = *(const bf16x8*)(B1s + (32 * NI * wn + 32 * ni + l31) * 72 + 16 * ks + 8 * h2);
      }
#pragma unroll
      for (int mi = 0; mi < 2; ++mi)
#pragma unroll
        for (int ni = 0; ni < NI; ++ni) {
          acc0[mi][ni] = SWAP ? MFMA32(bf0[ni], af[mi], acc0[mi][ni]) : MFMA32(af[mi], bf0[ni], acc0[mi][ni]);
          if (NB == 2) acc1[mi][ni] = SWAP ? MFMA32(bf1[ni], af[mi], acc1[mi][ni]) : MFMA32(af[mi], bf1[ni], acc1[mi][ni]);
        }
    }
    __builtin_amdgcn_s_setprio(0);
  }
}

template <int NI>
DI void zero_acc(f32x16 (&a)[2][NI]) {
#pragma unroll
  for (int mi = 0; mi < 2; ++mi)
#pragma unroll
    for (int ni = 0; ni < NI; ++ni)
#pragma unroll
      for (int r = 0; r < 16; ++r) a[mi][ni][r] = 0.f;
}

#define EPI_VARS const int tid = threadIdx.x + opq(), lane = tid & 63, w = tid >> 6, wm = w >> 1, wn = w & 1, l31 = lane & 31, h2 = lane >> 5; (void)tid; (void)lane; (void)w
#define EPI_BEGIN(NI_) _Pragma("unroll") for (int mi = 0; mi < 2; ++mi) _Pragma("unroll") for (int ni = 0; ni < NI_; ++ni) _Pragma("unroll") for (int r = 0; r < 16; ++r) { \
    const int row = 64 * wm + 32 * mi + crow(r, h2); const int col = 32 * NI_ * wn + 32 * ni + l31;
#define EPI_END }

DI bool xcd_tile(int iter, int MT, int NT, int& mt, int& nt) {
  const int x = blockIdx.x & 7, lb = blockIdx.x >> 3, nb = gridDim.x >> 3;
  if (NT == 8) {
    const int j = lb + iter * nb;
    if (lb >= nb || j >= MT) return false;
    mt = (x & 1) * (MT >> 1) + (j >> 1);
    nt = 2 * (x >> 1) + (j & 1);
    return true;
  }
  const int full = NT >> 3, rem = NT & 7;
  const int per_full = full * MT, rem_tot = rem * MT;
  const int r0 = (rem_tot * x) >> 3, r1 = (rem_tot * (x + 1)) >> 3;
  const int j = lb + iter * nb;
  if (lb >= nb || j >= per_full + (r1 - r0)) return false;
  if (j < per_full) { mt = j / full; nt = x * full + j % full; }
  else { const int u = r0 + (j - per_full); nt = 8 * full + u / MT; mt = u % MT; }
  return true;
}

DI void phase_ffn_a(const bf16_t* __restrict__ Nb, const bf16_t* __restrict__ W1, const bf16_t* __restrict__ W3,
                            bf16_t* __restrict__ H, char* lds) {
  EPI_VARS;
  for (int iter = 0;; ++iter) {
    int mt, nt;
    if (!xcd_tile(iter, 256, 22, mt, nt)) break;
    f32x16 a0[2][2], a1[2][2];
    zero_acc<2>(a0); zero_acc<2>(a1);
    gemm_main<2, 2, true>(a0, a1, Nb + (size_t)mt * 128 * 1024, 1024, W1 + (size_t)nt * 128 * 1024, W3 + (size_t)nt * 128 * 1024, 1024, 1024, lds);
#pragma unroll
    for (int mi = 0; mi < 2; ++mi)
#pragma unroll
      for (int ni = 0; ni < 2; ++ni) {
        bf16_t* hp = H + (size_t)(mt * 128 + 64 * wm + 32 * mi + l31) * 2816 + nt * 128 + 64 * wn + 32 * ni + 4 * h2;
#pragma unroll
        for (int g = 0; g < 4; ++g) {
          u32x2 o;
          o.x = pack2(siluf_(a0[mi][ni][4 * g]) * a1[mi][ni][4 * g], siluf_(a0[mi][ni][4 * g + 1]) * a1[mi][ni][4 * g + 1]);
          o.y = pack2(siluf_(a0[mi][ni][4 * g + 2]) * a1[mi][ni][4 * g + 2], siluf_(a0[mi][ni][4 * g + 3]) * a1[mi][ni][4 * g + 3]);
          *(u32x2*)(hp + 8 * g) = o;
        }
      }
  }
}

DI void phase_gemm_resid(const bf16_t* __restrict__ A, int K, const bf16_t* __restrict__ Bt, const float* xsrc, float* x,
                                 float scale, char* lds) {
  EPI_VARS;
  for (int iter = 0;; ++iter) {
    int mt, nt;
    if (!xcd_tile(iter, 256, 4, mt, nt)) break;
    f32x16 a0[2][4];
    zero_acc<4>(a0);
    gemm_main<4, 1, true>(a0, a0, A + (size_t)mt * 128 * K, K, Bt + (size_t)nt * 256 * K, nullptr, K, K, lds);
#pragma unroll
    for (int mi = 0; mi < 2; ++mi)
#pragma unroll
      for (int ni = 0; ni < 4; ++ni) {
        float4 xs[4];
        const size_t base = (size_t)(mt * 128 + 64 * wm + 32 * mi + l31) * 1024 + nt * 256 + 128 * wn + 32 * ni + 4 * h2;
#pragma unroll
        for (int g = 0; g < 4; ++g) xs[g] = *(const float4*)(xsrc + base + 8 * g);
#pragma unroll
        for (int g = 0; g < 4; ++g) {
          float4 o;
          o.x = xs[g].x + scale * a0[mi][ni][4 * g];
          o.y = xs[g].y + scale * a0[mi][ni][4 * g + 1];
          o.z = xs[g].z + scale * a0[mi][ni][4 * g + 2];
          o.w = xs[g].w + scale * a0[mi][ni][4 * g + 3];
          *(float4*)(x + base + 8 * g) = o;
        }
      }
  }
}

DI void phase_ple(const bf16_t* __restrict__ Nb, const bf16_t* __restrict__ PB, const bf16_t* __restrict__ PG,
                          const bf16_t* __restrict__ PP, float* __restrict__ x, char* lds) {
  EPI_VARS;
  for (int iter = 0;; ++iter) {
    int mt, nt;
    if (!xcd_tile(iter, 256, 8, mt, nt)) break;
    f32x16 a0[2][2], a1[2][2];
    zero_acc<2>(a0); zero_acc<2>(a1);
    gemm_main<2, 1, true>(a0, a0, Nb + (size_t)mt * 128 * 1024, 1024, PG + (size_t)nt * 128 * 1024, nullptr, 1024, 1024, lds);
    gemm_main<2, 1, true>(a1, a1, PB + (size_t)mt * 128 * 256, 256, PP + (size_t)nt * 128 * 256, nullptr, 256, 256, lds);
#pragma unroll
    for (int mi = 0; mi < 2; ++mi)
#pragma unroll
      for (int ni = 0; ni < 2; ++ni) {
        float* xp = x + (size_t)(mt * 128 + 64 * wm + 32 * mi + l31) * 1024 + nt * 128 + 64 * wn + 32 * ni + 4 * h2;
        float4 xs[4];
#pragma unroll
        for (int g = 0; g < 4; ++g) xs[g] = *(const float4*)(xp + 8 * g);
#pragma unroll
        for (int g = 0; g < 4; ++g) {
          float4 o;
          o.x = xs[g].x + sigmoidf_(a0[mi][ni][4 * g]) * a1[mi][ni][4 * g];
          o.y = xs[g].y + sigmoidf_(a0[mi][ni][4 * g + 1]) * a1[mi][ni][4 * g + 1];
          o.z = xs[g].z + sigmoidf_(a0[mi][ni][4 * g + 2]) * a1[mi][ni][4 * g + 2];
          o.w = xs[g].w + sigmoidf_(a0[mi][ni][4 * g + 3]) * a1[mi][ni][4 * g + 3];
          *(float4*)(xp + 8 * g) = o;
        }
      }
  }
}

DI void phase_merge(const bf16_t* __restrict__ Np, const bf16_t* __restrict__ Y, const bf16_t* __restrict__ WG,
                            const bf16_t* __restrict__ WB, bf16_t* __restrict__ M, char* lds) {
  EPI_VARS;
  for (int iter = 0;; ++iter) {
    int mt, nt;
    if (!xcd_tile(iter, 256, 8, mt, nt)) break;
    f32x16 am[2][2];
    zero_acc<2>(am);
#pragma unroll 1
    for (int n = 0; n < 4; ++n) {
      unsigned sg[2][2][8];
      {
        f32x16 ag[2][2];
        zero_acc<2>(ag);
        gemm_main<2, 1, true>(ag, ag, Np + (size_t)mt * 128 * 1024, 1024, WG + (size_t)n * 1048576 + (size_t)nt * 128 * 1024, nullptr, 1024, 1024, lds);
#pragma unroll
        for (int mi = 0; mi < 2; ++mi)
#pragma unroll
          for (int ni = 0; ni < 2; ++ni)
#pragma unroll
            for (int r = 0; r < 8; ++r) sg[mi][ni][r] = pack2(sigmoidf_(ag[mi][ni][2 * r]), sigmoidf_(ag[mi][ni][2 * r + 1]));
      }
      f32x16 ab[2][2];
      zero_acc<2>(ab);
      gemm_main<2, 1, true>(ab, ab, Y + (size_t)mt * 128 * 1024 + n * 256, 1024, WB + (size_t)n * 262144 + (size_t)nt * 128 * 256, nullptr, 256, 256, lds);
#pragma unroll
      for (int mi = 0; mi < 2; ++mi)
#pragma unroll
        for (int ni = 0; ni < 2; ++ni)
#pragma unroll
          for (int r = 0; r < 8; ++r) {
            am[mi][ni][2 * r] += __uint_as_float(sg[mi][ni][r] << 16) * ab[mi][ni][2 * r];
            am[mi][ni][2 * r + 1] += __uint_as_float(sg[mi][ni][r] & 0xffff0000u) * ab[mi][ni][2 * r + 1];
          }
    }
#pragma unroll
    for (int mi = 0; mi < 2; ++mi)
#pragma unroll
      for (int ni = 0; ni < 2; ++ni) {
        bf16_t* mp = M + (size_t)(mt * 128 + 64 * wm + 32 * mi + l31) * 1024 + nt * 128 + 64 * wn + 32 * ni + 4 * h2;
#pragma unroll
        for (int g = 0; g < 4; ++g) {
          u32x2 o;
          o.x = pack2(am[mi][ni][4 * g], am[mi][ni][4 * g + 1]);
          o.y = pack2(am[mi][ni][4 * g + 2], am[mi][ni][4 * g + 3]);
          *(u32x2*)(mp + 8 * g) = o;
        }
      }
  }
}

DI void rope32_out(const float* c, const float2* tab, float sc, float* o) {
#pragma unroll
  for (int i = 0; i < 16; ++i) {
    const float2 cs = tab[i];
    const float a = c[i], b = c[16 + i];
    o[i] = (a * cs.x - b * cs.y) * sc;
    o[16 + i] = (b * cs.x + a * cs.y) * sc;
  }
}

DI void phase_proj(CParams& p, const bf16_t* __restrict__ Nb, const bf16_t* __restrict__ WIN, int S, char* lds) {
  EPI_VARS;
  bf16_t* PR = (bf16_t*)(p.ws + OFF_PR);
  float* AB = (float*)(p.ws + OFF_AB);
  const float2* t32 = (const float2*)(p.ws + OFF_TAB);
  const float2* t64 = (const float2*)(p.ws + OFF_TAB + 2 * MiB);
  float* Ct = (float*)lds;
  for (int iter = 0;; ++iter) {
    int mt, nt2;
    if (!xcd_tile(iter, 256, 18, mt, nt2)) break;
    f32x16 a0[2][4];
    zero_acc<4>(a0);
    gemm_main<4, 1>(a0, a0, Nb + (size_t)mt * 128 * 1024, 1024, WIN + (size_t)nt2 * 256 * 1024, nullptr, 1024, 1024, lds);
   for (int hv = 0; hv < 2; ++hv) {
    const int nt = 2 * nt2 + hv;
    __syncthreads();
    if (wn == hv) {
#pragma unroll
      for (int mi = 0; mi < 2; ++mi)
#pragma unroll
        for (int ni = 0; ni < 4; ++ni)
#pragma unroll
          for (int r = 0; r < 16; ++r) Ct[(64 * wm + 32 * mi + crow(r, h2)) * 132 + 32 * ni + l31] = a0[mi][ni][r];
    }
    __syncthreads();
    const int erow = tid >> 1, half = tid & 1;
    const int tok = mt * 128 + erow, pos = tok & (S - 1);
    const float* cr = Ct + erow * 132 + 64 * half;
    bf16_t* dst = PR + (size_t)tok * NPR + nt * 128 + 64 * half;
    int type = 0; float sc = 1.f;
    if (nt == 3 || nt == 4) { type = 1; sc = 0.17677669529663687f * LOG2E; }
    else if (nt == 5 || nt == 6) { type = 1; }
    else if (nt >= 17 && nt <= 22) { type = 2; sc = 0.125f * LOG2E; }
    else if (nt >= 23 && nt <= 28) { type = 2; }
    else if (nt == 35) type = 3;
    if (type == 0) {
#pragma unroll
      for (int j = 0; j < 8; ++j) store8bf(dst + 8 * j, cr + 8 * j);
    } else if (type == 1) {
#pragma unroll
      for (int hh = 0; hh < 2; ++hh) {
        float o[32];
        rope32_out(cr + 32 * hh, t32 + (size_t)pos * 16, sc, o);
#pragma unroll
        for (int j = 0; j < 4; ++j) store8bf(dst + 32 * hh + 8 * j, o + 8 * j);
      }
    } else if (type == 2) {
      const float2* tab = t64 + (size_t)pos * 32;
#pragma unroll
      for (int j = 0; j < 4; ++j) {
        float lo[8], hi[8];
#pragma unroll
        for (int e = 0; e < 8; ++e) {
          const float2 cs = tab[8 * j + e];
          const float a = cr[8 * j + e], b = cr[32 + 8 * j + e];
          lo[e] = (a * cs.x - b * cs.y) * sc;
          hi[e] = (b * cs.x + a * cs.y) * sc;
        }
        store8bf(dst + 8 * j, lo);
        store8bf(dst + 32 + 8 * j, hi);
      }
    } else {
      if (half == 0) {
        float o[32];
        rope32_out(cr, t32 + (size_t)pos * 16, 1.f, o);
#pragma unroll
        for (int j = 0; j < 4; ++j) store8bf(dst + 8 * j, o + 8 * j);
      } else {
        const float* c2 = Ct + erow * 132 + 32;
#pragma unroll
        for (int j = 0; j < 4; ++j) {
          float4 v; v.x = c2[4 * j]; v.y = c2[4 * j + 1]; v.z = c2[4 * j + 2]; v.w = c2[4 * j + 3];
          ((float4*)(AB + (size_t)tok * 16))[j] = v;
        }
      }
    }
   }
  }
}

DI void mla_up_tile(CParams& p, int mt, int j, int S, char* lds) {
  EPI_VARS;
  const bf16_t* PR = (const bf16_t*)(p.ws + OFF_PR);
  const bf16_t* wb = (const bf16_t*)(p.ws + OFF_WB);
  bf16_t* Qb = (bf16_t*)(p.ws + OFF_Q);
  bf16_t* Kb = (bf16_t*)(p.ws + OFF_K);
  bf16_t* Vb = (bf16_t*)(p.ws + OFF_V);
  const float2* t32 = (const float2*)(p.ws + OFF_TAB);
  float* Ct = (float*)lds;
  float* rst = (float*)(lds + 67584);
  const bool isq = j < 3;
  const int K = isq ? 256 : 128;
  const int nt = isq ? j : j - 3;
  const bf16_t* A = PR + (size_t)mt * 128 * NPR + (isq ? C_CQ : C_CKV);
  const bf16_t* B = wb + (isq ? W_UQ : W_UKV) + (size_t)nt * 128 * K;
  const int erow = tid >> 1, half = tid & 1;
  {
    const bf16_t* ar = A + (size_t)erow * NPR + half * (K / 2);
    float ss = 0.f;
    for (int c = 0; c < K / 16; ++c) {
      const u32x4 u = *(const u32x4*)(ar + 8 * c);
      const unsigned uu[4] = {u.x, u.y, u.z, u.w};
#pragma unroll
      for (int e = 0; e < 4; ++e) {
        const float lo = __uint_as_float(uu[e] << 16), hi = __uint_as_float(uu[e] & 0xffff0000u);
        ss += lo * lo + hi * hi;
      }
    }
    ss += __shfl_xor(ss, 1);
    if (half == 0) rst[erow] = rsqrtf(ss / (float)K + EPS);
  }
  f32x16 a0[2][2];
  zero_acc<2>(a0);
  gemm_main<2, 1>(a0, a0, A, NPR, B, nullptr, K, K, lds);
  __syncthreads();
  EPI_BEGIN(2)
    Ct[row * 132 + col] = a0[mi][ni][r];
  EPI_END
  __syncthreads();
  const int tok = mt * 128 + erow, pos = tok & (S - 1);
  const float rs = rst[erow];
  const float* cr = Ct + erow * 132 + 64 * half;
  if (isq) {
    const float sc = rs * 0.10206207261596577f * LOG2E;
    if (nt < 2) {
      bf16_t* dst = Qb + ((size_t)tok * 4 + 2 * nt + half) * 96;
#pragma unroll
      for (int jj = 0; jj < 8; ++jj) {
        float o[8];
#pragma unroll
        for (int e = 0; e < 8; ++e) o[e] = cr[8 * jj + e] * sc;
        store8bf(dst + 8 * jj, o);
      }
    } else {
#pragma unroll
      for (int hh = 0; hh < 2; ++hh) {
        float o[32];
        rope32_out(cr + 32 * hh, t32 + (size_t)pos * 16, sc, o);
        bf16_t* dst = Qb + ((size_t)tok * 4 + 2 * half + hh) * 96 + 64;
#pragma unroll
        for (int jj = 0; jj < 4; ++jj) store8bf(dst + 8 * jj, o + 8 * jj);
      }
    }
  } else {
    bf16_t* dst = half == 0 ? (Kb + ((size_t)tok * 4 + nt) * 96) : (Vb + ((size_t)tok * 4 + nt) * 64);
#pragma unroll
    for (int jj = 0; jj < 8; ++jj) {
      float o[8];
#pragma unroll
      for (int e = 0; e < 8; ++e) o[e] = cr[8 * jj + e] * rs;
      store8bf(dst + 8 * jj, o);
    }
    if (half == 0) {
      const u32x4* src = (const u32x4*)(PR + (size_t)tok * NPR + 4480);
#pragma unroll
      for (int jj = 0; jj < 4; ++jj) ((u32x4*)(dst + 64))[jj] = src[jj];
    }
  }
}

typedef short s16x4_t __attribute__((ext_vector_type(4)));
DI bf16x8 tr_pair(const bf16_t* p0, const bf16_t* p1) {
  const s16x4_t lo = __builtin_amdgcn_ds_read_tr16_b64_v4i16((__attribute__((address_space(3))) s16x4_t*)p0);
  const s16x4_t hi = __builtin_amdgcn_ds_read_tr16_b64_v4i16((__attribute__((address_space(3))) s16x4_t*)p1);
  return __builtin_shufflevector(lo, hi, 0, 1, 2, 3, 4, 5, 6, 7);
}

template <int DK, bool BAND>
DI void flash_loop(f32x16 (&O)[2], float& m, float& l, const bf16_t* __restrict__ qrow, const bf16_t* __restrict__ kbase,
                   size_t kstride, const bf16_t* __restrict__ vbase, size_t vstride, int ntiles, int tq, int u0, int L,
                   char* lds) {
  const int tid = threadIdx.x + opq(), lane = tid & 63, l31 = lane & 31, h2 = lane >> 5;
  constexpr int KR = DK + 8, KCH = DK / 8, KN = 64 * KCH / 256;
  constexpr int STAGE = 64 * KR * 2 + 64 * 72 * 2;
  bf16x8 qf[DK / 16];
#pragma unroll
  for (int ks = 0; ks < DK / 16; ++ks) qf[ks] = *(const bf16x8*)(qrow + 16 * ks + 8 * h2);
  u32x4 rkA[KN], rvA[2], rkB[KN], rvB[2];
  auto gload = [&](int kt, u32x4 (&rk)[KN], u32x4 (&rv)[2]) {
#pragma unroll
    for (int i = 0; i < KN; ++i) {
      const int ci = tid + 256 * i, row = ci / KCH, c = ci % KCH;
      int rr = u0 + 64 * kt + row;
      if (BAND) rr = min(max(rr, 0), L - 1);
      rk[i] = *(const u32x4*)(kbase + (size_t)rr * kstride + c * 8);
    }
#pragma unroll
    for (int i = 0; i < 2; ++i) {
      const int ci = tid + 256 * i, row = ci >> 3, c = ci & 7;
      int rr = u0 + 64 * kt + row;
      if (BAND) rr = min(max(rr, 0), L - 1);
      rv[i] = *(const u32x4*)(vbase + (size_t)rr * vstride + c * 8);
    }
  };
  auto swrite = [&](int st, const u32x4 (&rk)[KN], const u32x4 (&rv)[2]) {
    bf16_t* Ks = (bf16_t*)(lds + st * STAGE);
    bf16_t* Vs = Ks + 64 * KR;
#pragma unroll
    for (int i = 0; i < KN; ++i) {
      const int ci = tid + 256 * i, row = ci / KCH, c = ci % KCH;
      *(u32x4*)(Ks + row * KR + c * 8) = rk[i];
    }
#pragma unroll
    for (int i = 0; i < 2; ++i) {
      const int ci = tid + 256 * i, row = ci >> 3, c = ci & 7;
      *(u32x4*)(Vs + row * 72 + c * 8) = rv[i];
    }
  };
  const int trq = (lane & 15) >> 2, trp = lane & 3, trblk = (lane >> 4) & 1;
  const int troff = (4 * h2 + trq) * 72 + 16 * trblk + 4 * trp;
  __syncthreads();
  gload(0, rkA, rvA);
  swrite(0, rkA, rvA);
  gload(1, rkA, rvA);
  if (ntiles > 2) gload(2, rkB, rvB);
  for (int kt2 = 0; kt2 < ntiles; kt2 += 2)
#pragma unroll
  for (int par = 0; par < 2; ++par) {
    const int kt = kt2 + par;
    __syncthreads();
    if (par == 0) {
      if (kt + 1 < ntiles) swrite((kt + 1) & 1, rkA, rvA);
      if (kt + 3 < ntiles) gload(kt + 3, rkA, rvA);
    } else {
      if (kt + 1 < ntiles) swrite((kt + 1) & 1, rkB, rvB);
      if (kt + 3 < ntiles) gload(kt + 3, rkB, rvB);
    }
    const bf16_t* Ks = (const bf16_t*)(lds + (kt & 1) * STAGE);
    const bf16_t* Vs = Ks + 64 * KR;
    f32x16 Sx[2];
#pragma unroll
    for (int j = 0; j < 2; ++j)
#pragma unroll
      for (int r = 0; r < 16; ++r) Sx[j][r] = 0.f;
#pragma unroll
    for (int ks = 0; ks < DK / 16; ++ks)
#pragma unroll
      for (int j = 0; j < 2; ++j) {
        const bf16x8 kf = *(const bf16x8*)(Ks + (32 * j + l31) * KR + 16 * ks + 8 * h2);
        Sx[j] = MFMA32(kf, qf[ks], Sx[j]);
      }
    if (BAND) {
#pragma unroll
      for (int j = 0; j < 2; ++j)
#pragma unroll
        for (int r = 0; r < 16; ++r) {
          const int u = u0 + 64 * kt + 32 * j + crow(r, h2);
          const int d = u - tq;
          const bool valid = (d <= 64) && (d >= -64) && (u >= 0) && (u < L);
          Sx[j][r] = valid ? Sx[j][r] : -1e30f;
        }
    }
    float mx = Sx[0][0];
#pragma unroll
    for (int j = 0; j < 2; ++j)
#pragma unroll
      for (int r = 0; r < 16; ++r) mx = fmaxf(mx, Sx[j][r]);
    mx = xhalf_max(mx);
    if (__any(mx - m > DEFER_THR)) {
      const float mn = fmaxf(m, mx);
      const float alpha = exp2_(m - mn);
      m = mn;
      l *= alpha;
#pragma unroll
      for (int t = 0; t < 2; ++t)
#pragma unroll
        for (int r = 0; r < 16; ++r) O[t][r] *= alpha;
    }
    float ls = 0.f;
#pragma unroll
    for (int j = 0; j < 2; ++j)
#pragma unroll
      for (int r = 0; r < 16; ++r) { const float pv = exp2_(Sx[j][r] - m); Sx[j][r] = pv; ls += pv; }
    l += ls;
#pragma unroll
    for (int j = 0; j < 2; ++j)
#pragma unroll
      for (int s = 0; s < 2; ++s) {
        const bf16x8 pf = pack8(Sx[j][8 * s], Sx[j][8 * s + 1], Sx[j][8 * s + 2], Sx[j][8 * s + 3], Sx[j][8 * s + 4],
                                Sx[j][8 * s + 5], Sx[j][8 * s + 6], Sx[j][8 * s + 7]);
#pragma unroll
        for (int t = 0; t < 2; ++t) {
          const bf16_t* vp = Vs + (32 * j + 16 * s) * 72 + 32 * t + troff;
          const bf16x8 vf = tr_pair(vp, vp + 8 * 72);
          O[t] = MFMA32(vf, pf, O[t]);
        }
      }
  }
}

DI void flash_loop_diff(f32x16 (&O0)[2], f32x16 (&O1)[2], float& m0, float& l0, float& m1, float& l1,
                        const bf16_t* __restrict__ qrow, const bf16_t* __restrict__ kbase, size_t kstride,
                        const bf16_t* __restrict__ vbase, size_t vstride, int ntiles, char* lds) {
  const int tid = threadIdx.x + opq(), lane = tid & 63, l31 = lane & 31, h2 = lane >> 5;
  constexpr int KR = 72;
  constexpr int STAGE = 64 * KR * 2 + 64 * 72 * 2;
  bf16x8 qf0[2], qf1[2];
#pragma unroll
  for (int ks = 0; ks < 2; ++ks) {
    qf0[ks] = *(const bf16x8*)(qrow + 16 * ks + 8 * h2);
    qf1[ks] = *(const bf16x8*)(qrow + 32 + 16 * ks + 8 * h2);
  }
  u32x4 rk[2], rv[2];
  auto gload = [&](int kt) {
#pragma unroll
    for (int i = 0; i < 2; ++i) {
      const int ci = tid + 256 * i, row = ci >> 3, c = ci & 7;
      const int rr = 64 * kt + row;
      rk[i] = *(const u32x4*)(kbase + (size_t)rr * kstride + c * 8);
      rv[i] = *(const u32x4*)(vbase + (size_t)rr * vstride + c * 8);
    }
  };
  auto swrite = [&](int st) {
    bf16_t* Ks = (bf16_t*)(lds + st * STAGE);
    bf16_t* Vs = Ks + 64 * KR;
#pragma unroll
    for (int i = 0; i < 2; ++i) {
      const int ci = tid + 256 * i, row = ci >> 3, c = ci & 7;
      *(u32x4*)(Ks + row * KR + c * 8) = rk[i];
      *(u32x4*)(Vs + row * 72 + c * 8) = rv[i];
    }
  };
  const int trq = (lane & 15) >> 2, trp = lane & 3, trblk = (lane >> 4) & 1;
  const int troff = (4 * h2 + trq) * 72 + 16 * trblk + 4 * trp;
  __syncthreads();
  gload(0);
  swrite(0);
  if (ntiles > 1) gload(1);
  for (int kt = 0; kt < ntiles; ++kt) {
    __syncthreads();
    if (kt + 1 < ntiles) swrite((kt + 1) & 1);
    if (kt + 2 < ntiles) gload(kt + 2);
    const bf16_t* Ks = (const bf16_t*)(lds + (kt & 1) * STAGE);
    const bf16_t* Vs = Ks + 64 * KR;
    bf16x8 pf[2][2][2];
#pragma unroll
    for (int mp = 0; mp < 2; ++mp) {
      f32x16 Sx[2];
#pragma unroll
      for (int j = 0; j < 2; ++j)
#pragma unroll
        for (int r = 0; r < 16; ++r) Sx[j][r] = 0.f;
#pragma unroll
      for (int ks = 0; ks < 2; ++ks)
#pragma unroll
        for (int j = 0; j < 2; ++j) {
          const bf16x8 kf = *(const bf16x8*)(Ks + (32 * j + l31) * KR + 32 * mp + 16 * ks + 8 * h2);
          Sx[j] = MFMA32(kf, mp == 0 ? qf0[ks] : qf1[ks], Sx[j]);
        }
      float& m = mp == 0 ? m0 : m1;
      float& l = mp == 0 ? l0 : l1;
      float mx = Sx[0][0];
#pragma unroll
      for (int j = 0; j < 2; ++j)
#pragma unroll
        for (int r = 0; r < 16; ++r) mx = fmaxf(mx, Sx[j][r]);
      mx = xhalf_max(mx);
      if (__any(mx - m > DEFER_THR)) {
        const float mn = fmaxf(m, mx);
        const float alpha = exp2_(m - mn);
        m = mn;
        l *= alpha;
#pragma unroll
        for (int t = 0; t < 2; ++t)
#pragma unroll
          for (int r = 0; r < 16; ++r) { if (mp == 0) O0[t][r] *= alpha; else O1[t][r] *= alpha; }
      }
      float ls = 0.f;
#pragma unroll
      for (int j = 0; j < 2; ++j)
#pragma unroll
        for (int r = 0; r < 16; ++r) { const float pv = exp2_(Sx[j][r] - m); Sx[j][r] = pv; ls += pv; }
      l += ls;
#pragma unroll
      for (int j = 0; j < 2; ++j)
#pragma unroll
        for (int s = 0; s < 2; ++s)
          pf[mp][j][s] = pack8(Sx[j][8 * s], Sx[j][8 * s + 1], Sx[j][8 * s + 2], Sx[j][8 * s + 3], Sx[j][8 * s + 4],
                               Sx[j][8 * s + 5], Sx[j][8 * s + 6], Sx[j][8 * s + 7]);
    }
#pragma unroll
    for (int j = 0; j < 2; ++j)
#pragma unroll
      for (int s = 0; s < 2; ++s)
#pragma unroll
        for (int t = 0; t < 2; ++t) {
          const bf16_t* vp = Vs + (32 * j + 16 * s) * 72 + 32 * t + troff;
          const bf16x8 vf = tr_pair(vp, vp + 8 * 72);
          O0[t] = MFMA32(vf, pf[0][j][s], O0[t]);
          O1[t] = MFMA32(vf, pf[1][j][s], O1[t]);
        }
  }
}

DI void zeroO(f32x16 (&O)[2]) {
#pragma unroll
  for (int t = 0; t < 2; ++t)
#pragma unroll
    for (int r = 0; r < 16; ++r) O[t][r] = 0.f;
}

DI void store_o(bf16_t* dst, const f32x16 (&O)[2], int h2) {
#pragma unroll
  for (int t = 0; t < 2; ++t)
#pragma unroll
    for (int g = 0; g < 4; ++g) {
      u32x2 u; u.x = pack2(O[t][4 * g], O[t][4 * g + 1]); u.y = pack2(O[t][4 * g + 2], O[t][4 * g + 3]);
      *(u32x2*)(dst + 32 * t + 8 * g + 4 * h2) = u;
    }
}

DI void mla_item(CParams& p, int it, int S, char* lds) {
  const int tid = threadIdx.x + opq(), lane = tid & 63, w = tid >> 6, l31 = lane & 31, h2 = lane >> 5;
  const int lgq = (S == 2048) ? 4 : 7;
  const int qb = it & ((1 << lgq) - 1), bh = it >> lgq, h = bh & 3, b = bh >> 2;
  const int tokbase = b * S, gtok = tokbase + 128 * qb + 32 * w + l31;
  const bf16_t* Qb = (const bf16_t*)(p.ws + OFF_Q);
  const bf16_t* Kb = (const bf16_t*)(p.ws + OFF_K);
  const bf16_t* Vb = (const bf16_t*)(p.ws + OFF_V);
  bf16_t* Y = (bf16_t*)(p.ws + OFF_N);
  f32x16 O[2]; zeroO(O);
  float m = -1e30f, l = 0.f;
  flash_loop<96, false>(O, m, l, Qb + ((size_t)gtok * 4 + h) * 96, Kb + ((size_t)tokbase * 4 + h) * 96, 384,
                        Vb + ((size_t)tokbase * 4 + h) * 64, 256, S / 64, 0, 0, 0, lds);
  l += __shfl_xor(l, 32);
  const float il = 1.f / l;
#pragma unroll
  for (int t = 0; t < 2; ++t)
#pragma unroll
    for (int r = 0; r < 16; ++r) O[t][r] *= il;
  store_o(Y + (size_t)gtok * 1024 + h * 64, O, h2);
}

DI void diff_item(CParams& p, int layer, int it, int S, char* lds) {
  const int tid = threadIdx.x + opq(), lane = tid & 63, w = tid >> 6, l31 = lane & 31, h2 = lane >> 5;
  const int lgq = (S == 2048) ? 4 : 7;
  const int qb = it & ((1 << lgq) - 1), bh = it >> lgq, h = bh & 3, b = bh >> 2;
  const int tokbase = b * S, gtok = tokbase + 128 * qb + 32 * w + l31;
  const bf16_t* PR = (const bf16_t*)(p.ws + OFF_PR);
  bf16_t* Y = (bf16_t*)(p.ws + OFF_N);
  const float* lam = p.diff_lambda + layer * 128;
  float s1 = 0.f, s2 = 0.f;
  if (lane < 32) { s1 = lam[lane] * lam[32 + lane]; s2 = lam[64 + lane] * lam[96 + lane]; }
  s1 = wave_sum(s1); s2 = wave_sum(s2);
  const float lambda_init = layer ? 0.35550907f : 0.2f;
  const float lambda_full = expf(s1) - expf(s2) + lambda_init;
  f32x16 of[2], O1[2];
  zeroO(of); zeroO(O1);
  {
    float m0 = -1e30f, l0 = 0.f, m1 = -1e30f, l1 = 0.f;
    flash_loop_diff(of, O1, m0, l0, m1, l1, PR + (size_t)gtok * NPR + C_BQ + (2 * h) * 32,
                    PR + (size_t)tokbase * NPR + C_BK + (2 * h) * 32, NPR, PR + (size_t)tokbase * NPR + C_BV + h * 64, NPR,
                    S / 64, lds);
    l0 += __shfl_xor(l0, 32);
    l1 += __shfl_xor(l1, 32);
    const float c0 = 1.f / l0, c1 = -lambda_full / l1;
#pragma unroll
    for (int t = 0; t < 2; ++t)
#pragma unroll
      for (int r = 0; r < 16; ++r) of[t][r] = c0 * of[t][r] + c1 * O1[t][r];
  }
  float ss = 0.f;
#pragma unroll
  for (int t = 0; t < 2; ++t)
#pragma unroll
    for (int r = 0; r < 16; ++r) ss += of[t][r] * of[t][r];
  ss += __shfl_xor(ss, 32);
  const float rs = rsqrtf(ss * (1.f / 64.f) + EPS) * (1.f - lambda_init);
  const float* sg = p.diff_subln + layer * 64;
#pragma unroll
  for (int t = 0; t < 2; ++t)
#pragma unroll
    for (int r = 0; r < 16; ++r) of[t][r] *= rs * sg[32 * t + crow(r, h2)];
  store_o(Y + (size_t)gtok * 1024 + 256 + h * 64, of, h2);
}

DI void dil_item(CParams& p, int it, int S, int B, char* lds) {
  const int tid = threadIdx.x + opq(), lane = tid & 63, w = tid >> 6, l31 = lane & 31, h2 = lane >> 5;
  const int lgS = (S == 2048) ? 11 : 14, lgB = (B == 16) ? 4 : 1;
  const int rq = it & ((1 << (lgS - 7)) - 1);
  int rest = it >> (lgS - 7);
  const int head = rest & 3; rest >>= 2;
  const int b = rest & (B - 1), g = rest >> lgB;
  const int lgd = 2 * g, dil = 1 << lgd;
  const int L = S >> lgd, lgnqb = lgS - lgd - 7;
  const int res = rq >> lgnqb, qb = rq & ((1 << lgnqb) - 1);
  const int tokbase = b * S;
  const int tq = 128 * qb + 32 * w + l31;
  const int gtok = tokbase + tq * dil + res;
  const bf16_t* PR = (const bf16_t*)(p.ws + OFF_PR);
  bf16_t* OD = (bf16_t*)(p.ws + OFF_OD);
  float* LSE = (float*)(p.ws + OFF_LSE);
  f32x16 O[2]; zeroO(O);
  float m = -1e30f, l = 0.f;
  const int hc = (g * 4 + head) * 64;
  flash_loop<64, true>(O, m, l, PR + (size_t)gtok * NPR + C_DQ + hc, PR + (size_t)(tokbase + res) * NPR + C_DK + hc,
                       (size_t)dil * NPR, PR + (size_t)(tokbase + res) * NPR + C_DV + hc, (size_t)dil * NPR, 4, tq,
                       128 * qb - 64, L, lds);
  l += __shfl_xor(l, 32);
  const float il = 1.f / l;
#pragma unroll
  for (int t = 0; t < 2; ++t)
#pragma unroll
    for (int r = 0; r < 16; ++r) O[t][r] *= il;
  store_o(OD + ((size_t)g * TG + gtok) * 256 + head * 64, O, h2);
  if (h2 == 0) LSE[((size_t)g * TG + gtok) * 4 + head] = m + __log2f(l);
}

constexpr size_t OFF_X2 = 564 * MiB, WS_BIG = 597 * MiB;
#define DN_QK_OFF (p.big_ws ? OFF_X2 : OFF_OD)
#define DN_GC_OFF ((p.big_ws ? OFF_X2 : OFF_OD) + 32 * MiB)
constexpr size_t DN_UW_OFF = OFF_Q;

DI void dn_prep_item(CParams& p, int layer, int it, int S, char* lds) {
  const int tid = threadIdx.x + opq(), lane = tid & 63, w = tid >> 6, l15 = lane & 15, g4 = lane >> 4;
  const int NC = S / 64;
  const int ch = it % NC, bh = it / NC, h = bh & 3, b = bh >> 2;
  const int tokbase = b * S, s0 = ch * 64;
  const bf16_t* PR = (const bf16_t*)(p.ws + OFF_PR);
  const float* AB = (const float*)(p.ws + OFF_AB);
  bf16_t* QKg = (bf16_t*)(p.ws + DN_QK_OFF) + ((size_t)bh * NC + ch) * 8192;
  bf16_t* raw = (bf16_t*)lds;
  float* convw = (float*)(lds + 27200);
  float* RU = (float*)lds;
  float* RW = (float*)(lds + 16384);
  float* Am = (float*)(lds + 32768);
  bf16_t* Kimg = (bf16_t*)(lds + 50176);
  bf16_t* Qimg = (bf16_t*)(lds + 59392);
  float* gcs = (float*)(lds + 68608);
  float* betas = gcs + 128;
  const float* cw = p.dn_conv + (size_t)layer * 5 * 768;
  {
    u32x4 rawreg[7];
    float cwr[4];
#pragma unroll
    for (int k = 0; k < 7; ++k) {
      const int ci = tid + 256 * k;
      const int rr = ci / 24, c = ci % 24, seg = c >> 3, c8 = c & 7;
      const int s = s0 + rr - 2;
      rawreg[k] = u32x4{0u, 0u, 0u, 0u};
      if (ci < 68 * 24 && s >= 0 && s < S)
        rawreg[k] = *(const u32x4*)(PR + (size_t)(tokbase + s) * NPR + C_DNQKV + seg * 256 + h * 64 + c8 * 8);
    }
#pragma unroll
    for (int k = 0; k < 4; ++k) {
      const int i = tid + 256 * k;
      cwr[k] = 0.f;
      if (i < 960) { const int j = i / 192, c = i % 192; cwr[k] = cw[j * 768 + (c >> 6) * 256 + h * 64 + (c & 63)]; }
    }
#pragma unroll
    for (int k = 0; k < 7; ++k) {
      const int ci = tid + 256 * k;
      const int rr = ci / 24, c = ci % 24, seg = c >> 3, c8 = c & 7;
      if (ci < 68 * 24) *(u32x4*)(raw + rr * 200 + seg * 64 + c8 * 8) = rawreg[k];
    }
#pragma unroll
    for (int k = 0; k < 4; ++k) { const int i = tid + 256 * k; if (i < 960) convw[i] = cwr[k]; }
  }
  if (tid < 128) {
    const int d = tid >> 6, pl = tid & 63;
    const int i = d ? 63 - pl : pl;
    const size_t tok = (size_t)tokbase + s0 + i;
    const float Aexp = expf(p.dn_a_log[layer * 8 + d * 4 + h]);
    const float a = AB[tok * 16 + d * 8 + h] + p.dn_dt_bias[layer * 8 + d * 4 + h];
    const float bb = AB[tok * 16 + d * 8 + 4 + h];
    const float sp = fmaxf(a, 0.f) + __logf(1.f + __expf(-fabsf(a)));
    float g = -Aexp * sp;
#pragma unroll
    for (int o = 1; o < 64; o <<= 1) { const float tv = __shfl_up(g, o); if (lane >= o) g += tv; }
    gcs[tid] = g;
    betas[tid] = sigmoidf_(bb);
    float* GC = (float*)(p.ws + DN_GC_OFF) + (((size_t)bh * 2 + d) * NC + ch) * 64;
    GC[pl] = g;
  }
  __syncthreads();
  const int pp = tid >> 2, cgp = tid & 3;
  float kv[16], vv[16];
  {
    float qv[16];
#pragma unroll
    for (int seg = 0; seg < 3; ++seg) {
      float acc[16];
#pragma unroll
      for (int c = 0; c < 16; ++c) acc[c] = 0.f;
#pragma unroll
      for (int j = 0; j < 5; ++j) {
        const bf16_t* rp = raw + (pp + j) * 200 + seg * 64 + 16 * cgp;
        const float* wp = convw + j * 192 + seg * 64 + 16 * cgp;
        const u32x4 u0 = *(const u32x4*)rp, u1 = *(const u32x4*)(rp + 8);
        const unsigned uu[8] = {u0.x, u0.y, u0.z, u0.w, u1.x, u1.y, u1.z, u1.w};
#pragma unroll
        for (int e = 0; e < 8; ++e) {
          acc[2 * e] += wp[2 * e] * __uint_as_float(uu[e] << 16);
          acc[2 * e + 1] += wp[2 * e + 1] * __uint_as_float(uu[e] & 0xffff0000u);
        }
      }
#pragma unroll
      for (int c = 0; c < 16; ++c) {
        const float sv = acc[c] * __builtin_amdgcn_rcpf(1.f + __expf(-acc[c]));
        if (seg == 0) qv[c] = sv; else if (seg == 1) kv[c] = sv; else vv[c] = sv;
      }
    }
    float sq = 0.f, sk = 0.f;
#pragma unroll
    for (int c = 0; c < 16; ++c) { sq += qv[c] * qv[c]; sk += kv[c] * kv[c]; }
    sq += __shfl_xor(sq, 1); sq += __shfl_xor(sq, 2);
    sk += __shfl_xor(sk, 1); sk += __shfl_xor(sk, 2);
    const float rq = rsqrtf(sq + EPS) * 0.125f, rk = rsqrtf(sk + EPS);
#pragma unroll
    for (int c = 0; c < 16; ++c) { qv[c] *= rq; kv[c] *= rk; }
    store8bf(Kimg + pp * 72 + 16 * cgp, kv); store8bf(Kimg + pp * 72 + 16 * cgp + 8, kv + 8);
    store8bf(Qimg + pp * 72 + 16 * cgp, qv); store8bf(Qimg + pp * 72 + 16 * cgp + 8, qv + 8);
    store8bf(QKg + pp * 64 + 16 * cgp, qv); store8bf(QKg + pp * 64 + 16 * cgp + 8, qv + 8);
    store8bf(QKg + 4096 + pp * 64 + 16 * cgp, kv); store8bf(QKg + 4096 + pp * 64 + 16 * cgp + 8, kv + 8);
  }
  for (int d = 0; d < 2; ++d) {
    __syncthreads();
    {
      const int pl = d ? 63 - pp : pp;
      const float bet = betas[d * 64 + pl], egc = __expf(gcs[d * 64 + pl]);
#pragma unroll
      for (int c = 0; c < 16; ++c) {
        RU[pl * 64 + 16 * cgp + c] = vv[c] * bet;
        RW[pl * 64 + 16 * cgp + c] = kv[c] * bet * egc;
      }
    }
    {
      f32x4 KK[4];
#pragma unroll
      for (int t = 0; t < 4; ++t) KK[t] = f32x4{0.f, 0.f, 0.f, 0.f};
      const int jl = 16 * w + l15;
      const int jrow = d ? 63 - jl : jl;
#pragma unroll
      for (int ks = 0; ks < 2; ++ks) {
        const bf16x8 bfk = *(const bf16x8*)(Kimg + jrow * 72 + 32 * ks + 8 * g4);
#pragma unroll
        for (int rt = 0; rt < 4; ++rt) {
          const int il = 16 * rt + l15;
          const int irow = d ? 63 - il : il;
          const bf16x8 afk = *(const bf16x8*)(Kimg + irow * 72 + 32 * ks + 8 * g4);
          KK[rt] = MFMA16(afk, bfk, KK[rt]);
        }
      }
      const float gcj = gcs[d * 64 + jl];
#pragma unroll
      for (int rt = 0; rt < 4; ++rt)
#pragma unroll
        for (int r = 0; r < 4; ++r) {
          const int i = 16 * rt + 4 * g4 + r;
          const float ee = __expf(fminf(gcs[d * 64 + i] - gcj, 0.f));
          Am[i * 68 + jl] = (i > jl) ? betas[d * 64 + i] * KK[rt][r] * ee : 0.f;
        }
    }
    __syncthreads();
    float xs[32];
#pragma unroll
    for (int q = 0; q < 32; ++q) xs[q] = 0.f;
    const int c = tid >> 1, half = tid & 1;
    {
      const float* Rc = (c < 64) ? (RU + c) : (RW + (c - 64));
      const float* Ah = Am + 4 * half;
#pragma unroll
      for (int i = 0; i < 64; ++i) {
        float part = 0.f;
#pragma unroll
        for (int q = 0; q < (i + 7) / 8; ++q) {
          const f32x4 a = *(const f32x4*)(Ah + i * 68 + 8 * q);
          part += a[0] * xs[4 * q] + a[1] * xs[4 * q + 1] + a[2] * xs[4 * q + 2] + a[3] * xs[4 * q + 3];
        }
        const float other = __int_as_float(__builtin_amdgcn_update_dpp(0, __float_as_int(part), 0xB1, 0xf, 0xf, true));
        const float xi = Rc[i * 64] - (part + other);
        const int loc = ((i >> 3) << 2) + (i & 3);
        if (((i >> 2) & 1) == 0) xs[loc] = (half == 0) ? xi : xs[loc];
        else xs[loc] = (half == 1) ? xi : xs[loc];
        if (i < 16 ? ((i & 7) == 7) : (i < 32 ? ((i & 3) == 3) : ((i & 1) == 1))) asm volatile("" ::: "memory");
      }
    }
    {
      bf16_t* UWg = (bf16_t*)(p.ws + DN_UW_OFF) + ((((size_t)bh * 2 + d) * NC + ch) * 8192);
      const float sgn = (c < 64) ? 1.f : -1.f;
      bf16_t* dst = UWg + ((c < 64) ? c : (4096 + c - 64));
#pragma unroll
      for (int loc = 0; loc < 32; ++loc) {
        const int i = (((loc >> 2) * 2 + half) << 2) + (loc & 3);
        dst[i * 64] = f2bf(sgn * xs[loc]);
      }
    }
  }
}

DI void dn_scan_chain(CParams& p, int it, int S, char* lds) {
  __builtin_amdgcn_s_setprio(3);
  const int tid0 = threadIdx.x + opq();
  const int dir = it & 1, bh = it >> 1, h = bh & 3, b = bh >> 2;
  const int tokbase = b * S, NC = S / 64;
  bf16_t* OUT = (bf16_t*)(p.ws + (dir ? OFF_OB : OFF_OF));
  const bf16_t* QKg = (const bf16_t*)(p.ws + DN_QK_OFF) + (size_t)bh * NC * 8192;
  const bf16_t* UWg = (const bf16_t*)(p.ws + DN_UW_OFF) + (size_t)it * NC * 8192;
  const float* GCg = (const float*)(p.ws + DN_GC_OFF) + (size_t)it * NC * 64;
  bf16_t* Uimg = (bf16_t*)lds;
  bf16_t* Wn = Uimg + 4608;
  bf16_t* Qimg = Wn + 4608;
  bf16_t* Kimg = Qimg + 4608;
  bf16_t* Kt = Kimg + 4608;
  bf16_t* Iimg = Kt + 4608;
  float* gcs = (float*)(lds + 6 * 9216);
  f32x4 Sd[4];
#pragma unroll
  for (int t = 0; t < 4; ++t) Sd[t] = f32x4{0.f, 0.f, 0.f, 0.f};
  u32x4 ru[2], rw[2], rq[2], rk[2];
  float rg = 0.f;
  auto prefetch = [&](int cc_) {
    const int ch_ = dir ? (NC - 1 - cc_) : cc_;
    const int tp = tid0 + opq();
    const bf16_t* uw = UWg + (size_t)ch_ * 8192;
    const bf16_t* qk = QKg + (size_t)ch_ * 8192;
#pragma unroll
    for (int k = 0; k < 2; ++k) {
      const int ci = tp + 256 * k, row = ci >> 3, c8 = ci & 7;
      const int srow = dir ? 63 - row : row;
      ru[k] = *(const u32x4*)(uw + row * 64 + c8 * 8);
      rw[k] = *(const u32x4*)(uw + 4096 + row * 64 + c8 * 8);
      rq[k] = *(const u32x4*)(qk + srow * 64 + c8 * 8);
      rk[k] = *(const u32x4*)(qk + 4096 + srow * 64 + c8 * 8);
    }
    if (tp < 64) rg = GCg[(size_t)ch_ * 64 + tp];
  };
  prefetch(0);
  for (int cc = 0; cc < NC; ++cc) {
    const int tid = tid0 + opq(), lane = tid & 63, w = tid >> 6, l15 = lane & 15, g4 = lane >> 4;
    const int e_col = 16 * w + l15;
    const int ch = dir ? (NC - 1 - cc) : cc;
    const int s0 = ch * 64;
    __syncthreads();
#pragma unroll
    for (int k = 0; k < 2; ++k) {
      const int ci = tid + 256 * k, row = ci >> 3, c8 = ci & 7;
      *(u32x4*)(Uimg + row * 72 + c8 * 8) = ru[k];
      *(u32x4*)(Wn + row * 72 + c8 * 8) = rw[k];
      *(u32x4*)(Qimg + row * 72 + c8 * 8) = rq[k];
      *(u32x4*)(Kimg + row * 72 + c8 * 8) = rk[k];
      const unsigned uu[4] = {rk[k].x, rk[k].y, rk[k].z, rk[k].w};
#pragma unroll
      for (int e = 0; e < 4; ++e) {
        Kt[(8 * c8 + 2 * e) * 72 + row] = (bf16_t)(uu[e] & 0xffffu);
        Kt[(8 * c8 + 2 * e + 1) * 72 + row] = (bf16_t)(uu[e] >> 16);
      }
    }
    if (tid < 64) gcs[tid] = rg;
    if (cc + 1 < NC) prefetch(cc + 1);
    __syncthreads();
    {
      f32x4 QK[4];
#pragma unroll
      for (int t = 0; t < 4; ++t) QK[t] = f32x4{0.f, 0.f, 0.f, 0.f};
#pragma unroll
      for (int ks = 0; ks < 2; ++ks) {
        const bf16x8 bfk = *(const bf16x8*)(Kimg + (16 * w + l15) * 72 + 32 * ks + 8 * g4);
#pragma unroll
        for (int rt = 0; rt < 4; ++rt) {
          const bf16x8 afq = *(const bf16x8*)(Qimg + (16 * rt + l15) * 72 + 32 * ks + 8 * g4);
          QK[rt] = MFMA16(afq, bfk, QK[rt]);
        }
      }
      const float gcj = gcs[e_col];
#pragma unroll
      for (int rt = 0; rt < 4; ++rt)
#pragma unroll
        for (int r = 0; r < 4; ++r) {
          const int i = 16 * rt + 4 * g4 + r;
          const float ee = __expf(fminf(gcs[i] - gcj, 0.f));
          Iimg[i * 72 + e_col] = f2bf((i >= e_col) ? QK[rt][r] * ee : 0.f);
        }
    }
    __syncthreads();
    {
      bf16x8 Bs[2];
#pragma unroll
      for (int ks = 0; ks < 2; ++ks)
        Bs[ks] = pack8(Sd[2 * ks][0], Sd[2 * ks][1], Sd[2 * ks][2], Sd[2 * ks][3], Sd[2 * ks + 1][0], Sd[2 * ks + 1][1],
                       Sd[2 * ks + 1][2], Sd[2 * ks + 1][3]);
      f32x4 vn[4], qs[4], iv[4];
#pragma unroll
      for (int rt = 0; rt < 4; ++rt) {
#pragma unroll
        for (int r = 0; r < 4; ++r) vn[rt][r] = bf2f(Uimg[(16 * rt + 4 * g4 + r) * 72 + e_col]);
        qs[rt] = f32x4{0.f, 0.f, 0.f, 0.f};
        iv[rt] = f32x4{0.f, 0.f, 0.f, 0.f};
#pragma unroll
        for (int ks = 0; ks < 2; ++ks) {
          const bf16_t* wp = Wn + (16 * rt + l15) * 72 + 32 * ks + 4 * g4;
          const bf16_t* qp = Qimg + (16 * rt + l15) * 72 + 32 * ks + 4 * g4;
          vn[rt] = MFMA16(ld2x4(wp, wp + 16), Bs[ks], vn[rt]);
          qs[rt] = MFMA16(ld2x4(qp, qp + 16), Bs[ks], qs[rt]);
        }
      }
      bf16x8 Bv[2];
#pragma unroll
      for (int ks = 0; ks < 2; ++ks)
        Bv[ks] = pack8(vn[2 * ks][0], vn[2 * ks][1], vn[2 * ks][2], vn[2 * ks][3], vn[2 * ks + 1][0], vn[2 * ks + 1][1],
                       vn[2 * ks + 1][2], vn[2 * ks + 1][3]);
#pragma unroll
      for (int rt = 0; rt < 4; ++rt)
#pragma unroll
        for (int ks = 0; ks < 2; ++ks) {
          const bf16_t* ip = Iimg + (16 * rt + l15) * 72 + 32 * ks + 4 * g4;
          iv[rt] = MFMA16(ld2x4(ip, ip + 16), Bv[ks], iv[rt]);
        }
      const float gc63 = gcs[63];
#pragma unroll
      for (int rt = 0; rt < 4; ++rt)
#pragma unroll
        for (int r = 0; r < 4; ++r) {
          const int pos = 16 * rt + 4 * g4 + r;
          const float o = qs[rt][r] * __expf(gcs[pos]) + iv[rt][r];
          const int i = dir ? 63 - pos : pos;
          OUT[((size_t)tokbase + s0 + i) * 256 + h * 64 + e_col] = f2bf(o);
          vn[rt][r] *= __expf(gc63 - gcs[pos]);
        }
      bf16x8 Bv2[2];
#pragma unroll
      for (int ks = 0; ks < 2; ++ks)
        Bv2[ks] = pack8(vn[2 * ks][0], vn[2 * ks][1], vn[2 * ks][2], vn[2 * ks][3], vn[2 * ks + 1][0], vn[2 * ks + 1][1],
                        vn[2 * ks + 1][2], vn[2 * ks + 1][3]);
      const float gl = __expf(gc63);
#pragma unroll
      for (int dt = 0; dt < 4; ++dt) {
#pragma unroll
        for (int r = 0; r < 4; ++r) Sd[dt][r] *= gl;
#pragma unroll
        for (int ks = 0; ks < 2; ++ks) {
          const bf16_t* kp = Kt + (16 * dt + l15) * 72 + 32 * ks + 4 * g4;
          Sd[dt] = MFMA16(ld2x4(kp, kp + 16), Bv2[ks], Sd[dt]);
        }
      }
    }
  }
  __builtin_amdgcn_s_setprio(0);
}

DI void phase_combine(CParams& p, int layer, const float* __restrict__ xg) {
  const int tidq = threadIdx.x + opq(); const int wave = tidq >> 6, lane = tidq & 63;
  const bf16_t* PR = (const bf16_t*)(p.ws + OFF_PR);
  const bf16_t* OD = (const bf16_t*)(p.ws + OFF_OD);
  const float* LSE = (const float*)(p.ws + OFF_LSE);
  const bf16_t* OFb = (const bf16_t*)(p.ws + OFF_OF);
  const bf16_t* OBb = (const bf16_t*)(p.ws + OFF_OB);
  bf16_t* Y = (bf16_t*)(p.ws + OFF_N);
  bf16_t* Np = (bf16_t*)(p.ws + OFF_Q);
  const float* gmix = p.norm_mix + layer * 1024;
  const float* gdn = p.dn_out_norm + layer * 64;
  const int head = lane >> 4;
  for (int r = blockIdx.x * 4 + wave; r < TG; r += gridDim.x * 4) {
    {
      float lg[3];
#pragma unroll
      for (int g = 0; g < 3; ++g) lg[g] = LSE[((size_t)g * TG + r) * 4 + head];
      const float mx = fmaxf(lg[0], fmaxf(lg[1], lg[2]));
      float wg[3], den = 0.f;
#pragma unroll
      for (int g = 0; g < 3; ++g) { wg[g] = exp2_(lg[g] - mx); den += wg[g]; }
      const float id = 1.f / den;
      float o[4] = {0.f, 0.f, 0.f, 0.f};
#pragma unroll
      for (int g = 0; g < 3; ++g) {
        const u32x2 u = ((const u32x2*)(OD + ((size_t)g * TG + r) * 256))[lane];
        const float c = wg[g] * id;
        o[0] += c * __uint_as_float(u.x << 16); o[1] += c * __uint_as_float(u.x & 0xffff0000u);
        o[2] += c * __uint_as_float(u.y << 16); o[3] += c * __uint_as_float(u.y & 0xffff0000u);
      }
      u32x2 ou; ou.x = pack2(o[0], o[1]); ou.y = pack2(o[2], o[3]);
      ((u32x2*)(Y + (size_t)r * 1024 + 768))[lane] = ou;
    }
    {
      const u32x2 uf = ((const u32x2*)(OFb + (size_t)r * 256))[lane];
      const u32x2 ub = ((const u32x2*)(OBb + (size_t)r * 256))[lane];
      const u32x2 uz = ((const u32x2*)(PR + (size_t)r * NPR + C_Z))[lane];
      float o[4], z[4];
      o[0] = __uint_as_float(uf.x << 16) + __uint_as_float(ub.x << 16);
      o[1] = __uint_as_float(uf.x & 0xffff0000u) + __uint_as_float(ub.x & 0xffff0000u);
      o[2] = __uint_as_float(uf.y << 16) + __uint_as_float(ub.y << 16);
      o[3] = __uint_as_float(uf.y & 0xffff0000u) + __uint_as_float(ub.y & 0xffff0000u);
      z[0] = __uint_as_float(uz.x << 16); z[1] = __uint_as_float(uz.x & 0xffff0000u);
      z[2] = __uint_as_float(uz.y << 16); z[3] = __uint_as_float(uz.y & 0xffff0000u);
      float ss = o[0] * o[0] + o[1] * o[1] + o[2] * o[2] + o[3] * o[3];
      ss += __shfl_xor(ss, 1); ss += __shfl_xor(ss, 2); ss += __shfl_xor(ss, 4); ss += __shfl_xor(ss, 8);
      const float rs = rsqrtf(ss * (1.f / 64.f) + EPS);
      const float4 gg = ((const float4*)gdn)[lane & 15];
      u32x2 ou;
      ou.x = pack2(o[0] * rs * gg.x * siluf_(z[0]), o[1] * rs * gg.y * siluf_(z[1]));
      ou.y = pack2(o[2] * rs * gg.z * siluf_(z[2]), o[3] * rs * gg.w * siluf_(z[3]));
      ((u32x2*)(Y + (size_t)r * 1024 + 512))[lane] = ou;
    }
    {
      const float4* xr = (const float4*)(xg + (size_t)r * 1024);
      float4 v[4];
      float ss = 0.f;
#pragma unroll
      for (int i = 0; i < 4; ++i) { v[i] = xr[lane + 64 * i]; ss += v[i].x * v[i].x + v[i].y * v[i].y + v[i].z * v[i].z + v[i].w * v[i].w; }
      ss = wave_sum(ss);
      const float rs = rsqrtf(ss * (1.f / 1024.f) + EPS);
#pragma unroll
      for (int i = 0; i < 4; ++i) {
        const float4 gg = ((const float4*)gmix)[lane + 64 * i];
        u32x2 o; o.x = pack2(v[i].x * rs * gg.x, v[i].y * rs * gg.y); o.y = pack2(v[i].z * rs * gg.z, v[i].w * rs * gg.w);
        ((u32x2*)(Np + (size_t)r * 1024))[lane + 64 * i] = o;
      }
    }
  }
}

#define XB_TMO      128
#define XB_XCNT(j)  (256  + 64 * (j))
#define XB_XSUB(j)  (1280 + 64 * (j))
#define XB_XGEN(j)  (2304 + 64 * (j))
#define XB_TOP      3328
#define XB_TOPGEN   3392
#define XCD_BAR_WORDS 3456
#define XB_SPIN_CAP (1u << 27)
#define LAS __attribute__((address_space(3)))
constexpr size_t OFF_BAR = OFF_CNT + 65536;
DI unsigned xb_ld(unsigned* p) { return __hip_atomic_load(p, __ATOMIC_RELAXED, __HIP_MEMORY_SCOPE_AGENT); }
DI unsigned xb_add(unsigned* p, unsigned v) { return __hip_atomic_fetch_add(p, v, __ATOMIC_RELAXED, __HIP_MEMORY_SCOPE_AGENT); }
DI unsigned xb_xcc_id() { return (unsigned)__builtin_amdgcn_s_getreg((3 << 11) | 20) & 0xFu; }
#define XB_SPIN(cond, bar) do { unsigned _sp = 0; while (cond) { __builtin_amdgcn_s_sleep(1); \
    if ((++_sp & 255u) == 0u) { if (xb_ld(&(bar)[XB_TMO])) break; if (_sp > XB_SPIN_CAP) { atomicAdd(&(bar)[XB_TMO], 1u); break; } } } } while (0)
struct XcdBarrier { unsigned* bar; unsigned x; volatile LAS unsigned* st; };
DI XcdBarrier xcd_barrier_post(unsigned* bar, volatile LAS unsigned* st) {
  XcdBarrier b; b.bar = bar; b.x = xb_xcc_id(); b.st = st;
  if (threadIdx.x == 0) (void)xb_add(&bar[XB_XCNT(b.x)], 1u);
  return b;
}
DI void xcd_barrier_complete(unsigned* bar, unsigned x, unsigned& nloc, unsigned& nx) {
  const unsigned G = gridDim.x * gridDim.y * gridDim.z;
  unsigned sum, cnt, mine, sp = 0u;
  for (;;) {
    sum = 0u; cnt = 0u; mine = 0u;
#pragma unroll
    for (unsigned j = 0; j < 16; ++j) { const unsigned c = xb_ld(&bar[XB_XCNT(j)]); sum += c; cnt += (c > 0u) ? 1u : 0u; mine = (j == x) ? c : mine; }
    if (sum == G) break;
    __builtin_amdgcn_s_sleep(1);
    if ((++sp & 255u) == 0u) { if (xb_ld(&bar[XB_TMO])) break; if (sp > XB_SPIN_CAP) { atomicAdd(&bar[XB_TMO], 1u); break; } }
  }
  nloc = mine > 0u ? mine : 1u; nx = cnt > 0u ? cnt : 1u;
}
DI void xcd_barrier(const XcdBarrier& b) {
  asm volatile("s_waitcnt vmcnt(0)" ::: "memory");
  __syncthreads();
  if (threadIdx.x == 0) {
    unsigned* bar = b.bar;
    __builtin_amdgcn_s_waitcnt(0);
    unsigned nloc = b.st[0], nx = b.st[1];
    if (nloc == 0u) { xcd_barrier_complete(bar, b.x, nloc, nx); b.st[0] = nloc; b.st[1] = nx; }
    const unsigned old = xb_add(&bar[XB_XSUB(b.x)], 1u);
    const unsigned gen = old / nloc;
    if (old + 1u == (gen + 1u) * nloc) {
      __builtin_amdgcn_fence(__ATOMIC_RELEASE, "agent");
      asm volatile("s_waitcnt vmcnt(0)" ::: "memory");
      const unsigned og = xb_add(&bar[XB_TOP], 1u);
      const unsigned tg = og / nx;
      if (og + 1u == (tg + 1u) * nx) xb_add(&bar[XB_TOPGEN], 1u);
      else XB_SPIN(xb_ld(&bar[XB_TOPGEN]) == tg, bar);
      __builtin_amdgcn_fence(__ATOMIC_ACQUIRE, "agent");
      xb_add(&bar[XB_XGEN(b.x)], 1u);
      asm volatile("s_waitcnt vmcnt(0)" ::: "memory");
    } else {
      XB_SPIN(xb_ld(&bar[XB_XGEN(b.x)]) == gen, bar);
      __builtin_amdgcn_fence(__ATOMIC_ACQUIRE, "agent");
      asm volatile("s_waitcnt vmcnt(0)" ::: "memory");
    }
  }
  __syncthreads();
}

#ifndef REP_MIX
#define REP_MIX 1
#endif
#ifndef REP_GEMM
#define REP_GEMM 1
#endif
__global__ void __launch_bounds__(256, 2) mega(Params pk) {
  extern __shared__ __attribute__((aligned(16))) char lds[];
  __shared__ uint4 sh_words;
  cg::grid_group grid = cg::this_grid();
  CParams* kp = (CParams*)__builtin_amdgcn_kernarg_segment_ptr();
  if (threadIdx.x == 0) sh_words = make_uint4(0u, 0u, 0u, 0u);
  __syncthreads();
  XcdBarrier xb;
  { CParams& p = *launder(kp); xb = xcd_barrier_post((unsigned*)(p.ws + OFF_BAR), (volatile LAS unsigned*)&sh_words); }
#define s_item (((volatile int*)&sh_words)[2])
#define GSYNC() xcd_barrier(xb)
#define PP_ CParams& p = *launder(kp); const bf16_t* wb = (const bf16_t*)(p.ws + OFF_WB); bf16_t* Nb = (bf16_t*)(p.ws + OFF_N); \
            bf16_t* PRb = (bf16_t*)(p.ws + OFF_PR); bf16_t* Npb = (bf16_t*)(p.ws + OFF_Q); bf16_t* PB = (bf16_t*)(p.ws + OFF_OD); \
            float* xg = p.x + (size_t)grp * TG * 1024; (void)wb; (void)Nb; (void)PRb; (void)Npb; (void)PB; (void)xg;
  { CParams& p = *launder(kp); phase_init(p, lds); phase_norm(p.x_in[0], p.norm_ff1, (bf16_t*)(p.ws + OFF_Q), nullptr, nullptr); }
  grid.sync();
  for (int layer = 0; layer < 2; ++layer) {
    if (layer > 0) { CParams& p = *launder(kp); phase_convert(p, layer, lds); GSYNC(); }
    for (int grp = 0; grp < 2; ++grp) {
      const int S = grp ? 2048 : 16384, B = grp ? 16 : 2;
      const float* xsrc0 = nullptr;
      { CParams& p = *launder(kp); xsrc0 = layer == 0 ? p.x_in[grp] : p.x + (size_t)grp * TG * 1024; }
      for (int rep = 0; rep < REP_GEMM; ++rep) {
        { PP_ phase_ffn_a(Npb, wb + W_FF1_1, wb + W_FF1_3, PRb, lds); }
        GSYNC();
      }
      { PP_ phase_gemm_resid(PRb, 2816, wb + W_FF1_2, xsrc0, xg, 0.5f, lds); }
      GSYNC();
      { PP_ phase_norm(xg, p.norm_mix + layer * 1024, Nb, nullptr, nullptr); }
      GSYNC();
      for (int rep = 0; rep < REP_GEMM; ++rep) {
        { PP_ phase_proj(p, Nb, wb + W_IN, S, lds); }
        GSYNC();
      }
      {
        PP_
        int* c0 = (int*)(p.ws + OFF_CNT) + (layer * 2 + grp) * 4;
        for (;;) {
          __syncthreads();
          if (threadIdx.x == 0) s_item = atomicAdd(c0, 1);
          __syncthreads();
          const int it = s_item;
          if (it >= 2048) break;
          dn_prep_item(p, layer, it, S, lds);
        }
      }
      GSYNC();
      {
        PP_
        int* cb = (int*)(p.ws + OFF_CNT) + 64 + (layer * 2 + grp) * 32;
        const int nDN = B * 8, nDil = p.big_ws ? 3072 : 0;
        const int lgq = grp ? 4 : 7;
        for (;;) {
          __syncthreads();
          if (threadIdx.x == 0) s_item = atomicAdd(cb, 1);
          __syncthreads();
          const int it = s_item;
          if (it >= nDN) break;
          dn_scan_chain(p, it, S, lds);
        }
        for (int xo = 0; xo < 8; ++xo) {
          const int xq = (blockIdx.x + xo) & 7;
          for (;;) {
            __syncthreads();
            if (threadIdx.x == 0) s_item = atomicAdd(cb + 8 + xq, 1);
            __syncthreads();
            const int j = s_item;
            if (j >= 128) break;
            const int pair = xq + 8 * (j >> lgq), qb = j & ((1 << lgq) - 1);
            diff_item(p, layer, (pair << lgq) + qb, S, lds);
          }
        }
        for (;;) {
          __syncthreads();
          if (threadIdx.x == 0) s_item = atomicAdd(cb + 1, 1);
          __syncthreads();
          const int it = s_item;
          if (it >= nDil) break;
          dil_item(p, it, S, B, lds);
        }
      }
      GSYNC();
      {
        PP_
        int* c2 = (int*)(p.ws + OFF_CNT) + (layer * 2 + grp) * 4 + 2;
        const int nDil = p.big_ws ? 0 : 3072, total = nDil + 256 * 7;
        for (;;) {
          __syncthreads();
          if (threadIdx.x == 0) s_item = atomicAdd(c2, 1);
          __syncthreads();
          int it = s_item;
          if (it >= total) break;
          if (it < nDil) { dil_item(p, it, S, B, lds); continue; }
          it -= nDil;
          mla_up_tile(p, it / 7, it % 7, S, lds);
        }
      }
      GSYNC();
      {
        PP_
        int* cb = (int*)(p.ws + OFF_CNT) + 64 + (layer * 2 + grp) * 32 + 16;
        const int lgq = grp ? 4 : 7;
        for (int xo = 0; xo < 8; ++xo) {
          const int xq = (blockIdx.x + xo) & 7;
          for (;;) {
            __syncthreads();
            if (threadIdx.x == 0) s_item = atomicAdd(cb + xq, 1);
            __syncthreads();
            const int j = s_item;
            if (j >= 128) break;
            const int pair = xq + 8 * (j >> lgq), qb = j & ((1 << lgq) - 1);
            mla_item(p, (pair << lgq) + qb, S, lds);
          }
        }
      }
      GSYNC();
      { PP_ phase_combine(p, layer, xg); }
      GSYNC();
      for (int rep = 0; rep < REP_GEMM; ++rep) {
        { PP_ phase_merge(Npb, Nb, wb + W_G, wb + W_B, PRb, lds); }
        GSYNC();
      }
      { PP_ phase_gemm_resid(PRb, 1024, wb + W_O, xg, xg, 1.0f, lds); }
      GSYNC();
      { PP_ phase_norm(xg, p.norm_ff2 + layer * 1024, Nb, nullptr, nullptr); }
      GSYNC();
      for (int rep = 0; rep < REP_GEMM; ++rep) {
        { PP_ phase_ffn_a(Nb, wb + W_FF2_1, wb + W_FF2_3, PRb, lds); }
        GSYNC();
      }
      { PP_ phase_gemm_resid(PRb, 2816, wb + W_FF2_2, xg, xg, 0.5f, lds); }
      GSYNC();
      { PP_ phase_norm(xg, p.norm_ple + layer * 1024, Nb, p.p_in[grp] + (size_t)layer * TG * 256, PB); }
      GSYNC();
      {
        PP_
        phase_ple(Nb, PB, wb + W_PG, wb + W_PP, xg, lds);
        const int nl = grp ? layer + 1 : layer, ng = grp ^ 1;
        if (nl < 2) phase_norm(nl == 0 ? p.x_in[ng] : p.x + (size_t)ng * TG * 1024, p.norm_ff1 + nl * 1024, Npb, nullptr, nullptr);
      }
      GSYNC();
    }
  }
  { CParams& p = *launder(kp); phase_final_norm(p.x, p.norm_final); }
}

extern "C" void kernel_launch(void* const* d_in, const int* in_sizes, int n_in, void* d_out, int out_size, void* d_ws,
                              size_t ws_size, hipStream_t stream) {
  (void)in_sizes; (void)n_in; (void)out_size;
  Params p{};
  p.x_in[0] = (const float*)d_in[0]; p.x_in[1] = (const float*)d_in[1];
  p.p_in[0] = (const float*)d_in[2]; p.p_in[1] = (const float*)d_in[3];
  p.norm_ff1 = (const float*)d_in[4]; p.ff1_w1 = (const float*)d_in[5]; p.ff1_w3 = (const float*)d_in[6];
  p.ff1_w2 = (const float*)d_in[7]; p.norm_mix = (const float*)d_in[8]; p.w_in = (const float*)d_in[9];
  p.mla_q_norm = (const float*)d_in[10]; p.mla_kv_norm = (const float*)d_in[11]; p.mla_w_uq = (const float*)d_in[12];
  p.mla_w_ukv = (const float*)d_in[13]; p.diff_lambda = (const float*)d_in[14]; p.diff_subln = (const float*)d_in[15];
  p.dn_conv = (const float*)d_in[16]; p.dn_a_log = (const float*)d_in[17]; p.dn_dt_bias = (const float*)d_in[18];
  p.dn_out_norm = (const float*)d_in[19]; p.w_branch = (const float*)d_in[20]; p.w_gate = (const float*)d_in[21];
  p.w_out = (const float*)d_in[22]; p.norm_ff2 = (const float*)d_in[23]; p.ff2_w1 = (const float*)d_in[24];
  p.ff2_w3 = (const float*)d_in[25]; p.ff2_w2 = (const float*)d_in[26]; p.norm_ple = (const float*)d_in[27];
  p.ple_gate = (const float*)d_in[28]; p.ple_proj = (const float*)d_in[29]; p.norm_final = (const float*)d_in[30];
  p.x = (float*)d_out;
  p.ws = (char*)d_ws;
  p.big_ws = (ws_size >= WS_BIG) ? 1 : 0;
  static int grid_blocks = 0;
  if (!grid_blocks) {
    int dev = 0, cus = 0, per_cu = 0;
    hipGetDevice(&dev);
    hipDeviceGetAttribute(&cus, hipDeviceAttributeMultiprocessorCount, dev);
    hipFuncSetAttribute((const void*)mega, hipFuncAttributeMaxDynamicSharedMemorySize, (int)LDS_BYTES);
    hipOccupancyMaxActiveBlocksPerMultiprocessor(&per_cu, mega, 256, LDS_BYTES);
    if (per_cu < 1) per_cu = 1;
    grid_blocks = cus * per_cu;
  }
  if (ws_size < WS_NEED) {
    fprintf(stderr, "workspace too small: %zu < %zu\n", ws_size, (size_t)WS_NEED);
    return;
  }
  (void)hipMemsetAsync((char*)d_ws + OFF_BAR, 0, XCD_BAR_WORDS * 4, stream);
  void* args[] = {&p};
  hipError_t e = hipLaunchCooperativeKernel((void*)mega, dim3(grid_blocks), dim3(256), args, LDS_BYTES, stream);
  if (e != hipSuccess) fprintf(stderr, "cooperative launch failed: %s (grid %d)\n", hipGetErrorString(e), grid_blocks);
}
```

```cpp
#include <hip/hip_runtime.h>
#include <hip/hip_cooperative_groups.h>
#include <stdint.h>
#include <stdio.h>
namespace cg = cooperative_groups;

typedef unsigned short bf16_t;
using bf16x8 = __attribute__((ext_vector_type(8))) short;
using bf16x4 = __attribute__((ext_vector_type(4))) short;
using f32x16 = __attribute__((ext_vector_type(16))) float;
using f32x4 = __attribute__((ext_vector_type(4))) float;
using u32x4 = __attribute__((ext_vector_type(4))) unsigned;
using u32x2 = __attribute__((ext_vector_type(2))) unsigned;

#define DI __device__ __forceinline__
#define MFMA32(a, b, c) __builtin_amdgcn_mfma_f32_32x32x16_bf16((a), (b), (c), 0, 0, 0)
#define MFMA16(a, b, c) __builtin_amdgcn_mfma_f32_16x16x32_bf16((a), (b), (c), 0, 0, 0)

constexpr int TG = 32768;
constexpr int NPR = 4608;
constexpr float EPS = 1e-6f;
constexpr float LOG2E = 1.4426950408889634f;
constexpr float DEFER_THR = 8.f;
constexpr int C_CQ = 0, C_CKV = 256, C_BQ = 384, C_BK = 640, C_BV = 896, C_DNQKV = 1152, C_Z = 1920,
              C_DQ = 2176, C_DK = 2944, C_DV = 3712;
constexpr size_t MiB = 1048576;
constexpr size_t OFF_WB = 0, OFF_TAB = 57 * MiB, OFF_CNT = 63 * MiB, OFF_N = 64 * MiB, OFF_PR = 128 * MiB,
                 OFF_Q = 416 * MiB, OFF_K = 440 * MiB, OFF_V = 464 * MiB, OFF_AB = 480 * MiB, OFF_OD = 482 * MiB,
                 OFF_LSE = 530 * MiB, OFF_OF = 532 * MiB, OFF_OB = 548 * MiB, WS_NEED = 564 * MiB;
constexpr size_t W_FF1_1 = 0, W_FF1_3 = 2883584, W_FF1_2 = 5767168, W_IN = 8650752, W_UQ = 13369344,
                 W_UKV = 13467648, W_G = 13533184, W_B = 17727488, W_O = 18776064, W_FF2_1 = 19824640,
                 W_FF2_3 = 22708224, W_FF2_2 = 25591808, W_PG = 28475392, W_PP = 29523968;
constexpr size_t LDS_BYTES = 78336;

struct Params {
  const float* x_in[2];
  const float* p_in[2];
  const float *norm_ff1, *ff1_w1, *ff1_w3, *ff1_w2, *norm_mix, *w_in, *mla_q_norm, *mla_kv_norm, *mla_w_uq,
      *mla_w_ukv, *diff_lambda, *diff_subln, *dn_conv, *dn_a_log, *dn_dt_bias, *dn_out_norm, *w_branch, *w_gate,
      *w_out, *norm_ff2, *ff2_w1, *ff2_w3, *ff2_w2, *norm_ple, *ple_gate, *ple_proj, *norm_final;
  float* x;
  char* ws;
  long long big_ws;
};

typedef const __attribute__((address_space(4))) Params CParams;
DI CParams* launder(CParams* q) { asm volatile("" : "+s"(q)); return q; }

typedef __bf16 bf2_t __attribute__((ext_vector_type(2)));
typedef float f2_t __attribute__((ext_vector_type(2)));
DI bf16_t f2bf(float x) { return __builtin_bit_cast(bf16_t, (__bf16)x); }
DI float bf2f(bf16_t b) { return __uint_as_float(((unsigned)b) << 16); }
DI unsigned pack2(float a, float b) { f2_t v = {a, b}; return __builtin_bit_cast(unsigned, __builtin_convertvector(v, bf2_t)); }
DI float wave_sum(float v) {
#pragma unroll
  for (int o = 32; o > 0; o >>= 1) v += __shfl_xor(v, o);
  return v;
}
DI float sigmoidf_(float x) { return __builtin_amdgcn_rcpf(1.f + __expf(-x)); }
DI float siluf_(float x) { return x * __builtin_amdgcn_rcpf(1.f + __expf(-x)); }
DI float exp2_(float x) { return __builtin_amdgcn_exp2f(x); }
DI int opq() { int z; asm volatile("v_mov_b32 %0, 0" : "=v"(z)); return z; }
DI float xhalf_max(float v) {
  const auto r = __builtin_amdgcn_permlane32_swap(__float_as_uint(v), __float_as_uint(v), false, false);
  return fmaxf(__uint_as_float(r[0]), __uint_as_float(r[1]));
}
DI int crow(int r, int h2) { return (r & 3) + 8 * (r >> 2) + 4 * h2; }
DI bf16x8 pack8(float a0, float a1, float a2, float a3, float a4, float a5, float a6, float a7) {
  u32x4 u;
  u.x = pack2(a0, a1); u.y = pack2(a2, a3); u.z = pack2(a4, a5); u.w = pack2(a6, a7);
  return __builtin_bit_cast(bf16x8, u);
}
DI bf16x8 ld2x4(const bf16_t* p0, const bf16_t* p1) {
  u32x2 a = *(const u32x2*)p0, b = *(const u32x2*)p1;
  u32x4 u; u.x = a.x; u.y = a.y; u.z = b.x; u.w = b.y;
  return __builtin_bit_cast(bf16x8, u);
}
DI void store8bf(bf16_t* dst, const float* v) {
  u32x4 u; u.x = pack2(v[0], v[1]); u.y = pack2(v[2], v[3]); u.z = pack2(v[4], v[5]); u.w = pack2(v[6], v[7]);
  *(u32x4*)dst = u;
}

struct MatDesc { const float* src; bf16_t* dst; int K, ldsrc, Ndst, map; const float* rowscale; int frag; };

DI int map_col(int map, int n) {
  if (map == 0) return n;
  if (map == 1) {
    if (n < 384) return n;
    if (n < 1920) return n + 32;
    if (n < 4480) return n + 48;
    if (n < 4512) return n - 4480 + 384;
    if (n < 4528) return n - 4512 + 1952;
    return -1;
  }
  if (n < 256) return (n >> 6) * 96 + (n & 63);
  return ((n - 256) >> 5) * 96 + 64 + ((n - 256) & 31);
}

DI MatDesc get_mat(CParams& p, int l, int id) {
  bf16_t* wb = (bf16_t*)(p.ws + OFF_WB);
  MatDesc d; d.map = 0; d.rowscale = nullptr; d.frag = (id == 2 || id == 14 || id == 17) ? 1 : 0;
  const size_t FF = (size_t)1024 * 2816;
  switch (id) {
    case 0: d.src = p.ff1_w1 + l * FF; d.dst = wb + W_FF1_1; d.K = 1024; d.ldsrc = 2816; d.Ndst = 2816; break;
    case 1: d.src = p.ff1_w3 + l * FF; d.dst = wb + W_FF1_3; d.K = 1024; d.ldsrc = 2816; d.Ndst = 2816; break;
    case 2: d.src = p.ff1_w2 + l * FF; d.dst = wb + W_FF1_2; d.K = 2816; d.ldsrc = 1024; d.Ndst = 1024; break;
    case 3: d.src = p.w_in + (size_t)l * 1024 * 4528; d.dst = wb + W_IN; d.K = 1024; d.ldsrc = 4528; d.Ndst = 4608; d.map = 1; break;
    case 4: d.src = p.mla_w_uq + (size_t)l * 256 * 384; d.dst = wb + W_UQ; d.K = 256; d.ldsrc = 384; d.Ndst = 384; d.map = 2; d.rowscale = p.mla_q_norm + l * 256; break;
    case 5: d.src = p.mla_w_ukv + (size_t)l * 128 * 512; d.dst = wb + W_UKV; d.K = 128; d.ldsrc = 512; d.Ndst = 512; d.rowscale = p.mla_kv_norm + l * 128; break;
    case 6: case 7: case 8: case 9:
      d.src = p.w_gate + (size_t)(l * 4 + id - 6) * 1048576; d.dst = wb + W_G + (size_t)(id - 6) * 1048576; d.K = 1024; d.ldsrc = 1024; d.Ndst = 1024; break;
    case 10: case 11: case 12: case 13:
      d.src = p.w_branch + (size_t)(l * 4 + id - 10) * 262144; d.dst = wb + W_B + (size_t)(id - 10) * 262144; d.K = 256; d.ldsrc = 1024; d.Ndst = 1024; break;
    case 14: d.src = p.w_out + (size_t)l * 1048576; d.dst = wb + W_O; d.K = 1024; d.ldsrc = 1024; d.Ndst = 1024; break;
    case 15: d.src = p.ff2_w1 + l * FF; d.dst = wb + W_FF2_1; d.K = 1024; d.ldsrc = 2816; d.Ndst = 2816; break;
    case 16: d.src = p.ff2_w3 + l * FF; d.dst = wb + W_FF2_3; d.K = 1024; d.ldsrc = 2816; d.Ndst = 2816; break;
    case 17: d.src = p.ff2_w2 + l * FF; d.dst = wb + W_FF2_2; d.K = 2816; d.ldsrc = 1024; d.Ndst = 1024; break;
    case 18: d.src = p.ple_gate + (size_t)l * 1048576; d.dst = wb + W_PG; d.K = 1024; d.ldsrc = 1024; d.Ndst = 1024; break;
    default: d.src = p.ple_proj + (size_t)l * 262144; d.dst = wb + W_PP; d.K = 256; d.ldsrc = 1024; d.Ndst = 1024; break;
  }
  return d;
}

DI void phase_convert(CParams& p, int l, char* lds) {
  float* T = (float*)lds;
  const int tid = threadIdx.x + opq();
  for (int id = 0; id < 20; ++id) {
    MatDesc d = get_mat(p, l, id);
    const int nkt = d.K >> 6, nnt = d.Ndst >> 6, nt_all = nkt * nnt;
    for (int t = blockIdx.x; t < nt_all; t += gridDim.x) {
      const int kt = t / nnt, nt = t % nnt;
      __syncthreads();
      {
        const int nl = tid & 63;
        const int sc = map_col(d.map, nt * 64 + nl);
#pragma unroll 4
        for (int i = 0; i < 16; ++i) {
          const int kl = (tid >> 6) + 4 * i;
          const int k = kt * 64 + kl;
          float v = 0.f;
          if (sc >= 0) v = d.src[(size_t)k * d.ldsrc + sc];
          if (d.rowscale) v *= d.rowscale[k];
          T[kl * 65 + nl] = v;
        }
      }
      __syncthreads();
      if (d.frag) {
#pragma unroll
        for (int i = 0; i < 2; ++i) {
          const int ci = tid + 256 * i, nl = ci & 63, c8 = ci >> 6;
          float v[8];
#pragma unroll
          for (int e = 0; e < 8; ++e) v[e] = T[(8 * c8 + e) * 65 + nl];
          const int n = nt * 64 + nl, k = kt * 64 + 8 * c8;
          const size_t off = (((size_t)(n >> 5) * (d.K >> 4) + (k >> 4)) * 64 + ((k >> 3) & 1) * 32 + (n & 31)) * 8;
          store8bf(d.dst + off, v);
        }
      } else {
        const int kl = tid & 63;
#pragma unroll 4
        for (int i = 0; i < 16; ++i) {
          const int nl = (tid >> 6) + 4 * i;
          d.dst[(size_t)(nt * 64 + nl) * d.K + kt * 64 + kl] = f2bf(T[kl * 65 + nl]);
        }
      }
    }
  }
}

DI void phase_init(CParams& p, char* lds) {
  const size_t gtid = (size_t)blockIdx.x * 256 + threadIdx.x + opq(), gn = (size_t)gridDim.x * 256;
  {
    float2* t32 = (float2*)(p.ws + OFF_TAB);
    float2* t64 = (float2*)(p.ws + OFF_TAB + 2 * MiB);
    for (size_t i = gtid; i < (size_t)16384 * 48; i += gn) {
      const int pos = (int)(i / 48), f = (int)(i % 48);
      float inv;
      if (f < 16) inv = exp2f(-(float)f * (13.287712379549449f / 16.f));
      else inv = exp2f(-(float)(f - 16) * (13.287712379549449f / 32.f));
      const float ang = (float)pos * inv;
      const double xd = (double)ang;
      const double n = rint(xd * 0.15915494309189535);
      const float rf = (float)(xd - n * 6.283185307179586);
      float2 cs; cs.x = __cosf(rf); cs.y = __sinf(rf);
      if (f < 16) t32[(size_t)pos * 16 + f] = cs; else t64[(size_t)pos * 32 + (f - 16)] = cs;
    }
  }
  if (blockIdx.x == 0) ((int*)(p.ws + OFF_CNT))[threadIdx.x] = 0;
  phase_convert(p, 0, lds);
}

DI void phase_norm(const float* __restrict__ x, const float* __restrict__ g, bf16_t* __restrict__ dst,
                           const float* __restrict__ psrc, bf16_t* __restrict__ pdst) {
  const int tidq = threadIdx.x + opq(); const int wave = tidq >> 6, lane = tidq & 63;
  for (int r = blockIdx.x * 4 + wave; r < TG; r += gridDim.x * 4) {
    const float4* xr = (const float4*)(x + (size_t)r * 1024);
    float4 v[4];
    float ss = 0.f;
#pragma unroll
    for (int i = 0; i < 4; ++i) { v[i] = xr[lane + 64 * i]; ss += v[i].x * v[i].x + v[i].y * v[i].y + v[i].z * v[i].z + v[i].w * v[i].w; }
    ss = wave_sum(ss);
    const float rs = rsqrtf(ss * (1.f / 1024.f) + EPS);
#pragma unroll
    for (int i = 0; i < 4; ++i) {
      const float4 gg = ((const float4*)g)[lane + 64 * i];
      u32x2 o; o.x = pack2(v[i].x * rs * gg.x, v[i].y * rs * gg.y); o.y = pack2(v[i].z * rs * gg.z, v[i].w * rs * gg.w);
      ((u32x2*)(dst + (size_t)r * 1024))[lane + 64 * i] = o;
    }
    if (psrc) {
      const float4 pv = ((const float4*)(psrc + (size_t)r * 256))[lane];
      u32x2 o; o.x = pack2(pv.x, pv.y); o.y = pack2(pv.z, pv.w);
      ((u32x2*)(pdst + (size_t)r * 256))[lane] = o;
    }
  }
}

DI void phase_final_norm(float* __restrict__ x, const float* __restrict__ g) {
  const int tidq = threadIdx.x + opq(); const int wave = tidq >> 6, lane = tidq & 63;
  for (int r = blockIdx.x * 4 + wave; r < 2 * TG; r += gridDim.x * 4) {
    float4* xr = (float4*)(x + (size_t)r * 1024);
    float4 v[4];
    float ss = 0.f;
#pragma unroll
    for (int i = 0; i < 4; ++i) { v[i] = xr[lane + 64 * i]; ss += v[i].x * v[i].x + v[i].y * v[i].y + v[i].z * v[i].z + v[i].w * v[i].w; }
    ss = wave_sum(ss);
    const float rs = rsqrtf(ss * (1.f / 1024.f) + EPS);
#pragma unroll
    for (int i = 0; i < 4; ++i) {
      const float4 gg = ((const float4*)g)[lane + 64 * i];
      float4 o; o.x = v[i].x * rs * gg.x; o.y = v[i].y * rs * gg.y; o.z = v[i].z * rs * gg.z; o.w = v[i].w * rs * gg.w;
      xr[lane + 64 * i] = o;
    }
  }
}

template <int NI, int NB, bool SWAP = false>
DI void gemm_main(f32x16 (&acc0)[2][NI], f32x16 (&acc1)[2][NI], const bf16_t* __restrict__ A, int lda,
                  const bf16_t* __restrict__ B0, const bf16_t* __restrict__ B1, int ldb, int K, char* lds) {
  const int tid = threadIdx.x + opq(), lane = tid & 63, w = tid >> 6, wm = w >> 1, wn = w & 1, l31 = lane & 31, h2 = lane >> 5;
  bf16_t* As = (bf16_t*)lds;
  bf16_t* B0s = As + 128 * 72;
  bf16_t* B1s = B0s + 64 * NI * 72;
  const int lr = tid >> 3, lc = (tid & 7) * 8;
  u32x4 ra[4], rb0[2 * NI], rb1[2 * NI];
  const bf16_t* ap = A + (size_t)lr * lda + lc;
  const bf16_t* bp0 = B0 + (size_t)lr * ldb + lc;
  const bf16_t* bp1 = (NB == 2) ? (B1 + (size_t)lr * ldb + lc) : B0;
#pragma unroll
  for (int i = 0; i < 4; ++i) ra[i] = *(const u32x4*)(ap + (size_t)(32 * i) * lda);
#pragma unroll
  for (int i = 0; i < 2 * NI; ++i) {
    rb0[i] = *(const u32x4*)(bp0 + (size_t)(32 * i) * ldb);
    if (NB == 2) rb1[i] = *(const u32x4*)(bp1 + (size_t)(32 * i) * ldb);
  }
  for (int k0 = 0; k0 < K; k0 += 64) {
    __syncthreads();
#pragma unroll
    for (int i = 0; i < 4; ++i) *(u32x4*)(As + (lr + 32 * i) * 72 + lc) = ra[i];
#pragma unroll
    for (int i = 0; i < 2 * NI; ++i) {
      *(u32x4*)(B0s + (lr + 32 * i) * 72 + lc) = rb0[i];
      if (NB == 2) *(u32x4*)(B1s + (lr + 32 * i) * 72 + lc) = rb1[i];
    }
    if (k0 + 64 < K) {
      const int kn = k0 + 64;
#pragma unroll
      for (int i = 0; i < 4; ++i) ra[i] = *(const u32x4*)(ap + (size_t)(32 * i) * lda + kn);
#pragma unroll
      for (int i = 0; i < 2 * NI; ++i) {
        rb0[i] = *(const u32x4*)(bp0 + (size_t)(32 * i) * ldb + kn);
        if (NB == 2) rb1[i] = *(const u32x4*)(bp1 + (size_t)(32 * i) * ldb + kn);
      }
    }
    __syncthreads();
    __builtin_amdgcn_s_setprio(1);
#pragma unroll
    for (int ks = 0; ks < 4; ++ks) {
      bf16x8 af[2], bf0[NI], bf1[NI];
#pragma unroll
      for (int mi = 0; mi < 2; ++mi) af[mi] = *(const bf16x8*)(As + (64 * wm + 32 * mi + l31) * 72 + 16 * ks + 8 * h2);
#pragma unroll
      for (int ni = 0; ni < NI; ++ni) {
        bf0[ni] = *(const bf16x8*)(B0s + (32 * NI * wn + 32 * ni + l31) * 72 + 16 * ks + 8 * h2);
        if (NB == 2) bf1[ni] = *(const bf16x8*)(B1s + (32 * NI * wn + 32 * ni + l31) * 72 + 16 * ks + 8 * h2);
      }
#pragma unroll
      for (int mi = 0; mi < 2; ++mi)
#pragma unroll
        for (int ni = 0; ni < NI; ++ni) {
          acc0[mi][ni] = SWAP ? MFMA32(bf0[ni], af[mi], acc0[mi][ni]) : MFMA32(af[mi], bf0[ni], acc0[mi][ni]);
          if (NB == 2) acc1[mi][ni] = SWAP ? MFMA32(bf1[ni], af[mi], acc1[mi][ni]) : MFMA32(af[mi], bf1[ni], acc1[mi][ni]);
        }
    }
    __builtin_amdgcn_s_setprio(0);
  }
}

DI void gemm_main_bd(f32x16 (&acc)[4][2], const bf16_t* __restrict__ A, int lda, const bf16_t* __restrict__ Bf, int n0,
                     int K, char* lds) {
  const int tid = threadIdx.x + opq(), lane = tid & 63, w = tid >> 6, l31 = lane & 31, h2 = lane >> 5;
  bf16_t* As0 = (bf16_t*)lds;
  const int lr = tid >> 3, lc = (tid & 7) * 8;
  const int KS = K >> 4, nsteps = K >> 6;
  u32x4 ra[4];
  const bf16_t* ap = A + (size_t)lr * lda + lc;
  const bf16_t* bq0 = Bf + ((size_t)((n0 >> 5) + 2 * w) * KS) * 512 + lane * 8;
  const bf16_t* bq1 = bq0 + (size_t)KS * 512;
  bf16x8 bc[2][4], bn[2][4];
#pragma unroll
  for (int i = 0; i < 4; ++i) ra[i] = *(const u32x4*)(ap + (size_t)(32 * i) * lda);
#pragma unroll
  for (int ks = 0; ks < 4; ++ks) { bn[0][ks] = *(const bf16x8*)(bq0 + ks * 512); bn[1][ks] = *(const bf16x8*)(bq1 + ks * 512); }
  __syncthreads();
#pragma unroll
  for (int i = 0; i < 4; ++i) *(u32x4*)(As0 + (lr + 32 * i) * 72 + lc) = ra[i];
  if (nsteps > 1) {
#pragma unroll
    for (int i = 0; i < 4; ++i) ra[i] = *(const u32x4*)(ap + (size_t)(32 * i) * lda + 64);
  }
  __syncthreads();
  for (int k = 0; k < nsteps; ++k) {
    const bf16_t* As = As0 + (k & 1) * (128 * 72);
    bf16_t* Aw = As0 + ((k + 1) & 1) * (128 * 72);
#pragma unroll
    for (int ks = 0; ks < 4; ++ks) { bc[0][ks] = bn[0][ks]; bc[1][ks] = bn[1][ks]; }
    if (k + 1 < nsteps) {
#pragma unroll
      for (int ks = 0; ks < 4; ++ks) {
        bn[0][ks] = *(const bf16x8*)(bq0 + (size_t)(4 * (k + 1) + ks) * 512);
        bn[1][ks] = *(const bf16x8*)(bq1 + (size_t)(4 * (k + 1) + ks) * 512);
      }
#pragma unroll
      for (int i = 0; i < 4; ++i) *(u32x4*)(Aw + (lr + 32 * i) * 72 + lc) = ra[i];
      if (k + 2 < nsteps) {
#pragma unroll
        for (int i = 0; i < 4; ++i) ra[i] = *(const u32x4*)(ap + (size_t)(32 * i) * lda + (size_t)(k + 2) * 64);
      }
    }
    __builtin_amdgcn_s_setprio(1);
#pragma unroll
    for (int ks = 0; ks < 4; ++ks) {
      bf16x8 af[4];
#pragma unroll
      for (int mi = 0; mi < 4; ++mi) af[mi] = *(const bf16x8*)(As + (32 * mi + l31) * 72 + 16 * ks + 8 * h2);
#pragma unroll
      for (int mi = 0; mi < 4; ++mi)
#pragma unroll
        for (int ni = 0; ni < 2; ++ni) acc[mi][ni] = MFMA32(bc[ni][ks], af[mi], acc[mi][ni]);
    }
    __builtin_amdgcn_s_setprio(0);
    __syncthreads();
  }
}

template <int NI>
DI void zero_acc(f32x16 (&a)[2][NI]) {
#pragma unroll
  for (int mi = 0; mi < 2; ++mi)
#pragma unroll
    for (int ni = 0; ni < NI; ++ni)
#pragma unroll
      for (int r = 0; r < 16; ++r) a[mi][ni][r] = 0.f;
}

#define EPI_VARS const int tid = threadIdx.x + opq(), lane = tid & 63, w = tid >> 6, wm = w >> 1, wn = w & 1, l31 = lane & 31, h2 = lane >> 5; (void)tid; (void)lane; (void)w
#define EPI_BEGIN(NI_) _Pragma("unroll") for (int mi = 0; mi < 2; ++mi) _Pragma("unroll") for (int ni = 0; ni < NI_; ++ni) _Pragma("unroll") for (int r = 0; r < 16; ++r) { \
    const int row = 64 * wm + 32 * mi + crow(r, h2); const int col = 32 * NI_ * wn + 32 * ni + l31;
#define EPI_END }

DI bool xcd_tile(int iter, int MT, int NT, int& mt, int& nt) {
  const int x = blockIdx.x & 7, lb = blockIdx.x >> 3, nb = gridDim.x >> 3;
  if (NT == 8) {
    const int j = lb + iter * nb;
    if (lb >= nb || j >= MT) return false;
    mt = (x & 1) * (MT >> 1) + (j >> 1);
    nt = 2 * (x >> 1) + (j & 1);
    return true;
  }
  const int full = NT >> 3, rem = NT & 7;
  const int per_full = full * MT, rem_tot = rem * MT;
  const int r0 = (rem_tot * x) >> 3, r1 = (rem_tot * (x + 1)) >> 3;
  const int j = lb + iter * nb;
  if (lb >= nb || j >= per_full + (r1 - r0)) return false;
  if (j < per_full) { mt = j / full; nt = x * full + j % full; }
  else { const int u = r0 + (j - per_full); nt = 8 * full + u / MT; mt = u % MT; }
  return true;
}

DI void phase_ffn_a(const bf16_t* __restrict__ Nb, const bf16_t* __restrict__ W1, const bf16_t* __restrict__ W3,
                            bf16_t* __restrict__ H, char* lds) {
  EPI_VARS;
  for (int iter = 0;; ++iter) {
    int mt, nt;
    if (!xcd_tile(iter, 256, 22, mt, nt)) break;
    f32x16 a0[2][2], a1[2][2];
    zero_acc<2>(a0); zero_acc<2>(a1);
    gemm_main<2, 2, true>(a0, a1, Nb + (size_t)mt * 128 * 1024, 1024, W1 + (size_t)nt * 128 * 1024, W3 + (size_t)nt * 128 * 1024, 1024, 1024, lds);
#pragma unroll
    for (int mi = 0; mi < 2; ++mi)
#pragma unroll
      for (int ni = 0; ni < 2; ++ni) {
        bf16_t* hp = H + (size_t)(mt * 128 + 64 * wm + 32 * mi + l31) * 2816 + nt * 128 + 64 * wn + 32 * ni + 4 * h2;
#pragma unroll
        for (int g = 0; g < 4; ++g) {
          u32x2 o;
          o.x = pack2(siluf_(a0[mi][ni][4 * g]) * a1[mi][ni][4 * g], siluf_(a0[mi][ni][4 * g + 1]) * a1[mi][ni][4 * g + 1]);
          o.y = pack2(siluf_(a0[mi][ni][4 * g + 2]) * a1[mi][ni][4 * g + 2], siluf_(a0[mi][ni][4 * g + 3]) * a1[mi][ni][4 * g + 3]);
          *(u32x2*)(hp + 8 * g) = o;
        }
      }
  }
}

DI void phase_gemm_resid(const bf16_t* __restrict__ A, int K, const bf16_t* __restrict__ Bf, const float* xsrc, float* x,
                         float scale, char* lds) {
  const int tid = threadIdx.x + opq(), lane = tid & 63, w = tid >> 6, l31 = lane & 31, h2 = lane >> 5;
  for (int iter = 0;; ++iter) {
    int mt, nt;
    if (!xcd_tile(iter, 256, 4, mt, nt)) break;
    f32x16 a0[4][2];
#pragma unroll
    for (int mi = 0; mi < 4; ++mi)
#pragma unroll
      for (int ni = 0; ni < 2; ++ni)
#pragma unroll
        for (int r = 0; r < 16; ++r) a0[mi][ni][r] = 0.f;
    gemm_main_bd(a0, A + (size_t)mt * 128 * K, K, Bf, nt * 256, K, lds);
#pragma unroll
    for (int mi = 0; mi < 4; ++mi)
#pragma unroll
      for (int ni = 0; ni < 2; ++ni) {
        float4 xs[4];
        const size_t base = (size_t)(mt * 128 + 32 * mi + l31) * 1024 + nt * 256 + 64 * w + 32 * ni + 4 * h2;
#pragma unroll
        for (int g = 0; g < 4; ++g) xs[g] = *(const float4*)(xsrc + base + 8 * g);
#pragma unroll
        for (int g = 0; g < 4; ++g) {
          float4 o;
          o.x = xs[g].x + scale * a0[mi][ni][4 * g];
          o.y = xs[g].y + scale * a0[mi][ni][4 * g + 1];
          o.z = xs[g].z + scale * a0[mi][ni][4 * g + 2];
          o.w = xs[g].w + scale * a0[mi][ni][4 * g + 3];
          *(float4*)(x + base + 8 * g) = o;
        }
      }
  }
}

DI void phase_ple(const bf16_t* __restrict__ Nb, const bf16_t* __restrict__ PB, const bf16_t* __restrict__ PG,
                          const bf16_t* __restrict__ PP, float* __restrict__ x, char* lds) {
  EPI_VARS;
  for (int iter = 0;; ++iter) {
    int mt, nt;
    if (!xcd_tile(iter, 256, 8, mt, nt)) break;
    f32x16 a0[2][2], a1[2][2];
    zero_acc<2>(a0); zero_acc<2>(a1);
    gemm_main<2, 1, true>(a0, a0, Nb + (size_t)mt * 128 * 1024, 1024, PG + (size_t)nt * 128 * 1024, nullptr, 1024, 1024, lds);
    gemm_main<2, 1, true>(a1, a1, PB + (size_t)mt * 128 * 256, 256, PP + (size_t)nt * 128 * 256, nullptr, 256, 256, lds);
#pragma unroll
    for (int mi = 0; mi < 2; ++mi)
#pragma unroll
      for (int ni = 0; ni < 2; ++ni) {
        float* xp = x + (size_t)(mt * 128 + 64 * wm + 32 * mi + l31) * 1024 + nt * 128 + 64 * wn + 32 * ni + 4 * h2;
        float4 xs[4];
#pragma unroll
        for (int g = 0; g < 4; ++g) xs[g] = *(const float4*)(xp + 8 * g);
#pragma unroll
        for (int g = 0; g < 4; ++g) {
          float4 o;
          o.x = xs[g].x + sigmoidf_(a0[mi][ni][4 * g]) * a1[mi][ni][4 * g];
          o.y = xs[g].y + sigmoidf_(a0[mi][ni][4 * g + 1]) * a1[mi][ni][4 * g + 1];
          o.z = xs[g].z + sigmoidf_(a0[mi][ni][4 * g + 2]) * a1[mi][ni][4 * g + 2];
          o.w = xs[g].w + sigmoidf_(a0[mi][ni][4 * g + 3]) * a1[mi][ni][4 * g + 3];
          *(float4*)(xp + 8 * g) = o;
        }
      }
  }
}

DI void phase_merge(const bf16_t* __restrict__ Np, const bf16_t* __restrict__ Y, const bf16_t* __restrict__ WG,
                            const bf16_t* __restrict__ WB, bf16_t* __restrict__ M, char* lds) {
  EPI_VARS;
  for (int iter = 0;; ++iter) {
    int mt, nt;
    if (!xcd_tile(iter, 256, 8, mt, nt)) break;
    f32x16 am[2][2];
    zero_acc<2>(am);
#pragma unroll 1
    for (int n = 0; n < 4; ++n) {
      unsigned sg[2][2][8];
      {
        f32x16 ag[2][2];
        zero_acc<2>(ag);
        gemm_main<2, 1, true>(ag, ag, Np + (size_t)mt * 128 * 1024, 1024, WG + (size_t)n * 1048576 + (size_t)nt * 128 * 1024, nullptr, 1024, 1024, lds);
#pragma unroll
        for (int mi = 0; mi < 2; ++mi)
#pragma unroll
          for (int ni = 0; ni < 2; ++ni)
#pragma unroll
            for (int r = 0; r < 8; ++r) sg[mi][ni][r] = pack2(sigmoidf_(ag[mi][ni][2 * r]), sigmoidf_(ag[mi][ni][2 * r + 1]));
      }
      f32x16 ab[2][2];
      zero_acc<2>(ab);
      gemm_main<2, 1, true>(ab, ab, Y + (size_t)mt * 128 * 1024 + n * 256, 1024, WB + (size_t)n * 262144 + (size_t)nt * 128 * 256, nullptr, 256, 256, lds);
#pragma unroll
      for (int mi = 0; mi < 2; ++mi)
#pragma unroll
        for (int ni = 0; ni < 2; ++ni)
#pragma unroll
          for (int r = 0; r < 8; ++r) {
            am[mi][ni][2 * r] += __uint_as_float(sg[mi][ni][r] << 16) * ab[mi][ni][2 * r];
            am[mi][ni][2 * r + 1] += __uint_as_float(sg[mi][ni][r] & 0xffff0000u) * ab[mi][ni][2 * r + 1];
          }
    }
#pragma unroll
    for (int mi = 0; mi < 2; ++mi)
#pragma unroll
      for (int ni = 0; ni < 2; ++ni) {
        bf16_t* mp = M + (size_t)(mt * 128 + 64 * wm + 32 * mi + l31) * 1024 + nt * 128 + 64 * wn + 32 * ni + 4 * h2;
#pragma unroll
        for (int g = 0; g < 4; ++g) {
          u32x2 o;
          o.x = pack2(am[mi][ni][4 * g], am[mi][ni][4 * g + 1]);
          o.y = pack2(am[mi][ni][4 * g + 2], am[mi][ni][4 * g + 3]);
          *(u32x2*)(mp + 8 * g) = o;
        }
      }
  }
}

DI void rope32_out(const float* c, const float2* tab, float sc, float* o) {
#pragma unroll
  for (int i = 0; i < 16; ++i) {
    const float2 cs = tab[i];
    const float a = c[i], b = c[16 + i];
    o[i] = (a * cs.x - b * cs.y) * sc;
    o[16 + i] = (b * cs.x + a * cs.y) * sc;
  }
}

DI void phase_proj(CParams& p, const bf16_t* __restrict__ Nb, const bf16_t* __restrict__ WIN, int S, char* lds) {
  EPI_VARS;
  bf16_t* PR = (bf16_t*)(p.ws + OFF_PR);
  float* AB = (float*)(p.ws + OFF_AB);
  const float2* t32 = (const float2*)(p.ws + OFF_TAB);
  const float2* t64 = (const float2*)(p.ws + OFF_TAB + 2 * MiB);
  float* Ct = (float*)lds;
  for (int iter = 0;; ++iter) {
    int mt, nt2;
    if (!xcd_tile(iter, 256, 18, mt, nt2)) break;
    f32x16 a0[2][4];
    zero_acc<4>(a0);
    gemm_main<4, 1>(a0, a0, Nb + (size_t)mt * 128 * 1024, 1024, WIN + (size_t)nt2 * 256 * 1024, nullptr, 1024, 1024, lds);
   for (int hv = 0; hv < 2; ++hv) {
    const int nt = 2 * nt2 + hv;
    __syncthreads();
    if (wn == hv) {
#pragma unroll
      for (int mi = 0; mi < 2; ++mi)
#pragma unroll
        for (int ni = 0; ni < 4; ++ni)
#pragma unroll
          for (int r = 0; r < 16; ++r) Ct[(64 * wm + 32 * mi + crow(r, h2)) * 132 + 32 * ni + l31] = a0[mi][ni][r];
    }
    __syncthreads();
    const int erow = tid >> 1, half = tid & 1;
    const int tok = mt * 128 + erow, pos = tok & (S - 1);
    const float* cr = Ct + erow * 132 + 64 * half;
    bf16_t* dst = PR + (size_t)tok * NPR + nt * 128 + 64 * half;
    int type = 0; float sc = 1.f;
    if (nt == 3 || nt == 4) { type = 1; sc = 0.17677669529663687f * LOG2E; }
    else if (nt == 5 || nt == 6) { type = 1; }
    else if (nt >= 17 && nt <= 22) { type = 2; sc = 0.125f * LOG2E; }
    else if (nt >= 23 && nt <= 28) { type = 2; }
    else if (nt == 35) type = 3;
    if (type == 0) {
#pragma unroll
      for (int j = 0; j < 8; ++j) store8bf(dst + 8 * j, cr + 8 * j);
    } else if (type == 1) {
#pragma unroll
      for (int hh = 0; hh < 2; ++hh) {
        float o[32];
        rope32_out(cr + 32 * hh, t32 + (size_t)pos * 16, sc, o);
#pragma unroll
        for (int j = 0; j < 4; ++j) store8bf(dst + 32 * hh + 8 * j, o + 8 * j);
      }
    } else if (type == 2) {
      const float2* tab = t64 + (size_t)pos * 32;
#pragma unroll
      for (int j = 0; j < 4; ++j) {
        float lo[8], hi[8];
#pragma unroll
        for (int e = 0; e < 8; ++e) {
          const float2 cs = tab[8 * j + e];
          const float a = cr[8 * j + e], b = cr[32 + 8 * j + e];
          lo[e] = (a * cs.x - b * cs.y) * sc;
          hi[e] = (b * cs.x + a * cs.y) * sc;
        }
        store8bf(dst + 8 * j, lo);
        store8bf(dst + 32 + 8 * j, hi);
      }
    } else {
      if (half == 0) {
        float o[32];
        rope32_out(cr, t32 + (size_t)pos * 16, 1.f, o);
#pragma unroll
        for (int j = 0; j < 4; ++j) store8bf(dst + 8 * j, o + 8 * j);
      } else {
        const float* c2 = Ct + erow * 132 + 32;
#pragma unroll
        for (int j = 0; j < 4; ++j) {
          float4 v; v.x = c2[4 * j]; v.y = c2[4 * j + 1]; v.z = c2[4 * j + 2]; v.w = c2[4 * j + 3];
          ((float4*)(AB + (size_t)tok * 16))[j] = v;
        }
      }
    }
   }
  }
}

DI void mla_up_tile(CParams& p, int mt, int j, int S, char* lds) {
  EPI_VARS;
  const bf16_t* PR = (const bf16_t*)(p.ws + OFF_PR);
  const bf16_t* wb = (const bf16_t*)(p.ws + OFF_WB);
  bf16_t* Qb = (bf16_t*)(p.ws + OFF_Q);
  bf16_t* Kb = (bf16_t*)(p.ws + OFF_K);
  bf16_t* Vb = (bf16_t*)(p.ws + OFF_V);
  const float2* t32 = (const float2*)(p.ws + OFF_TAB);
  float* Ct = (float*)lds;
  float* rst = (float*)(lds + 67584);
  const bool isq = j < 3;
  const int K = isq ? 256 : 128;
  const int nt = isq ? j : j - 3;
  const bf16_t* A = PR + (size_t)mt * 128 * NPR + (isq ? C_CQ : C_CKV);
  const bf16_t* B = wb + (isq ? W_UQ : W_UKV) + (size_t)nt * 128 * K;
  const int erow = tid >> 1, half = tid & 1;
  {
    const bf16_t* ar = A + (size_t)erow * NPR + half * (K / 2);
    float ss = 0.f;
    for (int c = 0; c < K / 16; ++c) {
      const u32x4 u = *(const u32x4*)(ar + 8 * c);
      const unsigned uu[4] = {u.x, u.y, u.z, u.w};
#pragma unroll
      for (int e = 0; e < 4; ++e) {
        const float lo = __uint_as_float(uu[e] << 16), hi = __uint_as_float(uu[e] & 0xffff0000u);
        ss += lo * lo + hi * hi;
      }
    }
    ss += __shfl_xor(ss, 1);
    if (half == 0) rst[erow] = rsqrtf(ss / (float)K + EPS);
  }
  f32x16 a0[2][2];
  zero_acc<2>(a0);
  gemm_main<2, 1>(a0, a0, A, NPR, B, nullptr, K, K, lds);
  __syncthreads();
  EPI_BEGIN(2)
    Ct[row * 132 + col] = a0[mi][ni][r];
  EPI_END
  __syncthreads();
  const int tok = mt * 128 + erow, pos = tok & (S - 1);
  const float rs = rst[erow];
  const float* cr = Ct + erow * 132 + 64 * half;
  if (isq) {
    const float sc = rs * 0.10206207261596577f * LOG2E;
    if (nt < 2) {
      bf16_t* dst = Qb + ((size_t)tok * 4 + 2 * nt + half) * 96;
#pragma unroll
      for (int jj = 0; jj < 8; ++jj) {
        float o[8];
#pragma unroll
        for (int e = 0; e < 8; ++e) o[e] = cr[8 * jj + e] * sc;
        store8bf(dst + 8 * jj, o);
      }
    } else {
#pragma unroll
      for (int hh = 0; hh < 2; ++hh) {
        float o[32];
        rope32_out(cr + 32 * hh, t32 + (size_t)pos * 16, sc, o);
        bf16_t* dst = Qb + ((size_t)tok * 4 + 2 * half + hh) * 96 + 64;
#pragma unroll
        for (int jj = 0; jj < 4; ++jj) store8bf(dst + 8 * jj, o + 8 * jj);
      }
    }
  } else {
    bf16_t* dst = half == 0 ? (Kb + ((size_t)tok * 4 + nt) * 96) : (Vb + ((size_t)tok * 4 + nt) * 64);
#pragma unroll
    for (int jj = 0; jj < 8; ++jj) {
      float o[8];
#pragma unroll
      for (int e = 0; e < 8; ++e) o[e] = cr[8 * jj + e] * rs;
      store8bf(dst + 8 * jj, o);
    }
    if (half == 0) {
      const u32x4* src = (const u32x4*)(PR + (size_t)tok * NPR + 4480);
#pragma unroll
      for (int jj = 0; jj < 4; ++jj) ((u32x4*)(dst + 64))[jj] = src[jj];
    }
  }
}

typedef short s16x4_t __attribute__((ext_vector_type(4)));
DI bf16x8 tr_pair(const bf16_t* p0, const bf16_t* p1) {
  const s16x4_t lo = __builtin_amdgcn_ds_read_tr16_b64_v4i16((__attribute__((address_space(3))) s16x4_t*)p0);
  const s16x4_t hi = __builtin_amdgcn_ds_read_tr16_b64_v4i16((__attribute__((address_space(3))) s16x4_t*)p1);
  return __builtin_shufflevector(lo, hi, 0, 1, 2, 3, 4, 5, 6, 7);
}

template <int DK, bool BAND>
DI void flash_loop(f32x16 (&O)[2], float& m, float& l, const bf16_t* __restrict__ qrow, const bf16_t* __restrict__ kbase,
                   size_t kstride, const bf16_t* __restrict__ vbase, size_t vstride, int ntiles, int tq, int u0, int L,
                   char* lds) {
  const int tid = threadIdx.x + opq(), lane = tid & 63, l31 = lane & 31, h2 = lane >> 5;
  constexpr int KR = DK + 8, KCH = DK / 8, KN = 64 * KCH / 256;
  constexpr int STAGE = 64 * KR * 2 + 64 * 72 * 2;
  bf16x8 qf[DK / 16];
#pragma unroll
  for (int ks = 0; ks < DK / 16; ++ks) qf[ks] = *(const bf16x8*)(qrow + 16 * ks + 8 * h2);
  u32x4 rkA[KN], rvA[2], rkB[KN], rvB[2];
  auto gload = [&](int kt, u32x4 (&rk)[KN], u32x4 (&rv)[2]) {
#pragma unroll
    for (int i = 0; i < KN; ++i) {
      const int ci = tid + 256 * i, row = ci / KCH, c = ci % KCH;
      int rr = u0 + 64 * kt + row;
      if (BAND) rr = min(max(rr, 0), L - 1);
      rk[i] = *(const u32x4*)(kbase + (size_t)rr * kstride + c * 8);
    }
#pragma unroll
    for (int i = 0; i < 2; ++i) {
      const int ci = tid + 256 * i, row = ci >> 3, c = ci & 7;
      int rr = u0 + 64 * kt + row;
      if (BAND) rr = min(max(rr, 0), L - 1);
      rv[i] = *(const u32x4*)(vbase + (size_t)rr * vstride + c * 8);
    }
  };
  auto swrite = [&](int st, const u32x4 (&rk)[KN], const u32x4 (&rv)[2]) {
    bf16_t* Ks = (bf16_t*)(lds + st * STAGE);
    bf16_t* Vs = Ks + 64 * KR;
#pragma unroll
    for (int i = 0; i < KN; ++i) {
      const int ci = tid + 256 * i, row = ci / KCH, c = ci % KCH;
      *(u32x4*)(Ks + row * KR + c * 8) = rk[i];
    }
#pragma unroll
    for (int i = 0; i < 2; ++i) {
      const int ci = tid + 256 * i, row = ci >> 3, c = ci & 7;
      *(u32x4*)(Vs + row * 72 + c * 8) = rv[i];
    }
  };
  const int trq = (lane & 15) >> 2, trp = lane & 3, trblk = (lane >> 4) & 1;
  const int troff = (4 * h2 + trq) * 72 + 16 * trblk + 4 * trp;
  __syncthreads();
  gload(0, rkA, rvA);
  swrite(0, rkA, rvA);
  gload(1, rkA, rvA);
  if (ntiles > 2) gload(2, rkB, rvB);
  for (int kt2 = 0; kt2 < ntiles; kt2 += 2)
#pragma unroll
  for (int par = 0; par < 2; ++par) {
    const int kt = kt2 + par;
    __syncthreads();
    if (par == 0) {
      if (kt + 1 < ntiles) swrite((kt + 1) & 1, rkA, rvA);
      if (kt + 3 < ntiles) gload(kt + 3, rkA, rvA);
    } else {
      if (kt + 1 < ntiles) swrite((kt + 1) & 1, rkB, rvB);
      if (kt + 3 < ntiles) gload(kt + 3, rkB, rvB);
    }
    const bf16_t* Ks = (const bf16_t*)(lds + (kt & 1) * STAGE);
    const bf16_t* Vs = Ks + 64 * KR;
    f32x16 Sx[2];
#pragma unroll
    for (int j = 0; j < 2; ++j)
#pragma unroll
      for (int r = 0; r < 16; ++r) Sx[j][r] = 0.f;
#pragma unroll
    for (int ks = 0; ks < DK / 16; ++ks)
#pragma unroll
      for (int j = 0; j < 2; ++j) {
        const bf16x8 kf = *(const bf16x8*)(Ks + (32 * j + l31) * KR + 16 * ks + 8 * h2);
        Sx[j] = MFMA32(kf, qf[ks], Sx[j]);
      }
    if (BAND) {
#pragma unroll
      for (int j = 0; j < 2; ++j)
#pragma unroll
        for (int r = 0; r < 16; ++r) {
          const int u = u0 + 64 * kt + 32 * j + crow(r, h2);
          const int d = u - tq;
          const bool valid = (d <= 64) && (d >= -64) && (u >= 0) && (u < L);
          Sx[j][r] = valid ? Sx[j][r] : -1e30f;
        }
    }
    float mx = Sx[0][0];
#pragma unroll
    for (int j = 0; j < 2; ++j)
#pragma unroll
      for (int r = 0; r < 16; ++r) mx = fmaxf(mx, Sx[j][r]);
    mx = xhalf_max(mx);
    if (__any(mx - m > DEFER_THR)) {
      const float mn = fmaxf(m, mx);
      const float alpha = exp2_(m - mn);
      m = mn;
      l *= alpha;
#pragma unroll
      for (int t = 0; t < 2; ++t)
#pragma unroll
        for (int r = 0; r < 16; ++r) O[t][r] *= alpha;
    }
    float ls = 0.f;
#pragma unroll
    for (int j = 0; j < 2; ++j)
#pragma unroll
      for (int r = 0; r < 16; ++r) { const float pv = exp2_(Sx[j][r] - m); Sx[j][r] = pv; ls += pv; }
    l += ls;
#pragma unroll
    for (int j = 0; j < 2; ++j)
#pragma unroll
      for (int s = 0; s < 2; ++s) {
        const bf16x8 pf = pack8(Sx[j][8 * s], Sx[j][8 * s + 1], Sx[j][8 * s + 2], Sx[j][8 * s + 3], Sx[j][8 * s + 4],
                                Sx[j][8 * s + 5], Sx[j][8 * s + 6], Sx[j][8 * s + 7]);
#pragma unroll
        for (int t = 0; t < 2; ++t) {
          const bf16_t* vp = Vs + (32 * j + 16 * s) * 72 + 32 * t + troff;
          const bf16x8 vf = tr_pair(vp, vp + 8 * 72);
          O[t] = MFMA32(vf, pf, O[t]);
        }
      }
  }
}

DI void flash_loop_diff(f32x16 (&O0)[2], f32x16 (&O1)[2], float& m0, float& l0, float& m1, float& l1,
                        const bf16_t* __restrict__ qrow, const bf16_t* __restrict__ kbase, size_t kstride,
                        const bf16_t* __restrict__ vbase, size_t vstride, int ntiles, char* lds) {
  const int tid = threadIdx.x + opq(), lane = tid & 63, l31 = lane & 31, h2 = lane >> 5;
  constexpr int KR = 72;
  constexpr int STAGE = 64 * KR * 2 + 64 * 72 * 2;
  bf16x8 qf0[2], qf1[2];
#pragma unroll
  for (int ks = 0; ks < 2; ++ks) {
    qf0[ks] = *(const bf16x8*)(qrow + 16 * ks + 8 * h2);
    qf1[ks] = *(const bf16x8*)(qrow + 32 + 16 * ks + 8 * h2);
  }
  u32x4 rk[2], rv[2];
  auto gload = [&](int kt) {
#pragma unroll
    for (int i = 0; i < 2; ++i) {
      const int ci = tid + 256 * i, row = ci >> 3, c = ci & 7;
      const int rr = 64 * kt + row;
      rk[i] = *(const u32x4*)(kbase + (size_t)rr * kstride + c * 8);
      rv[i] = *(const u32x4*)(vbase + (size_t)rr * vstride + c * 8);
    }
  };
  auto swrite = [&](int st) {
    bf16_t* Ks = (bf16_t*)(lds + st * STAGE);
    bf16_t* Vs = Ks + 64 * KR;
#pragma unroll
    for (int i = 0; i < 2; ++i) {
      const int ci = tid + 256 * i, row = ci >> 3, c = ci & 7;
      *(u32x4*)(Ks + row * KR + c * 8) = rk[i];
      *(u32x4*)(Vs + row * 72 + c * 8) = rv[i];
    }
  };
  const int trq = (lane & 15) >> 2, trp = lane & 3, trblk = (lane >> 4) & 1;
  const int troff = (4 * h2 + trq) * 72 + 16 * trblk + 4 * trp;
  __syncthreads();
  gload(0);
  swrite(0);
  if (ntiles > 1) gload(1);
  for (int kt = 0; kt < ntiles; ++kt) {
    __syncthreads();
    if (kt + 1 < ntiles) swrite((kt + 1) & 1);
    if (kt + 2 < ntiles) gload(kt + 2);
    const bf16_t* Ks = (const bf16_t*)(lds + (kt & 1) * STAGE);
    const bf16_t* Vs = Ks + 64 * KR;
    bf16x8 pf[2][2][2];
#pragma unroll
    for (int mp = 0; mp < 2; ++mp) {
      f32x16 Sx[2];
#pragma unroll
      for (int j = 0; j < 2; ++j)
#pragma unroll
        for (int r = 0; r < 16; ++r) Sx[j][r] = 0.f;
#pragma unroll
      for (int ks = 0; ks < 2; ++ks)
#pragma unroll
        for (int j = 0; j < 2; ++j) {
          const bf16x8 kf = *(const bf16x8*)(Ks + (32 * j + l31) * KR + 32 * mp + 16 * ks + 8 * h2);
          Sx[j] = MFMA32(kf, mp == 0 ? qf0[ks] : qf1[ks], Sx[j]);
        }
      float& m = mp == 0 ? m0 : m1;
      float& l = mp == 0 ? l0 : l1;
      float mx = Sx[0][0];
#pragma unroll
      for (int j = 0; j < 2; ++j)
#pragma unroll
        for (int r = 0; r < 16; ++r) mx = fmaxf(mx, Sx[j][r]);
      mx = xhalf_max(mx);
      if (__any(mx - m > DEFER_THR)) {
        const float mn = fmaxf(m, mx);
        const float alpha = exp2_(m - mn);
        m = mn;
        l *= alpha;
#pragma unroll
        for (int t = 0; t < 2; ++t)
#pragma unroll
          for (int r = 0; r < 16; ++r) { if (mp == 0) O0[t][r] *= alpha; else O1[t][r] *= alpha; }
      }
      float ls = 0.f;
#pragma unroll
      for (int j = 0; j < 2; ++j)
#pragma unroll
        for (int r = 0; r < 16; ++r) { const float pv = exp2_(Sx[j][r] - m); Sx[j][r] = pv; ls += pv; }
      l += ls;
#pragma unroll
      for (int j = 0; j < 2; ++j)
#pragma unroll
        for (int s = 0; s < 2; ++s)
          pf[mp][j][s] = pack8(Sx[j][8 * s], Sx[j][8 * s + 1], Sx[j][8 * s + 2], Sx[j][8 * s + 3], Sx[j][8 * s + 4],
                               Sx[j][8 * s + 5], Sx[j][8 * s + 6], Sx[j][8 * s + 7]);
    }
#pragma unroll
    for (int j = 0; j < 2; ++j)
#pragma unroll
      for (int s = 0; s < 2; ++s)
#pragma unroll
        for (int t = 0; t < 2; ++t) {
          const bf16_t* vp = Vs + (32 * j + 16 * s) * 72 + 32 * t + troff;
          const bf16x8 vf = tr_pair(vp, vp + 8 * 72);
          O0[t] = MFMA32(vf, pf[0][j][s], O0[t]);
          O1[t] = MFMA32(vf, pf[1][j][s], O1[t]);
        }
  }
}

DI void zeroO(f32x16 (&O)[2]) {
#pragma unroll
  for (int t = 0; t < 2; ++t)
#pragma unroll
    for (int r = 0; r < 16; ++r) O[t][r] = 0.f;
}

DI void store_o(bf16_t* dst, const f32x16 (&O)[2], int h2) {
#pragma unroll
  for (int t = 0; t < 2; ++t)
#pragma unroll
    for (int g = 0; g < 4; ++g) {
      u32x2 u; u.x = pack2(O[t][4 * g], O[t][4 * g + 1]); u.y = pack2(O[t][4 * g + 2], O[t][4 * g + 3]);
      *(u32x2*)(dst + 32 * t + 8 * g + 4 * h2) = u;
    }
}

DI void mla_item(CParams& p, int it, int S, char* lds) {
  const int tid = threadIdx.x + opq(), lane = tid & 63, w = tid >> 6, l31 = lane & 31, h2 = lane >> 5;
  const int lgq = (S == 2048) ? 4 : 7;
  const int qb = it & ((1 << lgq) - 1), bh = it >> lgq, h = bh & 3, b = bh >> 2;
  const int tokbase = b * S, gtok = tokbase + 128 * qb + 32 * w + l31;
  const bf16_t* Qb = (const bf16_t*)(p.ws + OFF_Q);
  const bf16_t* Kb = (const bf16_t*)(p.ws + OFF_K);
  const bf16_t* Vb = (const bf16_t*)(p.ws + OFF_V);
  bf16_t* Y = (bf16_t*)(p.ws + OFF_N);
  f32x16 O[2]; zeroO(O);
  float m = -1e30f, l = 0.f;
  flash_loop<96, false>(O, m, l, Qb + ((size_t)gtok * 4 + h) * 96, Kb + ((size_t)tokbase * 4 + h) * 96, 384,
                        Vb + ((size_t)tokbase * 4 + h) * 64, 256, S / 64, 0, 0, 0, lds);
  l += __shfl_xor(l, 32);
  const float il = 1.f / l;
#pragma unroll
  for (int t = 0; t < 2; ++t)
#pragma unroll
    for (int r = 0; r < 16; ++r) O[t][r] *= il;
  store_o(Y + (size_t)gtok * 1024 + h * 64, O, h2);
}

DI void diff_item(CParams& p, int layer, int it, int S, char* lds) {
  const int tid = threadIdx.x + opq(), lane = tid & 63, w = tid >> 6, l31 = lane & 31, h2 = lane >> 5;
  const int lgq = (S == 2048) ? 4 : 7;
  const int qb = it & ((1 << lgq) - 1), bh = it >> lgq, h = bh & 3, b = bh >> 2;
  const int tokbase = b * S, gtok = tokbase + 128 * qb + 32 * w + l31;
  const bf16_t* PR = (const bf16_t*)(p.ws + OFF_PR);
  bf16_t* Y = (bf16_t*)(p.ws + OFF_N);
  const float* lam = p.diff_lambda + layer * 128;
  float s1 = 0.f, s2 = 0.f;
  if (lane < 32) { s1 = lam[lane] * lam[32 + lane]; s2 = lam[64 + lane] * lam[96 + lane]; }
  s1 = wave_sum(s1); s2 = wave_sum(s2);
  const float lambda_init = layer ? 0.35550907f : 0.2f;
  const float lambda_full = expf(s1) - expf(s2) + lambda_init;
  f32x16 of[2], O1[2];
  zeroO(of); zeroO(O1);
  {
    float m0 = -1e30f, l0 = 0.f, m1 = -1e30f, l1 = 0.f;
    flash_loop_diff(of, O1, m0, l0, m1, l1, PR + (size_t)gtok * NPR + C_BQ + (2 * h) * 32,
                    PR + (size_t)tokbase * NPR + C_BK + (2 * h) * 32, NPR, PR + (size_t)tokbase * NPR + C_BV + h * 64, NPR,
                    S / 64, lds);
    l0 += __shfl_xor(l0, 32);
    l1 += __shfl_xor(l1, 32);
    const float c0 = 1.f / l0, c1 = -lambda_full / l1;
#pragma unroll
    for (int t = 0; t < 2; ++t)
#pragma unroll
      for (int r = 0; r < 16; ++r) of[t][r] = c0 * of[t][r] + c1 * O1[t][r];
  }
  float ss = 0.f;
#pragma unroll
  for (int t = 0; t < 2; ++t)
#pragma unroll
    for (int r = 0; r < 16; ++r) ss += of[t][r] * of[t][r];
  ss += __shfl_xor(ss, 32);
  const float rs = rsqrtf(ss * (1.f / 64.f) + EPS) * (1.f - lambda_init);
  const float* sg = p.diff_subln + layer * 64;
#pragma unroll
  for (int t = 0; t < 2; ++t)
#pragma unroll
    for (int r = 0; r < 16; ++r) of[t][r] *= rs * sg[32 * t + crow(r, h2)];
  store_o(Y + (size_t)gtok * 1024 + 256 + h * 64, of, h2);
}

DI void dil_item(CParams& p, int it, int S, int B, char* lds) {
  const int tid = threadIdx.x + opq(), lane = tid & 63, w = tid >> 6, l31 = lane & 31, h2 = lane >> 5;
  const int lgS = (S == 2048) ? 11 : 14, lgB = (B == 16) ? 4 : 1;
  const int rq = it & ((1 << (lgS - 7)) - 1);
  int rest = it >> (lgS - 7);
  const int head = rest & 3; rest >>= 2;
  const int b = rest & (B - 1), g = rest >> lgB;
  const int lgd = 2 * g, dil = 1 << lgd;
  const int L = S >> lgd, lgnqb = lgS - lgd - 7;
  const int res = rq >> lgnqb, qb = rq & ((1 << lgnqb) - 1);
  const int tokbase = b * S;
  const int tq = 128 * qb + 32 * w + l31;
  const int gtok = tokbase + tq * dil + res;
  const bf16_t* PR = (const bf16_t*)(p.ws + OFF_PR);
  bf16_t* OD = (bf16_t*)(p.ws + OFF_OD);
  float* LSE = (float*)(p.ws + OFF_LSE);
  f32x16 O[2]; zeroO(O);
  float m = -1e30f, l = 0.f;
  const int hc = (g * 4 + head) * 64;
  flash_loop<64, true>(O, m, l, PR + (size_t)gtok * NPR + C_DQ + hc, PR + (size_t)(tokbase + res) * NPR + C_DK + hc,
                       (size_t)dil * NPR, PR + (size_t)(tokbase + res) * NPR + C_DV + hc, (size_t)dil * NPR, 4, tq,
                       128 * qb - 64, L, lds);
  l += __shfl_xor(l, 32);
  const float il = 1.f / l;
#pragma unroll
  for (int t = 0; t < 2; ++t)
#pragma unroll
    for (int r = 0; r < 16; ++r) O[t][r] *= il;
  store_o(OD + ((size_t)g * TG + gtok) * 256 + head * 64, O, h2);
  if (h2 == 0) LSE[((size_t)g * TG + gtok) * 4 + head] = m + __log2f(l);
}

constexpr size_t OFF_X2 = 564 * MiB, WS_BIG = 597 * MiB;
#define DN_QK_OFF (p.big_ws ? OFF_X2 : OFF_OD)
#define DN_GC_OFF ((p.big_ws ? OFF_X2 : OFF_OD) + 32 * MiB)
constexpr size_t DN_UW_OFF = OFF_Q;

DI void dn_prep_item(CParams& p, int layer, int it, int S, char* lds) {
  const int tid = threadIdx.x + opq(), lane = tid & 63, w = tid >> 6, l15 = lane & 15, g4 = lane >> 4;
  const int NC = S / 64;
  const int ch = it % NC, bh = it / NC, h = bh & 3, b = bh >> 2;
  const int tokbase = b * S, s0 = ch * 64;
  const bf16_t* PR = (const bf16_t*)(p.ws + OFF_PR);
  const float* AB = (const float*)(p.ws + OFF_AB);
  bf16_t* QKg = (bf16_t*)(p.ws + DN_QK_OFF) + ((size_t)bh * NC + ch) * 8192;
  bf16_t* raw = (bf16_t*)lds;
  float* convw = (float*)(lds + 27200);
  float* RU = (float*)lds;
  float* RW = (float*)(lds + 16384);
  float* Am = (float*)(lds + 32768);
  bf16_t* Kimg = (bf16_t*)(lds + 50176);
  bf16_t* Qimg = (bf16_t*)(lds + 59392);
  float* gcs = (float*)(lds + 68608);
  float* betas = gcs + 128;
  const float* cw = p.dn_conv + (size_t)layer * 5 * 768;
  {
    u32x4 rawreg[7];
    float cwr[4];
#pragma unroll
    for (int k = 0; k < 7; ++k) {
      const int ci = tid + 256 * k;
      const int rr = ci / 24, c = ci % 24, seg = c >> 3, c8 = c & 7;
      const int s = s0 + rr - 2;
      rawreg[k] = u32x4{0u, 0u, 0u, 0u};
      if (ci < 68 * 24 && s >= 0 && s < S)
        rawreg[k] = *(const u32x4*)(PR + (size_t)(tokbase + s) * NPR + C_DNQKV + seg * 256 + h * 64 + c8 * 8);
    }
#pragma unroll
    for (int k = 0; k < 4; ++k) {
      const int i = tid + 256 * k;
      cwr[k] = 0.f;
      if (i < 960) { const int j = i / 192, c = i % 192; cwr[k] = cw[j * 768 + (c >> 6) * 256 + h * 64 + (c & 63)]; }
    }
#pragma unroll
    for (int k = 0; k < 7; ++k) {
      const int ci = tid + 256 * k;
      const int rr = ci / 24, c = ci % 24, seg = c >> 3, c8 = c & 7;
      if (ci < 68 * 24) *(u32x4*)(raw + rr * 200 + seg * 64 + c8 * 8) = rawreg[k];
    }
#pragma unroll
    for (int k = 0; k < 4; ++k) { const int i = tid + 256 * k; if (i < 960) convw[i] = cwr[k]; }
  }
  if (tid < 128) {
    const int d = tid >> 6, pl = tid & 63;
    const int i = d ? 63 - pl : pl;
    const size_t tok = (size_t)tokbase + s0 + i;
    const float Aexp = expf(p.dn_a_log[layer * 8 + d * 4 + h]);
    const float a = AB[tok * 16 + d * 8 + h] + p.dn_dt_bias[layer * 8 + d * 4 + h];
    const float bb = AB[tok * 16 + d * 8 + 4 + h];
    const float sp = fmaxf(a, 0.f) + __logf(1.f + __expf(-fabsf(a)));
    float g = -Aexp * sp;
#pragma unroll
    for (int o = 1; o < 64; o <<= 1) { const float tv = __shfl_up(g, o); if (lane >= o) g += tv; }
    gcs[tid] = g;
    betas[tid] = sigmoidf_(bb);
    float* GC = (float*)(p.ws + DN_GC_OFF) + (((size_t)bh * 2 + d) * NC + ch) * 64;
    GC[pl] = g;
  }
  __syncthreads();
  const int pp = tid >> 2, cgp = tid & 3;
  float kv[16], vv[16];
  {
    float qv[16];
#pragma unroll
    for (int seg = 0; seg < 3; ++seg) {
      float acc[16];
#pragma unroll
      for (int c = 0; c < 16; ++c) acc[c] = 0.f;
#pragma unroll
      for (int j = 0; j < 5; ++j) {
        const bf16_t* rp = raw + (pp + j) * 200 + seg * 64 + 16 * cgp;
        const float* wp = convw + j * 192 + seg * 64 + 16 * cgp;
        const u32x4 u0 = *(const u32x4*)rp, u1 = *(const u32x4*)(rp + 8);
        const unsigned uu[8] = {u0.x, u0.y, u0.z, u0.w, u1.x, u1.y, u1.z, u1.w};
#pragma unroll
        for (int e = 0; e < 8; ++e) {
          acc[2 * e] += wp[2 * e] * __uint_as_float(uu[e] << 16);
          acc[2 * e + 1] += wp[2 * e + 1] * __uint_as_float(uu[e] & 0xffff0000u);
        }
      }
#pragma unroll
      for (int c = 0; c < 16; ++c) {
        const float sv = acc[c] * __builtin_amdgcn_rcpf(1.f + __expf(-acc[c]));
        if (seg == 0) qv[c] = sv; else if (seg == 1) kv[c] = sv; else vv[c] = sv;
      }
    }
    float sq = 0.f, sk = 0.f;
#pragma unroll
    for (int c = 0; c < 16; ++c) { sq += qv[c] * qv[c]; sk += kv[c] * kv[c]; }
    sq += __shfl_xor(sq, 1); sq += __shfl_xor(sq, 2);
    sk += __shfl_xor(sk, 1); sk += __shfl_xor(sk, 2);
    const float rq = rsqrtf(sq + EPS) * 0.125f, rk = rsqrtf(sk + EPS);
#pragma unroll
    for (int c = 0; c < 16; ++c) { qv[c] *= rq; kv[c] *= rk; }
    store8bf(Kimg + pp * 72 + 16 * cgp, kv); store8bf(Kimg + pp * 72 + 16 * cgp + 8, kv + 8);
    store8bf(Qimg + pp * 72 + 16 * cgp, qv); store8bf(Qimg + pp * 72 + 16 * cgp + 8, qv + 8);
    store8bf(QKg + pp * 64 + 16 * cgp, qv); store8bf(QKg + pp * 64 + 16 * cgp + 8, qv + 8);
    store8bf(QKg + 4096 + pp * 64 + 16 * cgp, kv); store8bf(QKg + 4096 + pp * 64 + 16 * cgp + 8, kv + 8);
  }
  for (int d = 0; d < 2; ++d) {
    __syncthreads();
    {
      const int pl = d ? 63 - pp : pp;
      const float bet = betas[d * 64 + pl], egc = __expf(gcs[d * 64 + pl]);
#pragma unroll
      for (int c = 0; c < 16; ++c) {
        RU[pl * 64 + 16 * cgp + c] = vv[c] * bet;
        RW[pl * 64 + 16 * cgp + c] = kv[c] * bet * egc;
      }
    }
    {
      f32x4 KK[4];
#pragma unroll
      for (int t = 0; t < 4; ++t) KK[t] = f32x4{0.f, 0.f, 0.f, 0.f};
      const int jl = 16 * w + l15;
      const int jrow = d ? 63 - jl : jl;
#pragma unroll
      for (int ks = 0; ks < 2; ++ks) {
        const bf16x8 bfk = *(const bf16x8*)(Kimg + jrow * 72 + 32 * ks + 8 * g4);
#pragma unroll
        for (int rt = 0; rt < 4; ++rt) {
          const int il = 16 * rt + l15;
          const int irow = d ? 63 - il : il;
          const bf16x8 afk = *(const bf16x8*)(Kimg + irow * 72 + 32 * ks + 8 * g4);
          KK[rt] = MFMA16(afk, bfk, KK[rt]);
        }
      }
      const float gcj = gcs[d * 64 + jl];
#pragma unroll
      for (int rt = 0; rt < 4; ++rt)
#pragma unroll
        for (int r = 0; r < 4; ++r) {
          const int i = 16 * rt + 4 * g4 + r;
          const float ee = __expf(fminf(gcs[d * 64 + i] - gcj, 0.f));
          Am[i * 68 + jl] = (i > jl) ? betas[d * 64 + i] * KK[rt][r] * ee : 0.f;
        }
    }
    __syncthreads();
    float xs[32];
#pragma unroll
    for (int q = 0; q < 32; ++q) xs[q] = 0.f;
    const int c = tid >> 1, half = tid & 1;
    {
      const float* Rc = (c < 64) ? (RU + c) : (RW + (c - 64));
      const float* Ah = Am + 4 * half;
#pragma unroll
      for (int i = 0; i < 64; ++i) {
        float part = 0.f;
#pragma unroll
        for (int q = 0; q < (i + 7) / 8; ++q) {
          const f32x4 a = *(const f32x4*)(Ah + i * 68 + 8 * q);
          part += a[0] * xs[4 * q] + a[1] * xs[4 * q + 1] + a[2] * xs[4 * q + 2] + a[3] * xs[4 * q + 3];
        }
        const float other = __int_as_float(__builtin_amdgcn_update_dpp(0, __float_as_int(part), 0xB1, 0xf, 0xf, true));
        const float xi = Rc[i * 64] - (part + other);
        const int loc = ((i >> 3) << 2) + (i & 3);
        if (((i >> 2) & 1) == 0) xs[loc] = (half == 0) ? xi : xs[loc];
        else xs[loc] = (half == 1) ? xi : xs[loc];
        if (i < 16 ? ((i & 7) == 7) : (i < 32 ? ((i & 3) == 3) : ((i & 1) == 1))) asm volatile("" ::: "memory");
      }
    }
    {
      bf16_t* UWg = (bf16_t*)(p.ws + DN_UW_OFF) + ((((size_t)bh * 2 + d) * NC + ch) * 8192);
      const float sgn = (c < 64) ? 1.f : -1.f;
      bf16_t* dst = UWg + ((c < 64) ? c : (4096 + c - 64));
#pragma unroll
      for (int loc = 0; loc < 32; ++loc) {
        const int i = (((loc >> 2) * 2 + half) << 2) + (loc & 3);
        dst[i * 64] = f2bf(sgn * xs[loc]);
      }
    }
  }
}

DI void dn_scan_chain(CParams& p, int it, int S, char* lds) {
  __builtin_amdgcn_s_setprio(3);
  const int tid0 = threadIdx.x + opq();
  const int dir = it & 1, bh = it >> 1, h = bh & 3, b = bh >> 2;
  const int tokbase = b * S, NC = S / 64;
  bf16_t* OUT = (bf16_t*)(p.ws + (dir ? OFF_OB : OFF_OF));
  const bf16_t* QKg = (const bf16_t*)(p.ws + DN_QK_OFF) + (size_t)bh * NC * 8192;
  const bf16_t* UWg = (const bf16_t*)(p.ws + DN_UW_OFF) + (size_t)it * NC * 8192;
  const float* GCg = (const float*)(p.ws + DN_GC_OFF) + (size_t)it * NC * 64;
  bf16_t* Uimg = (bf16_t*)lds;
  bf16_t* Wn = Uimg + 4608;
  bf16_t* Qimg = Wn + 4608;
  bf16_t* Kimg = Qimg + 4608;
  bf16_t* Kt = Kimg + 4608;
  bf16_t* Iimg = Kt + 4608;
  float* gcs = (float*)(lds + 6 * 9216);
  f32x4 Sd[4];
#pragma unroll
  for (int t = 0; t < 4; ++t) Sd[t] = f32x4{0.f, 0.f, 0.f, 0.f};
  u32x4 ru[2], rw[2], rq[2], rk[2];
  float rg = 0.f;
  auto prefetch = [&](int cc_) {
    const int ch_ = dir ? (NC - 1 - cc_) : cc_;
    const int tp = tid0 + opq();
    const bf16_t* uw = UWg + (size_t)ch_ * 8192;
    const bf16_t* qk = QKg + (size_t)ch_ * 8192;
#pragma unroll
    for (int k = 0; k < 2; ++k) {
      const int ci = tp + 256 * k, row = ci >> 3, c8 = ci & 7;
      const int srow = dir ? 63 - row : row;
      ru[k] = *(const u32x4*)(uw + row * 64 + c8 * 8);
      rw[k] = *(const u32x4*)(uw + 4096 + row * 64 + c8 * 8);
      rq[k] = *(const u32x4*)(qk + srow * 64 + c8 * 8);
      rk[k] = *(const u32x4*)(qk + 4096 + srow * 64 + c8 * 8);
    }
    if (tp < 64) rg = GCg[(size_t)ch_ * 64 + tp];
  };
  prefetch(0);
  for (int cc = 0; cc < NC; ++cc) {
    const int tid = tid0 + opq(), lane = tid & 63, w = tid >> 6, l15 = lane & 15, g4 = lane >> 4;
    const int e_col = 16 * w + l15;
    const int ch = dir ? (NC - 1 - cc) : cc;
    const int s0 = ch * 64;
    __syncthreads();
#pragma unroll
    for (int k = 0; k < 2; ++k) {
      const int ci = tid + 256 * k, row = ci >> 3, c8 = ci & 7;
      *(u32x4*)(Uimg + row * 72 + c8 * 8) = ru[k];
      *(u32x4*)(Wn + row * 72 + c8 * 8) = rw[k];
      *(u32x4*)(Qimg + row * 72 + c8 * 8) = rq[k];
      *(u32x4*)(Kimg + row * 72 + c8 * 8) = rk[k];
      const unsigned uu[4] = {rk[k].x, rk[k].y, rk[k].z, rk[k].w};
#pragma unroll
      for (int e = 0; e < 4; ++e) {
        Kt[(8 * c8 + 2 * e) * 72 + row] = (bf16_t)(uu[e] & 0xffffu);
        Kt[(8 * c8 + 2 * e + 1) * 72 + row] = (bf16_t)(uu[e] >> 16);
      }
    }
    if (tid < 64) gcs[tid] = rg;
    if (cc + 1 < NC) prefetch(cc + 1);
    __syncthreads();
    {
      f32x4 QK[4];
#pragma unroll
      for (int t = 0; t < 4; ++t) QK[t] = f32x4{0.f, 0.f, 0.f, 0.f};
#pragma unroll
      for (int ks = 0; ks < 2; ++ks) {
        const bf16x8 bfk = *(const bf16x8*)(Kimg + (16 * w + l15) * 72 + 32 * ks + 8 * g4);
#pragma unroll
        for (int rt = 0; rt < 4; ++rt) {
          const bf16x8 afq = *(const bf16x8*)(Qimg + (16 * rt + l15) * 72 + 32 * ks + 8 * g4);
          QK[rt] = MFMA16(afq, bfk, QK[rt]);
        }
      }
      const float gcj = gcs[e_col];
#pragma unroll
      for (int rt = 0; rt < 4; ++rt)
#pragma unroll
        for (int r = 0; r < 4; ++r) {
          const int i = 16 * rt + 4 * g4 + r;
          const float ee = __expf(fminf(gcs[i] - gcj, 0.f));
          Iimg[i * 72 + e_col] = f2bf((i >= e_col) ? QK[rt][r] * ee : 0.f);
        }
    }
    __syncthreads();
    {
      bf16x8 Bs[2];
#pragma unroll
      for (int ks = 0; ks < 2; ++ks)
        Bs[ks] = pack8(Sd[2 * ks][0], Sd[2 * ks][1], Sd[2 * ks][2], Sd[2 * ks][3], Sd[2 * ks + 1][0], Sd[2 * ks + 1][1],
                       Sd[2 * ks + 1][2], Sd[2 * ks + 1][3]);
      f32x4 vn[4], qs[4], iv[4];
#pragma unroll
      for (int rt = 0; rt < 4; ++rt) {
#pragma unroll
        for (int r = 0; r < 4; ++r) vn[rt][r] = bf2f(Uimg[(16 * rt + 4 * g4 + r) * 72 + e_col]);
        qs[rt] = f32x4{0.f, 0.f, 0.f, 0.f};
        iv[rt] = f32x4{0.f, 0.f, 0.f, 0.f};
#pragma unroll
        for (int ks = 0; ks < 2; ++ks) {
          const bf16_t* wp = Wn + (16 * rt + l15) * 72 + 32 * ks + 4 * g4;
          const bf16_t* qp = Qimg + (16 * rt + l15) * 72 + 32 * ks + 4 * g4;
          vn[rt] = MFMA16(ld2x4(wp, wp + 16), Bs[ks], vn[rt]);
          qs[rt] = MFMA16(ld2x4(qp, qp + 16), Bs[ks], qs[rt]);
        }
      }
      bf16x8 Bv[2];
#pragma unroll
      for (int ks = 0; ks < 2; ++ks)
        Bv[ks] = pack8(vn[2 * ks][0], vn[2 * ks][1], vn[2 * ks][2], vn[2 * ks][3], vn[2 * ks + 1][0], vn[2 * ks + 1][1],
                       vn[2 * ks + 1][2], vn[2 * ks + 1][3]);
#pragma unroll
      for (int rt = 0; rt < 4; ++rt)
#pragma unroll
        for (int ks = 0; ks < 2; ++ks) {
          const bf16_t* ip = Iimg + (16 * rt + l15) * 72 + 32 * ks + 4 * g4;
          iv[rt] = MFMA16(ld2x4(ip, ip + 16), Bv[ks], iv[rt]);
        }
      const float gc63 = gcs[63];
#pragma unroll
      for (int rt = 0; rt < 4; ++rt)
#pragma unroll
        for (int r = 0; r < 4; ++r) {
          const int pos = 16 * rt + 4 * g4 + r;
          const float o = qs[rt][r] * __expf(gcs[pos]) + iv[rt][r];
          const int i = dir ? 63 - pos : pos;
          OUT[((size_t)tokbase + s0 + i) * 256 + h * 64 + e_col] = f2bf(o);
          vn[rt][r] *= __expf(gc63 - gcs[pos]);
        }
      bf16x8 Bv2[2];
#pragma unroll
      for (int ks = 0; ks < 2; ++ks)
        Bv2[ks] = pack8(vn[2 * ks][0], vn[2 * ks][1], vn[2 * ks][2], vn[2 * ks][3], vn[2 * ks + 1][0], vn[2 * ks + 1][1],
                        vn[2 * ks + 1][2], vn[2 * ks + 1][3]);
      const float gl = __expf(gc63);
#pragma unroll
      for (int dt = 0; dt < 4; ++dt) {
#pragma unroll
        for (int r = 0; r < 4; ++r) Sd[dt][r] *= gl;
#pragma unroll
        for (int ks = 0; ks < 2; ++ks) {
          const bf16_t* kp = Kt + (16 * dt + l15) * 72 + 32 * ks + 4 * g4;
          Sd[dt] = MFMA16(ld2x4(kp, kp + 16), Bv2[ks], Sd[dt]);
        }
      }
    }
  }
  __builtin_amdgcn_s_setprio(0);
}

DI void phase_combine(CParams& p, int layer, const float* __restrict__ xg) {
  const int tidq = threadIdx.x + opq(); const int wave = tidq >> 6, lane = tidq & 63;
  const bf16_t* PR = (const bf16_t*)(p.ws + OFF_PR);
  const bf16_t* OD = (const bf16_t*)(p.ws + OFF_OD);
  const float* LSE = (const float*)(p.ws + OFF_LSE);
  const bf16_t* OFb = (const bf16_t*)(p.ws + OFF_OF);
  const bf16_t* OBb = (const bf16_t*)(p.ws + OFF_OB);
  bf16_t* Y = (bf16_t*)(p.ws + OFF_N);
  bf16_t* Np = (bf16_t*)(p.ws + OFF_Q);
  const float* gmix = p.norm_mix + layer * 1024;
  const float* gdn = p.dn_out_norm + layer * 64;
  const int head = lane >> 4;
  for (int r = blockIdx.x * 4 + wave; r < TG; r += gridDim.x * 4) {
    {
      float lg[3];
#pragma unroll
      for (int g = 0; g < 3; ++g) lg[g] = LSE[((size_t)g * TG + r) * 4 + head];
      const float mx = fmaxf(lg[0], fmaxf(lg[1], lg[2]));
      float wg[3], den = 0.f;
#pragma unroll
      for (int g = 0; g < 3; ++g) { wg[g] = exp2_(lg[g] - mx); den += wg[g]; }
      const float id = 1.f / den;
      float o[4] = {0.f, 0.f, 0.f, 0.f};
#pragma unroll
      for (int g = 0; g < 3; ++g) {
        const u32x2 u = ((const u32x2*)(OD + ((size_t)g * TG + r) * 256))[lane];
        const float c = wg[g] * id;
        o[0] += c * __uint_as_float(u.x << 16); o[1] += c * __uint_as_float(u.x & 0xffff0000u);
        o[2] += c * __uint_as_float(u.y << 16); o[3] += c * __uint_as_float(u.y & 0xffff0000u);
      }
      u32x2 ou; ou.x = pack2(o[0], o[1]); ou.y = pack2(o[2], o[3]);
      ((u32x2*)(Y + (size_t)r * 1024 + 768))[lane] = ou;
    }
    {
      const u32x2 uf = ((const u32x2*)(OFb + (size_t)r * 256))[lane];
      const u32x2 ub = ((const u32x2*)(OBb + (size_t)r * 256))[lane];
      const u32x2 uz = ((const u32x2*)(PR + (size_t)r * NPR + C_Z))[lane];
      float o[4], z[4];
      o[0] = __uint_as_float(uf.x << 16) + __uint_as_float(ub.x << 16);
      o[1] = __uint_as_float(uf.x & 0xffff0000u) + __uint_as_float(ub.x & 0xffff0000u);
      o[2] = __uint_as_float(uf.y << 16) + __uint_as_float(ub.y << 16);
      o[3] = __uint_as_float(uf.y & 0xffff0000u) + __uint_as_float(ub.y & 0xffff0000u);
      z[0] = __uint_as_float(uz.x << 16); z[1] = __uint_as_float(uz.x & 0xffff0000u);
      z[2] = __uint_as_float(uz.y << 16); z[3] = __uint_as_float(uz.y & 0xffff0000u);
      float ss = o[0] * o[0] + o[1] * o[1] + o[2] * o[2] + o[3] * o[3];
      ss += __shfl_xor(ss, 1); ss += __shfl_xor(ss, 2); ss += __shfl_xor(ss, 4); ss += __shfl_xor(ss, 8);
      const float rs = rsqrtf(ss * (1.f / 64.f) + EPS);
      const float4 gg = ((const float4*)gdn)[lane & 15];
      u32x2 ou;
      ou.x = pack2(o[0] * rs * gg.x * siluf_(z[0]), o[1] * rs * gg.y * siluf_(z[1]));
      ou.y = pack2(o[2] * rs * gg.z * siluf_(z[2]), o[3] * rs * gg.w * siluf_(z[3]));
      ((u32x2*)(Y + (size_t)r * 1024 + 512))[lane] = ou;
    }
    {
      const float4* xr = (const float4*)(xg + (size_t)r * 1024);
      float4 v[4];
      float ss = 0.f;
#pragma unroll
      for (int i = 0; i < 4; ++i) { v[i] = xr[lane + 64 * i]; ss += v[i].x * v[i].x + v[i].y * v[i].y + v[i].z * v[i].z + v[i].w * v[i].w; }
      ss = wave_sum(ss);
      const float rs = rsqrtf(ss * (1.f / 1024.f) + EPS);
#pragma unroll
      for (int i = 0; i < 4; ++i) {
        const float4 gg = ((const float4*)gmix)[lane + 64 * i];
        u32x2 o; o.x = pack2(v[i].x * rs * gg.x, v[i].y * rs * gg.y); o.y = pack2(v[i].z * rs * gg.z, v[i].w * rs * gg.w);
        ((u32x2*)(Np + (size_t)r * 1024))[lane + 64 * i] = o;
      }
    }
  }
}

#define XB_TMO      128
#define XB_XCNT(j)  (256  + 64 * (j))
#define XB_XSUB(j)  (1280 + 64 * (j))
#define XB_XGEN(j)  (2304 + 64 * (j))
#define XB_TOP      3328
#define XB_TOPGEN   3392
#define XCD_BAR_WORDS 3456
#define XB_SPIN_CAP (1u << 27)
#define LAS __attribute__((address_space(3)))
constexpr size_t OFF_BAR = OFF_CNT + 65536;
DI unsigned xb_ld(unsigned* p) { return __hip_atomic_load(p, __ATOMIC_RELAXED, __HIP_MEMORY_SCOPE_AGENT); }
DI unsigned xb_add(unsigned* p, unsigned v) { return __hip_atomic_fetch_add(p, v, __ATOMIC_RELAXED, __HIP_MEMORY_SCOPE_AGENT); }
DI unsigned xb_xcc_id() { return (unsigned)__builtin_amdgcn_s_getreg((3 << 11) | 20) & 0xFu; }
#define XB_SPIN(cond, bar) do { unsigned _sp = 0; while (cond) { __builtin_amdgcn_s_sleep(1); \
    if ((++_sp & 255u) == 0u) { if (xb_ld(&(bar)[XB_TMO])) break; if (_sp > XB_SPIN_CAP) { atomicAdd(&(bar)[XB_TMO], 1u); break; } } } } while (0)
struct XcdBarrier { unsigned* bar; unsigned x; volatile LAS unsigned* st; };
DI XcdBarrier xcd_barrier_post(unsigned* bar, volatile LAS unsigned* st) {
  XcdBarrier b; b.bar = bar; b.x = xb_xcc_id(); b.st = st;
  if (threadIdx.x == 0) (void)xb_add(&bar[XB_XCNT(b.x)], 1u);
  return b;
}
DI void xcd_barrier_complete(unsigned* bar, unsigned x, unsigned& nloc, unsigned& nx) {
  const unsigned G = gridDim.x * gridDim.y * gridDim.z;
  unsigned sum, cnt, mine, sp = 0u;
  for (;;) {
    sum = 0u; cnt = 0u; mine = 0u;
#pragma unroll
    for (unsigned j = 0; j < 16; ++j) { const unsigned c = xb_ld(&bar[XB_XCNT(j)]); sum += c; cnt += (c > 0u) ? 1u : 0u; mine = (j == x) ? c : mine; }
    if (sum == G) break;
    __builtin_amdgcn_s_sleep(1);
    if ((++sp & 255u) == 0u) { if (xb_ld(&bar[XB_TMO])) break; if (sp > XB_SPIN_CAP) { atomicAdd(&bar[XB_TMO], 1u); break; } }
  }
  nloc = mine > 0u ? mine : 1u; nx = cnt > 0u ? cnt : 1u;
}
DI void xcd_barrier(const XcdBarrier& b) {
  asm volatile("s_waitcnt vmcnt(0)" ::: "memory");
  __syncthreads();
  if (threadIdx.x == 0) {
    unsigned* bar = b.bar;
    __builtin_amdgcn_s_waitcnt(0);
    unsigned nloc = b.st[0], nx = b.st[1];
    if (nloc == 0u) { xcd_barrier_complete(bar, b.x, nloc, nx); b.st[0] = nloc; b.st[1] = nx; }
    const unsigned old = xb_add(&bar[XB_XSUB(b.x)], 1u);
    const unsigned gen = old / nloc;
    if (old + 1u == (gen + 1u) * nloc) {
      __builtin_amdgcn_fence(__ATOMIC_RELEASE, "agent");
      asm volatile("s_waitcnt vmcnt(0)" ::: "memory");
      const unsigned og = xb_add(&bar[XB_TOP], 1u);
      const unsigned tg = og / nx;
      if (og + 1u == (tg + 1u) * nx) xb_add(&bar[XB_TOPGEN], 1u);
      else XB_SPIN(xb_ld(&bar[XB_TOPGEN]) == tg, bar);
      __builtin_amdgcn_fence(__ATOMIC_ACQUIRE, "agent");
      xb_add(&bar[XB_XGEN(b.x)], 1u);
      asm volatile("s_waitcnt vmcnt(0)" ::: "memory");
    } else {
      XB_SPIN(xb_ld(&bar[XB_XGEN(b.x)]) == gen, bar);
      __builtin_amdgcn_fence(__ATOMIC_ACQUIRE, "agent");
      asm volatile("s_waitcnt vmcnt(0)" ::: "memory");
    }
  }
  __syncthreads();
}

#ifndef REP_MIX
#define REP_MIX 1
#endif
#ifndef REP_GEMM
#define REP_GEMM 1
#endif
__global__ void __launch_bounds__(256, 2) mega(Params pk) {
  extern __shared__ __attribute__((aligned(16))) char lds[];
  __shared__ uint4 sh_words;
  cg::grid_group grid = cg::this_grid();
  CParams* kp = (CParams*)__builtin_amdgcn_kernarg_segment_ptr();
  if (threadIdx.x == 0) sh_words = make_uint4(0u, 0u, 0u, 0u);
  __syncthreads();
  XcdBarrier xb;
  { CParams& p = *launder(kp); xb = xcd_barrier_post((unsigned*)(p.ws + OFF_BAR), (volatile LAS unsigned*)&sh_words); }
#define s_item (((volatile int*)&sh_words)[2])
#define GSYNC() xcd_barrier(xb)
#define PP_ CParams& p = *launder(kp); const bf16_t* wb = (const bf16_t*)(p.ws + OFF_WB); bf16_t* Nb = (bf16_t*)(p.ws + OFF_N); \
            bf16_t* PRb = (bf16_t*)(p.ws + OFF_PR); bf16_t* Npb = (bf16_t*)(p.ws + OFF_Q); bf16_t* PB = (bf16_t*)(p.ws + OFF_OD); \
            float* xg = p.x + (size_t)grp * TG * 1024; (void)wb; (void)Nb; (void)PRb; (void)Npb; (void)PB; (void)xg;
  { CParams& p = *launder(kp); phase_init(p, lds); phase_norm(p.x_in[0], p.norm_ff1, (bf16_t*)(p.ws + OFF_Q), nullptr, nullptr); }
  grid.sync();
  for (int layer = 0; layer < 2; ++layer) {
    if (layer > 0) { CParams& p = *launder(kp); phase_convert(p, layer, lds); GSYNC(); }
    for (int grp = 0; grp < 2; ++grp) {
      const int S = grp ? 2048 : 16384, B = grp ? 16 : 2;
      const float* xsrc0 = nullptr;
      { CParams& p = *launder(kp); xsrc0 = layer == 0 ? p.x_in[grp] : p.x + (size_t)grp * TG * 1024; }
      for (int rep = 0; rep < REP_GEMM; ++rep) {
        { PP_ phase_ffn_a(Npb, wb + W_FF1_1, wb + W_FF1_3, PRb, lds); }
        GSYNC();
      }
      { PP_ phase_gemm_resid(PRb, 2816, wb + W_FF1_2, xsrc0, xg, 0.5f, lds); }
      GSYNC();
      { PP_ phase_norm(xg, p.norm_mix + layer * 1024, Nb, nullptr, nullptr); }
      GSYNC();
      for (int rep = 0; rep < REP_GEMM; ++rep) {
        { PP_ phase_proj(p, Nb, wb + W_IN, S, lds); }
        GSYNC();
      }
      {
        PP_
        int* c0 = (int*)(p.ws + OFF_CNT) + (layer * 2 + grp) * 4;
        for (;;) {
          __syncthreads();
          if (threadIdx.x == 0) s_item = atomicAdd(c0, 1);
          __syncthreads();
          const int it = s_item;
          if (it >= 2048) break;
          dn_prep_item(p, layer, it, S, lds);
        }
      }
      GSYNC();
      {
        PP_
        int* cb = (int*)(p.ws + OFF_CNT) + 64 + (layer * 2 + grp) * 32;
        const int nDN = B * 8, nDil = p.big_ws ? 3072 : 0;
        const int lgq = grp ? 4 : 7;
        for (;;) {
          __syncthreads();
          if (threadIdx.x == 0) s_item = atomicAdd(cb, 1);
          __syncthreads();
          const int it = s_item;
          if (it >= nDN) break;
          dn_scan_chain(p, it, S, lds);
        }
        for (int xo = 0; xo < 8; ++xo) {
          const int xq = (blockIdx.x + xo) & 7;
          for (;;) {
            __syncthreads();
            if (threadIdx.x == 0) s_item = atomicAdd(cb + 8 + xq, 1);
            __syncthreads();
            const int j = s_item;
            if (j >= 128) break;
            const int pair = xq + 8 * (j >> lgq), qb = j & ((1 << lgq) - 1);
            diff_item(p, layer, (pair << lgq) + qb, S, lds);
          }
        }
        for (;;) {
          __syncthreads();
          if (threadIdx.x == 0) s_item = atomicAdd(cb + 1, 1);
          __syncthreads();
          const int it = s_item;
          if (it >= nDil) break;
          dil_item(p, it, S, B, lds);
        }
      }
      GSYNC();
      {
        PP_
        int* c2 = (int*)(p.ws + OFF_CNT) + (layer * 2 + grp) * 4 + 2;
        const int nDil = p.big_ws ? 0 : 3072, total = nDil + 256 * 7;
        for (;;) {
          __syncthreads();
          if (threadIdx.x == 0) s_item = atomicAdd(c2, 1);
          __syncthreads();
          int it = s_item;
          if (it >= total) break;
          if (it < nDil) { dil_item(p, it, S, B, lds); continue; }
          it -= nDil;
          mla_up_tile(p, it / 7, it % 7, S, lds);
        }
      }
      GSYNC();
      {
        PP_
        int* cb = (int*)(p.ws + OFF_CNT) + 64 + (layer * 2 + grp) * 32 + 16;
        const int lgq = grp ? 4 : 7;
        for (int xo = 0; xo < 8; ++xo) {
          const int xq = (blockIdx.x + xo) & 7;
          for (;;) {
            __syncthreads();
            if (threadIdx.x == 0) s_item = atomicAdd(cb + xq, 1);
            __syncthreads();
            const int j = s_item;
            if (j >= 128) break;
            const int pair = xq + 8 * (j >> lgq), qb = j & ((1 << lgq) - 1);
            mla_item(p, (pair << lgq) + qb, S, lds);
          }
        }
      }
      GSYNC();
      { PP_ phase_combine(p, layer, xg); }
      GSYNC();
      for (int rep = 0; rep < REP_GEMM; ++rep) {
        { PP_ phase_merge(Npb, Nb, wb + W_G, wb + W_B, PRb, lds); }
        GSYNC();
      }
      { PP_ phase_gemm_resid(PRb, 1024, wb + W_O, xg, xg, 1.0f, lds); }
      GSYNC();
      { PP_ phase_norm(xg, p.norm_ff2 + layer * 1024, Nb, nullptr, nullptr); }
      GSYNC();
      for (int rep = 0; rep < REP_GEMM; ++rep) {
        { PP_ phase_ffn_a(Nb, wb + W_FF2_1, wb + W_FF2_3, PRb, lds); }
        GSYNC();
      }
      { PP_ phase_gemm_resid(PRb, 2816, wb + W_FF2_2, xg, xg, 0.5f, lds); }
      GSYNC();
      { PP_ phase_norm(xg, p.norm_ple + layer * 1024, Nb, p.p_in[grp] + (size_t)layer * TG * 256, PB); }
      GSYNC();
      {
        PP_
        phase_ple(Nb, PB, wb + W_PG, wb + W_PP, xg, lds);
        const int nl = grp ? layer + 1 : layer, ng = grp ^ 1;
        if (nl < 2) phase_norm(nl == 0 ? p.x_in[ng] : p.x + (size_t)ng * TG * 1024, p.norm_ff1 + nl * 1024, Npb, nullptr, nullptr);
      }
      GSYNC();
    }
  }
  { CParams& p = *launder(kp); phase_final_norm(p.x, p.norm_final); }
}

extern "C" void kernel_launch(void* const* d_in, const int* in_sizes, int n_in, void* d_out, int out_size, void* d_ws,
                              size_t ws_size, hipStream_t stream) {
  (void)in_sizes; (void)n_in; (void)out_size;
  Params p{};
  p.x_in[0] = (const float*)d_in[0]; p.x_in[1] = (const float*)d_in[1];
  p.p_in[0] = (const float*)d_in[2]; p.p_in[1] = (const float*)d_in[3];
  p.norm_ff1 = (const float*)d_in[4]; p.ff1_w1 = (const float*)d_in[5]; p.ff1_w3 = (const float*)d_in[6];
  p.ff1_w2 = (const float*)d_in[7]; p.norm_mix = (const float*)d_in[8]; p.w_in = (const float*)d_in[9];
  p.mla_q_norm = (const float*)d_in[10]; p.mla_kv_norm = (const float*)d_in[11]; p.mla_w_uq = (const float*)d_in[12];
  p.mla_w_ukv = (const float*)d_in[13]; p.diff_lambda = (const float*)d_in[14]; p.diff_subln = (const float*)d_in[15];
  p.dn_conv = (const float*)d_in[16]; p.dn_a_log = (const float*)d_in[17]; p.dn_dt_bias = (const float*)d_in[18];
  p.dn_out_norm = (const float*)d_in[19]; p.w_branch = (const float*)d_in[20]; p.w_gate = (const float*)d_in[21];
  p.w_out = (const float*)d_in[22]; p.norm_ff2 = (const float*)d_in[23]; p.ff2_w1 = (const float*)d_in[24];
  p.ff2_w3 = (const float*)d_in[25]; p.ff2_w2 = (const float*)d_in[26]; p.norm_ple = (const float*)d_in[27];
  p.ple_gate = (const float*)d_in[28]; p.ple_proj = (const float*)d_in[29]; p.norm_final = (const float*)d_in[30];
  p.x = (float*)d_out;
  p.ws = (char*)d_ws;
  p.big_ws = (ws_size >= WS_BIG) ? 1 : 0;
  static int grid_blocks = 0;
  if (!grid_blocks) {
    int dev = 0, cus = 0, per_cu = 0;
    hipGetDevice(&dev);
    hipDeviceGetAttribute(&cus, hipDeviceAttributeMultiprocessorCount, dev);
    hipFuncSetAttribute((const void*)mega, hipFuncAttributeMaxDynamicSharedMemorySize, (int)LDS_BYTES);
    hipOccupancyMaxActiveBlocksPerMultiprocessor(&per_cu, mega, 256, LDS_BYTES);
    if (per_cu < 1) per_cu = 1;
    grid_blocks = cus * per_cu;
  }
  if (ws_size < WS_NEED) {
    fprintf(stderr, "workspace too small: %zu < %zu\n", ws_size, (size_t)WS_NEED);
    return;
  }
  (void)hipMemsetAsync((char*)d_ws + OFF_BAR, 0, XCD_BAR_WORDS * 4, stream);
  void* args[] = {&p};
  hipError_t e = hipLaunchCooperativeKernel((void*)mega, dim3(grid_blocks), dim3(256), args, LDS_BYTES, stream);
  if (e != hipSuccess) fprintf(stderr, "cooperative launch failed: %s (grid %d)\n", hipGetErrorString(e), grid_blocks);
}
```

```cpp
#include <hip/hip_runtime.h>
#include <hip/hip_cooperative_groups.h>
#include <stdint.h>
#include <stdio.h>
namespace cg = cooperative_groups;

typedef unsigned short bf16_t;
using bf16x8 = __attribute__((ext_vector_type(8))) short;
using bf16x4 = __attribute__((ext_vector_type(4))) short;
using f32x16 = __attribute__((ext_vector_type(16))) float;
using f32x4 = __attribute__((ext_vector_type(4))) float;
using u32x4 = __attribute__((ext_vector_type(4))) unsigned;
using u32x2 = __attribute__((ext_vector_type(2))) unsigned;

#define DI __device__ __forceinline__
#define MFMA32(a, b, c) __builtin_amdgcn_mfma_f32_32x32x16_bf16((a), (b), (c), 0, 0, 0)
#define MFMA16(a, b, c) __builtin_amdgcn_mfma_f32_16x16x32_bf16((a), (b), (c), 0, 0, 0)

constexpr int TG = 32768;
constexpr int NPR = 4608;
constexpr float EPS = 1e-6f;
constexpr float LOG2E = 1.4426950408889634f;
constexpr float DEFER_THR = 8.f;
constexpr int C_CQ = 0, C_CKV = 256, C_BQ = 384, C_BK = 640, C_BV = 896, C_DNQKV = 1152, C_Z = 1920,
              C_DQ = 2176, C_DK = 2944, C_DV = 3712;
constexpr size_t MiB = 1048576;
constexpr size_t OFF_WB = 0, OFF_TAB = 57 * MiB, OFF_CNT = 63 * MiB, OFF_N = 64 * MiB, OFF_PR = 128 * MiB,
                 OFF_Q = 416 * MiB, OFF_K = 440 * MiB, OFF_V = 464 * MiB, OFF_AB = 480 * MiB, OFF_OD = 482 * MiB,
                 OFF_LSE = 530 * MiB, OFF_OF = 532 * MiB, OFF_OB = 548 * MiB, WS_NEED = 564 * MiB;
constexpr size_t W_FF1_1 = 0, W_FF1_3 = 2883584, W_FF1_2 = 5767168, W_IN = 8650752, W_UQ = 13369344,
                 W_UKV = 13467648, W_G = 13533184, W_B = 17727488, W_O = 18776064, W_FF2_1 = 19824640,
                 W_FF2_3 = 22708224, W_FF2_2 = 25591808, W_PG = 28475392, W_PP = 29523968;
constexpr size_t LDS_BYTES = 78336;

struct Params {
  const float* x_in[2];
  const float* p_in[2];
  const float *norm_ff1, *ff1_w1, *ff1_w3, *ff1_w2, *norm_mix, *w_in, *mla_q_norm, *mla_kv_norm, *mla_w_uq,
      *mla_w_ukv, *diff_lambda, *diff_subln, *dn_conv, *dn_a_log, *dn_dt_bias, *dn_out_norm, *w_branch, *w_gate,
      *w_out, *norm_ff2, *ff2_w1, *ff2_w3, *ff2_w2, *norm_ple, *ple_gate, *ple_proj, *norm_final;
  float* x;
  char* ws;
  long long big_ws;
};

typedef const __attribute__((address_space(4))) Params CParams;
DI CParams* launder(CParams* q) { asm volatile("" : "+s"(q)); return q; }

typedef __bf16 bf2_t __attribute__((ext_vector_type(2)));
typedef float f2_t __attribute__((ext_vector_type(2)));
DI bf16_t f2bf(float x) { return __builtin_bit_cast(bf16_t, (__bf16)x); }
DI float bf2f(bf16_t b) { return __uint_as_float(((unsigned)b) << 16); }
DI unsigned pack2(float a, float b) { f2_t v = {a, b}; return __builtin_bit_cast(unsigned, __builtin_convertvector(v, bf2_t)); }
DI float wave_sum(float v) {
#pragma unroll
  for (int o = 32; o > 0; o >>= 1) v += __shfl_xor(v, o);
  return v;
}
DI float sigmoidf_(float x) { return __builtin_amdgcn_rcpf(1.f + __expf(-x)); }
DI float siluf_(float x) { return x * __builtin_amdgcn_rcpf(1.f + __expf(-x)); }
DI float exp2_(float x) { return __builtin_amdgcn_exp2f(x); }
DI int opq() { int z; asm volatile("v_mov_b32 %0, 0" : "=v"(z)); return z; }
DI float xhalf_max(float v) {
  const auto r = __builtin_amdgcn_permlane32_swap(__float_as_uint(v), __float_as_uint(v), false, false);
  return fmaxf(__uint_as_float(r[0]), __uint_as_float(r[1]));
}
DI int crow(int r, int h2) { return (r & 3) + 8 * (r >> 2) + 4 * h2; }
DI bf16x8 pack8(float a0, float a1, float a2, float a3, float a4, float a5, float a6, float a7) {
  u32x4 u;
  u.x = pack2(a0, a1); u.y = pack2(a2, a3); u.z = pack2(a4, a5); u.w = pack2(a6, a7);
  return __builtin_bit_cast(bf16x8, u);
}
DI bf16x8 ld2x4(const bf16_t* p0, const bf16_t* p1) {
  u32x2 a = *(const u32x2*)p0, b = *(const u32x2*)p1;
  u32x4 u; u.x = a.x; u.y = a.y; u.z = b.x; u.w = b.y;
  return __builtin_bit_cast(bf16x8, u);
}
DI void store8bf(bf16_t* dst, const float* v) {
  u32x4 u; u.x = pack2(v[0], v[1]); u.y = pack2(v[2], v[3]); u.z = pack2(v[4], v[5]); u.w = pack2(v[6], v[7]);
  *(u32x4*)dst = u;
}

struct MatDesc { const float* src; bf16_t* dst; int K, ldsrc, Ndst, map; const float* rowscale; int frag; };

DI int map_col(int map, int n) {
  if (map == 0) return n;
  if (map == 1) {
    if (n < 384) return n;
    if (n < 1920) return n + 32;
    if (n < 4480) return n + 48;
    if (n < 4512) return n - 4480 + 384;
    if (n < 4528) return n - 4512 + 1952;
    return -1;
  }
  if (n < 256) return (n >> 6) * 96 + (n & 63);
  return ((n - 256) >> 5) * 96 + 64 + ((n - 256) & 31);
}

DI MatDesc get_mat(CParams& p, int l, int id) {
  bf16_t* wb = (bf16_t*)(p.ws + OFF_WB);
  MatDesc d; d.map = 0; d.rowscale = nullptr; d.frag = (id == 2 || id == 14 || id == 17) ? 1 : 0;
  const size_t FF = (size_t)1024 * 2816;
  switch (id) {
    case 0: d.src = p.ff1_w1 + l * FF; d.dst = wb + W_FF1_1; d.K = 1024; d.ldsrc = 2816; d.Ndst = 2816; break;
    case 1: d.src = p.ff1_w3 + l * FF; d.dst = wb + W_FF1_3; d.K = 1024; d.ldsrc = 2816; d.Ndst = 2816; break;
    case 2: d.src = p.ff1_w2 + l * FF; d.dst = wb + W_FF1_2; d.K = 2816; d.ldsrc = 1024; d.Ndst = 1024; break;
    case 3: d.src = p.w_in + (size_t)l * 1024 * 4528; d.dst = wb + W_IN; d.K = 1024; d.ldsrc = 4528; d.Ndst = 4608; d.map = 1; break;
    case 4: d.src = p.mla_w_uq + (size_t)l * 256 * 384; d.dst = wb + W_UQ; d.K = 256; d.ldsrc = 384; d.Ndst = 384; d.map = 2; d.rowscale = p.mla_q_norm + l * 256; break;
    case 5: d.src = p.mla_w_ukv + (size_t)l * 128 * 512; d.dst = wb + W_UKV; d.K = 128; d.ldsrc = 512; d.Ndst = 512; d.rowscale = p.mla_kv_norm + l * 128; break;
    case 6: case 7: case 8: case 9:
      d.src = p.w_gate + (size_t)(l * 4 + id - 6) * 1048576; d.dst = wb + W_G + (size_t)(id - 6) * 1048576; d.K = 1024; d.ldsrc = 1024; d.Ndst = 1024; break;
    case 10: case 11: case 12: case 13:
      d.src = p.w_branch + (size_t)(l * 4 + id - 10) * 262144; d.dst = wb + W_B + (size_t)(id - 10) * 262144; d.K = 256; d.ldsrc = 1024; d.Ndst = 1024; break;
    case 14: d.src = p.w_out + (size_t)l * 1048576; d.dst = wb + W_O; d.K = 1024; d.ldsrc = 1024; d.Ndst = 1024; break;
    case 15: d.src = p.ff2_w1 + l * FF; d.dst = wb + W_FF2_1; d.K = 1024; d.ldsrc = 2816; d.Ndst = 2816; break;
    case 16: d.src = p.ff2_w3 + l * FF; d.dst = wb + W_FF2_3; d.K = 1024; d.ldsrc = 2816; d.Ndst = 2816; break;
    case 17: d.src = p.ff2_w2 + l * FF; d.dst = wb + W_FF2_2; d.K = 2816; d.ldsrc = 1024; d.Ndst = 1024; break;
    case 18: d.src = p.ple_gate + (size_t)l * 1048576; d.dst = wb + W_PG; d.K = 1024; d.ldsrc = 1024; d.Ndst = 1024; break;
    default: d.src = p.ple_proj + (size_t)l * 262144; d.dst = wb + W_PP; d.K = 256; d.ldsrc = 1024; d.Ndst = 1024; break;
  }
  return d;
}

DI void phase_convert(CParams& p, int l, char* lds) {
  float* T = (float*)lds;
  const int tid = threadIdx.x + opq();
  for (int id = 0; id < 20; ++id) {
    MatDesc d = get_mat(p, l, id);
    const int nkt = d.K >> 6, nnt = d.Ndst >> 6, nt_all = nkt * nnt;
    for (int t = blockIdx.x; t < nt_all; t += gridDim.x) {
      const int kt = t / nnt, nt = t % nnt;
      __syncthreads();
      {
        const int nl = tid & 63;
        const int sc = map_col(d.map, nt * 64 + nl);
#pragma unroll 4
        for (int i = 0; i < 16; ++i) {
          const int kl = (tid >> 6) + 4 * i;
          const int k = kt * 64 + kl;
          float v = 0.f;
          if (sc >= 0) v = d.src[(size_t)k * d.ldsrc + sc];
          if (d.rowscale) v *= d.rowscale[k];
          T[kl * 65 + nl] = v;
        }
      }
      __syncthreads();
      if (d.frag) {
#pragma unroll
        for (int i = 0; i < 2; ++i) {
          const int ci = tid + 256 * i, nl = ci & 63, c8 = ci >> 6;
          float v[8];
#pragma unroll
          for (int e = 0; e < 8; ++e) v[e] = T[(8 * c8 + e) * 65 + nl];
          const int n = nt * 64 + nl, k = kt * 64 + 8 * c8;
          const size_t off = (((size_t)(n >> 5) * (d.K >> 4) + (k >> 4)) * 64 + ((k >> 3) & 1) * 32 + (n & 31)) * 8;
          store8bf(d.dst + off, v);
        }
      } else {
        const int kl = tid & 63;
#pragma unroll 4
        for (int i = 0; i < 16; ++i) {
          const int nl = (tid >> 6) + 4 * i;
          d.dst[(size_t)(nt * 64 + nl) * d.K + kt * 64 + kl] = f2bf(T[kl * 65 + nl]);
        }
      }
    }
  }
}

DI void phase_init(CParams& p, char* lds) {
  const size_t gtid = (size_t)blockIdx.x * 256 + threadIdx.x + opq(), gn = (size_t)gridDim.x * 256;
  {
    float2* t32 = (float2*)(p.ws + OFF_TAB);
    float2* t64 = (float2*)(p.ws + OFF_TAB + 2 * MiB);
    for (size_t i = gtid; i < (size_t)16384 * 48; i += gn) {
      const int pos = (int)(i / 48), f = (int)(i % 48);
      float inv;
      if (f < 16) inv = exp2f(-(float)f * (13.287712379549449f / 16.f));
      else inv = exp2f(-(float)(f - 16) * (13.287712379549449f / 32.f));
      const float ang = (float)pos * inv;
      const double xd = (double)ang;
      const double n = rint(xd * 0.15915494309189535);
      const float rf = (float)(xd - n * 6.283185307179586);
      float2 cs; cs.x = __cosf(rf); cs.y = __sinf(rf);
      if (f < 16) t32[(size_t)pos * 16 + f] = cs; else t64[(size_t)pos * 32 + (f - 16)] = cs;
    }
  }
  if (blockIdx.x == 0) ((int*)(p.ws + OFF_CNT))[threadIdx.x] = 0;
  phase_convert(p, 0, lds);
}

DI void phase_norm(const float* __restrict__ x, const float* __restrict__ g, bf16_t* __restrict__ dst,
                           const float* __restrict__ psrc, bf16_t* __restrict__ pdst) {
  const int tidq = threadIdx.x + opq(); const int wave = tidq >> 6, lane = tidq & 63;
  for (int r = blockIdx.x * 4 + wave; r < TG; r += gridDim.x * 4) {
    const float4* xr = (const float4*)(x + (size_t)r * 1024);
    float4 v[4];
    float ss = 0.f;
#pragma unroll
    for (int i = 0; i < 4; ++i) { v[i] = xr[lane + 64 * i]; ss += v[i].x * v[i].x + v[i].y * v[i].y + v[i].z * v[i].z + v[i].w * v[i].w; }
    ss = wave_sum(ss);
    const float rs = rsqrtf(ss * (1.f / 1024.f) + EPS);
#pragma unroll
    for (int i = 0; i < 4; ++i) {
      const float4 gg = ((const float4*)g)[lane + 64 * i];
      u32x2 o; o.x = pack2(v[i].x * rs * gg.x, v[i].y * rs * gg.y); o.y = pack2(v[i].z * rs * gg.z, v[i].w * rs * gg.w);
      ((u32x2*)(dst + (size_t)r * 1024))[lane + 64 * i] = o;
    }
    if (psrc) {
      const float4 pv = ((const float4*)(psrc + (size_t)r * 256))[lane];
      u32x2 o; o.x = pack2(pv.x, pv.y); o.y = pack2(pv.z, pv.w);
      ((u32x2*)(pdst + (size_t)r * 256))[lane] = o;
    }
  }
}

DI void phase_final_norm(float* __restrict__ x, const float* __restrict__ g) {
  const int tidq = threadIdx.x + opq(); const int wave = tidq >> 6, lane = tidq & 63;
  for (int r = blockIdx.x * 4 + wave; r < 2 * TG; r += gridDim.x * 4) {
    float4* xr = (float4*)(x + (size_t)r * 1024);
    float4 v[4];
    float ss = 0.f;
#pragma unroll
    for (int i = 0; i < 4; ++i) { v[i] = xr[lane + 64 * i]; ss += v[i].x * v[i].x + v[i].y * v[i].y + v[i].z * v[i].z + v[i].w * v[i].w; }
    ss = wave_sum(ss);
    const float rs = rsqrtf(ss * (1.f / 1024.f) + EPS);
#pragma unroll
    for (int i = 0; i < 4; ++i) {
      const float4 gg = ((const float4*)g)[lane + 64 * i];
      float4 o; o.x = v[i].x * rs * gg.x; o.y = v[i].y * rs * gg.y; o.z = v[i].z * rs * gg.z; o.w = v[i].w * rs * gg.w;
      xr[lane + 64 * i] = o;
    }
  }
}

template <int NI, int NB, bool SWAP = false>
DI void gemm_main(f32x16 (&acc0)[2][NI], f32x16 (&acc1)[2][NI], const bf16_t* __restrict__ A, int lda,
                  const bf16_t* __restrict__ B0, const bf16_t* __restrict__ B1, int ldb, int K, char* lds) {
  const int tid = threadIdx.x + opq(), lane = tid & 63, w = tid >> 6, wm = w >> 1, wn = w & 1, l31 = lane & 31, h2 = lane >> 5;
  bf16_t* As = (bf16_t*)lds;
  bf16_t* B0s = As + 128 * 72;
  bf16_t* B1s = B0s + 64 * NI * 72;
  const int lr = tid >> 3, lc = (tid & 7) * 8;
  u32x4 ra[4], rb0[2 * NI], rb1[2 * NI];
  const char* Ab = (const char*)A;
  const char* B0b = (const char*)B0;
  const char* B1b = (NB == 2) ? (const char*)B1 : (const char*)B0;
  const unsigned aoff = (unsigned)(lr * lda + lc) * 2u, boff = (unsigned)(lr * ldb + lc) * 2u;
  const unsigned astep = (unsigned)(32 * lda) * 2u, bstep = (unsigned)(32 * ldb) * 2u;
#pragma unroll
  for (int i = 0; i < 4; ++i) ra[i] = *(const u32x4*)(Ab + (aoff + astep * i));
#pragma unroll
  for (int i = 0; i < 2 * NI; ++i) {
    rb0[i] = *(const u32x4*)(B0b + (boff + bstep * i));
    if (NB == 2) rb1[i] = *(const u32x4*)(B1b + (boff + bstep * i));
  }
  for (int k0 = 0; k0 < K; k0 += 64) {
    __syncthreads();
#pragma unroll
    for (int i = 0; i < 4; ++i) *(u32x4*)(As + (lr + 32 * i) * 72 + lc) = ra[i];
#pragma unroll
    for (int i = 0; i < 2 * NI; ++i) {
      *(u32x4*)(B0s + (lr + 32 * i) * 72 + lc) = rb0[i];
      if (NB == 2) *(u32x4*)(B1s + (lr + 32 * i) * 72 + lc) = rb1[i];
    }
    if (k0 + 64 < K) {
      const unsigned kb = (unsigned)(k0 + 64) * 2u;
#pragma unroll
      for (int i = 0; i < 4; ++i) ra[i] = *(const u32x4*)(Ab + (aoff + astep * i + kb));
#pragma unroll
      for (int i = 0; i < 2 * NI; ++i) {
        rb0[i] = *(const u32x4*)(B0b + (boff + bstep * i + kb));
        if (NB == 2) rb1[i] = *(const u32x4*)(B1b + (boff + bstep * i + kb));
      }
    }
    __syncthreads();
    __builtin_amdgcn_s_setprio(1);
#pragma unroll
    for (int ks = 0; ks < 4; ++ks) {
      bf16x8 af[2], bf0[NI], bf1[NI];
#pragma unroll
      for (int mi = 0; mi < 2; ++mi) af[mi] = *(const bf16x8*)(As + (64 * wm + 32 * mi + l31) * 72 + 16 * ks + 8 * h2);
#pragma unroll
      for (int ni = 0; ni < NI; ++ni) {
        bf0[ni] = *(const bf16x8*)(B0s + (32 * NI * wn + 32 * ni + l31) * 72 + 16 * ks + 8 * h2);
        if (NB == 2) bf1[ni] = *(const bf16x8*)(B1s + (32 * NI * wn + 32 * ni + l31) * 72 + 16 * ks + 8 * h2);
      }
#pragma unroll
      for (int mi = 0; mi < 2; ++mi)
#pragma unroll
        for (int ni = 0; ni < NI; ++ni) {
          acc0[mi][ni] = SWAP ? MFMA32(bf0[ni], af[mi], acc0[mi][ni]) : MFMA32(af[mi], bf0[ni], acc0[mi][ni]);
          if (NB == 2) acc1[mi][ni] = SWAP ? MFMA32(bf1[ni], af[mi], acc1[mi][ni]) : MFMA32(af[mi], bf1[ni], acc1[mi][ni]);
        }
    }
    __builtin_amdgcn_s_setprio(0);
  }
}

DI void gemm_main_bd(f32x16 (&acc)[4][2], const bf16_t* __restrict__ A, int lda, const bf16_t* __restrict__ Bf, int n0,
                     int K, char* lds) {
  const int tid = threadIdx.x + opq(), lane = tid & 63, w = tid >> 6, l31 = lane & 31, h2 = lane >> 5;
  bf16_t* As0 = (bf16_t*)lds;
  const int lr = tid >> 3, lc = (tid & 7) * 8;
  const int KS = K >> 4, nsteps = K >> 6;
  u32x4 ra[4];
  const bf16_t* ap = A + (size_t)lr * lda + lc;
  const bf16_t* bq0 = Bf + ((size_t)((n0 >> 5) + 2 * w) * KS) * 512 + lane * 8;
  const bf16_t* bq1 = bq0 + (size_t)KS * 512;
  bf16x8 bc[2][4], bn[2][4];
#pragma unroll
  for (int i = 0; i < 4; ++i) ra[i] = *(const u32x4*)(ap + (size_t)(32 * i) * lda);
#pragma unroll
  for (int ks = 0; ks < 4; ++ks) { bn[0][ks] = *(const bf16x8*)(bq0 + ks * 512); bn[1][ks] = *(const bf16x8*)(bq1 + ks * 512); }
  __syncthreads();
#pragma unroll
  for (int i = 0; i < 4; ++i) *(u32x4*)(As0 + (lr + 32 * i) * 72 + lc) = ra[i];
  if (nsteps > 1) {
#pragma unroll
    for (int i = 0; i < 4; ++i) ra[i] = *(const u32x4*)(ap + (size_t)(32 * i) * lda + 64);
  }
  __syncthreads();
  for (int k = 0; k < nsteps; ++k) {
    const bf16_t* As = As0 + (k & 1) * (128 * 72);
    bf16_t* Aw = As0 + ((k + 1) & 1) * (128 * 72);
#pragma unroll
    for (int ks = 0; ks < 4; ++ks) { bc[0][ks] = bn[0][ks]; bc[1][ks] = bn[1][ks]; }
    if (k + 1 < nsteps) {
#pragma unroll
      for (int ks = 0; ks < 4; ++ks) {
        bn[0][ks] = *(const bf16x8*)(bq0 + (size_t)(4 * (k + 1) + ks) * 512);
        bn[1][ks] = *(const bf16x8*)(bq1 + (size_t)(4 * (k + 1) + ks) * 512);
      }
#pragma unroll
      for (int i = 0; i < 4; ++i) *(u32x4*)(Aw + (lr + 32 * i) * 72 + lc) = ra[i];
      if (k + 2 < nsteps) {
#pragma unroll
        for (int i = 0; i < 4; ++i) ra[i] = *(const u32x4*)(ap + (size_t)(32 * i) * lda + (size_t)(k + 2) * 64);
      }
    }
    __builtin_amdgcn_s_setprio(1);
#pragma unroll
    for (int ks = 0; ks < 4; ++ks) {
      bf16x8 af[4];
#pragma unroll
      for (int mi = 0; mi < 4; ++mi) af[mi] = *(const bf16x8*)(As + (32 * mi + l31) * 72 + 16 * ks + 8 * h2);
#pragma unroll
      for (int mi = 0; mi < 4; ++mi)
#pragma unroll
        for (int ni = 0; ni < 2; ++ni) acc[mi][ni] = MFMA32(bc[ni][ks], af[mi], acc[mi][ni]);
    }
    __builtin_amdgcn_s_setprio(0);
    __syncthreads();
  }
}

template <int NI>
DI void zero_acc(f32x16 (&a)[2][NI]) {
#pragma unroll
  for (int mi = 0; mi < 2; ++mi)
#pragma unroll
    for (int ni = 0; ni < NI; ++ni)
#pragma unroll
      for (int r = 0; r < 16; ++r) a[mi][ni][r] = 0.f;
}

#define EPI_VARS const int tid = threadIdx.x + opq(), lane = tid & 63, w = tid >> 6, wm = w >> 1, wn = w & 1, l31 = lane & 31, h2 = lane >> 5; (void)tid; (void)lane; (void)w
#define EPI_BEGIN(NI_) _Pragma("unroll") for (int mi = 0; mi < 2; ++mi) _Pragma("unroll") for (int ni = 0; ni < NI_; ++ni) _Pragma("unroll") for (int r = 0; r < 16; ++r) { \
    const int row = 64 * wm + 32 * mi + crow(r, h2); const int col = 32 * NI_ * wn + 32 * ni + l31;
#define EPI_END }

DI bool xcd_tile(int iter, int MT, int NT, int& mt, int& nt) {
  const int x = blockIdx.x & 7, lb = blockIdx.x >> 3, nb = gridDim.x >> 3;
  if (NT == 8) {
    const int j = lb + iter * nb;
    if (lb >= nb || j >= MT) return false;
    mt = (x & 1) * (MT >> 1) + (j >> 1);
    nt = 2 * (x >> 1) + (j & 1);
    return true;
  }
  const int full = NT >> 3, rem = NT & 7;
  const int per_full = full * MT, rem_tot = rem * MT;
  const int r0 = (rem_tot * x) >> 3, r1 = (rem_tot * (x + 1)) >> 3;
  const int j = lb + iter * nb;
  if (lb >= nb || j >= per_full + (r1 - r0)) return false;
  if (j < per_full) { mt = j / full; nt = x * full + j % full; }
  else { const int u = r0 + (j - per_full); nt = 8 * full + u / MT; mt = u % MT; }
  return true;
}

DI void phase_ffn_a(const bf16_t* __restrict__ Nb, const bf16_t* __restrict__ W1, const bf16_t* __restrict__ W3,
                            bf16_t* __restrict__ H, char* lds) {
  EPI_VARS;
  for (int iter = 0;; ++iter) {
    int mt, nt;
    if (!xcd_tile(iter, 256, 22, mt, nt)) break;
    f32x16 a0[2][2], a1[2][2];
    zero_acc<2>(a0); zero_acc<2>(a1);
    gemm_main<2, 2, true>(a0, a1, Nb + (size_t)mt * 128 * 1024, 1024, W1 + (size_t)nt * 128 * 1024, W3 + (size_t)nt * 128 * 1024, 1024, 1024, lds);
#pragma unroll
    for (int mi = 0; mi < 2; ++mi)
#pragma unroll
      for (int ni = 0; ni < 2; ++ni) {
        bf16_t* hp = H + (size_t)(mt * 128 + 64 * wm + 32 * mi + l31) * 2816 + nt * 128 + 64 * wn + 32 * ni + 4 * h2;
#pragma unroll
        for (int g = 0; g < 4; ++g) {
          u32x2 o;
          o.x = pack2(siluf_(a0[mi][ni][4 * g]) * a1[mi][ni][4 * g], siluf_(a0[mi][ni][4 * g + 1]) * a1[mi][ni][4 * g + 1]);
          o.y = pack2(siluf_(a0[mi][ni][4 * g + 2]) * a1[mi][ni][4 * g + 2], siluf_(a0[mi][ni][4 * g + 3]) * a1[mi][ni][4 * g + 3]);
          *(u32x2*)(hp + 8 * g) = o;
        }
      }
  }
}

DI void phase_gemm_resid(const bf16_t* __restrict__ A, int K, const bf16_t* __restrict__ Bf, const float* xsrc, float* x,
                         float scale, char* lds) {
  const int tid = threadIdx.x + opq(), lane = tid & 63, w = tid >> 6, l31 = lane & 31, h2 = lane >> 5;
  for (int iter = 0;; ++iter) {
    int mt, nt;
    if (!xcd_tile(iter, 256, 4, mt, nt)) break;
    f32x16 a0[4][2];
#pragma unroll
    for (int mi = 0; mi < 4; ++mi)
#pragma unroll
      for (int ni = 0; ni < 2; ++ni)
#pragma unroll
        for (int r = 0; r < 16; ++r) a0[mi][ni][r] = 0.f;
    gemm_main_bd(a0, A + (size_t)mt * 128 * K, K, Bf, nt * 256, K, lds);
#pragma unroll
    for (int mi = 0; mi < 4; ++mi)
#pragma unroll
      for (int ni = 0; ni < 2; ++ni) {
        float4 xs[4];
        const size_t base = (size_t)(mt * 128 + 32 * mi + l31) * 1024 + nt * 256 + 64 * w + 32 * ni + 4 * h2;
#pragma unroll
        for (int g = 0; g < 4; ++g) xs[g] = *(const float4*)(xsrc + base + 8 * g);
#pragma unroll
        for (int g = 0; g < 4; ++g) {
          float4 o;
          o.x = xs[g].x + scale * a0[mi][ni][4 * g];
          o.y = xs[g].y + scale * a0[mi][ni][4 * g + 1];
          o.z = xs[g].z + scale * a0[mi][ni][4 * g + 2];
          o.w = xs[g].w + scale * a0[mi][ni][4 * g + 3];
          *(float4*)(x + base + 8 * g) = o;
        }
      }
  }
}

DI void phase_ple(const bf16_t* __restrict__ Nb, const bf16_t* __restrict__ PB, const bf16_t* __restrict__ PG,
                          const bf16_t* __restrict__ PP, float* __restrict__ x, char* lds) {
  EPI_VARS;
  for (int iter = 0;; ++iter) {
    int mt, nt;
    if (!xcd_tile(iter, 256, 8, mt, nt)) break;
    f32x16 a0[2][2], a1[2][2];
    zero_acc<2>(a0); zero_acc<2>(a1);
    gemm_main<2, 1, true>(a0, a0, Nb + (size_t)mt * 128 * 1024, 1024, PG + (size_t)nt * 128 * 1024, nullptr, 1024, 1024, lds);
    gemm_main<2, 1, true>(a1, a1, PB + (size_t)mt * 128 * 256, 256, PP + (size_t)nt * 128 * 256, nullptr, 256, 256, lds);
#pragma unroll
    for (int mi = 0; mi < 2; ++mi)
#pragma unroll
      for (int ni = 0; ni < 2; ++ni) {
        float* xp = x + (size_t)(mt * 128 + 64 * wm + 32 * mi + l31) * 1024 + nt * 128 + 64 * wn + 32 * ni + 4 * h2;
        float4 xs[4];
#pragma unroll
        for (int g = 0; g < 4; ++g) xs[g] = *(const float4*)(xp + 8 * g);
#pragma unroll
        for (int g = 0; g < 4; ++g) {
          float4 o;
          o.x = xs[g].x + sigmoidf_(a0[mi][ni][4 * g]) * a1[mi][ni][4 * g];
          o.y = xs[g].y + sigmoidf_(a0[mi][ni][4 * g + 1]) * a1[mi][ni][4 * g + 1];
          o.z = xs[g].z + sigmoidf_(a0[mi][ni][4 * g + 2]) * a1[mi][ni][4 * g + 2];
          o.w = xs[g].w + sigmoidf_(a0[mi][ni][4 * g + 3]) * a1[mi][ni][4 * g + 3];
          *(float4*)(xp + 8 * g) = o;
        }
      }
  }
}

DI void phase_merge(const bf16_t* __restrict__ Np, const bf16_t* __restrict__ Y, const bf16_t* __restrict__ WG,
                            const bf16_t* __restrict__ WB, bf16_t* __restrict__ M, char* lds) {
  EPI_VARS;
  for (int iter = 0;; ++iter) {
    int mt, nt;
    if (!xcd_tile(iter, 256, 8, mt, nt)) break;
    f32x16 am[2][2];
    zero_acc<2>(am);
#pragma unroll 1
    for (int n = 0; n < 4; ++n) {
      unsigned sg[2][2][8];
      {
        f32x16 ag[2][2];
        zero_acc<2>(ag);
        gemm_main<2, 1, true>(ag, ag, Np + (size_t)mt * 128 * 1024, 1024, WG + (size_t)n * 1048576 + (size_t)nt * 128 * 1024, nullptr, 1024, 1024, lds);
#pragma unroll
        for (int mi = 0; mi < 2; ++mi)
#pragma unroll
          for (int ni = 0; ni < 2; ++ni)
#pragma unroll
            for (int r = 0; r < 8; ++r) sg[mi][ni][r] = pack2(sigmoidf_(ag[mi][ni][2 * r]), sigmoidf_(ag[mi][ni][2 * r + 1]));
      }
      f32x16 ab[2][2];
      zero_acc<2>(ab);
      gemm_main<2, 1, true>(ab, ab, Y + (size_t)mt * 128 * 1024 + n * 256, 1024, WB + (size_t)n * 262144 + (size_t)nt * 128 * 256, nullptr, 256, 256, lds);
#pragma unroll
      for (int mi = 0; mi < 2; ++mi)
#pragma unroll
        for (int ni = 0; ni < 2; ++ni)
#pragma unroll
          for (int r = 0; r < 8; ++r) {
            am[mi][ni][2 * r] += __uint_as_float(sg[mi][ni][r] << 16) * ab[mi][ni][2 * r];
            am[mi][ni][2 * r + 1] += __uint_as_float(sg[mi][ni][r] & 0xffff0000u) * ab[mi][ni][2 * r + 1];
          }
    }
#pragma unroll
    for (int mi = 0; mi < 2; ++mi)
#pragma unroll
      for (int ni = 0; ni < 2; ++ni) {
        bf16_t* mp = M + (size_t)(mt * 128 + 64 * wm + 32 * mi + l31) * 1024 + nt * 128 + 64 * wn + 32 * ni + 4 * h2;
#pragma unroll
        for (int g = 0; g < 4; ++g) {
          u32x2 o;
          o.x = pack2(am[mi][ni][4 * g], am[mi][ni][4 * g + 1]);
          o.y = pack2(am[mi][ni][4 * g + 2], am[mi][ni][4 * g + 3]);
          *(u32x2*)(mp + 8 * g) = o;
        }
      }
  }
}

DI void rope32_out(const float* c, const float2* tab, float sc, float* o) {
#pragma unroll
  for (int i = 0; i < 16; ++i) {
    const float2 cs = tab[i];
    const float a = c[i], b = c[16 + i];
    o[i] = (a * cs.x - b * cs.y) * sc;
    o[16 + i] = (b * cs.x + a * cs.y) * sc;
  }
}

DI void phase_proj(CParams& p, const bf16_t* __restrict__ Nb, const bf16_t* __restrict__ WIN, int S, char* lds) {
  EPI_VARS;
  bf16_t* PR = (bf16_t*)(p.ws + OFF_PR);
  float* AB = (float*)(p.ws + OFF_AB);
  const float2* t32 = (const float2*)(p.ws + OFF_TAB);
  const float2* t64 = (const float2*)(p.ws + OFF_TAB + 2 * MiB);
  float* Ct = (float*)lds;
  for (int iter = 0;; ++iter) {
    int mt, nt2;
    if (!xcd_tile(iter, 256, 18, mt, nt2)) break;
    f32x16 a0[2][4];
    zero_acc<4>(a0);
    gemm_main<4, 1>(a0, a0, Nb + (size_t)mt * 128 * 1024, 1024, WIN + (size_t)nt2 * 256 * 1024, nullptr, 1024, 1024, lds);
   for (int hv = 0; hv < 2; ++hv) {
    const int nt = 2 * nt2 + hv;
    __syncthreads();
    if (wn == hv) {
#pragma unroll
      for (int mi = 0; mi < 2; ++mi)
#pragma unroll
        for (int ni = 0; ni < 4; ++ni)
#pragma unroll
          for (int r = 0; r < 16; ++r) Ct[(64 * wm + 32 * mi + crow(r, h2)) * 132 + 32 * ni + l31] = a0[mi][ni][r];
    }
    __syncthreads();
    const int erow = tid >> 1, half = tid & 1;
    const int tok = mt * 128 + erow, pos = tok & (S - 1);
    const float* cr = Ct + erow * 132 + 64 * half;
    bf16_t* dst = PR + (size_t)tok * NPR + nt * 128 + 64 * half;
    int type = 0; float sc = 1.f;
    if (nt == 3 || nt == 4) { type = 1; sc = 0.17677669529663687f * LOG2E; }
    else if (nt == 5 || nt == 6) { type = 1; }
    else if (nt >= 17 && nt <= 22) { type = 2; sc = 0.125f * LOG2E; }
    else if (nt >= 23 && nt <= 28) { type = 2; }
    else if (nt == 35) type = 3;
    if (type == 0) {
#pragma unroll
      for (int j = 0; j < 8; ++j) store8bf(dst + 8 * j, cr + 8 * j);
    } else if (type == 1) {
#pragma unroll
      for (int hh = 0; hh < 2; ++hh) {
        float o[32];
        rope32_out(cr + 32 * hh, t32 + (size_t)pos * 16, sc, o);
#pragma unroll
        for (int j = 0; j < 4; ++j) store8bf(dst + 32 * hh + 8 * j, o + 8 * j);
      }
    } else if (type == 2) {
      const float2* tab = t64 + (size_t)pos * 32;
#pragma unroll
      for (int j = 0; j < 4; ++j) {
        float lo[8], hi[8];
#pragma unroll
        for (int e = 0; e < 8; ++e) {
          const float2 cs = tab[8 * j + e];
          const float a = cr[8 * j + e], b = cr[32 + 8 * j + e];
          lo[e] = (a * cs.x - b * cs.y) * sc;
          hi[e] = (b * cs.x + a * cs.y) * sc;
        }
        store8bf(dst + 8 * j, lo);
        store8bf(dst + 32 + 8 * j, hi);
      }
    } else {
      if (half == 0) {
        float o[32];
        rope32_out(cr, t32 + (size_t)pos * 16, 1.f, o);
#pragma unroll
        for (int j = 0; j < 4; ++j) store8bf(dst + 8 * j, o + 8 * j);
      } else {
        const float* c2 = Ct + erow * 132 + 32;
#pragma unroll
        for (int j = 0; j < 4; ++j) {
          float4 v; v.x = c2[4 * j]; v.y = c2[4 * j + 1]; v.z = c2[4 * j + 2]; v.w = c2[4 * j + 3];
          ((float4*)(AB + (size_t)tok * 16))[j] = v;
        }
      }
    }
   }
  }
}

DI void mla_up_tile(CParams& p, int mt, int j, int S, char* lds) {
  EPI_VARS;
  const bf16_t* PR = (const bf16_t*)(p.ws + OFF_PR);
  const bf16_t* wb = (const bf16_t*)(p.ws + OFF_WB);
  bf16_t* Qb = (bf16_t*)(p.ws + OFF_Q);
  bf16_t* Kb = (bf16_t*)(p.ws + OFF_K);
  bf16_t* Vb = (bf16_t*)(p.ws + OFF_V);
  const float2* t32 = (const float2*)(p.ws + OFF_TAB);
  float* Ct = (float*)lds;
  float* rst = (float*)(lds + 67584);
  const bool isq = j < 3;
  const int K = isq ? 256 : 128;
  const int nt = isq ? j : j - 3;
  const bf16_t* A = PR + (size_t)mt * 128 * NPR + (isq ? C_CQ : C_CKV);
  const bf16_t* B = wb + (isq ? W_UQ : W_UKV) + (size_t)nt * 128 * K;
  const int erow = tid >> 1, half = tid & 1;
  {
    const bf16_t* ar = A + (size_t)erow * NPR + half * (K / 2);
    float ss = 0.f;
    for (int c = 0; c < K / 16; ++c) {
      const u32x4 u = *(const u32x4*)(ar + 8 * c);
      const unsigned uu[4] = {u.x, u.y, u.z, u.w};
#pragma unroll
      for (int e = 0; e < 4; ++e) {
        const float lo = __uint_as_float(uu[e] << 16), hi = __uint_as_float(uu[e] & 0xffff0000u);
        ss += lo * lo + hi * hi;
      }
    }
    ss += __shfl_xor(ss, 1);
    if (half == 0) rst[erow] = rsqrtf(ss / (float)K + EPS);
  }
  f32x16 a0[2][2];
  zero_acc<2>(a0);
  gemm_main<2, 1>(a0, a0, A, NPR, B, nullptr, K, K, lds);
  __syncthreads();
  EPI_BEGIN(2)
    Ct[row * 132 + col] = a0[mi][ni][r];
  EPI_END
  __syncthreads();
  const int tok = mt * 128 + erow, pos = tok & (S - 1);
  const float rs = rst[erow];
  const float* cr = Ct + erow * 132 + 64 * half;
  if (isq) {
    const float sc = rs * 0.10206207261596577f * LOG2E;
    if (nt < 2) {
      bf16_t* dst = Qb + ((size_t)tok * 4 + 2 * nt + half) * 96;
#pragma unroll
      for (int jj = 0; jj < 8; ++jj) {
        float o[8];
#pragma unroll
        for (int e = 0; e < 8; ++e) o[e] = cr[8 * jj + e] * sc;
        store8bf(dst + 8 * jj, o);
      }
    } else {
#pragma unroll
      for (int hh = 0; hh < 2; ++hh) {
        float o[32];
        rope32_out(cr + 32 * hh, t32 + (size_t)pos * 16, sc, o);
        bf16_t* dst = Qb + ((size_t)tok * 4 + 2 * half + hh) * 96 + 64;
#pragma unroll
        for (int jj = 0; jj < 4; ++jj) store8bf(dst + 8 * jj, o + 8 * jj);
      }
    }
  } else {
    bf16_t* dst = half == 0 ? (Kb + ((size_t)tok * 4 + nt) * 96) : (Vb + ((size_t)tok * 4 + nt) * 64);
#pragma unroll
    for (int jj = 0; jj < 8; ++jj) {
      float o[8];
#pragma unroll
      for (int e = 0; e < 8; ++e) o[e] = cr[8 * jj + e] * rs;
      store8bf(dst + 8 * jj, o);
    }
    if (half == 0) {
      const u32x4* src = (const u32x4*)(PR + (size_t)tok * NPR + 4480);
#pragma unroll
      for (int jj = 0; jj < 4; ++jj) ((u32x4*)(dst + 64))[jj] = src[jj];
    }
  }
}

typedef short s16x4_t __attribute__((ext_vector_type(4)));
DI bf16x8 tr_pair(const bf16_t* p0, const bf16_t* p1) {
  const s16x4_t lo = __builtin_amdgcn_ds_read_tr16_b64_v4i16((__attribute__((address_space(3))) s16x4_t*)p0);
  const s16x4_t hi = __builtin_amdgcn_ds_read_tr16_b64_v4i16((__attribute__((address_space(3))) s16x4_t*)p1);
  return __builtin_shufflevector(lo, hi, 0, 1, 2, 3, 4, 5, 6, 7);
}

template <int DK, bool BAND>
DI void flash_loop(f32x16 (&O)[2], float& m, float& l, const bf16_t* __restrict__ qrow, const bf16_t* __restrict__ kbase,
                   size_t kstride, const bf16_t* __restrict__ vbase, size_t vstride, int ntiles, int tq, int u0, int L,
                   char* lds) {
  const int tid = threadIdx.x + opq(), lane = tid & 63, l31 = lane & 31, h2 = lane >> 5;
  constexpr int KR = DK + 8, KCH = DK / 8, KN = 64 * KCH / 256;
  constexpr int STAGE = 64 * KR * 2 + 64 * 72 * 2;
  bf16x8 qf[DK / 16];
#pragma unroll
  for (int ks = 0; ks < DK / 16; ++ks) qf[ks] = *(const bf16x8*)(qrow + 16 * ks + 8 * h2);
  u32x4 rkA[KN], rvA[2], rkB[KN], rvB[2];
  auto gload = [&](int kt, u32x4 (&rk)[KN], u32x4 (&rv)[2]) {
#pragma unroll
    for (int i = 0; i < KN; ++i) {
      const int ci = tid + 256 * i, row = ci / KCH, c = ci % KCH;
      int rr = u0 + 64 * kt + row;
      if (BAND) rr = min(max(rr, 0), L - 1);
      rk[i] = *(const u32x4*)(kbase + (size_t)rr * kstride + c * 8);
    }
#pragma unroll
    for (int i = 0; i < 2; ++i) {
      const int ci = tid + 256 * i, row = ci >> 3, c = ci & 7;
      int rr = u0 + 64 * kt + row;
      if (BAND) rr = min(max(rr, 0), L - 1);
      rv[i] = *(const u32x4*)(vbase + (size_t)rr * vstride + c * 8);
    }
  };
  auto swrite = [&](int st, const u32x4 (&rk)[KN], const u32x4 (&rv)[2]) {
    bf16_t* Ks = (bf16_t*)(lds + st * STAGE);
    bf16_t* Vs = Ks + 64 * KR;
#pragma unroll
    for (int i = 0; i < KN; ++i) {
      const int ci = tid + 256 * i, row = ci / KCH, c = ci % KCH;
      *(u32x4*)(Ks + row * KR + c * 8) = rk[i];
    }
#pragma unroll
    for (int i = 0; i < 2; ++i) {
      const int ci = tid + 256 * i, row = ci >> 3, c = ci & 7;
      *(u32x4*)(Vs + row * 72 + c * 8) = rv[i];
    }
  };
  const int trq = (lane & 15) >> 2, trp = lane & 3, trblk = (lane >> 4) & 1;
  const int troff = (4 * h2 + trq) * 72 + 16 * trblk + 4 * trp;
  __syncthreads();
  gload(0, rkA, rvA);
  swrite(0, rkA, rvA);
  gload(1, rkA, rvA);
  if (ntiles > 2) gload(2, rkB, rvB);
  for (int kt2 = 0; kt2 < ntiles; kt2 += 2)
#pragma unroll
  for (int par = 0; par < 2; ++par) {
    const int kt = kt2 + par;
    __syncthreads();
    if (par == 0) {
      if (kt + 1 < ntiles) swrite((kt + 1) & 1, rkA, rvA);
      if (kt + 3 < ntiles) gload(kt + 3, rkA, rvA);
    } else {
      if (kt + 1 < ntiles) swrite((kt + 1) & 1, rkB, rvB);
      if (kt + 3 < ntiles) gload(kt + 3, rkB, rvB);
    }
    const bf16_t* Ks = (const bf16_t*)(lds + (kt & 1) * STAGE);
    const bf16_t* Vs = Ks + 64 * KR;
    f32x16 Sx[2];
#pragma unroll
    for (int j = 0; j < 2; ++j)
#pragma unroll
      for (int r = 0; r < 16; ++r) Sx[j][r] = 0.f;
#pragma unroll
    for (int ks = 0; ks < DK / 16; ++ks)
#pragma unroll
      for (int j = 0; j < 2; ++j) {
        const bf16x8 kf = *(const bf16x8*)(Ks + (32 * j + l31) * KR + 16 * ks + 8 * h2);
        Sx[j] = MFMA32(kf, qf[ks], Sx[j]);
      }
    if (BAND) {
#pragma unroll
      for (int j = 0; j < 2; ++j)
#pragma unroll
        for (int r = 0; r < 16; ++r) {
          const int u = u0 + 64 * kt + 32 * j + crow(r, h2);
          const int d = u - tq;
          const bool valid = (d <= 64) && (d >= -64) && (u >= 0) && (u < L);
          Sx[j][r] = valid ? Sx[j][r] : -1e30f;
        }
    }
    float mx = Sx[0][0];
#pragma unroll
    for (int j = 0; j < 2; ++j)
#pragma unroll
      for (int r = 0; r < 16; ++r) mx = fmaxf(mx, Sx[j][r]);
    mx = xhalf_max(mx);
    if (__any(mx - m > DEFER_THR)) {
      const float mn = fmaxf(m, mx);
      const float alpha = exp2_(m - mn);
      m = mn;
      l *= alpha;
#pragma unroll
      for (int t = 0; t < 2; ++t)
#pragma unroll
        for (int r = 0; r < 16; ++r) O[t][r] *= alpha;
    }
    float ls = 0.f;
#pragma unroll
    for (int j = 0; j < 2; ++j)
#pragma unroll
      for (int r = 0; r < 16; ++r) { const float pv = exp2_(Sx[j][r] - m); Sx[j][r] = pv; ls += pv; }
    l += ls;
#pragma unroll
    for (int j = 0; j < 2; ++j)
#pragma unroll
      for (int s = 0; s < 2; ++s) {
        const bf16x8 pf = pack8(Sx[j][8 * s], Sx[j][8 * s + 1], Sx[j][8 * s + 2], Sx[j][8 * s + 3], Sx[j][8 * s + 4],
                                Sx[j][8 * s + 5], Sx[j][8 * s + 6], Sx[j][8 * s + 7]);
#pragma unroll
        for (int t = 0; t < 2; ++t) {
          const bf16_t* vp = Vs + (32 * j + 16 * s) * 72 + 32 * t + troff;
          const bf16x8 vf = tr_pair(vp, vp + 8 * 72);
          O[t] = MFMA32(vf, pf, O[t]);
        }
      }
  }
}

DI void flash_loop_diff(f32x16 (&O0)[2], f32x16 (&O1)[2], float& m0, float& l0, float& m1, float& l1,
                        const bf16_t* __restrict__ qrow, const bf16_t* __restrict__ kbase, size_t kstride,
                        const bf16_t* __restrict__ vbase, size_t vstride, int ntiles, char* lds) {
  const int tid = threadIdx.x + opq(), lane = tid & 63, l31 = lane & 31, h2 = lane >> 5;
  constexpr int KR = 72;
  constexpr int STAGE = 64 * KR * 2 + 64 * 72 * 2;
  bf16x8 qf0[2], qf1[2];
#pragma unroll
  for (int ks = 0; ks < 2; ++ks) {
    qf0[ks] = *(const bf16x8*)(qrow + 16 * ks + 8 * h2);
    qf1[ks] = *(const bf16x8*)(qrow + 32 + 16 * ks + 8 * h2);
  }
  u32x4 rk[2], rv[2];
  auto gload = [&](int kt) {
#pragma unroll
    for (int i = 0; i < 2; ++i) {
      const int ci = tid + 256 * i, row = ci >> 3, c = ci & 7;
      const int rr = 64 * kt + row;
      rk[i] = *(const u32x4*)(kbase + (size_t)rr * kstride + c * 8);
      rv[i] = *(const u32x4*)(vbase + (size_t)rr * vstride + c * 8);
    }
  };
  auto swrite = [&](int st) {
    bf16_t* Ks = (bf16_t*)(lds + st * STAGE);
    bf16_t* Vs = Ks + 64 * KR;
#pragma unroll
    for (int i = 0; i < 2; ++i) {
      const int ci = tid + 256 * i, row = ci >> 3, c = ci & 7;
      *(u32x4*)(Ks + row * KR + c * 8) = rk[i];
      *(u32x4*)(Vs + row * 72 + c * 8) = rv[i];
    }
  };
  const int trq = (lane & 15) >> 2, trp = lane & 3, trblk = (lane >> 4) & 1;
  const int troff = (4 * h2 + trq) * 72 + 16 * trblk + 4 * trp;
  __syncthreads();
  gload(0);
  swrite(0);
  if (ntiles > 1) gload(1);
  for (int kt = 0; kt < ntiles; ++kt) {
    __syncthreads();
    if (kt + 1 < ntiles) swrite((kt + 1) & 1);
    if (kt + 2 < ntiles) gload(kt + 2);
    const bf16_t* Ks = (const bf16_t*)(lds + (kt & 1) * STAGE);
    const bf16_t* Vs = Ks + 64 * KR;
    bf16x8 pf[2][2][2];
#pragma unroll
    for (int mp = 0; mp < 2; ++mp) {
      f32x16 Sx[2];
#pragma unroll
      for (int j = 0; j < 2; ++j)
#pragma unroll
        for (int r = 0; r < 16; ++r) Sx[j][r] = 0.f;
#pragma unroll
      for (int ks = 0; ks < 2; ++ks)
#pragma unroll
        for (int j = 0; j < 2; ++j) {
          const bf16x8 kf = *(const bf16x8*)(Ks + (32 * j + l31) * KR + 32 * mp + 16 * ks + 8 * h2);
          Sx[j] = MFMA32(kf, mp == 0 ? qf0[ks] : qf1[ks], Sx[j]);
        }
      float& m = mp == 0 ? m0 : m1;
      float& l = mp == 0 ? l0 : l1;
      float mx = Sx[0][0];
#pragma unroll
      for (int j = 0; j < 2; ++j)
#pragma unroll
        for (int r = 0; r < 16; ++r) mx = fmaxf(mx, Sx[j][r]);
      mx = xhalf_max(mx);
      if (__any(mx - m > DEFER_THR)) {
        const float mn = fmaxf(m, mx);
        const float alpha = exp2_(m - mn);
        m = mn;
        l *= alpha;
#pragma unroll
        for (int t = 0; t < 2; ++t)
#pragma unroll
          for (int r = 0; r < 16; ++r) { if (mp == 0) O0[t][r] *= alpha; else O1[t][r] *= alpha; }
      }
      float ls = 0.f;
#pragma unroll
      for (int j = 0; j < 2; ++j)
#pragma unroll
        for (int r = 0; r < 16; ++r) { const float pv = exp2_(Sx[j][r] - m); Sx[j][r] = pv; ls += pv; }
      l += ls;
#pragma unroll
      for (int j = 0; j < 2; ++j)
#pragma unroll
        for (int s = 0; s < 2; ++s)
          pf[mp][j][s] = pack8(Sx[j][8 * s], Sx[j][8 * s + 1], Sx[j][8 * s + 2], Sx[j][8 * s + 3], Sx[j][8 * s + 4],
                               Sx[j][8 * s + 5], Sx[j][8 * s + 6], Sx[j][8 * s + 7]);
    }
#pragma unroll
    for (int j = 0; j < 2; ++j)
#pragma unroll
      for (int s = 0; s < 2; ++s)
#pragma unroll
        for (int t = 0; t < 2; ++t) {
          const bf16_t* vp = Vs + (32 * j + 16 * s) * 72 + 32 * t + troff;
          const bf16x8 vf = tr_pair(vp, vp + 8 * 72);
          O0[t] = MFMA32(vf, pf[0][j][s], O0[t]);
          O1[t] = MFMA32(vf, pf[1][j][s], O1[t]);
        }
  }
}

DI void zeroO(f32x16 (&O)[2]) {
#pragma unroll
  for (int t = 0; t < 2; ++t)
#pragma unroll
    for (int r = 0; r < 16; ++r) O[t][r] = 0.f;
}

DI void store_o(bf16_t* dst, const f32x16 (&O)[2], int h2) {
#pragma unroll
  for (int t = 0; t < 2; ++t)
#pragma unroll
    for (int g = 0; g < 4; ++g) {
      u32x2 u; u.x = pack2(O[t][4 * g], O[t][4 * g + 1]); u.y = pack2(O[t][4 * g + 2], O[t][4 * g + 3]);
      *(u32x2*)(dst + 32 * t + 8 * g + 4 * h2) = u;
    }
}

DI void mla_item(CParams& p, int it, int S, char* lds) {
  const int tid = threadIdx.x + opq(), lane = tid & 63, w = tid >> 6, l31 = lane & 31, h2 = lane >> 5;
  const int lgq = (S == 2048) ? 4 : 7;
  const int qb = it & ((1 << lgq) - 1), bh = it >> lgq, h = bh & 3, b = bh >> 2;
  const int tokbase = b * S, gtok = tokbase + 128 * qb + 32 * w + l31;
  const bf16_t* Qb = (const bf16_t*)(p.ws + OFF_Q);
  const bf16_t* Kb = (const bf16_t*)(p.ws + OFF_K);
  const bf16_t* Vb = (const bf16_t*)(p.ws + OFF_V);
  bf16_t* Y = (bf16_t*)(p.ws + OFF_N);
  f32x16 O[2]; zeroO(O);
  float m = -1e30f, l = 0.f;
  flash_loop<96, false>(O, m, l, Qb + ((size_t)gtok * 4 + h) * 96, Kb + ((size_t)tokbase * 4 + h) * 96, 384,
                        Vb + ((size_t)tokbase * 4 + h) * 64, 256, S / 64, 0, 0, 0, lds);
  l += __shfl_xor(l, 32);
  const float il = 1.f / l;
#pragma unroll
  for (int t = 0; t < 2; ++t)
#pragma unroll
    for (int r = 0; r < 16; ++r) O[t][r] *= il;
  store_o(Y + (size_t)gtok * 1024 + h * 64, O, h2);
}

DI void diff_item(CParams& p, int layer, int it, int S, char* lds) {
  const int tid = threadIdx.x + opq(), lane = tid & 63, w = tid >> 6, l31 = lane & 31, h2 = lane >> 5;
  const int lgq = (S == 2048) ? 4 : 7;
  const int qb = it & ((1 << lgq) - 1), bh = it >> lgq, h = bh & 3, b = bh >> 2;
  const int tokbase = b * S, gtok = tokbase + 128 * qb + 32 * w + l31;
  const bf16_t* PR = (const bf16_t*)(p.ws + OFF_PR);
  bf16_t* Y = (bf16_t*)(p.ws + OFF_N);
  const float* lam = p.diff_lambda + layer * 128;
  float s1 = 0.f, s2 = 0.f;
  if (lane < 32) { s1 = lam[lane] * lam[32 + lane]; s2 = lam[64 + lane] * lam[96 + lane]; }
  s1 = wave_sum(s1); s2 = wave_sum(s2);
  const float lambda_init = layer ? 0.35550907f : 0.2f;
  const float lambda_full = expf(s1) - expf(s2) + lambda_init;
  f32x16 of[2], O1[2];
  zeroO(of); zeroO(O1);
  {
    float m0 = -1e30f, l0 = 0.f, m1 = -1e30f, l1 = 0.f;
    flash_loop_diff(of, O1, m0, l0, m1, l1, PR + (size_t)gtok * NPR + C_BQ + (2 * h) * 32,
                    PR + (size_t)tokbase * NPR + C_BK + (2 * h) * 32, NPR, PR + (size_t)tokbase * NPR + C_BV + h * 64, NPR,
                    S / 64, lds);
    l0 += __shfl_xor(l0, 32);
    l1 += __shfl_xor(l1, 32);
    const float c0 = 1.f / l0, c1 = -lambda_full / l1;
#pragma unroll
    for (int t = 0; t < 2; ++t)
#pragma unroll
      for (int r = 0; r < 16; ++r) of[t][r] = c0 * of[t][r] + c1 * O1[t][r];
  }
  float ss = 0.f;
#pragma unroll
  for (int t = 0; t < 2; ++t)
#pragma unroll
    for (int r = 0; r < 16; ++r) ss += of[t][r] * of[t][r];
  ss += __shfl_xor(ss, 32);
  const float rs = rsqrtf(ss * (1.f / 64.f) + EPS) * (1.f - lambda_init);
  const float* sg = p.diff_subln + layer * 64;
#pragma unroll
  for (int t = 0; t < 2; ++t)
#pragma unroll
    for (int r = 0; r < 16; ++r) of[t][r] *= rs * sg[32 * t + crow(r, h2)];
  store_o(Y + (size_t)gtok * 1024 + 256 + h * 64, of, h2);
}

DI void dil_item(CParams& p, int it, int S, int B, char* lds) {
  const int tid = threadIdx.x + opq(), lane = tid & 63, w = tid >> 6, l31 = lane & 31, h2 = lane >> 5;
  const int lgS = (S == 2048) ? 11 : 14, lgB = (B == 16) ? 4 : 1;
  const int rq = it & ((1 << (lgS - 7)) - 1);
  int rest = it >> (lgS - 7);
  const int head = rest & 3; rest >>= 2;
  const int b = rest & (B - 1), g = rest >> lgB;
  const int lgd = 2 * g, dil = 1 << lgd;
  const int L = S >> lgd, lgnqb = lgS - lgd - 7;
  const int res = rq >> lgnqb, qb = rq & ((1 << lgnqb) - 1);
  const int tokbase = b * S;
  const int tq = 128 * qb + 32 * w + l31;
  const int gtok = tokbase + tq * dil + res;
  const bf16_t* PR = (const bf16_t*)(p.ws + OFF_PR);
  bf16_t* OD = (bf16_t*)(p.ws + OFF_OD);
  float* LSE = (float*)(p.ws + OFF_LSE);
  f32x16 O[2]; zeroO(O);
  float m = -1e30f, l = 0.f;
  const int hc = (g * 4 + head) * 64;
  flash_loop<64, true>(O, m, l, PR + (size_t)gtok * NPR + C_DQ + hc, PR + (size_t)(tokbase + res) * NPR + C_DK + hc,
                       (size_t)dil * NPR, PR + (size_t)(tokbase + res) * NPR + C_DV + hc, (size_t)dil * NPR, 4, tq,
                       128 * qb - 64, L, lds);
  l += __shfl_xor(l, 32);
  const float il = 1.f / l;
#pragma unroll
  for (int t = 0; t < 2; ++t)
#pragma unroll
    for (int r = 0; r < 16; ++r) O[t][r] *= il;
  store_o(OD + ((size_t)g * TG + gtok) * 256 + head * 64, O, h2);
  if (h2 == 0) LSE[((size_t)g * TG + gtok) * 4 + head] = m + __log2f(l);
}

constexpr size_t OFF_X2 = 564 * MiB, WS_BIG = 597 * MiB;
#define DN_QK_OFF (p.big_ws ? OFF_X2 : OFF_OD)
#define DN_GC_OFF ((p.big_ws ? OFF_X2 : OFF_OD) + 32 * MiB)
constexpr size_t DN_UW_OFF = OFF_Q;

DI void dn_prep_item(CParams& p, int layer, int it, int S, char* lds) {
  const int tid = threadIdx.x + opq(), lane = tid & 63, w = tid >> 6, l15 = lane & 15, g4 = lane >> 4;
  const int NC = S / 64;
  const int ch = it % NC, bh = it / NC, h = bh & 3, b = bh >> 2;
  const int tokbase = b * S, s0 = ch * 64;
  const bf16_t* PR = (const bf16_t*)(p.ws + OFF_PR);
  const float* AB = (const float*)(p.ws + OFF_AB);
  bf16_t* QKg = (bf16_t*)(p.ws + DN_QK_OFF) + ((size_t)bh * NC + ch) * 8192;
  bf16_t* raw = (bf16_t*)lds;
  float* convw = (float*)(lds + 27200);
  float* RU = (float*)lds;
  float* RW = (float*)(lds + 16384);
  float* Am = (float*)(lds + 32768);
  bf16_t* Kimg = (bf16_t*)(lds + 50176);
  bf16_t* Qimg = (bf16_t*)(lds + 59392);
  float* gcs = (float*)(lds + 68608);
  float* betas = gcs + 128;
  const float* cw = p.dn_conv + (size_t)layer * 5 * 768;
  {
    u32x4 rawreg[7];
    float cwr[4];
#pragma unroll
    for (int k = 0; k < 7; ++k) {
      const int ci = tid + 256 * k;
      const int rr = ci / 24, c = ci % 24, seg = c >> 3, c8 = c & 7;
      const int s = s0 + rr - 2;
      rawreg[k] = u32x4{0u, 0u, 0u, 0u};
      if (ci < 68 * 24 && s >= 0 && s < S)
        rawreg[k] = *(const u32x4*)(PR + (size_t)(tokbase + s) * NPR + C_DNQKV + seg * 256 + h * 64 + c8 * 8);
    }
#pragma unroll
    for (int k = 0; k < 4; ++k) {
      const int i = tid + 256 * k;
      cwr[k] = 0.f;
      if (i < 960) { const int j = i / 192, c = i % 192; cwr[k] = cw[j * 768 + (c >> 6) * 256 + h * 64 + (c & 63)]; }
    }
#pragma unroll
    for (int k = 0; k < 7; ++k) {
      const int ci = tid + 256 * k;
      const int rr = ci / 24, c = ci % 24, seg = c >> 3, c8 = c & 7;
      if (ci < 68 * 24) *(u32x4*)(raw + rr * 200 + seg * 64 + c8 * 8) = rawreg[k];
    }
#pragma unroll
    for (int k = 0; k < 4; ++k) { const int i = tid + 256 * k; if (i < 960) convw[i] = cwr[k]; }
  }
  if (tid < 128) {
    const int d = tid >> 6, pl = tid & 63;
    const int i = d ? 63 - pl : pl;
    const size_t tok = (size_t)tokbase + s0 + i;
    const float Aexp = expf(p.dn_a_log[layer * 8 + d * 4 + h]);
    const float a = AB[tok * 16 + d * 8 + h] + p.dn_dt_bias[layer * 8 + d * 4 + h];
    const float bb = AB[tok * 16 + d * 8 + 4 + h];
    const float sp = fmaxf(a, 0.f) + __logf(1.f + __expf(-fabsf(a)));
    float g = -Aexp * sp;
#pragma unroll
    for (int o = 1; o < 64; o <<= 1) { const float tv = __shfl_up(g, o); if (lane >= o) g += tv; }
    gcs[tid] = g;
    betas[tid] = sigmoidf_(bb);
    float* GC = (float*)(p.ws + DN_GC_OFF) + (((size_t)bh * 2 + d) * NC + ch) * 64;
    GC[pl] = g;
  }
  __syncthreads();
  const int pp = tid >> 2, cgp = tid & 3;
  float kv[16], vv[16];
  {
    float qv[16];
#pragma unroll
    for (int seg = 0; seg < 3; ++seg) {
      float acc[16];
#pragma unroll
      for (int c = 0; c < 16; ++c) acc[c] = 0.f;
#pragma unroll
      for (int j = 0; j < 5; ++j) {
        const bf16_t* rp = raw + (pp + j) * 200 + seg * 64 + 16 * cgp;
        const float* wp = convw + j * 192 + seg * 64 + 16 * cgp;
        const u32x4 u0 = *(const u32x4*)rp, u1 = *(const u32x4*)(rp + 8);
        const unsigned uu[8] = {u0.x, u0.y, u0.z, u0.w, u1.x, u1.y, u1.z, u1.w};
#pragma unroll
        for (int e = 0; e < 8; ++e) {
          acc[2 * e] += wp[2 * e] * __uint_as_float(uu[e] << 16);
          acc[2 * e + 1] += wp[2 * e + 1] * __uint_as_float(uu[e] & 0xffff0000u);
        }
      }
#pragma unroll
      for (int c = 0; c < 16; ++c) {
        const float sv = acc[c] * __builtin_amdgcn_rcpf(1.f + __expf(-acc[c]));
        if (seg == 0) qv[c] = sv; else if (seg == 1) kv[c] = sv; else vv[c] = sv;
      }
    }
    float sq = 0.f, sk = 0.f;
#pragma unroll
    for (int c = 0; c < 16; ++c) { sq += qv[c] * qv[c]; sk += kv[c] * kv[c]; }
    sq += __shfl_xor(sq, 1); sq += __shfl_xor(sq, 2);
    sk += __shfl_xor(sk, 1); sk += __shfl_xor(sk, 2);
    const float rq = rsqrtf(sq + EPS) * 0.125f, rk = rsqrtf(sk + EPS);
#pragma unroll
    for (int c = 0; c < 16; ++c) { qv[c] *= rq; kv[c] *= rk; }
    store8bf(Kimg + pp * 72 + 16 * cgp, kv); store8bf(Kimg + pp * 72 + 16 * cgp + 8, kv + 8);
    store8bf(Qimg + pp * 72 + 16 * cgp, qv); store8bf(Qimg + pp * 72 + 16 * cgp + 8, qv + 8);
    store8bf(QKg + pp * 64 + 16 * cgp, qv); store8bf(QKg + pp * 64 + 16 * cgp + 8, qv + 8);
    store8bf(QKg + 4096 + pp * 64 + 16 * cgp, kv); store8bf(QKg + 4096 + pp * 64 + 16 * cgp + 8, kv + 8);
  }
  for (int d = 0; d < 2; ++d) {
    __syncthreads();
    {
      const int pl = d ? 63 - pp : pp;
      const float bet = betas[d * 64 + pl], egc = __expf(gcs[d * 64 + pl]);
#pragma unroll
      for (int c = 0; c < 16; ++c) {
        RU[pl * 64 + 16 * cgp + c] = vv[c] * bet;
        RW[pl * 64 + 16 * cgp + c] = kv[c] * bet * egc;
      }
    }
    {
      f32x4 KK[4];
#pragma unroll
      for (int t = 0; t < 4; ++t) KK[t] = f32x4{0.f, 0.f, 0.f, 0.f};
      const int jl = 16 * w + l15;
      const int jrow = d ? 63 - jl : jl;
#pragma unroll
      for (int ks = 0; ks < 2; ++ks) {
        const bf16x8 bfk = *(const bf16x8*)(Kimg + jrow * 72 + 32 * ks + 8 * g4);
#pragma unroll
        for (int rt = 0; rt < 4; ++rt) {
          const int il = 16 * rt + l15;
          const int irow = d ? 63 - il : il;
          const bf16x8 afk = *(const bf16x8*)(Kimg + irow * 72 + 32 * ks + 8 * g4);
          KK[rt] = MFMA16(afk, bfk, KK[rt]);
        }
      }
      const float gcj = gcs[d * 64 + jl];
#pragma unroll
      for (int rt = 0; rt < 4; ++rt)
#pragma unroll
        for (int r = 0; r < 4; ++r) {
          const int i = 16 * rt + 4 * g4 + r;
          const float ee = __expf(fminf(gcs[d * 64 + i] - gcj, 0.f));
          Am[i * 68 + jl] = (i > jl) ? betas[d * 64 + i] * KK[rt][r] * ee : 0.f;
        }
    }
    __syncthreads();
    float xs[32];
#pragma unroll
    for (int q = 0; q < 32; ++q) xs[q] = 0.f;
    const int c = tid >> 1, half = tid & 1;
    {
      const float* Rc = (c < 64) ? (RU + c) : (RW + (c - 64));
      const float* Ah = Am + 4 * half;
#pragma unroll
      for (int i = 0; i < 64; ++i) {
        float part = 0.f;
#pragma unroll
        for (int q = 0; q < (i + 7) / 8; ++q) {
          const f32x4 a = *(const f32x4*)(Ah + i * 68 + 8 * q);
          part += a[0] * xs[4 * q] + a[1] * xs[4 * q + 1] + a[2] * xs[4 * q + 2] + a[3] * xs[4 * q + 3];
        }
        const float other = __int_as_float(__builtin_amdgcn_update_dpp(0, __float_as_int(part), 0xB1, 0xf, 0xf, true));
        const float xi = Rc[i * 64] - (part + other);
        const int loc = ((i >> 3) << 2) + (i & 3);
        if (((i >> 2) & 1) == 0) xs[loc] = (half == 0) ? xi : xs[loc];
        else xs[loc] = (half == 1) ? xi : xs[loc];
        if (i < 16 ? ((i & 7) == 7) : (i < 32 ? ((i & 3) == 3) : ((i & 1) == 1))) asm volatile("" ::: "memory");
      }
    }
    {
      bf16_t* UWg = (bf16_t*)(p.ws + DN_UW_OFF) + ((((size_t)bh * 2 + d) * NC + ch) * 8192);
      const float sgn = (c < 64) ? 1.f : -1.f;
      bf16_t* dst = UWg + ((c < 64) ? c : (4096 + c - 64));
#pragma unroll
      for (int loc = 0; loc < 32; ++loc) {
        const int i = (((loc >> 2) * 2 + half) << 2) + (loc & 3);
        dst[i * 64] = f2bf(sgn * xs[loc]);
      }
    }
  }
}

DI void dn_scan_chain(CParams& p, int it, int S, char* lds) {
  __builtin_amdgcn_s_setprio(3);
  const int tid0 = threadIdx.x + opq();
  const int dir = it & 1, bh = it >> 1, h = bh & 3, b = bh >> 2;
  const int tokbase = b * S, NC = S / 64;
  bf16_t* OUT = (bf16_t*)(p.ws + (dir ? OFF_OB : OFF_OF));
  const bf16_t* QKg = (const bf16_t*)(p.ws + DN_QK_OFF) + (size_t)bh * NC * 8192;
  const bf16_t* UWg = (const bf16_t*)(p.ws + DN_UW_OFF) + (size_t)it * NC * 8192;
  const float* GCg = (const float*)(p.ws + DN_GC_OFF) + (size_t)it * NC * 64;
  bf16_t* Uimg = (bf16_t*)lds;
  bf16_t* Wn = Uimg + 4608;
  bf16_t* Qimg = Wn + 4608;
  bf16_t* Kimg = Qimg + 4608;
  bf16_t* Kt = Kimg + 4608;
  bf16_t* Iimg = Kt + 4608;
  float* gcs = (float*)(lds + 6 * 9216);
  f32x4 Sd[4];
#pragma unroll
  for (int t = 0; t < 4; ++t) Sd[t] = f32x4{0.f, 0.f, 0.f, 0.f};
  u32x4 ru[2], rw[2], rq[2], rk[2];
  float rg = 0.f;
  auto prefetch = [&](int cc_) {
    const int ch_ = dir ? (NC - 1 - cc_) : cc_;
    const int tp = tid0 + opq();
    const bf16_t* uw = UWg + (size_t)ch_ * 8192;
    const bf16_t* qk = QKg + (size_t)ch_ * 8192;
#pragma unroll
    for (int k = 0; k < 2; ++k) {
      const int ci = tp + 256 * k, row = ci >> 3, c8 = ci & 7;
      const int srow = dir ? 63 - row : row;
      ru[k] = *(const u32x4*)(uw + row * 64 + c8 * 8);
      rw[k] = *(const u32x4*)(uw + 4096 + row * 64 + c8 * 8);
      rq[k] = *(const u32x4*)(qk + srow * 64 + c8 * 8);
      rk[k] = *(const u32x4*)(qk + 4096 + srow * 64 + c8 * 8);
    }
    if (tp < 64) rg = GCg[(size_t)ch_ * 64 + tp];
  };
  prefetch(0);
  for (int cc = 0; cc < NC; ++cc) {
    const int tid = tid0 + opq(), lane = tid & 63, w = tid >> 6, l15 = lane & 15, g4 = lane >> 4;
    const int e_col = 16 * w + l15;
    const int ch = dir ? (NC - 1 - cc) : cc;
    const int s0 = ch * 64;
    __syncthreads();
#pragma unroll
    for (int k = 0; k < 2; ++k) {
      const int ci = tid + 256 * k, row = ci >> 3, c8 = ci & 7;
      *(u32x4*)(Uimg + row * 72 + c8 * 8) = ru[k];
      *(u32x4*)(Wn + row * 72 + c8 * 8) = rw[k];
      *(u32x4*)(Qimg + row * 72 + c8 * 8) = rq[k];
      *(u32x4*)(Kimg + row * 72 + c8 * 8) = rk[k];
      const unsigned uu[4] = {rk[k].x, rk[k].y, rk[k].z, rk[k].w};
#pragma unroll
      for (int e = 0; e < 4; ++e) {
        Kt[(8 * c8 + 2 * e) * 72 + row] = (bf16_t)(uu[e] & 0xffffu);
        Kt[(8 * c8 + 2 * e + 1) * 72 + row] = (bf16_t)(uu[e] >> 16);
      }
    }
    if (tid < 64) gcs[tid] = rg;
    if (cc + 1 < NC) prefetch(cc + 1);
    __syncthreads();
    {
      f32x4 QK[4];
#pragma unroll
      for (int t = 0; t < 4; ++t) QK[t] = f32x4{0.f, 0.f, 0.f, 0.f};
#pragma unroll
      for (int ks = 0; ks < 2; ++ks) {
        const bf16x8 bfk = *(const bf16x8*)(Kimg + (16 * w + l15) * 72 + 32 * ks + 8 * g4);
#pragma unroll
        for (int rt = 0; rt < 4; ++rt) {
          const bf16x8 afq = *(const bf16x8*)(Qimg + (16 * rt + l15) * 72 + 32 * ks + 8 * g4);
          QK[rt] = MFMA16(afq, bfk, QK[rt]);
        }
      }
      const float gcj = gcs[e_col];
#pragma unroll
      for (int rt = 0; rt < 4; ++rt)
#pragma unroll
        for (int r = 0; r < 4; ++r) {
          const int i = 16 * rt + 4 * g4 + r;
          const float ee = __expf(fminf(gcs[i] - gcj, 0.f));
          Iimg[i * 72 + e_col] = f2bf((i >= e_col) ? QK[rt][r] * ee : 0.f);
        }
    }
    __syncthreads();
    {
      bf16x8 Bs[2];
#pragma unroll
      for (int ks = 0; ks < 2; ++ks)
        Bs[ks] = pack8(Sd[2 * ks][0], Sd[2 * ks][1], Sd[2 * ks][2], Sd[2 * ks][3], Sd[2 * ks + 1][0], Sd[2 * ks + 1][1],
                       Sd[2 * ks + 1][2], Sd[2 * ks + 1][3]);
      f32x4 vn[4], qs[4], iv[4];
#pragma unroll
      for (int rt = 0; rt < 4; ++rt) {
#pragma unroll
        for (int r = 0; r < 4; ++r) vn[rt][r] = bf2f(Uimg[(16 * rt + 4 * g4 + r) * 72 + e_col]);
        qs[rt] = f32x4{0.f, 0.f, 0.f, 0.f};
        iv[rt] = f32x4{0.f, 0.f, 0.f, 0.f};
#pragma unroll
        for (int ks = 0; ks < 2; ++ks) {
          const bf16_t* wp = Wn + (16 * rt + l15) * 72 + 32 * ks + 4 * g4;
          const bf16_t* qp = Qimg + (16 * rt + l15) * 72 + 32 * ks + 4 * g4;
          vn[rt] = MFMA16(ld2x4(wp, wp + 16), Bs[ks], vn[rt]);
          qs[rt] = MFMA16(ld2x4(qp, qp + 16), Bs[ks], qs[rt]);
        }
      }
      bf16x8 Bv[2];
#pragma unroll
      for (int ks = 0; ks < 2; ++ks)
        Bv[ks] = pack8(vn[2 * ks][0], vn[2 * ks][1], vn[2 * ks][2], vn[2 * ks][3], vn[2 * ks + 1][0], vn[2 * ks + 1][1],
                       vn[2 * ks + 1][2], vn[2 * ks + 1][3]);
#pragma unroll
      for (int rt = 0; rt < 4; ++rt)
#pragma unroll
        for (int ks = 0; ks < 2; ++ks) {
          const bf16_t* ip = Iimg + (16 * rt + l15) * 72 + 32 * ks + 4 * g4;
          iv[rt] = MFMA16(ld2x4(ip, ip + 16), Bv[ks], iv[rt]);
        }
      const float gc63 = gcs[63];
#pragma unroll
      for (int rt = 0; rt < 4; ++rt)
#pragma unroll
        for (int r = 0; r < 4; ++r) {
          const int pos = 16 * rt + 4 * g4 + r;
          const float o = qs[rt][r] * __expf(gcs[pos]) + iv[rt][r];
          const int i = dir ? 63 - pos : pos;
          OUT[((size_t)tokbase + s0 + i) * 256 + h * 64 + e_col] = f2bf(o);
          vn[rt][r] *= __expf(gc63 - gcs[pos]);
        }
      bf16x8 Bv2[2];
#pragma unroll
      for (int ks = 0; ks < 2; ++ks)
        Bv2[ks] = pack8(vn[2 * ks][0], vn[2 * ks][1], vn[2 * ks][2], vn[2 * ks][3], vn[2 * ks + 1][0], vn[2 * ks + 1][1],
                        vn[2 * ks + 1][2], vn[2 * ks + 1][3]);
      const float gl = __expf(gc63);
#pragma unroll
      for (int dt = 0; dt < 4; ++dt) {
#pragma unroll
        for (int r = 0; r < 4; ++r) Sd[dt][r] *= gl;
#pragma unroll
        for (int ks = 0; ks < 2; ++ks) {
          const bf16_t* kp = Kt + (16 * dt + l15) * 72 + 32 * ks + 4 * g4;
          Sd[dt] = MFMA16(ld2x4(kp, kp + 16), Bv2[ks], Sd[dt]);
        }
      }
    }
  }
  __builtin_amdgcn_s_setprio(0);
}

DI void phase_combine(CParams& p, int layer, const float* __restrict__ xg) {
  const int tidq = threadIdx.x + opq(); const int wave = tidq >> 6, lane = tidq & 63;
  const bf16_t* PR = (const bf16_t*)(p.ws + OFF_PR);
  const bf16_t* OD = (const bf16_t*)(p.ws + OFF_OD);
  const float* LSE = (const float*)(p.ws + OFF_LSE);
  const bf16_t* OFb = (const bf16_t*)(p.ws + OFF_OF);
  const bf16_t* OBb = (const bf16_t*)(p.ws + OFF_OB);
  bf16_t* Y = (bf16_t*)(p.ws + OFF_N);
  bf16_t* Np = (bf16_t*)(p.ws + OFF_Q);
  const float* gmix = p.norm_mix + layer * 1024;
  const float* gdn = p.dn_out_norm + layer * 64;
  const int head = lane >> 4;
  for (int r = blockIdx.x * 4 + wave; r < TG; r += gridDim.x * 4) {
    {
      float lg[3];
#pragma unroll
      for (int g = 0; g < 3; ++g) lg[g] = LSE[((size_t)g * TG + r) * 4 + head];
      const float mx = fmaxf(lg[0], fmaxf(lg[1], lg[2]));
      float wg[3], den = 0.f;
#pragma unroll
      for (int g = 0; g < 3; ++g) { wg[g] = exp2_(lg[g] - mx); den += wg[g]; }
      const float id = 1.f / den;
      float o[4] = {0.f, 0.f, 0.f, 0.f};
#pragma unroll
      for (int g = 0; g < 3; ++g) {
        const u32x2 u = ((const u32x2*)(OD + ((size_t)g * TG + r) * 256))[lane];
        const float c = wg[g] * id;
        o[0] += c * __uint_as_float(u.x << 16); o[1] += c * __uint_as_float(u.x & 0xffff0000u);
        o[2] += c * __uint_as_float(u.y << 16); o[3] += c * __uint_as_float(u.y & 0xffff0000u);
      }
      u32x2 ou; ou.x = pack2(o[0], o[1]); ou.y = pack2(o[2], o[3]);
      ((u32x2*)(Y + (size_t)r * 1024 + 768))[lane] = ou;
    }
    {
      const u32x2 uf = ((const u32x2*)(OFb + (size_t)r * 256))[lane];
      const u32x2 ub = ((const u32x2*)(OBb + (size_t)r * 256))[lane];
      const u32x2 uz = ((const u32x2*)(PR + (size_t)r * NPR + C_Z))[lane];
      float o[4], z[4];
      o[0] = __uint_as_float(uf.x << 16) + __uint_as_float(ub.x << 16);
      o[1] = __uint_as_float(uf.x & 0xffff0000u) + __uint_as_float(ub.x & 0xffff0000u);
      o[2] = __uint_as_float(uf.y << 16) + __uint_as_float(ub.y << 16);
      o[3] = __uint_as_float(uf.y & 0xffff0000u) + __uint_as_float(ub.y & 0xffff0000u);
      z[0] = __uint_as_float(uz.x << 16); z[1] = __uint_as_float(uz.x & 0xffff0000u);
      z[2] = __uint_as_float(uz.y << 16); z[3] = __uint_as_float(uz.y & 0xffff0000u);
      float ss = o[0] * o[0] + o[1] * o[1] + o[2] * o[2] + o[3] * o[3];
      ss += __shfl_xor(ss, 1); ss += __shfl_xor(ss, 2); ss += __shfl_xor(ss, 4); ss += __shfl_xor(ss, 8);
      const float rs = rsqrtf(ss * (1.f / 64.f) + EPS);
      const float4 gg = ((const float4*)gdn)[lane & 15];
      u32x2 ou;
      ou.x = pack2(o[0] * rs * gg.x * siluf_(z[0]), o[1] * rs * gg.y * siluf_(z[1]));
      ou.y = pack2(o[2] * rs * gg.z * siluf_(z[2]), o[3] * rs * gg.w * siluf_(z[3]));
      ((u32x2*)(Y + (size_t)r * 1024 + 512))[lane] = ou;
    }
    {
      const float4* xr = (const float4*)(xg + (size_t)r * 1024);
      float4 v[4];
      float ss = 0.f;
#pragma unroll
      for (int i = 0; i < 4; ++i) { v[i] = xr[lane + 64 * i]; ss += v[i].x * v[i].x + v[i].y * v[i].y + v[i].z * v[i].z + v[i].w * v[i].w; }
      ss = wave_sum(ss);
      const float rs = rsqrtf(ss * (1.f / 1024.f) + EPS);
#pragma unroll
      for (int i = 0; i < 4; ++i) {
        const float4 gg = ((const float4*)gmix)[lane + 64 * i];
        u32x2 o; o.x = pack2(v[i].x * rs * gg.x, v[i].y * rs * gg.y); o.y = pack2(v[i].z * rs * gg.z, v[i].w * rs * gg.w);
        ((u32x2*)(Np + (size_t)r * 1024))[lane + 64 * i] = o;
      }
    }
  }
}

#define XB_TMO      128
#define XB_XCNT(j)  (256  + 64 * (j))
#define XB_XSUB(j)  (1280 + 64 * (j))
#define XB_XGEN(j)  (2304 + 64 * (j))
#define XB_TOP      3328
#define XB_TOPGEN   3392
#define XCD_BAR_WORDS 3456
#define XB_SPIN_CAP (1u << 27)
#define LAS __attribute__((address_space(3)))
constexpr size_t OFF_BAR = OFF_CNT + 65536;
DI unsigned xb_ld(unsigned* p) { return __hip_atomic_load(p, __ATOMIC_RELAXED, __HIP_MEMORY_SCOPE_AGENT); }
DI unsigned xb_add(unsigned* p, unsigned v) { return __hip_atomic_fetch_add(p, v, __ATOMIC_RELAXED, __HIP_MEMORY_SCOPE_AGENT); }
DI unsigned xb_xcc_id() { return (unsigned)__builtin_amdgcn_s_getreg((3 << 11) | 20) & 0xFu; }
#define XB_SPIN(cond, bar) do { unsigned _sp = 0; while (cond) { __builtin_amdgcn_s_sleep(1); \
    if ((++_sp & 255u) == 0u) { if (xb_ld(&(bar)[XB_TMO])) break; if (_sp > XB_SPIN_CAP) { atomicAdd(&(bar)[XB_TMO], 1u); break; } } } } while (0)
struct XcdBarrier { unsigned* bar; unsigned x; volatile LAS unsigned* st; };
DI XcdBarrier xcd_barrier_post(unsigned* bar, volatile LAS unsigned* st) {
  XcdBarrier b; b.bar = bar; b.x = xb_xcc_id(); b.st = st;
  if (threadIdx.x == 0) (void)xb_add(&bar[XB_XCNT(b.x)], 1u);
  return b;
}
DI void xcd_barrier_complete(unsigned* bar, unsigned x, unsigned& nloc, unsigned& nx) {
  const unsigned G = gridDim.x * gridDim.y * gridDim.z;
  unsigned sum, cnt, mine, sp = 0u;
  for (;;) {
    sum = 0u; cnt = 0u; mine = 0u;
#pragma unroll
    for (unsigned j = 0; j < 16; ++j) { const unsigned c = xb_ld(&bar[XB_XCNT(j)]); sum += c; cnt += (c > 0u) ? 1u : 0u; mine = (j == x) ? c : mine; }
    if (sum == G) break;
    __builtin_amdgcn_s_sleep(1);
    if ((++sp & 255u) == 0u) { if (xb_ld(&bar[XB_TMO])) break; if (sp > XB_SPIN_CAP) { atomicAdd(&bar[XB_TMO], 1u); break; } }
  }
  nloc = mine > 0u ? mine : 1u; nx = cnt > 0u ? cnt : 1u;
}
DI void xcd_barrier(const XcdBarrier& b) {
  asm volatile("s_waitcnt vmcnt(0)" ::: "memory");
  __syncthreads();
  if (threadIdx.x == 0) {
    unsigned* bar = b.bar;
    __builtin_amdgcn_s_waitcnt(0);
    unsigned nloc = b.st[0], nx = b.st[1];
    if (nloc == 0u) { xcd_barrier_complete(bar, b.x, nloc, nx); b.st[0] = nloc; b.st[1] = nx; }
    const unsigned old = xb_add(&bar[XB_XSUB(b.x)], 1u);
    const unsigned gen = old / nloc;
    if (old + 1u == (gen + 1u) * nloc) {
      __builtin_amdgcn_fence(__ATOMIC_RELEASE, "agent");
      asm volatile("s_waitcnt vmcnt(0)" ::: "memory");
      const unsigned og = xb_add(&bar[XB_TOP], 1u);
      const unsigned tg = og / nx;
      if (og + 1u == (tg + 1u) * nx) xb_add(&bar[XB_TOPGEN], 1u);
      else XB_SPIN(xb_ld(&bar[XB_TOPGEN]) == tg, bar);
      __builtin_amdgcn_fence(__ATOMIC_ACQUIRE, "agent");
      xb_add(&bar[XB_XGEN(b.x)], 1u);
      asm volatile("s_waitcnt vmcnt(0)" ::: "memory");
    } else {
      XB_SPIN(xb_ld(&bar[XB_XGEN(b.x)]) == gen, bar);
      __builtin_amdgcn_fence(__ATOMIC_ACQUIRE, "agent");
      asm volatile("s_waitcnt vmcnt(0)" ::: "memory");
    }
  }
  __syncthreads();
}

#ifndef REP_MIX
#define REP_MIX 1
#endif
#ifndef REP_GEMM
#define REP_GEMM 1
#endif
__global__ void __launch_bounds__(256, 2) mega(Params pk) {
  extern __shared__ __attribute__((aligned(16))) char lds[];
  __shared__ uint4 sh_words;
  cg::grid_group grid = cg::this_grid();
  CParams* kp = (CParams*)__builtin_amdgcn_kernarg_segment_ptr();
  if (threadIdx.x == 0) sh_words = make_uint4(0u, 0u, 0u, 0u);
  __syncthreads();
  XcdBarrier xb;
  { CParams& p = *launder(kp); xb = xcd_barrier_post((unsigned*)(p.ws + OFF_BAR), (volatile LAS unsigned*)&sh_words); }
#define s_item (((volatile int*)&sh_words)[2])
#define GSYNC() xcd_barrier(xb)
#define PP_ CParams& p = *launder(kp); const bf16_t* wb = (const bf16_t*)(p.ws + OFF_WB); bf16_t* Nb = (bf16_t*)(p.ws + OFF_N); \
            bf16_t* PRb = (bf16_t*)(p.ws + OFF_PR); bf16_t* Npb = (bf16_t*)(p.ws + OFF_Q); bf16_t* PB = (bf16_t*)(p.ws + OFF_OD); \
            float* xg = p.x + (size_t)grp * TG * 1024; (void)wb; (void)Nb; (void)PRb; (void)Npb; (void)PB; (void)xg;
  { CParams& p = *launder(kp); phase_init(p, lds); phase_norm(p.x_in[0], p.norm_ff1, (bf16_t*)(p.ws + OFF_Q), nullptr, nullptr); }
  grid.sync();
  for (int layer = 0; layer < 2; ++layer) {
    if (layer > 0) { CParams& p = *launder(kp); phase_convert(p, layer, lds); GSYNC(); }
    for (int grp = 0; grp < 2; ++grp) {
      const int S = grp ? 2048 : 16384, B = grp ? 16 : 2;
      const float* xsrc0 = nullptr;
      { CParams& p = *launder(kp); xsrc0 = layer == 0 ? p.x_in[grp] : p.x + (size_t)grp * TG * 1024; }
      for (int rep = 0; rep < REP_GEMM; ++rep) {
        { PP_ phase_ffn_a(Npb, wb + W_FF1_1, wb + W_FF1_3, PRb, lds); }
        GSYNC();
      }
      { PP_ phase_gemm_resid(PRb, 2816, wb + W_FF1_2, xsrc0, xg, 0.5f, lds); }
      GSYNC();
      { PP_ phase_norm(xg, p.norm_mix + layer * 1024, Nb, nullptr, nullptr); }
      GSYNC();
      for (int rep = 0; rep < REP_GEMM; ++rep) {
        { PP_ phase_proj(p, Nb, wb + W_IN, S, lds); }
        GSYNC();
      }
      {
        PP_
        int* c0 = (int*)(p.ws + OFF_CNT) + (layer * 2 + grp) * 4;
        for (;;) {
          __syncthreads();
          if (threadIdx.x == 0) s_item = atomicAdd(c0, 1);
          __syncthreads();
          const int it = s_item;
          if (it >= 2048) break;
          dn_prep_item(p, layer, it, S, lds);
        }
      }
      GSYNC();
      {
        PP_
        int* cb = (int*)(p.ws + OFF_CNT) + 64 + (layer * 2 + grp) * 32;
        const int nDN = B * 8, nDil = p.big_ws ? 3072 : 0;
        const int lgq = grp ? 4 : 7;
        for (;;) {
          __syncthreads();
          if (threadIdx.x == 0) s_item = atomicAdd(cb, 1);
          __syncthreads();
          const int it = s_item;
          if (it >= nDN) break;
          dn_scan_chain(p, it, S, lds);
        }
        for (int xo = 0; xo < 8; ++xo) {
          const int xq = (blockIdx.x + xo) & 7;
          for (;;) {
            __syncthreads();
            if (threadIdx.x == 0) s_item = atomicAdd(cb + 8 + xq, 1);
            __syncthreads();
            const int j = s_item;
            if (j >= 128) break;
            const int pair = xq + 8 * (j >> lgq), qb = j & ((1 << lgq) - 1);
            diff_item(p, layer, (pair << lgq) + qb, S, lds);
          }
        }
        for (;;) {
          __syncthreads();
          if (threadIdx.x == 0) s_item = atomicAdd(cb + 1, 1);
          __syncthreads();
          const int it = s_item;
          if (it >= nDil) break;
          dil_item(p, it, S, B, lds);
        }
      }
      GSYNC();
      {
        PP_
        int* c2 = (int*)(p.ws + OFF_CNT) + (layer * 2 + grp) * 4 + 2;
        const int nDil = p.big_ws ? 0 : 3072, total = nDil + 256 * 7;
        for (;;) {
          __syncthreads();
          if (threadIdx.x == 0) s_item = atomicAdd(c2, 1);
          __syncthreads();
          int it = s_item;
          if (it >= total) break;
          if (it < nDil) { dil_item(p, it, S, B, lds); continue; }
          it -= nDil;
          mla_up_tile(p, it / 7, it % 7, S, lds);
        }
      }
      GSYNC();
      {
        PP_
        int* cb = (int*)(p.ws + OFF_CNT) + 64 + (layer * 2 + grp) * 32 + 16;
        const int lgq = grp ? 4 : 7;
        for (int xo = 0; xo < 8; ++xo) {
          const int xq = (blockIdx.x + xo) & 7;
          for (;;) {
            __syncthreads();
            if (threadIdx.x == 0) s_item = atomicAdd(cb + xq, 1);
            __syncthreads();
            const int j = s_item;
            if (j >= 128) break;
            const int pair = xq + 8 * (j >> lgq), qb = j & ((1 << lgq) - 1);
            mla_item(p, (pair << lgq) + qb, S, lds);
          }
        }
      }
      GSYNC();
      { PP_ phase_combine(p, layer, xg); }
      GSYNC();
      for (int rep = 0; rep < REP_GEMM; ++rep) {
        { PP_ phase_merge(Npb, Nb, wb + W_G, wb + W_B, PRb, lds); }
        GSYNC();
      }
      { PP_ phase_gemm_resid(PRb, 1024, wb + W_O, xg, xg, 1.0f, lds); }
      GSYNC();
      { PP_ phase_norm(xg, p.norm_ff2 + layer * 1024, Nb, nullptr, nullptr); }
      GSYNC();
      for (int rep = 0; rep < REP_GEMM; ++rep) {
        { PP_ phase_ffn_a(Nb, wb + W_FF2_1, wb + W_FF2_3, PRb, lds); }
        GSYNC();
      }
      { PP_ phase_gemm_resid(PRb, 2816, wb + W_FF2_2, xg, xg, 0.5f, lds); }
      GSYNC();
      { PP_ phase_norm(xg, p.norm_ple + layer * 1024, Nb, p.p_in[grp] + (size_t)layer * TG * 256, PB); }
      GSYNC();
      {
        PP_
        phase_ple(Nb, PB, wb + W_PG, wb + W_PP, xg, lds);
        const int nl = grp ? layer + 1 : layer, ng = grp ^ 1;
        if (nl < 2) phase_norm(nl == 0 ? p.x_in[ng] : p.x + (size_t)ng * TG * 1024, p.norm_ff1 + nl * 1024, Npb, nullptr, nullptr);
      }
      GSYNC();
    }
  }
  { CParams& p = *launder(kp); phase_final_norm(p.x, p.norm_final); }
}

extern "C" void kernel_launch(void* const* d_in, const int* in_sizes, int n_in, void* d_out, int out_size, void* d_ws,
                              size_t ws_size, hipStream_t stream) {
  (void)in_sizes; (void)n_in; (void)out_size;
  Params p{};
  p.x_in[0] = (const float*)d_in[0]; p.x_in[1] = (const float*)d_in[1];
  p.p_in[0] = (const float*)d_in[2]; p.p_in[1] = (const float*)d_in[3];
  p.norm_ff1 = (const float*)d_in[4]; p.ff1_w1 = (const float*)d_in[5]; p.ff1_w3 = (const float*)d_in[6];
  p.ff1_w2 = (const float*)d_in[7]; p.norm_mix = (const float*)d_in[8]; p.w_in = (const float*)d_in[9];
  p.mla_q_norm = (const float*)d_in[10]; p.mla_kv_norm = (const float*)d_in[11]; p.mla_w_uq = (const float*)d_in[12];
  p.mla_w_ukv = (const float*)d_in[13]; p.diff_lambda = (const float*)d_in[14]; p.diff_subln = (const float*)d_in[15];
  p.dn_conv = (const float*)d_in[16]; p.dn_a_log = (const float*)d_in[17]; p.dn_dt_bias = (const float*)d_in[18];
  p.dn_out_norm = (const float*)d_in[19]; p.w_branch = (const float*)d_in[20]; p.w_gate = (const float*)d_in[21];
  p.w_out = (const float*)d_in[22]; p.norm_ff2 = (const float*)d_in[23]; p.ff2_w1 = (const float*)d_in[24];
  p.ff2_w3 = (const float*)d_in[25]; p.ff2_w2 = (const float*)d_in[26]; p.norm_ple = (const float*)d_in[27];
  p.ple_gate = (const float*)d_in[28]; p.ple_proj = (const float*)d_in[29]; p.norm_final = (const float*)d_in[30];
  p.x = (float*)d_out;
  p.ws = (char*)d_ws;
  p.big_ws = (ws_size >= WS_BIG) ? 1 : 0;
  static int grid_blocks = 0;
  if (!grid_blocks) {
    int dev = 0, cus = 0, per_cu = 0;
    hipGetDevice(&dev);
    hipDeviceGetAttribute(&cus, hipDeviceAttributeMultiprocessorCount, dev);
    hipFuncSetAttribute((const void*)mega, hipFuncAttributeMaxDynamicSharedMemorySize, (int)LDS_BYTES);
    hipOccupancyMaxActiveBlocksPerMultiprocessor(&per_cu, mega, 256, LDS_BYTES);
    if (per_cu < 1) per_cu = 1;
    grid_blocks = cus * per_cu;
  }
  if (ws_size < WS_NEED) {
    fprintf(stderr, "workspace too small: %zu < %zu\n", ws_size, (size_t)WS_NEED);
    return;
  }
  (void)hipMemsetAsync((char*)d_ws + OFF_BAR, 0, XCD_BAR_WORDS * 4, stream);
  void* args[] = {&p};
  hipError_t e = hipLaunchCooperativeKernel((void*)mega, dim3(grid_blocks), dim3(256), args, LDS_BYTES, stream);
  if (e != hipSuccess) fprintf(stderr, "cooperative launch failed: %s (grid %d)\n", hipGetErrorString(e), grid_blocks);
}
```

```cpp
#include <hip/hip_runtime.h>
#include <hip/hip_cooperative_groups.h>
#include <stdint.h>
#include <stdio.h>
namespace cg = cooperative_groups;

typedef unsigned short bf16_t;
using bf16x8 = __attribute__((ext_vector_type(8))) short;
using bf16x4 = __attribute__((ext_vector_type(4))) short;
using f32x16 = __attribute__((ext_vector_type(16))) float;
using f32x4 = __attribute__((ext_vector_type(4))) float;
using u32x4 = __attribute__((ext_vector_type(4))) unsigned;
using u32x2 = __attribute__((ext_vector_type(2))) unsigned;

#define DI __device__ __forceinline__
#define MFMA32(a, b, c) __builtin_amdgcn_mfma_f32_32x32x16_bf16((a), (b), (c), 0, 0, 0)
#define MFMA16(a, b, c) __builtin_amdgcn_mfma_f32_16x16x32_bf16((a), (b), (c), 0, 0, 0)

constexpr int TG = 32768;
constexpr int NPR = 4608;
constexpr float EPS = 1e-6f;
constexpr float LOG2E = 1.4426950408889634f;
constexpr float DEFER_THR = 8.f;
constexpr int C_CQ = 0, C_CKV = 256, C_BQ = 384, C_BK = 640, C_BV = 896, C_DNQKV = 1152, C_Z = 1920,
              C_DQ = 2176, C_DK = 2944, C_DV = 3712;
constexpr size_t MiB = 1048576;
constexpr size_t OFF_WB = 0, OFF_TAB = 57 * MiB, OFF_CNT = 63 * MiB, OFF_N = 64 * MiB, OFF_PR = 128 * MiB,
                 OFF_Q = 416 * MiB, OFF_K = 440 * MiB, OFF_V = 464 * MiB, OFF_AB = 480 * MiB, OFF_OD = 482 * MiB,
                 OFF_LSE = 530 * MiB, OFF_OF = 532 * MiB, OFF_OB = 548 * MiB, WS_NEED = 564 * MiB;
constexpr size_t W_FF1_1 = 0, W_FF1_3 = 2883584, W_FF1_2 = 5767168, W_IN = 8650752, W_UQ = 13369344,
                 W_UKV = 13467648, W_G = 13533184, W_B = 17727488, W_O = 18776064, W_FF2_1 = 19824640,
                 W_FF2_3 = 22708224, W_FF2_2 = 25591808, W_PG = 28475392, W_PP = 29523968;
constexpr size_t LDS_BYTES = 78336;

struct Params {
  const float* x_in[2];
  const float* p_in[2];
  const float *norm_ff1, *ff1_w1, *ff1_w3, *ff1_w2, *norm_mix, *w_in, *mla_q_norm, *mla_kv_norm, *mla_w_uq,
      *mla_w_ukv, *diff_lambda, *diff_subln, *dn_conv, *dn_a_log, *dn_dt_bias, *dn_out_norm, *w_branch, *w_gate,
      *w_out, *norm_ff2, *ff2_w1, *ff2_w3, *ff2_w2, *norm_ple, *ple_gate, *ple_proj, *norm_final;
  float* x;
  char* ws;
  long long big_ws;
};

typedef const __attribute__((address_space(4))) Params CParams;
DI CParams* launder(CParams* q) { asm volatile("" : "+s"(q)); return q; }

typedef __bf16 bf2_t __attribute__((ext_vector_type(2)));
typedef float f2_t __attribute__((ext_vector_type(2)));
DI bf16_t f2bf(float x) { return __builtin_bit_cast(bf16_t, (__bf16)x); }
DI float bf2f(bf16_t b) { return __uint_as_float(((unsigned)b) << 16); }
DI unsigned pack2(float a, float b) { f2_t v = {a, b}; return __builtin_bit_cast(unsigned, __builtin_convertvector(v, bf2_t)); }
DI float wave_sum(float v) {
#pragma unroll
  for (int o = 32; o > 0; o >>= 1) v += __shfl_xor(v, o);
  return v;
}
DI float sigmoidf_(float x) { return __builtin_amdgcn_rcpf(1.f + __expf(-x)); }
DI float siluf_(float x) { return x * __builtin_amdgcn_rcpf(1.f + __expf(-x)); }
DI float exp2_(float x) { return __builtin_amdgcn_exp2f(x); }
DI int opq() { int z; asm volatile("v_mov_b32 %0, 0" : "=v"(z)); return z; }
DI float xhalf_max(float v) {
  const auto r = __builtin_amdgcn_permlane32_swap(__float_as_uint(v), __float_as_uint(v), false, false);
  return fmaxf(__uint_as_float(r[0]), __uint_as_float(r[1]));
}
DI int crow(int r, int h2) { return (r & 3) + 8 * (r >> 2) + 4 * h2; }
DI bf16x8 pack8(float a0, float a1, float a2, float a3, float a4, float a5, float a6, float a7) {
  u32x4 u;
  u.x = pack2(a0, a1); u.y = pack2(a2, a3); u.z = pack2(a4, a5); u.w = pack2(a6, a7);
  return __builtin_bit_cast(bf16x8, u);
}
DI bf16x8 ld2x4(const bf16_t* p0, const bf16_t* p1) {
  u32x2 a = *(const u32x2*)p0, b = *(const u32x2*)p1;
  u32x4 u; u.x = a.x; u.y = a.y; u.z = b.x; u.w = b.y;
  return __builtin_bit_cast(bf16x8, u);
}
DI void store8bf(bf16_t* dst, const float* v) {
  u32x4 u; u.x = pack2(v[0], v[1]); u.y = pack2(v[2], v[3]); u.z = pack2(v[4], v[5]); u.w = pack2(v[6], v[7]);
  *(u32x4*)dst = u;
}

struct MatDesc { const float* src; bf16_t* dst; int K, ldsrc, Ndst, map; const float* rowscale; int frag; };

DI int map_col(int map, int n) {
  if (map == 0) return n;
  if (map == 1) {
    if (n < 384) return n;
    if (n < 1920) return n + 32;
    if (n < 4480) return n + 48;
    if (n < 4512) return n - 4480 + 384;
    if (n < 4528) return n - 4512 + 1952;
    return -1;
  }
  if (n < 256) return (n >> 6) * 96 + (n & 63);
  return ((n - 256) >> 5) * 96 + 64 + ((n - 256) & 31);
}

DI MatDesc get_mat(CParams& p, int l, int id) {
  bf16_t* wb = (bf16_t*)(p.ws + OFF_WB);
  MatDesc d; d.map = 0; d.rowscale = nullptr; d.frag = (id == 2 || id == 14 || id == 17) ? 1 : 0;
  const size_t FF = (size_t)1024 * 2816;
  switch (id) {
    case 0: d.src = p.ff1_w1 + l * FF; d.dst = wb + W_FF1_1; d.K = 1024; d.ldsrc = 2816; d.Ndst = 2816; break;
    case 1: d.src = p.ff1_w3 + l * FF; d.dst = wb + W_FF1_3; d.K = 1024; d.ldsrc = 2816; d.Ndst = 2816; break;
    case 2: d.src = p.ff1_w2 + l * FF; d.dst = wb + W_FF1_2; d.K = 2816; d.ldsrc = 1024; d.Ndst = 1024; break;
    case 3: d.src = p.w_in + (size_t)l * 1024 * 4528; d.dst = wb + W_IN; d.K = 1024; d.ldsrc = 4528; d.Ndst = 4608; d.map = 1; break;
    case 4: d.src = p.mla_w_uq + (size_t)l * 256 * 384; d.dst = wb + W_UQ; d.K = 256; d.ldsrc = 384; d.Ndst = 384; d.map = 2; d.rowscale = p.mla_q_norm + l * 256; break;
    case 5: d.src = p.mla_w_ukv + (size_t)l * 128 * 512; d.dst = wb + W_UKV; d.K = 128; d.ldsrc = 512; d.Ndst = 512; d.rowscale = p.mla_kv_norm + l * 128; break;
    case 6: case 7: case 8: case 9:
      d.src = p.w_gate + (size_t)(l * 4 + id - 6) * 1048576; d.dst = wb + W_G + (size_t)(id - 6) * 1048576; d.K = 1024; d.ldsrc = 1024; d.Ndst = 1024; break;
    case 10: case 11: case 12: case 13:
      d.src = p.w_branch + (size_t)(l * 4 + id - 10) * 262144; d.dst = wb + W_B + (size_t)(id - 10) * 262144; d.K = 256; d.ldsrc = 1024; d.Ndst = 1024; break;
    case 14: d.src = p.w_out + (size_t)l * 1048576; d.dst = wb + W_O; d.K = 1024; d.ldsrc = 1024; d.Ndst = 1024; break;
    case 15: d.src = p.ff2_w1 + l * FF; d.dst = wb + W_FF2_1; d.K = 1024; d.ldsrc = 2816; d.Ndst = 2816; break;
    case 16: d.src = p.ff2_w3 + l * FF; d.dst = wb + W_FF2_3; d.K = 1024; d.ldsrc = 2816; d.Ndst = 2816; break;
    case 17: d.src = p.ff2_w2 + l * FF; d.dst = wb + W_FF2_2; d.K = 2816; d.ldsrc = 1024; d.Ndst = 1024; break;
    case 18: d.src = p.ple_gate + (size_t)l * 1048576; d.dst = wb + W_PG; d.K = 1024; d.ldsrc = 1024; d.Ndst = 1024; break;
    default: d.src = p.ple_proj + (size_t)l * 262144; d.dst = wb + W_PP; d.K = 256; d.ldsrc = 1024; d.Ndst = 1024; break;
  }
  return d;
}

DI void phase_convert(CParams& p, int l, char* lds) {
  float* T = (float*)lds;
  const int tid = threadIdx.x + opq();
  for (int id = 0; id < 20; ++id) {
    MatDesc d = get_mat(p, l, id);
    const int nkt = d.K >> 6, nnt = d.Ndst >> 6, nt_all = nkt * nnt;
    for (int t = blockIdx.x; t < nt_all; t += gridDim.x) {
      const int kt = t / nnt, nt = t % nnt;
      __syncthreads();
      {
        const int nl = tid & 63;
        const int sc = map_col(d.map, nt * 64 + nl);
#pragma unroll 4
        for (int i = 0; i < 16; ++i) {
          const int kl = (tid >> 6) + 4 * i;
          const int k = kt * 64 + kl;
          float v = 0.f;
          if (sc >= 0) v = d.src[(size_t)k * d.ldsrc + sc];
          if (d.rowscale) v *= d.rowscale[k];
          T[kl * 65 + nl] = v;
        }
      }
      __syncthreads();
      if (d.frag) {
#pragma unroll
        for (int i = 0; i < 2; ++i) {
          const int ci = tid + 256 * i, nl = ci & 63, c8 = ci >> 6;
          float v[8];
#pragma unroll
          for (int e = 0; e < 8; ++e) v[e] = T[(8 * c8 + e) * 65 + nl];
          const int n = nt * 64 + nl, k = kt * 64 + 8 * c8;
          const size_t off = (((size_t)(n >> 5) * (d.K >> 4) + (k >> 4)) * 64 + ((k >> 3) & 1) * 32 + (n & 31)) * 8;
          store8bf(d.dst + off, v);
        }
      } else {
        const int kl = tid & 63;
#pragma unroll 4
        for (int i = 0; i < 16; ++i) {
          const int nl = (tid >> 6) + 4 * i;
          d.dst[(size_t)(nt * 64 + nl) * d.K + kt * 64 + kl] = f2bf(T[kl * 65 + nl]);
        }
      }
    }
  }
}

DI void phase_init(CParams& p, char* lds) {
  const size_t gtid = (size_t)blockIdx.x * 256 + threadIdx.x + opq(), gn = (size_t)gridDim.x * 256;
  {
    float2* t32 = (float2*)(p.ws + OFF_TAB);
    float2* t64 = (float2*)(p.ws + OFF_TAB + 2 * MiB);
    for (size_t i = gtid; i < (size_t)16384 * 48; i += gn) {
      const int pos = (int)(i / 48), f = (int)(i % 48);
      float inv;
      if (f < 16) inv = exp2f(-(float)f * (13.287712379549449f / 16.f));
      else inv = exp2f(-(float)(f - 16) * (13.287712379549449f / 32.f));
      const float ang = (float)pos * inv;
      const double xd = (double)ang;
      const double n = rint(xd * 0.15915494309189535);
      const float rf = (float)(xd - n * 6.283185307179586);
      float2 cs; cs.x = __cosf(rf); cs.y = __sinf(rf);
      if (f < 16) t32[(size_t)pos * 16 + f] = cs; else t64[(size_t)pos * 32 + (f - 16)] = cs;
    }
  }
  if (blockIdx.x == 0) ((int*)(p.ws + OFF_CNT))[threadIdx.x] = 0;
  phase_convert(p, 0, lds);
}

DI void phase_norm(const float* __restrict__ x, const float* __restrict__ g, bf16_t* __restrict__ dst,
                           const float* __restrict__ psrc, bf16_t* __restrict__ pdst) {
  const int tidq = threadIdx.x + opq(); const int wave = tidq >> 6, lane = tidq & 63;
  for (int r = blockIdx.x * 4 + wave; r < TG; r += gridDim.x * 4) {
    const float4* xr = (const float4*)(x + (size_t)r * 1024);
    float4 v[4];
    float ss = 0.f;
#pragma unroll
    for (int i = 0; i < 4; ++i) { v[i] = xr[lane + 64 * i]; ss += v[i].x * v[i].x + v[i].y * v[i].y + v[i].z * v[i].z + v[i].w * v[i].w; }
    ss = wave_sum(ss);
    const float rs = rsqrtf(ss * (1.f / 1024.f) + EPS);
#pragma unroll
    for (int i = 0; i < 4; ++i) {
      const float4 gg = ((const float4*)g)[lane + 64 * i];
      u32x2 o; o.x = pack2(v[i].x * rs * gg.x, v[i].y * rs * gg.y); o.y = pack2(v[i].z * rs * gg.z, v[i].w * rs * gg.w);
      ((u32x2*)(dst + (size_t)r * 1024))[lane + 64 * i] = o;
    }
    if (psrc) {
      const float4 pv = ((const float4*)(psrc + (size_t)r * 256))[lane];
      u32x2 o; o.x = pack2(pv.x, pv.y); o.y = pack2(pv.z, pv.w);
      ((u32x2*)(pdst + (size_t)r * 256))[lane] = o;
    }
  }
}

DI void phase_final_norm(float* __restrict__ x, const float* __restrict__ g) {
  const int tidq = threadIdx.x + opq(); const int wave = tidq >> 6, lane = tidq & 63;
  for (int r = blockIdx.x * 4 + wave; r < 2 * TG; r += gridDim.x * 4) {
    float4* xr = (float4*)(x + (size_t)r * 1024);
    float4 v[4];
    float ss = 0.f;
#pragma unroll
    for (int i = 0; i < 4; ++i) { v[i] = xr[lane + 64 * i]; ss += v[i].x * v[i].x + v[i].y * v[i].y + v[i].z * v[i].z + v[i].w * v[i].w; }
    ss = wave_sum(ss);
    const float rs = rsqrtf(ss * (1.f / 1024.f) + EPS);
#pragma unroll
    for (int i = 0; i < 4; ++i) {
      const float4 gg = ((const float4*)g)[lane + 64 * i];
      float4 o; o.x = v[i].x * rs * gg.x; o.y = v[i].y * rs * gg.y; o.z = v[i].z * rs * gg.z; o.w = v[i].w * rs * gg.w;
      xr[lane + 64 * i] = o;
    }
  }
}

template <int NI, int NB, bool SWAP = false>
DI void gemm_main(f32x16 (&acc0)[2][NI], f32x16 (&acc1)[2][NI], const bf16_t* __restrict__ A, int lda,
                  const bf16_t* __restrict__ B0, const bf16_t* __restrict__ B1, int ldb, int K, char* lds) {
  const int tid = threadIdx.x + opq(), lane = tid & 63, w = tid >> 6, wm = w >> 1, wn = w & 1, l31 = lane & 31, h2 = lane >> 5;
  bf16_t* As = (bf16_t*)lds;
  bf16_t* B0s = As + 128 * 72;
  bf16_t* B1s = B0s + 64 * NI * 72;
  const int lr = tid >> 3, lc = (tid & 7) * 8;
  u32x4 ra[4], rb0[2 * NI], rb1[2 * NI];
  const char* Ab = (const char*)A;
  const char* B0b = (const char*)B0;
  const char* B1b = (NB == 2) ? (const char*)B1 : (const char*)B0;
  const unsigned aoff = (unsigned)(lr * lda + lc) * 2u, boff = (unsigned)(lr * ldb + lc) * 2u;
  const unsigned astep = (unsigned)(32 * lda) * 2u, bstep = (unsigned)(32 * ldb) * 2u;
#pragma unroll
  for (int i = 0; i < 4; ++i) ra[i] = *(const u32x4*)(Ab + (aoff + astep * i));
#pragma unroll
  for (int i = 0; i < 2 * NI; ++i) {
    rb0[i] = *(const u32x4*)(B0b + (boff + bstep * i));
    if (NB == 2) rb1[i] = *(const u32x4*)(B1b + (boff + bstep * i));
  }
  for (int k0 = 0; k0 < K; k0 += 64) {
    __syncthreads();
#pragma unroll
    for (int i = 0; i < 4; ++i) *(u32x4*)(As + (lr + 32 * i) * 72 + lc) = ra[i];
#pragma unroll
    for (int i = 0; i < 2 * NI; ++i) {
      *(u32x4*)(B0s + (lr + 32 * i) * 72 + lc) = rb0[i];
      if (NB == 2) *(u32x4*)(B1s + (lr + 32 * i) * 72 + lc) = rb1[i];
    }
    if (k0 + 64 < K) {
      const unsigned kb = (unsigned)(k0 + 64) * 2u;
#pragma unroll
      for (int i = 0; i < 4; ++i) ra[i] = *(const u32x4*)(Ab + (aoff + astep * i + kb));
#pragma unroll
      for (int i = 0; i < 2 * NI; ++i) {
        rb0[i] = *(const u32x4*)(B0b + (boff + bstep * i + kb));
        if (NB == 2) rb1[i] = *(const u32x4*)(B1b + (boff + bstep * i + kb));
      }
    }
    __syncthreads();
    __builtin_amdgcn_s_setprio(1);
#pragma unroll
    for (int ks = 0; ks < 4; ++ks) {
      bf16x8 af[2], bf0[NI], bf1[NI];
#pragma unroll
      for (int mi = 0; mi < 2; ++mi) af[mi] = *(const bf16x8*)(As + (64 * wm + 32 * mi + l31) * 72 + 16 * ks + 8 * h2);
#pragma unroll
      for (int ni = 0; ni < NI; ++ni) {
        bf0[ni] = *(const bf16x8*)(B0s + (32 * NI * wn + 32 * ni + l31) * 72 + 16 * ks + 8 * h2);
        if (NB == 2) bf1[ni] = *(const bf16x8*)(B1s + (32 * NI * wn + 32 * ni + l31) * 72 + 16 * ks + 8 * h2);
      }
#pragma unroll
      for (int mi = 0; mi < 2; ++mi)
#pragma unroll
        for (int ni = 0; ni < NI; ++ni) {
          acc0[mi][ni] = SWAP ? MFMA32(bf0[ni], af[mi], acc0[mi][ni]) : MFMA32(af[mi], bf0[ni], acc0[mi][ni]);
          if (NB == 2) acc1[mi][ni] = SWAP ? MFMA32(bf1[ni], af[mi], acc1[mi][ni]) : MFMA32(af[mi], bf1[ni], acc1[mi][ni]);
        }
    }
    __builtin_amdgcn_s_setprio(0);
  }
}

DI void gemm_main_bd(f32x16 (&acc)[4][2], const bf16_t* __restrict__ A, int lda, const bf16_t* __restrict__ Bf, int n0,
                     int K, char* lds) {
  const int tid = threadIdx.x + opq(), lane = tid & 63, w = tid >> 6, l31 = lane & 31, h2 = lane >> 5;
  bf16_t* As0 = (bf16_t*)lds;
  const int lr = tid >> 3, lc = (tid & 7) * 8;
  const int KS = K >> 4, nsteps = K >> 6;
  u32x4 ra[4];
  const char* Ab = (const char*)A;
  const unsigned aoff = (unsigned)(lr * lda + lc) * 2u, astep = (unsigned)(32 * lda) * 2u;
  const int wu = __builtin_amdgcn_readfirstlane(w);
  const char* Bb0 = (const char*)(Bf + ((size_t)((n0 >> 5) + 2 * wu) * KS) * 512);
  const char* Bb1 = Bb0 + (size_t)KS * 1024;
  const unsigned loff = (unsigned)lane * 16u;
  bf16x8 bc[2][4], bn[2][4];
#pragma unroll
  for (int i = 0; i < 4; ++i) ra[i] = *(const u32x4*)(Ab + (aoff + astep * i));
#pragma unroll
  for (int ks = 0; ks < 4; ++ks) { bn[0][ks] = *(const bf16x8*)(Bb0 + (loff + 1024u * ks)); bn[1][ks] = *(const bf16x8*)(Bb1 + (loff + 1024u * ks)); }
  __syncthreads();
#pragma unroll
  for (int i = 0; i < 4; ++i) *(u32x4*)(As0 + (lr + 32 * i) * 72 + lc) = ra[i];
  if (nsteps > 1) {
#pragma unroll
    for (int i = 0; i < 4; ++i) ra[i] = *(const u32x4*)(Ab + (aoff + astep * i + 128u));
  }
  __syncthreads();
  for (int k = 0; k < nsteps; ++k) {
    const bf16_t* As = As0 + (k & 1) * (128 * 72);
    bf16_t* Aw = As0 + ((k + 1) & 1) * (128 * 72);
#pragma unroll
    for (int ks = 0; ks < 4; ++ks) { bc[0][ks] = bn[0][ks]; bc[1][ks] = bn[1][ks]; }
    if (k + 1 < nsteps) {
#pragma unroll
      for (int ks = 0; ks < 4; ++ks) {
        bn[0][ks] = *(const bf16x8*)(Bb0 + (loff + 1024u * (unsigned)(4 * (k + 1) + ks)));
        bn[1][ks] = *(const bf16x8*)(Bb1 + (loff + 1024u * (unsigned)(4 * (k + 1) + ks)));
      }
#pragma unroll
      for (int i = 0; i < 4; ++i) *(u32x4*)(Aw + (lr + 32 * i) * 72 + lc) = ra[i];
      if (k + 2 < nsteps) {
#pragma unroll
        for (int i = 0; i < 4; ++i) ra[i] = *(const u32x4*)(Ab + (aoff + astep * i + 128u * (unsigned)(k + 2)));
      }
    }
    __builtin_amdgcn_s_setprio(1);
#pragma unroll
    for (int ks = 0; ks < 4; ++ks) {
      bf16x8 af[4];
#pragma unroll
      for (int mi = 0; mi < 4; ++mi) af[mi] = *(const bf16x8*)(As + (32 * mi + l31) * 72 + 16 * ks + 8 * h2);
#pragma unroll
      for (int mi = 0; mi < 4; ++mi)
#pragma unroll
        for (int ni = 0; ni < 2; ++ni) acc[mi][ni] = MFMA32(bc[ni][ks], af[mi], acc[mi][ni]);
    }
    __builtin_amdgcn_s_setprio(0);
    __syncthreads();
  }
}

template <int NI>
DI void zero_acc(f32x16 (&a)[2][NI]) {
#pragma unroll
  for (int mi = 0; mi < 2; ++mi)
#pragma unroll
    for (int ni = 0; ni < NI; ++ni)
#pragma unroll
      for (int r = 0; r < 16; ++r) a[mi][ni][r] = 0.f;
}

#define EPI_VARS const int tid = threadIdx.x + opq(), lane = tid & 63, w = tid >> 6, wm = w >> 1, wn = w & 1, l31 = lane & 31, h2 = lane >> 5; (void)tid; (void)lane; (void)w
#define EPI_BEGIN(NI_) _Pragma("unroll") for (int mi = 0; mi < 2; ++mi) _Pragma("unroll") for (int ni = 0; ni < NI_; ++ni) _Pragma("unroll") for (int r = 0; r < 16; ++r) { \
    const int row = 64 * wm + 32 * mi + crow(r, h2); const int col = 32 * NI_ * wn + 32 * ni + l31;
#define EPI_END }

DI bool xcd_tile(int iter, int MT, int NT, int& mt, int& nt) {
  const int x = blockIdx.x & 7, lb = blockIdx.x >> 3, nb = gridDim.x >> 3;
  if (NT == 8) {
    const int j = lb + iter * nb;
    if (lb >= nb || j >= MT) return false;
    mt = (x & 1) * (MT >> 1) + (j >> 1);
    nt = 2 * (x >> 1) + (j & 1);
    return true;
  }
  const int full = NT >> 3, rem = NT & 7;
  const int per_full = full * MT, rem_tot = rem * MT;
  const int r0 = (rem_tot * x) >> 3, r1 = (rem_tot * (x + 1)) >> 3;
  const int j = lb + iter * nb;
  if (lb >= nb || j >= per_full + (r1 - r0)) return false;
  if (j < per_full) { mt = j / full; nt = x * full + j % full; }
  else { const int u = r0 + (j - per_full); nt = 8 * full + u / MT; mt = u % MT; }
  return true;
}

DI void phase_ffn_a(const bf16_t* __restrict__ Nb, const bf16_t* __restrict__ W1, const bf16_t* __restrict__ W3,
                            bf16_t* __restrict__ H, char* lds) {
  EPI_VARS;
  for (int iter = 0;; ++iter) {
    int mt, nt;
    if (!xcd_tile(iter, 256, 22, mt, nt)) break;
    f32x16 a0[2][2], a1[2][2];
    zero_acc<2>(a0); zero_acc<2>(a1);
    gemm_main<2, 2, true>(a0, a1, Nb + (size_t)mt * 128 * 1024, 1024, W1 + (size_t)nt * 128 * 1024, W3 + (size_t)nt * 128 * 1024, 1024, 1024, lds);
#pragma unroll
    for (int mi = 0; mi < 2; ++mi)
#pragma unroll
      for (int ni = 0; ni < 2; ++ni) {
        bf16_t* hp = H + (size_t)(mt * 128 + 64 * wm + 32 * mi + l31) * 2816 + nt * 128 + 64 * wn + 32 * ni + 4 * h2;
#pragma unroll
        for (int g = 0; g < 4; ++g) {
          u32x2 o;
          o.x = pack2(siluf_(a0[mi][ni][4 * g]) * a1[mi][ni][4 * g], siluf_(a0[mi][ni][4 * g + 1]) * a1[mi][ni][4 * g + 1]);
          o.y = pack2(siluf_(a0[mi][ni][4 * g + 2]) * a1[mi][ni][4 * g + 2], siluf_(a0[mi][ni][4 * g + 3]) * a1[mi][ni][4 * g + 3]);
          *(u32x2*)(hp + 8 * g) = o;
        }
      }
  }
}

DI void phase_gemm_resid(const bf16_t* __restrict__ A, int K, const bf16_t* __restrict__ Bf, const float* xsrc, float* x,
                         float scale, char* lds) {
  const int tid = threadIdx.x + opq(), lane = tid & 63, w = tid >> 6, l31 = lane & 31, h2 = lane >> 5;
  for (int iter = 0;; ++iter) {
    int mt, nt;
    if (!xcd_tile(iter, 256, 4, mt, nt)) break;
    f32x16 a0[4][2];
#pragma unroll
    for (int mi = 0; mi < 4; ++mi)
#pragma unroll
      for (int ni = 0; ni < 2; ++ni)
#pragma unroll
        for (int r = 0; r < 16; ++r) a0[mi][ni][r] = 0.f;
    gemm_main_bd(a0, A + (size_t)mt * 128 * K, K, Bf, nt * 256, K, lds);
#pragma unroll
    for (int mi = 0; mi < 4; ++mi)
#pragma unroll
      for (int ni = 0; ni < 2; ++ni) {
        float4 xs[4];
        const size_t base = (size_t)(mt * 128 + 32 * mi + l31) * 1024 + nt * 256 + 64 * w + 32 * ni + 4 * h2;
#pragma unroll
        for (int g = 0; g < 4; ++g) xs[g] = *(const float4*)(xsrc + base + 8 * g);
#pragma unroll
        for (int g = 0; g < 4; ++g) {
          float4 o;
          o.x = xs[g].x + scale * a0[mi][ni][4 * g];
          o.y = xs[g].y + scale * a0[mi][ni][4 * g + 1];
          o.z = xs[g].z + scale * a0[mi][ni][4 * g + 2];
          o.w = xs[g].w + scale * a0[mi][ni][4 * g + 3];
          *(float4*)(x + base + 8 * g) = o;
        }
      }
  }
}

DI void phase_ple(const bf16_t* __restrict__ Nb, const bf16_t* __restrict__ PB, const bf16_t* __restrict__ PG,
                          const bf16_t* __restrict__ PP, float* __restrict__ x, char* lds) {
  EPI_VARS;
  for (int iter = 0;; ++iter) {
    int mt, nt;
    if (!xcd_tile(iter, 256, 8, mt, nt)) break;
    f32x16 a0[2][2], a1[2][2];
    zero_acc<2>(a0); zero_acc<2>(a1);
    gemm_main<2, 1, true>(a0, a0, Nb + (size_t)mt * 128 * 1024, 1024, PG + (size_t)nt * 128 * 1024, nullptr, 1024, 1024, lds);
    gemm_main<2, 1, true>(a1, a1, PB + (size_t)mt * 128 * 256, 256, PP + (size_t)nt * 128 * 256, nullptr, 256, 256, lds);
#pragma unroll
    for (int mi = 0; mi < 2; ++mi)
#pragma unroll
      for (int ni = 0; ni < 2; ++ni) {
        float* xp = x + (size_t)(mt * 128 + 64 * wm + 32 * mi + l31) * 1024 + nt * 128 + 64 * wn + 32 * ni + 4 * h2;
        float4 xs[4];
#pragma unroll
        for (int g = 0; g < 4; ++g) xs[g] = *(const float4*)(xp + 8 * g);
#pragma unroll
        for (int g = 0; g < 4; ++g) {
          float4 o;
          o.x = xs[g].x + sigmoidf_(a0[mi][ni][4 * g]) * a1[mi][ni][4 * g];
          o.y = xs[g].y + sigmoidf_(a0[mi][ni][4 * g + 1]) * a1[mi][ni][4 * g + 1];
          o.z = xs[g].z + sigmoidf_(a0[mi][ni][4 * g + 2]) * a1[mi][ni][4 * g + 2];
          o.w = xs[g].w + sigmoidf_(a0[mi][ni][4 * g + 3]) * a1[mi][ni][4 * g + 3];
          *(float4*)(xp + 8 * g) = o;
        }
      }
  }
}

DI void phase_merge(const bf16_t* __restrict__ Np, const bf16_t* __restrict__ Y, const bf16_t* __restrict__ WG,
                            const bf16_t* __restrict__ WB, bf16_t* __restrict__ M, char* lds) {
  EPI_VARS;
  for (int iter = 0;; ++iter) {
    int mt, nt;
    if (!xcd_tile(iter, 256, 8, mt, nt)) break;
    f32x16 am[2][2];
    zero_acc<2>(am);
#pragma unroll 1
    for (int n = 0; n < 4; ++n) {
      unsigned sg[2][2][8];
      {
        f32x16 ag[2][2];
        zero_acc<2>(ag);
        gemm_main<2, 1, true>(ag, ag, Np + (size_t)mt * 128 * 1024, 1024, WG + (size_t)n * 1048576 + (size_t)nt * 128 * 1024, nullptr, 1024, 1024, lds);
#pragma unroll
        for (int mi = 0; mi < 2; ++mi)
#pragma unroll
          for (int ni = 0; ni < 2; ++ni)
#pragma unroll
            for (int r = 0; r < 8; ++r) sg[mi][ni][r] = pack2(sigmoidf_(ag[mi][ni][2 * r]), sigmoidf_(ag[mi][ni][2 * r + 1]));
      }
      f32x16 ab[2][2];
      zero_acc<2>(ab);
      gemm_main<2, 1, true>(ab, ab, Y + (size_t)mt * 128 * 1024 + n * 256, 1024, WB + (size_t)n * 262144 + (size_t)nt * 128 * 256, nullptr, 256, 256, lds);
#pragma unroll
      for (int mi = 0; mi < 2; ++mi)
#pragma unroll
        for (int ni = 0; ni < 2; ++ni)
#pragma unroll
          for (int r = 0; r < 8; ++r) {
            am[mi][ni][2 * r] += __uint_as_float(sg[mi][ni][r] << 16) * ab[mi][ni][2 * r];
            am[mi][ni][2 * r + 1] += __uint_as_float(sg[mi][ni][r] & 0xffff0000u) * ab[mi][ni][2 * r + 1];
          }
    }
#pragma unroll
    for (int mi = 0; mi < 2; ++mi)
#pragma unroll
      for (int ni = 0; ni < 2; ++ni) {
        bf16_t* mp = M + (size_t)(mt * 128 + 64 * wm + 32 * mi + l31) * 1024 + nt * 128 + 64 * wn + 32 * ni + 4 * h2;
#pragma unroll
        for (int g = 0; g < 4; ++g) {
          u32x2 o;
          o.x = pack2(am[mi][ni][4 * g], am[mi][ni][4 * g + 1]);
          o.y = pack2(am[mi][ni][4 * g + 2], am[mi][ni][4 * g + 3]);
          *(u32x2*)(mp + 8 * g) = o;
        }
      }
  }
}

DI void rope32_out(const float* c, const float2* tab, float sc, float* o) {
#pragma unroll
  for (int i = 0; i < 16; ++i) {
    const float2 cs = tab[i];
    const float a = c[i], b = c[16 + i];
    o[i] = (a * cs.x - b * cs.y) * sc;
    o[16 + i] = (b * cs.x + a * cs.y) * sc;
  }
}

DI void phase_proj(CParams& p, const bf16_t* __restrict__ Nb, const bf16_t* __restrict__ WIN, int S, char* lds) {
  EPI_VARS;
  bf16_t* PR = (bf16_t*)(p.ws + OFF_PR);
  float* AB = (float*)(p.ws + OFF_AB);
  const float2* t32 = (const float2*)(p.ws + OFF_TAB);
  const float2* t64 = (const float2*)(p.ws + OFF_TAB + 2 * MiB);
  float* Ct = (float*)lds;
  for (int iter = 0;; ++iter) {
    int mt, nt2;
    if (!xcd_tile(iter, 256, 18, mt, nt2)) break;
    f32x16 a0[2][4];
    zero_acc<4>(a0);
    gemm_main<4, 1>(a0, a0, Nb + (size_t)mt * 128 * 1024, 1024, WIN + (size_t)nt2 * 256 * 1024, nullptr, 1024, 1024, lds);
   for (int hv = 0; hv < 2; ++hv) {
    const int nt = 2 * nt2 + hv;
    __syncthreads();
    if (wn == hv) {
#pragma unroll
      for (int mi = 0; mi < 2; ++mi)
#pragma unroll
        for (int ni = 0; ni < 4; ++ni)
#pragma unroll
          for (int r = 0; r < 16; ++r) Ct[(64 * wm + 32 * mi + crow(r, h2)) * 132 + 32 * ni + l31] = a0[mi][ni][r];
    }
    __syncthreads();
    const int erow = tid >> 1, half = tid & 1;
    const int tok = mt * 128 + erow, pos = tok & (S - 1);
    const float* cr = Ct + erow * 132 + 64 * half;
    bf16_t* dst = PR + (size_t)tok * NPR + nt * 128 + 64 * half;
    int type = 0; float sc = 1.f;
    if (nt == 3 || nt == 4) { type = 1; sc = 0.17677669529663687f * LOG2E; }
    else if (nt == 5 || nt == 6) { type = 1; }
    else if (nt >= 17 && nt <= 22) { type = 2; sc = 0.125f * LOG2E; }
    else if (nt >= 23 && nt <= 28) { type = 2; }
    else if (nt == 35) type = 3;
    if (type == 0) {
#pragma unroll
      for (int j = 0; j < 8; ++j) store8bf(dst + 8 * j, cr + 8 * j);
    } else if (type == 1) {
#pragma unroll
      for (int hh = 0; hh < 2; ++hh) {
        float o[32];
        rope32_out(cr + 32 * hh, t32 + (size_t)pos * 16, sc, o);
#pragma unroll
        for (int j = 0; j < 4; ++j) store8bf(dst + 32 * hh + 8 * j, o + 8 * j);
      }
    } else if (type == 2) {
      const float2* tab = t64 + (size_t)pos * 32;
#pragma unroll
      for (int j = 0; j < 4; ++j) {
        float lo[8], hi[8];
#pragma unroll
        for (int e = 0; e < 8; ++e) {
          const float2 cs = tab[8 * j + e];
          const float a = cr[8 * j + e], b = cr[32 + 8 * j + e];
          lo[e] = (a * cs.x - b * cs.y) * sc;
          hi[e] = (b * cs.x + a * cs.y) * sc;
        }
        store8bf(dst + 8 * j, lo);
        store8bf(dst + 32 + 8 * j, hi);
      }
    } else {
      if (half == 0) {
        float o[32];
        rope32_out(cr, t32 + (size_t)pos * 16, 1.f, o);
#pragma unroll
        for (int j = 0; j < 4; ++j) store8bf(dst + 8 * j, o + 8 * j);
      } else {
        const float* c2 = Ct + erow * 132 + 32;
#pragma unroll
        for (int j = 0; j < 4; ++j) {
          float4 v; v.x = c2[4 * j]; v.y = c2[4 * j + 1]; v.z = c2[4 * j + 2]; v.w = c2[4 * j + 3];
          ((float4*)(AB + (size_t)tok * 16))[j] = v;
        }
      }
    }
   }
  }
}

DI void mla_up_tile(CParams& p, int mt, int j, int S, char* lds) {
  EPI_VARS;
  const bf16_t* PR = (const bf16_t*)(p.ws + OFF_PR);
  const bf16_t* wb = (const bf16_t*)(p.ws + OFF_WB);
  bf16_t* Qb = (bf16_t*)(p.ws + OFF_Q);
  bf16_t* Kb = (bf16_t*)(p.ws + OFF_K);
  bf16_t* Vb = (bf16_t*)(p.ws + OFF_V);
  const float2* t32 = (const float2*)(p.ws + OFF_TAB);
  float* Ct = (float*)lds;
  float* rst = (float*)(lds + 67584);
  const bool isq = j < 3;
  const int K = isq ? 256 : 128;
  const int nt = isq ? j : j - 3;
  const bf16_t* A = PR + (size_t)mt * 128 * NPR + (isq ? C_CQ : C_CKV);
  const bf16_t* B = wb + (isq ? W_UQ : W_UKV) + (size_t)nt * 128 * K;
  const int erow = tid >> 1, half = tid & 1;
  {
    const bf16_t* ar = A + (size_t)erow * NPR + half * (K / 2);
    float ss = 0.f;
    for (int c = 0; c < K / 16; ++c) {
      const u32x4 u = *(const u32x4*)(ar + 8 * c);
      const unsigned uu[4] = {u.x, u.y, u.z, u.w};
#pragma unroll
      for (int e = 0; e < 4; ++e) {
        const float lo = __uint_as_float(uu[e] << 16), hi = __uint_as_float(uu[e] & 0xffff0000u);
        ss += lo * lo + hi * hi;
      }
    }
    ss += __shfl_xor(ss, 1);
    if (half == 0) rst[erow] = rsqrtf(ss / (float)K + EPS);
  }
  f32x16 a0[2][2];
  zero_acc<2>(a0);
  gemm_main<2, 1>(a0, a0, A, NPR, B, nullptr, K, K, lds);
  __syncthreads();
  EPI_BEGIN(2)
    Ct[row * 132 + col] = a0[mi][ni][r];
  EPI_END
  __syncthreads();
  const int tok = mt * 128 + erow, pos = tok & (S - 1);
  const float rs = rst[erow];
  const float* cr = Ct + erow * 132 + 64 * half;
  if (isq) {
    const float sc = rs * 0.10206207261596577f * LOG2E;
    if (nt < 2) {
      bf16_t* dst = Qb + ((size_t)tok * 4 + 2 * nt + half) * 96;
#pragma unroll
      for (int jj = 0; jj < 8; ++jj) {
        float o[8];
#pragma unroll
        for (int e = 0; e < 8; ++e) o[e] = cr[8 * jj + e] * sc;
        store8bf(dst + 8 * jj, o);
      }
    } else {
#pragma unroll
      for (int hh = 0; hh < 2; ++hh) {
        float o[32];
        rope32_out(cr + 32 * hh, t32 + (size_t)pos * 16, sc, o);
        bf16_t* dst = Qb + ((size_t)tok * 4 + 2 * half + hh) * 96 + 64;
#pragma unroll
        for (int jj = 0; jj < 4; ++jj) store8bf(dst + 8 * jj, o + 8 * jj);
      }
    }
  } else {
    bf16_t* dst = half == 0 ? (Kb + ((size_t)tok * 4 + nt) * 96) : (Vb + ((size_t)tok * 4 + nt) * 64);
#pragma unroll
    for (int jj = 0; jj < 8; ++jj) {
      float o[8];
#pragma unroll
      for (int e = 0; e < 8; ++e) o[e] = cr[8 * jj + e] * rs;
      store8bf(dst + 8 * jj, o);
    }
    if (half == 0) {
      const u32x4* src = (const u32x4*)(PR + (size_t)tok * NPR + 4480);
#pragma unroll
      for (int jj = 0; jj < 4; ++jj) ((u32x4*)(dst + 64))[jj] = src[jj];
    }
  }
}

typedef short s16x4_t __attribute__((ext_vector_type(4)));
DI bf16x8 tr_pair(const bf16_t* p0, const bf16_t* p1) {
  const s16x4_t lo = __builtin_amdgcn_ds_read_tr16_b64_v4i16((__attribute__((address_space(3))) s16x4_t*)p0);
  const s16x4_t hi = __builtin_amdgcn_ds_read_tr16_b64_v4i16((__attribute__((address_space(3))) s16x4_t*)p1);
  return __builtin_shufflevector(lo, hi, 0, 1, 2, 3, 4, 5, 6, 7);
}

template <int DK, bool BAND>
DI void flash_loop(f32x16 (&O)[2], float& m, float& l, const bf16_t* __restrict__ qrow, const bf16_t* __restrict__ kbase,
                   size_t kstride, const bf16_t* __restrict__ vbase, size_t vstride, int ntiles, int tq, int u0, int L,
                   char* lds) {
  const int tid = threadIdx.x + opq(), lane = tid & 63, l31 = lane & 31, h2 = lane >> 5;
  constexpr int KR = DK + 8, KCH = DK / 8, KN = 64 * KCH / 256;
  constexpr int STAGE = 64 * KR * 2 + 64 * 72 * 2;
  bf16x8 qf[DK / 16];
#pragma unroll
  for (int ks = 0; ks < DK / 16; ++ks) qf[ks] = *(const bf16x8*)(qrow + 16 * ks + 8 * h2);
  u32x4 rkA[KN], rvA[2], rkB[KN], rvB[2];
  auto gload = [&](int kt, u32x4 (&rk)[KN], u32x4 (&rv)[2]) {
#pragma unroll
    for (int i = 0; i < KN; ++i) {
      const int ci = tid + 256 * i, row = ci / KCH, c = ci % KCH;
      int rr = u0 + 64 * kt + row;
      if (BAND) rr = min(max(rr, 0), L - 1);
      rk[i] = *(const u32x4*)((const char*)kbase + ((unsigned)rr * (unsigned)(kstride * 2) + (unsigned)c * 16u));
    }
#pragma unroll
    for (int i = 0; i < 2; ++i) {
      const int ci = tid + 256 * i, row = ci >> 3, c = ci & 7;
      int rr = u0 + 64 * kt + row;
      if (BAND) rr = min(max(rr, 0), L - 1);
      rv[i] = *(const u32x4*)((const char*)vbase + ((unsigned)rr * (unsigned)(vstride * 2) + (unsigned)c * 16u));
    }
  };
  auto swrite = [&](int st, const u32x4 (&rk)[KN], const u32x4 (&rv)[2]) {
    bf16_t* Ks = (bf16_t*)(lds + st * STAGE);
    bf16_t* Vs = Ks + 64 * KR;
#pragma unroll
    for (int i = 0; i < KN; ++i) {
      const int ci = tid + 256 * i, row = ci / KCH, c = ci % KCH;
      *(u32x4*)(Ks + row * KR + c * 8) = rk[i];
    }
#pragma unroll
    for (int i = 0; i < 2; ++i) {
      const int ci = tid + 256 * i, row = ci >> 3, c = ci & 7;
      *(u32x4*)(Vs + row * 72 + c * 8) = rv[i];
    }
  };
  const int trq = (lane & 15) >> 2, trp = lane & 3, trblk = (lane >> 4) & 1;
  const int troff = (4 * h2 + trq) * 72 + 16 * trblk + 4 * trp;
  __syncthreads();
  gload(0, rkA, rvA);
  swrite(0, rkA, rvA);
  gload(1, rkA, rvA);
  if (ntiles > 2) gload(2, rkB, rvB);
  for (int kt2 = 0; kt2 < ntiles; kt2 += 2)
#pragma unroll
  for (int par = 0; par < 2; ++par) {
    const int kt = kt2 + par;
    __syncthreads();
    if (par == 0) {
      if (kt + 1 < ntiles) swrite((kt + 1) & 1, rkA, rvA);
      if (kt + 3 < ntiles) gload(kt + 3, rkA, rvA);
    } else {
      if (kt + 1 < ntiles) swrite((kt + 1) & 1, rkB, rvB);
      if (kt + 3 < ntiles) gload(kt + 3, rkB, rvB);
    }
    const bf16_t* Ks = (const bf16_t*)(lds + (kt & 1) * STAGE);
    const bf16_t* Vs = Ks + 64 * KR;
    f32x16 Sx[2];
#pragma unroll
    for (int j = 0; j < 2; ++j)
#pragma unroll
      for (int r = 0; r < 16; ++r) Sx[j][r] = 0.f;
#pragma unroll
    for (int ks = 0; ks < DK / 16; ++ks)
#pragma unroll
      for (int j = 0; j < 2; ++j) {
        const bf16x8 kf = *(const bf16x8*)(Ks + (32 * j + l31) * KR + 16 * ks + 8 * h2);
        Sx[j] = MFMA32(kf, qf[ks], Sx[j]);
      }
    if (BAND) {
#pragma unroll
      for (int j = 0; j < 2; ++j)
#pragma unroll
        for (int r = 0; r < 16; ++r) {
          const int u = u0 + 64 * kt + 32 * j + crow(r, h2);
          const int d = u - tq;
          const bool valid = (d <= 64) && (d >= -64) && (u >= 0) && (u < L);
          Sx[j][r] = valid ? Sx[j][r] : -1e30f;
        }
    }
    float mx = Sx[0][0];
#pragma unroll
    for (int j = 0; j < 2; ++j)
#pragma unroll
      for (int r = 0; r < 16; ++r) mx = fmaxf(mx, Sx[j][r]);
    mx = xhalf_max(mx);
    if (__any(mx - m > DEFER_THR)) {
      const float mn = fmaxf(m, mx);
      const float alpha = exp2_(m - mn);
      m = mn;
      l *= alpha;
#pragma unroll
      for (int t = 0; t < 2; ++t)
#pragma unroll
        for (int r = 0; r < 16; ++r) O[t][r] *= alpha;
    }
    float ls = 0.f;
#pragma unroll
    for (int j = 0; j < 2; ++j)
#pragma unroll
      for (int r = 0; r < 16; ++r) { const float pv = exp2_(Sx[j][r] - m); Sx[j][r] = pv; ls += pv; }
    l += ls;
#pragma unroll
    for (int j = 0; j < 2; ++j)
#pragma unroll
      for (int s = 0; s < 2; ++s) {
        const bf16x8 pf = pack8(Sx[j][8 * s], Sx[j][8 * s + 1], Sx[j][8 * s + 2], Sx[j][8 * s + 3], Sx[j][8 * s + 4],
                                Sx[j][8 * s + 5], Sx[j][8 * s + 6], Sx[j][8 * s + 7]);
#pragma unroll
        for (int t = 0; t < 2; ++t) {
          const bf16_t* vp = Vs + (32 * j + 16 * s) * 72 + 32 * t + troff;
          const bf16x8 vf = tr_pair(vp, vp + 8 * 72);
          O[t] = MFMA32(vf, pf, O[t]);
        }
      }
  }
}

DI void flash_loop_diff(f32x16 (&O0)[2], f32x16 (&O1)[2], float& m0, float& l0, float& m1, float& l1,
                        const bf16_t* __restrict__ qrow, const bf16_t* __restrict__ kbase, size_t kstride,
                        const bf16_t* __restrict__ vbase, size_t vstride, int ntiles, char* lds) {
  const int tid = threadIdx.x + opq(), lane = tid & 63, l31 = lane & 31, h2 = lane >> 5;
  constexpr int KR = 72;
  constexpr int STAGE = 64 * KR * 2 + 64 * 72 * 2;
  bf16x8 qf0[2], qf1[2];
#pragma unroll
  for (int ks = 0; ks < 2; ++ks) {
    qf0[ks] = *(const bf16x8*)(qrow + 16 * ks + 8 * h2);
    qf1[ks] = *(const bf16x8*)(qrow + 32 + 16 * ks + 8 * h2);
  }
  u32x4 rk[2], rv[2];
  auto gload = [&](int kt) {
#pragma unroll
    for (int i = 0; i < 2; ++i) {
      const int ci = tid + 256 * i, row = ci >> 3, c = ci & 7;
      const int rr = 64 * kt + row;
      rk[i] = *(const u32x4*)((const char*)kbase + ((unsigned)rr * (unsigned)(kstride * 2) + (unsigned)c * 16u));
      rv[i] = *(const u32x4*)((const char*)vbase + ((unsigned)rr * (unsigned)(vstride * 2) + (unsigned)c * 16u));
    }
  };
  auto swrite = [&](int st) {
    bf16_t* Ks = (bf16_t*)(lds + st * STAGE);
    bf16_t* Vs = Ks + 64 * KR;
#pragma unroll
    for (int i = 0; i < 2; ++i) {
      const int ci = tid + 256 * i, row = ci >> 3, c = ci & 7;
      *(u32x4*)(Ks + row * KR + c * 8) = rk[i];
      *(u32x4*)(Vs + row * 72 + c * 8) = rv[i];
    }
  };
  const int trq = (lane & 15) >> 2, trp = lane & 3, trblk = (lane >> 4) & 1;
  const int troff = (4 * h2 + trq) * 72 + 16 * trblk + 4 * trp;
  __syncthreads();
  gload(0);
  swrite(0);
  if (ntiles > 1) gload(1);
  for (int kt = 0; kt < ntiles; ++kt) {
    __syncthreads();
    if (kt + 1 < ntiles) swrite((kt + 1) & 1);
    if (kt + 2 < ntiles) gload(kt + 2);
    const bf16_t* Ks = (const bf16_t*)(lds + (kt & 1) * STAGE);
    const bf16_t* Vs = Ks + 64 * KR;
    bf16x8 pf[2][2][2];
#pragma unroll
    for (int mp = 0; mp < 2; ++mp) {
      f32x16 Sx[2];
#pragma unroll
      for (int j = 0; j < 2; ++j)
#pragma unroll
        for (int r = 0; r < 16; ++r) Sx[j][r] = 0.f;
#pragma unroll
      for (int ks = 0; ks < 2; ++ks)
#pragma unroll
        for (int j = 0; j < 2; ++j) {
          const bf16x8 kf = *(const bf16x8*)(Ks + (32 * j + l31) * KR + 32 * mp + 16 * ks + 8 * h2);
          Sx[j] = MFMA32(kf, mp == 0 ? qf0[ks] : qf1[ks], Sx[j]);
        }
      float& m = mp == 0 ? m0 : m1;
      float& l = mp == 0 ? l0 : l1;
      float mx = Sx[0][0];
#pragma unroll
      for (int j = 0; j < 2; ++j)
#pragma unroll
        for (int r = 0; r < 16; ++r) mx = fmaxf(mx, Sx[j][r]);
      mx = xhalf_max(mx);
      if (__any(mx - m > DEFER_THR)) {
        const float mn = fmaxf(m, mx);
        const float alpha = exp2_(m - mn);
        m = mn;
        l *= alpha;
#pragma unroll
        for (int t = 0; t < 2; ++t)
#pragma unroll
          for (int r = 0; r < 16; ++r) { if (mp == 0) O0[t][r] *= alpha; else O1[t][r] *= alpha; }
      }
      float ls = 0.f;
#pragma unroll
      for (int j = 0; j < 2; ++j)
#pragma unroll
        for (int r = 0; r < 16; ++r) { const float pv = exp2_(Sx[j][r] - m); Sx[j][r] = pv; ls += pv; }
      l += ls;
#pragma unroll
      for (int j = 0; j < 2; ++j)
#pragma unroll
        for (int s = 0; s < 2; ++s)
          pf[mp][j][s] = pack8(Sx[j][8 * s], Sx[j][8 * s + 1], Sx[j][8 * s + 2], Sx[j][8 * s + 3], Sx[j][8 * s + 4],
                               Sx[j][8 * s + 5], Sx[j][8 * s + 6], Sx[j][8 * s + 7]);
    }
#pragma unroll
    for (int j = 0; j < 2; ++j)
#pragma unroll
      for (int s = 0; s < 2; ++s)
#pragma unroll
        for (int t = 0; t < 2; ++t) {
          const bf16_t* vp = Vs + (32 * j + 16 * s) * 72 + 32 * t + troff;
          const bf16x8 vf = tr_pair(vp, vp + 8 * 72);
          O0[t] = MFMA32(vf, pf[0][j][s], O0[t]);
          O1[t] = MFMA32(vf, pf[1][j][s], O1[t]);
        }
  }
}

DI void zeroO(f32x16 (&O)[2]) {
#pragma unroll
  for (int t = 0; t < 2; ++t)
#pragma unroll
    for (int r = 0; r < 16; ++r) O[t][r] = 0.f;
}

DI void store_o(bf16_t* dst, const f32x16 (&O)[2], int h2) {
#pragma unroll
  for (int t = 0; t < 2; ++t)
#pragma unroll
    for (int g = 0; g < 4; ++g) {
      u32x2 u; u.x = pack2(O[t][4 * g], O[t][4 * g + 1]); u.y = pack2(O[t][4 * g + 2], O[t][4 * g + 3]);
      *(u32x2*)(dst + 32 * t + 8 * g + 4 * h2) = u;
    }
}

DI void mla_item(CParams& p, int it, int S, char* lds) {
  const int tid = threadIdx.x + opq(), lane = tid & 63, w = tid >> 6, l31 = lane & 31, h2 = lane >> 5;
  const int lgq = (S == 2048) ? 4 : 7;
  const int qb = it & ((1 << lgq) - 1), bh = it >> lgq, h = bh & 3, b = bh >> 2;
  const int tokbase = b * S, gtok = tokbase + 128 * qb + 32 * w + l31;
  const bf16_t* Qb = (const bf16_t*)(p.ws + OFF_Q);
  const bf16_t* Kb = (const bf16_t*)(p.ws + OFF_K);
  const bf16_t* Vb = (const bf16_t*)(p.ws + OFF_V);
  bf16_t* Y = (bf16_t*)(p.ws + OFF_N);
  f32x16 O[2]; zeroO(O);
  float m = -1e30f, l = 0.f;
  flash_loop<96, false>(O, m, l, Qb + ((size_t)gtok * 4 + h) * 96, Kb + ((size_t)tokbase * 4 + h) * 96, 384,
                        Vb + ((size_t)tokbase * 4 + h) * 64, 256, S / 64, 0, 0, 0, lds);
  l += __shfl_xor(l, 32);
  const float il = 1.f / l;
#pragma unroll
  for (int t = 0; t < 2; ++t)
#pragma unroll
    for (int r = 0; r < 16; ++r) O[t][r] *= il;
  store_o(Y + (size_t)gtok * 1024 + h * 64, O, h2);
}

DI void diff_item(CParams& p, int layer, int it, int S, char* lds) {
  const int tid = threadIdx.x + opq(), lane = tid & 63, w = tid >> 6, l31 = lane & 31, h2 = lane >> 5;
  const int lgq = (S == 2048) ? 4 : 7;
  const int qb = it & ((1 << lgq) - 1), bh = it >> lgq, h = bh & 3, b = bh >> 2;
  const int tokbase = b * S, gtok = tokbase + 128 * qb + 32 * w + l31;
  const bf16_t* PR = (const bf16_t*)(p.ws + OFF_PR);
  bf16_t* Y = (bf16_t*)(p.ws + OFF_N);
  const float* lam = p.diff_lambda + layer * 128;
  float s1 = 0.f, s2 = 0.f;
  if (lane < 32) { s1 = lam[lane] * lam[32 + lane]; s2 = lam[64 + lane] * lam[96 + lane]; }
  s1 = wave_sum(s1); s2 = wave_sum(s2);
  const float lambda_init = layer ? 0.35550907f : 0.2f;
  const float lambda_full = expf(s1) - expf(s2) + lambda_init;
  f32x16 of[2], O1[2];
  zeroO(of); zeroO(O1);
  {
    float m0 = -1e30f, l0 = 0.f, m1 = -1e30f, l1 = 0.f;
    flash_loop_diff(of, O1, m0, l0, m1, l1, PR + (size_t)gtok * NPR + C_BQ + (2 * h) * 32,
                    PR + (size_t)tokbase * NPR + C_BK + (2 * h) * 32, NPR, PR + (size_t)tokbase * NPR + C_BV + h * 64, NPR,
                    S / 64, lds);
    l0 += __shfl_xor(l0, 32);
    l1 += __shfl_xor(l1, 32);
    const float c0 = 1.f / l0, c1 = -lambda_full / l1;
#pragma unroll
    for (int t = 0; t < 2; ++t)
#pragma unroll
      for (int r = 0; r < 16; ++r) of[t][r] = c0 * of[t][r] + c1 * O1[t][r];
  }
  float ss = 0.f;
#pragma unroll
  for (int t = 0; t < 2; ++t)
#pragma unroll
    for (int r = 0; r < 16; ++r) ss += of[t][r] * of[t][r];
  ss += __shfl_xor(ss, 32);
  const float rs = rsqrtf(ss * (1.f / 64.f) + EPS) * (1.f - lambda_init);
  const float* sg = p.diff_subln + layer * 64;
#pragma unroll
  for (int t = 0; t < 2; ++t)
#pragma unroll
    for (int r = 0; r < 16; ++r) of[t][r] *= rs * sg[32 * t + crow(r, h2)];
  store_o(Y + (size_t)gtok * 1024 + 256 + h * 64, of, h2);
}

DI void dil_item(CParams& p, int it, int S, int B, char* lds) {
  const int tid = threadIdx.x + opq(), lane = tid & 63, w = tid >> 6, l31 = lane & 31, h2 = lane >> 5;
  const int lgS = (S == 2048) ? 11 : 14, lgB = (B == 16) ? 4 : 1;
  const int rq = it & ((1 << (lgS - 7)) - 1);
  int rest = it >> (lgS - 7);
  const int head = rest & 3; rest >>= 2;
  const int b = rest & (B - 1), g = rest >> lgB;
  const int lgd = 2 * g, dil = 1 << lgd;
  const int L = S >> lgd, lgnqb = lgS - lgd - 7;
  const int res = rq >> lgnqb, qb = rq & ((1 << lgnqb) - 1);
  const int tokbase = b * S;
  const int tq = 128 * qb + 32 * w + l31;
  const int gtok = tokbase + tq * dil + res;
  const bf16_t* PR = (const bf16_t*)(p.ws + OFF_PR);
  bf16_t* OD = (bf16_t*)(p.ws + OFF_OD);
  float* LSE = (float*)(p.ws + OFF_LSE);
  f32x16 O[2]; zeroO(O);
  float m = -1e30f, l = 0.f;
  const int hc = (g * 4 + head) * 64;
  flash_loop<64, true>(O, m, l, PR + (size_t)gtok * NPR + C_DQ + hc, PR + (size_t)(tokbase + res) * NPR + C_DK + hc,
                       (size_t)dil * NPR, PR + (size_t)(tokbase + res) * NPR + C_DV + hc, (size_t)dil * NPR, 4, tq,
                       128 * qb - 64, L, lds);
  l += __shfl_xor(l, 32);
  const float il = 1.f / l;
#pragma unroll
  for (int t = 0; t < 2; ++t)
#pragma unroll
    for (int r = 0; r < 16; ++r) O[t][r] *= il;
  store_o(OD + ((size_t)g * TG + gtok) * 256 + head * 64, O, h2);
  if (h2 == 0) LSE[((size_t)g * TG + gtok) * 4 + head] = m + __log2f(l);
}

constexpr size_t OFF_X2 = 564 * MiB, WS_BIG = 597 * MiB;
#define DN_QK_OFF (p.big_ws ? OFF_X2 : OFF_OD)
#define DN_GC_OFF ((p.big_ws ? OFF_X2 : OFF_OD) + 32 * MiB)
constexpr size_t DN_UW_OFF = OFF_Q;

DI void dn_prep_item(CParams& p, int layer, int it, int S, char* lds) {
  const int tid = threadIdx.x + opq(), lane = tid & 63, w = tid >> 6, l15 = lane & 15, g4 = lane >> 4;
  const int NC = S / 64;
  const int ch = it % NC, bh = it / NC, h = bh & 3, b = bh >> 2;
  const int tokbase = b * S, s0 = ch * 64;
  const bf16_t* PR = (const bf16_t*)(p.ws + OFF_PR);
  const float* AB = (const float*)(p.ws + OFF_AB);
  bf16_t* QKg = (bf16_t*)(p.ws + DN_QK_OFF) + ((size_t)bh * NC + ch) * 8192;
  bf16_t* raw = (bf16_t*)lds;
  float* convw = (float*)(lds + 27200);
  float* RU = (float*)lds;
  float* RW = (float*)(lds + 16384);
  float* Am = (float*)(lds + 32768);
  bf16_t* Kimg = (bf16_t*)(lds + 50176);
  bf16_t* Qimg = (bf16_t*)(lds + 59392);
  float* gcs = (float*)(lds + 68608);
  float* betas = gcs + 128;
  const float* cw = p.dn_conv + (size_t)layer * 5 * 768;
  {
    u32x4 rawreg[7];
    float cwr[4];
#pragma unroll
    for (int k = 0; k < 7; ++k) {
      const int ci = tid + 256 * k;
      const int rr = ci / 24, c = ci % 24, seg = c >> 3, c8 = c & 7;
      const int s = s0 + rr - 2;
      rawreg[k] = u32x4{0u, 0u, 0u, 0u};
      if (ci < 68 * 24 && s >= 0 && s < S)
        rawreg[k] = *(const u32x4*)(PR + (size_t)(tokbase + s) * NPR + C_DNQKV + seg * 256 + h * 64 + c8 * 8);
    }
#pragma unroll
    for (int k = 0; k < 4; ++k) {
      const int i = tid + 256 * k;
      cwr[k] = 0.f;
      if (i < 960) { const int j = i / 192, c = i % 192; cwr[k] = cw[j * 768 + (c >> 6) * 256 + h * 64 + (c & 63)]; }
    }
#pragma unroll
    for (int k = 0; k < 7; ++k) {
      const int ci = tid + 256 * k;
      const int rr = ci / 24, c = ci % 24, seg = c >> 3, c8 = c & 7;
      if (ci < 68 * 24) *(u32x4*)(raw + rr * 200 + seg * 64 + c8 * 8) = rawreg[k];
    }
#pragma unroll
    for (int k = 0; k < 4; ++k) { const int i = tid + 256 * k; if (i < 960) convw[i] = cwr[k]; }
  }
  if (tid < 128) {
    const int d = tid >> 6, pl = tid & 63;
    const int i = d ? 63 - pl : pl;
    const size_t tok = (size_t)tokbase + s0 + i;
    const float Aexp = expf(p.dn_a_log[layer * 8 + d * 4 + h]);
    const float a = AB[tok * 16 + d * 8 + h] + p.dn_dt_bias[layer * 8 + d * 4 + h];
    const float bb = AB[tok * 16 + d * 8 + 4 + h];
    const float sp = fmaxf(a, 0.f) + __logf(1.f + __expf(-fabsf(a)));
    float g = -Aexp * sp;
#pragma unroll
    for (int o = 1; o < 64; o <<= 1) { const float tv = __shfl_up(g, o); if (lane >= o) g += tv; }
    gcs[tid] = g;
    betas[tid] = sigmoidf_(bb);
    float* GC = (float*)(p.ws + DN_GC_OFF) + (((size_t)bh * 2 + d) * NC + ch) * 64;
    GC[pl] = g;
  }
  __syncthreads();
  const int pp = tid >> 2, cgp = tid & 3;
  float kv[16], vv[16];
  {
    float qv[16];
#pragma unroll
    for (int seg = 0; seg < 3; ++seg) {
      float acc[16];
#pragma unroll
      for (int c = 0; c < 16; ++c) acc[c] = 0.f;
#pragma unroll
      for (int j = 0; j < 5; ++j) {
        const bf16_t* rp = raw + (pp + j) * 200 + seg * 64 + 16 * cgp;
        const float* wp = convw + j * 192 + seg * 64 + 16 * cgp;
        const u32x4 u0 = *(const u32x4*)rp, u1 = *(const u32x4*)(rp + 8);
        const unsigned uu[8] = {u0.x, u0.y, u0.z, u0.w, u1.x, u1.y, u1.z, u1.w};
#pragma unroll
        for (int e = 0; e < 8; ++e) {
          acc[2 * e] += wp[2 * e] * __uint_as_float(uu[e] << 16);
          acc[2 * e + 1] += wp[2 * e + 1] * __uint_as_float(uu[e] & 0xffff0000u);
        }
      }
#pragma unroll
      for (int c = 0; c < 16; ++c) {
        const float sv = acc[c] * __builtin_amdgcn_rcpf(1.f + __expf(-acc[c]));
        if (seg == 0) qv[c] = sv; else if (seg == 1) kv[c] = sv; else vv[c] = sv;
      }
    }
    float sq = 0.f, sk = 0.f;
#pragma unroll
    for (int c = 0; c < 16; ++c) { sq += qv[c] * qv[c]; sk += kv[c] * kv[c]; }
    sq += __shfl_xor(sq, 1); sq += __shfl_xor(sq, 2);
    sk += __shfl_xor(sk, 1); sk += __shfl_xor(sk, 2);
    const float rq = rsqrtf(sq + EPS) * 0.125f, rk = rsqrtf(sk + EPS);
#pragma unroll
    for (int c = 0; c < 16; ++c) { qv[c] *= rq; kv[c] *= rk; }
    store8bf(Kimg + pp * 72 + 16 * cgp, kv); store8bf(Kimg + pp * 72 + 16 * cgp + 8, kv + 8);
    store8bf(Qimg + pp * 72 + 16 * cgp, qv); store8bf(Qimg + pp * 72 + 16 * cgp + 8, qv + 8);
    store8bf(QKg + pp * 64 + 16 * cgp, qv); store8bf(QKg + pp * 64 + 16 * cgp + 8, qv + 8);
    store8bf(QKg + 4096 + pp * 64 + 16 * cgp, kv); store8bf(QKg + 4096 + pp * 64 + 16 * cgp + 8, kv + 8);
  }
  for (int d = 0; d < 2; ++d) {
    __syncthreads();
    {
      const int pl = d ? 63 - pp : pp;
      const float bet = betas[d * 64 + pl], egc = __expf(gcs[d * 64 + pl]);
#pragma unroll
      for (int c = 0; c < 16; ++c) {
        RU[pl * 64 + 16 * cgp + c] = vv[c] * bet;
        RW[pl * 64 + 16 * cgp + c] = kv[c] * bet * egc;
      }
    }
    {
      f32x4 KK[4];
#pragma unroll
      for (int t = 0; t < 4; ++t) KK[t] = f32x4{0.f, 0.f, 0.f, 0.f};
      const int jl = 16 * w + l15;
      const int jrow = d ? 63 - jl : jl;
#pragma unroll
      for (int ks = 0; ks < 2; ++ks) {
        const bf16x8 bfk = *(const bf16x8*)(Kimg + jrow * 72 + 32 * ks + 8 * g4);
#pragma unroll
        for (int rt = 0; rt < 4; ++rt) {
          const int il = 16 * rt + l15;
          const int irow = d ? 63 - il : il;
          const bf16x8 afk = *(const bf16x8*)(Kimg + irow * 72 + 32 * ks + 8 * g4);
          KK[rt] = MFMA16(afk, bfk, KK[rt]);
        }
      }
      const float gcj = gcs[d * 64 + jl];
#pragma unroll
      for (int rt = 0; rt < 4; ++rt)
#pragma unroll
        for (int r = 0; r < 4; ++r) {
          const int i = 16 * rt + 4 * g4 + r;
          const float ee = __expf(fminf(gcs[d * 64 + i] - gcj, 0.f));
          Am[i * 68 + jl] = (i > jl) ? betas[d * 64 + i] * KK[rt][r] * ee : 0.f;
        }
    }
    __syncthreads();
    float xs[32];
#pragma unroll
    for (int q = 0; q < 32; ++q) xs[q] = 0.f;
    const int c = tid >> 1, half = tid & 1;
    {
      const float* Rc = (c < 64) ? (RU + c) : (RW + (c - 64));
      const float* Ah = Am + 4 * half;
#pragma unroll
      for (int i = 0; i < 64; ++i) {
        float part = 0.f;
#pragma unroll
        for (int q = 0; q < (i + 7) / 8; ++q) {
          const f32x4 a = *(const f32x4*)(Ah + i * 68 + 8 * q);
          part += a[0] * xs[4 * q] + a[1] * xs[4 * q + 1] + a[2] * xs[4 * q + 2] + a[3] * xs[4 * q + 3];
        }
        const float other = __int_as_float(__builtin_amdgcn_update_dpp(0, __float_as_int(part), 0xB1, 0xf, 0xf, true));
        const float xi = Rc[i * 64] - (part + other);
        const int loc = ((i >> 3) << 2) + (i & 3);
        if (((i >> 2) & 1) == 0) xs[loc] = (half == 0) ? xi : xs[loc];
        else xs[loc] = (half == 1) ? xi : xs[loc];
        if (i < 16 ? ((i & 7) == 7) : (i < 32 ? ((i & 3) == 3) : ((i & 1) == 1))) asm volatile("" ::: "memory");
      }
    }
    {
      bf16_t* UWg = (bf16_t*)(p.ws + DN_UW_OFF) + ((((size_t)bh * 2 + d) * NC + ch) * 8192);
      const float sgn = (c < 64) ? 1.f : -1.f;
      bf16_t* dst = UWg + ((c < 64) ? c : (4096 + c - 64));
#pragma unroll
      for (int loc = 0; loc < 32; ++loc) {
        const int i = (((loc >> 2) * 2 + half) << 2) + (loc & 3);
        dst[i * 64] = f2bf(sgn * xs[loc]);
      }
    }
  }
}

DI void dn_scan_chain(CParams& p, int it, int S, char* lds) {
  __builtin_amdgcn_s_setprio(3);
  const int tid0 = threadIdx.x + opq();
  const int dir = it & 1, bh = it >> 1, h = bh & 3, b = bh >> 2;
  const int tokbase = b * S, NC = S / 64;
  bf16_t* OUT = (bf16_t*)(p.ws + (dir ? OFF_OB : OFF_OF));
  const bf16_t* QKg = (const bf16_t*)(p.ws + DN_QK_OFF) + (size_t)bh * NC * 8192;
  const bf16_t* UWg = (const bf16_t*)(p.ws + DN_UW_OFF) + (size_t)it * NC * 8192;
  const float* GCg = (const float*)(p.ws + DN_GC_OFF) + (size_t)it * NC * 64;
  bf16_t* Uimg = (bf16_t*)lds;
  bf16_t* Wn = Uimg + 4608;
  bf16_t* Qimg = Wn + 4608;
  bf16_t* Kimg = Qimg + 4608;
  bf16_t* Kt = Kimg + 4608;
  bf16_t* Iimg = Kt + 4608;
  float* gcs = (float*)(lds + 6 * 9216);
  f32x4 Sd[4];
#pragma unroll
  for (int t = 0; t < 4; ++t) Sd[t] = f32x4{0.f, 0.f, 0.f, 0.f};
  u32x4 ru[2], rw[2], rq[2], rk[2];
  float rg = 0.f;
  auto prefetch = [&](int cc_) {
    const int ch_ = dir ? (NC - 1 - cc_) : cc_;
    const int tp = tid0 + opq();
    const bf16_t* uw = UWg + (size_t)ch_ * 8192;
    const bf16_t* qk = QKg + (size_t)ch_ * 8192;
#pragma unroll
    for (int k = 0; k < 2; ++k) {
      const int ci = tp + 256 * k, row = ci >> 3, c8 = ci & 7;
      const int srow = dir ? 63 - row : row;
      ru[k] = *(const u32x4*)(uw + row * 64 + c8 * 8);
      rw[k] = *(const u32x4*)(uw + 4096 + row * 64 + c8 * 8);
      rq[k] = *(const u32x4*)(qk + srow * 64 + c8 * 8);
      rk[k] = *(const u32x4*)(qk + 4096 + srow * 64 + c8 * 8);
    }
    if (tp < 64) rg = GCg[(size_t)ch_ * 64 + tp];
  };
  prefetch(0);
  for (int cc = 0; cc < NC; ++cc) {
    const int tid = tid0 + opq(), lane = tid & 63, w = tid >> 6, l15 = lane & 15, g4 = lane >> 4;
    const int e_col = 16 * w + l15;
    const int ch = dir ? (NC - 1 - cc) : cc;
    const int s0 = ch * 64;
    __syncthreads();
#pragma unroll
    for (int k = 0; k < 2; ++k) {
      const int ci = tid + 256 * k, row = ci >> 3, c8 = ci & 7;
      *(u32x4*)(Uimg + row * 72 + c8 * 8) = ru[k];
      *(u32x4*)(Wn + row * 72 + c8 * 8) = rw[k];
      *(u32x4*)(Qimg + row * 72 + c8 * 8) = rq[k];
      *(u32x4*)(Kimg + row * 72 + c8 * 8) = rk[k];
      const unsigned uu[4] = {rk[k].x, rk[k].y, rk[k].z, rk[k].w};
#pragma unroll
      for (int e = 0; e < 4; ++e) {
        Kt[(8 * c8 + 2 * e) * 72 + row] = (bf16_t)(uu[e] & 0xffffu);
        Kt[(8 * c8 + 2 * e + 1) * 72 + row] = (bf16_t)(uu[e] >> 16);
      }
    }
    if (tid < 64) gcs[tid] = rg;
    if (cc + 1 < NC) prefetch(cc + 1);
    __syncthreads();
    {
      f32x4 QK[4];
#pragma unroll
      for (int t = 0; t < 4; ++t) QK[t] = f32x4{0.f, 0.f, 0.f, 0.f};
#pragma unroll
      for (int ks = 0; ks < 2; ++ks) {
        const bf16x8 bfk = *(const bf16x8*)(Kimg + (16 * w + l15) * 72 + 32 * ks + 8 * g4);
#pragma unroll
        for (int rt = 0; rt < 4; ++rt) {
          const bf16x8 afq = *(const bf16x8*)(Qimg + (16 * rt + l15) * 72 + 32 * ks + 8 * g4);
          QK[rt] = MFMA16(afq, bfk, QK[rt]);
        }
      }
      const float gcj = gcs[e_col];
#pragma unroll
      for (int rt = 0; rt < 4; ++rt)
#pragma unroll
        for (int r = 0; r < 4; ++r) {
          const int i = 16 * rt + 4 * g4 + r;
          const float ee = __expf(fminf(gcs[i] - gcj, 0.f));
          Iimg[i * 72 + e_col] = f2bf((i >= e_col) ? QK[rt][r] * ee : 0.f);
        }
    }
    __syncthreads();
    {
      bf16x8 Bs[2];
#pragma unroll
      for (int ks = 0; ks < 2; ++ks)
        Bs[ks] = pack8(Sd[2 * ks][0], Sd[2 * ks][1], Sd[2 * ks][2], Sd[2 * ks][3], Sd[2 * ks + 1][0], Sd[2 * ks + 1][1],
                       Sd[2 * ks + 1][2], Sd[2 * ks + 1][3]);
      f32x4 vn[4], qs[4], iv[4];
#pragma unroll
      for (int rt = 0; rt < 4; ++rt) {
#pragma unroll
        for (int r = 0; r < 4; ++r) vn[rt][r] = bf2f(Uimg[(16 * rt + 4 * g4 + r) * 72 + e_col]);
        qs[rt] = f32x4{0.f, 0.f, 0.f, 0.f};
        iv[rt] = f32x4{0.f, 0.f, 0.f, 0.f};
#pragma unroll
        for (int ks = 0; ks < 2; ++ks) {
          const bf16_t* wp = Wn + (16 * rt + l15) * 72 + 32 * ks + 4 * g4;
          const bf16_t* qp = Qimg + (16 * rt + l15) * 72 + 32 * ks + 4 * g4;
          vn[rt] = MFMA16(ld2x4(wp, wp + 16), Bs[ks], vn[rt]);
          qs[rt] = MFMA16(ld2x4(qp, qp + 16), Bs[ks], qs[rt]);
        }
      }
      bf16x8 Bv[2];
#pragma unroll
      for (int ks = 0; ks < 2; ++ks)
        Bv[ks] = pack8(vn[2 * ks][0], vn[2 * ks][1], vn[2 * ks][2], vn[2 * ks][3], vn[2 * ks + 1][0], vn[2 * ks + 1][1],
                       vn[2 * ks + 1][2], vn[2 * ks + 1][3]);
#pragma unroll
      for (int rt = 0; rt < 4; ++rt)
#pragma unroll
        for (int ks = 0; ks < 2; ++ks) {
          const bf16_t* ip = Iimg + (16 * rt + l15) * 72 + 32 * ks + 4 * g4;
          iv[rt] = MFMA16(ld2x4(ip, ip + 16), Bv[ks], iv[rt]);
        }
      const float gc63 = gcs[63];
#pragma unroll
      for (int rt = 0; rt < 4; ++rt)
#pragma unroll
        for (int r = 0; r < 4; ++r) {
          const int pos = 16 * rt + 4 * g4 + r;
          const float o = qs[rt][r] * __expf(gcs[pos]) + iv[rt][r];
          const int i = dir ? 63 - pos : pos;
          OUT[((size_t)tokbase + s0 + i) * 256 + h * 64 + e_col] = f2bf(o);
          vn[rt][r] *= __expf(gc63 - gcs[pos]);
        }
      bf16x8 Bv2[2];
#pragma unroll
      for (int ks = 0; ks < 2; ++ks)
        Bv2[ks] = pack8(vn[2 * ks][0], vn[2 * ks][1], vn[2 * ks][2], vn[2 * ks][3], vn[2 * ks + 1][0], vn[2 * ks + 1][1],
                        vn[2 * ks + 1][2], vn[2 * ks + 1][3]);
      const float gl = __expf(gc63);
#pragma unroll
      for (int dt = 0; dt < 4; ++dt) {
#pragma unroll
        for (int r = 0; r < 4; ++r) Sd[dt][r] *= gl;
#pragma unroll
        for (int ks = 0; ks < 2; ++ks) {
          const bf16_t* kp = Kt + (16 * dt + l15) * 72 + 32 * ks + 4 * g4;
          Sd[dt] = MFMA16(ld2x4(kp, kp + 16), Bv2[ks], Sd[dt]);
        }
      }
    }
  }
  __builtin_amdgcn_s_setprio(0);
}

DI void phase_combine(CParams& p, int layer, const float* __restrict__ xg) {
  const int tidq = threadIdx.x + opq(); const int wave = tidq >> 6, lane = tidq & 63;
  const bf16_t* PR = (const bf16_t*)(p.ws + OFF_PR);
  const bf16_t* OD = (const bf16_t*)(p.ws + OFF_OD);
  const float* LSE = (const float*)(p.ws + OFF_LSE);
  const bf16_t* OFb = (const bf16_t*)(p.ws + OFF_OF);
  const bf16_t* OBb = (const bf16_t*)(p.ws + OFF_OB);
  bf16_t* Y = (bf16_t*)(p.ws + OFF_N);
  bf16_t* Np = (bf16_t*)(p.ws + OFF_Q);
  const float* gmix = p.norm_mix + layer * 1024;
  const float* gdn = p.dn_out_norm + layer * 64;
  const int head = lane >> 4;
  for (int r = blockIdx.x * 4 + wave; r < TG; r += gridDim.x * 4) {
    {
      float lg[3];
#pragma unroll
      for (int g = 0; g < 3; ++g) lg[g] = LSE[((size_t)g * TG + r) * 4 + head];
      const float mx = fmaxf(lg[0], fmaxf(lg[1], lg[2]));
      float wg[3], den = 0.f;
#pragma unroll
      for (int g = 0; g < 3; ++g) { wg[g] = exp2_(lg[g] - mx); den += wg[g]; }
      const float id = 1.f / den;
      float o[4] = {0.f, 0.f, 0.f, 0.f};
#pragma unroll
      for (int g = 0; g < 3; ++g) {
        const u32x2 u = ((const u32x2*)(OD + ((size_t)g * TG + r) * 256))[lane];
        const float c = wg[g] * id;
        o[0] += c * __uint_as_float(u.x << 16); o[1] += c * __uint_as_float(u.x & 0xffff0000u);
        o[2] += c * __uint_as_float(u.y << 16); o[3] += c * __uint_as_float(u.y & 0xffff0000u);
      }
      u32x2 ou; ou.x = pack2(o[0], o[1]); ou.y = pack2(o[2], o[3]);
      ((u32x2*)(Y + (size_t)r * 1024 + 768))[lane] = ou;
    }
    {
      const u32x2 uf = ((const u32x2*)(OFb + (size_t)r * 256))[lane];
      const u32x2 ub = ((const u32x2*)(OBb + (size_t)r * 256))[lane];
      const u32x2 uz = ((const u32x2*)(PR + (size_t)r * NPR + C_Z))[lane];
      float o[4], z[4];
      o[0] = __uint_as_float(uf.x << 16) + __uint_as_float(ub.x << 16);
      o[1] = __uint_as_float(uf.x & 0xffff0000u) + __uint_as_float(ub.x & 0xffff0000u);
      o[2] = __uint_as_float(uf.y << 16) + __uint_as_float(ub.y << 16);
      o[3] = __uint_as_float(uf.y & 0xffff0000u) + __uint_as_float(ub.y & 0xffff0000u);
      z[0] = __uint_as_float(uz.x << 16); z[1] = __uint_as_float(uz.x & 0xffff0000u);
      z[2] = __uint_as_float(uz.y << 16); z[3] = __uint_as_float(uz.y & 0xffff0000u);
      float ss = o[0] * o[0] + o[1] * o[1] + o[2] * o[2] + o[3] * o[3];
      ss += __shfl_xor(ss, 1); ss += __shfl_xor(ss, 2); ss += __shfl_xor(ss, 4); ss += __shfl_xor(ss, 8);
      const float rs = rsqrtf(ss * (1.f / 64.f) + EPS);
      const float4 gg = ((const float4*)gdn)[lane & 15];
      u32x2 ou;
      ou.x = pack2(o[0] * rs * gg.x * siluf_(z[0]), o[1] * rs * gg.y * siluf_(z[1]));
      ou.y = pack2(o[2] * rs * gg.z * siluf_(z[2]), o[3] * rs * gg.w * siluf_(z[3]));
      ((u32x2*)(Y + (size_t)r * 1024 + 512))[lane] = ou;
    }
    {
      const float4* xr = (const float4*)(xg + (size_t)r * 1024);
      float4 v[4];
      float ss = 0.f;
#pragma unroll
      for (int i = 0; i < 4; ++i) { v[i] = xr[lane + 64 * i]; ss += v[i].x * v[i].x + v[i].y * v[i].y + v[i].z * v[i].z + v[i].w * v[i].w; }
      ss = wave_sum(ss);
      const float rs = rsqrtf(ss * (1.f / 1024.f) + EPS);
#pragma unroll
      for (int i = 0; i < 4; ++i) {
        const float4 gg = ((const float4*)gmix)[lane + 64 * i];
        u32x2 o; o.x = pack2(v[i].x * rs * gg.x, v[i].y * rs * gg.y); o.y = pack2(v[i].z * rs * gg.z, v[i].w * rs * gg.w);
        ((u32x2*)(Np + (size_t)r * 1024))[lane + 64 * i] = o;
      }
    }
  }
}

#define XB_TMO      128
#define XB_XCNT(j)  (256  + 64 * (j))
#define XB_XSUB(j)  (1280 + 64 * (j))
#define XB_XGEN(j)  (2304 + 64 * (j))
#define XB_TOP      3328
#define XB_TOPGEN   3392
#define XCD_BAR_WORDS 3456
#define XB_SPIN_CAP (1u << 27)
#define LAS __attribute__((address_space(3)))
constexpr size_t OFF_BAR = OFF_CNT + 65536;
DI unsigned xb_ld(unsigned* p) { return __hip_atomic_load(p, __ATOMIC_RELAXED, __HIP_MEMORY_SCOPE_AGENT); }
DI unsigned xb_add(unsigned* p, unsigned v) { return __hip_atomic_fetch_add(p, v, __ATOMIC_RELAXED, __HIP_MEMORY_SCOPE_AGENT); }
DI unsigned xb_xcc_id() { return (unsigned)__builtin_amdgcn_s_getreg((3 << 11) | 20) & 0xFu; }
#define XB_SPIN(cond, bar) do { unsigned _sp = 0; while (cond) { __builtin_amdgcn_s_sleep(1); \
    if ((++_sp & 255u) == 0u) { if (xb_ld(&(bar)[XB_TMO])) break; if (_sp > XB_SPIN_CAP) { atomicAdd(&(bar)[XB_TMO], 1u); break; } } } } while (0)
struct XcdBarrier { unsigned* bar; unsigned x; volatile LAS unsigned* st; };
DI XcdBarrier xcd_barrier_post(unsigned* bar, volatile LAS unsigned* st) {
  XcdBarrier b; b.bar = bar; b.x = xb_xcc_id(); b.st = st;
  if (threadIdx.x == 0) (void)xb_add(&bar[XB_XCNT(b.x)], 1u);
  return b;
}
DI void xcd_barrier_complete(unsigned* bar, unsigned x, unsigned& nloc, unsigned& nx) {
  const unsigned G = gridDim.x * gridDim.y * gridDim.z;
  unsigned sum, cnt, mine, sp = 0u;
  for (;;) {
    sum = 0u; cnt = 0u; mine = 0u;
#pragma unroll
    for (unsigned j = 0; j < 16; ++j) { const unsigned c = xb_ld(&bar[XB_XCNT(j)]); sum += c; cnt += (c > 0u) ? 1u : 0u; mine = (j == x) ? c : mine; }
    if (sum == G) break;
    __builtin_amdgcn_s_sleep(1);
    if ((++sp & 255u) == 0u) { if (xb_ld(&bar[XB_TMO])) break; if (sp > XB_SPIN_CAP) { atomicAdd(&bar[XB_TMO], 1u); break; } }
  }
  nloc = mine > 0u ? mine : 1u; nx = cnt > 0u ? cnt : 1u;
}
DI void xcd_barrier(const XcdBarrier& b) {
  asm volatile("s_waitcnt vmcnt(0)" ::: "memory");
  __syncthreads();
  if (threadIdx.x == 0) {
    unsigned* bar = b.bar;
    __builtin_amdgcn_s_waitcnt(0);
    unsigned nloc = b.st[0], nx = b.st[1];
    if (nloc == 0u) { xcd_barrier_complete(bar, b.x, nloc, nx); b.st[0] = nloc; b.st[1] = nx; }
    const unsigned old = xb_add(&bar[XB_XSUB(b.x)], 1u);
    const unsigned gen = old / nloc;
    if (old + 1u == (gen + 1u) * nloc) {
      __builtin_amdgcn_fence(__ATOMIC_RELEASE, "agent");
      asm volatile("s_waitcnt vmcnt(0)" ::: "memory");
      const unsigned og = xb_add(&bar[XB_TOP], 1u);
      const unsigned tg = og / nx;
      if (og + 1u == (tg + 1u) * nx) xb_add(&bar[XB_TOPGEN], 1u);
      else XB_SPIN(xb_ld(&bar[XB_TOPGEN]) == tg, bar);
      __builtin_amdgcn_fence(__ATOMIC_ACQUIRE, "agent");
      xb_add(&bar[XB_XGEN(b.x)], 1u);
      asm volatile("s_waitcnt vmcnt(0)" ::: "memory");
    } else {
      XB_SPIN(xb_ld(&bar[XB_XGEN(b.x)]) == gen, bar);
      __builtin_amdgcn_fence(__ATOMIC_ACQUIRE, "agent");
      asm volatile("s_waitcnt vmcnt(0)" ::: "memory");
    }
  }
  __syncthreads();
}

#ifndef REP_MIX
#define REP_MIX 1
#endif
#ifndef REP_GEMM
#define REP_GEMM 1
#endif
__global__ void __launch_bounds__(256, 2) mega(Params pk) {
  extern __shared__ __attribute__((aligned(16))) char lds[];
  __shared__ uint4 sh_words;
  cg::grid_group grid = cg::this_grid();
  CParams* kp = (CParams*)__builtin_amdgcn_kernarg_segment_ptr();
  if (threadIdx.x == 0) sh_words = make_uint4(0u, 0u, 0u, 0u);
  __syncthreads();
  XcdBarrier xb;
  { CParams& p = *launder(kp); xb = xcd_barrier_post((unsigned*)(p.ws + OFF_BAR), (volatile LAS unsigned*)&sh_words); }
#define s_item (((volatile int*)&sh_words)[2])
#define GSYNC() xcd_barrier(xb)
#define PP_ CParams& p = *launder(kp); const bf16_t* wb = (const bf16_t*)(p.ws + OFF_WB); bf16_t* Nb = (bf16_t*)(p.ws + OFF_N); \
            bf16_t* PRb = (bf16_t*)(p.ws + OFF_PR); bf16_t* Npb = (bf16_t*)(p.ws + OFF_Q); bf16_t* PB = (bf16_t*)(p.ws + OFF_OD); \
            float* xg = p.x + (size_t)grp * TG * 1024; (void)wb; (void)Nb; (void)PRb; (void)Npb; (void)PB; (void)xg;
  { CParams& p = *launder(kp); phase_init(p, lds); phase_norm(p.x_in[0], p.norm_ff1, (bf16_t*)(p.ws + OFF_Q), nullptr, nullptr); }
  grid.sync();
  for (int layer = 0; layer < 2; ++layer) {
    if (layer > 0) { CParams& p = *launder(kp); phase_convert(p, layer, lds); GSYNC(); }
    for (int grp = 0; grp < 2; ++grp) {
      const int S = grp ? 2048 : 16384, B = grp ? 16 : 2;
      const float* xsrc0 = nullptr;
      { CParams& p = *launder(kp); xsrc0 = layer == 0 ? p.x_in[grp] : p.x + (size_t)grp * TG * 1024; }
      for (int rep = 0; rep < REP_GEMM; ++rep) {
        { PP_ phase_ffn_a(Npb, wb + W_FF1_1, wb + W_FF1_3, PRb, lds); }
        GSYNC();
      }
      { PP_ phase_gemm_resid(PRb, 2816, wb + W_FF1_2, xsrc0, xg, 0.5f, lds); }
      GSYNC();
      { PP_ phase_norm(xg, p.norm_mix + layer * 1024, Nb, nullptr, nullptr); }
      GSYNC();
      for (int rep = 0; rep < REP_GEMM; ++rep) {
        { PP_ phase_proj(p, Nb, wb + W_IN, S, lds); }
        GSYNC();
      }
      {
        PP_
        int* c0 = (int*)(p.ws + OFF_CNT) + (layer * 2 + grp) * 4;
        for (;;) {
          __syncthreads();
          if (threadIdx.x == 0) s_item = atomicAdd(c0, 1);
          __syncthreads();
          const int it = __builtin_amdgcn_readfirstlane(s_item);
          if (it >= 2048) break;
          dn_prep_item(p, layer, it, S, lds);
        }
      }
      GSYNC();
      {
        PP_
        int* cb = (int*)(p.ws + OFF_CNT) + 64 + (layer * 2 + grp) * 32;
        const int nDN = B * 8, nDil = p.big_ws ? 3072 : 0;
        const int lgq = grp ? 4 : 7;
        for (;;) {
          __syncthreads();
          if (threadIdx.x == 0) s_item = atomicAdd(cb, 1);
          __syncthreads();
          const int it = __builtin_amdgcn_readfirstlane(s_item);
          if (it >= nDN) break;
          dn_scan_chain(p, it, S, lds);
        }
        for (int xo = 0; xo < 8; ++xo) {
          const int xq = (blockIdx.x + xo) & 7;
          for (;;) {
            __syncthreads();
            if (threadIdx.x == 0) s_item = atomicAdd(cb + 8 + xq, 1);
            __syncthreads();
            const int j = __builtin_amdgcn_readfirstlane(s_item);
            if (j >= 128) break;
            const int pair = xq + 8 * (j >> lgq), qb = j & ((1 << lgq) - 1);
            diff_item(p, layer, (pair << lgq) + qb, S, lds);
          }
        }
        for (;;) {
          __syncthreads();
          if (threadIdx.x == 0) s_item = atomicAdd(cb + 1, 1);
          __syncthreads();
          const int it = __builtin_amdgcn_readfirstlane(s_item);
          if (it >= nDil) break;
          dil_item(p, it, S, B, lds);
        }
      }
      GSYNC();
      {
        PP_
        int* c2 = (int*)(p.ws + OFF_CNT) + (layer * 2 + grp) * 4 + 2;
        const int nDil = p.big_ws ? 0 : 3072, total = nDil + 256 * 7;
        for (;;) {
          __syncthreads();
          if (threadIdx.x == 0) s_item = atomicAdd(c2, 1);
          __syncthreads();
          int it = __builtin_amdgcn_readfirstlane(s_item);
          if (it >= total) break;
          if (it < nDil) { dil_item(p, it, S, B, lds); continue; }
          it -= nDil;
          mla_up_tile(p, it / 7, it % 7, S, lds);
        }
      }
      GSYNC();
      {
        PP_
        int* cb = (int*)(p.ws + OFF_CNT) + 64 + (layer * 2 + grp) * 32 + 16;
        const int lgq = grp ? 4 : 7;
        for (int xo = 0; xo < 8; ++xo) {
          const int xq = (blockIdx.x + xo) & 7;
          for (;;) {
            __syncthreads();
            if (threadIdx.x == 0) s_item = atomicAdd(cb + xq, 1);
            __syncthreads();
            const int j = __builtin_amdgcn_readfirstlane(s_item);
            if (j >= 128) break;
            const int pair = xq + 8 * (j >> lgq), qb = j & ((1 << lgq) - 1);
            mla_item(p, (pair << lgq) + qb, S, lds);
          }
        }
      }
      GSYNC();
      { PP_ phase_combine(p, layer, xg); }
      GSYNC();
      for (int rep = 0; rep < REP_GEMM; ++rep) {
        { PP_ phase_merge(Npb, Nb, wb + W_G, wb + W_B, PRb, lds); }
        GSYNC();
      }
      { PP_ phase_gemm_resid(PRb, 1024, wb + W_O, xg, xg, 1.0f, lds); }
      GSYNC();
      { PP_ phase_norm(xg, p.norm_ff2 + layer * 1024, Nb, nullptr, nullptr); }
      GSYNC();
      for (int rep = 0; rep < REP_GEMM; ++rep) {
        { PP_ phase_ffn_a(Nb, wb + W_FF2_1, wb + W_FF2_3, PRb, lds); }
        GSYNC();
      }
      { PP_ phase_gemm_resid(PRb, 2816, wb + W_FF2_2, xg, xg, 0.5f, lds); }
      GSYNC();
      { PP_ phase_norm(xg, p.norm_ple + layer * 1024, Nb, p.p_in[grp] + (size_t)layer * TG * 256, PB); }
      GSYNC();
      {
        PP_
        phase_ple(Nb, PB, wb + W_PG, wb + W_PP, xg, lds);
        const int nl = grp ? layer + 1 : layer, ng = grp ^ 1;
        if (nl < 2) phase_norm(nl == 0 ? p.x_in[ng] : p.x + (size_t)ng * TG * 1024, p.norm_ff1 + nl * 1024, Npb, nullptr, nullptr);
      }
      GSYNC();
    }
  }
  { CParams& p = *launder(kp); phase_final_norm(p.x, p.norm_final); }
}

extern "C" void kernel_launch(void* const* d_in, const int* in_sizes, int n_in, void* d_out, int out_size, void* d_ws,
                              size_t ws_size, hipStream_t stream) {
  (void)in_sizes; (void)n_in; (void)out_size;
  Params p{};
  p.x_in[0] = (const float*)d_in[0]; p.x_in[1] = (const float*)d_in[1];
  p.p_in[0] = (const float*)d_in[2]; p.p_in[1] = (const float*)d_in[3];
  p.norm_ff1 = (const float*)d_in[4]; p.ff1_w1 = (const float*)d_in[5]; p.ff1_w3 = (const float*)d_in[6];
  p.ff1_w2 = (const float*)d_in[7]; p.norm_mix = (const float*)d_in[8]; p.w_in = (const float*)d_in[9];
  p.mla_q_norm = (const float*)d_in[10]; p.mla_kv_norm = (const float*)d_in[11]; p.mla_w_uq = (const float*)d_in[12];
  p.mla_w_ukv = (const float*)d_in[13]; p.diff_lambda = (const float*)d_in[14]; p.diff_subln = (const float*)d_in[15];
  p.dn_conv = (const float*)d_in[16]; p.dn_a_log = (const float*)d_in[17]; p.dn_dt_bias = (const float*)d_in[18];
  p.dn_out_norm = (const float*)d_in[19]; p.w_branch = (const float*)d_in[20]; p.w_gate = (const float*)d_in[21];
  p.w_out = (const float*)d_in[22]; p.norm_ff2 = (const float*)d_in[23]; p.ff2_w1 = (const float*)d_in[24];
  p.ff2_w3 = (const float*)d_in[25]; p.ff2_w2 = (const float*)d_in[26]; p.norm_ple = (const float*)d_in[27];
  p.ple_gate = (const float*)d_in[28]; p.ple_proj = (const float*)d_in[29]; p.norm_final = (const float*)d_in[30];
  p.x = (float*)d_out;
  p.ws = (char*)d_ws;
  p.big_ws = (ws_size >= WS_BIG) ? 1 : 0;
  static int grid_blocks = 0;
  if (!grid_blocks) {
    int dev = 0, cus = 0, per_cu = 0;
    hipGetDevice(&dev);
    hipDeviceGetAttribute(&cus, hipDeviceAttributeMultiprocessorCount, dev);
    hipFuncSetAttribute((const void*)mega, hipFuncAttributeMaxDynamicSharedMemorySize, (int)LDS_BYTES);
    hipOccupancyMaxActiveBlocksPerMultiprocessor(&per_cu, mega, 256, LDS_BYTES);
    if (per_cu < 1) per_cu = 1;
    grid_blocks = cus * per_cu;
  }
  if (ws_size < WS_NEED) {
    fprintf(stderr, "workspace too small: %zu < %zu\n", ws_size, (size_t)WS_NEED);
    return;
  }
  (void)hipMemsetAsync((char*)d_ws + OFF_BAR, 0, XCD_BAR_WORDS * 4, stream);
  void* args[] = {&p};
  hipError_t e = hipLaunchCooperativeKernel((void*)mega, dim3(grid_blocks), dim3(256), args, LDS_BYTES, stream);
  if (e != hipSuccess) fprintf(stderr, "cooperative launch failed: %s (grid %d)\n", hipGetErrorString(e), grid_blocks);
}
```

```cpp
#include <hip/hip_runtime.h>
#include <hip/hip_cooperative_groups.h>
#include <stdint.h>
#include <stdio.h>
namespace cg = cooperative_groups;

typedef unsigned short bf16_t;
using bf16x8 = __attribute__((ext_vector_type(8))) short;
using bf16x4 = __attribute__((ext_vector_type(4))) short;
using f32x16 = __attribute__((ext_vector_type(16))) float;
using f32x4 = __attribute__((ext_vector_type(4))) float;
using u32x4 = __attribute__((ext_vector_type(4))) unsigned;
using u32x2 = __attribute__((ext_vector_type(2))) unsigned;

#define DI __device__ __forceinline__
#define MFMA32(a, b, c) __builtin_amdgcn_mfma_f32_32x32x16_bf16((a), (b), (c), 0, 0, 0)
#define MFMA16(a, b, c) __builtin_amdgcn_mfma_f32_16x16x32_bf16((a), (b), (c), 0, 0, 0)

constexpr int TG = 32768;
constexpr int NPR = 4608;
constexpr float EPS = 1e-6f;
constexpr float LOG2E = 1.4426950408889634f;
constexpr float DEFER_THR = 8.f;
constexpr int C_CQ = 0, C_CKV = 256, C_BQ = 384, C_BK = 640, C_BV = 896, C_DNQKV = 1152, C_Z = 1920,
              C_DQ = 2176, C_DK = 2944, C_DV = 3712;
constexpr size_t MiB = 1048576;
constexpr size_t OFF_WB = 0, OFF_TAB = 57 * MiB, OFF_CNT = 63 * MiB, OFF_N = 64 * MiB, OFF_PR = 128 * MiB,
                 OFF_Q = 416 * MiB, OFF_K = 440 * MiB, OFF_V = 464 * MiB, OFF_AB = 480 * MiB, OFF_OD = 482 * MiB,
                 OFF_LSE = 530 * MiB, OFF_OF = 532 * MiB, OFF_OB = 548 * MiB, WS_NEED = 564 * MiB;
constexpr size_t W_FF1_1 = 0, W_FF1_3 = 2883584, W_FF1_2 = 5767168, W_IN = 8650752, W_UQ = 13369344,
                 W_UKV = 13467648, W_G = 13533184, W_B = 17727488, W_O = 18776064, W_FF2_1 = 19824640,
                 W_FF2_3 = 22708224, W_FF2_2 = 25591808, W_PG = 28475392, W_PP = 29523968;
constexpr size_t LDS_BYTES = 78336;

struct Params {
  const float* x_in[2];
  const float* p_in[2];
  const float *norm_ff1, *ff1_w1, *ff1_w3, *ff1_w2, *norm_mix, *w_in, *mla_q_norm, *mla_kv_norm, *mla_w_uq,
      *mla_w_ukv, *diff_lambda, *diff_subln, *dn_conv, *dn_a_log, *dn_dt_bias, *dn_out_norm, *w_branch, *w_gate,
      *w_out, *norm_ff2, *ff2_w1, *ff2_w3, *ff2_w2, *norm_ple, *ple_gate, *ple_proj, *norm_final;
  float* x;
  char* ws;
  long long big_ws;
};

typedef const __attribute__((address_space(4))) Params CParams;
DI CParams* launder(CParams* q) { asm volatile("" : "+s"(q)); return q; }

typedef __bf16 bf2_t __attribute__((ext_vector_type(2)));
typedef float f2_t __attribute__((ext_vector_type(2)));
DI bf16_t f2bf(float x) { return __builtin_bit_cast(bf16_t, (__bf16)x); }
DI float bf2f(bf16_t b) { return __uint_as_float(((unsigned)b) << 16); }
DI unsigned pack2(float a, float b) { f2_t v = {a, b}; return __builtin_bit_cast(unsigned, __builtin_convertvector(v, bf2_t)); }
DI float wave_sum(float v) {
#pragma unroll
  for (int o = 32; o > 0; o >>= 1) v += __shfl_xor(v, o);
  return v;
}
DI float sigmoidf_(float x) { return __builtin_amdgcn_rcpf(1.f + __expf(-x)); }
DI float siluf_(float x) { return x * __builtin_amdgcn_rcpf(1.f + __expf(-x)); }
DI float exp2_(float x) { return __builtin_amdgcn_exp2f(x); }
DI int opq() { int z; asm volatile("v_mov_b32 %0, 0" : "=v"(z)); return z; }
DI float xhalf_max(float v) {
  const auto r = __builtin_amdgcn_permlane32_swap(__float_as_uint(v), __float_as_uint(v), false, false);
  return fmaxf(__uint_as_float(r[0]), __uint_as_float(r[1]));
}
DI int crow(int r, int h2) { return (r & 3) + 8 * (r >> 2) + 4 * h2; }
DI bf16x8 pack8(float a0, float a1, float a2, float a3, float a4, float a5, float a6, float a7) {
  u32x4 u;
  u.x = pack2(a0, a1); u.y = pack2(a2, a3); u.z = pack2(a4, a5); u.w = pack2(a6, a7);
  return __builtin_bit_cast(bf16x8, u);
}
DI bf16x8 ld2x4(const bf16_t* p0, const bf16_t* p1) {
  u32x2 a = *(const u32x2*)p0, b = *(const u32x2*)p1;
  u32x4 u; u.x = a.x; u.y = a.y; u.z = b.x; u.w = b.y;
  return __builtin_bit_cast(bf16x8, u);
}
DI void store8bf(bf16_t* dst, const float* v) {
  u32x4 u; u.x = pack2(v[0], v[1]); u.y = pack2(v[2], v[3]); u.z = pack2(v[4], v[5]); u.w = pack2(v[6], v[7]);
  *(u32x4*)dst = u;
}

struct MatDesc { const float* src; bf16_t* dst; int K, ldsrc, Ndst, map; const float* rowscale; int frag; };

DI int map_col(int map, int n) {
  if (map == 0) return n;
  if (map == 1) {
    if (n < 384) return n;
    if (n < 1920) return n + 32;
    if (n < 4480) return n + 48;
    if (n < 4512) return n - 4480 + 384;
    if (n < 4528) return n - 4512 + 1952;
    return -1;
  }
  if (n < 256) return (n >> 6) * 96 + (n & 63);
  return ((n - 256) >> 5) * 96 + 64 + ((n - 256) & 31);
}

DI MatDesc get_mat(CParams& p, int l, int id) {
  bf16_t* wb = (bf16_t*)(p.ws + OFF_WB);
  MatDesc d; d.map = 0; d.rowscale = nullptr; d.frag = (id == 2 || id == 14 || id == 17) ? 1 : 0;
  const size_t FF = (size_t)1024 * 2816;
  switch (id) {
    case 0: d.src = p.ff1_w1 + l * FF; d.dst = wb + W_FF1_1; d.K = 1024; d.ldsrc = 2816; d.Ndst = 2816; break;
    case 1: d.src = p.ff1_w3 + l * FF; d.dst = wb + W_FF1_3; d.K = 1024; d.ldsrc = 2816; d.Ndst = 2816; break;
    case 2: d.src = p.ff1_w2 + l * FF; d.dst = wb + W_FF1_2; d.K = 2816; d.ldsrc = 1024; d.Ndst = 1024; break;
    case 3: d.src = p.w_in + (size_t)l * 1024 * 4528; d.dst = wb + W_IN; d.K = 1024; d.ldsrc = 4528; d.Ndst = 4608; d.map = 1; break;
    case 4: d.src = p.mla_w_uq + (size_t)l * 256 * 384; d.dst = wb + W_UQ; d.K = 256; d.ldsrc = 384; d.Ndst = 384; d.map = 2; d.rowscale = p.mla_q_norm + l * 256; break;
    case 5: d.src = p.mla_w_ukv + (size_t)l * 128 * 512; d.dst = wb + W_UKV; d.K = 128; d.ldsrc = 512; d.Ndst = 512; d.rowscale = p.mla_kv_norm + l * 128; break;
    case 6: case 7: case 8: case 9:
      d.src = p.w_gate + (size_t)(l * 4 + id - 6) * 1048576; d.dst = wb + W_G + (size_t)(id - 6) * 1048576; d.K = 1024; d.ldsrc = 1024; d.Ndst = 1024; break;
    case 10: case 11: case 12: case 13:
      d.src = p.w_branch + (size_t)(l * 4 + id - 10) * 262144; d.dst = wb + W_B + (size_t)(id - 10) * 262144; d.K = 256; d.ldsrc = 1024; d.Ndst = 1024; break;
    case 14: d.src = p.w_out + (size_t)l * 1048576; d.dst = wb + W_O; d.K = 1024; d.ldsrc = 1024; d.Ndst = 1024; break;
    case 15: d.src = p.ff2_w1 + l * FF; d.dst = wb + W_FF2_1; d.K = 1024; d.ldsrc = 2816; d.Ndst = 2816; break;
    case 16: d.src = p.ff2_w3 + l * FF; d.dst = wb + W_FF2_3; d.K = 1024; d.ldsrc = 2816; d.Ndst = 2816; break;
    case 17: d.src = p.ff2_w2 + l * FF; d.dst = wb + W_FF2_2; d.K = 2816; d.ldsrc = 1024; d.Ndst = 1024; break;
    case 18: d.src = p.ple_gate + (size_t)l * 1048576; d.dst = wb + W_PG; d.K = 1024; d.ldsrc = 1024; d.Ndst = 1024; break;
    default: d.src = p.ple_proj + (size_t)l * 262144; d.dst = wb + W_PP; d.K = 256; d.ldsrc = 1024; d.Ndst = 1024; break;
  }
  return d;
}

DI void phase_convert(CParams& p, int l, char* lds, int id0 = 0, int id1 = 20) {
  float* T = (float*)lds;
  const int tid = threadIdx.x + opq();
  for (int id = id0; id < id1; ++id) {
    MatDesc d = get_mat(p, l, id);
    const int nkt = d.K >> 6, nnt = d.Ndst >> 6, nt_all = nkt * nnt;
    for (int t = blockIdx.x; t < nt_all; t += gridDim.x) {
      const int kt = t / nnt, nt = t % nnt;
      __syncthreads();
      {
        const int nl = tid & 63;
        const int sc = map_col(d.map, nt * 64 + nl);
#pragma unroll 4
        for (int i = 0; i < 16; ++i) {
          const int kl = (tid >> 6) + 4 * i;
          const int k = kt * 64 + kl;
          float v = 0.f;
          if (sc >= 0) v = d.src[(size_t)k * d.ldsrc + sc];
          if (d.rowscale) v *= d.rowscale[k];
          T[kl * 65 + nl] = v;
        }
      }
      __syncthreads();
      if (d.frag) {
#pragma unroll
        for (int i = 0; i < 2; ++i) {
          const int ci = tid + 256 * i, nl = ci & 63, c8 = ci >> 6;
          float v[8];
#pragma unroll
          for (int e = 0; e < 8; ++e) v[e] = T[(8 * c8 + e) * 65 + nl];
          const int n = nt * 64 + nl, k = kt * 64 + 8 * c8;
          const size_t off = (((size_t)(n >> 5) * (d.K >> 4) + (k >> 4)) * 64 + ((k >> 3) & 1) * 32 + (n & 31)) * 8;
          store8bf(d.dst + off, v);
        }
      } else {
        const int kl = tid & 63;
#pragma unroll 4
        for (int i = 0; i < 16; ++i) {
          const int nl = (tid >> 6) + 4 * i;
          d.dst[(size_t)(nt * 64 + nl) * d.K + kt * 64 + kl] = f2bf(T[kl * 65 + nl]);
        }
      }
    }
  }
}

DI void phase_init(CParams& p, char* lds) {
  const size_t gtid = (size_t)blockIdx.x * 256 + threadIdx.x + opq(), gn = (size_t)gridDim.x * 256;
  {
    float2* t32 = (float2*)(p.ws + OFF_TAB);
    float2* t64 = (float2*)(p.ws + OFF_TAB + 2 * MiB);
    for (size_t i = gtid; i < (size_t)16384 * 48; i += gn) {
      const int pos = (int)(i / 48), f = (int)(i % 48);
      float inv;
      if (f < 16) inv = exp2f(-(float)f * (13.287712379549449f / 16.f));
      else inv = exp2f(-(float)(f - 16) * (13.287712379549449f / 32.f));
      const float ang = (float)pos * inv;
      const double xd = (double)ang;
      const double n = rint(xd * 0.15915494309189535);
      const float rf = (float)(xd - n * 6.283185307179586);
      float2 cs; cs.x = __cosf(rf); cs.y = __sinf(rf);
      if (f < 16) t32[(size_t)pos * 16 + f] = cs; else t64[(size_t)pos * 32 + (f - 16)] = cs;
    }
  }
  if (blockIdx.x == 0) ((int*)(p.ws + OFF_CNT))[threadIdx.x] = 0;
  phase_convert(p, 0, lds);
}

DI void phase_norm(const float* __restrict__ x, const float* __restrict__ g, bf16_t* __restrict__ dst,
                           const float* __restrict__ psrc, bf16_t* __restrict__ pdst) {
  const int tidq = threadIdx.x + opq(); const int wave = tidq >> 6, lane = tidq & 63;
  for (int r = blockIdx.x * 4 + wave; r < TG; r += gridDim.x * 4) {
    const float4* xr = (const float4*)(x + (size_t)r * 1024);
    float4 v[4];
    float ss = 0.f;
#pragma unroll
    for (int i = 0; i < 4; ++i) { v[i] = xr[lane + 64 * i]; ss += v[i].x * v[i].x + v[i].y * v[i].y + v[i].z * v[i].z + v[i].w * v[i].w; }
    ss = wave_sum(ss);
    const float rs = rsqrtf(ss * (1.f / 1024.f) + EPS);
#pragma unroll
    for (int i = 0; i < 4; ++i) {
      const float4 gg = ((const float4*)g)[lane + 64 * i];
      u32x2 o; o.x = pack2(v[i].x * rs * gg.x, v[i].y * rs * gg.y); o.y = pack2(v[i].z * rs * gg.z, v[i].w * rs * gg.w);
      ((u32x2*)(dst + (size_t)r * 1024))[lane + 64 * i] = o;
    }
    if (psrc) {
      const float4 pv = ((const float4*)(psrc + (size_t)r * 256))[lane];
      u32x2 o; o.x = pack2(pv.x, pv.y); o.y = pack2(pv.z, pv.w);
      ((u32x2*)(pdst + (size_t)r * 256))[lane] = o;
    }
  }
}

DI void phase_final_norm(float* __restrict__ x, const float* __restrict__ g) {
  const int tidq = threadIdx.x + opq(); const int wave = tidq >> 6, lane = tidq & 63;
  for (int r = blockIdx.x * 4 + wave; r < 2 * TG; r += gridDim.x * 4) {
    float4* xr = (float4*)(x + (size_t)r * 1024);
    float4 v[4];
    float ss = 0.f;
#pragma unroll
    for (int i = 0; i < 4; ++i) { v[i] = xr[lane + 64 * i]; ss += v[i].x * v[i].x + v[i].y * v[i].y + v[i].z * v[i].z + v[i].w * v[i].w; }
    ss = wave_sum(ss);
    const float rs = rsqrtf(ss * (1.f / 1024.f) + EPS);
#pragma unroll
    for (int i = 0; i < 4; ++i) {
      const float4 gg = ((const float4*)g)[lane + 64 * i];
      float4 o; o.x = v[i].x * rs * gg.x; o.y = v[i].y * rs * gg.y; o.z = v[i].z * rs * gg.z; o.w = v[i].w * rs * gg.w;
      xr[lane + 64 * i] = o;
    }
  }
}

template <int NI, int NB, bool SWAP = false>
DI void gemm_main(f32x16 (&acc0)[2][NI], f32x16 (&acc1)[2][NI], const bf16_t* __restrict__ A, int lda,
                  const bf16_t* __restrict__ B0, const bf16_t* __restrict__ B1, int ldb, int K, char* lds) {
  const int tid = threadIdx.x + opq(), lane = tid & 63, w = tid >> 6, wm = w >> 1, wn = w & 1, l31 = lane & 31, h2 = lane >> 5;
  bf16_t* As = (bf16_t*)lds;
  bf16_t* B0s = As + 128 * 72;
  bf16_t* B1s = B0s + 64 * NI * 72;
  const int lr = tid >> 3, lc = (tid & 7) * 8;
  u32x4 ra[4], rb0[2 * NI], rb1[2 * NI];
  const char* Ab = (const char*)A;
  const char* B0b = (const char*)B0;
  const char* B1b = (NB == 2) ? (const char*)B1 : (const char*)B0;
  const unsigned aoff = (unsigned)(lr * lda + lc) * 2u, boff = (unsigned)(lr * ldb + lc) * 2u;
  const unsigned astep = (unsigned)(32 * lda) * 2u, bstep = (unsigned)(32 * ldb) * 2u;
#pragma unroll
  for (int i = 0; i < 4; ++i) ra[i] = *(const u32x4*)(Ab + (aoff + astep * i));
#pragma unroll
  for (int i = 0; i < 2 * NI; ++i) {
    rb0[i] = *(const u32x4*)(B0b + (boff + bstep * i));
    if (NB == 2) rb1[i] = *(const u32x4*)(B1b + (boff + bstep * i));
  }
  for (int k0 = 0; k0 < K; k0 += 64) {
    __syncthreads();
#pragma unroll
    for (int i = 0; i < 4; ++i) *(u32x4*)(As + (lr + 32 * i) * 72 + lc) = ra[i];
#pragma unroll
    for (int i = 0; i < 2 * NI; ++i) {
      *(u32x4*)(B0s + (lr + 32 * i) * 72 + lc) = rb0[i];
      if (NB == 2) *(u32x4*)(B1s + (lr + 32 * i) * 72 + lc) = rb1[i];
    }
    if (k0 + 64 < K) {
      const unsigned kb = (unsigned)(k0 + 64) * 2u;
#pragma unroll
      for (int i = 0; i < 4; ++i) ra[i] = *(const u32x4*)(Ab + (aoff + astep * i + kb));
#pragma unroll
      for (int i = 0; i < 2 * NI; ++i) {
        rb0[i] = *(const u32x4*)(B0b + (boff + bstep * i + kb));
        if (NB == 2) rb1[i] = *(const u32x4*)(B1b + (boff + bstep * i + kb));
      }
    }
    __syncthreads();
    __builtin_amdgcn_s_setprio(1);
#pragma unroll
    for (int ks = 0; ks < 4; ++ks) {
      bf16x8 af[2], bf0[NI], bf1[NI];
#pragma unroll
      for (int mi = 0; mi < 2; ++mi) af[mi] = *(const bf16x8*)(As + (64 * wm + 32 * mi + l31) * 72 + 16 * ks + 8 * h2);
#pragma unroll
      for (int ni = 0; ni < NI; ++ni) {
        bf0[ni] = *(const bf16x8*)(B0s + (32 * NI * wn + 32 * ni + l31) * 72 + 16 * ks + 8 * h2);
        if (NB == 2) bf1[ni] = *(const bf16x8*)(B1s + (32 * NI * wn + 32 * ni + l31) * 72 + 16 * ks + 8 * h2);
      }
#pragma unroll
      for (int mi = 0; mi < 2; ++mi)
#pragma unroll
        for (int ni = 0; ni < NI; ++ni) {
          acc0[mi][ni] = SWAP ? MFMA32(bf0[ni], af[mi], acc0[mi][ni]) : MFMA32(af[mi], bf0[ni], acc0[mi][ni]);
          if (NB == 2) acc1[mi][ni] = SWAP ? MFMA32(bf1[ni], af[mi], acc1[mi][ni]) : MFMA32(af[mi], bf1[ni], acc1[mi][ni]);
        }
    }
    __builtin_amdgcn_s_setprio(0);
  }
}

DI void gemm_main_bd(f32x16 (&acc)[4][2], const bf16_t* __restrict__ A, int lda, const bf16_t* __restrict__ Bf, int n0,
                     int K, char* lds) {
  const int tid = threadIdx.x + opq(), lane = tid & 63, w = tid >> 6, l31 = lane & 31, h2 = lane >> 5;
  bf16_t* As0 = (bf16_t*)lds;
  const int lr = tid >> 3, lc = (tid & 7) * 8;
  const int KS = K >> 4, nsteps = K >> 6;
  u32x4 ra[4];
  const char* Ab = (const char*)A;
  const unsigned aoff = (unsigned)(lr * lda + lc) * 2u, astep = (unsigned)(32 * lda) * 2u;
  const int wu = __builtin_amdgcn_readfirstlane(w);
  const char* Bb0 = (const char*)(Bf + ((size_t)((n0 >> 5) + 2 * wu) * KS) * 512);
  const char* Bb1 = Bb0 + (size_t)KS * 1024;
  const unsigned loff = (unsigned)lane * 16u;
  bf16x8 bc[2][4], bn[2][4];
#pragma unroll
  for (int i = 0; i < 4; ++i) ra[i] = *(const u32x4*)(Ab + (aoff + astep * i));
#pragma unroll
  for (int ks = 0; ks < 4; ++ks) { bn[0][ks] = *(const bf16x8*)(Bb0 + (loff + 1024u * ks)); bn[1][ks] = *(const bf16x8*)(Bb1 + (loff + 1024u * ks)); }
  __syncthreads();
#pragma unroll
  for (int i = 0; i < 4; ++i) *(u32x4*)(As0 + (lr + 32 * i) * 72 + lc) = ra[i];
  if (nsteps > 1) {
#pragma unroll
    for (int i = 0; i < 4; ++i) ra[i] = *(const u32x4*)(Ab + (aoff + astep * i + 128u));
  }
  __syncthreads();
  for (int k = 0; k < nsteps; ++k) {
    const bf16_t* As = As0 + (k & 1) * (128 * 72);
    bf16_t* Aw = As0 + ((k + 1) & 1) * (128 * 72);
#pragma unroll
    for (int ks = 0; ks < 4; ++ks) { bc[0][ks] = bn[0][ks]; bc[1][ks] = bn[1][ks]; }
    if (k + 1 < nsteps) {
#pragma unroll
      for (int ks = 0; ks < 4; ++ks) {
        bn[0][ks] = *(const bf16x8*)(Bb0 + (loff + 1024u * (unsigned)(4 * (k + 1) + ks)));
        bn[1][ks] = *(const bf16x8*)(Bb1 + (loff + 1024u * (unsigned)(4 * (k + 1) + ks)));
      }
#pragma unroll
      for (int i = 0; i < 4; ++i) *(u32x4*)(Aw + (lr + 32 * i) * 72 + lc) = ra[i];
      if (k + 2 < nsteps) {
#pragma unroll
        for (int i = 0; i < 4; ++i) ra[i] = *(const u32x4*)(Ab + (aoff + astep * i + 128u * (unsigned)(k + 2)));
      }
    }
    __builtin_amdgcn_s_setprio(1);
#pragma unroll
    for (int ks = 0; ks < 4; ++ks) {
      bf16x8 af[4];
#pragma unroll
      for (int mi = 0; mi < 4; ++mi) af[mi] = *(const bf16x8*)(As + (32 * mi + l31) * 72 + 16 * ks + 8 * h2);
#pragma unroll
      for (int mi = 0; mi < 4; ++mi)
#pragma unroll
        for (int ni = 0; ni < 2; ++ni) acc[mi][ni] = MFMA32(bc[ni][ks], af[mi], acc[mi][ni]);
    }
    __builtin_amdgcn_s_setprio(0);
    __syncthreads();
  }
}

template <int NI>
DI void zero_acc(f32x16 (&a)[2][NI]) {
#pragma unroll
  for (int mi = 0; mi < 2; ++mi)
#pragma unroll
    for (int ni = 0; ni < NI; ++ni)
#pragma unroll
      for (int r = 0; r < 16; ++r) a[mi][ni][r] = 0.f;
}

#define EPI_VARS const int tid = threadIdx.x + opq(), lane = tid & 63, w = tid >> 6, wm = w >> 1, wn = w & 1, l31 = lane & 31, h2 = lane >> 5; (void)tid; (void)lane; (void)w
#define EPI_BEGIN(NI_) _Pragma("unroll") for (int mi = 0; mi < 2; ++mi) _Pragma("unroll") for (int ni = 0; ni < NI_; ++ni) _Pragma("unroll") for (int r = 0; r < 16; ++r) { \
    const int row = 64 * wm + 32 * mi + crow(r, h2); const int col = 32 * NI_ * wn + 32 * ni + l31;
#define EPI_END }

DI bool xcd_tile(int iter, int MT, int NT, int& mt, int& nt) {
  const int x = blockIdx.x & 7, lb = blockIdx.x >> 3, nb = gridDim.x >> 3;
  if (NT == 8) {
    const int j = lb + iter * nb;
    if (lb >= nb || j >= MT) return false;
    mt = (x & 1) * (MT >> 1) + (j >> 1);
    nt = 2 * (x >> 1) + (j & 1);
    return true;
  }
  const int full = NT >> 3, rem = NT & 7;
  const int per_full = full * MT, rem_tot = rem * MT;
  const int r0 = (rem_tot * x) >> 3, r1 = (rem_tot * (x + 1)) >> 3;
  const int j = lb + iter * nb;
  if (lb >= nb || j >= per_full + (r1 - r0)) return false;
  if (j < per_full) { mt = j / full; nt = x * full + j % full; }
  else { const int u = r0 + (j - per_full); nt = 8 * full + u / MT; mt = u % MT; }
  return true;
}

DI void phase_ffn_a(const bf16_t* __restrict__ Nb, const bf16_t* __restrict__ W1, const bf16_t* __restrict__ W3,
                            bf16_t* __restrict__ H, char* lds) {
  EPI_VARS;
  for (int iter = 0;; ++iter) {
    int mt, nt;
    if (!xcd_tile(iter, 256, 22, mt, nt)) break;
    f32x16 a0[2][2], a1[2][2];
    zero_acc<2>(a0); zero_acc<2>(a1);
    gemm_main<2, 2, true>(a0, a1, Nb + (size_t)mt * 128 * 1024, 1024, W1 + (size_t)nt * 128 * 1024, W3 + (size_t)nt * 128 * 1024, 1024, 1024, lds);
#pragma unroll
    for (int mi = 0; mi < 2; ++mi)
#pragma unroll
      for (int ni = 0; ni < 2; ++ni) {
        bf16_t* hp = H + (size_t)(mt * 128 + 64 * wm + 32 * mi + l31) * 2816 + nt * 128 + 64 * wn + 32 * ni + 4 * h2;
#pragma unroll
        for (int g = 0; g < 4; ++g) {
          u32x2 o;
          o.x = pack2(siluf_(a0[mi][ni][4 * g]) * a1[mi][ni][4 * g], siluf_(a0[mi][ni][4 * g + 1]) * a1[mi][ni][4 * g + 1]);
          o.y = pack2(siluf_(a0[mi][ni][4 * g + 2]) * a1[mi][ni][4 * g + 2], siluf_(a0[mi][ni][4 * g + 3]) * a1[mi][ni][4 * g + 3]);
          *(u32x2*)(hp + 8 * g) = o;
        }
      }
  }
}

DI void phase_gemm_resid(const bf16_t* __restrict__ A, int K, const bf16_t* __restrict__ Bf, const float* xsrc, float* x,
                         float scale, char* lds) {
  const int tid = threadIdx.x + opq(), lane = tid & 63, w = tid >> 6, l31 = lane & 31, h2 = lane >> 5;
  for (int iter = 0;; ++iter) {
    int mt, nt;
    if (!xcd_tile(iter, 256, 4, mt, nt)) break;
    f32x16 a0[4][2];
#pragma unroll
    for (int mi = 0; mi < 4; ++mi)
#pragma unroll
      for (int ni = 0; ni < 2; ++ni)
#pragma unroll
        for (int r = 0; r < 16; ++r) a0[mi][ni][r] = 0.f;
    gemm_main_bd(a0, A + (size_t)mt * 128 * K, K, Bf, nt * 256, K, lds);
#pragma unroll
    for (int mi = 0; mi < 4; ++mi)
#pragma unroll
      for (int ni = 0; ni < 2; ++ni) {
        float4 xs[4];
        const size_t base = (size_t)(mt * 128 + 32 * mi + l31) * 1024 + nt * 256 + 64 * w + 32 * ni + 4 * h2;
#pragma unroll
        for (int g = 0; g < 4; ++g) xs[g] = *(const float4*)(xsrc + base + 8 * g);
#pragma unroll
        for (int g = 0; g < 4; ++g) {
          float4 o;
          o.x = xs[g].x + scale * a0[mi][ni][4 * g];
          o.y = xs[g].y + scale * a0[mi][ni][4 * g + 1];
          o.z = xs[g].z + scale * a0[mi][ni][4 * g + 2];
          o.w = xs[g].w + scale * a0[mi][ni][4 * g + 3];
          *(float4*)(x + base + 8 * g) = o;
        }
      }
  }
}

DI void phase_ple(const bf16_t* __restrict__ Nb, const bf16_t* __restrict__ PB, const bf16_t* __restrict__ PG,
                          const bf16_t* __restrict__ PP, float* __restrict__ x, char* lds) {
  EPI_VARS;
  for (int iter = 0;; ++iter) {
    int mt, nt;
    if (!xcd_tile(iter, 256, 8, mt, nt)) break;
    f32x16 a0[2][2], a1[2][2];
    zero_acc<2>(a0); zero_acc<2>(a1);
    gemm_main<2, 1, true>(a0, a0, Nb + (size_t)mt * 128 * 1024, 1024, PG + (size_t)nt * 128 * 1024, nullptr, 1024, 1024, lds);
    gemm_main<2, 1, true>(a1, a1, PB + (size_t)mt * 128 * 256, 256, PP + (size_t)nt * 128 * 256, nullptr, 256, 256, lds);
#pragma unroll
    for (int mi = 0; mi < 2; ++mi)
#pragma unroll
      for (int ni = 0; ni < 2; ++ni) {
        float* xp = x + (size_t)(mt * 128 + 64 * wm + 32 * mi + l31) * 1024 + nt * 128 + 64 * wn + 32 * ni + 4 * h2;
        float4 xs[4];
#pragma unroll
        for (int g = 0; g < 4; ++g) xs[g] = *(const float4*)(xp + 8 * g);
#pragma unroll
        for (int g = 0; g < 4; ++g) {
          float4 o;
          o.x = xs[g].x + sigmoidf_(a0[mi][ni][4 * g]) * a1[mi][ni][4 * g];
          o.y = xs[g].y + sigmoidf_(a0[mi][ni][4 * g + 1]) * a1[mi][ni][4 * g + 1];
          o.z = xs[g].z + sigmoidf_(a0[mi][ni][4 * g + 2]) * a1[mi][ni][4 * g + 2];
          o.w = xs[g].w + sigmoidf_(a0[mi][ni][4 * g + 3]) * a1[mi][ni][4 * g + 3];
          *(float4*)(xp + 8 * g) = o;
        }
      }
  }
}

DI void phase_merge(const bf16_t* __restrict__ Np, const bf16_t* __restrict__ Y, const bf16_t* __restrict__ WG,
                            const bf16_t* __restrict__ WB, bf16_t* __restrict__ M, char* lds) {
  EPI_VARS;
  for (int iter = 0;; ++iter) {
    int mt, nt;
    if (!xcd_tile(iter, 256, 8, mt, nt)) break;
    f32x16 am[2][2];
    zero_acc<2>(am);
#pragma unroll 1
    for (int n = 0; n < 4; ++n) {
      unsigned sg[2][2][8];
      {
        f32x16 ag[2][2];
        zero_acc<2>(ag);
        gemm_main<2, 1, true>(ag, ag, Np + (size_t)mt * 128 * 1024, 1024, WG + (size_t)n * 1048576 + (size_t)nt * 128 * 1024, nullptr, 1024, 1024, lds);
#pragma unroll
        for (int mi = 0; mi < 2; ++mi)
#pragma unroll
          for (int ni = 0; ni < 2; ++ni)
#pragma unroll
            for (int r = 0; r < 8; ++r) sg[mi][ni][r] = pack2(sigmoidf_(ag[mi][ni][2 * r]), sigmoidf_(ag[mi][ni][2 * r + 1]));
      }
      f32x16 ab[2][2];
      zero_acc<2>(ab);
      gemm_main<2, 1, true>(ab, ab, Y + (size_t)mt * 128 * 1024 + n * 256, 1024, WB + (size_t)n * 262144 + (size_t)nt * 128 * 256, nullptr, 256, 256, lds);
#pragma unroll
      for (int mi = 0; mi < 2; ++mi)
#pragma unroll
        for (int ni = 0; ni < 2; ++ni)
#pragma unroll
          for (int r = 0; r < 8; ++r) {
            am[mi][ni][2 * r] += __uint_as_float(sg[mi][ni][r] << 16) * ab[mi][ni][2 * r];
            am[mi][ni][2 * r + 1] += __uint_as_float(sg[mi][ni][r] & 0xffff0000u) * ab[mi][ni][2 * r + 1];
          }
    }
#pragma unroll
    for (int mi = 0; mi < 2; ++mi)
#pragma unroll
      for (int ni = 0; ni < 2; ++ni) {
        bf16_t* mp = M + (size_t)(mt * 128 + 64 * wm + 32 * mi + l31) * 1024 + nt * 128 + 64 * wn + 32 * ni + 4 * h2;
#pragma unroll
        for (int g = 0; g < 4; ++g) {
          u32x2 o;
          o.x = pack2(am[mi][ni][4 * g], am[mi][ni][4 * g + 1]);
          o.y = pack2(am[mi][ni][4 * g + 2], am[mi][ni][4 * g + 3]);
          *(u32x2*)(mp + 8 * g) = o;
        }
      }
  }
}

DI void rope32_out(const float* c, const float2* tab, float sc, float* o) {
#pragma unroll
  for (int i = 0; i < 16; ++i) {
    const float2 cs = tab[i];
    const float a = c[i], b = c[16 + i];
    o[i] = (a * cs.x - b * cs.y) * sc;
    o[16 + i] = (b * cs.x + a * cs.y) * sc;
  }
}

DI void phase_proj(CParams& p, const bf16_t* __restrict__ Nb, const bf16_t* __restrict__ WIN, int S, char* lds) {
  EPI_VARS;
  bf16_t* PR = (bf16_t*)(p.ws + OFF_PR);
  float* AB = (float*)(p.ws + OFF_AB);
  const float2* t32 = (const float2*)(p.ws + OFF_TAB);
  const float2* t64 = (const float2*)(p.ws + OFF_TAB + 2 * MiB);
  float* Ct = (float*)lds;
  for (int iter = 0;; ++iter) {
    int mt, nt2;
    if (!xcd_tile(iter, 256, 18, mt, nt2)) break;
    f32x16 a0[2][4];
    zero_acc<4>(a0);
    gemm_main<4, 1>(a0, a0, Nb + (size_t)mt * 128 * 1024, 1024, WIN + (size_t)nt2 * 256 * 1024, nullptr, 1024, 1024, lds);
   for (int hv = 0; hv < 2; ++hv) {
    const int nt = 2 * nt2 + hv;
    __syncthreads();
    if (wn == hv) {
#pragma unroll
      for (int mi = 0; mi < 2; ++mi)
#pragma unroll
        for (int ni = 0; ni < 4; ++ni)
#pragma unroll
          for (int r = 0; r < 16; ++r) Ct[(64 * wm + 32 * mi + crow(r, h2)) * 132 + 32 * ni + l31] = a0[mi][ni][r];
    }
    __syncthreads();
    const int erow = tid >> 1, half = tid & 1;
    const int tok = mt * 128 + erow, pos = tok & (S - 1);
    const float* cr = Ct + erow * 132 + 64 * half;
    bf16_t* dst = PR + (size_t)tok * NPR + nt * 128 + 64 * half;
    int type = 0; float sc = 1.f;
    if (nt == 3 || nt == 4) { type = 1; sc = 0.17677669529663687f * LOG2E; }
    else if (nt == 5 || nt == 6) { type = 1; }
    else if (nt >= 17 && nt <= 22) { type = 2; sc = 0.125f * LOG2E; }
    else if (nt >= 23 && nt <= 28) { type = 2; }
    else if (nt == 35) type = 3;
    if (type == 0) {
#pragma unroll
      for (int j = 0; j < 8; ++j) store8bf(dst + 8 * j, cr + 8 * j);
    } else if (type == 1) {
#pragma unroll
      for (int hh = 0; hh < 2; ++hh) {
        float o[32];
        rope32_out(cr + 32 * hh, t32 + (size_t)pos * 16, sc, o);
#pragma unroll
        for (int j = 0; j < 4; ++j) store8bf(dst + 32 * hh + 8 * j, o + 8 * j);
      }
    } else if (type == 2) {
      const float2* tab = t64 + (size_t)pos * 32;
#pragma unroll
      for (int j = 0; j < 4; ++j) {
        float lo[8], hi[8];
#pragma unroll
        for (int e = 0; e < 8; ++e) {
          const float2 cs = tab[8 * j + e];
          const float a = cr[8 * j + e], b = cr[32 + 8 * j + e];
          lo[e] = (a * cs.x - b * cs.y) * sc;
          hi[e] = (b * cs.x + a * cs.y) * sc;
        }
        store8bf(dst + 8 * j, lo);
        store8bf(dst + 32 + 8 * j, hi);
      }
    } else {
      if (half == 0) {
        float o[32];
        rope32_out(cr, t32 + (size_t)pos * 16, 1.f, o);
#pragma unroll
        for (int j = 0; j < 4; ++j) store8bf(dst + 8 * j, o + 8 * j);
      } else {
        const float* c2 = Ct + erow * 132 + 32;
#pragma unroll
        for (int j = 0; j < 4; ++j) {
          float4 v; v.x = c2[4 * j]; v.y = c2[4 * j + 1]; v.z = c2[4 * j + 2]; v.w = c2[4 * j + 3];
          ((float4*)(AB + (size_t)tok * 16))[j] = v;
        }
      }
    }
   }
  }
}

DI void mla_up_tile(CParams& p, int mt, int j, int S, char* lds) {
  EPI_VARS;
  const bf16_t* PR = (const bf16_t*)(p.ws + OFF_PR);
  const bf16_t* wb = (const bf16_t*)(p.ws + OFF_WB);
  bf16_t* Qb = (bf16_t*)(p.ws + OFF_Q);
  bf16_t* Kb = (bf16_t*)(p.ws + OFF_K);
  bf16_t* Vb = (bf16_t*)(p.ws + OFF_V);
  const float2* t32 = (const float2*)(p.ws + OFF_TAB);
  float* Ct = (float*)lds;
  float* rst = (float*)(lds + 67584);
  const bool isq = j < 3;
  const int K = isq ? 256 : 128;
  const int nt = isq ? j : j - 3;
  const bf16_t* A = PR + (size_t)mt * 128 * NPR + (isq ? C_CQ : C_CKV);
  const bf16_t* B = wb + (isq ? W_UQ : W_UKV) + (size_t)nt * 128 * K;
  const int erow = tid >> 1, half = tid & 1;
  {
    const bf16_t* ar = A + (size_t)erow * NPR + half * (K / 2);
    float ss = 0.f;
    for (int c = 0; c < K / 16; ++c) {
      const u32x4 u = *(const u32x4*)(ar + 8 * c);
      const unsigned uu[4] = {u.x, u.y, u.z, u.w};
#pragma unroll
      for (int e = 0; e < 4; ++e) {
        const float lo = __uint_as_float(uu[e] << 16), hi = __uint_as_float(uu[e] & 0xffff0000u);
        ss += lo * lo + hi * hi;
      }
    }
    ss += __shfl_xor(ss, 1);
    if (half == 0) rst[erow] = rsqrtf(ss / (float)K + EPS);
  }
  f32x16 a0[2][2];
  zero_acc<2>(a0);
  gemm_main<2, 1>(a0, a0, A, NPR, B, nullptr, K, K, lds);
  __syncthreads();
  EPI_BEGIN(2)
    Ct[row * 132 + col] = a0[mi][ni][r];
  EPI_END
  __syncthreads();
  const int tok = mt * 128 + erow, pos = tok & (S - 1);
  const float rs = rst[erow];
  const float* cr = Ct + erow * 132 + 64 * half;
  if (isq) {
    const float sc = rs * 0.10206207261596577f * LOG2E;
    if (nt < 2) {
      bf16_t* dst = Qb + ((size_t)tok * 4 + 2 * nt + half) * 96;
#pragma unroll
      for (int jj = 0; jj < 8; ++jj) {
        float o[8];
#pragma unroll
        for (int e = 0; e < 8; ++e) o[e] = cr[8 * jj + e] * sc;
        store8bf(dst + 8 * jj, o);
      }
    } else {
#pragma unroll
      for (int hh = 0; hh < 2; ++hh) {
        float o[32];
        rope32_out(cr + 32 * hh, t32 + (size_t)pos * 16, sc, o);
        bf16_t* dst = Qb + ((size_t)tok * 4 + 2 * half + hh) * 96 + 64;
#pragma unroll
        for (int jj = 0; jj < 4; ++jj) store8bf(dst + 8 * jj, o + 8 * jj);
      }
    }
  } else {
    bf16_t* dst = half == 0 ? (Kb + ((size_t)tok * 4 + nt) * 96) : (Vb + ((size_t)tok * 4 + nt) * 64);
#pragma unroll
    for (int jj = 0; jj < 8; ++jj) {
      float o[8];
#pragma unroll
      for (int e = 0; e < 8; ++e) o[e] = cr[8 * jj + e] * rs;
      store8bf(dst + 8 * jj, o);
    }
    if (half == 0) {
      const u32x4* src = (const u32x4*)(PR + (size_t)tok * NPR + 4480);
#pragma unroll
      for (int jj = 0; jj < 4; ++jj) ((u32x4*)(dst + 64))[jj] = src[jj];
    }
  }
}

typedef short s16x4_t __attribute__((ext_vector_type(4)));
DI bf16x8 tr_pair(const bf16_t* p0, const bf16_t* p1) {
  const s16x4_t lo = __builtin_amdgcn_ds_read_tr16_b64_v4i16((__attribute__((address_space(3))) s16x4_t*)p0);
  const s16x4_t hi = __builtin_amdgcn_ds_read_tr16_b64_v4i16((__attribute__((address_space(3))) s16x4_t*)p1);
  return __builtin_shufflevector(lo, hi, 0, 1, 2, 3, 4, 5, 6, 7);
}

template <int DK, bool BAND>
DI void flash_loop(f32x16 (&O)[2], float& m, float& l, const bf16_t* __restrict__ qrow, const bf16_t* __restrict__ kbase,
                   size_t kstride, const bf16_t* __restrict__ vbase, size_t vstride, int ntiles, int tq, int u0, int L,
                   char* lds) {
  const int tid = threadIdx.x + opq(), lane = tid & 63, l31 = lane & 31, h2 = lane >> 5;
  constexpr int KR = DK + 8, KCH = DK / 8, KN = 64 * KCH / 256;
  constexpr int STAGE = 64 * KR * 2 + 64 * 72 * 2;
  bf16x8 qf[DK / 16];
#pragma unroll
  for (int ks = 0; ks < DK / 16; ++ks) qf[ks] = *(const bf16x8*)(qrow + 16 * ks + 8 * h2);
  u32x4 rkA[KN], rvA[2], rkB[KN], rvB[2];
  auto gload = [&](int kt, u32x4 (&rk)[KN], u32x4 (&rv)[2]) {
#pragma unroll
    for (int i = 0; i < KN; ++i) {
      const int ci = tid + 256 * i, row = ci / KCH, c = ci % KCH;
      int rr = u0 + 64 * kt + row;
      if (BAND) rr = min(max(rr, 0), L - 1);
      rk[i] = *(const u32x4*)((const char*)kbase + ((unsigned)rr * (unsigned)(kstride * 2) + (unsigned)c * 16u));
    }
#pragma unroll
    for (int i = 0; i < 2; ++i) {
      const int ci = tid + 256 * i, row = ci >> 3, c = ci & 7;
      int rr = u0 + 64 * kt + row;
      if (BAND) rr = min(max(rr, 0), L - 1);
      rv[i] = *(const u32x4*)((const char*)vbase + ((unsigned)rr * (unsigned)(vstride * 2) + (unsigned)c * 16u));
    }
  };
  auto swrite = [&](int st, const u32x4 (&rk)[KN], const u32x4 (&rv)[2]) {
    bf16_t* Ks = (bf16_t*)(lds + st * STAGE);
    bf16_t* Vs = Ks + 64 * KR;
#pragma unroll
    for (int i = 0; i < KN; ++i) {
      const int ci = tid + 256 * i, row = ci / KCH, c = ci % KCH;
      *(u32x4*)(Ks + row * KR + c * 8) = rk[i];
    }
#pragma unroll
    for (int i = 0; i < 2; ++i) {
      const int ci = tid + 256 * i, row = ci >> 3, c = ci & 7;
      *(u32x4*)(Vs + row * 72 + c * 8) = rv[i];
    }
  };
  const int trq = (lane & 15) >> 2, trp = lane & 3, trblk = (lane >> 4) & 1;
  const int troff = (4 * h2 + trq) * 72 + 16 * trblk + 4 * trp;
  __syncthreads();
  gload(0, rkA, rvA);
  swrite(0, rkA, rvA);
  gload(1, rkA, rvA);
  if (ntiles > 2) gload(2, rkB, rvB);
  for (int kt2 = 0; kt2 < ntiles; kt2 += 2)
#pragma unroll
  for (int par = 0; par < 2; ++par) {
    const int kt = kt2 + par;
    __syncthreads();
    if (par == 0) {
      if (kt + 1 < ntiles) swrite((kt + 1) & 1, rkA, rvA);
      if (kt + 3 < ntiles) gload(kt + 3, rkA, rvA);
    } else {
      if (kt + 1 < ntiles) swrite((kt + 1) & 1, rkB, rvB);
      if (kt + 3 < ntiles) gload(kt + 3, rkB, rvB);
    }
    const bf16_t* Ks = (const bf16_t*)(lds + (kt & 1) * STAGE);
    const bf16_t* Vs = Ks + 64 * KR;
    f32x16 Sx[2];
#pragma unroll
    for (int j = 0; j < 2; ++j)
#pragma unroll
      for (int r = 0; r < 16; ++r) Sx[j][r] = 0.f;
#pragma unroll
    for (int ks = 0; ks < DK / 16; ++ks)
#pragma unroll
      for (int j = 0; j < 2; ++j) {
        const bf16x8 kf = *(const bf16x8*)(Ks + (32 * j + l31) * KR + 16 * ks + 8 * h2);
        Sx[j] = MFMA32(kf, qf[ks], Sx[j]);
      }
    if (BAND) {
#pragma unroll
      for (int j = 0; j < 2; ++j)
#pragma unroll
        for (int r = 0; r < 16; ++r) {
          const int u = u0 + 64 * kt + 32 * j + crow(r, h2);
          const int d = u - tq;
          const bool valid = (d <= 64) && (d >= -64) && (u >= 0) && (u < L);
          Sx[j][r] = valid ? Sx[j][r] : -1e30f;
        }
    }
    float mx = Sx[0][0];
#pragma unroll
    for (int j = 0; j < 2; ++j)
#pragma unroll
      for (int r = 0; r < 16; ++r) mx = fmaxf(mx, Sx[j][r]);
    mx = xhalf_max(mx);
    if (__any(mx - m > DEFER_THR)) {
      const float mn = fmaxf(m, mx);
      const float alpha = exp2_(m - mn);
      m = mn;
      l *= alpha;
#pragma unroll
      for (int t = 0; t < 2; ++t)
#pragma unroll
        for (int r = 0; r < 16; ++r) O[t][r] *= alpha;
    }
    float ls = 0.f;
#pragma unroll
    for (int j = 0; j < 2; ++j)
#pragma unroll
      for (int r = 0; r < 16; ++r) { const float pv = exp2_(Sx[j][r] - m); Sx[j][r] = pv; ls += pv; }
    l += ls;
#pragma unroll
    for (int j = 0; j < 2; ++j)
#pragma unroll
      for (int s = 0; s < 2; ++s) {
        const bf16x8 pf = pack8(Sx[j][8 * s], Sx[j][8 * s + 1], Sx[j][8 * s + 2], Sx[j][8 * s + 3], Sx[j][8 * s + 4],
                                Sx[j][8 * s + 5], Sx[j][8 * s + 6], Sx[j][8 * s + 7]);
#pragma unroll
        for (int t = 0; t < 2; ++t) {
          const bf16_t* vp = Vs + (32 * j + 16 * s) * 72 + 32 * t + troff;
          const bf16x8 vf = tr_pair(vp, vp + 8 * 72);
          O[t] = MFMA32(vf, pf, O[t]);
        }
      }
  }
}

DI void flash_loop_diff(f32x16 (&O0)[2], f32x16 (&O1)[2], float& m0, float& l0, float& m1, float& l1,
                        const bf16_t* __restrict__ qrow, const bf16_t* __restrict__ kbase, size_t kstride,
                        const bf16_t* __restrict__ vbase, size_t vstride, int ntiles, char* lds) {
  const int tid = threadIdx.x + opq(), lane = tid & 63, l31 = lane & 31, h2 = lane >> 5;
  constexpr int KR = 72;
  constexpr int STAGE = 64 * KR * 2 + 64 * 72 * 2;
  bf16x8 qf0[2], qf1[2];
#pragma unroll
  for (int ks = 0; ks < 2; ++ks) {
    qf0[ks] = *(const bf16x8*)(qrow + 16 * ks + 8 * h2);
    qf1[ks] = *(const bf16x8*)(qrow + 32 + 16 * ks + 8 * h2);
  }
  u32x4 rk[2], rv[2];
  auto gload = [&](int kt) {
#pragma unroll
    for (int i = 0; i < 2; ++i) {
      const int ci = tid + 256 * i, row = ci >> 3, c = ci & 7;
      const int rr = 64 * kt + row;
      rk[i] = *(const u32x4*)((const char*)kbase + ((unsigned)rr * (unsigned)(kstride * 2) + (unsigned)c * 16u));
      rv[i] = *(const u32x4*)((const char*)vbase + ((unsigned)rr * (unsigned)(vstride * 2) + (unsigned)c * 16u));
    }
  };
  auto swrite = [&](int st) {
    bf16_t* Ks = (bf16_t*)(lds + st * STAGE);
    bf16_t* Vs = Ks + 64 * KR;
#pragma unroll
    for (int i = 0; i < 2; ++i) {
      const int ci = tid + 256 * i, row = ci >> 3, c = ci & 7;
      *(u32x4*)(Ks + row * KR + c * 8) = rk[i];
      *(u32x4*)(Vs + row * 72 + c * 8) = rv[i];
    }
  };
  const int trq = (lane & 15) >> 2, trp = lane & 3, trblk = (lane >> 4) & 1;
  const int troff = (4 * h2 + trq) * 72 + 16 * trblk + 4 * trp;
  __syncthreads();
  gload(0);
  swrite(0);
  if (ntiles > 1) gload(1);
  for (int kt = 0; kt < ntiles; ++kt) {
    __syncthreads();
    if (kt + 1 < ntiles) swrite((kt + 1) & 1);
    if (kt + 2 < ntiles) gload(kt + 2);
    const bf16_t* Ks = (const bf16_t*)(lds + (kt & 1) * STAGE);
    const bf16_t* Vs = Ks + 64 * KR;
    bf16x8 pf[2][2][2];
#pragma unroll
    for (int mp = 0; mp < 2; ++mp) {
      f32x16 Sx[2];
#pragma unroll
      for (int j = 0; j < 2; ++j)
#pragma unroll
        for (int r = 0; r < 16; ++r) Sx[j][r] = 0.f;
#pragma unroll
      for (int ks = 0; ks < 2; ++ks)
#pragma unroll
        for (int j = 0; j < 2; ++j) {
          const bf16x8 kf = *(const bf16x8*)(Ks + (32 * j + l31) * KR + 32 * mp + 16 * ks + 8 * h2);
          Sx[j] = MFMA32(kf, mp == 0 ? qf0[ks] : qf1[ks], Sx[j]);
        }
      float& m = mp == 0 ? m0 : m1;
      float& l = mp == 0 ? l0 : l1;
      float mx = Sx[0][0];
#pragma unroll
      for (int j = 0; j < 2; ++j)
#pragma unroll
        for (int r = 0; r < 16; ++r) mx = fmaxf(mx, Sx[j][r]);
      mx = xhalf_max(mx);
      if (__any(mx - m > DEFER_THR)) {
        const float mn = fmaxf(m, mx);
        const float alpha = exp2_(m - mn);
        m = mn;
        l *= alpha;
#pragma unroll
        for (int t = 0; t < 2; ++t)
#pragma unroll
          for (int r = 0; r < 16; ++r) { if (mp == 0) O0[t][r] *= alpha; else O1[t][r] *= alpha; }
      }
      float ls = 0.f;
#pragma unroll
      for (int j = 0; j < 2; ++j)
#pragma unroll
        for (int r = 0; r < 16; ++r) { const float pv = exp2_(Sx[j][r] - m); Sx[j][r] = pv; ls += pv; }
      l += ls;
#pragma unroll
      for (int j = 0; j < 2; ++j)
#pragma unroll
        for (int s = 0; s < 2; ++s)
          pf[mp][j][s] = pack8(Sx[j][8 * s], Sx[j][8 * s + 1], Sx[j][8 * s + 2], Sx[j][8 * s + 3], Sx[j][8 * s + 4],
                               Sx[j][8 * s + 5], Sx[j][8 * s + 6], Sx[j][8 * s + 7]);
    }
#pragma unroll
    for (int j = 0; j < 2; ++j)
#pragma unroll
      for (int s = 0; s < 2; ++s)
#pragma unroll
        for (int t = 0; t < 2; ++t) {
          const bf16_t* vp = Vs + (32 * j + 16 * s) * 72 + 32 * t + troff;
          const bf16x8 vf = tr_pair(vp, vp + 8 * 72);
          O0[t] = MFMA32(vf, pf[0][j][s], O0[t]);
          O1[t] = MFMA32(vf, pf[1][j][s], O1[t]);
        }
  }
}

DI void zeroO(f32x16 (&O)[2]) {
#pragma unroll
  for (int t = 0; t < 2; ++t)
#pragma unroll
    for (int r = 0; r < 16; ++r) O[t][r] = 0.f;
}

DI void store_o(bf16_t* dst, const f32x16 (&O)[2], int h2) {
#pragma unroll
  for (int t = 0; t < 2; ++t)
#pragma unroll
    for (int g = 0; g < 4; ++g) {
      u32x2 u; u.x = pack2(O[t][4 * g], O[t][4 * g + 1]); u.y = pack2(O[t][4 * g + 2], O[t][4 * g + 3]);
      *(u32x2*)(dst + 32 * t + 8 * g + 4 * h2) = u;
    }
}

DI void mla_item(CParams& p, int it, int S, char* lds) {
  const int tid = threadIdx.x + opq(), lane = tid & 63, w = tid >> 6, l31 = lane & 31, h2 = lane >> 5;
  const int lgq = (S == 2048) ? 4 : 7;
  const int qb = it & ((1 << lgq) - 1), bh = it >> lgq, h = bh & 3, b = bh >> 2;
  const int tokbase = b * S, gtok = tokbase + 128 * qb + 32 * w + l31;
  const bf16_t* Qb = (const bf16_t*)(p.ws + OFF_Q);
  const bf16_t* Kb = (const bf16_t*)(p.ws + OFF_K);
  const bf16_t* Vb = (const bf16_t*)(p.ws + OFF_V);
  bf16_t* Y = (bf16_t*)(p.ws + OFF_N);
  f32x16 O[2]; zeroO(O);
  float m = -1e30f, l = 0.f;
  flash_loop<96, false>(O, m, l, Qb + ((size_t)gtok * 4 + h) * 96, Kb + ((size_t)tokbase * 4 + h) * 96, 384,
                        Vb + ((size_t)tokbase * 4 + h) * 64, 256, S / 64, 0, 0, 0, lds);
  l += __shfl_xor(l, 32);
  const float il = 1.f / l;
#pragma unroll
  for (int t = 0; t < 2; ++t)
#pragma unroll
    for (int r = 0; r < 16; ++r) O[t][r] *= il;
  store_o(Y + (size_t)gtok * 1024 + h * 64, O, h2);
}

DI void diff_item(CParams& p, int layer, int it, int S, char* lds) {
  const int tid = threadIdx.x + opq(), lane = tid & 63, w = tid >> 6, l31 = lane & 31, h2 = lane >> 5;
  const int lgq = (S == 2048) ? 4 : 7;
  const int qb = it & ((1 << lgq) - 1), bh = it >> lgq, h = bh & 3, b = bh >> 2;
  const int tokbase = b * S, gtok = tokbase + 128 * qb + 32 * w + l31;
  const bf16_t* PR = (const bf16_t*)(p.ws + OFF_PR);
  bf16_t* Y = (bf16_t*)(p.ws + OFF_N);
  const float* lam = p.diff_lambda + layer * 128;
  float s1 = 0.f, s2 = 0.f;
  if (lane < 32) { s1 = lam[lane] * lam[32 + lane]; s2 = lam[64 + lane] * lam[96 + lane]; }
  s1 = wave_sum(s1); s2 = wave_sum(s2);
  const float lambda_init = layer ? 0.35550907f : 0.2f;
  const float lambda_full = expf(s1) - expf(s2) + lambda_init;
  f32x16 of[2], O1[2];
  zeroO(of); zeroO(O1);
  {
    float m0 = -1e30f, l0 = 0.f, m1 = -1e30f, l1 = 0.f;
    flash_loop_diff(of, O1, m0, l0, m1, l1, PR + (size_t)gtok * NPR + C_BQ + (2 * h) * 32,
                    PR + (size_t)tokbase * NPR + C_BK + (2 * h) * 32, NPR, PR + (size_t)tokbase * NPR + C_BV + h * 64, NPR,
                    S / 64, lds);
    l0 += __shfl_xor(l0, 32);
    l1 += __shfl_xor(l1, 32);
    const float c0 = 1.f / l0, c1 = -lambda_full / l1;
#pragma unroll
    for (int t = 0; t < 2; ++t)
#pragma unroll
      for (int r = 0; r < 16; ++r) of[t][r] = c0 * of[t][r] + c1 * O1[t][r];
  }
  float ss = 0.f;
#pragma unroll
  for (int t = 0; t < 2; ++t)
#pragma unroll
    for (int r = 0; r < 16; ++r) ss += of[t][r] * of[t][r];
  ss += __shfl_xor(ss, 32);
  const float rs = rsqrtf(ss * (1.f / 64.f) + EPS) * (1.f - lambda_init);
  const float* sg = p.diff_subln + layer * 64;
#pragma unroll
  for (int t = 0; t < 2; ++t)
#pragma unroll
    for (int r = 0; r < 16; ++r) of[t][r] *= rs * sg[32 * t + crow(r, h2)];
  store_o(Y + (size_t)gtok * 1024 + 256 + h * 64, of, h2);
}

DI void dil_item(CParams& p, int it, int S, int B, char* lds) {
  const int tid = threadIdx.x + opq(), lane = tid & 63, w = tid >> 6, l31 = lane & 31, h2 = lane >> 5;
  const int lgS = (S == 2048) ? 11 : 14, lgB = (B == 16) ? 4 : 1;
  const int rq = it & ((1 << (lgS - 7)) - 1);
  int rest = it >> (lgS - 7);
  const int head = rest & 3; rest >>= 2;
  const int b = rest & (B - 1), g = rest >> lgB;
  const int lgd = 2 * g, dil = 1 << lgd;
  const int L = S >> lgd, lgnqb = lgS - lgd - 7;
  const int res = rq >> lgnqb, qb = rq & ((1 << lgnqb) - 1);
  const int tokbase = b * S;
  const int tq = 128 * qb + 32 * w + l31;
  const int gtok = tokbase + tq * dil + res;
  const bf16_t* PR = (const bf16_t*)(p.ws + OFF_PR);
  bf16_t* OD = (bf16_t*)(p.ws + OFF_OD);
  float* LSE = (float*)(p.ws + OFF_LSE);
  f32x16 O[2]; zeroO(O);
  float m = -1e30f, l = 0.f;
  const int hc = (g * 4 + head) * 64;
  flash_loop<64, true>(O, m, l, PR + (size_t)gtok * NPR + C_DQ + hc, PR + (size_t)(tokbase + res) * NPR + C_DK + hc,
                       (size_t)dil * NPR, PR + (size_t)(tokbase + res) * NPR + C_DV + hc, (size_t)dil * NPR, 4, tq,
                       128 * qb - 64, L, lds);
  l += __shfl_xor(l, 32);
  const float il = 1.f / l;
#pragma unroll
  for (int t = 0; t < 2; ++t)
#pragma unroll
    for (int r = 0; r < 16; ++r) O[t][r] *= il;
  store_o(OD + ((size_t)g * TG + gtok) * 256 + head * 64, O, h2);
  if (h2 == 0) LSE[((size_t)g * TG + gtok) * 4 + head] = m + __log2f(l);
}

constexpr size_t OFF_X2 = 564 * MiB, WS_BIG = 597 * MiB;
#define DN_QK_OFF (p.big_ws ? OFF_X2 : OFF_OD)
#define DN_GC_OFF ((p.big_ws ? OFF_X2 : OFF_OD) + 32 * MiB)
constexpr size_t DN_UW_OFF = OFF_Q;

DI void dn_prep_item(CParams& p, int layer, int it, int S, char* lds) {
  const int tid = threadIdx.x + opq(), lane = tid & 63, w = tid >> 6, l15 = lane & 15, g4 = lane >> 4;
  const int NC = S / 64;
  const int ch = it % NC, bh = it / NC, h = bh & 3, b = bh >> 2;
  const int tokbase = b * S, s0 = ch * 64;
  const bf16_t* PR = (const bf16_t*)(p.ws + OFF_PR);
  const float* AB = (const float*)(p.ws + OFF_AB);
  bf16_t* QKg = (bf16_t*)(p.ws + DN_QK_OFF) + ((size_t)bh * NC + ch) * 8192;
  bf16_t* raw = (bf16_t*)lds;
  float* convw = (float*)(lds + 27200);
  float* RU = (float*)lds;
  float* RW = (float*)(lds + 16384);
  float* Am = (float*)(lds + 32768);
  bf16_t* Kimg = (bf16_t*)(lds + 50176);
  bf16_t* Qimg = (bf16_t*)(lds + 59392);
  float* gcs = (float*)(lds + 68608);
  float* betas = gcs + 128;
  const float* cw = p.dn_conv + (size_t)layer * 5 * 768;
  {
    u32x4 rawreg[7];
    float cwr[4];
#pragma unroll
    for (int k = 0; k < 7; ++k) {
      const int ci = tid + 256 * k;
      const int rr = ci / 24, c = ci % 24, seg = c >> 3, c8 = c & 7;
      const int s = s0 + rr - 2;
      rawreg[k] = u32x4{0u, 0u, 0u, 0u};
      if (ci < 68 * 24 && s >= 0 && s < S)
        rawreg[k] = *(const u32x4*)(PR + (size_t)(tokbase + s) * NPR + C_DNQKV + seg * 256 + h * 64 + c8 * 8);
    }
#pragma unroll
    for (int k = 0; k < 4; ++k) {
      const int i = tid + 256 * k;
      cwr[k] = 0.f;
      if (i < 960) { const int j = i / 192, c = i % 192; cwr[k] = cw[j * 768 + (c >> 6) * 256 + h * 64 + (c & 63)]; }
    }
#pragma unroll
    for (int k = 0; k < 7; ++k) {
      const int ci = tid + 256 * k;
      const int rr = ci / 24, c = ci % 24, seg = c >> 3, c8 = c & 7;
      if (ci < 68 * 24) *(u32x4*)(raw + rr * 200 + seg * 64 + c8 * 8) = rawreg[k];
    }
#pragma unroll
    for (int k = 0; k < 4; ++k) { const int i = tid + 256 * k; if (i < 960) convw[i] = cwr[k]; }
  }
  if (tid < 128) {
    const int d = tid >> 6, pl = tid & 63;
    const int i = d ? 63 - pl : pl;
    const size_t tok = (size_t)tokbase + s0 + i;
    const float Aexp = expf(p.dn_a_log[layer * 8 + d * 4 + h]);
    const float a = AB[tok * 16 + d * 8 + h] + p.dn_dt_bias[layer * 8 + d * 4 + h];
    const float bb = AB[tok * 16 + d * 8 + 4 + h];
    const float sp = fmaxf(a, 0.f) + __logf(1.f + __expf(-fabsf(a)));
    float g = -Aexp * sp;
#pragma unroll
    for (int o = 1; o < 64; o <<= 1) { const float tv = __shfl_up(g, o); if (lane >= o) g += tv; }
    gcs[tid] = g;
    betas[tid] = sigmoidf_(bb);
    float* GC = (float*)(p.ws + DN_GC_OFF) + (((size_t)bh * 2 + d) * NC + ch) * 64;
    GC[pl] = g;
  }
  __syncthreads();
  const int pp = tid >> 2, cgp = tid & 3;
  float kv[16], vv[16];
  {
    float qv[16];
#pragma unroll
    for (int seg = 0; seg < 3; ++seg) {
      float acc[16];
#pragma unroll
      for (int c = 0; c < 16; ++c) acc[c] = 0.f;
#pragma unroll
      for (int j = 0; j < 5; ++j) {
        const bf16_t* rp = raw + (pp + j) * 200 + seg * 64 + 16 * cgp;
        const float* wp = convw + j * 192 + seg * 64 + 16 * cgp;
        const u32x4 u0 = *(const u32x4*)rp, u1 = *(const u32x4*)(rp + 8);
        const unsigned uu[8] = {u0.x, u0.y, u0.z, u0.w, u1.x, u1.y, u1.z, u1.w};
#pragma unroll
        for (int e = 0; e < 8; ++e) {
          acc[2 * e] += wp[2 * e] * __uint_as_float(uu[e] << 16);
          acc[2 * e + 1] += wp[2 * e + 1] * __uint_as_float(uu[e] & 0xffff0000u);
        }
      }
#pragma unroll
      for (int c = 0; c < 16; ++c) {
        const float sv = acc[c] * __builtin_amdgcn_rcpf(1.f + __expf(-acc[c]));
        if (seg == 0) qv[c] = sv; else if (seg == 1) kv[c] = sv; else vv[c] = sv;
      }
    }
    float sq = 0.f, sk = 0.f;
#pragma unroll
    for (int c = 0; c < 16; ++c) { sq += qv[c] * qv[c]; sk += kv[c] * kv[c]; }
    sq += __shfl_xor(sq, 1); sq += __shfl_xor(sq, 2);
    sk += __shfl_xor(sk, 1); sk += __shfl_xor(sk, 2);
    const float rq = rsqrtf(sq + EPS) * 0.125f, rk = rsqrtf(sk + EPS);
#pragma unroll
    for (int c = 0; c < 16; ++c) { qv[c] *= rq; kv[c] *= rk; }
    store8bf(Kimg + pp * 72 + 16 * cgp, kv); store8bf(Kimg + pp * 72 + 16 * cgp + 8, kv + 8);
    store8bf(Qimg + pp * 72 + 16 * cgp, qv); store8bf(Qimg + pp * 72 + 16 * cgp + 8, qv + 8);
    store8bf(QKg + pp * 64 + 16 * cgp, qv); store8bf(QKg + pp * 64 + 16 * cgp + 8, qv + 8);
    store8bf(QKg + 4096 + pp * 64 + 16 * cgp, kv); store8bf(QKg + 4096 + pp * 64 + 16 * cgp + 8, kv + 8);
  }
  for (int d = 0; d < 2; ++d) {
    __syncthreads();
    {
      const int pl = d ? 63 - pp : pp;
      const float bet = betas[d * 64 + pl], egc = __expf(gcs[d * 64 + pl]);
#pragma unroll
      for (int c = 0; c < 16; ++c) {
        RU[pl * 64 + 16 * cgp + c] = vv[c] * bet;
        RW[pl * 64 + 16 * cgp + c] = kv[c] * bet * egc;
      }
    }
    {
      f32x4 KK[4];
#pragma unroll
      for (int t = 0; t < 4; ++t) KK[t] = f32x4{0.f, 0.f, 0.f, 0.f};
      const int jl = 16 * w + l15;
      const int jrow = d ? 63 - jl : jl;
#pragma unroll
      for (int ks = 0; ks < 2; ++ks) {
        const bf16x8 bfk = *(const bf16x8*)(Kimg + jrow * 72 + 32 * ks + 8 * g4);
#pragma unroll
        for (int rt = 0; rt < 4; ++rt) {
          const int il = 16 * rt + l15;
          const int irow = d ? 63 - il : il;
          const bf16x8 afk = *(const bf16x8*)(Kimg + irow * 72 + 32 * ks + 8 * g4);
          KK[rt] = MFMA16(afk, bfk, KK[rt]);
        }
      }
      const float gcj = gcs[d * 64 + jl];
#pragma unroll
      for (int rt = 0; rt < 4; ++rt)
#pragma unroll
        for (int r = 0; r < 4; ++r) {
          const int i = 16 * rt + 4 * g4 + r;
          const float ee = __expf(fminf(gcs[d * 64 + i] - gcj, 0.f));
          Am[i * 68 + jl] = (i > jl) ? betas[d * 64 + i] * KK[rt][r] * ee : 0.f;
        }
    }
    __syncthreads();
    float xs[32];
#pragma unroll
    for (int q = 0; q < 32; ++q) xs[q] = 0.f;
    const int c = tid >> 1, half = tid & 1;
    {
      const float* Rc = (c < 64) ? (RU + c) : (RW + (c - 64));
      const float* Ah = Am + 4 * half;
#pragma unroll
      for (int i = 0; i < 64; ++i) {
        float part = 0.f;
#pragma unroll
        for (int q = 0; q < (i + 7) / 8; ++q) {
          const f32x4 a = *(const f32x4*)(Ah + i * 68 + 8 * q);
          part += a[0] * xs[4 * q] + a[1] * xs[4 * q + 1] + a[2] * xs[4 * q + 2] + a[3] * xs[4 * q + 3];
        }
        const float other = __int_as_float(__builtin_amdgcn_update_dpp(0, __float_as_int(part), 0xB1, 0xf, 0xf, true));
        const float xi = Rc[i * 64] - (part + other);
        const int loc = ((i >> 3) << 2) + (i & 3);
        if (((i >> 2) & 1) == 0) xs[loc] = (half == 0) ? xi : xs[loc];
        else xs[loc] = (half == 1) ? xi : xs[loc];
        if (i < 16 ? ((i & 7) == 7) : (i < 32 ? ((i & 3) == 3) : ((i & 1) == 1))) asm volatile("" ::: "memory");
      }
    }
    {
      bf16_t* UWg = (bf16_t*)(p.ws + DN_UW_OFF) + ((((size_t)bh * 2 + d) * NC + ch) * 8192);
      const float sgn = (c < 64) ? 1.f : -1.f;
      bf16_t* dst = UWg + ((c < 64) ? c : (4096 + c - 64));
#pragma unroll
      for (int loc = 0; loc < 32; ++loc) {
        const int i = (((loc >> 2) * 2 + half) << 2) + (loc & 3);
        dst[i * 64] = f2bf(sgn * xs[loc]);
      }
    }
  }
}

DI void dn_scan_chain(CParams& p, int it, int S, char* lds) {
  __builtin_amdgcn_s_setprio(3);
  const int tid0 = threadIdx.x + opq();
  const int dir = it & 1, bh = it >> 1, h = bh & 3, b = bh >> 2;
  const int tokbase = b * S, NC = S / 64;
  bf16_t* OUT = (bf16_t*)(p.ws + (dir ? OFF_OB : OFF_OF));
  const bf16_t* QKg = (const bf16_t*)(p.ws + DN_QK_OFF) + (size_t)bh * NC * 8192;
  const bf16_t* UWg = (const bf16_t*)(p.ws + DN_UW_OFF) + (size_t)it * NC * 8192;
  const float* GCg = (const float*)(p.ws + DN_GC_OFF) + (size_t)it * NC * 64;
  bf16_t* Uimg = (bf16_t*)lds;
  bf16_t* Wn = Uimg + 4608;
  bf16_t* Qimg = Wn + 4608;
  bf16_t* Kimg = Qimg + 4608;
  bf16_t* Kt = Kimg + 4608;
  bf16_t* Iimg = Kt + 4608;
  float* gcs = (float*)(lds + 6 * 9216);
  f32x4 Sd[4];
#pragma unroll
  for (int t = 0; t < 4; ++t) Sd[t] = f32x4{0.f, 0.f, 0.f, 0.f};
  u32x4 ru[2], rw[2], rq[2], rk[2];
  float rg = 0.f;
  auto prefetch = [&](int cc_) {
    const int ch_ = dir ? (NC - 1 - cc_) : cc_;
    const int tp = tid0 + opq();
    const bf16_t* uw = UWg + (size_t)ch_ * 8192;
    const bf16_t* qk = QKg + (size_t)ch_ * 8192;
#pragma unroll
    for (int k = 0; k < 2; ++k) {
      const int ci = tp + 256 * k, row = ci >> 3, c8 = ci & 7;
      const int srow = dir ? 63 - row : row;
      ru[k] = *(const u32x4*)(uw + row * 64 + c8 * 8);
      rw[k] = *(const u32x4*)(uw + 4096 + row * 64 + c8 * 8);
      rq[k] = *(const u32x4*)(qk + srow * 64 + c8 * 8);
      rk[k] = *(const u32x4*)(qk + 4096 + srow * 64 + c8 * 8);
    }
    if (tp < 64) rg = GCg[(size_t)ch_ * 64 + tp];
  };
  prefetch(0);
  for (int cc = 0; cc < NC; ++cc) {
    const int tid = tid0 + opq(), lane = tid & 63, w = tid >> 6, l15 = lane & 15, g4 = lane >> 4;
    const int e_col = 16 * w + l15;
    const int ch = dir ? (NC - 1 - cc) : cc;
    const int s0 = ch * 64;
    __syncthreads();
#pragma unroll
    for (int k = 0; k < 2; ++k) {
      const int ci = tid + 256 * k, row = ci >> 3, c8 = ci & 7;
      *(u32x4*)(Uimg + row * 72 + c8 * 8) = ru[k];
      *(u32x4*)(Wn + row * 72 + c8 * 8) = rw[k];
      *(u32x4*)(Qimg + row * 72 + c8 * 8) = rq[k];
      *(u32x4*)(Kimg + row * 72 + c8 * 8) = rk[k];
      const unsigned uu[4] = {rk[k].x, rk[k].y, rk[k].z, rk[k].w};
#pragma unroll
      for (int e = 0; e < 4; ++e) {
        Kt[(8 * c8 + 2 * e) * 72 + row] = (bf16_t)(uu[e] & 0xffffu);
        Kt[(8 * c8 + 2 * e + 1) * 72 + row] = (bf16_t)(uu[e] >> 16);
      }
    }
    if (tid < 64) gcs[tid] = rg;
    if (cc + 1 < NC) prefetch(cc + 1);
    __syncthreads();
    {
      f32x4 QK[4];
#pragma unroll
      for (int t = 0; t < 4; ++t) QK[t] = f32x4{0.f, 0.f, 0.f, 0.f};
#pragma unroll
      for (int ks = 0; ks < 2; ++ks) {
        const bf16x8 bfk = *(const bf16x8*)(Kimg + (16 * w + l15) * 72 + 32 * ks + 8 * g4);
#pragma unroll
        for (int rt = 0; rt < 4; ++rt) {
          const bf16x8 afq = *(const bf16x8*)(Qimg + (16 * rt + l15) * 72 + 32 * ks + 8 * g4);
          QK[rt] = MFMA16(afq, bfk, QK[rt]);
        }
      }
      const float gcj = gcs[e_col];
#pragma unroll
      for (int rt = 0; rt < 4; ++rt)
#pragma unroll
        for (int r = 0; r < 4; ++r) {
          const int i = 16 * rt + 4 * g4 + r;
          const float ee = __expf(fminf(gcs[i] - gcj, 0.f));
          Iimg[i * 72 + e_col] = f2bf((i >= e_col) ? QK[rt][r] * ee : 0.f);
        }
    }
    __syncthreads();
    {
      bf16x8 Bs[2];
#pragma unroll
      for (int ks = 0; ks < 2; ++ks)
        Bs[ks] = pack8(Sd[2 * ks][0], Sd[2 * ks][1], Sd[2 * ks][2], Sd[2 * ks][3], Sd[2 * ks + 1][0], Sd[2 * ks + 1][1],
                       Sd[2 * ks + 1][2], Sd[2 * ks + 1][3]);
      f32x4 vn[4], qs[4], iv[4];
#pragma unroll
      for (int rt = 0; rt < 4; ++rt) {
#pragma unroll
        for (int r = 0; r < 4; ++r) vn[rt][r] = bf2f(Uimg[(16 * rt + 4 * g4 + r) * 72 + e_col]);
        qs[rt] = f32x4{0.f, 0.f, 0.f, 0.f};
        iv[rt] = f32x4{0.f, 0.f, 0.f, 0.f};
#pragma unroll
        for (int ks = 0; ks < 2; ++ks) {
          const bf16_t* wp = Wn + (16 * rt + l15) * 72 + 32 * ks + 4 * g4;
          const bf16_t* qp = Qimg + (16 * rt + l15) * 72 + 32 * ks + 4 * g4;
          vn[rt] = MFMA16(ld2x4(wp, wp + 16), Bs[ks], vn[rt]);
          qs[rt] = MFMA16(ld2x4(qp, qp + 16), Bs[ks], qs[rt]);
        }
      }
      bf16x8 Bv[2];
#pragma unroll
      for (int ks = 0; ks < 2; ++ks)
        Bv[ks] = pack8(vn[2 * ks][0], vn[2 * ks][1], vn[2 * ks][2], vn[2 * ks][3], vn[2 * ks + 1][0], vn[2 * ks + 1][1],
                       vn[2 * ks + 1][2], vn[2 * ks + 1][3]);
#pragma unroll
      for (int rt = 0; rt < 4; ++rt)
#pragma unroll
        for (int ks = 0; ks < 2; ++ks) {
          const bf16_t* ip = Iimg + (16 * rt + l15) * 72 + 32 * ks + 4 * g4;
          iv[rt] = MFMA16(ld2x4(ip, ip + 16), Bv[ks], iv[rt]);
        }
      const float gc63 = gcs[63];
#pragma unroll
      for (int rt = 0; rt < 4; ++rt)
#pragma unroll
        for (int r = 0; r < 4; ++r) {
          const int pos = 16 * rt + 4 * g4 + r;
          const float o = qs[rt][r] * __expf(gcs[pos]) + iv[rt][r];
          const int i = dir ? 63 - pos : pos;
          OUT[((size_t)tokbase + s0 + i) * 256 + h * 64 + e_col] = f2bf(o);
          vn[rt][r] *= __expf(gc63 - gcs[pos]);
        }
      bf16x8 Bv2[2];
#pragma unroll
      for (int ks = 0; ks < 2; ++ks)
        Bv2[ks] = pack8(vn[2 * ks][0], vn[2 * ks][1], vn[2 * ks][2], vn[2 * ks][3], vn[2 * ks + 1][0], vn[2 * ks + 1][1],
                        vn[2 * ks + 1][2], vn[2 * ks + 1][3]);
      const float gl = __expf(gc63);
#pragma unroll
      for (int dt = 0; dt < 4; ++dt) {
#pragma unroll
        for (int r = 0; r < 4; ++r) Sd[dt][r] *= gl;
#pragma unroll
        for (int ks = 0; ks < 2; ++ks) {
          const bf16_t* kp = Kt + (16 * dt + l15) * 72 + 32 * ks + 4 * g4;
          Sd[dt] = MFMA16(ld2x4(kp, kp + 16), Bv2[ks], Sd[dt]);
        }
      }
    }
  }
  __builtin_amdgcn_s_setprio(0);
}

DI void phase_combine(CParams& p, int layer, const float* __restrict__ xg) {
  const int tidq = threadIdx.x + opq(); const int wave = tidq >> 6, lane = tidq & 63;
  const bf16_t* PR = (const bf16_t*)(p.ws + OFF_PR);
  const bf16_t* OD = (const bf16_t*)(p.ws + OFF_OD);
  const float* LSE = (const float*)(p.ws + OFF_LSE);
  const bf16_t* OFb = (const bf16_t*)(p.ws + OFF_OF);
  const bf16_t* OBb = (const bf16_t*)(p.ws + OFF_OB);
  bf16_t* Y = (bf16_t*)(p.ws + OFF_N);
  bf16_t* Np = (bf16_t*)(p.ws + OFF_Q);
  const float* gmix = p.norm_mix + layer * 1024;
  const float* gdn = p.dn_out_norm + layer * 64;
  const int head = lane >> 4;
  for (int r = blockIdx.x * 4 + wave; r < TG; r += gridDim.x * 4) {
    {
      float lg[3];
#pragma unroll
      for (int g = 0; g < 3; ++g) lg[g] = LSE[((size_t)g * TG + r) * 4 + head];
      const float mx = fmaxf(lg[0], fmaxf(lg[1], lg[2]));
      float wg[3], den = 0.f;
#pragma unroll
      for (int g = 0; g < 3; ++g) { wg[g] = exp2_(lg[g] - mx); den += wg[g]; }
      const float id = 1.f / den;
      float o[4] = {0.f, 0.f, 0.f, 0.f};
#pragma unroll
      for (int g = 0; g < 3; ++g) {
        const u32x2 u = ((const u32x2*)(OD + ((size_t)g * TG + r) * 256))[lane];
        const float c = wg[g] * id;
        o[0] += c * __uint_as_float(u.x << 16); o[1] += c * __uint_as_float(u.x & 0xffff0000u);
        o[2] += c * __uint_as_float(u.y << 16); o[3] += c * __uint_as_float(u.y & 0xffff0000u);
      }
      u32x2 ou; ou.x = pack2(o[0], o[1]); ou.y = pack2(o[2], o[3]);
      ((u32x2*)(Y + (size_t)r * 1024 + 768))[lane] = ou;
    }
    {
      const u32x2 uf = ((const u32x2*)(OFb + (size_t)r * 256))[lane];
      const u32x2 ub = ((const u32x2*)(OBb + (size_t)r * 256))[lane];
      const u32x2 uz = ((const u32x2*)(PR + (size_t)r * NPR + C_Z))[lane];
      float o[4], z[4];
      o[0] = __uint_as_float(uf.x << 16) + __uint_as_float(ub.x << 16);
      o[1] = __uint_as_float(uf.x & 0xffff0000u) + __uint_as_float(ub.x & 0xffff0000u);
      o[2] = __uint_as_float(uf.y << 16) + __uint_as_float(ub.y << 16);
      o[3] = __uint_as_float(uf.y & 0xffff0000u) + __uint_as_float(ub.y & 0xffff0000u);
      z[0] = __uint_as_float(uz.x << 16); z[1] = __uint_as_float(uz.x & 0xffff0000u);
      z[2] = __uint_as_float(uz.y << 16); z[3] = __uint_as_float(uz.y & 0xffff0000u);
      float ss = o[0] * o[0] + o[1] * o[1] + o[2] * o[2] + o[3] * o[3];
      ss += __shfl_xor(ss, 1); ss += __shfl_xor(ss, 2); ss += __shfl_xor(ss, 4); ss += __shfl_xor(ss, 8);
      const float rs = rsqrtf(ss * (1.f / 64.f) + EPS);
      const float4 gg = ((const float4*)gdn)[lane & 15];
      u32x2 ou;
      ou.x = pack2(o[0] * rs * gg.x * siluf_(z[0]), o[1] * rs * gg.y * siluf_(z[1]));
      ou.y = pack2(o[2] * rs * gg.z * siluf_(z[2]), o[3] * rs * gg.w * siluf_(z[3]));
      ((u32x2*)(Y + (size_t)r * 1024 + 512))[lane] = ou;
    }
    {
      const float4* xr = (const float4*)(xg + (size_t)r * 1024);
      float4 v[4];
      float ss = 0.f;
#pragma unroll
      for (int i = 0; i < 4; ++i) { v[i] = xr[lane + 64 * i]; ss += v[i].x * v[i].x + v[i].y * v[i].y + v[i].z * v[i].z + v[i].w * v[i].w; }
      ss = wave_sum(ss);
      const float rs = rsqrtf(ss * (1.f / 1024.f) + EPS);
#pragma unroll
      for (int i = 0; i < 4; ++i) {
        const float4 gg = ((const float4*)gmix)[lane + 64 * i];
        u32x2 o; o.x = pack2(v[i].x * rs * gg.x, v[i].y * rs * gg.y); o.y = pack2(v[i].z * rs * gg.z, v[i].w * rs * gg.w);
        ((u32x2*)(Np + (size_t)r * 1024))[lane + 64 * i] = o;
      }
    }
  }
}

#define XB_TMO      128
#define XB_XCNT(j)  (256  + 64 * (j))
#define XB_XSUB(j)  (1280 + 64 * (j))
#define XB_XGEN(j)  (2304 + 64 * (j))
#define XB_TOP      3328
#define XB_TOPGEN   3392
#define XCD_BAR_WORDS 3456
#define XB_SPIN_CAP (1u << 27)
#define LAS __attribute__((address_space(3)))
constexpr size_t OFF_BAR = OFF_CNT + 65536;
DI unsigned xb_ld(unsigned* p) { return __hip_atomic_load(p, __ATOMIC_RELAXED, __HIP_MEMORY_SCOPE_AGENT); }
DI unsigned xb_add(unsigned* p, unsigned v) { return __hip_atomic_fetch_add(p, v, __ATOMIC_RELAXED, __HIP_MEMORY_SCOPE_AGENT); }
DI unsigned xb_xcc_id() { return (unsigned)__builtin_amdgcn_s_getreg((3 << 11) | 20) & 0xFu; }
#define XB_SPIN(cond, bar) do { unsigned _sp = 0; while (cond) { __builtin_amdgcn_s_sleep(1); \
    if ((++_sp & 255u) == 0u) { if (xb_ld(&(bar)[XB_TMO])) break; if (_sp > XB_SPIN_CAP) { atomicAdd(&(bar)[XB_TMO], 1u); break; } } } } while (0)
struct XcdBarrier { unsigned* bar; unsigned x; volatile LAS unsigned* st; };
DI XcdBarrier xcd_barrier_post(unsigned* bar, volatile LAS unsigned* st) {
  XcdBarrier b; b.bar = bar; b.x = xb_xcc_id(); b.st = st;
  if (threadIdx.x == 0) (void)xb_add(&bar[XB_XCNT(b.x)], 1u);
  return b;
}
DI void xcd_barrier_complete(unsigned* bar, unsigned x, unsigned& nloc, unsigned& nx) {
  const unsigned G = gridDim.x * gridDim.y * gridDim.z;
  unsigned sum, cnt, mine, sp = 0u;
  for (;;) {
    sum = 0u; cnt = 0u; mine = 0u;
#pragma unroll
    for (unsigned j = 0; j < 16; ++j) { const unsigned c = xb_ld(&bar[XB_XCNT(j)]); sum += c; cnt += (c > 0u) ? 1u : 0u; mine = (j == x) ? c : mine; }
    if (sum == G) break;
    __builtin_amdgcn_s_sleep(1);
    if ((++sp & 255u) == 0u) { if (xb_ld(&bar[XB_TMO])) break; if (sp > XB_SPIN_CAP) { atomicAdd(&bar[XB_TMO], 1u); break; } }
  }
  nloc = mine > 0u ? mine : 1u; nx = cnt > 0u ? cnt : 1u;
}
DI void xcd_barrier(const XcdBarrier& b) {
  asm volatile("s_waitcnt vmcnt(0)" ::: "memory");
  __syncthreads();
  if (threadIdx.x == 0) {
    unsigned* bar = b.bar;
    __builtin_amdgcn_s_waitcnt(0);
    unsigned nloc = b.st[0], nx = b.st[1];
    if (nloc == 0u) { xcd_barrier_complete(bar, b.x, nloc, nx); b.st[0] = nloc; b.st[1] = nx; }
    const unsigned old = xb_add(&bar[XB_XSUB(b.x)], 1u);
    const unsigned gen = old / nloc;
    if (old + 1u == (gen + 1u) * nloc) {
      __builtin_amdgcn_fence(__ATOMIC_RELEASE, "agent");
      asm volatile("s_waitcnt vmcnt(0)" ::: "memory");
      const unsigned og = xb_add(&bar[XB_TOP], 1u);
      const unsigned tg = og / nx;
      if (og + 1u == (tg + 1u) * nx) xb_add(&bar[XB_TOPGEN], 1u);
      else XB_SPIN(xb_ld(&bar[XB_TOPGEN]) == tg, bar);
      __builtin_amdgcn_fence(__ATOMIC_ACQUIRE, "agent");
      xb_add(&bar[XB_XGEN(b.x)], 1u);
      asm volatile("s_waitcnt vmcnt(0)" ::: "memory");
    } else {
      XB_SPIN(xb_ld(&bar[XB_XGEN(b.x)]) == gen, bar);
      __builtin_amdgcn_fence(__ATOMIC_ACQUIRE, "agent");
      asm volatile("s_waitcnt vmcnt(0)" ::: "memory");
    }
  }
  __syncthreads();
}

#ifndef REP_MIX
#define REP_MIX 1
#endif
#ifndef REP_GEMM
#define REP_GEMM 1
#endif
__global__ void __launch_bounds__(256, 2) mega(Params pk) {
  extern __shared__ __attribute__((aligned(16))) char lds[];
  __shared__ uint4 sh_words;
  cg::grid_group grid = cg::this_grid();
  CParams* kp = (CParams*)__builtin_amdgcn_kernarg_segment_ptr();
  if (threadIdx.x == 0) sh_words = make_uint4(0u, 0u, 0u, 0u);
  __syncthreads();
  XcdBarrier xb;
  { CParams& p = *launder(kp); xb = xcd_barrier_post((unsigned*)(p.ws + OFF_BAR), (volatile LAS unsigned*)&sh_words); }
#define s_item (((volatile int*)&sh_words)[2])
#define GSYNC() xcd_barrier(xb)
#define PP_ CParams& p = *launder(kp); const bf16_t* wb = (const bf16_t*)(p.ws + OFF_WB); bf16_t* Nb = (bf16_t*)(p.ws + OFF_N); \
            bf16_t* PRb = (bf16_t*)(p.ws + OFF_PR); bf16_t* Npb = (bf16_t*)(p.ws + OFF_Q); bf16_t* PB = (bf16_t*)(p.ws + OFF_OD); \
            float* xg = p.x + (size_t)grp * TG * 1024; (void)wb; (void)Nb; (void)PRb; (void)Npb; (void)PB; (void)xg;
  { CParams& p = *launder(kp); phase_init(p, lds); phase_norm(p.x_in[0], p.norm_ff1, (bf16_t*)(p.ws + OFF_Q), nullptr, nullptr); }
  grid.sync();
  for (int layer = 0; layer < 2; ++layer) {
    for (int grp = 0; grp < 2; ++grp) {
      const int S = grp ? 2048 : 16384, B = grp ? 16 : 2;
      const float* xsrc0 = nullptr;
      { CParams& p = *launder(kp); xsrc0 = layer == 0 ? p.x_in[grp] : p.x + (size_t)grp * TG * 1024; }
      for (int rep = 0; rep < REP_GEMM; ++rep) {
        {
        PP_
        phase_ffn_a(Npb, wb + W_FF1_1, wb + W_FF1_3, PRb, lds);
        if (layer == 1 && grp == 0) { __syncthreads(); phase_convert(p, 1, lds, 18, 20); }
      }
        GSYNC();
      }
      { PP_ phase_gemm_resid(PRb, 2816, wb + W_FF1_2, xsrc0, xg, 0.5f, lds); }
      GSYNC();
      { PP_ phase_norm(xg, p.norm_mix + layer * 1024, Nb, nullptr, nullptr); }
      GSYNC();
      for (int rep = 0; rep < REP_GEMM; ++rep) {
        { PP_ phase_proj(p, Nb, wb + W_IN, S, lds); }
        GSYNC();
      }
      {
        PP_
        int* c0 = (int*)(p.ws + OFF_CNT) + (layer * 2 + grp) * 4;
        for (;;) {
          __syncthreads();
          if (threadIdx.x == 0) s_item = atomicAdd(c0, 1);
          __syncthreads();
          const int it = __builtin_amdgcn_readfirstlane(s_item);
          if (it >= 2048) break;
          dn_prep_item(p, layer, it, S, lds);
        }
      }
      GSYNC();
      {
        PP_
        int* cb = (int*)(p.ws + OFF_CNT) + 64 + (layer * 2 + grp) * 32;
        const int nDN = B * 8, nDil = p.big_ws ? 3072 : 0;
        const int lgq = grp ? 4 : 7;
        for (;;) {
          __syncthreads();
          if (threadIdx.x == 0) s_item = atomicAdd(cb, 1);
          __syncthreads();
          const int it = __builtin_amdgcn_readfirstlane(s_item);
          if (it >= nDN) break;
          dn_scan_chain(p, it, S, lds);
        }
        for (int xo = 0; xo < 8; ++xo) {
          const int xq = (blockIdx.x + xo) & 7;
          for (;;) {
            __syncthreads();
            if (threadIdx.x == 0) s_item = atomicAdd(cb + 8 + xq, 1);
            __syncthreads();
            const int j = __builtin_amdgcn_readfirstlane(s_item);
            if (j >= 128) break;
            const int pair = xq + 8 * (j >> lgq), qb = j & ((1 << lgq) - 1);
            diff_item(p, layer, (pair << lgq) + qb, S, lds);
          }
        }
        for (;;) {
          __syncthreads();
          if (threadIdx.x == 0) s_item = atomicAdd(cb + 1, 1);
          __syncthreads();
          const int it = __builtin_amdgcn_readfirstlane(s_item);
          if (it >= nDil) break;
          dil_item(p, it, S, B, lds);
        }
      }
      GSYNC();
      {
        PP_
        int* c2 = (int*)(p.ws + OFF_CNT) + (layer * 2 + grp) * 4 + 2;
        const int nDil = p.big_ws ? 0 : 3072, total = nDil + 256 * 7;
        for (;;) {
          __syncthreads();
          if (threadIdx.x == 0) s_item = atomicAdd(c2, 1);
          __syncthreads();
          int it = __builtin_amdgcn_readfirstlane(s_item);
          if (it >= total) break;
          if (it < nDil) { dil_item(p, it, S, B, lds); continue; }
          it -= nDil;
          mla_up_tile(p, it / 7, it % 7, S, lds);
        }
      }
      GSYNC();
      {
        PP_
        int* cb = (int*)(p.ws + OFF_CNT) + 64 + (layer * 2 + grp) * 32 + 16;
        const int lgq = grp ? 4 : 7;
        for (int xo = 0; xo < 8; ++xo) {
          const int xq = (blockIdx.x + xo) & 7;
          for (;;) {
            __syncthreads();
            if (threadIdx.x == 0) s_item = atomicAdd(cb + xq, 1);
            __syncthreads();
            const int j = __builtin_amdgcn_readfirstlane(s_item);
            if (j >= 128) break;
            const int pair = xq + 8 * (j >> lgq), qb = j & ((1 << lgq) - 1);
            mla_item(p, (pair << lgq) + qb, S, lds);
          }
        }
      }
      GSYNC();
      { PP_ phase_combine(p, layer, xg); }
      GSYNC();
      for (int rep = 0; rep < REP_GEMM; ++rep) {
        { PP_ phase_merge(Npb, Nb, wb + W_G, wb + W_B, PRb, lds); }
        GSYNC();
      }
      { PP_ phase_gemm_resid(PRb, 1024, wb + W_O, xg, xg, 1.0f, lds); }
      GSYNC();
      { PP_ phase_norm(xg, p.norm_ff2 + layer * 1024, Nb, nullptr, nullptr); }
      GSYNC();
      for (int rep = 0; rep < REP_GEMM; ++rep) {
        { PP_ phase_ffn_a(Nb, wb + W_FF2_1, wb + W_FF2_3, PRb, lds); }
        GSYNC();
      }
      { PP_ phase_gemm_resid(PRb, 2816, wb + W_FF2_2, xg, xg, 0.5f, lds); }
      GSYNC();
      { PP_ phase_norm(xg, p.norm_ple + layer * 1024, Nb, p.p_in[grp] + (size_t)layer * TG * 256, PB); }
      GSYNC();
      {
        PP_
        phase_ple(Nb, PB, wb + W_PG, wb + W_PP, xg, lds);
        const int nl = grp ? layer + 1 : layer, ng = grp ^ 1;
        if (nl < 2) phase_norm(nl == 0 ? p.x_in[ng] : p.x + (size_t)ng * TG * 1024, p.norm_ff1 + nl * 1024, Npb, nullptr, nullptr);
        if (layer == 0 && grp == 1) { __syncthreads(); phase_convert(p, 1, lds, 0, 18); }
      }
      GSYNC();
    }
  }
  { CParams& p = *launder(kp); phase_final_norm(p.x, p.norm_final); }
}

extern "C" void kernel_launch(void* const* d_in, const int* in_sizes, int n_in, void* d_out, int out_size, void* d_ws,
                              size_t ws_size, hipStream_t stream) {
  (void)in_sizes; (void)n_in; (void)out_size;
  Params p{};
  p.x_in[0] = (const float*)d_in[0]; p.x_in[1] = (const float*)d_in[1];
  p.p_in[0] = (const float*)d_in[2]; p.p_in[1] = (const float*)d_in[3];
  p.norm_ff1 = (const float*)d_in[4]; p.ff1_w1 = (const float*)d_in[5]; p.ff1_w3 = (const float*)d_in[6];
  p.ff1_w2 = (const float*)d_in[7]; p.norm_mix = (const float*)d_in[8]; p.w_in = (const float*)d_in[9];
  p.mla_q_norm = (const float*)d_in[10]; p.mla_kv_norm = (const float*)d_in[11]; p.mla_w_uq = (const float*)d_in[12];
  p.mla_w_ukv = (const float*)d_in[13]; p.diff_lambda = (const float*)d_in[14]; p.diff_subln = (const float*)d_in[15];
  p.dn_conv = (const float*)d_in[16]; p.dn_a_log = (const float*)d_in[17]; p.dn_dt_bias = (const float*)d_in[18];
  p.dn_out_norm = (const float*)d_in[19]; p.w_branch = (const float*)d_in[20]; p.w_gate = (const float*)d_in[21];
  p.w_out = (const float*)d_in[22]; p.norm_ff2 = (const float*)d_in[23]; p.ff2_w1 = (const float*)d_in[24];
  p.ff2_w3 = (const float*)d_in[25]; p.ff2_w2 = (const float*)d_in[26]; p.norm_ple = (const float*)d_in[27];
  p.ple_gate = (const float*)d_in[28]; p.ple_proj = (const float*)d_in[29]; p.norm_final = (const float*)d_in[30];
  p.x = (float*)d_out;
  p.ws = (char*)d_ws;
  p.big_ws = (ws_size >= WS_BIG) ? 1 : 0;
  static int grid_blocks = 0;
  if (!grid_blocks) {
    int dev = 0, cus = 0, per_cu = 0;
    hipGetDevice(&dev);
    hipDeviceGetAttribute(&cus, hipDeviceAttributeMultiprocessorCount, dev);
    hipFuncSetAttribute((const void*)mega, hipFuncAttributeMaxDynamicSharedMemorySize, (int)LDS_BYTES);
    hipOccupancyMaxActiveBlocksPerMultiprocessor(&per_cu, mega, 256, LDS_BYTES);
    if (per_cu < 1) per_cu = 1;
    grid_blocks = cus * per_cu;
  }
  if (ws_size < WS_NEED) {
    fprintf(stderr, "workspace too small: %zu < %zu\n", ws_size, (size_t)WS_NEED);
    return;
  }
  (void)hipMemsetAsync((char*)d_ws + OFF_BAR, 0, XCD_BAR_WORDS * 4, stream);
  void* args[] = {&p};
  hipError_t e = hipLaunchCooperativeKernel((void*)mega, dim3(grid_blocks), dim3(256), args, LDS_BYTES, stream);
  if (e != hipSuccess) fprintf(stderr, "cooperative launch failed: %s (grid %d)\n", hipGetErrorString(e), grid_blocks);
}
```
